# Optimizing an MI355X kernel written in HIP

```python
import jax
import jax.numpy as jnp
from jax import lax
import numpy as np

D_MODEL = 1024
BATCH = 16
SEQ = 2048
DEPTH = 1

CHUNK = 64
HEAD_DIM = 64
RWKV_WIDTH = D_MODEL // 2
RWKV_HEADS = RWKV_WIDTH // HEAD_DIM
DSA_WIDTH = D_MODEL - RWKV_WIDTH
DSA_HEADS = DSA_WIDTH // HEAD_DIM
MIX_WIDTH = RWKV_WIDTH + DSA_WIDTH
DECAY_LORA = 64
AAA_LORA = 64
GATE_LORA = 128
GN_EPS = HEAD_DIM * 1e-5
KV_LATENT = 128
IDX_HEADS = 4
IDX_DIM = 64
TOPK_MAX = 256
Q_BLOCK = 128
N_GROUPS = 4
EXPERTS_PER_GROUP = 8
N_EXPERTS = N_GROUPS * EXPERTS_PER_GROUP
D_EXPERT = 512
TOP_K_EXPERT = 2
MOE_BLOCK = 128
NORM_EPS = 1e-6
ADA_INIT = 0.5

RWKV_SPLITS = (RWKV_WIDTH, RWKV_WIDTH, RWKV_WIDTH, DECAY_LORA, AAA_LORA, GATE_LORA)
DSA_SPLITS = (DSA_WIDTH, KV_LATENT, IDX_HEADS * IDX_DIM, IDX_DIM, IDX_HEADS)
RWKV_COLS = sum(RWKV_SPLITS)
IN_COLS = RWKV_COLS + sum(DSA_SPLITS)

kernel_name = 'hybrid_rwkv7_dsa_hmoe_block'


def rms_norm(x, g):
    xf = x.astype(jnp.float32)
    y = xf * lax.rsqrt(jnp.mean(xf * xf, axis=-1, keepdims=True) + NORM_EPS)
    return (y * g.astype(jnp.float32)).astype(x.dtype)


def modulate(h, shift, scale):
    return h * (1 + scale[:, None, :]) + shift[:, None, :]


def split_cols(t, sizes):
    return jnp.split(t, np.cumsum(sizes)[:-1].tolist(), axis=-1)


def rwkv7_time_mix(p, shift_mu, w0, w_decay_up, a0, w_aaa_up, w_gate_up, k_k, k_a, r_k, gn_g, gn_b):
    B, S, _ = p.shape
    f32 = jnp.float32
    p_prev = jnp.pad(p, ((0, 0), (1, 0), (0, 0)))[:, :-1]
    p = p + shift_mu * (p_prev - p)
    r, k, v, wl, al, gl = split_cols(p, RWKV_SPLITS)
    log_w = -jax.nn.softplus(-(w0 + jnp.tanh(wl) @ w_decay_up)) - 0.5
    decay = jnp.exp(-jnp.exp(log_w.astype(f32)))
    a = jax.nn.sigmoid(a0 + al @ w_aaa_up)
    g = jax.nn.sigmoid(gl) @ w_gate_up
    heads = lambda t: t.reshape(B, S, RWKV_HEADS, HEAD_DIM).astype(f32)
    kk = heads(k * k_k)
    kk = kk / jnp.maximum(jnp.sqrt(jnp.sum(kk * kk, axis=-1, keepdims=True)), 1e-12)
    k = k * (1 + (a - 1) * k_a)
    r_h, k_h, v_h, a_h, w_h = heads(r), heads(k), heads(v), heads(a), heads(decay)

    def step(state, inp):
        r_t, w_t, k_t, v_t, kk_t, a_t = inp
        sa = jnp.einsum('bhij,bhj->bhi', state, -kk_t)
        state = (state * w_t[:, :, None, :] + sa[..., None] * (kk_t * a_t)[:, :, None, :]
                 + v_t[..., None] * k_t[:, :, None, :])
        return state, jnp.einsum('bhij,bhj->bhi', state, r_t)

    seq_first = lambda t: jnp.swapaxes(t, 0, 1)
    init = jnp.zeros((B, RWKV_HEADS, HEAD_DIM, HEAD_DIM), f32)
    _, y = lax.scan(step, init, (seq_first(r_h), seq_first(w_h), seq_first(k_h),
                                 seq_first(v_h), seq_first(kk), seq_first(a_h)))
    y = seq_first(y)
    mu = jnp.mean(y, axis=-1, keepdims=True)
    var = jnp.mean(jnp.square(y - mu), axis=-1, keepdims=True)
    y = ((y - mu) * lax.rsqrt(var + GN_EPS)).reshape(B, S, RWKV_WIDTH) * gn_g + gn_b
    bonus = (jnp.sum(r_h * k_h * r_k, axis=-1, keepdims=True) * v_h).reshape(B, S, RWKV_WIDTH)
    return ((y + bonus) * g).astype(p.dtype)


def dsa_mix(q, ckv, q_idx, k_idx, w_idx, kv_norm_g, k_idx_norm_g, w_uk, w_uv):
    B, S, _ = q.shape
    topk = min(TOPK_MAX, S // 4)
    f32 = jnp.float32
    ckv = rms_norm(ckv, kv_norm_g)
    q_lat = jnp.einsum('bshd,chd->bshc', q.reshape(B, S, DSA_HEADS, HEAD_DIM), w_uk)
    q_idx = q_idx.reshape(B, S, IDX_HEADS, IDX_DIM)
    k_idx = rms_norm(k_idx, k_idx_norm_g)
    key_chunk = jnp.arange(S) // CHUNK
    gather = jax.vmap(lambda table, idx: table[idx])

    def block(start):
        qi = lax.dynamic_slice_in_dim(q_idx, start, Q_BLOCK, axis=1)
        wi = lax.dynamic_slice_in_dim(w_idx, start, Q_BLOCK, axis=1)
        ql = lax.dynamic_slice_in_dim(q_lat, start, Q_BLOCK, axis=1)
        q_chunk = (start + jnp.arange(Q_BLOCK)) // CHUNK
        admissible = key_chunk[None, :] <= q_chunk[:, None]
        rel = jax.nn.relu(jnp.einsum('bqhd,bsd->bqhs', qi, k_idx).astype(f32) * IDX_DIM ** -0.5)
        score = jnp.einsum('bqh,bqhs->bqs', wi.astype(f32) * IDX_HEADS ** -0.5, rel)
        score = jnp.where(admissible[None], score, -jnp.inf)
        _, sel = lax.top_k(score, topk)
        valid = (sel // CHUNK) <= q_chunk[None, :, None]
        kv = gather(ckv, sel)
        logits = jnp.einsum('bqhc,bqkc->bqhk', ql, kv).astype(f32) * HEAD_DIM ** -0.5
        logits = jnp.where(valid[:, :, None, :], logits, -jnp.inf)
        prob = jax.nn.softmax(logits, axis=-1).astype(kv.dtype)
        o_lat = jnp.einsum('bqhk,bqkc->bqhc', prob, kv)
        return jnp.einsum('bqhc,chd->bqhd', o_lat, w_uv).reshape(B, Q_BLOCK, DSA_WIDTH)

    out = lax.map(block, jnp.arange(S // Q_BLOCK) * Q_BLOCK)
    return jnp.swapaxes(out, 0, 1).reshape(B, S, DSA_WIDTH)


def hierarchical_moe(h, w_group, b_group, w_expert, b_expert, e_gate, e_up, e_down):
    B, S, D = h.shape
    f32 = jnp.float32
    n_tok = B * S
    xf = h.reshape(n_tok, D)
    g_logits = (xf @ w_group).astype(f32) + b_group.astype(f32)
    g_sel = jnp.argmax(g_logits, axis=-1)
    p_group = jnp.take_along_axis(jax.nn.softmax(g_logits, axis=-1), g_sel[:, None], axis=1)
    e_logits = ((xf @ w_expert).astype(f32) + b_expert.astype(f32)).reshape(n_tok, N_GROUPS, EXPERTS_PER_GROUP)
    e_logits = jnp.take_along_axis(e_logits, g_sel[:, None, None], axis=1)[:, 0]
    top_p, top_i = lax.top_k(jax.nn.softmax(e_logits, axis=-1), TOP_K_EXPERT)
    weight = (p_group * top_p / jnp.sum(top_p, axis=-1, keepdims=True)).reshape(-1)
    expert = (g_sel[:, None] * EXPERTS_PER_GROUP + top_i).reshape(-1)
    token = jnp.repeat(jnp.arange(n_tok), TOP_K_EXPERT)
    n_assign = n_tok * TOP_K_EXPERT
    order = jnp.argsort(expert)
    s_exp, s_tok, s_w = expert[order], token[order], weight[order]
    counts = jnp.bincount(expert, length=N_EXPERTS)
    start = jnp.cumsum(counts) - counts
    padded = (counts + MOE_BLOCK - 1) // MOE_BLOCK * MOE_BLOCK
    pend = jnp.cumsum(padded)
    dest = (pend - padded)[s_exp] + jnp.arange(n_assign) - start[s_exp]
    n_blocks = -(-n_assign // MOE_BLOCK) + N_EXPERTS
    n_rows = n_blocks * MOE_BLOCK
    row_tok = jnp.zeros((n_rows,), jnp.int32).at[dest].set(s_tok)
    row_w = jnp.zeros((n_rows,), f32).at[dest].set(s_w)
    block_exp = jnp.minimum(jnp.searchsorted(pend, jnp.arange(n_blocks) * MOE_BLOCK, side='right'), N_EXPERTS - 1)

    def expert_block(args):
        tok, w, e = args
        xb = xf[tok]
        hid = jax.nn.silu(xb @ e_gate[e]) * (xb @ e_up[e])
        return (hid @ e_down[e]) * w[:, None].astype(xb.dtype)

    y = lax.map(expert_block, (row_tok.reshape(n_blocks, MOE_BLOCK), row_w.reshape(n_blocks, MOE_BLOCK), block_exp))
    out = jnp.zeros_like(xf).at[row_tok].add(y.reshape(n_rows, D))
    return out.reshape(B, S, D)


def setup_inputs(seed: int = 0) -> dict:
    key = jax.random.key(seed)
    ks = iter(jax.random.split(key, 40))
    f32 = jnp.float32
    L = DEPTH
    nrm = lambda shape, scale: jax.random.normal(next(ks), shape, f32) * scale
    gain = lambda shape: 1.0 + nrm(shape, 0.02)
    return {
        'x': nrm((BATCH, SEQ, D_MODEL), 1.0),
        'c': nrm((BATCH, D_MODEL), 1.0),
        'ada_w': nrm((L, D_MODEL, 6 * D_MODEL), ADA_INIT * D_MODEL ** -0.5),
        'ada_b': nrm((L, 6 * D_MODEL), 0.01),
        'norm1_g': gain((L, D_MODEL)),
        'w_in': nrm((L, D_MODEL, IN_COLS), D_MODEL ** -0.5),
        'shift_mu': jax.random.uniform(next(ks), (L, RWKV_COLS), f32),
        'w0': jax.random.uniform(next(ks), (L, RWKV_WIDTH), f32, minval=-6.0, maxval=0.0),
        'w_decay_up': nrm((L, DECAY_LORA, RWKV_WIDTH), 0.5 * DECAY_LORA ** -0.5),
        'a0': nrm((L, RWKV_WIDTH), 0.1),
        'w_aaa_up': nrm((L, AAA_LORA, RWKV_WIDTH), AAA_LORA ** -0.5),
        'w_gate_up': nrm((L, GATE_LORA, RWKV_WIDTH), GATE_LORA ** -0.5),
        'k_k': 0.85 + nrm((L, RWKV_WIDTH), 0.02),
        'k_a': gain((L, RWKV_WIDTH)),
        'r_k': nrm((L, RWKV_HEADS, HEAD_DIM), 0.1),
        'gn_g': gain((L, RWKV_WIDTH)),
        'gn_b': nrm((L, RWKV_WIDTH), 0.01),
        'kv_norm_g': gain((L, KV_LATENT)),
        'k_idx_norm_g': gain((L, IDX_DIM)),
        'w_uk': nrm((L, KV_LATENT, DSA_HEADS, HEAD_DIM), KV_LATENT ** -0.5),
        'w_uv': nrm((L, KV_LATENT, DSA_HEADS, HEAD_DIM), KV_LATENT ** -0.5),
        'w_out': nrm((L, MIX_WIDTH, D_MODEL), MIX_WIDTH ** -0.5),
        'norm2_g': gain((L, D_MODEL)),
        'w_group': nrm((L, D_MODEL, N_GROUPS), D_MODEL ** -0.5),
        'b_group': nrm((L, N_GROUPS), 0.01),
        'w_expert': nrm((L, D_MODEL, N_EXPERTS), D_MODEL ** -0.5),
        'b_expert': nrm((L, N_EXPERTS), 0.01),
        'e_gate': nrm((L, N_EXPERTS, D_MODEL, D_EXPERT), D_MODEL ** -0.5),
        'e_up': nrm((L, N_EXPERTS, D_MODEL, D_EXPERT), D_MODEL ** -0.5),
        'e_down': nrm((L, N_EXPERTS, D_EXPERT, D_MODEL), D_EXPERT ** -0.5),
        'final_ada_w': nrm((D_MODEL, 2 * D_MODEL), ADA_INIT * D_MODEL ** -0.5),
        'final_ada_b': nrm((2 * D_MODEL,), 0.01),
        'final_norm_g': gain((D_MODEL,)),
    }


def reference(x, c, ada_w, ada_b, norm1_g, w_in, shift_mu, w0, w_decay_up, a0, w_aaa_up, w_gate_up,
              k_k, k_a, r_k, gn_g, gn_b, kv_norm_g, k_idx_norm_g, w_uk, w_uv, w_out, norm2_g,
              w_group, b_group, w_expert, b_expert, e_gate, e_up, e_down,
              final_ada_w, final_ada_b, final_norm_g):
    c_act = jax.nn.silu(c)
    for l in range(DEPTH):
        shift1, scale1, gate1, shift2, scale2, gate2 = jnp.split(c_act @ ada_w[l] + ada_b[l], 6, axis=-1)
        h = modulate(rms_norm(x, norm1_g[l]), shift1, scale1)
        proj = h @ w_in[l]
        y_rwkv = rwkv7_time_mix(proj[..., :RWKV_COLS], shift_mu[l], w0[l], w_decay_up[l], a0[l],
                                w_aaa_up[l], w_gate_up[l], k_k[l], k_a[l], r_k[l], gn_g[l], gn_b[l])
        q, ckv, q_idx, k_idx, w_idx = split_cols(proj[..., RWKV_COLS:], DSA_SPLITS)
        y_dsa = dsa_mix(q, ckv, q_idx, k_idx, w_idx, kv_norm_g[l], k_idx_norm_g[l], w_uk[l], w_uv[l])
        mixed = jnp.concatenate([y_rwkv, y_dsa], axis=-1) @ w_out[l]
        x = x + (1 + gate1[:, None, :]) * mixed
        h = modulate(rms_norm(x, norm2_g[l]), shift2, scale2)
        x = x + (1 + gate2[:, None, :]) * hierarchical_moe(h, w_group[l], b_group[l], w_expert[l], b_expert[l],
                                                           e_gate[l], e_up[l], e_down[l])
    shift_f, scale_f = jnp.split(c_act @ final_ada_w + final_ada_b, 2, axis=-1)
    return modulate(rms_norm(x, final_norm_g), shift_f, scale_f)
```

```cpp
#include <hip/hip_runtime.h>
#include <hip/hip_cooperative_groups.h>
#include <stdint.h>
#include <stdio.h>

namespace cg = cooperative_groups;

#ifndef MEGA
#define MEGA 0
#endif

typedef unsigned short bf16_t;
typedef short bf16x8 __attribute__((ext_vector_type(8)));
typedef float f32x16 __attribute__((ext_vector_type(16)));
typedef float f32x4 __attribute__((ext_vector_type(4)));
typedef unsigned u32x4 __attribute__((ext_vector_type(4)));
typedef unsigned u32x2 __attribute__((ext_vector_type(2)));

#define DI __device__ __forceinline__

constexpr int DM = 1024, BATCH = 16, SEQ = 2048, NTOK = BATCH * SEQ;
constexpr int RW = 512, NH = 8, HD = 64;
constexpr int PROJ_N = 2756, PROJ_LD = 2816;
constexpr int C_R = 0, C_K = 512, C_V = 1024, C_WL = 1536, C_AL = 1600, C_GL = 1664;
constexpr int C_Q = 1792, C_CKV = 2304, C_QI = 2432, C_KI = 2688, C_WI = 2752;
constexpr int NEXP = 32, DEXP = 512, LCAP = 32768;
constexpr int NTHR = 512;
constexpr int LDS_BYTES = 65536;

constexpr size_t MiB = 1048576;
constexpr size_t OFF_A = 0;
constexpr size_t OFF_B = 64 * MiB;
constexpr size_t OFF_C = 240 * MiB;
constexpr size_t OFF_F = 400 * MiB;
constexpr size_t OFF_G = 464 * MiB;
constexpr size_t OFF_W = 484 * MiB;
constexpr size_t OFF_S = 492 * MiB;

struct Params {
  const float *x, *c, *ada_w, *ada_b, *norm1_g, *w_in, *shift_mu, *w0, *w_decay_up, *a0, *w_aaa_up, *w_gate_up;
  const float *k_k, *k_a, *r_k, *gn_g, *gn_b, *kv_norm_g, *k_idx_norm_g, *w_uk, *w_uv, *w_out, *norm2_g;
  const float *w_group, *b_group, *w_expert, *b_expert, *e_gate, *e_up, *e_down, *final_ada_w, *final_ada_b, *final_norm_g;
  float* out;
  char* ws;
};

DI float bf2f(bf16_t u) { return __uint_as_float(((unsigned)u) << 16); }
DI bf16_t f2bf(float f) { unsigned u = __float_as_uint(f); u += 0x7fffu + ((u >> 16) & 1u); return (bf16_t)(u >> 16); }
DI unsigned pack2(float lo, float hi) { return (unsigned)f2bf(lo) | ((unsigned)f2bf(hi) << 16); }
DI float wave_sum(float v) { for (int o = 32; o; o >>= 1) v += __shfl_xor(v, o); return v; }
DI float wave_max(float v) { for (int o = 32; o; o >>= 1) v = fmaxf(v, __shfl_xor(v, o)); return v; }
DI float sigmoidf_(float v) { return 1.0f / (1.0f + __expf(-v)); }
DI int crow(int r, int hi) { return (r & 3) + 8 * (r >> 2) + 4 * hi; }

DI bf16_t* ws_h1(const Params& p) { return (bf16_t*)(p.ws + OFF_A); }
DI float* ws_y(const Params& p) { return (float*)(p.ws + OFF_A); }
DI bf16_t* ws_h2(const Params& p) { return (bf16_t*)(p.ws + OFF_A); }
DI bf16_t* ws_proj(const Params& p) { return (bf16_t*)(p.ws + OFF_B); }
DI bf16_t* ws_wgu(const Params& p) { return (bf16_t*)(p.ws + OFF_B); }
DI bf16_t* ws_wd(const Params& p) { return (bf16_t*)(p.ws + OFF_B + 64 * MiB); }
DI bf16_t* ws_hid(const Params& p) { return (bf16_t*)(p.ws + OFF_B + 96 * MiB); }
DI bf16_t* ws_kp(const Params& p) { return (bf16_t*)(p.ws + OFF_C); }
DI bf16_t* ws_kk(const Params& p) { return (bf16_t*)(p.ws + OFF_C + 32 * MiB); }
DI bf16_t* ws_bb(const Params& p) { return (bf16_t*)(p.ws + OFF_C + 64 * MiB); }
DI bf16_t* ws_ee(const Params& p) { return (bf16_t*)(p.ws + OFF_C + 96 * MiB); }
DI bf16_t* ws_gg(const Params& p) { return (bf16_t*)(p.ws + OFF_C + 128 * MiB); }
DI bf16_t* ws_mix(const Params& p) { return (bf16_t*)(p.ws + OFF_C); }
DI bf16_t* ws_ybuf(const Params& p) { return (bf16_t*)(p.ws + OFF_C); }
DI bf16_t* ws_qlat(const Params& p) { return (bf16_t*)(p.ws + OFF_F); }
DI bf16_t* ws_ckv(const Params& p) { return (bf16_t*)(p.ws + OFF_G); }
DI bf16_t* ws_kidx(const Params& p) { return (bf16_t*)(p.ws + OFF_G + 8 * MiB); }
DI unsigned* ws_mask(const Params& p) { return (unsigned*)(p.ws + OFF_G + 12 * MiB); }
DI bf16_t* ws_wtin(const Params& p) { return (bf16_t*)(p.ws + OFF_W); }
DI bf16_t* ws_wtout(const Params& p) { return (bf16_t*)(p.ws + OFF_W + 6 * MiB); }
DI float* ws_mod(const Params& p) { return (float*)(p.ws + OFF_S); }
DI float* ws_fmod(const Params& p) { return (float*)(p.ws + OFF_S + 512 * 1024); }
DI float* ws_bonus(const Params& p) { return (float*)(p.ws + OFF_S + 1 * MiB); }
DI int* ws_cnt(const Params& p) { return (int*)(p.ws + OFF_S + 2 * MiB); }
DI float* ws_wa(const Params& p) { return (float*)(p.ws + OFF_S + 2 * MiB + 4096); }
DI int* ws_list(const Params& p) { return (int*)(p.ws + OFF_S + 3 * MiB); }

template <class RowMap>
DI void transpose_tile(const float* src, int N, int k0, int n0, bf16_t* dst, int dstld, RowMap rm, char* lds) {
  float* tile = (float*)lds;
  const int t = threadIdx.x;
  __syncthreads();
  {
    const int nc = t & 63, krb = t >> 6;
#pragma unroll
    for (int i = 0; i < 8; ++i) {
      const int kr = krb + 8 * i;
      const int n = n0 + nc;
      tile[kr * 65 + nc] = (n < N) ? src[(size_t)(k0 + kr) * N + n] : 0.f;
    }
  }
  __syncthreads();
  {
    const int nr = t >> 3, kc = (t & 7) * 8;
    u32x4 w;
    w.x = pack2(tile[(kc + 0) * 65 + nr], tile[(kc + 1) * 65 + nr]);
    w.y = pack2(tile[(kc + 2) * 65 + nr], tile[(kc + 3) * 65 + nr]);
    w.z = pack2(tile[(kc + 4) * 65 + nr], tile[(kc + 5) * 65 + nr]);
    w.w = pack2(tile[(kc + 6) * 65 + nr], tile[(kc + 7) * 65 + nr]);
    *(u32x4*)(dst + (size_t)rm(n0 + nr) * dstld + k0 + kc) = w;
  }
}
struct RowId { DI int operator()(int n) const { return n; } };
struct RowGU { int add; DI int operator()(int n) const { return (n >> 5) * 64 + (n & 31) + add; } };

DI void phase0(const Params& p, int bid, int nb, char* lds) {
  const int t = threadIdx.x;
  if (bid == 0 && t < NEXP) ws_cnt(p)[t] = 0;
  for (int task = bid; task < 256; task += nb) {
    float* cact = (float*)lds;
    __syncthreads();
    for (int i = t; i < 16 * 1024; i += NTHR) { const float v = p.c[i]; cact[i] = v / (1.0f + __expf(-v)); }
    __syncthreads();
    const int col = task * 32 + (t & 31), ks = t >> 5;
    const float* w; int ld, cc;
    if (col < 6144) { w = p.ada_w; ld = 6144; cc = col; } else { w = p.final_ada_w; ld = 2048; cc = col - 6144; }
    float acc[16];
#pragma unroll
    for (int b = 0; b < 16; ++b) acc[b] = 0.f;
    for (int kk = 0; kk < 64; ++kk) {
      const int k = ks * 64 + kk;
      const float wv = w[(size_t)k * ld + cc];
#pragma unroll
      for (int b = 0; b < 16; ++b) acc[b] += cact[b * 1024 + k] * wv;
    }
    __syncthreads();
    float* red = (float*)lds;
#pragma unroll
    for (int b = 0; b < 16; ++b) red[(ks * 16 + b) * 32 + (t & 31)] = acc[b];
    __syncthreads();
    {
      const int b = t >> 5, cl = t & 31, colo = task * 32 + cl;
      float s = 0.f;
      for (int k2 = 0; k2 < 16; ++k2) s += red[(k2 * 16 + b) * 32 + cl];
      if (colo < 6144) ws_mod(p)[b * 6144 + colo] = s + p.ada_b[colo];
      else ws_fmod(p)[b * 2048 + colo - 6144] = s + p.final_ada_b[colo - 6144];
    }
  }
  for (int task = bid; task < 704 + 256; task += nb) {
    if (task < 704) { const int kt = task / 44, nt = task % 44; transpose_tile(p.w_in, PROJ_N, kt * 64, nt * 64, ws_wtin(p), 1024, RowId(), lds); }
    else { const int q = task - 704, kt = q >> 4, nt = q & 15; transpose_tile(p.w_out, 1024, kt * 64, nt * 64, ws_wtout(p), 1024, RowId(), lds); }
  }
}

DI void phase1(const Params& p, int bid, int nb, char* lds) {
  const int lane = threadIdx.x & 63, wid = threadIdx.x >> 6;
  const float* mod = ws_mod(p);
  for (int row = bid * 8 + wid; row < NTOK; row += nb * 8) {
    const int b = row >> 11;
    const float* xr = p.x + (size_t)row * DM;
    f32x4 v[4]; float ss = 0.f;
#pragma unroll
    for (int i = 0; i < 4; ++i) { v[i] = *(const f32x4*)(xr + lane * 4 + 256 * i); ss += v[i][0] * v[i][0] + v[i][1] * v[i][1] + v[i][2] * v[i][2] + v[i][3] * v[i][3]; }
    ss = wave_sum(ss);
    const float rstd = rsqrtf(ss * (1.0f / DM) + 1e-6f);
#pragma unroll
    for (int i = 0; i < 4; ++i) {
      const int col = lane * 4 + 256 * i;
      const f32x4 g = *(const f32x4*)(p.norm1_g + col), sh = *(const f32x4*)(mod + b * 6144 + col), sc = *(const f32x4*)(mod + b * 6144 + 1024 + col);
      float o[4];
#pragma unroll
      for (int j = 0; j < 4; ++j) o[j] = v[i][j] * rstd * g[j] * (1.0f + sc[j]) + sh[j];
      u32x2 w; w.x = pack2(o[0], o[1]); w.y = pack2(o[2], o[3]);
      *(u32x2*)(ws_h1(p) + (size_t)row * DM + col) = w;
    }
  }
}

constexpr int GBM = 256, GBN = 128, GBK = 32, GROW = 80, G_LDSA = GBM * GROW, G_STAGE = (GBM + GBN) * GROW;
template <class ARow, class Epi>
DI void gemm_tile(const bf16_t* A, int lda, ARow arow, const bf16_t* Bt, int ldb, int n0, int K, Epi epi, char* lds) {
  const int t = threadIdx.x, lane = t & 63, wid = t >> 6, wm = wid >> 1, wn = wid & 1, r32 = lane & 31, hi = lane >> 5;
  const int srow = t >> 2, sch = t & 3;
  const bf16_t* a0p = A + (size_t)arow(srow) * lda + sch * 8;
  const bf16_t* a1p = A + (size_t)arow(srow + 128) * lda + sch * 8;
  const bf16_t* bp = Bt + (size_t)(n0 + srow) * ldb + sch * 8;
  const int wa0 = srow * GROW + sch * 16, wa1 = (srow + 128) * GROW + sch * 16, wb = G_LDSA + srow * GROW + sch * 16;
  const int ra = (wm * 64 + r32) * GROW + hi * 16, rb = G_LDSA + (wn * 64 + r32) * GROW + hi * 16;
  f32x16 acc[2][2];
#pragma unroll
  for (int i = 0; i < 2; ++i)
#pragma unroll
    for (int j = 0; j < 2; ++j)
#pragma unroll
      for (int r = 0; r < 16; ++r) acc[i][j][r] = 0.f;
  u32x4 ga0 = *(const u32x4*)a0p, ga1 = *(const u32x4*)a1p, gb = *(const u32x4*)bp;
  __syncthreads();
  *(u32x4*)(lds + wa0) = ga0; *(u32x4*)(lds + wa1) = ga1; *(u32x4*)(lds + wb) = gb;
  __syncthreads();
  const int nk = K / GBK;
  for (int kt = 0; kt < nk; ++kt) {
    char* cur = lds + (kt & 1) * G_STAGE;
    char* nxt = lds + ((kt + 1) & 1) * G_STAGE;
    if (kt + 1 < nk) { ga0 = *(const u32x4*)(a0p + (kt + 1) * GBK); ga1 = *(const u32x4*)(a1p + (kt + 1) * GBK); gb = *(const u32x4*)(bp + (kt + 1) * GBK); }
#pragma unroll
    for (int ks = 0; ks < 2; ++ks) {
      bf16x8 a[2], b[2];
#pragma unroll
      for (int i = 0; i < 2; ++i) { a[i] = *(const bf16x8*)(cur + ra + i * 32 * GROW + ks * 32); b[i] = *(const bf16x8*)(cur + rb + i * 32 * GROW + ks * 32); }
#pragma unroll
      for (int i = 0; i < 2; ++i)
#pragma unroll
        for (int j = 0; j < 2; ++j) acc[i][j] = __builtin_amdgcn_mfma_f32_32x32x16_bf16(a[i], b[j], acc[i][j], 0, 0, 0);
    }
    if (kt + 1 < nk) { *(u32x4*)(nxt + wa0) = ga0; *(u32x4*)(nxt + wa1) = ga1; *(u32x4*)(nxt + wb) = gb; }
    __syncthreads();
  }
#pragma unroll
  for (int i = 0; i < 2; ++i)
#pragma unroll
    for (int r = 0; r < 16; ++r) epi(wm * 64 + i * 32 + crow(r, hi), wn * 64 + r32, acc[i][0][r], acc[i][1][r]);
}

struct ARowBase { int base; DI int operator()(int r) const { return base + r; } };

struct EpiProj { bf16_t* o; int row0, col0; DI void operator()(int r, int c, float v0, float v1) const {
  bf16_t* q = o + (size_t)(row0 + r) * PROJ_LD + col0 + c; q[0] = f2bf(v0); q[32] = f2bf(v1); } };
DI void phase2(const Params& p, int bid, int nb, char* lds) {
  constexpr int NT = PROJ_LD / GBN;
  for (int tile = bid; tile < (NTOK / GBM) * NT; tile += nb) {
    const int mt = tile / NT, nt = tile % NT;
    gemm_tile(ws_h1(p), DM, ARowBase{mt * GBM}, ws_wtin(p), DM, nt * GBN, DM, EpiProj{ws_proj(p), mt * GBM, nt * GBN}, lds);
  }
}

DI float proj_shift(const bf16_t* proj, const float* mu, int gt, int col) {
  const float pv = bf2f(proj[(size_t)gt * PROJ_LD + col]);
  const float pp = (gt & (SEQ - 1)) ? bf2f(proj[(size_t)(gt - 1) * PROJ_LD + col]) : 0.f;
  return pv + mu[col] * (pp - pv);
}
DI void phase3a(const Params& p, int bid, int nb, char* lds) {
  const int t = threadIdx.x, lane = t & 63, wid = t >> 6;
  float* xl = (float*)lds;
  const bf16_t* proj = ws_proj(p);
  for (int tile = bid; tile < NTOK / 16; tile += nb) {
    const int t0 = tile * 16;
    __syncthreads();
    for (int idx = t; idx < 16 * 256; idx += NTHR) {
      const int tok = idx >> 8, col = idx & 255;
      float v = proj_shift(proj, p.shift_mu, t0 + tok, C_WL + col);
      if (col < 64) v = tanhf(v); else if (col >= 128) v = sigmoidf_(v);
      xl[idx] = v;
    }
    __syncthreads();
    const int c = t;
    float acc[16];
#pragma unroll
    for (int i = 0; i < 16; ++i) acc[i] = 0.f;
    for (int k4 = 0; k4 < 16; ++k4) {
      float w[4];
#pragma unroll
      for (int j = 0; j < 4; ++j) w[j] = p.w_decay_up[(k4 * 4 + j) * RW + c];
#pragma unroll
      for (int i = 0; i < 16; ++i) { const f32x4 xv = *(const f32x4*)(xl + i * 256 + k4 * 4); acc[i] += xv[0] * w[0] + xv[1] * w[1] + xv[2] * w[2] + xv[3] * w[3]; }
    }
    {
      const float w0c = p.w0[c];
#pragma unroll
      for (int i = 0; i < 16; ++i) {
        const float z = -(w0c + acc[i]);
        const float sp = fmaxf(z, 0.f) + log1pf(__expf(-fabsf(z)));
        ws_ee(p)[(size_t)(t0 + i) * RW + c] = f2bf(__expf(-sp - 0.5f));
      }
    }
#pragma unroll
    for (int i = 0; i < 16; ++i) acc[i] = 0.f;
    for (int k4 = 0; k4 < 32; ++k4) {
      float w[4];
#pragma unroll
      for (int j = 0; j < 4; ++j) w[j] = p.w_gate_up[(k4 * 4 + j) * RW + c];
#pragma unroll
      for (int i = 0; i < 16; ++i) { const f32x4 xv = *(const f32x4*)(xl + i * 256 + 128 + k4 * 4); acc[i] += xv[0] * w[0] + xv[1] * w[1] + xv[2] * w[2] + xv[3] * w[3]; }
    }
#pragma unroll
    for (int i = 0; i < 16; ++i) ws_gg(p)[(size_t)(t0 + i) * RW + c] = f2bf(acc[i]);
#pragma unroll
    for (int i = 0; i < 16; ++i) acc[i] = 0.f;
    for (int k4 = 0; k4 < 16; ++k4) {
      float w[4];
#pragma unroll
      for (int j = 0; j < 4; ++j) w[j] = p.w_aaa_up[(k4 * 4 + j) * RW + c];
#pragma unroll
      for (int i = 0; i < 16; ++i) { const f32x4 xv = *(const f32x4*)(xl + i * 256 + 64 + k4 * 4); acc[i] += xv[0] * w[0] + xv[1] * w[1] + xv[2] * w[2] + xv[3] * w[3]; }
    }
    {
      const float a0c = p.a0[c], kkc = p.k_k[c], kac = p.k_a[c], rkc = p.r_k[c];
#pragma unroll
      for (int i = 0; i < 16; ++i) {
        const int gt = t0 + i;
        const float a = sigmoidf_(a0c + acc[i]);
        const float r = proj_shift(proj, p.shift_mu, gt, C_R + c);
        const float k = proj_shift(proj, p.shift_mu, gt, C_K + c);
        float kk = k * kkc;
        const float nrm = fmaxf(sqrtf(wave_sum(kk * kk)), 1e-12f);
        kk = kk / nrm;
        const float kp = k * (1.0f + (a - 1.0f) * kac);
        const float bs = wave_sum(r * kp * rkc);
        ws_kp(p)[(size_t)gt * RW + c] = f2bf(kp);
        ws_kk(p)[(size_t)gt * RW + c] = f2bf(kk);
        ws_bb(p)[(size_t)gt * RW + c] = f2bf(kk * a);
        if (lane == 0) ws_bonus(p)[gt * NH + wid] = bs;
      }
    }
  }
}

DI void phase3b(const Params& p, int bid, int nb, char* lds) {
  const int t = threadIdx.x, lane = t & 63, wid = t >> 6;
  float* ql = (float*)lds;
  const bf16_t* proj = ws_proj(p);
  for (int tile = bid; tile < NTOK / 16; tile += nb) {
    const int t0 = tile * 16;
    __syncthreads();
    for (int idx = t; idx < 16 * 512; idx += NTHR) ql[idx] = bf2f(proj[(size_t)(t0 + (idx >> 9)) * PROJ_LD + C_Q + (idx & 511)]);
#pragma unroll
    for (int q = 0; q < 2; ++q) {
      const int gt = t0 + wid * 2 + q;
      const float v0 = bf2f(proj[(size_t)gt * PROJ_LD + C_CKV + lane * 2]), v1 = bf2f(proj[(size_t)gt * PROJ_LD + C_CKV + lane * 2 + 1]);
      const float rs = rsqrtf(wave_sum(v0 * v0 + v1 * v1) * (1.0f / 128.0f) + 1e-6f);
      *(unsigned*)(ws_ckv(p) + (size_t)gt * 128 + lane * 2) = pack2(v0 * rs * p.kv_norm_g[lane * 2], v1 * rs * p.kv_norm_g[lane * 2 + 1]);
      const float u = bf2f(proj[(size_t)gt * PROJ_LD + C_KI + lane]);
      const float rs2 = rsqrtf(wave_sum(u * u) * (1.0f / 64.0f) + 1e-6f);
      ws_kidx(p)[(size_t)gt * 64 + lane] = f2bf(u * rs2 * p.k_idx_norm_g[lane]);
    }
    __syncthreads();
    const int h = wid;
#pragma unroll 1
    for (int ps = 0; ps < 2; ++ps) {
      const int cidx = lane + 64 * ps;
      float w[64];
      const float* wp = p.w_uk + (size_t)(cidx * NH + h) * HD;
#pragma unroll
      for (int d4 = 0; d4 < 16; ++d4) { const f32x4 wv = *(const f32x4*)(wp + d4 * 4); w[d4 * 4] = wv[0]; w[d4 * 4 + 1] = wv[1]; w[d4 * 4 + 2] = wv[2]; w[d4 * 4 + 3] = wv[3]; }
#pragma unroll 1
      for (int i = 0; i < 16; ++i) {
        float acc = 0.f;
#pragma unroll
        for (int d4 = 0; d4 < 16; ++d4) { const f32x4 qv = *(const f32x4*)(ql + i * 512 + h * 64 + d4 * 4); acc += qv[0] * w[d4 * 4] + qv[1] * w[d4 * 4 + 1] + qv[2] * w[d4 * 4 + 2] + qv[3] * w[d4 * 4 + 3]; }
        ws_qlat(p)[((size_t)(t0 + i) * NH + h) * 128 + cidx] = f2bf(acc * 0.125f);
      }
    }
  }
}

DI void unpack8(const u32x4 w, float* o) {
  o[0] = __uint_as_float(w.x << 16); o[1] = __uint_as_float(w.x & 0xffff0000u); o[2] = __uint_as_float(w.y << 16); o[3] = __uint_as_float(w.y & 0xffff0000u);
  o[4] = __uint_as_float(w.z << 16); o[5] = __uint_as_float(w.z & 0xffff0000u); o[6] = __uint_as_float(w.w << 16); o[7] = __uint_as_float(w.w & 0xffff0000u);
}
DI void load8(const bf16_t* p, float* o) { unpack8(*(const u32x4*)p, o); }
DI void phase4a(const Params& p, int bid, int nb, char* lds) {
  const int t = threadIdx.x, i = t >> 3, cg8 = (t & 7) * 8;
  const bf16_t* proj = ws_proj(p);
  for (int task = bid; task < BATCH * NH; task += nb) {
    const int b = task >> 3, h = task & 7;
    const int cbase = h * HD + cg8;
    float mu_r[8], st[8], rprev[8];
#pragma unroll
    for (int j = 0; j < 8; ++j) { mu_r[j] = p.shift_mu[C_R + cbase + j]; st[j] = 0.f; rprev[j] = 0.f; }
    const float mu_v = p.shift_mu[C_V + h * HD + i];
    float vprev = 0.f;
    const size_t tok0 = (size_t)b * SEQ;
    u32x4 n_kk, n_bb, n_kp, n_ee, n_r; bf16_t n_v;
    {
      const size_t g = tok0;
      n_kk = *(const u32x4*)(ws_kk(p) + g * RW + cbase); n_bb = *(const u32x4*)(ws_bb(p) + g * RW + cbase);
      n_kp = *(const u32x4*)(ws_kp(p) + g * RW + cbase); n_ee = *(const u32x4*)(ws_ee(p) + g * RW + cbase);
      n_r = *(const u32x4*)(proj + g * PROJ_LD + C_R + cbase); n_v = proj[g * PROJ_LD + C_V + h * HD + i];
    }
    for (int s = 0; s < SEQ; ++s) {
      const u32x4 c_kk = n_kk, c_bb = n_bb, c_kp = n_kp, c_ee = n_ee, c_r = n_r; const bf16_t c_v = n_v;
      if (s + 1 < SEQ) {
        const size_t g = tok0 + s + 1;
        n_kk = *(const u32x4*)(ws_kk(p) + g * RW + cbase); n_bb = *(const u32x4*)(ws_bb(p) + g * RW + cbase);
        n_kp = *(const u32x4*)(ws_kp(p) + g * RW + cbase); n_ee = *(const u32x4*)(ws_ee(p) + g * RW + cbase);
        n_r = *(const u32x4*)(proj + g * PROJ_LD + C_R + cbase); n_v = proj[g * PROJ_LD + C_V + h * HD + i];
      }
      float kk[8], bb[8], kp[8], ee[8], rr[8];
      unpack8(c_kk, kk); unpack8(c_bb, bb); unpack8(c_kp, kp); unpack8(c_ee, ee); unpack8(c_r, rr);
      const float vraw = bf2f(c_v);
      const float v = vraw + mu_v * (vprev - vraw); vprev = vraw;
      float sa = 0.f;
#pragma unroll
      for (int j = 0; j < 8; ++j) sa += st[j] * kk[j];
      sa += __shfl_xor(sa, 1); sa += __shfl_xor(sa, 2); sa += __shfl_xor(sa, 4);
      sa = -sa;
      float y = 0.f;
#pragma unroll
      for (int j = 0; j < 8; ++j) {
        const float r = rr[j] + mu_r[j] * (rprev[j] - rr[j]); rprev[j] = rr[j];
        const float w = __expf(-ee[j]);
        st[j] = st[j] * w + sa * bb[j] + v * kp[j];
        y += st[j] * r;
      }
      y += __shfl_xor(y, 1); y += __shfl_xor(y, 2); y += __shfl_xor(y, 4);
      if ((t & 7) == 0) ws_y(p)[(tok0 + s) * RW + h * HD + i] = y;
    }
  }
}

DI unsigned fkey(float f) { const unsigned u = __float_as_uint(f); return (u & 0x80000000u) ? ~u : (u | 0x80000000u); }
DI int block_sum_i(int v, int* red, int wid, int lane) {
  for (int o = 32; o; o >>= 1) v += __shfl_xor(v, o);
  __syncthreads();
  if (lane == 0) red[wid] = v;
  __syncthreads();
  int s = 0;
#pragma unroll
  for (int w = 0; w < 8; ++w) s += red[w];
  return s;
}
DI void phase4b(const Params& p, int bid, int nb, char* lds) {
  const int t = threadIdx.x, lane = t & 63, wid = t >> 6;
  float* qf = (float*)lds;
  float* wi = qf + 256;
  int* red = (int*)(wi + 4);
  int* wtie = red + 8;
  const bf16_t* proj = ws_proj(p);
  for (int gq = bid; gq < NTOK; gq += nb) {
    const int b = gq >> 11, s = gq & (SEQ - 1);
    const int n = ((s >> 6) + 1) * 64;
    unsigned* mrow = ws_mask(p) + (size_t)gq * 64;
    if (n <= 256) {
      if (t < 64) mrow[t] = (t * 32 < n) ? 0xffffffffu : 0u;
      continue;
    }
    __syncthreads();
    if (t < 256) qf[t] = bf2f(proj[(size_t)gq * PROJ_LD + C_QI + t]) * 0.125f;
    else if (t < 260) wi[t - 256] = bf2f(proj[(size_t)gq * PROJ_LD + C_WI + t - 256]) * 0.5f;
    __syncthreads();
    unsigned uk[4];
#pragma unroll 1
    for (int q = 0; q < 4; ++q) {
      const int key = t * 4 + q;
      uk[q] = 0u;
      if (key < n) {
        float kf[64];
        const bf16_t* kr = ws_kidx(p) + ((size_t)b * SEQ + key) * 64;
#pragma unroll
        for (int d8 = 0; d8 < 8; ++d8) load8(kr + d8 * 8, kf + d8 * 8);
        float sc = 0.f;
#pragma unroll
        for (int hh = 0; hh < 4; ++hh) {
          float dot = 0.f;
#pragma unroll
          for (int d4 = 0; d4 < 16; ++d4) { const f32x4 qv = *(const f32x4*)(qf + hh * 64 + d4 * 4); dot += qv[0] * kf[d4 * 4] + qv[1] * kf[d4 * 4 + 1] + qv[2] * kf[d4 * 4 + 2] + qv[3] * kf[d4 * 4 + 3]; }
          sc += wi[hh] * fmaxf(dot, 0.f);
        }
        sc = sc + 0.0f;
        uk[q] = fkey(sc);
      }
    }
    unsigned T = 0u;
    for (int bit = 31; bit >= 0; --bit) {
      const unsigned cand = T | (1u << bit);
      const int c = (uk[0] >= cand) + (uk[1] >= cand) + (uk[2] >= cand) + (uk[3] >= cand);
      if (block_sum_i(c, red, wid, lane) >= 256) T = cand;
    }
    const int cgt = block_sum_i((uk[0] > T) + (uk[1] > T) + (uk[2] > T) + (uk[3] > T), red, wid, lane);
    const int need = 256 - cgt;
    const int tl = (uk[0] == T) + (uk[1] == T) + (uk[2] == T) + (uk[3] == T);
    int incl = tl;
    for (int o = 1; o < 64; o <<= 1) { const int u = __shfl_up(incl, o); if (lane >= o) incl += u; }
    __syncthreads();
    if (lane == 63) wtie[wid] = incl;
    __syncthreads();
    int before = incl - tl;
    for (int w = 0; w < wid; ++w) before += wtie[w];
    unsigned nib = 0u;
#pragma unroll
    for (int q = 0; q < 4; ++q) {
      bool sel = uk[q] > T;
      if (uk[q] == T) { sel = before < need; ++before; }
      if (sel) nib |= 1u << q;
    }
    unsigned word = nib << ((lane & 7) * 4);
    word |= __shfl_xor(word, 1); word |= __shfl_xor(word, 2); word |= __shfl_xor(word, 4);
    if ((lane & 7) == 0) mrow[t >> 3] = word;
  }
}

DI void phase5a(const Params& p, int bid, int nb, char* lds) {
  const int lane = threadIdx.x & 63, wid = threadIdx.x >> 6;
  const bf16_t* proj = ws_proj(p);
  for (int gt = bid * 8 + wid; gt < NTOK; gt += nb * 8) {
    const int c0 = lane * 8, h = lane >> 3;
    const f32x4 y0 = *(const f32x4*)(ws_y(p) + (size_t)gt * RW + c0), y1 = *(const f32x4*)(ws_y(p) + (size_t)gt * RW + c0 + 4);
    float y[8] = {y0[0], y0[1], y0[2], y0[3], y1[0], y1[1], y1[2], y1[3]};
    float s = 0.f;
#pragma unroll
    for (int j = 0; j < 8; ++j) s += y[j];
    s += __shfl_xor(s, 1); s += __shfl_xor(s, 2); s += __shfl_xor(s, 4);
    const float mean = s * (1.0f / 64.0f);
    float q = 0.f;
#pragma unroll
    for (int j = 0; j < 8; ++j) { const float d = y[j] - mean; q += d * d; }
    q += __shfl_xor(q, 1); q += __shfl_xor(q, 2); q += __shfl_xor(q, 4);
    const float rstd = rsqrtf(q * (1.0f / 64.0f) + 64e-5f);
    float g[8], vr[8], vp[8];
    load8(ws_gg(p) + (size_t)gt * RW + c0, g);
    load8(proj + (size_t)gt * PROJ_LD + C_V + c0, vr);
    if (gt & (SEQ - 1)) load8(proj + (size_t)(gt - 1) * PROJ_LD + C_V + c0, vp);
    else {
#pragma unroll
      for (int j = 0; j < 8; ++j) vp[j] = 0.f;
    }
    const float bs = ws_bonus(p)[gt * NH + h];
    float o[8];
#pragma unroll
    for (int j = 0; j < 8; ++j) {
      const float v = vr[j] + p.shift_mu[C_V + c0 + j] * (vp[j] - vr[j]);
      o[j] = ((y[j] - mean) * rstd * p.gn_g[c0 + j] + p.gn_b[c0 + j] + bs * v) * g[j];
    }
    u32x4 w; w.x = pack2(o[0], o[1]); w.y = pack2(o[2], o[3]); w.z = pack2(o[4], o[5]); w.w = pack2(o[6], o[7]);
    *(u32x4*)(ws_mix(p) + (size_t)gt * DM + c0) = w;
  }
}

DI void phase5b(const Params& p, int bid, int nb, char* lds) {
  const int t = threadIdx.x, lane = t & 63, wid = t >> 6;
  float* ql = (float*)lds;
  float* pr = ql + 1024;
  float* ol = pr + 2048;
  int* sel = (int*)(ol + 1024);
  int* nselp = sel + 256;
  for (int gq = bid; gq < NTOK; gq += nb) {
    const int b = gq >> 11;
    const bf16_t* ckv = ws_ckv(p) + (size_t)b * SEQ * 128;
    __syncthreads();
    for (int idx = t; idx < 1024; idx += NTHR) ql[idx] = bf2f(ws_qlat(p)[(size_t)gq * 1024 + idx]);
    if (wid == 0) {
      const unsigned word = ws_mask(p)[(size_t)gq * 64 + lane];
      const int cnt = __popc(word);
      int incl = cnt;
      for (int o = 1; o < 64; o <<= 1) { const int u = __shfl_up(incl, o); if (lane >= o) incl += u; }
      int pos = incl - cnt;
      unsigned w = word;
      while (w) { const int bit = __ffs(w) - 1; w &= w - 1; if (pos < 256) sel[pos] = lane * 32 + bit; ++pos; }
      if (lane == 63) *nselp = incl < 256 ? incl : 256;
    }
    __syncthreads();
    const int nsel = *nselp;
    const int h = wid;
    float lg[4]; float mx = -1e30f;
#pragma unroll
    for (int q = 0; q < 4; ++q) {
      const int slot = lane + 64 * q;
      lg[q] = -1e30f;
      if (slot < nsel) {
        const bf16_t* kr = ckv + (size_t)sel[slot] * 128;
        float acc = 0.f;
#pragma unroll
        for (int d8 = 0; d8 < 16; ++d8) {
          float kf[8]; load8(kr + d8 * 8, kf);
          const f32x4 q0 = *(const f32x4*)(ql + h * 128 + d8 * 8), q1 = *(const f32x4*)(ql + h * 128 + d8 * 8 + 4);
          acc += q0[0] * kf[0] + q0[1] * kf[1] + q0[2] * kf[2] + q0[3] * kf[3] + q1[0] * kf[4] + q1[1] * kf[5] + q1[2] * kf[6] + q1[3] * kf[7];
        }
        lg[q] = acc;
      }
      mx = fmaxf(mx, lg[q]);
    }
    mx = wave_max(mx);
    float sm = 0.f;
#pragma unroll
    for (int q = 0; q < 4; ++q) { lg[q] = (lane + 64 * q < nsel) ? __expf(lg[q] - mx) : 0.f; sm += lg[q]; }
    sm = wave_sum(sm);
    const float inv = 1.0f / sm;
#pragma unroll
    for (int q = 0; q < 4; ++q) pr[h * 256 + lane + 64 * q] = lg[q] * inv;
    __syncthreads();
    {
      float o0 = 0.f, o1 = 0.f;
      for (int slot = 0; slot < nsel; ++slot) {
        const unsigned kv2 = *(const unsigned*)(ckv + (size_t)sel[slot] * 128 + lane * 2);
        const float pp = pr[h * 256 + slot];
        o0 += pp * __uint_as_float(kv2 << 16); o1 += pp * __uint_as_float(kv2 & 0xffff0000u);
      }
      ol[h * 128 + lane * 2] = o0; ol[h * 128 + lane * 2 + 1] = o1;
    }
    __syncthreads();
    {
      float acc = 0.f;
      for (int cc = 0; cc < 128; ++cc) acc += ol[h * 128 + cc] * p.w_uv[(size_t)(cc * NH + h) * HD + lane];
      ws_mix(p)[(size_t)gq * DM + RW + h * HD + lane] = f2bf(acc);
    }
  }
}

struct EpiOut { const float* x; const float* mod; float* o; int row0, col0; DI void operator()(int r, int c, float v0, float v1) const {
  const int row = row0 + r, col = col0 + c, b = row >> 11; const size_t idx = (size_t)row * DM + col;
  o[idx] = x[idx] + (1.0f + mod[b * 6144 + 2048 + col]) * v0; o[idx + 32] = x[idx + 32] + (1.0f + mod[b * 6144 + 2048 + col + 32]) * v1; } };
DI void phase6(const Params& p, int bid, int nb, char* lds) {
  constexpr int NT = DM / GBN;
  for (int tile = bid; tile < (NTOK / GBM) * NT; tile += nb) {
    const int mt = tile / NT, nt = tile % NT;
    gemm_tile(ws_mix(p), DM, ARowBase{mt * GBM}, ws_wtout(p), DM, nt * GBN, DM, EpiOut{p.x, ws_mod(p), p.out, mt * GBM, nt * GBN}, lds);
  }
}

DI void phase7(const Params& p, int bid, int nb, char* lds) {
  const int t = threadIdx.x, lane = t & 63, wid = t >> 6;
  float* hT = (float*)lds;
  float* part = hT + 8192;
  float* lg = part + 8 * 8 * 36;
  const float* mod = ws_mod(p);
  for (int tile = bid; tile < NTOK / 8; tile += nb) {
    const int gt = tile * 8 + wid, b = gt >> 11;
    __syncthreads();
    {
      const float* xr = p.out + (size_t)gt * DM;
      f32x4 v[4]; float ss = 0.f;
#pragma unroll
      for (int i = 0; i < 4; ++i) { v[i] = *(const f32x4*)(xr + lane * 4 + 256 * i); ss += v[i][0] * v[i][0] + v[i][1] * v[i][1] + v[i][2] * v[i][2] + v[i][3] * v[i][3]; }
      ss = wave_sum(ss);
      const float rstd = rsqrtf(ss * (1.0f / DM) + 1e-6f);
#pragma unroll
      for (int i = 0; i < 4; ++i) {
        const int col = lane * 4 + 256 * i;
        const f32x4 g = *(const f32x4*)(p.norm2_g + col), sh = *(const f32x4*)(mod + b * 6144 + 3072 + col), sc = *(const f32x4*)(mod + b * 6144 + 4096 + col);
        float o[4];
#pragma unroll
        for (int j = 0; j < 4; ++j) { o[j] = v[i][j] * rstd * g[j] * (1.0f + sc[j]) + sh[j]; hT[(col + j) * 8 + wid] = o[j]; }
        u32x2 w; w.x = pack2(o[0], o[1]); w.y = pack2(o[2], o[3]);
        *(u32x2*)(ws_h2(p) + (size_t)gt * DM + col) = w;
      }
    }
    __syncthreads();
    if (lane < 36) {
      float acc[8];
#pragma unroll
      for (int i = 0; i < 8; ++i) acc[i] = 0.f;
      for (int kq = 0; kq < 128; ++kq) {
        const int k = wid * 128 + kq;
        const float wv = lane < 32 ? p.w_expert[k * 32 + lane] : p.w_group[k * 4 + lane - 32];
        const f32x4 h0 = *(const f32x4*)(hT + k * 8), h1 = *(const f32x4*)(hT + k * 8 + 4);
        acc[0] += h0[0] * wv; acc[1] += h0[1] * wv; acc[2] += h0[2] * wv; acc[3] += h0[3] * wv;
        acc[4] += h1[0] * wv; acc[5] += h1[1] * wv; acc[6] += h1[2] * wv; acc[7] += h1[3] * wv;
      }
#pragma unroll
      for (int i = 0; i < 8; ++i) part[(wid * 8 + i) * 36 + lane] = acc[i];
    }
    __syncthreads();
    if (t < 8 * 36) {
      const int tok = t / 36, o = t % 36;
      float s = 0.f;
      for (int w = 0; w < 8; ++w) s += part[(w * 8 + tok) * 36 + o];
      s += (o < 32) ? p.b_expert[o] : p.b_group[o - 32];
      lg[tok * 36 + o] = s;
    }
    __syncthreads();
    if (t < 8) {
      const float* l = lg + t * 36;
      int gs = 0; float gm = l[32];
      for (int g = 1; g < 4; ++g) if (l[32 + g] > gm) { gm = l[32 + g]; gs = g; }
      float gsum = 0.f;
      for (int g = 0; g < 4; ++g) gsum += expf(l[32 + g] - gm);
      const float pgroup = 1.0f / gsum;
      const float* el = l + gs * 8;
      float em = el[0];
      for (int e = 1; e < 8; ++e) em = fmaxf(em, el[e]);
      float pe[8], esum = 0.f;
      for (int e = 0; e < 8; ++e) { pe[e] = expf(el[e] - em); esum += pe[e]; }
      for (int e = 0; e < 8; ++e) pe[e] /= esum;
      int i0 = 0;
      for (int e = 1; e < 8; ++e) if (pe[e] > pe[i0]) i0 = e;
      int i1 = (i0 == 0) ? 1 : 0;
      for (int e = 0; e < 8; ++e) if (e != i0 && pe[e] > pe[i1]) i1 = e;
      const float den = pe[i0] + pe[i1];
      const int tok = tile * 8 + t;
      const int e0 = gs * 8 + i0, e1 = gs * 8 + i1;
      const int p0 = atomicAdd(ws_cnt(p) + e0, 1), p1 = atomicAdd(ws_cnt(p) + e1, 1);
      ws_list(p)[e0 * LCAP + p0] = tok * 2; ws_list(p)[e1 * LCAP + p1] = tok * 2 + 1;
      ws_wa(p)[tok * 2] = pgroup * pe[i0] / den; ws_wa(p)[tok * 2 + 1] = pgroup * pe[i1] / den;
    }
  }
  for (int task = bid; task < 3 * 4096; task += nb) {
    const int which = task >> 12, q = task & 4095, e = q >> 7, r = q & 127;
    if (which < 2) { const int kt = r >> 3, nt = r & 7;
      transpose_tile((which == 0 ? p.e_gate : p.e_up) + (size_t)e * 1024 * 512, 512, kt * 64, nt * 64, ws_wgu(p) + (size_t)e * 1024 * 1024, 1024, RowGU{which * 32}, lds); }
    else { const int kt = r >> 4, nt = r & 15;
      transpose_tile(p.e_down + (size_t)e * 512 * 1024, 1024, kt * 64, nt * 64, ws_wd(p) + (size_t)e * 1024 * 512, 512, RowId(), lds); }
  }
}

struct Seg { int e, r0, cnt, start; };
DI Seg find_seg(const int* cnt, int mtile) {
  Seg s; s.e = -1; int acc = 0, start = 0;
  for (int e = 0; e < NEXP; ++e) { const int c = cnt[e], nt = (c + GBM - 1) / GBM; if (mtile < acc + nt) { s.e = e; s.r0 = (mtile - acc) * GBM; s.cnt = c; s.start = start; return s; } acc += nt; start += c; }
  return s;
}
struct ARowList { const int* list; int r0, cnt; DI int operator()(int r) const { int q = r0 + r; q = q < cnt ? q : cnt - 1; return list[q] >> 1; } };
struct EpiHid { bf16_t* o; int row0, nvalid, col0; DI void operator()(int r, int c, float g, float u) const {
  if (r < nvalid) o[(size_t)(row0 + r) * DEXP + ((col0 + c) >> 6) * 32 + (c & 31)] = f2bf(g / (1.0f + __expf(-g)) * u); } };
DI void phase8(const Params& p, int bid, int nb, char* lds) {
  const int* cnt = ws_cnt(p);
  for (int tile = bid; tile < 288 * 8; tile += nb) {
    const Seg s = find_seg(cnt, tile >> 3);
    if (s.e < 0) break;
    const int nt = tile & 7;
    gemm_tile(ws_h2(p), DM, ARowList{ws_list(p) + s.e * LCAP, s.r0, s.cnt}, ws_wgu(p) + (size_t)s.e * 1024 * 1024, DM, nt * GBN, DM,
              EpiHid{ws_hid(p), s.start + s.r0, s.cnt - s.r0, nt * GBN}, lds);
  }
}
struct ARowClamp { int base, r0, cnt; DI int operator()(int r) const { int q = r0 + r; q = q < cnt ? q : cnt - 1; return base + q; } };
struct EpiY { bf16_t* o; const int* list; const float* wa; int r0, cnt, col0; DI void operator()(int r, int c, float v0, float v1) const {
  if (r0 + r < cnt) { const int aid = list[r0 + r]; const float w = wa[aid]; bf16_t* q = o + (size_t)aid * DM + col0 + c; q[0] = f2bf(v0 * w); q[32] = f2bf(v1 * w); } } };
DI void phase9(const Params& p, int bid, int nb, char* lds) {
  const int* cnt = ws_cnt(p);
  for (int tile = bid; tile < 288 * 8; tile += nb) {
    const Seg s = find_seg(cnt, tile >> 3);
    if (s.e < 0) break;
    const int nt = tile & 7;
    gemm_tile(ws_hid(p), DEXP, ARowClamp{s.start, s.r0, s.cnt}, ws_wd(p) + (size_t)s.e * 1024 * 512, DEXP, nt * GBN, DEXP,
              EpiY{ws_ybuf(p), ws_list(p) + s.e * LCAP, ws_wa(p), s.r0, s.cnt, nt * GBN}, lds);
  }
}

DI void phase10(const Params& p, int bid, int nb, char* lds) {
  const int lane = threadIdx.x & 63, wid = threadIdx.x >> 6;
  const float* mod = ws_mod(p); const float* fm = ws_fmod(p);
  for (int gt = bid * 8 + wid; gt < NTOK; gt += nb * 8) {
    const int b = gt >> 11;
    float* xr = p.out + (size_t)gt * DM;
    const bf16_t* ya = ws_ybuf(p) + (size_t)(gt * 2) * DM; const bf16_t* yb = ya + DM;
    f32x4 v[4]; float ss = 0.f;
#pragma unroll
    for (int i = 0; i < 4; ++i) {
      const int col = lane * 4 + 256 * i;
      v[i] = *(const f32x4*)(xr + col);
      const u32x2 a = *(const u32x2*)(ya + col), bq = *(const u32x2*)(yb + col);
      const f32x4 g2 = *(const f32x4*)(mod + b * 6144 + 5120 + col);
      const float m0 = __uint_as_float(a.x << 16) + __uint_as_float(bq.x << 16), m1 = __uint_as_float(a.x & 0xffff0000u) + __uint_as_float(bq.x & 0xffff0000u);
      const float m2 = __uint_as_float(a.y << 16) + __uint_as_float(bq.y << 16), m3 = __uint_as_float(a.y & 0xffff0000u) + __uint_as_float(bq.y & 0xffff0000u);
      v[i][0] += (1.0f + g2[0]) * m0; v[i][1] += (1.0f + g2[1]) * m1; v[i][2] += (1.0f + g2[2]) * m2; v[i][3] += (1.0f + g2[3]) * m3;
      ss += v[i][0] * v[i][0] + v[i][1] * v[i][1] + v[i][2] * v[i][2] + v[i][3] * v[i][3];
    }
    ss = wave_sum(ss);
    const float rstd = rsqrtf(ss * (1.0f / DM) + 1e-6f);
#pragma unroll
    for (int i = 0; i < 4; ++i) {
      const int col = lane * 4 + 256 * i;
      const f32x4 g = *(const f32x4*)(p.final_norm_g + col), sh = *(const f32x4*)(fm + b * 2048 + col), sc = *(const f32x4*)(fm + b * 2048 + 1024 + col);
      f32x4 o;
#pragma unroll
      for (int j = 0; j < 4; ++j) o[j] = v[i][j] * rstd * g[j] * (1.0f + sc[j]) + sh[j];
      *(f32x4*)(xr + col) = o;
    }
  }
}

#define PHASE_KERNEL(name, body) __global__ void __launch_bounds__(NTHR) name(Params p) { extern __shared__ __attribute__((aligned(16))) char smem[]; body(p, blockIdx.x, gridDim.x, smem); }
PHASE_KERNEL(k_phase0, phase0)
PHASE_KERNEL(k_phase1, phase1)
PHASE_KERNEL(k_phase2, phase2)
PHASE_KERNEL(k_phase3a, phase3a)
PHASE_KERNEL(k_phase3b, phase3b)
PHASE_KERNEL(k_phase4a, phase4a)
PHASE_KERNEL(k_phase4b, phase4b)
PHASE_KERNEL(k_phase5a, phase5a)
PHASE_KERNEL(k_phase5b, phase5b)
PHASE_KERNEL(k_phase6, phase6)
PHASE_KERNEL(k_phase7, phase7)
PHASE_KERNEL(k_phase8, phase8)
PHASE_KERNEL(k_phase9, phase9)
PHASE_KERNEL(k_phase10, phase10)

extern "C" void kernel_launch(void* const* d_in, const int* in_sizes, int n_in, void* d_out, int out_size, void* d_ws, size_t ws_size, hipStream_t stream) {
  Params p{};
  const float** f = (const float**)&p;
  for (int i = 0; i < 33; ++i) f[i] = (const float*)d_in[i];
  p.out = (float*)d_out; p.ws = (char*)d_ws;
  const int G = 512;
#define LAUNCH(k, g) hipLaunchKernelGGL(k, dim3(g), dim3(NTHR), LDS_BYTES, stream, p)
  LAUNCH(k_phase0, G);
  LAUNCH(k_phase1, G);
  LAUNCH(k_phase2, G);
  LAUNCH(k_phase3a, G);
  LAUNCH(k_phase3b, G);
  LAUNCH(k_phase4a, 128);
  LAUNCH(k_phase4b, 1024);
  LAUNCH(k_phase5a, G);
  LAUNCH(k_phase5b, 1024);
  LAUNCH(k_phase6, G);
  LAUNCH(k_phase7, G);
  LAUNCH(k_phase8, G);
  LAUNCH(k_phase9, G);
  LAUNCH(k_phase10, G);
}
```

```cpp
#include <hip/hip_runtime.h>
#include <hip/hip_cooperative_groups.h>
#include <stdint.h>
#include <stdio.h>

namespace cg = cooperative_groups;

#ifndef MEGA
#define MEGA 1
#endif

typedef unsigned short bf16_t;
typedef short bf16x8 __attribute__((ext_vector_type(8)));
typedef float f32x16 __attribute__((ext_vector_type(16)));
typedef float f32x4 __attribute__((ext_vector_type(4)));
typedef float f32x4v __attribute__((ext_vector_type(4)));
typedef unsigned u32x4 __attribute__((ext_vector_type(4)));
typedef unsigned u32x2 __attribute__((ext_vector_type(2)));

#define DI __device__ __forceinline__

constexpr int DM = 1024, BATCH = 16, SEQ = 2048, NTOK = BATCH * SEQ;
constexpr int RW = 512, NH = 8, HD = 64;
constexpr int PROJ_N = 2756, PROJ_LD = 2816;
constexpr int C_R = 0, C_K = 512, C_V = 1024, C_WL = 1536, C_AL = 1600, C_GL = 1664;
constexpr int C_Q = 1792, C_CKV = 2304, C_QI = 2432, C_KI = 2688, C_WI = 2752;
constexpr int NEXP = 32, DEXP = 512, LCAP = 32768;
constexpr int NTHR = 512;
constexpr int LDS_BYTES = 163840;

constexpr size_t MiB = 1048576;
constexpr size_t OFF_A = 0;
constexpr size_t OFF_B = 64 * MiB;
constexpr size_t OFF_C = 240 * MiB;
constexpr size_t OFF_F = 400 * MiB;
constexpr size_t OFF_G = 464 * MiB;
constexpr size_t OFF_W = 484 * MiB;
constexpr size_t OFF_S = 492 * MiB;

struct Params {
  const float *x, *c, *ada_w, *ada_b, *norm1_g, *w_in, *shift_mu, *w0, *w_decay_up, *a0, *w_aaa_up, *w_gate_up;
  const float *k_k, *k_a, *r_k, *gn_g, *gn_b, *kv_norm_g, *k_idx_norm_g, *w_uk, *w_uv, *w_out, *norm2_g;
  const float *w_group, *b_group, *w_expert, *b_expert, *e_gate, *e_up, *e_down, *final_ada_w, *final_ada_b, *final_norm_g;
  float* out;
  char* ws;
};

DI int tid_() { int t = threadIdx.x; asm volatile("" : "+v"(t)); return t; }
DI float bf2f(bf16_t u) { return __uint_as_float(((unsigned)u) << 16); }
DI bf16_t f2bf(float f) { unsigned u = __float_as_uint(f); u += 0x7fffu + ((u >> 16) & 1u); return (bf16_t)(u >> 16); }
DI unsigned pack2(float lo, float hi) { return (unsigned)f2bf(lo) | ((unsigned)f2bf(hi) << 16); }
DI float wave_sum(float v) { for (int o = 32; o; o >>= 1) v += __shfl_xor(v, o); return v; }
DI float wave_max(float v) { for (int o = 32; o; o >>= 1) v = fmaxf(v, __shfl_xor(v, o)); return v; }
DI float sigmoidf_(float v) { return 1.0f / (1.0f + __expf(-v)); }
DI int crow(int r, int hi) { return (r & 3) + 8 * (r >> 2) + 4 * hi; }
DI unsigned cvtpk(float lo, float hi) { unsigned r; asm volatile("v_cvt_pk_bf16_f32 %0, %1, %2" : "=v"(r) : "v"(lo), "v"(hi)); return r; }

DI void unpack8(const u32x4 w, float* o) {
  o[0] = __uint_as_float(w.x << 16); o[1] = __uint_as_float(w.x & 0xffff0000u); o[2] = __uint_as_float(w.y << 16); o[3] = __uint_as_float(w.y & 0xffff0000u);
  o[4] = __uint_as_float(w.z << 16); o[5] = __uint_as_float(w.z & 0xffff0000u); o[6] = __uint_as_float(w.w << 16); o[7] = __uint_as_float(w.w & 0xffff0000u);
}
DI void load8(const bf16_t* p, float* o) { unpack8(*(const u32x4*)p, o); }

DI bf16_t* ws_h1(const Params& p) { return (bf16_t*)(p.ws + OFF_A); }
DI float* ws_y(const Params& p) { return (float*)(p.ws + OFF_A); }
DI bf16_t* ws_h2(const Params& p) { return (bf16_t*)(p.ws + OFF_A); }
DI bf16_t* ws_proj(const Params& p) { return (bf16_t*)(p.ws + OFF_B); }
DI float* ws_x1(const Params& p) { return (float*)(p.ws + OFF_B); }
DI bf16_t* ws_wgu(const Params& p) { return (bf16_t*)p.out; }
DI bf16_t* ws_wd(const Params& p) { return (bf16_t*)((char*)p.out + 64 * MiB); }
DI bf16_t* ws_hid(const Params& p) { return (bf16_t*)(p.ws + OFF_B + 96 * MiB); }
DI bf16_t* ws_kp(const Params& p) { return (bf16_t*)(p.ws + OFF_C); }
DI bf16_t* ws_kk(const Params& p) { return (bf16_t*)(p.ws + OFF_C + 32 * MiB); }
DI bf16_t* ws_bb(const Params& p) { return (bf16_t*)(p.ws + OFF_C + 64 * MiB); }
DI bf16_t* ws_ee(const Params& p) { return (bf16_t*)(p.ws + OFF_C + 96 * MiB); }
DI bf16_t* ws_gg(const Params& p) { return (bf16_t*)(p.ws + OFF_C + 128 * MiB); }
DI bf16_t* ws_mix(const Params& p) { return (bf16_t*)(p.ws + OFF_C); }
DI bf16_t* ws_ybuf(const Params& p) { return (bf16_t*)(p.ws + OFF_C); }
DI bf16_t* ws_qlat(const Params& p) { return (bf16_t*)(p.ws + OFF_F); }
DI bf16_t* ws_ckv(const Params& p) { return (bf16_t*)(p.ws + OFF_G); }
DI bf16_t* ws_kidx(const Params& p) { return (bf16_t*)(p.ws + OFF_G + 8 * MiB); }
DI unsigned* ws_mask(const Params& p) { return (unsigned*)(p.ws + OFF_G + 12 * MiB); }
DI bf16_t* ws_wtin(const Params& p) { return (bf16_t*)(p.ws + OFF_W); }
DI bf16_t* ws_wtout(const Params& p) { return (bf16_t*)(p.ws + OFF_W + 6 * MiB); }
DI bf16_t* ws_wuvt(const Params& p) { return (bf16_t*)(p.ws + OFF_S + 7 * MiB); }
DI bf16_t* ws_wdt(const Params& p) { return (bf16_t*)(p.ws + OFF_S + 8 * MiB + 64 * 1024); }
DI bf16_t* ws_wat(const Params& p) { return (bf16_t*)(p.ws + OFF_S + 8 * MiB + 128 * 1024); }
DI bf16_t* ws_wgt(const Params& p) { return (bf16_t*)(p.ws + OFF_S + 8 * MiB + 192 * 1024); }
DI bf16_t* ws_wukt(const Params& p) { return (bf16_t*)(p.ws + OFF_S + 8 * MiB + 320 * 1024); }
DI unsigned* ws_bar(const Params& p) { return (unsigned*)(p.ws + OFF_S + 8 * MiB); }
DI float* ws_mod(const Params& p) { return (float*)(p.ws + OFF_S); }
DI float* ws_fmod(const Params& p) { return (float*)(p.ws + OFF_S + 512 * 1024); }
DI float* ws_bonus(const Params& p) { return (float*)(p.ws + OFF_S + 1 * MiB); }
DI int* ws_cnt(const Params& p) { return (int*)(p.ws + OFF_S + 2 * MiB); }
DI float* ws_wa(const Params& p) { return (float*)(p.ws + OFF_S + 2 * MiB + 4096); }
DI int* ws_list(const Params& p) { return (int*)(p.ws + OFF_S + 3 * MiB); }

template <class RowMap>
DI void transpose_tile(const float* src, int N, int k0, int n0, bf16_t* dst, int dstld, RowMap rm, char* lds) {
  float* tile = (float*)lds;
  const int t = tid_();
  __syncthreads();
  {
    const int nc = t & 63, krb = t >> 6;
#pragma unroll
    for (int i = 0; i < 8; ++i) {
      const int kr = krb + 8 * i;
      const int n = n0 + nc;
      tile[kr * 65 + nc] = (n < N) ? src[(size_t)(k0 + kr) * N + n] : 0.f;
    }
  }
  __syncthreads();
  {
    const int nr = t >> 3, kc = (t & 7) * 8;
    u32x4 w;
    w.x = pack2(tile[(kc + 0) * 65 + nr], tile[(kc + 1) * 65 + nr]);
    w.y = pack2(tile[(kc + 2) * 65 + nr], tile[(kc + 3) * 65 + nr]);
    w.z = pack2(tile[(kc + 4) * 65 + nr], tile[(kc + 5) * 65 + nr]);
    w.w = pack2(tile[(kc + 6) * 65 + nr], tile[(kc + 7) * 65 + nr]);
    *(u32x4*)(dst + (size_t)rm(n0 + nr) * dstld + k0 + kc) = w;
  }
}
struct RowId { DI int operator()(int n) const { return n; } };
struct RowGU { int add; DI int operator()(int n) const { return (n >> 7) * 256 + (n & 127) + add; } };

DI void phase0(const Params& p, int bid, int nb, char* lds) {
  const int t = tid_();
  if (bid == 0 && t < NEXP) ws_cnt(p)[t] = 0;
  for (int idx = bid * NTHR + t; idx < 8 * 64 * 128; idx += nb * NTHR) {
    const int hh = idx >> 13, d = (idx >> 7) & 63, cc = idx & 127;
    ws_wuvt(p)[idx] = f2bf(p.w_uv[(size_t)(cc * NH + hh) * HD + d]);
    const int h2 = idx >> 13, c2 = (idx >> 6) & 127, d2 = idx & 63;
    ws_wukt(p)[idx] = f2bf(p.w_uk[(size_t)(c2 * NH + h2) * HD + d2]);
  }
  for (int task = bid; task < 32; task += nb) {
    if (task < 8) transpose_tile(p.w_decay_up, RW, 0, task * 64, ws_wdt(p), 64, RowId(), lds);
    else if (task < 16) transpose_tile(p.w_aaa_up, RW, 0, (task - 8) * 64, ws_wat(p), 64, RowId(), lds);
    else { const int q = task - 16; transpose_tile(p.w_gate_up, RW, (q >> 3) * 64, (q & 7) * 64, ws_wgt(p), 128, RowId(), lds); }
  }
  for (int task = bid; task < 256; task += nb) {
    float* cact = (float*)lds;
    __syncthreads();
    for (int i = t; i < 16 * 1024; i += NTHR) { const float v = p.c[i]; cact[i] = v / (1.0f + __expf(-v)); }
    __syncthreads();
    const int col = task * 32 + (t & 31), ks = t >> 5;
    const float* w; int ld, cc;
    if (col < 6144) { w = p.ada_w; ld = 6144; cc = col; } else { w = p.final_ada_w; ld = 2048; cc = col - 6144; }
    float acc[16];
#pragma unroll
    for (int b = 0; b < 16; ++b) acc[b] = 0.f;
    for (int kk = 0; kk < 64; ++kk) {
      const int k = ks * 64 + kk;
      const float wv = w[(size_t)k * ld + cc];
#pragma unroll
      for (int b = 0; b < 16; ++b) acc[b] += cact[b * 1024 + k] * wv;
    }
    __syncthreads();
    float* red = (float*)lds;
#pragma unroll
    for (int b = 0; b < 16; ++b) red[(ks * 16 + b) * 32 + (t & 31)] = acc[b];
    __syncthreads();
    {
      const int b = t >> 5, cl = t & 31, colo = task * 32 + cl;
      float s = 0.f;
      for (int k2 = 0; k2 < 16; ++k2) s += red[(k2 * 16 + b) * 32 + cl];
      if (colo < 6144) ws_mod(p)[b * 6144 + colo] = s + p.ada_b[colo];
      else ws_fmod(p)[b * 2048 + colo - 6144] = s + p.final_ada_b[colo - 6144];
    }
  }
  for (int task = bid; task < 704 + 256; task += nb) {
    if (task < 704) { const int kt = task / 44, nt = task % 44; transpose_tile(p.w_in, PROJ_N, kt * 64, nt * 64, ws_wtin(p), 1024, RowId(), lds); }
    else { const int q = task - 704, kt = q >> 4, nt = q & 15; transpose_tile(p.w_out, 1024, kt * 64, nt * 64, ws_wtout(p), 1024, RowId(), lds); }
  }
}

DI void phase1(const Params& p, int bid, int nb, char* lds) {
  const int lane = tid_() & 63, wid = tid_() >> 6;
  const float* mod = ws_mod(p);
  for (int row = bid * 8 + wid; row < NTOK; row += nb * 8) {
    const int b = row >> 11;
    const float* xr = p.x + (size_t)row * DM;
    f32x4 v[4]; float ss = 0.f;
#pragma unroll
    for (int i = 0; i < 4; ++i) { v[i] = *(const f32x4*)(xr + lane * 4 + 256 * i); ss += v[i][0] * v[i][0] + v[i][1] * v[i][1] + v[i][2] * v[i][2] + v[i][3] * v[i][3]; }
    ss = wave_sum(ss);
    const float rstd = rsqrtf(ss * (1.0f / DM) + 1e-6f);
#pragma unroll
    for (int i = 0; i < 4; ++i) {
      const int col = lane * 4 + 256 * i;
      const f32x4 g = *(const f32x4*)(p.norm1_g + col), sh = *(const f32x4*)(mod + b * 6144 + col), sc = *(const f32x4*)(mod + b * 6144 + 1024 + col);
      float o[4];
#pragma unroll
      for (int j = 0; j < 4; ++j) o[j] = v[i][j] * rstd * g[j] * (1.0f + sc[j]) + sh[j];
      u32x2 w; w.x = pack2(o[0], o[1]); w.y = pack2(o[2], o[3]);
      *(u32x2*)(ws_h1(p) + (size_t)row * DM + col) = w;
    }
  }
}

constexpr int GBM = 256, GBN = 128, GBK = 32, GROW = 80, G_LDSA = GBM * GROW, G_STAGE = (GBM + GBN) * GROW;
template <class ARow, class Epi>
DI void gemm_tile(const bf16_t* A, int lda, ARow arow, const bf16_t* Bt, int ldb, int n0, int K, Epi epi, char* lds) {
  const int t = tid_(), lane = t & 63, wid = t >> 6, wm = wid >> 1, wn = wid & 1, r32 = lane & 31, hi = lane >> 5;
  const int srow = t >> 2, sch = t & 3;
  const bf16_t* a0p = A + (size_t)arow(srow) * lda + sch * 8;
  const bf16_t* a1p = A + (size_t)arow(srow + 128) * lda + sch * 8;
  const bf16_t* bp = Bt + (size_t)(n0 + srow) * ldb + sch * 8;
  const int wa0 = srow * GROW + sch * 16, wa1 = (srow + 128) * GROW + sch * 16, wb = G_LDSA + srow * GROW + sch * 16;
  const int ra = (wm * 64 + r32) * GROW + hi * 16, rb = G_LDSA + (wn * 64 + r32) * GROW + hi * 16;
  f32x16 acc[2][2];
#pragma unroll
  for (int i = 0; i < 2; ++i)
#pragma unroll
    for (int j = 0; j < 2; ++j)
#pragma unroll
      for (int r = 0; r < 16; ++r) acc[i][j][r] = 0.f;
  u32x4 ga0 = *(const u32x4*)a0p, ga1 = *(const u32x4*)a1p, gb = *(const u32x4*)bp;
  __syncthreads();
  *(u32x4*)(lds + wa0) = ga0; *(u32x4*)(lds + wa1) = ga1; *(u32x4*)(lds + wb) = gb;
  __syncthreads();
  const int nk = K / GBK;
  for (int kt = 0; kt < nk; ++kt) {
    char* cur = lds + (kt & 1) * G_STAGE;
    char* nxt = lds + ((kt + 1) & 1) * G_STAGE;
    if (kt + 1 < nk) { ga0 = *(const u32x4*)(a0p + (kt + 1) * GBK); ga1 = *(const u32x4*)(a1p + (kt + 1) * GBK); gb = *(const u32x4*)(bp + (kt + 1) * GBK); }
#pragma unroll
    for (int ks = 0; ks < 2; ++ks) {
      bf16x8 a[2], b[2];
#pragma unroll
      for (int i = 0; i < 2; ++i) { a[i] = *(const bf16x8*)(cur + ra + i * 32 * GROW + ks * 32); b[i] = *(const bf16x8*)(cur + rb + i * 32 * GROW + ks * 32); }
#pragma unroll
      for (int i = 0; i < 2; ++i)
#pragma unroll
        for (int j = 0; j < 2; ++j) acc[i][j] = __builtin_amdgcn_mfma_f32_32x32x16_bf16(a[i], b[j], acc[i][j], 0, 0, 0);
    }
    if (kt + 1 < nk) { *(u32x4*)(nxt + wa0) = ga0; *(u32x4*)(nxt + wa1) = ga1; *(u32x4*)(nxt + wb) = gb; }
    __syncthreads();
  }
#pragma unroll
  for (int i = 0; i < 2; ++i)
#pragma unroll
    for (int r = 0; r < 16; ++r) epi(wm * 64 + i * 32 + crow(r, hi), wn * 64 + r32, acc[i][0][r], acc[i][1][r]);
}

struct ARowBase { int base; DI int operator()(int r) const { return base + r; } };

struct EpiProj { bf16_t* o; int row0, col0; DI void operator()(int r, int c, float v0, float v1) const {
  bf16_t* q = o + (size_t)(row0 + r) * PROJ_LD + col0 + c; q[0] = f2bf(v0); q[32] = f2bf(v1); } };
DI void phase2(const Params& p, int bid, int nb, char* lds) {
  constexpr int NT = PROJ_LD / GBN;
  for (int tile = bid; tile < (NTOK / GBM) * NT; tile += nb) {
    const int mt = tile / NT, nt = tile % NT;
    gemm_tile(ws_h1(p), DM, ARowBase{mt * GBM}, ws_wtin(p), DM, nt * GBN, DM, EpiProj{ws_proj(p), mt * GBM, nt * GBN}, lds);
  }
}

DI float proj_shift(const bf16_t* proj, const float* mu, int gt, int col) {
  const float pv = bf2f(proj[(size_t)gt * PROJ_LD + col]);
  const float pp = (gt & (SEQ - 1)) ? bf2f(proj[(size_t)(gt - 1) * PROJ_LD + col]) : 0.f;
  return pv + mu[col] * (pp - pv);
}
DI void phase3a(const Params& p, int bid, int nb, char* lds) {
  const int t = tid_(), lane = t & 63, wid = t >> 6;
  float* xl = (float*)lds;
  const bf16_t* proj = ws_proj(p);
  for (int tile = bid; tile < NTOK / 16; tile += nb) {
    const int t0 = tile * 16;
    __syncthreads();
    for (int idx = t; idx < 16 * 256; idx += NTHR) {
      const int tok = idx >> 8, col = idx & 255;
      float v = proj_shift(proj, p.shift_mu, t0 + tok, C_WL + col);
      if (col < 64) v = tanhf(v); else if (col >= 128) v = sigmoidf_(v);
      xl[idx] = v;
    }
    __syncthreads();
    const int c = t;
    float acc[16];
#pragma unroll
    for (int i = 0; i < 16; ++i) acc[i] = 0.f;
    for (int k4 = 0; k4 < 16; ++k4) {
      float w[4];
#pragma unroll
      for (int j = 0; j < 4; ++j) w[j] = p.w_decay_up[(k4 * 4 + j) * RW + c];
#pragma unroll
      for (int i = 0; i < 16; ++i) { const f32x4 xv = *(const f32x4*)(xl + i * 256 + k4 * 4); acc[i] += xv[0] * w[0] + xv[1] * w[1] + xv[2] * w[2] + xv[3] * w[3]; }
    }
    {
      const float w0c = p.w0[c];
#pragma unroll
      for (int i = 0; i < 16; ++i) {
        const float z = -(w0c + acc[i]);
        const float sp = fmaxf(z, 0.f) + log1pf(__expf(-fabsf(z)));
        ws_ee(p)[(size_t)(t0 + i) * RW + c] = f2bf(__expf(-sp - 0.5f));
      }
    }
#pragma unroll
    for (int i = 0; i < 16; ++i) acc[i] = 0.f;
    for (int k4 = 0; k4 < 32; ++k4) {
      float w[4];
#pragma unroll
      for (int j = 0; j < 4; ++j) w[j] = p.w_gate_up[(k4 * 4 + j) * RW + c];
#pragma unroll
      for (int i = 0; i < 16; ++i) { const f32x4 xv = *(const f32x4*)(xl + i * 256 + 128 + k4 * 4); acc[i] += xv[0] * w[0] + xv[1] * w[1] + xv[2] * w[2] + xv[3] * w[3]; }
    }
#pragma unroll
    for (int i = 0; i < 16; ++i) ws_gg(p)[(size_t)(t0 + i) * RW + c] = f2bf(acc[i]);
#pragma unroll
    for (int i = 0; i < 16; ++i) acc[i] = 0.f;
    for (int k4 = 0; k4 < 16; ++k4) {
      float w[4];
#pragma unroll
      for (int j = 0; j < 4; ++j) w[j] = p.w_aaa_up[(k4 * 4 + j) * RW + c];
#pragma unroll
      for (int i = 0; i < 16; ++i) { const f32x4 xv = *(const f32x4*)(xl + i * 256 + 64 + k4 * 4); acc[i] += xv[0] * w[0] + xv[1] * w[1] + xv[2] * w[2] + xv[3] * w[3]; }
    }
    {
      const float a0c = p.a0[c], kkc = p.k_k[c], kac = p.k_a[c], rkc = p.r_k[c];
#pragma unroll
      for (int i = 0; i < 16; ++i) {
        const int gt = t0 + i;
        const float a = sigmoidf_(a0c + acc[i]);
        const float r = proj_shift(proj, p.shift_mu, gt, C_R + c);
        const float k = proj_shift(proj, p.shift_mu, gt, C_K + c);
        float kk = k * kkc;
        const float nrm = fmaxf(sqrtf(wave_sum(kk * kk)), 1e-12f);
        kk = kk / nrm;
        const float kp = k * (1.0f + (a - 1.0f) * kac);
        const float bs = wave_sum(r * kp * rkc);
        ws_kp(p)[(size_t)gt * RW + c] = f2bf(kp);
        ws_kk(p)[(size_t)gt * RW + c] = f2bf(kk);
        ws_bb(p)[(size_t)gt * RW + c] = f2bf(kk * a);
        if (lane == 0) ws_bonus(p)[gt * NH + wid] = bs;
      }
    }
  }
}

DI void phase3b(const Params& p, int bid, int nb, char* lds) {
  const int t = tid_(), lane = t & 63, wid = t >> 6;
  float* ql = (float*)lds;
  const bf16_t* proj = ws_proj(p);
  for (int tile = bid; tile < NTOK / 16; tile += nb) {
    const int t0 = tile * 16;
    __syncthreads();
    for (int idx = t; idx < 16 * 512; idx += NTHR) ql[idx] = bf2f(proj[(size_t)(t0 + (idx >> 9)) * PROJ_LD + C_Q + (idx & 511)]);
#pragma unroll
    for (int q = 0; q < 2; ++q) {
      const int gt = t0 + wid * 2 + q;
      const float v0 = bf2f(proj[(size_t)gt * PROJ_LD + C_CKV + lane * 2]), v1 = bf2f(proj[(size_t)gt * PROJ_LD + C_CKV + lane * 2 + 1]);
      const float rs = rsqrtf(wave_sum(v0 * v0 + v1 * v1) * (1.0f / 128.0f) + 1e-6f);
      *(unsigned*)(ws_ckv(p) + (size_t)gt * 128 + lane * 2) = pack2(v0 * rs * p.kv_norm_g[lane * 2], v1 * rs * p.kv_norm_g[lane * 2 + 1]);
      const float u = bf2f(proj[(size_t)gt * PROJ_LD + C_KI + lane]);
      const float rs2 = rsqrtf(wave_sum(u * u) * (1.0f / 64.0f) + 1e-6f);
      ws_kidx(p)[(size_t)gt * 64 + lane] = f2bf(u * rs2 * p.k_idx_norm_g[lane]);
    }
    __syncthreads();
    const int h = wid;
#pragma unroll 1
    for (int ps = 0; ps < 2; ++ps) {
      const int cidx = lane + 64 * ps;
      float w[64];
      const float* wp = p.w_uk + (size_t)(cidx * NH + h) * HD;
#pragma unroll
      for (int d4 = 0; d4 < 16; ++d4) { const f32x4 wv = *(const f32x4*)(wp + d4 * 4); w[d4 * 4] = wv[0]; w[d4 * 4 + 1] = wv[1]; w[d4 * 4 + 2] = wv[2]; w[d4 * 4 + 3] = wv[3]; }
#pragma unroll 1
      for (int i = 0; i < 16; ++i) {
        float acc = 0.f;
#pragma unroll
        for (int d4 = 0; d4 < 16; ++d4) { const f32x4 qv = *(const f32x4*)(ql + i * 512 + h * 64 + d4 * 4); acc += qv[0] * w[d4 * 4] + qv[1] * w[d4 * 4 + 1] + qv[2] * w[d4 * 4 + 2] + qv[3] * w[d4 * 4 + 3]; }
        ws_qlat(p)[((size_t)(t0 + i) * NH + h) * 128 + cidx] = f2bf(acc * 0.125f);
      }
    }
  }
}

DI float xhalf_sum(float v) { auto rr = __builtin_amdgcn_permlane32_swap(__float_as_uint(v), __float_as_uint(v), false, false); return __uint_as_float(rr[0]) + __uint_as_float(rr[1]); }
DI float dpp_sum8(float v) {
  v += __int_as_float(__builtin_amdgcn_update_dpp(0, __float_as_int(v), 0xB1, 0xF, 0xF, true));
  v += __int_as_float(__builtin_amdgcn_update_dpp(0, __float_as_int(v), 0x4E, 0xF, 0xF, true));
  v += __int_as_float(__builtin_amdgcn_update_dpp(0, __float_as_int(v), 0x141, 0xF, 0xF, true));
  return v;
}
DI float dpp_sum16b(float v) { v = dpp_sum8(v); v += __int_as_float(__builtin_amdgcn_update_dpp(0, __float_as_int(v), 0x140, 0xF, 0xF, true)); return v; }
DI u32x2 pk4(float a, float b, float c, float d) { u32x2 w; w.x = cvtpk(a, b); w.y = cvtpk(c, d); return w; }
DI void ld4(const bf16_t* p, float* o) { const u32x2 w = *(const u32x2*)p; o[0] = __uint_as_float(w.x << 16); o[1] = __uint_as_float(w.x & 0xffff0000u); o[2] = __uint_as_float(w.y << 16); o[3] = __uint_as_float(w.y & 0xffff0000u); }
constexpr int XL_ROW = 528;
template <int MODE> DI void phase3_mfma(const Params& p, int bid, int nb, char* lds) {
  const int t_ = tid_(), wid = t_ >> 6, h = wid;
  const bf16_t* proj = ws_proj(p);
  for (int tile = bid; tile < NTOK / 64; tile += nb) {
    const int t0 = tile * 64;
    int t = t_;
    asm volatile("" : "+v"(t));
    const int lane = t & 63, r32_ = lane & 31, hi_ = lane >> 5;
    __syncthreads();
#pragma unroll
    for (int i = 0; i < 4; ++i) {
      const int id = t + 512 * i, tok = id >> 5, cc = (id & 31) * 8, gt = t0 + tok;
      float v[8], pv[8];
      const bool firstt = (gt & (SEQ - 1)) == 0;
      load8(proj + (unsigned)(gt * PROJ_LD + C_WL + cc), v);
      load8(proj + (unsigned)((firstt ? gt : gt - 1) * PROJ_LD + C_WL + cc), pv);
      const f32x4 m0 = *(const f32x4*)(p.shift_mu + C_WL + cc), m1 = *(const f32x4*)(p.shift_mu + C_WL + cc + 4);
      const float esc = (cc < 64) ? 2.0f : -1.0f;
      float x[8];
#pragma unroll
      for (int j = 0; j < 8; ++j) {
        const float mu = j < 4 ? m0[j] : m1[j - 4];
        const float pj = firstt ? 0.f : pv[j];
        const float xv = v[j] + mu * (pj - v[j]);
        const float rc = 1.0f / (__expf(esc * xv) + 1.0f);
        x[j] = (cc < 64) ? (1.0f - 2.0f * rc) : ((cc >= 128) ? rc : xv);
      }
      u32x4 w; w.x = cvtpk(x[0], x[1]); w.y = cvtpk(x[2], x[3]); w.z = cvtpk(x[4], x[5]); w.w = cvtpk(x[6], x[7]);
      *(u32x4*)(lds + tok * XL_ROW + cc * 2) = w;
    }
    if (MODE & 2) {
#pragma unroll
    for (int it = 0; it < 2; ++it) {
      const int gt = t0 + wid * 8 + it * 4 + (lane >> 4), c0 = (lane & 15) * 8;
      float v[8]; load8(proj + (size_t)gt * PROJ_LD + C_CKV + c0, v);
      float ss = 0.f;
#pragma unroll
      for (int j = 0; j < 8; ++j) ss += v[j] * v[j];
      const float rs = rsqrtf(dpp_sum16b(ss) * (1.0f / 128.0f) + 1e-6f);
      const f32x4 g0 = *(const f32x4*)(p.kv_norm_g + c0), g1 = *(const f32x4*)(p.kv_norm_g + c0 + 4);
      u32x4 w; w.x = cvtpk(v[0] * rs * g0[0], v[1] * rs * g0[1]); w.y = cvtpk(v[2] * rs * g0[2], v[3] * rs * g0[3]);
      w.z = cvtpk(v[4] * rs * g1[0], v[5] * rs * g1[1]); w.w = cvtpk(v[6] * rs * g1[2], v[7] * rs * g1[3]);
      *(u32x4*)(ws_ckv(p) + (size_t)gt * 128 + c0) = w;
    }
    {
      const int gt = t0 + wid * 8 + (lane >> 3), c0 = (lane & 7) * 8;
      float v[8]; load8(proj + (size_t)gt * PROJ_LD + C_KI + c0, v);
      float ss = 0.f;
#pragma unroll
      for (int j = 0; j < 8; ++j) ss += v[j] * v[j];
      const float rs = rsqrtf(dpp_sum8(ss) * (1.0f / 64.0f) + 1e-6f);
      const f32x4 g0 = *(const f32x4*)(p.k_idx_norm_g + c0), g1 = *(const f32x4*)(p.k_idx_norm_g + c0 + 4);
      u32x4 w; w.x = cvtpk(v[0] * rs * g0[0], v[1] * rs * g0[1]); w.y = cvtpk(v[2] * rs * g0[2], v[3] * rs * g0[3]);
      w.z = cvtpk(v[4] * rs * g1[0], v[5] * rs * g1[1]); w.w = cvtpk(v[6] * rs * g1[2], v[7] * rs * g1[3]);
      *(u32x4*)(ws_kidx(p) + (size_t)gt * 64 + c0) = w;
    }
    }
    __syncthreads();
#pragma unroll 1
    for (int nt = 0; nt < 2; ++nt) {
      int r32 = r32_, hi = hi_;
      asm volatile("" : "+v"(r32), "+v"(hi));
      const int gt = t0 + nt * 32 + r32;
      const bool first = (gt & (SEQ - 1)) == 0;
      const int gp = first ? gt : gt - 1;
      const char* xrow = lds + (nt * 32 + r32) * XL_ROW + hi * 16;
      const int chb = h * HD + 4 * hi;
      char* RBt = lds + 64 * XL_ROW + wid * 14336; char* KBt = RBt + 4752; char* OBt = KBt + 4752;
      const int t0w = t0 + nt * 32, frow = lane >> 3, fch = lane & 7;
      const int cwo = r32 * 144 + hi * 8;
#define P3_FLUSH(dst_, ld_, col_) do { _Pragma("unroll") for (int i_ = 0; i_ < 4; ++i_) { const int row_ = frow + 8 * i_; \
        *(u32x4*)((dst_) + (unsigned)((t0w + row_) * (ld_) + (col_) + fch * 8)) = *(const u32x4*)(OBt + row_ * 144 + fch * 16); } } while (0)
      if (MODE & 1) {
      f32x16 acc[2];
#pragma unroll
      for (int mt = 0; mt < 2; ++mt)
#pragma unroll
        for (int r = 0; r < 16; ++r) acc[mt][r] = 0.f;
#pragma unroll
      for (int ks = 0; ks < 4; ++ks) {
        const bf16x8 bx = *(const bf16x8*)(xrow + ks * 32);
#pragma unroll
        for (int mt = 0; mt < 2; ++mt) { const bf16x8 aw = *(const bf16x8*)(ws_wdt(p) + (size_t)(h * HD + mt * 32 + r32) * 64 + ks * 16 + hi * 8); acc[mt] = __builtin_amdgcn_mfma_f32_32x32x16_bf16(aw, bx, acc[mt], 0, 0, 0); }
      }
#pragma unroll
      for (int mt = 0; mt < 2; ++mt)
#pragma unroll
        for (int g = 0; g < 4; ++g) {
          const int ch = chb + 32 * mt + 8 * g;
          const f32x4 w0v = *(const f32x4*)(p.w0 + ch);
          float e[4];
#pragma unroll
          for (int i = 0; i < 4; ++i) e[i] = 0.6065306597f / (1.0f + __expf(-(w0v[i] + acc[mt][4 * g + i])));
          *(u32x2*)(OBt + cwo + mt * 64 + g * 16) = pk4(e[0], e[1], e[2], e[3]);
        }
      P3_FLUSH(ws_ee(p), RW, h * HD);
      __builtin_amdgcn_sched_barrier(0);
#pragma unroll
      for (int mt = 0; mt < 2; ++mt)
#pragma unroll
        for (int r = 0; r < 16; ++r) acc[mt][r] = 0.f;
#pragma unroll
      for (int ks = 0; ks < 8; ++ks) {
        const bf16x8 bx = *(const bf16x8*)(xrow + 256 + ks * 32);
#pragma unroll
        for (int mt = 0; mt < 2; ++mt) { const bf16x8 aw = *(const bf16x8*)(ws_wgt(p) + (size_t)(h * HD + mt * 32 + r32) * 128 + ks * 16 + hi * 8); acc[mt] = __builtin_amdgcn_mfma_f32_32x32x16_bf16(aw, bx, acc[mt], 0, 0, 0); }
      }
#pragma unroll
      for (int mt = 0; mt < 2; ++mt)
#pragma unroll
        for (int g = 0; g < 4; ++g)
          *(u32x2*)(OBt + cwo + mt * 64 + g * 16) =
              pk4(acc[mt][4 * g] + 0.0f, acc[mt][4 * g + 1] + 0.0f, acc[mt][4 * g + 2] + 0.0f, acc[mt][4 * g + 3] + 0.0f);
      P3_FLUSH(ws_gg(p), RW, h * HD);
      __builtin_amdgcn_sched_barrier(0);
#pragma unroll
      for (int mt = 0; mt < 2; ++mt)
#pragma unroll
        for (int r = 0; r < 16; ++r) acc[mt][r] = 0.f;
#pragma unroll
      for (int ks = 0; ks < 4; ++ks) {
        const bf16x8 bx = *(const bf16x8*)(xrow + 128 + ks * 32);
#pragma unroll
        for (int mt = 0; mt < 2; ++mt) { const bf16x8 aw = *(const bf16x8*)(ws_wat(p) + (size_t)(h * HD + mt * 32 + r32) * 64 + ks * 16 + hi * 8); acc[mt] = __builtin_amdgcn_mfma_f32_32x32x16_bf16(aw, bx, acc[mt], 0, 0, 0); }
      }
      __builtin_amdgcn_sched_barrier(0);
#pragma unroll
      for (int i_ = 0; i_ < 5; ++i_) {
        const int row_ = frow + 8 * i_;
        if (row_ < 33) {
          int tk_ = t0w - 1 + row_; tk_ = tk_ < 0 ? 0 : tk_;
          *(u32x4*)(RBt + row_ * 144 + fch * 16) = *(const u32x4*)(proj + (unsigned)(tk_ * PROJ_LD + C_R + h * HD + fch * 8));
          *(u32x4*)(KBt + row_ * 144 + fch * 16) = *(const u32x4*)(proj + (unsigned)(tk_ * PROJ_LD + C_K + h * HD + fch * 8));
        }
      }
      float ss = 0.f, bs = 0.f; float av[2][16];
#pragma unroll
      for (int mt = 0; mt < 2; ++mt)
#pragma unroll
        for (int g = 0; g < 4; ++g) {
          const int ch = chb + 32 * mt + 8 * g;
          float rv[4], rp[4], kv[4], kq[4];
          ld4((const bf16_t*)(RBt + 144 + cwo + mt * 64 + g * 16), rv); ld4((const bf16_t*)(KBt + 144 + cwo + mt * 64 + g * 16), kv);
          ld4((const bf16_t*)(RBt + cwo + mt * 64 + g * 16), rp); ld4((const bf16_t*)(KBt + cwo + mt * 64 + g * 16), kq);
          const f32x4 mur = *(const f32x4*)(p.shift_mu + C_R + ch), muk = *(const f32x4*)(p.shift_mu + C_K + ch);
          const f32x4 a0v = *(const f32x4*)(p.a0 + ch), kkc = *(const f32x4*)(p.k_k + ch), kac = *(const f32x4*)(p.k_a + ch), rkc = *(const f32x4*)(p.r_k + ch);
          float kp[4];
#pragma unroll
          for (int i = 0; i < 4; ++i) {
            const float a = 1.0f / (1.0f + __expf(-(a0v[i] + acc[mt][4 * g + i])));
            const float r = rv[i] + mur[i] * ((first ? 0.f : rp[i]) - rv[i]);
            const float k = kv[i] + muk[i] * ((first ? 0.f : kq[i]) - kv[i]);
            const float kk = k * kkc[i];
            ss += kk * kk;
            kp[i] = k * (1.0f + (a - 1.0f) * kac[i]);
            bs += r * kp[i] * rkc[i];
            av[mt][4 * g + i] = a;
          }
          *(u32x2*)(OBt + cwo + mt * 64 + g * 16) = pk4(kp[0], kp[1], kp[2], kp[3]);
        }
      P3_FLUSH(ws_kp(p), RW, h * HD);
      __builtin_amdgcn_sched_barrier(0);
      ss = xhalf_sum(ss); bs = xhalf_sum(bs);
      const float inv = 1.0f / fmaxf(sqrtf(ss), 1e-12f);
#pragma unroll
      for (int mt = 0; mt < 2; ++mt)
#pragma unroll
        for (int g = 0; g < 4; ++g) {
          const int ch = chb + 32 * mt + 8 * g;
          float kv[4], kq[4];
          ld4((const bf16_t*)(KBt + 144 + cwo + mt * 64 + g * 16), kv); ld4((const bf16_t*)(KBt + cwo + mt * 64 + g * 16), kq);
          const f32x4 muk = *(const f32x4*)(p.shift_mu + C_K + ch), kkc = *(const f32x4*)(p.k_k + ch);
          float kn[4];
#pragma unroll
          for (int i = 0; i < 4; ++i) { const float kprev = first ? 0.f : kq[i]; kn[i] = (kv[i] + muk[i] * (kprev - kv[i])) * kkc[i] * inv; }
          *(u32x2*)(OBt + cwo + mt * 64 + g * 16) = pk4(kn[0], kn[1], kn[2], kn[3]);
          *(u32x2*)(RBt + cwo + mt * 64 + g * 16) = pk4(kn[0] * av[mt][4 * g], kn[1] * av[mt][4 * g + 1], kn[2] * av[mt][4 * g + 2], kn[3] * av[mt][4 * g + 3]);
        }
      P3_FLUSH(ws_kk(p), RW, h * HD);
      { char* const OBs = OBt; OBt = RBt; P3_FLUSH(ws_bb(p), RW, h * HD); OBt = OBs; }
      if (hi == 0) ws_bonus(p)[gt * NH + h] = bs;
      }
#undef P3_FLUSH
    }
  }
}

DI void phase4a(const Params& p, int bid, int nb, char* lds) {
  const int t = tid_(), i = t >> 3, cg8 = (t & 7) * 8;
  const bf16_t* proj = ws_proj(p);
  for (int task = bid; task < BATCH * NH; task += nb) {
    const int b = task >> 3, h = task & 7;
    const int cbase = h * HD + cg8;
    float mu_r[8], st[8], rprev[8];
#pragma unroll
    for (int j = 0; j < 8; ++j) { mu_r[j] = p.shift_mu[C_R + cbase + j]; st[j] = 0.f; rprev[j] = 0.f; }
    const float mu_v = p.shift_mu[C_V + h * HD + i];
    float vprev = 0.f;
    const size_t tok0 = (size_t)b * SEQ;
    u32x4 n_kk, n_bb, n_kp, n_ee, n_r; bf16_t n_v;
    {
      const size_t g = tok0;
      n_kk = *(const u32x4*)(ws_kk(p) + g * RW + cbase); n_bb = *(const u32x4*)(ws_bb(p) + g * RW + cbase);
      n_kp = *(const u32x4*)(ws_kp(p) + g * RW + cbase); n_ee = *(const u32x4*)(ws_ee(p) + g * RW + cbase);
      n_r = *(const u32x4*)(proj + g * PROJ_LD + C_R + cbase); n_v = proj[g * PROJ_LD + C_V + h * HD + i];
    }
    for (int s = 0; s < SEQ; ++s) {
      const u32x4 c_kk = n_kk, c_bb = n_bb, c_kp = n_kp, c_ee = n_ee, c_r = n_r; const bf16_t c_v = n_v;
      if (s + 1 < SEQ) {
        const size_t g = tok0 + s + 1;
        n_kk = *(const u32x4*)(ws_kk(p) + g * RW + cbase); n_bb = *(const u32x4*)(ws_bb(p) + g * RW + cbase);
        n_kp = *(const u32x4*)(ws_kp(p) + g * RW + cbase); n_ee = *(const u32x4*)(ws_ee(p) + g * RW + cbase);
        n_r = *(const u32x4*)(proj + g * PROJ_LD + C_R + cbase); n_v = proj[g * PROJ_LD + C_V + h * HD + i];
      }
      float kk[8], bb[8], kp[8], ee[8], rr[8];
      unpack8(c_kk, kk); unpack8(c_bb, bb); unpack8(c_kp, kp); unpack8(c_ee, ee); unpack8(c_r, rr);
      const float vraw = bf2f(c_v);
      const float v = vraw + mu_v * (vprev - vraw); vprev = vraw;
      float sa = 0.f;
#pragma unroll
      for (int j = 0; j < 8; ++j) sa += st[j] * kk[j];
      sa += __shfl_xor(sa, 1); sa += __shfl_xor(sa, 2); sa += __shfl_xor(sa, 4);
      sa = -sa;
      float y = 0.f;
#pragma unroll
      for (int j = 0; j < 8; ++j) {
        const float r = rr[j] + mu_r[j] * (rprev[j] - rr[j]); rprev[j] = rr[j];
        const float w = __expf(-ee[j]);
        st[j] = st[j] * w + sa * bb[j] + v * kp[j];
        y += st[j] * r;
      }
      y += __shfl_xor(y, 1); y += __shfl_xor(y, 2); y += __shfl_xor(y, 4);
      if ((t & 7) == 0) ws_y(p)[(tok0 + s) * RW + h * HD + i] = y;
    }
  }
}

DI float dpp_sum16(float v) {
  v += __int_as_float(__builtin_amdgcn_update_dpp(0, __float_as_int(v), 0xB1, 0xF, 0xF, true));
  v += __int_as_float(__builtin_amdgcn_update_dpp(0, __float_as_int(v), 0x4E, 0xF, 0xF, true));
  v += __int_as_float(__builtin_amdgcn_update_dpp(0, __float_as_int(v), 0x141, 0xF, 0xF, true));
  v += __int_as_float(__builtin_amdgcn_update_dpp(0, __float_as_int(v), 0x140, 0xF, 0xF, true));
  return v;
}
constexpr int CK = 16;
constexpr int SC_CH = 16, SC_BUF = 5 * SC_CH * 64 * 4 + SC_CH * 32 * 4 + SC_CH * 8;
DI void phase4a_v2(const Params& p, int bid, int nb, char* lds) {
  const int t = tid_(), rowl = t >> 4, cg = t & 15;
  const bf16_t* proj = ws_proj(p);
  for (int task = bid; task < BATCH * NH * 2; task += nb) {
    const int b = task >> 4, h = (task >> 1) & 7, half = task & 1;
    const size_t tok0 = (size_t)b * SEQ;
    const int sst = t >> 4, scol = h * HD + cg * 4;
    const int vst = t >> 5, vrow = t & 31, vcol = C_V + h * HD + half * 32 + vrow;
    float mur[4];
#pragma unroll
    for (int j = 0; j < 4; ++j) mur[j] = p.shift_mu[C_R + scol + j];
    const float muv = p.shift_mu[vcol];
    u32x2 g_kk, g_bb, g_kp, g_ee, g_r, g_rp; bf16_t g_v, g_vp;
    auto stage_load = [&](int c) {
      if (t < 256) {
        const size_t g = tok0 + c * SC_CH + sst;
        g_kk = *(const u32x2*)(ws_kk(p) + g * RW + scol); g_bb = *(const u32x2*)(ws_bb(p) + g * RW + scol);
        g_kp = *(const u32x2*)(ws_kp(p) + g * RW + scol); g_ee = *(const u32x2*)(ws_ee(p) + g * RW + scol);
        g_r = *(const u32x2*)(proj + g * PROJ_LD + C_R + scol);
        if (c * SC_CH + sst > 0) g_rp = *(const u32x2*)(proj + (g - 1) * PROJ_LD + C_R + scol); else { g_rp.x = 0u; g_rp.y = 0u; }
      }
      const size_t gv = tok0 + c * SC_CH + vst;
      g_v = proj[gv * PROJ_LD + vcol];
      g_vp = (c * SC_CH + vst > 0) ? proj[(gv - 1) * PROJ_LD + vcol] : (bf16_t)0;
    };
    auto stage_write = [&](char* buf) {
      if (t < 256) {
        float* W = (float*)buf + sst * 64 + cg * 4;
        f32x4 o;
        o[0] = __expf(-__uint_as_float(g_ee.x << 16)); o[1] = __expf(-__uint_as_float(g_ee.x & 0xffff0000u));
        o[2] = __expf(-__uint_as_float(g_ee.y << 16)); o[3] = __expf(-__uint_as_float(g_ee.y & 0xffff0000u));
        *(f32x4*)W = o;
        o[0] = __uint_as_float(g_kk.x << 16); o[1] = __uint_as_float(g_kk.x & 0xffff0000u); o[2] = __uint_as_float(g_kk.y << 16); o[3] = __uint_as_float(g_kk.y & 0xffff0000u);
        *(f32x4*)(W + SC_CH * 64) = o;
        o[0] = __uint_as_float(g_bb.x << 16); o[1] = __uint_as_float(g_bb.x & 0xffff0000u); o[2] = __uint_as_float(g_bb.y << 16); o[3] = __uint_as_float(g_bb.y & 0xffff0000u);
        *(f32x4*)(W + 2 * SC_CH * 64) = o;
        o[0] = __uint_as_float(g_kp.x << 16); o[1] = __uint_as_float(g_kp.x & 0xffff0000u); o[2] = __uint_as_float(g_kp.y << 16); o[3] = __uint_as_float(g_kp.y & 0xffff0000u);
        *(f32x4*)(W + 3 * SC_CH * 64) = o;
        float r[4] = {__uint_as_float(g_r.x << 16), __uint_as_float(g_r.x & 0xffff0000u), __uint_as_float(g_r.y << 16), __uint_as_float(g_r.y & 0xffff0000u)};
        float rp[4] = {__uint_as_float(g_rp.x << 16), __uint_as_float(g_rp.x & 0xffff0000u), __uint_as_float(g_rp.y << 16), __uint_as_float(g_rp.y & 0xffff0000u)};
#pragma unroll
        for (int j = 0; j < 4; ++j) o[j] = r[j] + mur[j] * (rp[j] - r[j]);
        *(f32x4*)(W + 4 * SC_CH * 64) = o;
      }
      const float v = bf2f(g_v), vp = bf2f(g_vp);
      ((float*)buf)[5 * SC_CH * 64 + vst * 32 + vrow] = v + muv * (vp - v);
    };
    float st[4] = {0.f, 0.f, 0.f, 0.f};
    __syncthreads();
    stage_load(0); stage_write(lds);
    __syncthreads();
    float* yout = ws_y(p) + tok0 * RW + h * HD + half * 32 + rowl;
    for (int c = 0; c < SEQ / SC_CH; ++c) {
      const char* cur = lds + (c & 1) * SC_BUF;
      if (c + 1 < SEQ / SC_CH) stage_load(c + 1);
      const float* Wb = (const float*)cur + cg * 4;
      const float* Vb = (const float*)cur + 5 * SC_CH * 64 + rowl;
      float yv[SC_CH];
#pragma unroll
      for (int s = 0; s < SC_CH; ++s) {
        const f32x4 w = *(const f32x4*)(Wb + s * 64), kk = *(const f32x4*)(Wb + SC_CH * 64 + s * 64), bb = *(const f32x4*)(Wb + 2 * SC_CH * 64 + s * 64);
        const f32x4 kp = *(const f32x4*)(Wb + 3 * SC_CH * 64 + s * 64), rr = *(const f32x4*)(Wb + 4 * SC_CH * 64 + s * 64);
        const float v = Vb[s * 32];
        float sa = (st[0] * kk[0] + st[1] * kk[1]) + (st[2] * kk[2] + st[3] * kk[3]);
        sa = -dpp_sum16(sa);
#pragma unroll
        for (int j = 0; j < 4; ++j) st[j] = st[j] * w[j] + (sa * bb[j] + v * kp[j]);
        float y = (st[0] * rr[0] + st[1] * rr[1]) + (st[2] * rr[2] + st[3] * rr[3]);
        yv[s] = dpp_sum16(y);
      }
      if (cg == 0) {
#pragma unroll
        for (int s = 0; s < SC_CH; ++s) yout[(size_t)(c * SC_CH + s) * RW] = yv[s];
      }
      if (c + 1 < SEQ / SC_CH) stage_write(lds + ((c + 1) & 1) * SC_BUF);
      __syncthreads();
    }
  }
}

DI void moe_tr_wave(const Params& p, int id, int lane, float* tl  ) {
  const int which = id >> 12, q = id & 4095, e = q >> 7, r = q & 127;
  const float* src; int N, k0, n0;
  if (which < 2) { src = (which == 0 ? p.e_gate : p.e_up) + (size_t)e * 1024 * 512; N = 512; k0 = (r >> 3) * 64; n0 = (r & 7) * 64; }
  else { src = p.e_down + (size_t)e * 512 * 1024; N = 1024; k0 = (r >> 4) * 64; n0 = (r & 15) * 64; }
  const int lr = lane >> 4, lc = (lane & 15) * 4;
  f32x4 g[16];
#pragma unroll
  for (int i = 0; i < 16; ++i) g[i] = *(const f32x4*)(src + (size_t)(k0 + lr + 4 * i) * N + n0 + lc);
#pragma unroll
  for (int i = 0; i < 16; ++i) { float* d = tl + (lr + 4 * i) * 65 + lc; d[0] = g[i][0]; d[1] = g[i][1]; d[2] = g[i][2]; d[3] = g[i][3]; }
  bf16_t* dst;
  { const int n = n0 + lane;
    if (which < 2) dst = ws_wgu(p) + (size_t)e * 1024 * 1024 + (size_t)((n >> 7) * 256 + (n & 127) + which * 128) * 1024 + k0;
    else dst = ws_wd(p) + (size_t)e * 1024 * 512 + (size_t)n * 512 + k0; }
#pragma unroll
  for (int c8 = 0; c8 < 8; ++c8) {
    float v[8];
#pragma unroll
    for (int j = 0; j < 8; ++j) v[j] = tl[(c8 * 8 + j) * 65 + lane];
    u32x4 w; w.x = cvtpk(v[0], v[1]); w.y = cvtpk(v[2], v[3]); w.z = cvtpk(v[4], v[5]); w.w = cvtpk(v[6], v[7]);
    *(u32x4*)(dst + c8 * 8) = w;
  }
}

typedef float f32x2p __attribute__((ext_vector_type(2)));
DI void phase4a_v3(const Params& p, int bid, int nb, char* lds) {
  const int t = tid_(), wid = __builtin_amdgcn_readfirstlane(t >> 6);
  const int rowl = (t >> 3) & 31, cg = t & 7;
  const int pt = t & 255;
  const bf16_t* proj = ws_proj(p);
  for (int task = bid; task < BATCH * NH * 2; task += nb) {
    const int b = task >> 4, h = (task >> 1) & 7, half = task & 1;
    const size_t tok0 = (size_t)b * SEQ;
    const int sst = pt >> 4, scq = pt & 15, scol = h * HD + scq * 4;
    const int vst = pt >> 5, vrow = pt & 31, vcol = C_V + h * HD + half * 32 + vrow;
    float mur[4];
#pragma unroll
    for (int j = 0; j < 4; ++j) mur[j] = p.shift_mu[C_R + scol + j];
    const float muv = p.shift_mu[vcol];
    u32x2 g_kk, g_bb, g_kp, g_ee, g_r, g_rp; bf16_t g_v0, g_v0p, g_v1, g_v1p;
#define SC_LOAD(c_) do { const int c__ = (c_); const size_t g = tok0 + c__ * SC_CH + sst; \
      g_kk = *(const u32x2*)(ws_kk(p) + g * RW + scol); g_bb = *(const u32x2*)(ws_bb(p) + g * RW + scol); \
      g_kp = *(const u32x2*)(ws_kp(p) + g * RW + scol); g_ee = *(const u32x2*)(ws_ee(p) + g * RW + scol); \
      g_r = *(const u32x2*)(proj + g * PROJ_LD + C_R + scol); \
      g_rp = *(const u32x2*)(proj + (g - ((c__ * SC_CH + sst > 0) ? 1 : 0)) * PROJ_LD + C_R + scol); \
      if (c__ * SC_CH + sst == 0) { g_rp.x = 0u; g_rp.y = 0u; } \
      const size_t gv = tok0 + c__ * SC_CH + vst; \
      g_v0 = proj[gv * PROJ_LD + vcol]; g_v0p = (c__ * SC_CH + vst > 0) ? proj[(gv - 1) * PROJ_LD + vcol] : (bf16_t)0; \
      g_v1 = proj[(gv + 8) * PROJ_LD + vcol]; g_v1p = proj[(gv + 7) * PROJ_LD + vcol]; } while (0)
#define SC_WRITE(buf_) do { float* W = (float*)(buf_) + sst * 64 + scq * 4; f32x4 o; \
      o[0] = __expf(-__uint_as_float(g_ee.x << 16)); o[1] = __expf(-__uint_as_float(g_ee.x & 0xffff0000u)); \
      o[2] = __expf(-__uint_as_float(g_ee.y << 16)); o[3] = __expf(-__uint_as_float(g_ee.y & 0xffff0000u)); *(f32x4*)W = o; \
      o[0] = __uint_as_float(g_kk.x << 16); o[1] = __uint_as_float(g_kk.x & 0xffff0000u); o[2] = __uint_as_float(g_kk.y << 16); o[3] = __uint_as_float(g_kk.y & 0xffff0000u); *(f32x4*)(W + SC_CH * 64) = o; \
      o[0] = __uint_as_float(g_bb.x << 16); o[1] = __uint_as_float(g_bb.x & 0xffff0000u); o[2] = __uint_as_float(g_bb.y << 16); o[3] = __uint_as_float(g_bb.y & 0xffff0000u); *(f32x4*)(W + 2 * SC_CH * 64) = o; \
      o[0] = __uint_as_float(g_kp.x << 16); o[1] = __uint_as_float(g_kp.x & 0xffff0000u); o[2] = __uint_as_float(g_kp.y << 16); o[3] = __uint_as_float(g_kp.y & 0xffff0000u); *(f32x4*)(W + 3 * SC_CH * 64) = o; \
      { const float r0 = __uint_as_float(g_r.x << 16), r1 = __uint_as_float(g_r.x & 0xffff0000u), r2 = __uint_as_float(g_r.y << 16), r3 = __uint_as_float(g_r.y & 0xffff0000u); \
        const float q0 = __uint_as_float(g_rp.x << 16), q1 = __uint_as_float(g_rp.x & 0xffff0000u), q2 = __uint_as_float(g_rp.y << 16), q3 = __uint_as_float(g_rp.y & 0xffff0000u); \
        o[0] = r0 + mur[0] * (q0 - r0); o[1] = r1 + mur[1] * (q1 - r1); o[2] = r2 + mur[2] * (q2 - r2); o[3] = r3 + mur[3] * (q3 - r3); \
        const f32x4 wv_ = *(const f32x4*)W, bv_ = *(const f32x4*)(W + 2 * SC_CH * 64), kv_ = *(const f32x4*)(W + 3 * SC_CH * 64); \
        const float br_ = dpp_sum16((bv_[0] * o[0] + bv_[1] * o[1]) + (bv_[2] * o[2] + bv_[3] * o[3])), kr_ = dpp_sum16((kv_[0] * o[0] + kv_[1] * o[1]) + (kv_[2] * o[2] + kv_[3] * o[3])); \
        if (scq == 0) { float* X_ = (float*)(buf_) + 5 * SC_CH * 64 + SC_CH * 32 + sst * 2; X_[0] = br_; X_[1] = kr_; } \
        o[0] *= wv_[0]; o[1] *= wv_[1]; o[2] *= wv_[2]; o[3] *= wv_[3]; *(f32x4*)(W + 4 * SC_CH * 64) = o; } \
      { const float v0 = bf2f(g_v0), v0p = bf2f(g_v0p), v1 = bf2f(g_v1), v1p = bf2f(g_v1p); float* Vw = (float*)(buf_) + 5 * SC_CH * 64 + vst * 32 + vrow; \
        Vw[0] = v0 + muv * (v0p - v0); Vw[8 * 32] = v1 + muv * (v1p - v1); } } while (0)
    f32x2p st2[4];
#pragma unroll
    for (int j = 0; j < 4; ++j) st2[j] = (f32x2p){0.f, 0.f};
    __syncthreads();
    if (wid >= 4) { SC_LOAD(0); SC_WRITE(lds); SC_LOAD(1); }
    __syncthreads();
    float* yout = ws_y(p) + tok0 * RW + h * HD + half * 32 + rowl;
    for (int c = 0; c < SEQ / SC_CH; ++c) {
      const char* cur = lds + (c & 1) * SC_BUF;
      if (wid >= 4) {
        if (c + 1 < SEQ / SC_CH) SC_WRITE(lds + ((c + 1) & 1) * SC_BUF);
        if (c + 2 < SEQ / SC_CH) SC_LOAD(c + 2);
        if ((c & 7) == 3) {
          const int tid_tr = (task * 4 + (wid - 4)) + (BATCH * NH * 2 * 4) * (c >> 3);
          if (tid_tr < 3 * 4096) moe_tr_wave(p, tid_tr, t & 63, (float*)(lds + 2 * SC_BUF + 128) + (wid - 4) * (64 * 65));
        }
      } else {
        const float* Wb = (const float*)cur + cg * 8;
        const float* Vb = (const float*)cur + 5 * SC_CH * 64 + rowl;
        float yv[SC_CH];
#pragma unroll
        for (int s = 0; s < SC_CH; ++s) {
          const f32x4 w0 = *(const f32x4*)(Wb + s * 64), w1 = *(const f32x4*)(Wb + s * 64 + 4);
          const f32x4 k0 = *(const f32x4*)(Wb + SC_CH * 64 + s * 64), k1 = *(const f32x4*)(Wb + SC_CH * 64 + s * 64 + 4);
          const f32x4 b0 = *(const f32x4*)(Wb + 2 * SC_CH * 64 + s * 64), b1 = *(const f32x4*)(Wb + 2 * SC_CH * 64 + s * 64 + 4);
          const f32x4 p0 = *(const f32x4*)(Wb + 3 * SC_CH * 64 + s * 64), p1 = *(const f32x4*)(Wb + 3 * SC_CH * 64 + s * 64 + 4);
          const f32x4 r0 = *(const f32x4*)(Wb + 4 * SC_CH * 64 + s * 64), r1 = *(const f32x4*)(Wb + 4 * SC_CH * 64 + s * 64 + 4);
          const float v = Vb[s * 32];
#define LO2(x) __builtin_shufflevector(x, x, 0, 1)
#define HI2(x) __builtin_shufflevector(x, x, 2, 3)
          const f32x2p xs = *(const f32x2p*)((const float*)cur + 5 * SC_CH * 64 + SC_CH * 32 + s * 2);
          f32x2p sa2 = st2[0] * LO2(k0), yd2 = st2[0] * LO2(r0);
          sa2 = st2[1] * HI2(k0) + sa2; yd2 = st2[1] * HI2(r0) + yd2;
          sa2 = st2[2] * LO2(k1) + sa2; yd2 = st2[2] * LO2(r1) + yd2;
          sa2 = st2[3] * HI2(k1) + sa2; yd2 = st2[3] * HI2(r1) + yd2;
          const float sa = -dpp_sum8(sa2[0] + sa2[1]);
          const float yd = dpp_sum8(yd2[0] + yd2[1]);
          yv[s] = yd + sa * xs[0] + v * xs[1];
          const f32x2p sav = {sa, sa}, vv = {v, v};
          st2[0] = st2[0] * LO2(w0) + (sav * LO2(b0) + vv * LO2(p0));
          st2[1] = st2[1] * HI2(w0) + (sav * HI2(b0) + vv * HI2(p0));
          st2[2] = st2[2] * LO2(w1) + (sav * LO2(b1) + vv * LO2(p1));
          st2[3] = st2[3] * HI2(w1) + (sav * HI2(b1) + vv * HI2(p1));
#undef LO2
#undef HI2
        }
        if (cg == 0) {
#pragma unroll
          for (int s = 0; s < SC_CH; ++s) yout[(size_t)(c * SC_CH + s) * RW] = yv[s];
        }
      }
      __syncthreads();
    }
#undef SC_LOAD
#undef SC_WRITE
  }
}

DI void moe_tr_small(const Params& p, int id, int lane, float* tl  ) {
  const int which = id >> 14, r_ = id & 16383, e = r_ >> 9, rr = r_ & 511;
  const float* src; int N, k0, n0;
  if (which < 2) { src = (which == 0 ? p.e_gate : p.e_up) + (size_t)e * 1024 * 512; N = 512; k0 = (rr >> 5) * 64; n0 = (rr & 31) * 16; }
  else { src = p.e_down + (size_t)e * 512 * 1024; N = 1024; k0 = (rr >> 6) * 64; n0 = (rr & 63) * 16; }
  const float* sp = src + (size_t)(k0 + lane) * N + n0;
  const f32x4 g0 = *(const f32x4*)sp, g1 = *(const f32x4*)(sp + 4), g2 = *(const f32x4*)(sp + 8), g3 = *(const f32x4*)(sp + 12);
  float* d = tl + lane * 17;
  d[0] = g0[0]; d[1] = g0[1]; d[2] = g0[2]; d[3] = g0[3]; d[4] = g1[0]; d[5] = g1[1]; d[6] = g1[2]; d[7] = g1[3];
  d[8] = g2[0]; d[9] = g2[1]; d[10] = g2[2]; d[11] = g2[3]; d[12] = g3[0]; d[13] = g3[1]; d[14] = g3[2]; d[15] = g3[3];
  const int nn = lane & 15, kq = lane >> 4;
  float v[16];
#pragma unroll
  for (int i = 0; i < 16; ++i) v[i] = tl[(kq * 16 + i) * 17 + nn];
  u32x4 w0, w1;
  w0.x = cvtpk(v[0], v[1]); w0.y = cvtpk(v[2], v[3]); w0.z = cvtpk(v[4], v[5]); w0.w = cvtpk(v[6], v[7]);
  w1.x = cvtpk(v[8], v[9]); w1.y = cvtpk(v[10], v[11]); w1.z = cvtpk(v[12], v[13]); w1.w = cvtpk(v[14], v[15]);
  const int n = n0 + nn;
  bf16_t* dst;
  if (which < 2) dst = ws_wgu(p) + (size_t)e * 1024 * 1024 + (size_t)((n >> 7) * 256 + (n & 127) + which * 128) * 1024 + k0 + kq * 16;
  else dst = ws_wd(p) + (size_t)e * 1024 * 512 + (size_t)n * 512 + k0 + kq * 16;
  *(u32x4*)dst = w0; *(u32x4*)(dst + 8) = w1;
}

constexpr int CS_PSZ = 23552, CS_SLSZ = 13312, CS_SL0 = 4 * CS_PSZ, CS_CON = CS_SL0 + 4 * CS_SLSZ;
DI f32x4v cs_mm16(const float* A, int sam, int sak, const float* B, int sbk, int sbn, f32x4v c, int l16, int g) {
#pragma unroll
  for (int q = 0; q < 4; ++q) c = __builtin_amdgcn_mfma_f32_16x16x4f32(A[l16 * sam + (4 * q + g) * sak], B[(4 * q + g) * sbk + l16 * sbn], c, 0, 0, 0);
  return c;
}
DI void cs_st16(float* D, f32x4v c, int l16, int g) {
#pragma unroll
  for (int r = 0; r < 4; ++r) D[(4 * g + r) * 16 + l16] = c[r];
}
DI f32x4v cs_ld16(const float* D, int l16, int g) { f32x4v c;
#pragma unroll
  for (int r = 0; r < 4; ++r) c[r] = D[(4 * g + r) * 16 + l16];
  return c; }
DI void phase4a_chunk(const Params& p, int bid, int nb, char* lds) {
  const int t = tid_(), wid = __builtin_amdgcn_readfirstlane(t >> 6), lane = t & 63, l16 = lane & 15, g = lane >> 4;
  const bf16_t* proj = ws_proj(p);
  const f32x4v z4 = {0.f, 0.f, 0.f, 0.f};
  const bf16x8 zf = {0, 0, 0, 0, 0, 0, 0, 0};
  for (int task = bid; task < BATCH * NH * 2; task += nb) {
    const int b = task >> 4, h = (task >> 1) & 7, half = task & 1;
    const int tok0 = b * SEQ;
    f32x4v Sacc[4] = {z4, z4, z4, z4};
    char* Sb = lds + CS_CON; char* Ub = Sb + 4608;
    const int i0 = (wid & 1) * 16;
    __syncthreads();
    if (wid < 2) { for (int i = lane; i < 16 * 144 / 4; i += 64) ((unsigned*)(Sb + i0 * 144))[i] = 0u; }
    for (int rnd = 0; rnd < SEQ / CK / 4; ++rnd) {
      if (wid >= 4) {
        const int pw = wid - 4, c = rnd * 4 + pw, ct0 = tok0 + c * CK;
        char* ps = lds + pw * CS_PSZ;
        bf16_t* AB = (bf16_t*)ps; bf16_t* BT = AB + 16 * 72; bf16_t* KT = BT + 16 * 72; bf16_t* RB = KT + 16 * 72;
        float* KHT = (float*)(ps + 9216);
        float* Nf = (float*)(ps + 13312); float* AKB = Nf + 256; float* ABR = AKB + 256; float* AKR = ABR + 256;
        float* T0 = AKR + 256; float* T1 = Nf; float* Pm = T0 + 256; float* Mm = Pm + 256;
        bf16_t* ABT = (bf16_t*)(Mm + 256);
        bf16_t* APb = (bf16_t*)BT;
        bf16_t* MTb = (bf16_t*)KT;
        bf16_t* W1b = MTb + 16 * 24;
        bf16_t* ABRT = W1b + 16 * 24;
        char* sl = lds + CS_SL0 + pw * CS_SLSZ;
        bf16_t* QT = (bf16_t*)sl; bf16_t* APT = QT + 16 * 72; bf16_t* BHT = APT + 16 * 72; bf16_t* GGT = BHT + 64 * 24; bf16_t* HT = GGT + 64 * 24; bf16_t* VT = HT + 16 * 24;
        float* GAM = (float*)(sl + 2304 * 2 + 3072 * 2 + 768 + 1536);
        {
          const int j = lane, col = h * HD + j;
          float cum[CK], kkv[CK], bev[CK], kpv[CK], rv[CK];
          const float mur = p.shift_mu[C_R + col];
          float rprev = (c * CK > 0) ? bf2f(proj[(size_t)(ct0 - 1) * PROJ_LD + C_R + col]) : 0.f;
          float run = 0.f;
#pragma unroll
          for (int tt = 0; tt < CK; ++tt) {
            const size_t gi = (size_t)(ct0 + tt) * RW + col;
            run += bf2f(ws_ee(p)[gi]); cum[tt] = run;
            kkv[tt] = bf2f(ws_kk(p)[gi]); bev[tt] = bf2f(ws_bb(p)[gi]); kpv[tt] = bf2f(ws_kp(p)[gi]);
            const float rr = bf2f(proj[(size_t)(ct0 + tt) * PROJ_LD + C_R + col]);
            rv[tt] = rr + mur * (rprev - rr); rprev = rr;
          }
          const float cumC = cum[CK - 1];
          const float gamC = __expf(-cumC);
          u32x4 bh0, bh1; float bhv[CK], abv[CK], btv[CK], ktv[CK], rbv[CK];
          float gprev = 1.0f;
#pragma unroll
          for (int tt = 0; tt < CK; ++tt) {
            const float gt_ = __expf(-cum[tt]), gin = __builtin_amdgcn_rcpf(gt_), gh = gamC * gin;
            abv[tt] = -gprev * kkv[tt]; gprev = gt_;
            btv[tt] = bev[tt] * gin; ktv[tt] = kpv[tt] * gin; rbv[tt] = gt_ * rv[tt];
            bhv[tt] = bev[tt] * gh;
            KHT[j * 16 + tt] = kpv[tt] * gh;
          }
#pragma unroll
          for (int tt = 0; tt < CK; tt += 2) {
            const unsigned pa = cvtpk(abv[tt], abv[tt + 1]), pb = cvtpk(btv[tt], btv[tt + 1]), pk = cvtpk(ktv[tt], ktv[tt + 1]), pr = cvtpk(rbv[tt], rbv[tt + 1]);
            AB[tt * 72 + j] = (bf16_t)pa; AB[(tt + 1) * 72 + j] = (bf16_t)(pa >> 16);
            BT[tt * 72 + j] = (bf16_t)pb; BT[(tt + 1) * 72 + j] = (bf16_t)(pb >> 16);
            KT[tt * 72 + j] = (bf16_t)pk; KT[(tt + 1) * 72 + j] = (bf16_t)(pk >> 16);
            RB[tt * 72 + j] = (bf16_t)pr; RB[(tt + 1) * 72 + j] = (bf16_t)(pr >> 16);
          }
          bh0.x = cvtpk(bhv[0], bhv[1]); bh0.y = cvtpk(bhv[2], bhv[3]); bh0.z = cvtpk(bhv[4], bhv[5]); bh0.w = cvtpk(bhv[6], bhv[7]);
          bh1.x = cvtpk(bhv[8], bhv[9]); bh1.y = cvtpk(bhv[10], bhv[11]); bh1.z = cvtpk(bhv[12], bhv[13]); bh1.w = cvtpk(bhv[14], bhv[15]);
          *(u32x4*)(BHT + j * 24) = bh0; *(u32x4*)(BHT + j * 24 + 8) = bh1;
          bh0.x = cvtpk(abv[0], abv[1]); bh0.y = cvtpk(abv[2], abv[3]); bh0.z = cvtpk(abv[4], abv[5]); bh0.w = cvtpk(abv[6], abv[7]);
          bh1.x = cvtpk(abv[8], abv[9]); bh1.y = cvtpk(abv[10], abv[11]); bh1.z = cvtpk(abv[12], abv[13]); bh1.w = cvtpk(abv[14], abv[15]);
          *(u32x4*)(ABT + j * 24) = bh0; *(u32x4*)(ABT + j * 24 + 8) = bh1;
          GAM[j] = gamC;
          const int vi = lane & 31, sh = lane >> 5, vcol = C_V + h * HD + half * 32 + vi;
          const float muv = p.shift_mu[vcol];
          float vprev = (c * CK + sh * 8 > 0) ? bf2f(proj[(size_t)(ct0 + sh * 8 - 1) * PROJ_LD + vcol]) : 0.f;
          float vv[8];
#pragma unroll
          for (int q = 0; q < 8; ++q) { const float vr = bf2f(proj[(size_t)(ct0 + sh * 8 + q) * PROJ_LD + vcol]); vv[q] = vr + muv * (vprev - vr); vprev = vr; }
          u32x4 vw; vw.x = cvtpk(vv[0], vv[1]); vw.y = cvtpk(vv[2], vv[3]); vw.z = cvtpk(vv[4], vv[5]); vw.w = cvtpk(vv[6], vv[7]);
          *(u32x4*)(VT + vi * 24 + sh * 8) = vw;
        }
        {
          bf16x8 fb[2], fk[2], fa[2], fr[2];
#pragma unroll
          for (int ks = 0; ks < 2; ++ks) { const int off = l16 * 72 + 8 * g + 32 * ks;
            fb[ks] = *(const bf16x8*)(BT + off); fk[ks] = *(const bf16x8*)(KT + off); fa[ks] = *(const bf16x8*)(AB + off); fr[ks] = *(const bf16x8*)(RB + off); }
          f32x4v n_ = z4, akb = z4, abr = z4, akr = z4;
#pragma unroll
          for (int ks = 0; ks < 2; ++ks) {
            n_ = __builtin_amdgcn_mfma_f32_16x16x32_bf16(fb[ks], fa[ks], n_, 0, 0, 0);
            akb = __builtin_amdgcn_mfma_f32_16x16x32_bf16(fk[ks], fa[ks], akb, 0, 0, 0);
            abr = __builtin_amdgcn_mfma_f32_16x16x32_bf16(fb[ks], fr[ks], abr, 0, 0, 0);
            akr = __builtin_amdgcn_mfma_f32_16x16x32_bf16(fk[ks], fr[ks], akr, 0, 0, 0);
          }
#pragma unroll
          for (int r = 0; r < 4; ++r) { const int s_ = 4 * g + r, t_ = l16;
            Nf[s_ * 16 + t_] = (s_ < t_) ? n_[r] : 0.f; AKB[s_ * 16 + t_] = (s_ < t_) ? akb[r] : 0.f;
            ABR[s_ * 16 + t_] = (s_ <= t_) ? abr[r] : 0.f; AKR[s_ * 16 + t_] = (s_ <= t_) ? akr[r] : 0.f;
            Pm[s_ * 16 + t_] = ((s_ < t_) ? n_[r] : 0.f) + ((s_ == t_) ? 1.0f : 0.f); }
          { const int t_ = l16; float a4[4];
#pragma unroll
            for (int r = 0; r < 4; ++r) a4[r] = (4 * g + r <= t_) ? abr[r] : 0.f;
            *(u32x2*)(ABRT + t_ * 24 + 4 * g) = pk4(a4[0], a4[1], a4[2], a4[3]); }
        }
        {
          f32x4v c_;
          c_ = cs_mm16(Nf, 16, 1, Nf, 16, 1, z4, l16, g); cs_st16(T0, c_, l16, g);
          c_ = cs_mm16(Pm, 16, 1, T0, 16, 1, cs_ld16(Pm, l16, g), l16, g); cs_st16(Pm, c_, l16, g);
          c_ = cs_mm16(T0, 16, 1, T0, 16, 1, z4, l16, g); cs_st16(T1, c_, l16, g);
          c_ = cs_mm16(Pm, 16, 1, T1, 16, 1, cs_ld16(Pm, l16, g), l16, g); cs_st16(Pm, c_, l16, g);
          c_ = cs_mm16(T1, 16, 1, T1, 16, 1, z4, l16, g); cs_st16(T0, c_, l16, g);
          c_ = cs_mm16(Pm, 16, 1, T0, 16, 1, cs_ld16(Pm, l16, g), l16, g); cs_st16(Mm, c_, l16, g);
          *(u32x2*)(MTb + l16 * 24 + 4 * g) = pk4(c_[0] + 0.0f, c_[1] + 0.0f, c_[2] + 0.0f, c_[3] + 0.0f);
          f32x4v w_ = z4;
#pragma unroll
          for (int q = 0; q < 4; ++q) w_ = __builtin_amdgcn_mfma_f32_16x16x4f32(Mm[(4 * q + g) * 16 + l16], AKB[l16 * 16 + 4 * q + g], w_, 0, 0, 0);
          *(u32x2*)(W1b + l16 * 24 + 4 * g) = pk4(w_[0] + 0.0f, w_[1] + 0.0f, w_[2] + 0.0f, w_[3] + 0.0f);
        }
        {
          const bf16x8 mF = (g < 2) ? *(const bf16x8*)(MTb + l16 * 24 + 8 * g) : zf;
          const bf16x8 rF = (g < 2) ? *(const bf16x8*)(ABRT + l16 * 24 + 8 * g) : zf;
          const bf16x8 wF = (g < 2) ? *(const bf16x8*)(W1b + l16 * 24 + 8 * g) : zf;
#pragma unroll
          for (int nt = 0; nt < 4; ++nt) {
            const bf16x8 bF = (g < 2) ? *(const bf16x8*)(ABT + (16 * nt + l16) * 24 + 8 * g) : zf;
            const f32x4v c_ = __builtin_amdgcn_mfma_f32_16x16x32_bf16(mF, bF, z4, 0, 0, 0);
#pragma unroll
            for (int r = 0; r < 4; ++r) APT[(4 * g + r) * 72 + 16 * nt + l16] = f2bf(c_[r]);
            *(u32x2*)(APb + (16 * nt + l16) * 24 + 4 * g) = pk4(c_[0] + 0.0f, c_[1] + 0.0f, c_[2] + 0.0f, c_[3] + 0.0f);
          }
#pragma unroll
          for (int nt = 0; nt < 4; ++nt) {
            f32x4v c_;
#pragma unroll
            for (int r = 0; r < 4; ++r) c_[r] = bf2f(RB[(4 * g + r) * 72 + 16 * nt + l16]);
            const bf16x8 bF = (g < 2) ? *(const bf16x8*)(APb + (16 * nt + l16) * 24 + 8 * g) : zf;
            c_ = __builtin_amdgcn_mfma_f32_16x16x32_bf16(rF, bF, c_, 0, 0, 0);
#pragma unroll
            for (int r = 0; r < 4; ++r) QT[(4 * g + r) * 72 + 16 * nt + l16] = f2bf(c_[r]);
          }
          {
            f32x4v c_;
#pragma unroll
            for (int r = 0; r < 4; ++r) c_[r] = AKR[l16 * 16 + 4 * g + r];
            c_ = __builtin_amdgcn_mfma_f32_16x16x32_bf16(rF, wF, c_, 0, 0, 0);
#pragma unroll
            for (int r = 0; r < 4; ++r) HT[(4 * g + r) * 24 + l16] = f2bf(c_[r]);
          }
#pragma unroll
          for (int mt = 0; mt < 4; ++mt) {
            f32x4v c_;
#pragma unroll
            for (int r = 0; r < 4; ++r) c_[r] = KHT[(16 * mt + 4 * g + r) * 16 + l16];
            const bf16x8 aF = (g < 2) ? *(const bf16x8*)(BHT + (16 * mt + l16) * 24 + 8 * g) : zf;
            c_ = __builtin_amdgcn_mfma_f32_16x16x32_bf16(aF, wF, c_, 0, 0, 0);
#pragma unroll
            for (int r = 0; r < 4; ++r) GGT[(16 * mt + 4 * g + r) * 24 + l16] = f2bf(c_[r]);
          }
        }
      }
      else if (wid >= 2) {
        float* tl = (float*)(lds + CS_CON + 6144) + (wid - 2) * (64 * 17);
#pragma unroll 1
        for (int q = 0; q < 3; ++q) moe_tr_small(p, ((task * 2 + (wid - 2)) * 96 + rnd * 3 + q), lane, tl);
      }
      __syncthreads();
      if (wid < 2) {
#pragma unroll 1
        for (int k = 0; k < 4; ++k) {
          const char* sl = lds + CS_SL0 + k * CS_SLSZ;
          const bf16_t* QT = (const bf16_t*)sl; const bf16_t* APT = QT + 16 * 72; const bf16_t* BHT = APT + 16 * 72; const bf16_t* GGT = BHT + 64 * 24; const bf16_t* HT = GGT + 64 * 24; const bf16_t* VT = HT + 16 * 24;
          const float* GAM = (const float*)(sl + 2304 * 2 + 3072 * 2 + 768 + 1536);
          bf16x8 sA[2], qF[2], aF[2];
#pragma unroll
          for (int ks = 0; ks < 2; ++ks) { sA[ks] = *(const bf16x8*)(Sb + (i0 + l16) * 144 + (8 * g + 32 * ks) * 2);
            qF[ks] = *(const bf16x8*)(QT + l16 * 72 + 8 * g + 32 * ks); aF[ks] = *(const bf16x8*)(APT + l16 * 72 + 8 * g + 32 * ks); }
          const bf16x8 vF = (g < 2) ? *(const bf16x8*)(VT + (i0 + l16) * 24 + 8 * g) : zf;
          const bf16x8 hF = (g < 2) ? *(const bf16x8*)(HT + l16 * 24 + 8 * g) : zf;
          f32x4v yT = z4;
          yT = __builtin_amdgcn_mfma_f32_16x16x32_bf16(qF[0], sA[0], yT, 0, 0, 0);
          yT = __builtin_amdgcn_mfma_f32_16x16x32_bf16(qF[1], sA[1], yT, 0, 0, 0);
          yT = __builtin_amdgcn_mfma_f32_16x16x32_bf16(hF, vF, yT, 0, 0, 0);
          {
            float* yo = ws_y(p) + (size_t)(tok0 + (rnd * 4 + k) * CK + 4 * g) * RW + h * HD + half * 32 + i0 + l16;
#pragma unroll
            for (int r = 0; r < 4; ++r) yo[(size_t)r * RW] = yT[r];
          }
          f32x4v u = z4;
          u = __builtin_amdgcn_mfma_f32_16x16x32_bf16(sA[0], aF[0], u, 0, 0, 0);
          u = __builtin_amdgcn_mfma_f32_16x16x32_bf16(sA[1], aF[1], u, 0, 0, 0);
#pragma unroll
          for (int r = 0; r < 4; ++r) *(bf16_t*)(Ub + (i0 + 4 * g + r) * 48 + l16 * 2) = f2bf(u[r]);
          const bf16x8 uF = (g < 2) ? *(const bf16x8*)(Ub + (i0 + l16) * 48 + 16 * g) : zf;
#pragma unroll
          for (int nt = 0; nt < 4; ++nt) {
            const float gm = GAM[16 * nt + l16];
            const bf16x8 bF = (g < 2) ? *(const bf16x8*)(BHT + (16 * nt + l16) * 24 + 8 * g) : zf;
            const bf16x8 gF = (g < 2) ? *(const bf16x8*)(GGT + (16 * nt + l16) * 24 + 8 * g) : zf;
            f32x4v a_ = Sacc[nt] * gm;
            a_ = __builtin_amdgcn_mfma_f32_16x16x32_bf16(uF, bF, a_, 0, 0, 0);
            a_ = __builtin_amdgcn_mfma_f32_16x16x32_bf16(vF, gF, a_, 0, 0, 0);
            Sacc[nt] = a_;
#pragma unroll
            for (int r = 0; r < 4; ++r) *(bf16_t*)(Sb + (i0 + 4 * g + r) * 144 + (16 * nt + l16) * 2) = f2bf(a_[r]);
          }
        }
      }
      __syncthreads();
    }
  }
}

DI unsigned fkey(float f) { const unsigned u = __float_as_uint(f); return (u & 0x80000000u) ? ~u : (u | 0x80000000u); }
DI int block_sum_i(int v, int* red, int wid, int lane) {
  for (int o = 32; o; o >>= 1) v += __shfl_xor(v, o);
  __syncthreads();
  if (lane == 0) red[wid] = v;
  __syncthreads();
  int s = 0;
#pragma unroll
  for (int w = 0; w < 8; ++w) s += red[w];
  return s;
}
DI void phase4b(const Params& p, int bid, int nb, char* lds) {
  const int t = tid_(), lane = t & 63, wid = t >> 6;
  float* qf = (float*)lds;
  float* wi = qf + 256;
  int* red = (int*)(wi + 4);
  int* wtie = red + 8;
  const bf16_t* proj = ws_proj(p);
  for (int gq = bid; gq < NTOK; gq += nb) {
    const int b = gq >> 11, s = gq & (SEQ - 1);
    const int n = ((s >> 6) + 1) * 64;
    unsigned* mrow = ws_mask(p) + (size_t)gq * 64;
    if (n <= 256) {
      if (t < 64) mrow[t] = (t * 32 < n) ? 0xffffffffu : 0u;
      continue;
    }
    __syncthreads();
    if (t < 256) qf[t] = bf2f(proj[(size_t)gq * PROJ_LD + C_QI + t]) * 0.125f;
    else if (t < 260) wi[t - 256] = bf2f(proj[(size_t)gq * PROJ_LD + C_WI + t - 256]) * 0.5f;
    __syncthreads();
    unsigned uk[4];
#pragma unroll 1
    for (int q = 0; q < 4; ++q) {
      const int key = t * 4 + q;
      uk[q] = 0u;
      if (key < n) {
        float kf[64];
        const bf16_t* kr = ws_kidx(p) + ((size_t)b * SEQ + key) * 64;
#pragma unroll
        for (int d8 = 0; d8 < 8; ++d8) load8(kr + d8 * 8, kf + d8 * 8);
        float sc = 0.f;
#pragma unroll
        for (int hh = 0; hh < 4; ++hh) {
          float dot = 0.f;
#pragma unroll
          for (int d4 = 0; d4 < 16; ++d4) { const f32x4 qv = *(const f32x4*)(qf + hh * 64 + d4 * 4); dot += qv[0] * kf[d4 * 4] + qv[1] * kf[d4 * 4 + 1] + qv[2] * kf[d4 * 4 + 2] + qv[3] * kf[d4 * 4 + 3]; }
          sc += wi[hh] * fmaxf(dot, 0.f);
        }
        sc = sc + 0.0f;
        uk[q] = fkey(sc);
      }
    }
    unsigned T = 0u;
    for (int bit = 31; bit >= 0; --bit) {
      const unsigned cand = T | (1u << bit);
      const int c = (uk[0] >= cand) + (uk[1] >= cand) + (uk[2] >= cand) + (uk[3] >= cand);
      if (block_sum_i(c, red, wid, lane) >= 256) T = cand;
    }
    const int cgt = block_sum_i((uk[0] > T) + (uk[1] > T) + (uk[2] > T) + (uk[3] > T), red, wid, lane);
    const int need = 256 - cgt;
    const int tl = (uk[0] == T) + (uk[1] == T) + (uk[2] == T) + (uk[3] == T);
    int incl = tl;
    for (int o = 1; o < 64; o <<= 1) { const int u = __shfl_up(incl, o); if (lane >= o) incl += u; }
    __syncthreads();
    if (lane == 63) wtie[wid] = incl;
    __syncthreads();
    int before = incl - tl;
    for (int w = 0; w < wid; ++w) before += wtie[w];
    unsigned nib = 0u;
#pragma unroll
    for (int q = 0; q < 4; ++q) {
      bool sel = uk[q] > T;
      if (uk[q] == T) { sel = before < need; ++before; }
      if (sel) nib |= 1u << q;
    }
    unsigned word = nib << ((lane & 7) * 4);
    word |= __shfl_xor(word, 1); word |= __shfl_xor(word, 2); word |= __shfl_xor(word, 4);
    if ((lane & 7) == 0) mrow[t >> 3] = word;
  }
}

constexpr int IDX_LD = 2052;
DI void phase4b_mfma(const Params& p, int bid, int nb, char* lds) {
  const int t = tid_(), lane = t & 63, wid = t >> 6, q16 = lane & 15, g = lane >> 4;
  unsigned* S = (unsigned*)lds;
  const bf16_t* proj = ws_proj(p);
  for (int task = bid; task < NTOK / 16; task += nb) {
    const int b = (task & 255) >> 4, jq = task & 15, kq = task >> 8;
    const int q0 = (((kq & 1) ? 31 - jq : jq) + 32 * (kq >> 1)) * 16;
    const int n = ((q0 >> 6) + 1) * 64, ntile = n >> 4;
    if (n <= 256) {
      unsigned short* mrow = (unsigned short*)(ws_mask(p) + (size_t)(b * SEQ + q0 + q16) * 64);
      if (g == 0) for (int kt = wid; kt < ntile; kt += 8) mrow[kt] = 0xffffu;
      continue;
    }
    const int gq = b * SEQ + q0 + q16;
    const int ntw = (ntile - wid + 7) >> 3;
    const bf16_t* kbase = ws_kidx(p) + (size_t)b * SEQ * 64 + (wid * 16 + q16) * 64 + g * 8;
    bf16x8 qf[4][2]; float wq[4];
#pragma unroll
    for (int h = 0; h < 4; ++h) {
#pragma unroll
      for (int ks = 0; ks < 2; ++ks) qf[h][ks] = *(const bf16x8*)(proj + (size_t)gq * PROJ_LD + C_QI + h * 64 + ks * 32 + g * 8);
      wq[h] = bf2f(proj[(size_t)gq * PROJ_LD + C_WI + h]) * 0.0625f;
    }
    __syncthreads();
    bf16x8 k0 = *(const bf16x8*)kbase, k1 = *(const bf16x8*)(kbase + 32);
#pragma unroll
    for (int tt = 0; tt < 16; ++tt) {
      if (tt < ntw) {
        const bf16x8 c0 = k0, c1 = k1;
        if (tt + 1 < ntw) { int koff = (tt + 1) * 8 * 16 * 64; asm volatile("" : "+v"(koff)); k0 = *(const bf16x8*)(kbase + koff); k1 = *(const bf16x8*)(kbase + koff + 32); }
        float sc[4] = {0.f, 0.f, 0.f, 0.f};
#pragma unroll
        for (int h = 0; h < 4; ++h) {
          f32x4v acc = {0.f, 0.f, 0.f, 0.f};
          acc = __builtin_amdgcn_mfma_f32_16x16x32_bf16(c0, qf[h][0], acc, 0, 0, 0);
          acc = __builtin_amdgcn_mfma_f32_16x16x32_bf16(c1, qf[h][1], acc, 0, 0, 0);
#pragma unroll
          for (int r = 0; r < 4; ++r) sc[r] += wq[h] * fmaxf(acc[r], 0.f);
        }
        u32x4 kv;
#pragma unroll
        for (int r = 0; r < 4; ++r) {
          const unsigned bts = __float_as_uint(sc[r]);
          unsigned key = bts ^ ((unsigned)((int)bts >> 31) | 0x80000000u);
          key += (key == 0x7fffffffu) ? 1u : 0u;
          kv[r] = key;
        }
        *(u32x4*)(S + q16 * IDX_LD + (wid + 8 * tt) * 16 + 4 * g) = kv;
      }
    }
    __syncthreads();
    {
      const int nreg = n >> 6;
      const int qa = 2 * wid;
      unsigned ua[32], ub[32];
#pragma unroll
      for (int j = 0; j < 32; ++j) { ua[j] = (j < nreg) ? S[qa * IDX_LD + 64 * j + lane] : 0u; ub[j] = (j < nreg) ? S[(qa + 1) * IDX_LD + 64 * j + lane] : 0u; }
      unsigned Ta = 0u, Tb = 0u; bool xa = false, xb = false;
      for (int bit = 31; bit >= 0; --bit) {
        const unsigned ca = xa ? Ta : (Ta | (1u << bit)), cb = xb ? Tb : (Tb | (1u << bit));
        int va = 0, vb = 0;
#pragma unroll
        for (int j4 = 0; j4 < 8; ++j4) {
          if (j4 * 4 < nreg) {
#pragma unroll
            for (int j = j4 * 4; j < j4 * 4 + 4; ++j) { va += (ua[j] >= ca) ? 1 : 0; vb += (ub[j] >= cb) ? 1 : 0; }
          }
        }
        int vab = va | (vb << 16);
        vab += __builtin_amdgcn_update_dpp(0, vab, 0xB1, 0xF, 0xF, true);
        vab += __builtin_amdgcn_update_dpp(0, vab, 0x4E, 0xF, 0xF, true);
        vab += __builtin_amdgcn_update_dpp(0, vab, 0x141, 0xF, 0xF, true);
        vab += __builtin_amdgcn_update_dpp(0, vab, 0x140, 0xF, 0xF, true);
        const int tot = __builtin_amdgcn_readlane(vab, 0) + __builtin_amdgcn_readlane(vab, 16) + __builtin_amdgcn_readlane(vab, 32) + __builtin_amdgcn_readlane(vab, 48);
        const int na = tot & 0xffff, nq = tot >> 16;
        if (!xa && na >= 256) { Ta = ca; xa = (na == 256); }
        if (!xb && nq >= 256) { Tb = cb; xb = (nq == 256); }
        if (xa && xb) break;
      }
#pragma unroll 1
      for (int which = 0; which < 2; ++which) {
        const unsigned T = which ? Tb : Ta;
        int cgt = 0;
#pragma unroll
        for (int j = 0; j < 32; ++j) cgt += __popcll(__ballot((which ? ub[j] : ua[j]) > T));
        int need = 256 - cgt;
        unsigned* mrow = ws_mask(p) + (size_t)(b * SEQ + q0 + qa + which) * 64;
#pragma unroll
        for (int j = 0; j < 32; ++j) {
          if (j < nreg) {
            const unsigned uv = which ? ub[j] : ua[j];
            unsigned long long sel = __ballot(uv > T);
            const unsigned long long eq = __ballot(uv == T);
            const int pe = __popcll(eq);
            if (pe <= need) { sel |= eq; need -= pe; }
            else { unsigned long long e = eq; for (int i = 0; i < need; ++i) { const unsigned long long low = e & (0ull - e); sel |= low; e ^= low; } need = 0; }
            if (lane == 0) { mrow[2 * j] = (unsigned)sel; mrow[2 * j + 1] = (unsigned)(sel >> 32); }
          }
        }
      }
    }
  }
}

DI void phase5a(const Params& p, int bid, int nb, char* lds) {
  const int lane = tid_() & 63, wid = tid_() >> 6;
  const bf16_t* proj = ws_proj(p);
  for (int gt = bid * 8 + wid; gt < NTOK; gt += nb * 8) {
    const int c0 = lane * 8, h = lane >> 3;
    const f32x4 y0 = *(const f32x4*)(ws_y(p) + (size_t)gt * RW + c0), y1 = *(const f32x4*)(ws_y(p) + (size_t)gt * RW + c0 + 4);
    float y[8] = {y0[0], y0[1], y0[2], y0[3], y1[0], y1[1], y1[2], y1[3]};
    float s = 0.f;
#pragma unroll
    for (int j = 0; j < 8; ++j) s += y[j];
    s += __shfl_xor(s, 1); s += __shfl_xor(s, 2); s += __shfl_xor(s, 4);
    const float mean = s * (1.0f / 64.0f);
    float q = 0.f;
#pragma unroll
    for (int j = 0; j < 8; ++j) { const float d = y[j] - mean; q += d * d; }
    q += __shfl_xor(q, 1); q += __shfl_xor(q, 2); q += __shfl_xor(q, 4);
    const float rstd = rsqrtf(q * (1.0f / 64.0f) + 64e-5f);
    float g[8], vr[8], vp[8];
    load8(ws_gg(p) + (size_t)gt * RW + c0, g);
    load8(proj + (size_t)gt * PROJ_LD + C_V + c0, vr);
    if (gt & (SEQ - 1)) load8(proj + (size_t)(gt - 1) * PROJ_LD + C_V + c0, vp);
    else {
#pragma unroll
      for (int j = 0; j < 8; ++j) vp[j] = 0.f;
    }
    const float bs = ws_bonus(p)[gt * NH + h];
    float o[8];
#pragma unroll
    for (int j = 0; j < 8; ++j) {
      const float v = vr[j] + p.shift_mu[C_V + c0 + j] * (vp[j] - vr[j]);
      o[j] = ((y[j] - mean) * rstd * p.gn_g[c0 + j] + p.gn_b[c0 + j] + bs * v) * g[j];
    }
    u32x4 w; w.x = pack2(o[0], o[1]); w.y = pack2(o[2], o[3]); w.z = pack2(o[4], o[5]); w.w = pack2(o[6], o[7]);
    *(u32x4*)(ws_mix(p) + (size_t)gt * DM + c0) = w;
  }
}

DI void phase5b(const Params& p, int bid, int nb, char* lds) {
  const int t = tid_(), lane = t & 63, wid = t >> 6;
  float* ql = (float*)lds;
  float* pr = ql + 1024;
  float* ol = pr + 2048;
  int* sel = (int*)(ol + 1024);
  int* nselp = sel + 256;
  for (int gq = bid; gq < NTOK; gq += nb) {
    const int b = gq >> 11;
    const bf16_t* ckv = ws_ckv(p) + (size_t)b * SEQ * 128;
    __syncthreads();
    for (int idx = t; idx < 1024; idx += NTHR) ql[idx] = bf2f(ws_qlat(p)[(size_t)gq * 1024 + idx]);
    if (wid == 0) {
      const int nadm = (((gq & (SEQ - 1)) >> 6) + 1) * 64;
      const unsigned word = (lane * 32 < nadm) ? ws_mask(p)[(size_t)gq * 64 + lane] : 0u;
      const int cnt = __popc(word);
      int incl = cnt;
      for (int o = 1; o < 64; o <<= 1) { const int u = __shfl_up(incl, o); if (lane >= o) incl += u; }
      int pos = incl - cnt;
      unsigned w = word;
      while (w) { const int bit = __ffs(w) - 1; w &= w - 1; if (pos < 256) sel[pos] = lane * 32 + bit; ++pos; }
      if (lane == 63) *nselp = incl < 256 ? incl : 256;
    }
    __syncthreads();
    const int nsel = *nselp;
    const int h = wid;
    float lg[4]; float mx = -1e30f;
#pragma unroll
    for (int q = 0; q < 4; ++q) {
      const int slot = lane + 64 * q;
      lg[q] = -1e30f;
      if (slot < nsel) {
        const bf16_t* kr = ckv + (size_t)sel[slot] * 128;
        float acc = 0.f;
#pragma unroll
        for (int d8 = 0; d8 < 16; ++d8) {
          float kf[8]; load8(kr + d8 * 8, kf);
          const f32x4 q0 = *(const f32x4*)(ql + h * 128 + d8 * 8), q1 = *(const f32x4*)(ql + h * 128 + d8 * 8 + 4);
          acc += q0[0] * kf[0] + q0[1] * kf[1] + q0[2] * kf[2] + q0[3] * kf[3] + q1[0] * kf[4] + q1[1] * kf[5] + q1[2] * kf[6] + q1[3] * kf[7];
        }
        lg[q] = acc;
      }
      mx = fmaxf(mx, lg[q]);
    }
    mx = wave_max(mx);
    float sm = 0.f;
#pragma unroll
    for (int q = 0; q < 4; ++q) { lg[q] = (lane + 64 * q < nsel) ? __expf(lg[q] - mx) : 0.f; sm += lg[q]; }
    sm = wave_sum(sm);
    const float inv = 1.0f / sm;
#pragma unroll
    for (int q = 0; q < 4; ++q) pr[h * 256 + lane + 64 * q] = lg[q] * inv;
    __syncthreads();
    {
      float o0 = 0.f, o1 = 0.f;
      for (int slot = 0; slot < nsel; ++slot) {
        const unsigned kv2 = *(const unsigned*)(ckv + (size_t)sel[slot] * 128 + lane * 2);
        const float pp = pr[h * 256 + slot];
        o0 += pp * __uint_as_float(kv2 << 16); o1 += pp * __uint_as_float(kv2 & 0xffff0000u);
      }
      ol[h * 128 + lane * 2] = o0; ol[h * 128 + lane * 2 + 1] = o1;
    }
    __syncthreads();
    {
      float acc = 0.f;
      for (int cc = 0; cc < 128; ++cc) acc += ol[h * 128 + cc] * p.w_uv[(size_t)(cc * NH + h) * HD + lane];
      ws_mix(p)[(size_t)gq * DM + RW + h * HD + lane] = f2bf(acc);
    }
  }
}

typedef short s16x4 __attribute__((ext_vector_type(4)));
#define KSWZ(row, colB) ((row) * 256 + ((colB) ^ (((row) & 7) << 4)))
DI int v_st(int k, int c) { const int kk = (k & ~0xC) | ((k & 4) << 1) | ((k & 8) >> 1); return ((kk >> 3) * 4 + (c >> 5)) * 512 + ((kk & 7) * 32 + (c & 31)) * 2; }
DI int v_rd_base(int lane) { return ((lane & 3) << 3) | (((lane >> 2) & 3) << 6) | (((lane >> 4) & 1) << 5) | (((lane >> 5) & 1) << 8); }
constexpr int v_rd_off(int d0, int ks, int half) { return d0 * 512 + ks * 4096 + half * 2048; }
template <int OFF> DI s16x4 tr_read(int vb) { s16x4 r; asm volatile("ds_read_b64_tr_b16 %0, %1 offset:%2" : "=&v"(r) : "v"(vb), "i"(OFF) : "memory"); return r; }
template <int D0> DI void pv_one(f32x16& od, int vb, bf16x8 pa0, bf16x8 pa1, bf16x8 pa2, bf16x8 pa3) {
  const s16x4 l0 = tr_read<v_rd_off(D0, 0, 0)>(vb), h0 = tr_read<v_rd_off(D0, 0, 1)>(vb), l1 = tr_read<v_rd_off(D0, 1, 0)>(vb), h1 = tr_read<v_rd_off(D0, 1, 1)>(vb);
  const s16x4 l2 = tr_read<v_rd_off(D0, 2, 0)>(vb), h2 = tr_read<v_rd_off(D0, 2, 1)>(vb), l3 = tr_read<v_rd_off(D0, 3, 0)>(vb), h3 = tr_read<v_rd_off(D0, 3, 1)>(vb);
  asm volatile("s_waitcnt lgkmcnt(0)" ::: "memory"); __builtin_amdgcn_sched_barrier(0);
#define PKV(L, H) (bf16x8){L[0], L[1], L[2], L[3], H[0], H[1], H[2], H[3]}
  od = __builtin_amdgcn_mfma_f32_32x32x16_bf16(pa0, PKV(l0, h0), od, 0, 0, 0);
  od = __builtin_amdgcn_mfma_f32_32x32x16_bf16(pa1, PKV(l1, h1), od, 0, 0, 0);
  od = __builtin_amdgcn_mfma_f32_32x32x16_bf16(pa2, PKV(l2, h2), od, 0, 0, 0);
  od = __builtin_amdgcn_mfma_f32_32x32x16_bf16(pa3, PKV(l3, h3), od, 0, 0, 0);
#undef PKV
}
constexpr int ATT_TILE = 64 * 128 * 2;
constexpr int ATT_LDS = 4 * ATT_TILE + 8 * 64 * 4;
DI void phase5b_mfma(const Params& p, int bid, int nb, char* lds) {
  const int t = tid_(), lane = t & 63, wid = t >> 6, r32 = lane & 31, hi = lane >> 5;
  char* V_lds = lds; char* K_lds = lds + 2 * ATT_TILE;
  float* al_l = (float*)(lds + 4 * ATT_TILE) + wid * 64; float* li_l = al_l + 32;
  const int sr = t >> 4, sc = (t & 15) * 8;
  const int vst0 = v_st(sr, sc), vst1 = v_st(32 + sr, sc), kst0 = KSWZ(sr, sc * 2), kst1 = KSWZ(32 + sr, sc * 2);
  const int vb0 = (int)(uintptr_t)V_lds + v_rd_base(lane);
  const int h = wid;
  constexpr float LOG2E = 1.4426950408889634f, THR = 8.0f;
  for (int task = bid; task < NTOK / 32; task += nb) {
    const int b = (task & 255) >> 4;
    int qt; { const int j = task & 15, k = task >> 8; qt = (k == 0) ? j : (k == 1) ? 31 - j : (k == 2) ? 32 + j : 63 - j; }
    const int q0 = qt * 32, n = ((q0 >> 6) + 1) * 64, NT = n >> 6;
    const int gq = b * SEQ + q0 + r32;
    const bf16_t* ckv = ws_ckv(p) + (size_t)b * SEQ * 128;
    const unsigned* mrow = ws_mask(p) + (size_t)gq * 64;
    bf16x8 qr[8];
    {
      f32x16 qa[4];
#pragma unroll
      for (int mt = 0; mt < 4; ++mt)
#pragma unroll
        for (int r = 0; r < 16; ++r) qa[mt][r] = 0.f;
      const bf16_t* wuk = ws_wukt(p) + (size_t)(h * 128 + r32) * 64 + hi * 8;
#pragma unroll
      for (int ks = 0; ks < 4; ++ks) {
        const bf16x8 bq = *(const bf16x8*)(ws_proj(p) + (size_t)gq * PROJ_LD + C_Q + h * HD + ks * 16 + hi * 8);
#pragma unroll
        for (int mt = 0; mt < 4; ++mt) { const bf16x8 aw = *(const bf16x8*)(wuk + mt * 32 * 64 + ks * 16); qa[mt] = __builtin_amdgcn_mfma_f32_32x32x16_bf16(aw, bq, qa[mt], 0, 0, 0); }
      }
#define QPK(P, BASE, OUT) do { unsigned a0 = cvtpk(P[BASE + 0] * 0.125f, P[BASE + 1] * 0.125f), a1 = cvtpk(P[BASE + 2] * 0.125f, P[BASE + 3] * 0.125f);   \
    unsigned b0 = cvtpk(P[BASE + 4] * 0.125f, P[BASE + 5] * 0.125f), b1 = cvtpk(P[BASE + 6] * 0.125f, P[BASE + 7] * 0.125f);                              \
    auto r0 = __builtin_amdgcn_permlane32_swap(a0, b0, false, false); auto r1 = __builtin_amdgcn_permlane32_swap(a1, b1, false, false); \
    u32x4 w = {r0[0], r1[0], r0[1], r1[1]}; OUT = *reinterpret_cast<bf16x8*>(&w); } while (0)
#pragma unroll
      for (int mt = 0; mt < 4; ++mt) { QPK(qa[mt], 0, qr[2 * mt]); QPK(qa[mt], 8, qr[2 * mt + 1]); }
#undef QPK
    }
    float m_reg = -1e30f, l_reg = 0.f;
    f32x16 o[4];
#pragma unroll
    for (int d = 0; d < 4; ++d)
#pragma unroll
      for (int r = 0; r < 16; ++r) o[d][r] = 0.f;
    u32x4 s0 = *(const u32x4*)(ckv + (size_t)sr * 128 + sc), s1 = *(const u32x4*)(ckv + (size_t)(32 + sr) * 128 + sc);
    __syncthreads();
    *(u32x4*)(V_lds + vst0) = s0; *(u32x4*)(V_lds + vst1) = s1; *(u32x4*)(K_lds + kst0) = s0; *(u32x4*)(K_lds + kst1) = s1;
    __syncthreads();
    for (int j = 0; j < NT; ++j) {
      const int buf = j & 1;
      if (j + 1 < NT) { s0 = *(const u32x4*)(ckv + (size_t)((j + 1) * 64 + sr) * 128 + sc); s1 = *(const u32x4*)(ckv + (size_t)((j + 1) * 64 + 32 + sr) * 128 + sc); }
      const unsigned w0 = mrow[2 * j] >> (4 * hi), w1 = mrow[2 * j + 1] >> (4 * hi);
      f32x16 p0, p1;
#pragma unroll
      for (int r = 0; r < 16; ++r) { p0[r] = 0.f; p1[r] = 0.f; }
      const char* Kb = K_lds + buf * ATT_TILE;
#pragma unroll
      for (int d0 = 0; d0 < 8; ++d0) {
        const int cb = (d0 * 16 + hi * 8) * 2;
        const bf16x8 b0 = *(const bf16x8*)(Kb + KSWZ(r32, cb)), b1 = *(const bf16x8*)(Kb + KSWZ(32 + r32, cb));
        p0 = __builtin_amdgcn_mfma_f32_32x32x16_bf16(b0, qr[d0], p0, 0, 0, 0);
        p1 = __builtin_amdgcn_mfma_f32_32x32x16_bf16(b1, qr[d0], p1, 0, 0, 0);
      }
      float pmax = p0[0];
#pragma unroll
      for (int r = 1; r < 16; ++r) pmax = fmaxf(pmax, p0[r]);
#pragma unroll
      for (int r = 0; r < 16; ++r) pmax = fmaxf(pmax, p1[r]);
      { auto rr = __builtin_amdgcn_permlane32_swap(__float_as_uint(pmax), __float_as_uint(pmax), false, false); pmax = fmaxf(__uint_as_float(rr[0]), __uint_as_float(rr[1])); }
      float alpha = 1.f;
      if (!__all(pmax - m_reg <= THR)) { const float mn = fmaxf(m_reg, pmax); alpha = __builtin_amdgcn_exp2f((m_reg - mn) * LOG2E); m_reg = mn; }
      const float mnC = -m_reg * LOG2E;
      float ps = 0.f;
#pragma unroll
      for (int r = 0; r < 16; ++r) {
        const int bitp = (r & 3) + 8 * (r >> 2);
        float e0 = __builtin_amdgcn_exp2f(fmaf(p0[r], LOG2E, mnC)), e1 = __builtin_amdgcn_exp2f(fmaf(p1[r], LOG2E, mnC));
        e0 = ((w0 >> bitp) & 1u) ? e0 : 0.f; e1 = ((w1 >> bitp) & 1u) ? e1 : 0.f;
        p0[r] = e0; p1[r] = e1; ps += e0 + e1;
      }
      { auto rr = __builtin_amdgcn_permlane32_swap(__float_as_uint(ps), __float_as_uint(ps), false, false); ps = __uint_as_float(rr[0]) + __uint_as_float(rr[1]); }
      l_reg = l_reg * alpha + ps;
      if (__any(alpha < 1.f)) {
        if (hi == 0) al_l[r32] = alpha;
        asm volatile("s_waitcnt lgkmcnt(0)" ::: "memory");
#pragma unroll
        for (int d = 0; d < 4; ++d)
#pragma unroll
          for (int r = 0; r < 16; ++r) o[d][r] *= al_l[crow(r, hi)];
      }
      bf16x8 pa0, pa1, pa2, pa3;
#define PK4(P, BASE, OUT) do { unsigned a0 = cvtpk(P[BASE + 0], P[BASE + 1]), a1 = cvtpk(P[BASE + 2], P[BASE + 3]);   \
    unsigned b0 = cvtpk(P[BASE + 4], P[BASE + 5]), b1 = cvtpk(P[BASE + 6], P[BASE + 7]);                              \
    auto r0 = __builtin_amdgcn_permlane32_swap(a0, b0, false, false); auto r1 = __builtin_amdgcn_permlane32_swap(a1, b1, false, false); \
    u32x4 w = {r0[0], r1[0], r0[1], r1[1]}; OUT = *reinterpret_cast<bf16x8*>(&w); } while (0)
      PK4(p0, 0, pa0); PK4(p0, 8, pa1); PK4(p1, 0, pa2); PK4(p1, 8, pa3);
#undef PK4
      const int vb = vb0 + buf * ATT_TILE;
      pv_one<0>(o[0], vb, pa0, pa1, pa2, pa3); pv_one<1>(o[1], vb, pa0, pa1, pa2, pa3); pv_one<2>(o[2], vb, pa0, pa1, pa2, pa3); pv_one<3>(o[3], vb, pa0, pa1, pa2, pa3);
      if (j + 1 < NT) {
        char* Vn = V_lds + (buf ^ 1) * ATT_TILE; char* Kn = K_lds + (buf ^ 1) * ATT_TILE;
        *(u32x4*)(Vn + vst0) = s0; *(u32x4*)(Vn + vst1) = s1; *(u32x4*)(Kn + kst0) = s0; *(u32x4*)(Kn + kst1) = s1;
      }
      __syncthreads();
    }
    if (hi == 0) li_l[r32] = l_reg;
    asm volatile("s_waitcnt lgkmcnt(0)" ::: "memory");
    int hio = hi, r32o = r32;
    asm volatile("" : "+v"(hio), "+v"(r32o));
    char* Ow = lds + wid * 8192;
#pragma unroll
    for (int r = 0; r < 16; ++r) {
      const int row = crow(r, hio); const float rl = 1.0f / li_l[row];
#pragma unroll
      for (int d = 0; d < 4; ++d) *(bf16_t*)(Ow + KSWZ(row, (d * 32 + r32o) * 2)) = f2bf(o[d][r] * rl);
    }
    asm volatile("s_waitcnt lgkmcnt(0)" ::: "memory");
    f32x16 oa[2];
#pragma unroll
    for (int i = 0; i < 2; ++i)
#pragma unroll
      for (int r = 0; r < 16; ++r) oa[i][r] = 0.f;
    const bf16_t* wuv = ws_wuvt(p) + (size_t)h * 64 * 128 + r32o * 128 + hio * 8;
#pragma unroll
    for (int ks = 0; ks < 8; ++ks) {
      const bf16x8 a = *(const bf16x8*)(Ow + KSWZ(r32o, (ks * 16 + hio * 8) * 2));
#pragma unroll
      for (int i = 0; i < 2; ++i) {
        const bf16x8 bw = *(const bf16x8*)(wuv + i * 32 * 128 + ks * 16);
        oa[i] = __builtin_amdgcn_mfma_f32_32x32x16_bf16(a, bw, oa[i], 0, 0, 0);
      }
    }
    bf16_t* mx = ws_mix(p) + (size_t)(b * SEQ + q0 + 4 * hio) * DM + RW + h * HD + r32o;
#pragma unroll
    for (int i = 0; i < 2; ++i)
#pragma unroll
      for (int r = 0; r < 16; ++r) mx[((r & 3) + 8 * (r >> 2)) * DM + i * 32] = f2bf(oa[i][r]);
  }
}

struct EpiOut { const float* x; const float* mod; float* o; int row0, col0; DI void operator()(int r, int c, float v0, float v1) const {
  const int row = row0 + r, col = col0 + c, b = row >> 11; const size_t idx = (size_t)row * DM + col;
  o[idx] = x[idx] + (1.0f + mod[b * 6144 + 2048 + col]) * v0; o[idx + 32] = x[idx + 32] + (1.0f + mod[b * 6144 + 2048 + col + 32]) * v1; } };
DI void phase6(const Params& p, int bid, int nb, char* lds) {
  constexpr int NT = DM / GBN;
  for (int tile = bid; tile < (NTOK / GBM) * NT; tile += nb) {
    const int mt = tile / NT, nt = tile % NT;
    gemm_tile(ws_mix(p), DM, ARowBase{mt * GBM}, ws_wtout(p), DM, nt * GBN, DM, EpiOut{p.x, ws_mod(p), p.out, mt * GBM, nt * GBN}, lds);
  }
}

namespace pg8 {
#define PG8_LAS __attribute__((address_space(3)))
constexpr int BM = 256, BK = 64, HALF = 128, HTB = HALF * BK * 2  , STAGE_BYTES = 8 * HTB, NXCD = 8, WGM = 8;

__host__ __device__ __forceinline__ int lds_byte(int r, int c) { const int st = (r >> 4) * 2 + (c >> 5), rr = r & 15, cc = c & 31, ob = rr * 64 + cc * 2; return st * 1024 + (ob ^ (((ob >> 9) & 1) << 5)); }
__host__ __device__ __forceinline__ void stage_rc(int b, int& R, int& C) { const int st = b / 1024, sb = b % 1024, swz = sb ^ (((sb >> 9) & 1) << 5); R = (st >> 1) * 16 + swz / 64; C = (st & 1) * 32 + (swz % 64) / 2; }
__host__ __device__ __forceinline__ int perm32(int rho) { const int n = rho >> 4, i = rho & 15; return 8 * (i >> 2) + 4 * n + (i & 3); }

struct Unit { int pm, pn, e; };
struct Gemm { const bf16_t* A; const bf16_t* Bt; int M, N, K; size_t bstride; };

struct StaticOrder {
    static constexpr bool GATHER = false;
    int nM, nN, nwg, G, c;
    __host__ __device__ void init(int M, int N, int G_, int c_) { nM = M / BM; nN = N / BM; nwg = nM * nN; G = G_; c = c_; }
    __host__ __device__ bool next(int i, Unit& u) const {
        const long L = (long)i * G + c; if (L >= nwg) return false;
        int wgid = (int)L; { const int q = nwg / NXCD, r = nwg % NXCD, xcd = wgid % NXCD, off = wgid / NXCD; wgid = (xcd < r ? xcd * (q + 1) : r * (q + 1) + (xcd - r) * q) + off; }
        const int nig = WGM * nN, gid = wgid / nig, fm = gid * WGM, gsz = (nM - fm) < WGM ? (nM - fm) : WGM;
        u.pm = fm + ((wgid % nig) % gsz); u.pn = (wgid % nig) / gsz; u.e = 0; return true;
    }
    __device__ __forceinline__ void a_ready(const Unit&) const {}
    __device__ __forceinline__ void done(const Unit&) const {}
    __device__ __forceinline__ int arow(const Unit&, int) const { return 0; }
};
template <class Epi, class Sched, bool ALIGN_EPI = false, bool SP2 = false>
__device__ __forceinline__ void gemm_phase(PG8_LAS unsigned char* lds, const Gemm g, const Sched& S, const Epi& E) {
    const int tid = threadIdx.x, wid = __builtin_amdgcn_readfirstlane(tid >> 6), lane = tid & 63, wr = wid >> 2, wc = wid & 3, fr = lane & 15, fq = lane >> 4;
    const int K = g.K, nt = K / BK;
    unsigned voffA[2], voffB[2];
#pragma unroll
    for (int i = 0; i < 2; ++i) { int R, C; stage_rc(tid * 16 + i * 8192, R, C); const int Rb = Epi::PERM ? ((R & ~31) + perm32(R & 31)) : R;
        voffA[i] = (unsigned)(R * K + C) * 2u; voffB[i] = (unsigned)(Rb * K + C) * 2u; }
    unsigned vAc[2][2], vAn[2][2];
    const size_t kstep = (size_t)(BK * 2);
    const size_t hstep = (size_t)HALF * K * 2;
    const size_t tstep = 2 * hstep;
    const unsigned ldsw = (unsigned)wid * 1024u;
    const int aoff = lds_byte(wr * 64 + fr, fq * 8), boff = lds_byte(wc * 32 + fr, fq * 8);
#define PG8_SA(b, h) (((b) * 2 + (h)) * HTB)
#define PG8_SB(b, h) ((4 + (b) * 2 + (h)) * HTB)
#define PG8_STAGE(bufoff, gbase, voff) do { _Pragma("unroll") for (int _i = 0; _i < 2; ++_i) \
        __builtin_amdgcn_global_load_lds((const unsigned*)((const char*)(gbase) + (voff)[_i]), (PG8_LAS unsigned*)(lds + (bufoff) + ldsw + _i * 8192), 16, 0, 0); } while (0)
#define PG8_STAGE_A(bufoff, gbase, v0_, v1_) do { \
        __builtin_amdgcn_global_load_lds((const unsigned*)((const char*)(gbase) + (v0_)), (PG8_LAS unsigned*)(lds + (bufoff) + ldsw), 16, 0, 0); \
        __builtin_amdgcn_global_load_lds((const unsigned*)((const char*)(gbase) + (v1_)), (PG8_LAS unsigned*)(lds + (bufoff) + ldsw + 8192), 16, 0, 0); } while (0)
#define PG8_AOFF(u_, dst_) do { if constexpr (Sched::GATHER) { _Pragma("unroll") for (int h_ = 0; h_ < 2; ++h_) _Pragma("unroll") for (int i_ = 0; i_ < 2; ++i_) { int R_, C_; stage_rc(tid * 16 + i_ * 8192, R_, C_); \
            dst_[h_][i_] = (unsigned)(S.arow(u_, h_ * HALF + R_) * K + C_) * 2u; } asm volatile("s_waitcnt vmcnt(0)" ::: "memory"); } \
        else { _Pragma("unroll") for (int h_ = 0; h_ < 2; ++h_) _Pragma("unroll") for (int i_ = 0; i_ < 2; ++i_) dst_[h_][i_] = voffA[i_] + (unsigned)(h_ * hstep); } } while (0)
#define PG8_LDA(dst, b, h) do { _Pragma("unroll") for (int m = 0; m < 4; ++m) _Pragma("unroll") for (int k = 0; k < 2; ++k) dst[m][k] = *(const PG8_LAS bf16x8*)(lds + PG8_SA(b, h) + aoff + m * 2048 + k * 1024); } while (0)
#define PG8_LDB(dst, b, h) do { _Pragma("unroll") for (int n = 0; n < 2; ++n) _Pragma("unroll") for (int k = 0; k < 2; ++k) dst[n][k] = *(const PG8_LAS bf16x8*)(lds + PG8_SB(b, h) + boff + n * 2048 + k * 1024); } while (0)
#define PG8_MMA(ai, bj, At, Bt) do { __builtin_amdgcn_s_setprio(1); _Pragma("unroll") for (int m = 0; m < 4; ++m) _Pragma("unroll") for (int n = 0; n < 2; ++n) _Pragma("unroll") for (int k = 0; k < 2; ++k) \
        acc[ai][bj][m][n] = __builtin_amdgcn_mfma_f32_16x16x32_bf16(Bt[n][k], At[m][k], acc[ai][bj][m][n], 0, 0, 0); __builtin_amdgcn_s_setprio(0); } while (0)
#define PG8_WAIT_V(n) asm volatile("s_waitcnt vmcnt(" #n ")" ::: "memory")
#define PG8_WAIT_L(n) asm volatile("s_waitcnt lgkmcnt(" #n ")" ::: "memory")
#define PG8_BAR __builtin_amdgcn_s_barrier()
#define PG8_SCHED __builtin_amdgcn_sched_barrier(0)
    Unit cur, nxt; int ui = 0;
    if (!S.next(0, cur)) return;
    f32x4 acc[2][2][4][2];
#pragma unroll
    for (int a = 0; a < 2; ++a)
#pragma unroll
        for (int b = 0; b < 2; ++b)
#pragma unroll
            for (int m = 0; m < 4; ++m)
#pragma unroll
                for (int n = 0; n < 2; ++n) acc[a][b][m][n] = (f32x4){0.f, 0.f, 0.f, 0.f};
    bf16x8 At[4][2], B0[2][2], B1[2][2];
    const char* cA = Sched::GATHER ? (const char*)g.A : (const char*)g.A + (size_t)cur.pm * tstep; PG8_AOFF(cur, vAc); const char* cB = (const char*)g.Bt + (size_t)cur.e * g.bstride + (size_t)cur.pn * tstep;
    S.a_ready(cur);
    if constexpr (SP2) {
        PG8_STAGE(PG8_SB(0, 0), cB, voffB); PG8_STAGE(PG8_SB(0, 1), cB + hstep, voffB); PG8_STAGE_A(PG8_SA(0, 0), cA, vAc[0][0], vAc[0][1]); PG8_STAGE_A(PG8_SA(0, 1), cA, vAc[1][0], vAc[1][1]);
        if (wr == 1) PG8_BAR;
        PG8_WAIT_V(2); PG8_BAR;
        PG8_STAGE(PG8_SB(1, 0), cB + kstep, voffB); PG8_STAGE_A(PG8_SA(1, 0), cA + kstep, vAc[0][0], vAc[0][1]); PG8_STAGE(PG8_SB(1, 1), cB + hstep + kstep, voffB);
        PG8_WAIT_V(6); PG8_BAR;
    } else {
        PG8_STAGE(PG8_SB(0, 0), cB, voffB); PG8_STAGE(PG8_SA(0, 0), cA, voffA); PG8_STAGE(PG8_SB(0, 1), cB + hstep, voffB); PG8_STAGE(PG8_SA(0, 1), cA + hstep, voffA);
        if (wr == 1) PG8_BAR;
        PG8_WAIT_V(4); PG8_BAR;
        PG8_STAGE(PG8_SB(1, 0), cB + kstep, voffB); PG8_STAGE(PG8_SA(1, 0), cA + kstep, voffA); PG8_STAGE(PG8_SB(1, 1), cB + hstep + kstep, voffB);
        PG8_WAIT_V(6); PG8_BAR;
    }
    for (;;) {
        const bool has_next = S.next(ui + 1, nxt);
        const char* nA = (has_next && !Sched::GATHER) ? (const char*)g.A + (size_t)nxt.pm * tstep : cA;
        if (has_next) PG8_AOFF(nxt, vAn); else { _Pragma("unroll") for (int h_ = 0; h_ < 2; ++h_) _Pragma("unroll") for (int i_ = 0; i_ < 2; ++i_) vAn[h_][i_] = vAc[h_][i_]; }
        const char* nB = has_next ? (const char*)g.Bt + (size_t)nxt.e * g.bstride + (size_t)nxt.pn * tstep : cB;
        for (int t = 0; t < nt; t += 2) {
            const bool last = (t == nt - 2);
            const char* a1 = cA + (size_t)(t + 1) * kstep;
            const char* a2 = last ? nA : cA + (size_t)(t + 2) * kstep; const char* b2 = last ? nB : cB + (size_t)(t + 2) * kstep;
            const char* a3 = a2 + kstep; const char* b3 = b2 + kstep;
            if (last && has_next) S.a_ready(nxt);
            if constexpr (SP2) {
            PG8_LDB(B0, 0, 0); PG8_LDB(B1, 0, 1); PG8_SCHED; PG8_LDA(At, 0, 0); PG8_STAGE_A(PG8_SA(1, 1), a1, vAc[1][0], vAc[1][1]);
            PG8_WAIT_V(8); PG8_WAIT_L(0); PG8_BAR; PG8_MMA(0, 0, At, B0); PG8_MMA(0, 1, At, B1); PG8_BAR; PG8_SCHED;
            PG8_LDA(At, 0, 1); PG8_STAGE(PG8_SB(0, 0), b2, voffB); PG8_STAGE(PG8_SB(0, 1), b2 + hstep, voffB); PG8_STAGE_A(PG8_SA(0, 0), a2, last ? vAn[0][0] : vAc[0][0], last ? vAn[0][1] : vAc[0][1]);
            PG8_WAIT_V(8); PG8_WAIT_L(0); PG8_BAR; PG8_MMA(1, 0, At, B0); PG8_MMA(1, 1, At, B1); PG8_BAR; PG8_SCHED;
            PG8_LDB(B0, 1, 0); PG8_LDB(B1, 1, 1); PG8_SCHED; PG8_LDA(At, 1, 0); PG8_STAGE_A(PG8_SA(0, 1), a2, last ? vAn[1][0] : vAc[1][0], last ? vAn[1][1] : vAc[1][1]);
            PG8_WAIT_V(8); PG8_WAIT_L(0); PG8_BAR; PG8_MMA(0, 0, At, B0); PG8_MMA(0, 1, At, B1); PG8_BAR; PG8_SCHED;
            PG8_LDA(At, 1, 1); PG8_STAGE(PG8_SB(1, 0), b3, voffB); PG8_STAGE(PG8_SB(1, 1), b3 + hstep, voffB); PG8_STAGE_A(PG8_SA(1, 0), a3, last ? vAn[0][0] : vAc[0][0], last ? vAn[0][1] : vAc[0][1]);
            PG8_WAIT_V(8); PG8_WAIT_L(0); PG8_BAR; PG8_MMA(1, 0, At, B0); PG8_MMA(1, 1, At, B1); PG8_BAR; PG8_SCHED;
            } else {
            PG8_LDB(B0, 0, 0); PG8_SCHED; PG8_LDA(At, 0, 0); PG8_STAGE(PG8_SA(1, 1), a1 + hstep, voffA);
            PG8_WAIT_L(8); PG8_BAR; PG8_WAIT_L(0); PG8_MMA(0, 0, At, B0); PG8_BAR; PG8_SCHED;
            PG8_LDB(B1, 0, 1); PG8_STAGE(PG8_SB(0, 0), b2, voffB);
            PG8_BAR; PG8_WAIT_L(0); PG8_MMA(0, 1, At, B1); PG8_BAR;
            PG8_LDA(At, 0, 1); PG8_STAGE(PG8_SA(0, 0), a2, voffA);
            PG8_BAR; PG8_WAIT_L(0); PG8_MMA(1, 0, At, B0); PG8_BAR; PG8_SCHED;
            PG8_STAGE(PG8_SB(0, 1), b2 + hstep, voffB);
            PG8_WAIT_V(6); PG8_BAR; PG8_MMA(1, 1, At, B1); PG8_BAR;
            PG8_LDB(B0, 1, 0); PG8_SCHED; PG8_LDA(At, 1, 0); PG8_STAGE(PG8_SA(0, 1), a2 + hstep, voffA);
            PG8_WAIT_L(8); PG8_BAR; PG8_WAIT_L(0); PG8_MMA(0, 0, At, B0); PG8_BAR; PG8_SCHED;
            PG8_LDB(B1, 1, 1); PG8_STAGE(PG8_SB(1, 0), b3, voffB);
            PG8_BAR; PG8_WAIT_L(0); PG8_MMA(0, 1, At, B1); PG8_BAR;
            PG8_LDA(At, 1, 1); PG8_STAGE(PG8_SA(1, 0), a3, voffA);
            PG8_BAR; PG8_WAIT_L(0); PG8_MMA(1, 0, At, B0); PG8_BAR; PG8_SCHED;
            PG8_STAGE(PG8_SB(1, 1), b3 + hstep, voffB);
            PG8_WAIT_V(6); PG8_BAR; PG8_MMA(1, 1, At, B1); PG8_BAR;
            }
        }
        if constexpr (ALIGN_EPI) { if (wr == 0) PG8_BAR; }
        if constexpr (!Epi::AFTER_DRAIN) { E(acc, cur, wr, wc, fr, fq); S.done(cur); }
        if (!has_next) break;
#pragma unroll
        for (int a = 0; a < 2; ++a)
#pragma unroll
            for (int b = 0; b < 2; ++b)
#pragma unroll
                for (int m = 0; m < 4; ++m)
#pragma unroll
                    for (int n = 0; n < 2; ++n) acc[a][b][m][n] = (f32x4){0.f, 0.f, 0.f, 0.f};
        cur = nxt; cA = nA; cB = nB; ++ui;
#pragma unroll
        for (int h_ = 0; h_ < 2; ++h_)
#pragma unroll
            for (int i_ = 0; i_ < 2; ++i_) vAc[h_][i_] = vAn[h_][i_];
        if constexpr (ALIGN_EPI) { if (wr == 1) PG8_BAR; }
    }
    PG8_WAIT_V(0);
    if constexpr (!ALIGN_EPI) { if (wr == 0) PG8_BAR; }
    PG8_BAR;
    if constexpr (Epi::AFTER_DRAIN) { E.fused(acc, cur, wr, wc, fr, fq, lds, wid, lane); S.done(cur); }
#undef PG8_SA
#undef PG8_SB
#undef PG8_STAGE
#undef PG8_STAGE_A
#undef PG8_AOFF
#undef PG8_LDA
#undef PG8_LDB
#undef PG8_MMA
#undef PG8_WAIT_V
#undef PG8_WAIT_L
#undef PG8_BAR
#undef PG8_SCHED
}
}


constexpr int TAB_OFF = 131072;
DI void build_tables(const Params& p, char* lds) {
  int* T = (int*)(lds + TAB_OFF); unsigned char* te = (unsigned char*)(T + 80);
  __syncthreads();
  if (tid_() == 0) {
    int acc = 0;
    for (int e = 0; e < NEXP; ++e) { const int c = ws_cnt(p)[e]; T[e] = c; T[32 + e] = acc; const int nt = (c + 255) >> 8; for (int k = 0; k < nt; ++k) te[acc + k] = (unsigned char)e; acc += nt; }
    T[64] = acc;
  }
  __syncthreads();
}
template <bool GATHER_> struct GroupOrderT { static constexpr bool GATHER = GATHER_; const int* T; const unsigned char* te; int G, c; const int* list;
  DI bool next(int i, pg8::Unit& u) const { const int L = i * G + c; if (L >= T[64] * 4) return false; u.pm = L >> 2; u.pn = L & 3; u.e = te[u.pm]; return true; }
  DI void a_ready(const pg8::Unit&) const {}
  DI void done(const pg8::Unit&) const {}
  DI int arow(const pg8::Unit& u, int r) const {
    const int slot = (u.pm - T[32 + u.e]) * 256 + r; return slot < T[u.e] ? (list[u.e * LCAP + slot] >> 1) : 0; } };
typedef GroupOrderT<false> GroupOrder;

struct EpiProjP { static constexpr bool PERM = true, AFTER_DRAIN = false; bf16_t* O; int ldc;
  DI void operator()(const f32x4 (&acc)[2][2][4][2], const pg8::Unit& u, int wr, int wc, int fr, int fq) const {
    const int row0 = u.pm * 256 + wr * 64 + fr, col0 = u.pn * 256 + wc * 32 + 8 * fq;
#pragma unroll
    for (int ai = 0; ai < 2; ++ai)
#pragma unroll
      for (int m = 0; m < 4; ++m) { bf16_t* rowp = O + (size_t)(row0 + ai * 128 + m * 16) * ldc + col0;
#pragma unroll
        for (int bj = 0; bj < 2; ++bj) { const f32x4 v0 = acc[ai][bj][m][0] + 0.0f, v1 = acc[ai][bj][m][1] + 0.0f;
          u32x4 w; w.x = cvtpk(v0[0], v0[1]); w.y = cvtpk(v0[2], v0[3]); w.z = cvtpk(v1[0], v1[1]); w.w = cvtpk(v1[2], v1[3]);
          *(u32x4*)(rowp + bj * 128) = w; } }
  } };
DI void phase2_pg8(const Params& p, int bid, int nb, char* lds) {
  pg8::Gemm g{ws_h1(p), ws_wtin(p), NTOK, PROJ_LD, DM, 0};
  pg8::StaticOrder S; S.init(NTOK, PROJ_LD, nb, bid);
  EpiProjP E{ws_proj(p), PROJ_LD};
  __syncthreads();
  pg8::gemm_phase<EpiProjP, pg8::StaticOrder, true, true>((PG8_LAS unsigned char*)lds, g, S, E);
  __syncthreads();
}
struct EpiResidP { static constexpr bool PERM = false, AFTER_DRAIN = false; const float* x; const float* mod; float* o;
  DI void operator()(const f32x4 (&acc)[2][2][4][2], const pg8::Unit& u, int wr, int wc, int fr, int fq) const {
    const int row0 = u.pm * 256 + wr * 64 + fr, col0 = u.pn * 256 + wc * 32 + 4 * fq;
#pragma unroll
    for (int ai = 0; ai < 2; ++ai)
#pragma unroll
      for (int m = 0; m < 4; ++m) { const int row = row0 + ai * 128 + m * 16, b = row >> 11;
#pragma unroll
        for (int bj = 0; bj < 2; ++bj)
#pragma unroll
          for (int n = 0; n < 2; ++n) { const int col = col0 + bj * 128 + n * 16; const size_t idx = (size_t)row * DM + col;
            const f32x4 xv = *(const f32x4*)(x + idx), gv = *(const f32x4*)(mod + b * 6144 + 2048 + col);
            *(f32x4*)(o + idx) = xv + (gv + 1.0f) * acc[ai][bj][m][n]; } }
  } };
DI void phase6_pg8(const Params& p, int bid, int nb, char* lds) {
  pg8::Gemm g{ws_mix(p), ws_wtout(p), NTOK, DM, DM, 0};
  pg8::StaticOrder S; S.init(NTOK, DM, nb, bid);
  EpiResidP E{p.x, ws_mod(p), ws_x1(p)};
  __syncthreads();
  pg8::gemm_phase<EpiResidP, pg8::StaticOrder, true, true>((PG8_LAS unsigned char*)lds, g, S, E);
  __syncthreads();
}
DI bf16_t* ws_h2s(const Params& p) { return (bf16_t*)(p.ws + OFF_C); }
DI bf16_t* ws_hidp(const Params& p) { return (bf16_t*)(p.ws + OFF_F); }
DI void phase7c(const Params& p, int bid, int nb, char* lds) {
  build_tables(p, lds);
  const int* T = (const int*)(lds + TAB_OFF);
  const int lane = tid_() & 63, gw = bid * 8 + (tid_() >> 6), nw = nb * 8;
  for (int e = 0; e < NEXP; ++e) {
    const int c = T[e]; const size_t r0 = (size_t)T[32 + e] * 256;
    for (int r = gw; r < c; r += nw) {
      const int tok = ws_list(p)[e * LCAP + r] >> 1;
      const u32x4* src = (const u32x4*)(ws_h2(p) + (size_t)tok * DM); u32x4* dst = (u32x4*)(ws_h2s(p) + (r0 + r) * DM);
      dst[lane] = src[lane]; dst[lane + 64] = src[lane + 64];
    }
  }
}
struct EpiSwiGLU { static constexpr bool PERM = true, AFTER_DRAIN = false; bf16_t* O;
  DI void operator()(const f32x4 (&acc)[2][2][4][2], const pg8::Unit& u, int wr, int wc, int fr, int fq) const {
    const int row0 = u.pm * 256 + wr * 64 + fr, col0 = u.pn * 128 + wc * 32 + 8 * fq;
#pragma unroll
    for (int ai = 0; ai < 2; ++ai)
#pragma unroll
      for (int m = 0; m < 4; ++m) {
        float hv[8];
#pragma unroll
        for (int n = 0; n < 2; ++n)
#pragma unroll
          for (int i = 0; i < 4; ++i) { const float gt = acc[ai][0][m][n][i], up = acc[ai][1][m][n][i]; hv[n * 4 + i] = gt / (1.0f + __expf(-gt)) * up; }
        u32x4 w; w.x = cvtpk(hv[0], hv[1]); w.y = cvtpk(hv[2], hv[3]); w.z = cvtpk(hv[4], hv[5]); w.w = cvtpk(hv[6], hv[7]);
        *(u32x4*)(O + (size_t)(row0 + ai * 128 + m * 16) * DEXP + col0) = w; }
  } };
DI void phase8_pg8(const Params& p, int bid, int nb, char* lds) {
  build_tables(p, lds);
  pg8::Gemm g{ws_h2(p), ws_wgu(p), 0, 1024, DM, (size_t)1024 * 1024 * 2};
  GroupOrderT<true> S{(const int*)(lds + TAB_OFF), (const unsigned char*)((const int*)(lds + TAB_OFF) + 80), nb, bid, ws_list(p)};
  EpiSwiGLU E{ws_hidp(p)};
  pg8::gemm_phase<EpiSwiGLU, GroupOrderT<true>, true, true>((PG8_LAS unsigned char*)lds, g, S, E);
  __syncthreads();
}
struct EpiYP { static constexpr bool PERM = true, AFTER_DRAIN = false; bf16_t* O; const int* list; const float* wa; const int* T;
  DI void operator()(const f32x4 (&acc)[2][2][4][2], const pg8::Unit& u, int wr, int wc, int fr, int fq) const {
    const int cnt = T[u.e], rbase = (u.pm - T[32 + u.e]) * 256 + wr * 64 + fr, col0 = u.pn * 256 + wc * 32 + 8 * fq;
#pragma unroll
    for (int ai = 0; ai < 2; ++ai)
#pragma unroll
      for (int m = 0; m < 4; ++m) { const int r = rbase + ai * 128 + m * 16;
        if (r < cnt) { const int aid = list[u.e * LCAP + r]; const float wv = wa[aid]; bf16_t* rowp = O + (size_t)aid * DM + col0;
#pragma unroll
          for (int bj = 0; bj < 2; ++bj) { const f32x4 v0 = acc[ai][bj][m][0] * wv, v1 = acc[ai][bj][m][1] * wv;
            u32x4 w; w.x = cvtpk(v0[0], v0[1]); w.y = cvtpk(v0[2], v0[3]); w.z = cvtpk(v1[0], v1[1]); w.w = cvtpk(v1[2], v1[3]);
            *(u32x4*)(rowp + bj * 128) = w; } } }
  } };
DI void phase9_pg8(const Params& p, int bid, int nb, char* lds) {
  build_tables(p, lds);
  pg8::Gemm g{ws_hidp(p), ws_wd(p), 0, 1024, DEXP, (size_t)1024 * 512 * 2};
  GroupOrder S{(const int*)(lds + TAB_OFF), (const unsigned char*)((const int*)(lds + TAB_OFF) + 80), nb, bid, nullptr};
  EpiYP E{ws_ybuf(p), ws_list(p), ws_wa(p), (const int*)(lds + TAB_OFF)};
  pg8::gemm_phase<EpiYP, GroupOrder, true, true>((PG8_LAS unsigned char*)lds, g, S, E);
  __syncthreads();
}

typedef float f32x4m __attribute__((ext_vector_type(4)));
constexpr int H_LD = 1028;
DI void phase7(const Params& p, int bid, int nb, char* lds) {
  const int t = tid_(), lane = t & 63, wid = t >> 6, l16 = lane & 15, lg4 = lane >> 4;
  float* H = (float*)lds;
  float* part = H + 16 * H_LD;
  float* lgt = part + 8 * 16 * 48;
  int* ecnt = (int*)(lgt + 16 * 48);
  int* ebase = ecnt + 32;
  int* sl_aid = ebase + 32;
  int* sl_e = sl_aid + 512;
  const float* mod = ws_mod(p);
  if (t < NEXP) ecnt[t] = 0;
  int nloc = 0;
  for (int tile = bid; tile < NTOK / 16; tile += nb) {
    __syncthreads();
#pragma unroll
    for (int q = 0; q < 2; ++q) {
      const int tl = wid * 2 + q, gt = tile * 16 + tl, b = gt >> 11;
      const float* xr = ws_x1(p) + (size_t)gt * DM;
      f32x4 v[4]; float ss = 0.f;
#pragma unroll
      for (int i = 0; i < 4; ++i) { v[i] = *(const f32x4*)(xr + lane * 4 + 256 * i); ss += v[i][0] * v[i][0] + v[i][1] * v[i][1] + v[i][2] * v[i][2] + v[i][3] * v[i][3]; }
      ss = wave_sum(ss);
      const float rstd = rsqrtf(ss * (1.0f / DM) + 1e-6f);
#pragma unroll
      for (int i = 0; i < 4; ++i) {
        const int col = lane * 4 + 256 * i;
        const f32x4 g = *(const f32x4*)(p.norm2_g + col), sh = *(const f32x4*)(mod + b * 6144 + 3072 + col), sc = *(const f32x4*)(mod + b * 6144 + 4096 + col);
        f32x4 o;
#pragma unroll
        for (int j = 0; j < 4; ++j) o[j] = v[i][j] * rstd * g[j] * (1.0f + sc[j]) + sh[j];
        *(f32x4*)(H + tl * H_LD + col) = o;
        u32x2 w; w.x = cvtpk(o[0], o[1]); w.y = cvtpk(o[2], o[3]);
        *(u32x2*)(ws_h2(p) + (size_t)gt * DM + col) = w;
      }
    }
    __syncthreads();
    {
      f32x4m acc0 = {0.f, 0.f, 0.f, 0.f}, acc1 = acc0, acc2 = acc0;
      const float* hrow = H + l16 * H_LD + wid * 128 + lg4;
      const float* we = p.w_expert + (size_t)(wid * 128 + lg4) * 32 + l16;
      const float* wg = p.w_group + (size_t)(wid * 128 + lg4) * 4 + (l16 & 3);
#pragma unroll 8
      for (int s4 = 0; s4 < 32; ++s4) {
        const float a = hrow[s4 * 4];
        const float b0 = we[s4 * 128], b1 = we[s4 * 128 + 16];
        const float b2r = wg[s4 * 16];
        const float b2 = (l16 < 4) ? b2r : 0.f;
        acc0 = __builtin_amdgcn_mfma_f32_16x16x4f32(a, b0, acc0, 0, 0, 0);
        acc1 = __builtin_amdgcn_mfma_f32_16x16x4f32(a, b1, acc1, 0, 0, 0);
        acc2 = __builtin_amdgcn_mfma_f32_16x16x4f32(a, b2, acc2, 0, 0, 0);
      }
#pragma unroll
      for (int r = 0; r < 4; ++r) {
        float* pr = part + (wid * 16 + lg4 * 4 + r) * 48;
        pr[l16] = acc0[r]; pr[16 + l16] = acc1[r]; pr[32 + l16] = acc2[r];
      }
    }
    __syncthreads();
    for (int idx = t; idx < 16 * 36; idx += NTHR) {
      const int tok = idx / 36, o = idx % 36;
      float sacc = 0.f;
#pragma unroll
      for (int w = 0; w < 8; ++w) sacc += part[(w * 16 + tok) * 48 + o];
      sacc += (o < 32) ? p.b_expert[o] : p.b_group[o - 32];
      lgt[tok * 48 + o] = sacc;
    }
    __syncthreads();
    if (t < 16) {
      const float* l = lgt + t * 48;
      int gs = 0; float gm = l[32];
      for (int g = 1; g < 4; ++g) if (l[32 + g] > gm) { gm = l[32 + g]; gs = g; }
      float gsum = 0.f;
      for (int g = 0; g < 4; ++g) gsum += expf(l[32 + g] - gm);
      const float pgroup = 1.0f / gsum;
      const float* el = l + gs * 8;
      float em = el[0];
      for (int e = 1; e < 8; ++e) em = fmaxf(em, el[e]);
      float pe[8], esum = 0.f;
      for (int e = 0; e < 8; ++e) { pe[e] = expf(el[e] - em); esum += pe[e]; }
      for (int e = 0; e < 8; ++e) pe[e] /= esum;
      int i0 = 0;
      for (int e = 1; e < 8; ++e) if (pe[e] > pe[i0]) i0 = e;
      int i1 = (i0 == 0) ? 1 : 0;
      for (int e = 0; e < 8; ++e) if (e != i0 && pe[e] > pe[i1]) i1 = e;
      const float den = pe[i0] + pe[i1];
      const int tok = tile * 16 + t;
      const int e0 = gs * 8 + i0, e1 = gs * 8 + i1;
      ws_wa(p)[tok * 2] = pgroup * pe[i0] / den; ws_wa(p)[tok * 2 + 1] = pgroup * pe[i1] / den;
      const int slot = nloc * 32 + t * 2;
      sl_aid[slot] = tok * 2; sl_aid[slot + 1] = tok * 2 + 1;
      sl_e[slot] = e0 | (atomicAdd(ecnt + e0, 1) << 8); sl_e[slot + 1] = e1 | (atomicAdd(ecnt + e1, 1) << 8);
    }
    ++nloc;
  }
  __syncthreads();
  if (t < NEXP) ebase[t] = ecnt[t] ? atomicAdd(ws_cnt(p) + t, ecnt[t]) : 0;
  __syncthreads();
  for (int sidx = t; sidx < nloc * 32; sidx += NTHR) { const int ev = sl_e[sidx], e = ev & 255, r = ev >> 8; ws_list(p)[e * LCAP + ebase[e] + r] = sl_aid[sidx]; }
}
DI void phase7_tr(const Params& p, int bid, int nb, char* lds) {
  const int t = tid_();
  {
    float* tile = (float*)lds;
    const int ln4 = (t & 31) * 4, lkr = t >> 5, snr = t >> 2, skc = (t & 3) * 16;
#define MOE_TSRC(task_, src_, k0_, n0_, N_) const float* src_; int k0_, n0_, N_; { const int wh_ = (task_) >> 11, q_ = (task_) & 2047, e_ = q_ >> 6, r_ = q_ & 63; \
      if (wh_ < 2) { k0_ = (r_ >> 2) * 64; n0_ = (r_ & 3) * 128; N_ = 512; src_ = (wh_ == 0 ? p.e_gate : p.e_up) + (size_t)e_ * 1024 * 512; } \
      else { k0_ = (r_ >> 3) * 64; n0_ = (r_ & 7) * 128; N_ = 1024; src_ = p.e_down + (size_t)e_ * 512 * 1024; } }
    f32x4 g[4];
    int task = bid;
    if (task < 6144) { MOE_TSRC(task, src, k0, n0, N);
#pragma unroll
      for (int i = 0; i < 4; ++i) g[i] = *(const f32x4*)(src + (size_t)(k0 + lkr + 16 * i) * N + n0 + ln4); }
    for (; task < 6144; task += nb) {
      __syncthreads();
#pragma unroll
      for (int i = 0; i < 4; ++i) { float* d = tile + (lkr + 16 * i) * 129 + ln4; d[0] = g[i][0]; d[1] = g[i][1]; d[2] = g[i][2]; d[3] = g[i][3]; }
      if (task + nb < 6144) { MOE_TSRC(task + nb, src, k0, n0, N);
#pragma unroll
        for (int i = 0; i < 4; ++i) g[i] = *(const f32x4*)(src + (size_t)(k0 + lkr + 16 * i) * N + n0 + ln4); }
      __syncthreads();
      const int which = task >> 11, q = task & 2047, e = q >> 6, r = q & 63;
      float v[16];
#pragma unroll
      for (int j = 0; j < 16; ++j) v[j] = tile[(skc + j) * 129 + snr];
      u32x4 w0, w1;
      w0.x = cvtpk(v[0], v[1]); w0.y = cvtpk(v[2], v[3]); w0.z = cvtpk(v[4], v[5]); w0.w = cvtpk(v[6], v[7]);
      w1.x = cvtpk(v[8], v[9]); w1.y = cvtpk(v[10], v[11]); w1.z = cvtpk(v[12], v[13]); w1.w = cvtpk(v[14], v[15]);
      bf16_t* dst;
      if (which < 2) { const int k0 = (r >> 2) * 64, n = (r & 3) * 128 + snr; dst = ws_wgu(p) + (size_t)e * 1024 * 1024 + (size_t)((n >> 7) * 256 + (n & 127) + which * 128) * 1024 + k0 + skc; }
      else { const int k0 = (r >> 3) * 64, n = (r & 7) * 128 + snr; dst = ws_wd(p) + (size_t)e * 1024 * 512 + (size_t)n * 512 + k0 + skc; }
      *(u32x4*)dst = w0; *(u32x4*)(dst + 8) = w1;
    }
  }
}

struct Seg { int e, r0, cnt, start; };
DI Seg find_seg(const int* cnt, int mtile) {
  Seg s; s.e = -1; int acc = 0, start = 0;
  for (int e = 0; e < NEXP; ++e) { const int c = cnt[e], nt = (c + GBM - 1) / GBM; if (mtile < acc + nt) { s.e = e; s.r0 = (mtile - acc) * GBM; s.cnt = c; s.start = start; return s; } acc += nt; start += c; }
  return s;
}
struct ARowList { const int* list; int r0, cnt; DI int operator()(int r) const { int q = r0 + r; q = q < cnt ? q : cnt - 1; return list[q] >> 1; } };
struct EpiHid { bf16_t* o; int row0, nvalid, col0; DI void operator()(int r, int c, float g, float u) const {
  if (r < nvalid) o[(size_t)(row0 + r) * DEXP + ((col0 + c) >> 6) * 32 + (c & 31)] = f2bf(g / (1.0f + __expf(-g)) * u); } };
DI void phase8(const Params& p, int bid, int nb, char* lds) {
  const int* cnt = ws_cnt(p);
  for (int tile = bid; tile < 288 * 8; tile += nb) {
    const Seg s = find_seg(cnt, tile >> 3);
    if (s.e < 0) break;
    const int nt = tile & 7;
    gemm_tile(ws_h2(p), DM, ARowList{ws_list(p) + s.e * LCAP, s.r0, s.cnt}, ws_wgu(p) + (size_t)s.e * 1024 * 1024, DM, nt * GBN, DM,
              EpiHid{ws_hid(p), s.start + s.r0, s.cnt - s.r0, nt * GBN}, lds);
  }
}
struct ARowClamp { int base, r0, cnt; DI int operator()(int r) const { int q = r0 + r; q = q < cnt ? q : cnt - 1; return base + q; } };
struct EpiY { bf16_t* o; const int* list; const float* wa; int r0, cnt, col0; DI void operator()(int r, int c, float v0, float v1) const {
  if (r0 + r < cnt) { const int aid = list[r0 + r]; const float w = wa[aid]; bf16_t* q = o + (size_t)aid * DM + col0 + c; q[0] = f2bf(v0 * w); q[32] = f2bf(v1 * w); } } };
DI void phase9(const Params& p, int bid, int nb, char* lds) {
  const int* cnt = ws_cnt(p);
  for (int tile = bid; tile < 288 * 8; tile += nb) {
    const Seg s = find_seg(cnt, tile >> 3);
    if (s.e < 0) break;
    const int nt = tile & 7;
    gemm_tile(ws_hid(p), DEXP, ARowClamp{s.start, s.r0, s.cnt}, ws_wd(p) + (size_t)s.e * 1024 * 512, DEXP, nt * GBN, DEXP,
              EpiY{ws_ybuf(p), ws_list(p) + s.e * LCAP, ws_wa(p), s.r0, s.cnt, nt * GBN}, lds);
  }
}

DI void phase10(const Params& p, int bid, int nb, char* lds) {
  const int lane = tid_() & 63, wid = tid_() >> 6;
  const float* mod = ws_mod(p); const float* fm = ws_fmod(p);
  for (int gt = bid * 8 + wid; gt < NTOK; gt += nb * 8) {
    const int b = gt >> 11;
    const float* xr = ws_x1(p) + (size_t)gt * DM; float* xo = p.out + (size_t)gt * DM;
    const bf16_t* ya = ws_ybuf(p) + (size_t)(gt * 2) * DM; const bf16_t* yb = ya + DM;
    f32x4 v[4]; float ss = 0.f;
#pragma unroll
    for (int i = 0; i < 4; ++i) {
      const int col = lane * 4 + 256 * i;
      v[i] = *(const f32x4*)(xr + col);
      const u32x2 a = *(const u32x2*)(ya + col), bq = *(const u32x2*)(yb + col);
      const f32x4 g2 = *(const f32x4*)(mod + b * 6144 + 5120 + col);
      const float m0 = __uint_as_float(a.x << 16) + __uint_as_float(bq.x << 16), m1 = __uint_as_float(a.x & 0xffff0000u) + __uint_as_float(bq.x & 0xffff0000u);
      const float m2 = __uint_as_float(a.y << 16) + __uint_as_float(bq.y << 16), m3 = __uint_as_float(a.y & 0xffff0000u) + __uint_as_float(bq.y & 0xffff0000u);
      v[i][0] += (1.0f + g2[0]) * m0; v[i][1] += (1.0f + g2[1]) * m1; v[i][2] += (1.0f + g2[2]) * m2; v[i][3] += (1.0f + g2[3]) * m3;
      ss += v[i][0] * v[i][0] + v[i][1] * v[i][1] + v[i][2] * v[i][2] + v[i][3] * v[i][3];
    }
    ss = wave_sum(ss);
    const float rstd = rsqrtf(ss * (1.0f / DM) + 1e-6f);
#pragma unroll
    for (int i = 0; i < 4; ++i) {
      const int col = lane * 4 + 256 * i;
      const f32x4 g = *(const f32x4*)(p.final_norm_g + col), sh = *(const f32x4*)(fm + b * 2048 + col), sc = *(const f32x4*)(fm + b * 2048 + 1024 + col);
      f32x4 o;
#pragma unroll
      for (int j = 0; j < 4; ++j) o[j] = v[i][j] * rstd * g[j] * (1.0f + sc[j]) + sh[j];
      *(f32x4*)(xo + col) = o;
    }
  }
}

#define XB_TMO      128
#define XB_XCNT(j)  (256  + 64 * (j))
#define XB_XSUB(j)  (1280 + 64 * (j))
#define XB_XGEN(j)  (2304 + 64 * (j))
#define XB_TOP      3328
#define XB_TOPGEN   3392
#define XCD_BAR_WORDS 3456
#define XB_SPIN_CAP (1u << 18)
#define XLAS __attribute__((address_space(3)))

__device__ __forceinline__ unsigned xb_ld(unsigned* p)              { return __hip_atomic_load(p, __ATOMIC_RELAXED, __HIP_MEMORY_SCOPE_AGENT); }
__device__ __forceinline__ unsigned xb_add(unsigned* p, unsigned v) { return __hip_atomic_fetch_add(p, v, __ATOMIC_RELAXED, __HIP_MEMORY_SCOPE_AGENT); }
__device__ __forceinline__ unsigned xb_xcc_id() { return (unsigned)__builtin_amdgcn_s_getreg((3 << 11) | 20) & 0xFu; }
#define XB_SPIN(cond, bar) do { unsigned _sp = 0; while (cond) { __builtin_amdgcn_s_sleep(1); \
    if ((++_sp & 255u) == 0u) { if (xb_ld(&(bar)[XB_TMO])) break; if (_sp > XB_SPIN_CAP) { atomicAdd(&(bar)[XB_TMO], 1u); break; } } } } while (0)

struct XcdBarrier {
    unsigned* bar; unsigned x;
    volatile XLAS unsigned* st;
};

__device__ __forceinline__ XcdBarrier xcd_barrier_post(unsigned* bar, volatile XLAS unsigned* st) {
    XcdBarrier b; b.bar = bar; b.x = xb_xcc_id(); b.st = st;
    if (threadIdx.x == 0) (void)xb_add(&bar[XB_XCNT(b.x)], 1u);
    return b;
}
__device__ __forceinline__ void xcd_barrier_complete(unsigned* bar, unsigned x, unsigned& nloc, unsigned& nx) {
    const unsigned G = gridDim.x * gridDim.y * gridDim.z;
    unsigned sum, cnt, mine, sp = 0u;
    for (;;) {
        sum = 0u; cnt = 0u; mine = 0u;
#pragma unroll
        for (unsigned j = 0; j < 16; ++j) { const unsigned c = xb_ld(&bar[XB_XCNT(j)]); sum += c; cnt += (c > 0u) ? 1u : 0u; mine = (j == x) ? c : mine; }
        if (sum == G) break;
        __builtin_amdgcn_s_sleep(1);
        if ((++sp & 255u) == 0u) { if (xb_ld(&bar[XB_TMO])) break; if (sp > XB_SPIN_CAP) { atomicAdd(&bar[XB_TMO], 1u); break; } }
    }
    nloc = mine > 0u ? mine : 1u; nx = cnt > 0u ? cnt : 1u;
}

__device__ __forceinline__ void xcd_barrier(const XcdBarrier& b) {
    asm volatile("s_waitcnt vmcnt(0)" ::: "memory");
    __syncthreads();
    if (threadIdx.x == 0) {
        unsigned* bar = b.bar;
        __builtin_amdgcn_s_waitcnt(0);
        unsigned nloc = b.st[0], nx = b.st[1];
        if (nloc == 0u) { xcd_barrier_complete(bar, b.x, nloc, nx); b.st[0] = nloc; b.st[1] = nx; }
        const unsigned old = xb_add(&bar[XB_XSUB(b.x)], 1u);
        const unsigned gen = old / nloc;
        if (old + 1u == (gen + 1u) * nloc) {
            __builtin_amdgcn_fence(__ATOMIC_RELEASE, "agent");
            asm volatile("s_waitcnt vmcnt(0)" ::: "memory");
            const unsigned og = xb_add(&bar[XB_TOP], 1u);
            const unsigned tg = og / nx;
            if (og + 1u == (tg + 1u) * nx) xb_add(&bar[XB_TOPGEN], 1u);
            else XB_SPIN(xb_ld(&bar[XB_TOPGEN]) == tg, bar);
            __builtin_amdgcn_fence(__ATOMIC_ACQUIRE, "agent");
            xb_add(&bar[XB_XGEN(b.x)], 1u);
            asm volatile("s_waitcnt vmcnt(0)" ::: "memory");
        } else {
            XB_SPIN(xb_ld(&bar[XB_XGEN(b.x)]) == gen, bar);
            __builtin_amdgcn_fence(__ATOMIC_ACQUIRE, "agent");
            asm volatile("s_waitcnt vmcnt(0)" ::: "memory");
        }
    }
    __syncthreads();
}

#if MEGA
__global__ void __launch_bounds__(NTHR) k_mega(Params p) {
  extern __shared__ __attribute__((aligned(16))) char smem[];
  cg::grid_group grid = cg::this_grid();
  const int bid = blockIdx.x, nb = gridDim.x;
  volatile XLAS unsigned* xst = (volatile XLAS unsigned*)(XLAS char*)(smem + LDS_BYTES - 64);
  if (threadIdx.x < 4) xst[threadIdx.x] = 0u;
  if (bid == 0) for (int i = threadIdx.x; i < XCD_BAR_WORDS; i += NTHR) ws_bar(p)[i] = 0u;
  phase0(p, bid, nb, smem);
  grid.sync();
  XcdBarrier xb = xcd_barrier_post(ws_bar(p), xst);
#define SEAM() xcd_barrier(xb)
  phase1(p, bid, nb, smem); SEAM();
  phase2_pg8(p, bid, nb, smem); SEAM();
  phase3_mfma<3>(p, bid, nb, smem); SEAM();
  phase4a_chunk(p, bid, nb, smem); phase4b_mfma(p, bid, nb, smem); SEAM();
  phase5a(p, bid, nb, smem); phase5b_mfma(p, bid, nb, smem); SEAM();
  phase6_pg8(p, bid, nb, smem); SEAM();
  phase7(p, bid, nb, smem); SEAM();
  phase8_pg8(p, bid, nb, smem); SEAM();
  phase9_pg8(p, bid, nb, smem); SEAM();
  phase10(p, bid, nb, smem);
}
#else
#define PHASE_KERNEL(name, body) __global__ void __launch_bounds__(NTHR) name(Params p) { extern __shared__ __attribute__((aligned(16))) char smem[]; body(p, blockIdx.x, gridDim.x, smem); }
PHASE_KERNEL(k_phase0, phase0)
PHASE_KERNEL(k_phase1, phase1)
PHASE_KERNEL(k_phase2, phase2)
PHASE_KERNEL(k_phase3a, phase3a)
PHASE_KERNEL(k_phase3b, phase3b)
PHASE_KERNEL(k_phase4a, phase4a)
PHASE_KERNEL(k_phase4a2, phase4a_v2)
PHASE_KERNEL(k_phase4a3, phase4a_v3)
PHASE_KERNEL(k_phase4b, phase4b)
PHASE_KERNEL(k_phase4bm, phase4b_mfma)
PHASE_KERNEL(k_phase3m, phase3_mfma<3>)
PHASE_KERNEL(k_phase5a, phase5a)
PHASE_KERNEL(k_phase5b, phase5b)
PHASE_KERNEL(k_phase5bm, phase5b_mfma)
PHASE_KERNEL(k_phase6, phase6)
PHASE_KERNEL(k_phase7, phase7)
PHASE_KERNEL(k_phase8, phase8)
PHASE_KERNEL(k_phase9, phase9)
PHASE_KERNEL(k_phase10, phase10)
#endif

extern "C" void kernel_launch(void* const* d_in, const int* in_sizes, int n_in, void* d_out, int out_size, void* d_ws, size_t ws_size, hipStream_t stream) {
  Params p{};
  const float** f = (const float**)&p;
  for (int i = 0; i < 33; ++i) f[i] = (const float*)d_in[i];
  p.out = (float*)d_out; p.ws = (char*)d_ws;
  if (n_in != 33 || ws_size < (size_t)(OFF_S + 9 * MiB) || out_size != NTOK * DM) { fprintf(stderr, "kernel_launch: unexpected problem shape or workspace (n_in %d, ws %zu, out %d)\n", n_in, ws_size, out_size); return; }
#if MEGA
  static int grid_blocks = 0;
  if (!grid_blocks) {
    int dev = 0, cus = 0, per_cu = 0;
    hipGetDevice(&dev);
    hipDeviceGetAttribute(&cus, hipDeviceAttributeMultiprocessorCount, dev);
    hipFuncSetAttribute((const void*)k_mega, hipFuncAttributeMaxDynamicSharedMemorySize, LDS_BYTES);
    hipOccupancyMaxActiveBlocksPerMultiprocessor(&per_cu, k_mega, NTHR, LDS_BYTES);
    if (per_cu > 1) per_cu = 1;
    grid_blocks = cus * per_cu;
  }
  void* args[] = {&p};
  hipError_t e = hipLaunchCooperativeKernel((void*)k_mega, dim3(grid_blocks), dim3(NTHR), args, LDS_BYTES, stream);
  if (e != hipSuccess) fprintf(stderr, "cooperative launch failed: %s (grid %d)\n", hipGetErrorString(e), grid_blocks);
#else
  const int G = 512;
#define LAUNCH(k, g) hipLaunchKernelGGL(k, dim3(g), dim3(NTHR), LDS_BYTES, stream, p)
  LAUNCH(k_phase0, G);
  LAUNCH(k_phase1, G);
  LAUNCH(k_phase2, G);
  LAUNCH(k_phase3a, G);
  LAUNCH(k_phase3b, G);
  LAUNCH(k_phase4a, 128);
  LAUNCH(k_phase4b, 1024);
  LAUNCH(k_phase5a, G);
  LAUNCH(k_phase5b, 1024);
  LAUNCH(k_phase6, G);
  LAUNCH(k_phase7, G);
  LAUNCH(k_phase8, G);
  LAUNCH(k_phase9, G);
  LAUNCH(k_phase10, G);
#endif
}
```

```cpp
#include <hip/hip_runtime.h>
#include <hip/hip_cooperative_groups.h>
#include <stdint.h>
#include <stdio.h>

namespace cg = cooperative_groups;

#ifndef MEGA
#define MEGA 1
#endif

typedef unsigned short bf16_t;
typedef short bf16x8 __attribute__((ext_vector_type(8)));
typedef float f32x16 __attribute__((ext_vector_type(16)));
typedef float f32x4 __attribute__((ext_vector_type(4)));
typedef float f32x4v __attribute__((ext_vector_type(4)));
typedef unsigned u32x4 __attribute__((ext_vector_type(4)));
typedef unsigned u32x2 __attribute__((ext_vector_type(2)));

#define DI __device__ __forceinline__

constexpr int DM = 1024, BATCH = 16, SEQ = 2048, NTOK = BATCH * SEQ;
constexpr int RW = 512, NH = 8, HD = 64;
constexpr int PROJ_N = 2756, PROJ_LD = 2816;
constexpr int C_R = 0, C_K = 512, C_V = 1024, C_WL = 1536, C_AL = 1600, C_GL = 1664;
constexpr int C_Q = 1792, C_CKV = 2304, C_QI = 2432, C_KI = 2688, C_WI = 2752;
constexpr int NEXP = 32, DEXP = 512, LCAP = 32768;
constexpr int NTHR = 512;
constexpr int LDS_BYTES = 163840;

constexpr size_t MiB = 1048576;
constexpr size_t OFF_A = 0;
constexpr size_t OFF_B = 64 * MiB;
constexpr size_t OFF_C = 240 * MiB;
constexpr size_t OFF_F = 400 * MiB;
constexpr size_t OFF_G = 464 * MiB;
constexpr size_t OFF_W = 484 * MiB;
constexpr size_t OFF_S = 492 * MiB;

struct Params {
  const float *x, *c, *ada_w, *ada_b, *norm1_g, *w_in, *shift_mu, *w0, *w_decay_up, *a0, *w_aaa_up, *w_gate_up;
  const float *k_k, *k_a, *r_k, *gn_g, *gn_b, *kv_norm_g, *k_idx_norm_g, *w_uk, *w_uv, *w_out, *norm2_g;
  const float *w_group, *b_group, *w_expert, *b_expert, *e_gate, *e_up, *e_down, *final_ada_w, *final_ada_b, *final_norm_g;
  float* out;
  char* ws;
};

DI int tid_() { int t = threadIdx.x; asm volatile("" : "+v"(t)); return t; }
DI float bf2f(bf16_t u) { return __uint_as_float(((unsigned)u) << 16); }
DI bf16_t f2bf(float f) { unsigned u = __float_as_uint(f); u += 0x7fffu + ((u >> 16) & 1u); return (bf16_t)(u >> 16); }
DI unsigned pack2(float lo, float hi) { return (unsigned)f2bf(lo) | ((unsigned)f2bf(hi) << 16); }
DI float wave_sum(float v) { for (int o = 32; o; o >>= 1) v += __shfl_xor(v, o); return v; }
DI float wave_max(float v) { for (int o = 32; o; o >>= 1) v = fmaxf(v, __shfl_xor(v, o)); return v; }
DI float sigmoidf_(float v) { return 1.0f / (1.0f + __expf(-v)); }
DI int crow(int r, int hi) { return (r & 3) + 8 * (r >> 2) + 4 * hi; }
DI unsigned cvtpk(float lo, float hi) { unsigned r; asm volatile("v_cvt_pk_bf16_f32 %0, %1, %2" : "=v"(r) : "v"(lo), "v"(hi)); return r; }

DI void unpack8(const u32x4 w, float* o) {
  o[0] = __uint_as_float(w.x << 16); o[1] = __uint_as_float(w.x & 0xffff0000u); o[2] = __uint_as_float(w.y << 16); o[3] = __uint_as_float(w.y & 0xffff0000u);
  o[4] = __uint_as_float(w.z << 16); o[5] = __uint_as_float(w.z & 0xffff0000u); o[6] = __uint_as_float(w.w << 16); o[7] = __uint_as_float(w.w & 0xffff0000u);
}
DI void load8(const bf16_t* p, float* o) { unpack8(*(const u32x4*)p, o); }

DI bf16_t* ws_h1(const Params& p) { return (bf16_t*)(p.ws + OFF_A); }
DI float* ws_y(const Params& p) { return (float*)(p.ws + OFF_A); }
DI bf16_t* ws_h2(const Params& p) { return (bf16_t*)(p.ws + OFF_A); }
DI bf16_t* ws_proj(const Params& p) { return (bf16_t*)(p.ws + OFF_B); }
DI float* ws_x1(const Params& p) { return (float*)(p.ws + OFF_B); }
DI bf16_t* ws_wgu(const Params& p) { return (bf16_t*)p.out; }
DI bf16_t* ws_wd(const Params& p) { return (bf16_t*)((char*)p.out + 64 * MiB); }
DI bf16_t* ws_hid(const Params& p) { return (bf16_t*)(p.ws + OFF_B + 96 * MiB); }
DI bf16_t* ws_kp(const Params& p) { return (bf16_t*)(p.ws + OFF_C); }
DI bf16_t* ws_kk(const Params& p) { return (bf16_t*)(p.ws + OFF_C + 32 * MiB); }
DI bf16_t* ws_bb(const Params& p) { return (bf16_t*)(p.ws + OFF_C + 64 * MiB); }
DI bf16_t* ws_ee(const Params& p) { return (bf16_t*)(p.ws + OFF_C + 96 * MiB); }
DI bf16_t* ws_gg(const Params& p) { return (bf16_t*)(p.ws + OFF_C + 128 * MiB); }
DI bf16_t* ws_mix(const Params& p) { return (bf16_t*)(p.ws + OFF_C); }
DI bf16_t* ws_ybuf(const Params& p) { return (bf16_t*)(p.ws + OFF_C); }
DI bf16_t* ws_qlat(const Params& p) { return (bf16_t*)(p.ws + OFF_F); }
DI bf16_t* ws_ckv(const Params& p) { return (bf16_t*)(p.ws + OFF_G); }
DI bf16_t* ws_kidx(const Params& p) { return (bf16_t*)(p.ws + OFF_G + 8 * MiB); }
DI unsigned* ws_mask(const Params& p) { return (unsigned*)(p.ws + OFF_G + 12 * MiB); }
DI bf16_t* ws_wtin(const Params& p) { return (bf16_t*)(p.ws + OFF_W); }
DI bf16_t* ws_wtout(const Params& p) { return (bf16_t*)(p.ws + OFF_W + 6 * MiB); }
DI bf16_t* ws_wuvt(const Params& p) { return (bf16_t*)(p.ws + OFF_S + 7 * MiB); }
DI bf16_t* ws_wdt(const Params& p) { return (bf16_t*)(p.ws + OFF_S + 8 * MiB + 64 * 1024); }
DI bf16_t* ws_wat(const Params& p) { return (bf16_t*)(p.ws + OFF_S + 8 * MiB + 128 * 1024); }
DI bf16_t* ws_wgt(const Params& p) { return (bf16_t*)(p.ws + OFF_S + 8 * MiB + 192 * 1024); }
DI bf16_t* ws_wukt(const Params& p) { return (bf16_t*)(p.ws + OFF_S + 8 * MiB + 320 * 1024); }
DI unsigned* ws_bar(const Params& p) { return (unsigned*)(p.ws + OFF_S + 8 * MiB); }
DI float* ws_mod(const Params& p) { return (float*)(p.ws + OFF_S); }
DI float* ws_fmod(const Params& p) { return (float*)(p.ws + OFF_S + 512 * 1024); }
DI float* ws_bonus(const Params& p) { return (float*)(p.ws + OFF_S + 1 * MiB); }
DI int* ws_cnt(const Params& p) { return (int*)(p.ws + OFF_S + 2 * MiB); }
DI float* ws_wa(const Params& p) { return (float*)(p.ws + OFF_S + 2 * MiB + 4096); }
DI int* ws_list(const Params& p) { return (int*)(p.ws + OFF_S + 3 * MiB); }

template <class RowMap>
DI void transpose_tile(const float* src, int N, int k0, int n0, bf16_t* dst, int dstld, RowMap rm, char* lds) {
  float* tile = (float*)lds;
  const int t = tid_();
  __syncthreads();
  {
    const int nc = t & 63, krb = t >> 6;
#pragma unroll
    for (int i = 0; i < 8; ++i) {
      const int kr = krb + 8 * i;
      const int n = n0 + nc;
      tile[kr * 65 + nc] = (n < N) ? src[(size_t)(k0 + kr) * N + n] : 0.f;
    }
  }
  __syncthreads();
  {
    const int nr = t >> 3, kc = (t & 7) * 8;
    u32x4 w;
    w.x = pack2(tile[(kc + 0) * 65 + nr], tile[(kc + 1) * 65 + nr]);
    w.y = pack2(tile[(kc + 2) * 65 + nr], tile[(kc + 3) * 65 + nr]);
    w.z = pack2(tile[(kc + 4) * 65 + nr], tile[(kc + 5) * 65 + nr]);
    w.w = pack2(tile[(kc + 6) * 65 + nr], tile[(kc + 7) * 65 + nr]);
    *(u32x4*)(dst + (size_t)rm(n0 + nr) * dstld + k0 + kc) = w;
  }
}
struct RowId { DI int operator()(int n) const { return n; } };
struct RowGU { int add; DI int operator()(int n) const { return (n >> 7) * 256 + (n & 127) + add; } };

DI void phase0(const Params& p, int bid, int nb, char* lds) {
  const int t = tid_();
  if (bid == 0 && t < NEXP) ws_cnt(p)[t] = 0;
  for (int idx = bid * NTHR + t; idx < 8 * 64 * 128; idx += nb * NTHR) {
    const int hh = idx >> 13, d = (idx >> 7) & 63, cc = idx & 127;
    ws_wuvt(p)[idx] = f2bf(p.w_uv[(size_t)(cc * NH + hh) * HD + d]);
    const int h2 = idx >> 13, c2 = (idx >> 6) & 127, d2 = idx & 63;
    ws_wukt(p)[idx] = f2bf(p.w_uk[(size_t)(c2 * NH + h2) * HD + d2]);
  }
  for (int task = bid; task < 32; task += nb) {
    if (task < 8) transpose_tile(p.w_decay_up, RW, 0, task * 64, ws_wdt(p), 64, RowId(), lds);
    else if (task < 16) transpose_tile(p.w_aaa_up, RW, 0, (task - 8) * 64, ws_wat(p), 64, RowId(), lds);
    else { const int q = task - 16; transpose_tile(p.w_gate_up, RW, (q >> 3) * 64, (q & 7) * 64, ws_wgt(p), 128, RowId(), lds); }
  }
  for (int task = bid; task < 256; task += nb) {
    float* cact = (float*)lds;
    __syncthreads();
    for (int i = t; i < 16 * 1024; i += NTHR) { const float v = p.c[i]; cact[i] = v / (1.0f + __expf(-v)); }
    __syncthreads();
    const int col = task * 32 + (t & 31), ks = t >> 5;
    const float* w; int ld, cc;
    if (col < 6144) { w = p.ada_w; ld = 6144; cc = col; } else { w = p.final_ada_w; ld = 2048; cc = col - 6144; }
    float acc[16];
#pragma unroll
    for (int b = 0; b < 16; ++b) acc[b] = 0.f;
    for (int kk = 0; kk < 64; ++kk) {
      const int k = ks * 64 + kk;
      const float wv = w[(size_t)k * ld + cc];
#pragma unroll
      for (int b = 0; b < 16; ++b) acc[b] += cact[b * 1024 + k] * wv;
    }
    __syncthreads();
    float* red = (float*)lds;
#pragma unroll
    for (int b = 0; b < 16; ++b) red[(ks * 16 + b) * 32 + (t & 31)] = acc[b];
    __syncthreads();
    {
      const int b = t >> 5, cl = t & 31, colo = task * 32 + cl;
      float s = 0.f;
      for (int k2 = 0; k2 < 16; ++k2) s += red[(k2 * 16 + b) * 32 + cl];
      if (colo < 6144) ws_mod(p)[b * 6144 + colo] = s + p.ada_b[colo];
      else ws_fmod(p)[b * 2048 + colo - 6144] = s + p.final_ada_b[colo - 6144];
    }
  }
  for (int task = bid; task < 704 + 256; task += nb) {
    if (task < 704) { const int kt = task / 44, nt = task % 44; transpose_tile(p.w_in, PROJ_N, kt * 64, nt * 64, ws_wtin(p), 1024, RowId(), lds); }
    else { const int q = task - 704, kt = q >> 4, nt = q & 15; transpose_tile(p.w_out, 1024, kt * 64, nt * 64, ws_wtout(p), 1024, RowId(), lds); }
  }
}

DI void phase1(const Params& p, int bid, int nb, char* lds) {
  const int lane = tid_() & 63, wid = tid_() >> 6;
  const float* mod = ws_mod(p);
  for (int row = bid * 8 + wid; row < NTOK; row += nb * 8) {
    const int b = row >> 11;
    const float* xr = p.x + (size_t)row * DM;
    f32x4 v[4]; float ss = 0.f;
#pragma unroll
    for (int i = 0; i < 4; ++i) { v[i] = *(const f32x4*)(xr + lane * 4 + 256 * i); ss += v[i][0] * v[i][0] + v[i][1] * v[i][1] + v[i][2] * v[i][2] + v[i][3] * v[i][3]; }
    ss = wave_sum(ss);
    const float rstd = rsqrtf(ss * (1.0f / DM) + 1e-6f);
#pragma unroll
    for (int i = 0; i < 4; ++i) {
      const int col = lane * 4 + 256 * i;
      const f32x4 g = *(const f32x4*)(p.norm1_g + col), sh = *(const f32x4*)(mod + b * 6144 + col), sc = *(const f32x4*)(mod + b * 6144 + 1024 + col);
      float o[4];
#pragma unroll
      for (int j = 0; j < 4; ++j) o[j] = v[i][j] * rstd * g[j] * (1.0f + sc[j]) + sh[j];
      u32x2 w; w.x = pack2(o[0], o[1]); w.y = pack2(o[2], o[3]);
      *(u32x2*)(ws_h1(p) + (size_t)row * DM + col) = w;
    }
  }
}

constexpr int GBM = 256, GBN = 128, GBK = 32, GROW = 80, G_LDSA = GBM * GROW, G_STAGE = (GBM + GBN) * GROW;
template <class ARow, class Epi>
DI void gemm_tile(const bf16_t* A, int lda, ARow arow, const bf16_t* Bt, int ldb, int n0, int K, Epi epi, char* lds) {
  const int t = tid_(), lane = t & 63, wid = t >> 6, wm = wid >> 1, wn = wid & 1, r32 = lane & 31, hi = lane >> 5;
  const int srow = t >> 2, sch = t & 3;
  const bf16_t* a0p = A + (size_t)arow(srow) * lda + sch * 8;
  const bf16_t* a1p = A + (size_t)arow(srow + 128) * lda + sch * 8;
  const bf16_t* bp = Bt + (size_t)(n0 + srow) * ldb + sch * 8;
  const int wa0 = srow * GROW + sch * 16, wa1 = (srow + 128) * GROW + sch * 16, wb = G_LDSA + srow * GROW + sch * 16;
  const int ra = (wm * 64 + r32) * GROW + hi * 16, rb = G_LDSA + (wn * 64 + r32) * GROW + hi * 16;
  f32x16 acc[2][2];
#pragma unroll
  for (int i = 0; i < 2; ++i)
#pragma unroll
    for (int j = 0; j < 2; ++j)
#pragma unroll
      for (int r = 0; r < 16; ++r) acc[i][j][r] = 0.f;
  u32x4 ga0 = *(const u32x4*)a0p, ga1 = *(const u32x4*)a1p, gb = *(const u32x4*)bp;
  __syncthreads();
  *(u32x4*)(lds + wa0) = ga0; *(u32x4*)(lds + wa1) = ga1; *(u32x4*)(lds + wb) = gb;
  __syncthreads();
  const int nk = K / GBK;
  for (int kt = 0; kt < nk; ++kt) {
    char* cur = lds + (kt & 1) * G_STAGE;
    char* nxt = lds + ((kt + 1) & 1) * G_STAGE;
    if (kt + 1 < nk) { ga0 = *(const u32x4*)(a0p + (kt + 1) * GBK); ga1 = *(const u32x4*)(a1p + (kt + 1) * GBK); gb = *(const u32x4*)(bp + (kt + 1) * GBK); }
#pragma unroll
    for (int ks = 0; ks < 2; ++ks) {
      bf16x8 a[2], b[2];
#pragma unroll
      for (int i = 0; i < 2; ++i) { a[i] = *(const bf16x8*)(cur + ra + i * 32 * GROW + ks * 32); b[i] = *(const bf16x8*)(cur + rb + i * 32 * GROW + ks * 32); }
#pragma unroll
      for (int i = 0; i < 2; ++i)
#pragma unroll
        for (int j = 0; j < 2; ++j) acc[i][j] = __builtin_amdgcn_mfma_f32_32x32x16_bf16(a[i], b[j], acc[i][j], 0, 0, 0);
    }
    if (kt + 1 < nk) { *(u32x4*)(nxt + wa0) = ga0; *(u32x4*)(nxt + wa1) = ga1; *(u32x4*)(nxt + wb) = gb; }
    __syncthreads();
  }
#pragma unroll
  for (int i = 0; i < 2; ++i)
#pragma unroll
    for (int r = 0; r < 16; ++r) epi(wm * 64 + i * 32 + crow(r, hi), wn * 64 + r32, acc[i][0][r], acc[i][1][r]);
}

struct ARowBase { int base; DI int operator()(int r) const { return base + r; } };

struct EpiProj { bf16_t* o; int row0, col0; DI void operator()(int r, int c, float v0, float v1) const {
  bf16_t* q = o + (size_t)(row0 + r) * PROJ_LD + col0 + c; q[0] = f2bf(v0); q[32] = f2bf(v1); } };
DI void phase2(const Params& p, int bid, int nb, char* lds) {
  constexpr int NT = PROJ_LD / GBN;
  for (int tile = bid; tile < (NTOK / GBM) * NT; tile += nb) {
    const int mt = tile / NT, nt = tile % NT;
    gemm_tile(ws_h1(p), DM, ARowBase{mt * GBM}, ws_wtin(p), DM, nt * GBN, DM, EpiProj{ws_proj(p), mt * GBM, nt * GBN}, lds);
  }
}

DI float proj_shift(const bf16_t* proj, const float* mu, int gt, int col) {
  const float pv = bf2f(proj[(size_t)gt * PROJ_LD + col]);
  const float pp = (gt & (SEQ - 1)) ? bf2f(proj[(size_t)(gt - 1) * PROJ_LD + col]) : 0.f;
  return pv + mu[col] * (pp - pv);
}
DI void phase3a(const Params& p, int bid, int nb, char* lds) {
  const int t = tid_(), lane = t & 63, wid = t >> 6;
  float* xl = (float*)lds;
  const bf16_t* proj = ws_proj(p);
  for (int tile = bid; tile < NTOK / 16; tile += nb) {
    const int t0 = tile * 16;
    __syncthreads();
    for (int idx = t; idx < 16 * 256; idx += NTHR) {
      const int tok = idx >> 8, col = idx & 255;
      float v = proj_shift(proj, p.shift_mu, t0 + tok, C_WL + col);
      if (col < 64) v = tanhf(v); else if (col >= 128) v = sigmoidf_(v);
      xl[idx] = v;
    }
    __syncthreads();
    const int c = t;
    float acc[16];
#pragma unroll
    for (int i = 0; i < 16; ++i) acc[i] = 0.f;
    for (int k4 = 0; k4 < 16; ++k4) {
      float w[4];
#pragma unroll
      for (int j = 0; j < 4; ++j) w[j] = p.w_decay_up[(k4 * 4 + j) * RW + c];
#pragma unroll
      for (int i = 0; i < 16; ++i) { const f32x4 xv = *(const f32x4*)(xl + i * 256 + k4 * 4); acc[i] += xv[0] * w[0] + xv[1] * w[1] + xv[2] * w[2] + xv[3] * w[3]; }
    }
    {
      const float w0c = p.w0[c];
#pragma unroll
      for (int i = 0; i < 16; ++i) {
        const float z = -(w0c + acc[i]);
        const float sp = fmaxf(z, 0.f) + log1pf(__expf(-fabsf(z)));
        ws_ee(p)[(size_t)(t0 + i) * RW + c] = f2bf(__expf(-sp - 0.5f));
      }
    }
#pragma unroll
    for (int i = 0; i < 16; ++i) acc[i] = 0.f;
    for (int k4 = 0; k4 < 32; ++k4) {
      float w[4];
#pragma unroll
      for (int j = 0; j < 4; ++j) w[j] = p.w_gate_up[(k4 * 4 + j) * RW + c];
#pragma unroll
      for (int i = 0; i < 16; ++i) { const f32x4 xv = *(const f32x4*)(xl + i * 256 + 128 + k4 * 4); acc[i] += xv[0] * w[0] + xv[1] * w[1] + xv[2] * w[2] + xv[3] * w[3]; }
    }
#pragma unroll
    for (int i = 0; i < 16; ++i) ws_gg(p)[(size_t)(t0 + i) * RW + c] = f2bf(acc[i]);
#pragma unroll
    for (int i = 0; i < 16; ++i) acc[i] = 0.f;
    for (int k4 = 0; k4 < 16; ++k4) {
      float w[4];
#pragma unroll
      for (int j = 0; j < 4; ++j) w[j] = p.w_aaa_up[(k4 * 4 + j) * RW + c];
#pragma unroll
      for (int i = 0; i < 16; ++i) { const f32x4 xv = *(const f32x4*)(xl + i * 256 + 64 + k4 * 4); acc[i] += xv[0] * w[0] + xv[1] * w[1] + xv[2] * w[2] + xv[3] * w[3]; }
    }
    {
      const float a0c = p.a0[c], kkc = p.k_k[c], kac = p.k_a[c], rkc = p.r_k[c];
#pragma unroll
      for (int i = 0; i < 16; ++i) {
        const int gt = t0 + i;
        const float a = sigmoidf_(a0c + acc[i]);
        const float r = proj_shift(proj, p.shift_mu, gt, C_R + c);
        const float k = proj_shift(proj, p.shift_mu, gt, C_K + c);
        float kk = k * kkc;
        const float nrm = fmaxf(sqrtf(wave_sum(kk * kk)), 1e-12f);
        kk = kk / nrm;
        const float kp = k * (1.0f + (a - 1.0f) * kac);
        const float bs = wave_sum(r * kp * rkc);
        ws_kp(p)[(size_t)gt * RW + c] = f2bf(kp);
        ws_kk(p)[(size_t)gt * RW + c] = f2bf(kk);
        ws_bb(p)[(size_t)gt * RW + c] = f2bf(kk * a);
        if (lane == 0) ws_bonus(p)[gt * NH + wid] = bs;
      }
    }
  }
}

DI void phase3b(const Params& p, int bid, int nb, char* lds) {
  const int t = tid_(), lane = t & 63, wid = t >> 6;
  float* ql = (float*)lds;
  const bf16_t* proj = ws_proj(p);
  for (int tile = bid; tile < NTOK / 16; tile += nb) {
    const int t0 = tile * 16;
    __syncthreads();
    for (int idx = t; idx < 16 * 512; idx += NTHR) ql[idx] = bf2f(proj[(size_t)(t0 + (idx >> 9)) * PROJ_LD + C_Q + (idx & 511)]);
#pragma unroll
    for (int q = 0; q < 2; ++q) {
      const int gt = t0 + wid * 2 + q;
      const float v0 = bf2f(proj[(size_t)gt * PROJ_LD + C_CKV + lane * 2]), v1 = bf2f(proj[(size_t)gt * PROJ_LD + C_CKV + lane * 2 + 1]);
      const float rs = rsqrtf(wave_sum(v0 * v0 + v1 * v1) * (1.0f / 128.0f) + 1e-6f);
      *(unsigned*)(ws_ckv(p) + (size_t)gt * 128 + lane * 2) = pack2(v0 * rs * p.kv_norm_g[lane * 2], v1 * rs * p.kv_norm_g[lane * 2 + 1]);
      const float u = bf2f(proj[(size_t)gt * PROJ_LD + C_KI + lane]);
      const float rs2 = rsqrtf(wave_sum(u * u) * (1.0f / 64.0f) + 1e-6f);
      ws_kidx(p)[(size_t)gt * 64 + lane] = f2bf(u * rs2 * p.k_idx_norm_g[lane]);
    }
    __syncthreads();
    const int h = wid;
#pragma unroll 1
    for (int ps = 0; ps < 2; ++ps) {
      const int cidx = lane + 64 * ps;
      float w[64];
      const float* wp = p.w_uk + (size_t)(cidx * NH + h) * HD;
#pragma unroll
      for (int d4 = 0; d4 < 16; ++d4) { const f32x4 wv = *(const f32x4*)(wp + d4 * 4); w[d4 * 4] = wv[0]; w[d4 * 4 + 1] = wv[1]; w[d4 * 4 + 2] = wv[2]; w[d4 * 4 + 3] = wv[3]; }
#pragma unroll 1
      for (int i = 0; i < 16; ++i) {
        float acc = 0.f;
#pragma unroll
        for (int d4 = 0; d4 < 16; ++d4) { const f32x4 qv = *(const f32x4*)(ql + i * 512 + h * 64 + d4 * 4); acc += qv[0] * w[d4 * 4] + qv[1] * w[d4 * 4 + 1] + qv[2] * w[d4 * 4 + 2] + qv[3] * w[d4 * 4 + 3]; }
        ws_qlat(p)[((size_t)(t0 + i) * NH + h) * 128 + cidx] = f2bf(acc * 0.125f);
      }
    }
  }
}

DI float xhalf_sum(float v) { auto rr = __builtin_amdgcn_permlane32_swap(__float_as_uint(v), __float_as_uint(v), false, false); return __uint_as_float(rr[0]) + __uint_as_float(rr[1]); }
DI float dpp_sum8(float v) {
  v += __int_as_float(__builtin_amdgcn_update_dpp(0, __float_as_int(v), 0xB1, 0xF, 0xF, true));
  v += __int_as_float(__builtin_amdgcn_update_dpp(0, __float_as_int(v), 0x4E, 0xF, 0xF, true));
  v += __int_as_float(__builtin_amdgcn_update_dpp(0, __float_as_int(v), 0x141, 0xF, 0xF, true));
  return v;
}
DI float dpp_sum16b(float v) { v = dpp_sum8(v); v += __int_as_float(__builtin_amdgcn_update_dpp(0, __float_as_int(v), 0x140, 0xF, 0xF, true)); return v; }
DI u32x2 pk4(float a, float b, float c, float d) { u32x2 w; w.x = cvtpk(a, b); w.y = cvtpk(c, d); return w; }
DI void ld4(const bf16_t* p, float* o) { const u32x2 w = *(const u32x2*)p; o[0] = __uint_as_float(w.x << 16); o[1] = __uint_as_float(w.x & 0xffff0000u); o[2] = __uint_as_float(w.y << 16); o[3] = __uint_as_float(w.y & 0xffff0000u); }
constexpr int XL_ROW = 528;
template <int MODE> DI void phase3_mfma(const Params& p, int bid, int nb, char* lds) {
  const int t_ = tid_(), wid = t_ >> 6, h = wid;
  const bf16_t* proj = ws_proj(p);
  for (int tile = bid; tile < NTOK / 64; tile += nb) {
    const int t0 = tile * 64;
    int t = t_;
    asm volatile("" : "+v"(t));
    const int lane = t & 63, r32_ = lane & 31, hi_ = lane >> 5;
    __syncthreads();
#pragma unroll
    for (int i = 0; i < 4; ++i) {
      const int id = t + 512 * i, tok = id >> 5, cc = (id & 31) * 8, gt = t0 + tok;
      float v[8], pv[8];
      const bool firstt = (gt & (SEQ - 1)) == 0;
      load8(proj + (unsigned)(gt * PROJ_LD + C_WL + cc), v);
      load8(proj + (unsigned)((firstt ? gt : gt - 1) * PROJ_LD + C_WL + cc), pv);
      const f32x4 m0 = *(const f32x4*)(p.shift_mu + C_WL + cc), m1 = *(const f32x4*)(p.shift_mu + C_WL + cc + 4);
      const float esc = (cc < 64) ? 2.0f : -1.0f;
      float x[8];
#pragma unroll
      for (int j = 0; j < 8; ++j) {
        const float mu = j < 4 ? m0[j] : m1[j - 4];
        const float pj = firstt ? 0.f : pv[j];
        const float xv = v[j] + mu * (pj - v[j]);
        const float rc = 1.0f / (__expf(esc * xv) + 1.0f);
        x[j] = (cc < 64) ? (1.0f - 2.0f * rc) : ((cc >= 128) ? rc : xv);
      }
      u32x4 w; w.x = cvtpk(x[0], x[1]); w.y = cvtpk(x[2], x[3]); w.z = cvtpk(x[4], x[5]); w.w = cvtpk(x[6], x[7]);
      *(u32x4*)(lds + tok * XL_ROW + cc * 2) = w;
    }
    if (MODE & 2) {
#pragma unroll
    for (int it = 0; it < 2; ++it) {
      const int gt = t0 + wid * 8 + it * 4 + (lane >> 4), c0 = (lane & 15) * 8;
      float v[8]; load8(proj + (size_t)gt * PROJ_LD + C_CKV + c0, v);
      float ss = 0.f;
#pragma unroll
      for (int j = 0; j < 8; ++j) ss += v[j] * v[j];
      const float rs = rsqrtf(dpp_sum16b(ss) * (1.0f / 128.0f) + 1e-6f);
      const f32x4 g0 = *(const f32x4*)(p.kv_norm_g + c0), g1 = *(const f32x4*)(p.kv_norm_g + c0 + 4);
      u32x4 w; w.x = cvtpk(v[0] * rs * g0[0], v[1] * rs * g0[1]); w.y = cvtpk(v[2] * rs * g0[2], v[3] * rs * g0[3]);
      w.z = cvtpk(v[4] * rs * g1[0], v[5] * rs * g1[1]); w.w = cvtpk(v[6] * rs * g1[2], v[7] * rs * g1[3]);
      *(u32x4*)(ws_ckv(p) + (size_t)gt * 128 + c0) = w;
    }
    {
      const int gt = t0 + wid * 8 + (lane >> 3), c0 = (lane & 7) * 8;
      float v[8]; load8(proj + (size_t)gt * PROJ_LD + C_KI + c0, v);
      float ss = 0.f;
#pragma unroll
      for (int j = 0; j < 8; ++j) ss += v[j] * v[j];
      const float rs = rsqrtf(dpp_sum8(ss) * (1.0f / 64.0f) + 1e-6f);
      const f32x4 g0 = *(const f32x4*)(p.k_idx_norm_g + c0), g1 = *(const f32x4*)(p.k_idx_norm_g + c0 + 4);
      u32x4 w; w.x = cvtpk(v[0] * rs * g0[0], v[1] * rs * g0[1]); w.y = cvtpk(v[2] * rs * g0[2], v[3] * rs * g0[3]);
      w.z = cvtpk(v[4] * rs * g1[0], v[5] * rs * g1[1]); w.w = cvtpk(v[6] * rs * g1[2], v[7] * rs * g1[3]);
      *(u32x4*)(ws_kidx(p) + (size_t)gt * 64 + c0) = w;
    }
    }
    __syncthreads();
#pragma unroll 1
    for (int nt = 0; nt < 2; ++nt) {
      int r32 = r32_, hi = hi_;
      asm volatile("" : "+v"(r32), "+v"(hi));
      const int gt = t0 + nt * 32 + r32;
      const bool first = (gt & (SEQ - 1)) == 0;
      const int gp = first ? gt : gt - 1;
      const char* xrow = lds + (nt * 32 + r32) * XL_ROW + hi * 16;
      const int chb = h * HD + 4 * hi;
      char* RBt = lds + 64 * XL_ROW + wid * 14336; char* KBt = RBt + 4752; char* OBt = KBt + 4752;
      const int t0w = t0 + nt * 32, frow = lane >> 3, fch = lane & 7;
      const int cwo = r32 * 144 + hi * 8;
#define P3_FLUSH(dst_, ld_, col_) do { _Pragma("unroll") for (int i_ = 0; i_ < 4; ++i_) { const int row_ = frow + 8 * i_; \
        *(u32x4*)((dst_) + (unsigned)((t0w + row_) * (ld_) + (col_) + fch * 8)) = *(const u32x4*)(OBt + row_ * 144 + fch * 16); } } while (0)
      if (MODE & 1) {
      f32x16 acc[2];
#pragma unroll
      for (int mt = 0; mt < 2; ++mt)
#pragma unroll
        for (int r = 0; r < 16; ++r) acc[mt][r] = 0.f;
#pragma unroll
      for (int ks = 0; ks < 4; ++ks) {
        const bf16x8 bx = *(const bf16x8*)(xrow + ks * 32);
#pragma unroll
        for (int mt = 0; mt < 2; ++mt) { const bf16x8 aw = *(const bf16x8*)(ws_wdt(p) + (size_t)(h * HD + mt * 32 + r32) * 64 + ks * 16 + hi * 8); acc[mt] = __builtin_amdgcn_mfma_f32_32x32x16_bf16(aw, bx, acc[mt], 0, 0, 0); }
      }
#pragma unroll
      for (int mt = 0; mt < 2; ++mt)
#pragma unroll
        for (int g = 0; g < 4; ++g) {
          const int ch = chb + 32 * mt + 8 * g;
          const f32x4 w0v = *(const f32x4*)(p.w0 + ch);
          float e[4];
#pragma unroll
          for (int i = 0; i < 4; ++i) e[i] = 0.6065306597f / (1.0f + __expf(-(w0v[i] + acc[mt][4 * g + i])));
          *(u32x2*)(OBt + cwo + mt * 64 + g * 16) = pk4(e[0], e[1], e[2], e[3]);
        }
      P3_FLUSH(ws_ee(p), RW, h * HD);
      __builtin_amdgcn_sched_barrier(0);
#pragma unroll
      for (int mt = 0; mt < 2; ++mt)
#pragma unroll
        for (int r = 0; r < 16; ++r) acc[mt][r] = 0.f;
#pragma unroll
      for (int ks = 0; ks < 8; ++ks) {
        const bf16x8 bx = *(const bf16x8*)(xrow + 256 + ks * 32);
#pragma unroll
        for (int mt = 0; mt < 2; ++mt) { const bf16x8 aw = *(const bf16x8*)(ws_wgt(p) + (size_t)(h * HD + mt * 32 + r32) * 128 + ks * 16 + hi * 8); acc[mt] = __builtin_amdgcn_mfma_f32_32x32x16_bf16(aw, bx, acc[mt], 0, 0, 0); }
      }
#pragma unroll
      for (int mt = 0; mt < 2; ++mt)
#pragma unroll
        for (int g = 0; g < 4; ++g)
          *(u32x2*)(OBt + cwo + mt * 64 + g * 16) =
              pk4(acc[mt][4 * g] + 0.0f, acc[mt][4 * g + 1] + 0.0f, acc[mt][4 * g + 2] + 0.0f, acc[mt][4 * g + 3] + 0.0f);
      P3_FLUSH(ws_gg(p), RW, h * HD);
      __builtin_amdgcn_sched_barrier(0);
#pragma unroll
      for (int mt = 0; mt < 2; ++mt)
#pragma unroll
        for (int r = 0; r < 16; ++r) acc[mt][r] = 0.f;
#pragma unroll
      for (int ks = 0; ks < 4; ++ks) {
        const bf16x8 bx = *(const bf16x8*)(xrow + 128 + ks * 32);
#pragma unroll
        for (int mt = 0; mt < 2; ++mt) { const bf16x8 aw = *(const bf16x8*)(ws_wat(p) + (size_t)(h * HD + mt * 32 + r32) * 64 + ks * 16 + hi * 8); acc[mt] = __builtin_amdgcn_mfma_f32_32x32x16_bf16(aw, bx, acc[mt], 0, 0, 0); }
      }
      __builtin_amdgcn_sched_barrier(0);
#pragma unroll
      for (int i_ = 0; i_ < 5; ++i_) {
        const int row_ = frow + 8 * i_;
        if (row_ < 33) {
          int tk_ = t0w - 1 + row_; tk_ = tk_ < 0 ? 0 : tk_;
          *(u32x4*)(RBt + row_ * 144 + fch * 16) = *(const u32x4*)(proj + (unsigned)(tk_ * PROJ_LD + C_R + h * HD + fch * 8));
          *(u32x4*)(KBt + row_ * 144 + fch * 16) = *(const u32x4*)(proj + (unsigned)(tk_ * PROJ_LD + C_K + h * HD + fch * 8));
        }
      }
      float ss = 0.f, bs = 0.f; float av[2][16];
#pragma unroll
      for (int mt = 0; mt < 2; ++mt)
#pragma unroll
        for (int g = 0; g < 4; ++g) {
          const int ch = chb + 32 * mt + 8 * g;
          float rv[4], rp[4], kv[4], kq[4];
          ld4((const bf16_t*)(RBt + 144 + cwo + mt * 64 + g * 16), rv); ld4((const bf16_t*)(KBt + 144 + cwo + mt * 64 + g * 16), kv);
          ld4((const bf16_t*)(RBt + cwo + mt * 64 + g * 16), rp); ld4((const bf16_t*)(KBt + cwo + mt * 64 + g * 16), kq);
          const f32x4 mur = *(const f32x4*)(p.shift_mu + C_R + ch), muk = *(const f32x4*)(p.shift_mu + C_K + ch);
          const f32x4 a0v = *(const f32x4*)(p.a0 + ch), kkc = *(const f32x4*)(p.k_k + ch), kac = *(const f32x4*)(p.k_a + ch), rkc = *(const f32x4*)(p.r_k + ch);
          float kp[4];
#pragma unroll
          for (int i = 0; i < 4; ++i) {
            const float a = 1.0f / (1.0f + __expf(-(a0v[i] + acc[mt][4 * g + i])));
            const float r = rv[i] + mur[i] * ((first ? 0.f : rp[i]) - rv[i]);
            const float k = kv[i] + muk[i] * ((first ? 0.f : kq[i]) - kv[i]);
            const float kk = k * kkc[i];
            ss += kk * kk;
            kp[i] = k * (1.0f + (a - 1.0f) * kac[i]);
            bs += r * kp[i] * rkc[i];
            av[mt][4 * g + i] = a;
          }
          *(u32x2*)(OBt + cwo + mt * 64 + g * 16) = pk4(kp[0], kp[1], kp[2], kp[3]);
        }
      P3_FLUSH(ws_kp(p), RW, h * HD);
      __builtin_amdgcn_sched_barrier(0);
      ss = xhalf_sum(ss); bs = xhalf_sum(bs);
      const float inv = 1.0f / fmaxf(sqrtf(ss), 1e-12f);
#pragma unroll
      for (int mt = 0; mt < 2; ++mt)
#pragma unroll
        for (int g = 0; g < 4; ++g) {
          const int ch = chb + 32 * mt + 8 * g;
          float kv[4], kq[4];
          ld4((const bf16_t*)(KBt + 144 + cwo + mt * 64 + g * 16), kv); ld4((const bf16_t*)(KBt + cwo + mt * 64 + g * 16), kq);
          const f32x4 muk = *(const f32x4*)(p.shift_mu + C_K + ch), kkc = *(const f32x4*)(p.k_k + ch);
          float kn[4];
#pragma unroll
          for (int i = 0; i < 4; ++i) { const float kprev = first ? 0.f : kq[i]; kn[i] = (kv[i] + muk[i] * (kprev - kv[i])) * kkc[i] * inv; }
          *(u32x2*)(OBt + cwo + mt * 64 + g * 16) = pk4(kn[0], kn[1], kn[2], kn[3]);
          *(u32x2*)(RBt + cwo + mt * 64 + g * 16) = pk4(kn[0] * av[mt][4 * g], kn[1] * av[mt][4 * g + 1], kn[2] * av[mt][4 * g + 2], kn[3] * av[mt][4 * g + 3]);
        }
      P3_FLUSH(ws_kk(p), RW, h * HD);
      { char* const OBs = OBt; OBt = RBt; P3_FLUSH(ws_bb(p), RW, h * HD); OBt = OBs; }
      if (hi == 0) ws_bonus(p)[gt * NH + h] = bs;
      }
#undef P3_FLUSH
    }
  }
}

DI void phase4a(const Params& p, int bid, int nb, char* lds) {
  const int t = tid_(), i = t >> 3, cg8 = (t & 7) * 8;
  const bf16_t* proj = ws_proj(p);
  for (int task = bid; task < BATCH * NH; task += nb) {
    const int b = task >> 3, h = task & 7;
    const int cbase = h * HD + cg8;
    float mu_r[8], st[8], rprev[8];
#pragma unroll
    for (int j = 0; j < 8; ++j) { mu_r[j] = p.shift_mu[C_R + cbase + j]; st[j] = 0.f; rprev[j] = 0.f; }
    const float mu_v = p.shift_mu[C_V + h * HD + i];
    float vprev = 0.f;
    const size_t tok0 = (size_t)b * SEQ;
    u32x4 n_kk, n_bb, n_kp, n_ee, n_r; bf16_t n_v;
    {
      const size_t g = tok0;
      n_kk = *(const u32x4*)(ws_kk(p) + g * RW + cbase); n_bb = *(const u32x4*)(ws_bb(p) + g * RW + cbase);
      n_kp = *(const u32x4*)(ws_kp(p) + g * RW + cbase); n_ee = *(const u32x4*)(ws_ee(p) + g * RW + cbase);
      n_r = *(const u32x4*)(proj + g * PROJ_LD + C_R + cbase); n_v = proj[g * PROJ_LD + C_V + h * HD + i];
    }
    for (int s = 0; s < SEQ; ++s) {
      const u32x4 c_kk = n_kk, c_bb = n_bb, c_kp = n_kp, c_ee = n_ee, c_r = n_r; const bf16_t c_v = n_v;
      if (s + 1 < SEQ) {
        const size_t g = tok0 + s + 1;
        n_kk = *(const u32x4*)(ws_kk(p) + g * RW + cbase); n_bb = *(const u32x4*)(ws_bb(p) + g * RW + cbase);
        n_kp = *(const u32x4*)(ws_kp(p) + g * RW + cbase); n_ee = *(const u32x4*)(ws_ee(p) + g * RW + cbase);
        n_r = *(const u32x4*)(proj + g * PROJ_LD + C_R + cbase); n_v = proj[g * PROJ_LD + C_V + h * HD + i];
      }
      float kk[8], bb[8], kp[8], ee[8], rr[8];
      unpack8(c_kk, kk); unpack8(c_bb, bb); unpack8(c_kp, kp); unpack8(c_ee, ee); unpack8(c_r, rr);
      const float vraw = bf2f(c_v);
      const float v = vraw + mu_v * (vprev - vraw); vprev = vraw;
      float sa = 0.f;
#pragma unroll
      for (int j = 0; j < 8; ++j) sa += st[j] * kk[j];
      sa += __shfl_xor(sa, 1); sa += __shfl_xor(sa, 2); sa += __shfl_xor(sa, 4);
      sa = -sa;
      float y = 0.f;
#pragma unroll
      for (int j = 0; j < 8; ++j) {
        const float r = rr[j] + mu_r[j] * (rprev[j] - rr[j]); rprev[j] = rr[j];
        const float w = __expf(-ee[j]);
        st[j] = st[j] * w + sa * bb[j] + v * kp[j];
        y += st[j] * r;
      }
      y += __shfl_xor(y, 1); y += __shfl_xor(y, 2); y += __shfl_xor(y, 4);
      if ((t & 7) == 0) ws_y(p)[(tok0 + s) * RW + h * HD + i] = y;
    }
  }
}

DI float dpp_sum16(float v) {
  v += __int_as_float(__builtin_amdgcn_update_dpp(0, __float_as_int(v), 0xB1, 0xF, 0xF, true));
  v += __int_as_float(__builtin_amdgcn_update_dpp(0, __float_as_int(v), 0x4E, 0xF, 0xF, true));
  v += __int_as_float(__builtin_amdgcn_update_dpp(0, __float_as_int(v), 0x141, 0xF, 0xF, true));
  v += __int_as_float(__builtin_amdgcn_update_dpp(0, __float_as_int(v), 0x140, 0xF, 0xF, true));
  return v;
}
constexpr int CK = 16;
constexpr int SC_CH = 16, SC_BUF = 5 * SC_CH * 64 * 4 + SC_CH * 32 * 4 + SC_CH * 8;
DI void phase4a_v2(const Params& p, int bid, int nb, char* lds) {
  const int t = tid_(), rowl = t >> 4, cg = t & 15;
  const bf16_t* proj = ws_proj(p);
  for (int task = bid; task < BATCH * NH * 2; task += nb) {
    const int b = task >> 4, h = (task >> 1) & 7, half = task & 1;
    const size_t tok0 = (size_t)b * SEQ;
    const int sst = t >> 4, scol = h * HD + cg * 4;
    const int vst = t >> 5, vrow = t & 31, vcol = C_V + h * HD + half * 32 + vrow;
    float mur[4];
#pragma unroll
    for (int j = 0; j < 4; ++j) mur[j] = p.shift_mu[C_R + scol + j];
    const float muv = p.shift_mu[vcol];
    u32x2 g_kk, g_bb, g_kp, g_ee, g_r, g_rp; bf16_t g_v, g_vp;
    auto stage_load = [&](int c) {
      if (t < 256) {
        const size_t g = tok0 + c * SC_CH + sst;
        g_kk = *(const u32x2*)(ws_kk(p) + g * RW + scol); g_bb = *(const u32x2*)(ws_bb(p) + g * RW + scol);
        g_kp = *(const u32x2*)(ws_kp(p) + g * RW + scol); g_ee = *(const u32x2*)(ws_ee(p) + g * RW + scol);
        g_r = *(const u32x2*)(proj + g * PROJ_LD + C_R + scol);
        if (c * SC_CH + sst > 0) g_rp = *(const u32x2*)(proj + (g - 1) * PROJ_LD + C_R + scol); else { g_rp.x = 0u; g_rp.y = 0u; }
      }
      const size_t gv = tok0 + c * SC_CH + vst;
      g_v = proj[gv * PROJ_LD + vcol];
      g_vp = (c * SC_CH + vst > 0) ? proj[(gv - 1) * PROJ_LD + vcol] : (bf16_t)0;
    };
    auto stage_write = [&](char* buf) {
      if (t < 256) {
        float* W = (float*)buf + sst * 64 + cg * 4;
        f32x4 o;
        o[0] = __expf(-__uint_as_float(g_ee.x << 16)); o[1] = __expf(-__uint_as_float(g_ee.x & 0xffff0000u));
        o[2] = __expf(-__uint_as_float(g_ee.y << 16)); o[3] = __expf(-__uint_as_float(g_ee.y & 0xffff0000u));
        *(f32x4*)W = o;
        o[0] = __uint_as_float(g_kk.x << 16); o[1] = __uint_as_float(g_kk.x & 0xffff0000u); o[2] = __uint_as_float(g_kk.y << 16); o[3] = __uint_as_float(g_kk.y & 0xffff0000u);
        *(f32x4*)(W + SC_CH * 64) = o;
        o[0] = __uint_as_float(g_bb.x << 16); o[1] = __uint_as_float(g_bb.x & 0xffff0000u); o[2] = __uint_as_float(g_bb.y << 16); o[3] = __uint_as_float(g_bb.y & 0xffff0000u);
        *(f32x4*)(W + 2 * SC_CH * 64) = o;
        o[0] = __uint_as_float(g_kp.x << 16); o[1] = __uint_as_float(g_kp.x & 0xffff0000u); o[2] = __uint_as_float(g_kp.y << 16); o[3] = __uint_as_float(g_kp.y & 0xffff0000u);
        *(f32x4*)(W + 3 * SC_CH * 64) = o;
        float r[4] = {__uint_as_float(g_r.x << 16), __uint_as_float(g_r.x & 0xffff0000u), __uint_as_float(g_r.y << 16), __uint_as_float(g_r.y & 0xffff0000u)};
        float rp[4] = {__uint_as_float(g_rp.x << 16), __uint_as_float(g_rp.x & 0xffff0000u), __uint_as_float(g_rp.y << 16), __uint_as_float(g_rp.y & 0xffff0000u)};
#pragma unroll
        for (int j = 0; j < 4; ++j) o[j] = r[j] + mur[j] * (rp[j] - r[j]);
        *(f32x4*)(W + 4 * SC_CH * 64) = o;
      }
      const float v = bf2f(g_v), vp = bf2f(g_vp);
      ((float*)buf)[5 * SC_CH * 64 + vst * 32 + vrow] = v + muv * (vp - v);
    };
    float st[4] = {0.f, 0.f, 0.f, 0.f};
    __syncthreads();
    stage_load(0); stage_write(lds);
    __syncthreads();
    float* yout = ws_y(p) + tok0 * RW + h * HD + half * 32 + rowl;
    for (int c = 0; c < SEQ / SC_CH; ++c) {
      const char* cur = lds + (c & 1) * SC_BUF;
      if (c + 1 < SEQ / SC_CH) stage_load(c + 1);
      const float* Wb = (const float*)cur + cg * 4;
      const float* Vb = (const float*)cur + 5 * SC_CH * 64 + rowl;
      float yv[SC_CH];
#pragma unroll
      for (int s = 0; s < SC_CH; ++s) {
        const f32x4 w = *(const f32x4*)(Wb + s * 64), kk = *(const f32x4*)(Wb + SC_CH * 64 + s * 64), bb = *(const f32x4*)(Wb + 2 * SC_CH * 64 + s * 64);
        const f32x4 kp = *(const f32x4*)(Wb + 3 * SC_CH * 64 + s * 64), rr = *(const f32x4*)(Wb + 4 * SC_CH * 64 + s * 64);
        const float v = Vb[s * 32];
        float sa = (st[0] * kk[0] + st[1] * kk[1]) + (st[2] * kk[2] + st[3] * kk[3]);
        sa = -dpp_sum16(sa);
#pragma unroll
        for (int j = 0; j < 4; ++j) st[j] = st[j] * w[j] + (sa * bb[j] + v * kp[j]);
        float y = (st[0] * rr[0] + st[1] * rr[1]) + (st[2] * rr[2] + st[3] * rr[3]);
        yv[s] = dpp_sum16(y);
      }
      if (cg == 0) {
#pragma unroll
        for (int s = 0; s < SC_CH; ++s) yout[(size_t)(c * SC_CH + s) * RW] = yv[s];
      }
      if (c + 1 < SEQ / SC_CH) stage_write(lds + ((c + 1) & 1) * SC_BUF);
      __syncthreads();
    }
  }
}

DI void moe_tr_wave(const Params& p, int id, int lane, float* tl  ) {
  const int which = id >> 12, q = id & 4095, e = q >> 7, r = q & 127;
  const float* src; int N, k0, n0;
  if (which < 2) { src = (which == 0 ? p.e_gate : p.e_up) + (size_t)e * 1024 * 512; N = 512; k0 = (r >> 3) * 64; n0 = (r & 7) * 64; }
  else { src = p.e_down + (size_t)e * 512 * 1024; N = 1024; k0 = (r >> 4) * 64; n0 = (r & 15) * 64; }
  const int lr = lane >> 4, lc = (lane & 15) * 4;
  f32x4 g[16];
#pragma unroll
  for (int i = 0; i < 16; ++i) g[i] = *(const f32x4*)(src + (size_t)(k0 + lr + 4 * i) * N + n0 + lc);
#pragma unroll
  for (int i = 0; i < 16; ++i) { float* d = tl + (lr + 4 * i) * 65 + lc; d[0] = g[i][0]; d[1] = g[i][1]; d[2] = g[i][2]; d[3] = g[i][3]; }
  bf16_t* dst;
  { const int n = n0 + lane;
    if (which < 2) dst = ws_wgu(p) + (size_t)e * 1024 * 1024 + (size_t)((n >> 7) * 256 + (n & 127) + which * 128) * 1024 + k0;
    else dst = ws_wd(p) + (size_t)e * 1024 * 512 + (size_t)n * 512 + k0; }
#pragma unroll
  for (int c8 = 0; c8 < 8; ++c8) {
    float v[8];
#pragma unroll
    for (int j = 0; j < 8; ++j) v[j] = tl[(c8 * 8 + j) * 65 + lane];
    u32x4 w; w.x = cvtpk(v[0], v[1]); w.y = cvtpk(v[2], v[3]); w.z = cvtpk(v[4], v[5]); w.w = cvtpk(v[6], v[7]);
    *(u32x4*)(dst + c8 * 8) = w;
  }
}

typedef float f32x2p __attribute__((ext_vector_type(2)));
DI void phase4a_v3(const Params& p, int bid, int nb, char* lds) {
  const int t = tid_(), wid = __builtin_amdgcn_readfirstlane(t >> 6);
  const int rowl = (t >> 3) & 31, cg = t & 7;
  const int pt = t & 255;
  const bf16_t* proj = ws_proj(p);
  for (int task = bid; task < BATCH * NH * 2; task += nb) {
    const int b = task >> 4, h = (task >> 1) & 7, half = task & 1;
    const size_t tok0 = (size_t)b * SEQ;
    const int sst = pt >> 4, scq = pt & 15, scol = h * HD + scq * 4;
    const int vst = pt >> 5, vrow = pt & 31, vcol = C_V + h * HD + half * 32 + vrow;
    float mur[4];
#pragma unroll
    for (int j = 0; j < 4; ++j) mur[j] = p.shift_mu[C_R + scol + j];
    const float muv = p.shift_mu[vcol];
    u32x2 g_kk, g_bb, g_kp, g_ee, g_r, g_rp; bf16_t g_v0, g_v0p, g_v1, g_v1p;
#define SC_LOAD(c_) do { const int c__ = (c_); const size_t g = tok0 + c__ * SC_CH + sst; \
      g_kk = *(const u32x2*)(ws_kk(p) + g * RW + scol); g_bb = *(const u32x2*)(ws_bb(p) + g * RW + scol); \
      g_kp = *(const u32x2*)(ws_kp(p) + g * RW + scol); g_ee = *(const u32x2*)(ws_ee(p) + g * RW + scol); \
      g_r = *(const u32x2*)(proj + g * PROJ_LD + C_R + scol); \
      g_rp = *(const u32x2*)(proj + (g - ((c__ * SC_CH + sst > 0) ? 1 : 0)) * PROJ_LD + C_R + scol); \
      if (c__ * SC_CH + sst == 0) { g_rp.x = 0u; g_rp.y = 0u; } \
      const size_t gv = tok0 + c__ * SC_CH + vst; \
      g_v0 = proj[gv * PROJ_LD + vcol]; g_v0p = (c__ * SC_CH + vst > 0) ? proj[(gv - 1) * PROJ_LD + vcol] : (bf16_t)0; \
      g_v1 = proj[(gv + 8) * PROJ_LD + vcol]; g_v1p = proj[(gv + 7) * PROJ_LD + vcol]; } while (0)
#define SC_WRITE(buf_) do { float* W = (float*)(buf_) + sst * 64 + scq * 4; f32x4 o; \
      o[0] = __expf(-__uint_as_float(g_ee.x << 16)); o[1] = __expf(-__uint_as_float(g_ee.x & 0xffff0000u)); \
      o[2] = __expf(-__uint_as_float(g_ee.y << 16)); o[3] = __expf(-__uint_as_float(g_ee.y & 0xffff0000u)); *(f32x4*)W = o; \
      o[0] = __uint_as_float(g_kk.x << 16); o[1] = __uint_as_float(g_kk.x & 0xffff0000u); o[2] = __uint_as_float(g_kk.y << 16); o[3] = __uint_as_float(g_kk.y & 0xffff0000u); *(f32x4*)(W + SC_CH * 64) = o; \
      o[0] = __uint_as_float(g_bb.x << 16); o[1] = __uint_as_float(g_bb.x & 0xffff0000u); o[2] = __uint_as_float(g_bb.y << 16); o[3] = __uint_as_float(g_bb.y & 0xffff0000u); *(f32x4*)(W + 2 * SC_CH * 64) = o; \
      o[0] = __uint_as_float(g_kp.x << 16); o[1] = __uint_as_float(g_kp.x & 0xffff0000u); o[2] = __uint_as_float(g_kp.y << 16); o[3] = __uint_as_float(g_kp.y & 0xffff0000u); *(f32x4*)(W + 3 * SC_CH * 64) = o; \
      { const float r0 = __uint_as_float(g_r.x << 16), r1 = __uint_as_float(g_r.x & 0xffff0000u), r2 = __uint_as_float(g_r.y << 16), r3 = __uint_as_float(g_r.y & 0xffff0000u); \
        const float q0 = __uint_as_float(g_rp.x << 16), q1 = __uint_as_float(g_rp.x & 0xffff0000u), q2 = __uint_as_float(g_rp.y << 16), q3 = __uint_as_float(g_rp.y & 0xffff0000u); \
        o[0] = r0 + mur[0] * (q0 - r0); o[1] = r1 + mur[1] * (q1 - r1); o[2] = r2 + mur[2] * (q2 - r2); o[3] = r3 + mur[3] * (q3 - r3); \
        const f32x4 wv_ = *(const f32x4*)W, bv_ = *(const f32x4*)(W + 2 * SC_CH * 64), kv_ = *(const f32x4*)(W + 3 * SC_CH * 64); \
        const float br_ = dpp_sum16((bv_[0] * o[0] + bv_[1] * o[1]) + (bv_[2] * o[2] + bv_[3] * o[3])), kr_ = dpp_sum16((kv_[0] * o[0] + kv_[1] * o[1]) + (kv_[2] * o[2] + kv_[3] * o[3])); \
        if (scq == 0) { float* X_ = (float*)(buf_) + 5 * SC_CH * 64 + SC_CH * 32 + sst * 2; X_[0] = br_; X_[1] = kr_; } \
        o[0] *= wv_[0]; o[1] *= wv_[1]; o[2] *= wv_[2]; o[3] *= wv_[3]; *(f32x4*)(W + 4 * SC_CH * 64) = o; } \
      { const float v0 = bf2f(g_v0), v0p = bf2f(g_v0p), v1 = bf2f(g_v1), v1p = bf2f(g_v1p); float* Vw = (float*)(buf_) + 5 * SC_CH * 64 + vst * 32 + vrow; \
        Vw[0] = v0 + muv * (v0p - v0); Vw[8 * 32] = v1 + muv * (v1p - v1); } } while (0)
    f32x2p st2[4];
#pragma unroll
    for (int j = 0; j < 4; ++j) st2[j] = (f32x2p){0.f, 0.f};
    __syncthreads();
    if (wid >= 4) { SC_LOAD(0); SC_WRITE(lds); SC_LOAD(1); }
    __syncthreads();
    float* yout = ws_y(p) + tok0 * RW + h * HD + half * 32 + rowl;
    for (int c = 0; c < SEQ / SC_CH; ++c) {
      const char* cur = lds + (c & 1) * SC_BUF;
      if (wid >= 4) {
        if (c + 1 < SEQ / SC_CH) SC_WRITE(lds + ((c + 1) & 1) * SC_BUF);
        if (c + 2 < SEQ / SC_CH) SC_LOAD(c + 2);
        if ((c & 7) == 3) {
          const int tid_tr = (task * 4 + (wid - 4)) + (BATCH * NH * 2 * 4) * (c >> 3);
          if (tid_tr < 3 * 4096) moe_tr_wave(p, tid_tr, t & 63, (float*)(lds + 2 * SC_BUF + 128) + (wid - 4) * (64 * 65));
        }
      } else {
        const float* Wb = (const float*)cur + cg * 8;
        const float* Vb = (const float*)cur + 5 * SC_CH * 64 + rowl;
        float yv[SC_CH];
#pragma unroll
        for (int s = 0; s < SC_CH; ++s) {
          const f32x4 w0 = *(const f32x4*)(Wb + s * 64), w1 = *(const f32x4*)(Wb + s * 64 + 4);
          const f32x4 k0 = *(const f32x4*)(Wb + SC_CH * 64 + s * 64), k1 = *(const f32x4*)(Wb + SC_CH * 64 + s * 64 + 4);
          const f32x4 b0 = *(const f32x4*)(Wb + 2 * SC_CH * 64 + s * 64), b1 = *(const f32x4*)(Wb + 2 * SC_CH * 64 + s * 64 + 4);
          const f32x4 p0 = *(const f32x4*)(Wb + 3 * SC_CH * 64 + s * 64), p1 = *(const f32x4*)(Wb + 3 * SC_CH * 64 + s * 64 + 4);
          const f32x4 r0 = *(const f32x4*)(Wb + 4 * SC_CH * 64 + s * 64), r1 = *(const f32x4*)(Wb + 4 * SC_CH * 64 + s * 64 + 4);
          const float v = Vb[s * 32];
#define LO2(x) __builtin_shufflevector(x, x, 0, 1)
#define HI2(x) __builtin_shufflevector(x, x, 2, 3)
          const f32x2p xs = *(const f32x2p*)((const float*)cur + 5 * SC_CH * 64 + SC_CH * 32 + s * 2);
          f32x2p sa2 = st2[0] * LO2(k0), yd2 = st2[0] * LO2(r0);
          sa2 = st2[1] * HI2(k0) + sa2; yd2 = st2[1] * HI2(r0) + yd2;
          sa2 = st2[2] * LO2(k1) + sa2; yd2 = st2[2] * LO2(r1) + yd2;
          sa2 = st2[3] * HI2(k1) + sa2; yd2 = st2[3] * HI2(r1) + yd2;
          const float sa = -dpp_sum8(sa2[0] + sa2[1]);
          const float yd = dpp_sum8(yd2[0] + yd2[1]);
          yv[s] = yd + sa * xs[0] + v * xs[1];
          const f32x2p sav = {sa, sa}, vv = {v, v};
          st2[0] = st2[0] * LO2(w0) + (sav * LO2(b0) + vv * LO2(p0));
          st2[1] = st2[1] * HI2(w0) + (sav * HI2(b0) + vv * HI2(p0));
          st2[2] = st2[2] * LO2(w1) + (sav * LO2(b1) + vv * LO2(p1));
          st2[3] = st2[3] * HI2(w1) + (sav * HI2(b1) + vv * HI2(p1));
#undef LO2
#undef HI2
        }
        if (cg == 0) {
#pragma unroll
          for (int s = 0; s < SC_CH; ++s) yout[(size_t)(c * SC_CH + s) * RW] = yv[s];
        }
      }
      __syncthreads();
    }
#undef SC_LOAD
#undef SC_WRITE
  }
}

DI void moe_tr_small(const Params& p, int id, int lane, float* tl  ) {
  const int which = id >> 14, r_ = id & 16383, e = r_ >> 9, rr = r_ & 511;
  const float* src; int N, k0, n0;
  if (which < 2) { src = (which == 0 ? p.e_gate : p.e_up) + (size_t)e * 1024 * 512; N = 512; k0 = (rr >> 5) * 64; n0 = (rr & 31) * 16; }
  else { src = p.e_down + (size_t)e * 512 * 1024; N = 1024; k0 = (rr >> 6) * 64; n0 = (rr & 63) * 16; }
  const float* sp = src + (size_t)(k0 + lane) * N + n0;
  const f32x4 g0 = *(const f32x4*)sp, g1 = *(const f32x4*)(sp + 4), g2 = *(const f32x4*)(sp + 8), g3 = *(const f32x4*)(sp + 12);
  float* d = tl + lane * 17;
  d[0] = g0[0]; d[1] = g0[1]; d[2] = g0[2]; d[3] = g0[3]; d[4] = g1[0]; d[5] = g1[1]; d[6] = g1[2]; d[7] = g1[3];
  d[8] = g2[0]; d[9] = g2[1]; d[10] = g2[2]; d[11] = g2[3]; d[12] = g3[0]; d[13] = g3[1]; d[14] = g3[2]; d[15] = g3[3];
  const int nn = lane & 15, kq = lane >> 4;
  float v[16];
#pragma unroll
  for (int i = 0; i < 16; ++i) v[i] = tl[(kq * 16 + i) * 17 + nn];
  u32x4 w0, w1;
  w0.x = cvtpk(v[0], v[1]); w0.y = cvtpk(v[2], v[3]); w0.z = cvtpk(v[4], v[5]); w0.w = cvtpk(v[6], v[7]);
  w1.x = cvtpk(v[8], v[9]); w1.y = cvtpk(v[10], v[11]); w1.z = cvtpk(v[12], v[13]); w1.w = cvtpk(v[14], v[15]);
  const int n = n0 + nn;
  bf16_t* dst;
  if (which < 2) dst = ws_wgu(p) + (size_t)e * 1024 * 1024 + (size_t)((n >> 7) * 256 + (n & 127) + which * 128) * 1024 + k0 + kq * 16;
  else dst = ws_wd(p) + (size_t)e * 1024 * 512 + (size_t)n * 512 + k0 + kq * 16;
  *(u32x4*)dst = w0; *(u32x4*)(dst + 8) = w1;
}

constexpr int CS_PSZ = 23552, CS_SLSZ = 13312, CS_SL0 = 4 * CS_PSZ, CS_CON = CS_SL0 + 4 * CS_SLSZ;
DI f32x4v cs_mm16(const float* A, int sam, int sak, const float* B, int sbk, int sbn, f32x4v c, int l16, int g) {
#pragma unroll
  for (int q = 0; q < 4; ++q) c = __builtin_amdgcn_mfma_f32_16x16x4f32(A[l16 * sam + (4 * q + g) * sak], B[(4 * q + g) * sbk + l16 * sbn], c, 0, 0, 0);
  return c;
}
DI void cs_st16(float* D, f32x4v c, int l16, int g) {
#pragma unroll
  for (int r = 0; r < 4; ++r) D[(4 * g + r) * 16 + l16] = c[r];
}
DI f32x4v cs_ld16(const float* D, int l16, int g) { f32x4v c;
#pragma unroll
  for (int r = 0; r < 4; ++r) c[r] = D[(4 * g + r) * 16 + l16];
  return c; }
DI void cs_st4(bf16_t* base, int ld, f32x4v c) {
  const unsigned p01 = cvtpk(c[0] + 0.0f, c[1] + 0.0f), p23 = cvtpk(c[2] + 0.0f, c[3] + 0.0f);
  base[0] = (bf16_t)p01; base[ld] = (bf16_t)(p01 >> 16); base[2 * ld] = (bf16_t)p23; base[3 * ld] = (bf16_t)(p23 >> 16);
}
constexpr int CS_FLG = CS_CON + 6144 + 2 * 64 * 17 * 4;
DI void cs_wait(volatile int* f, int v) {
  while (__builtin_amdgcn_readfirstlane(*f) < v) __builtin_amdgcn_s_sleep(2);
  __builtin_amdgcn_fence(__ATOMIC_ACQUIRE, "workgroup");
}
DI void cs_post(volatile int* f, int v, int lane) {
  __builtin_amdgcn_fence(__ATOMIC_RELEASE, "workgroup");
  if (lane == 0) *f = v;
}
static_assert(CS_FLG + 48 <= LDS_BYTES - 64, "chunked scan LDS map");
#define CS_LAS __attribute__((address_space(3)))
DI void phase4a_chunk(const Params& p, int bid, int nb, char* lds) {
  const int t = tid_(), wid = __builtin_amdgcn_readfirstlane(t >> 6), lane = t & 63, l16 = lane & 15, g = lane >> 4;
  const bf16_t* proj = ws_proj(p);
  const f32x4v z4 = {0.f, 0.f, 0.f, 0.f};
  const bf16x8 zf = {0, 0, 0, 0, 0, 0, 0, 0};
  volatile int* fl_ready = (volatile int*)(lds + CS_FLG); volatile int* fl_done = fl_ready + 4;
  if (t < 12) fl_ready[t] = 0;
  int seq0 = 0;
  for (int task = bid; task < BATCH * NH * 2; task += nb, seq0 += SEQ / CK / 4) {
    const int b = task >> 4, h = (task >> 1) & 7, half = task & 1;
    const int tok0 = b * SEQ;
    f32x4v Sacc[4] = {z4, z4, z4, z4};
    char* Sb = lds + CS_CON; char* Ub = Sb + 4608;
    const int i0 = (wid & 1) * 16;
    __syncthreads();
    if (wid < 2) { for (int i = lane; i < 16 * 144 / 4; i += 64) ((unsigned*)(Sb + i0 * 144))[i] = 0u; }
    for (int rnd = 0; rnd < SEQ / CK / 4; ++rnd) {
      if (wid >= 4) {
        const int pw = wid - 4, c = rnd * 4 + pw, ct0 = tok0 + c * CK;
        char* ps = lds + pw * CS_PSZ;
        bf16_t* AB = (bf16_t*)ps; bf16_t* BT = AB + 16 * 72; bf16_t* KT = BT + 16 * 72; bf16_t* RB = KT + 16 * 72;
        float* KHT = (float*)(ps + 9216);
        float* Nf = (float*)(ps + 13312); float* AKB = Nf + 256; float* ABR = AKB + 256; float* AKR = ABR + 256;
        float* T0 = AKR + 256; float* T1 = Nf; float* Pm = T0 + 256; float* Mm = Pm + 256;
        bf16_t* ABT = (bf16_t*)(Mm + 256);
        bf16_t* APb = (bf16_t*)BT;
        bf16_t* MTb = (bf16_t*)KT;
        bf16_t* W1b = MTb + 16 * 24;
        bf16_t* ABRT = W1b + 16 * 24;
        char* sl = lds + CS_SL0 + pw * CS_SLSZ;
        bf16_t* QT = (bf16_t*)sl; bf16_t* APT = QT + 16 * 72; bf16_t* BHT = APT + 16 * 72; bf16_t* GGT = BHT + 64 * 24; bf16_t* HT = GGT + 64 * 24; bf16_t* VT = HT + 16 * 24;
        float* GAM = (float*)(sl + 2304 * 2 + 3072 * 2 + 768 + 1536);
        u32x4 bhw0, bhw1, vw; float gamC;
        {
          const int j = lane, col = h * HD + j;
          float cum[CK], kkv[CK], bev[CK], kpv[CK], rv[CK];
          const float mur = p.shift_mu[C_R + col];
          {
            CS_LAS char* rawl = (CS_LAS char*)(ps + 13312);
            const unsigned ro = (unsigned)((ct0 + (lane >> 3)) * RW + h * HD + (lane & 7) * 8) * 2u;
            const unsigned rp = (unsigned)((ct0 + (lane >> 3)) * PROJ_LD + C_R + h * HD + (lane & 7) * 8) * 2u;
            __builtin_amdgcn_global_load_lds((const unsigned*)((const char*)ws_ee(p) + ro), (CS_LAS unsigned*)(rawl), 16, 0, 0);
            __builtin_amdgcn_global_load_lds((const unsigned*)((const char*)ws_ee(p) + ro + 8 * RW * 2), (CS_LAS unsigned*)(rawl + 1024), 16, 0, 0);
            __builtin_amdgcn_global_load_lds((const unsigned*)((const char*)ws_kk(p) + ro), (CS_LAS unsigned*)(rawl + 2048), 16, 0, 0);
            __builtin_amdgcn_global_load_lds((const unsigned*)((const char*)ws_kk(p) + ro + 8 * RW * 2), (CS_LAS unsigned*)(rawl + 3072), 16, 0, 0);
            __builtin_amdgcn_global_load_lds((const unsigned*)((const char*)ws_bb(p) + ro), (CS_LAS unsigned*)(rawl + 4096), 16, 0, 0);
            __builtin_amdgcn_global_load_lds((const unsigned*)((const char*)ws_bb(p) + ro + 8 * RW * 2), (CS_LAS unsigned*)(rawl + 5120), 16, 0, 0);
            __builtin_amdgcn_global_load_lds((const unsigned*)((const char*)ws_kp(p) + ro), (CS_LAS unsigned*)(rawl + 6144), 16, 0, 0);
            __builtin_amdgcn_global_load_lds((const unsigned*)((const char*)ws_kp(p) + ro + 8 * RW * 2), (CS_LAS unsigned*)(rawl + 7168), 16, 0, 0);
            __builtin_amdgcn_global_load_lds((const unsigned*)((const char*)proj + rp), (CS_LAS unsigned*)(rawl + 8192), 16, 0, 0);
            __builtin_amdgcn_global_load_lds((const unsigned*)((const char*)proj + rp + 8 * PROJ_LD * 2), (CS_LAS unsigned*)(rawl + 9216), 16, 0, 0);
          }
          float rprev = (c * CK > 0) ? bf2f(proj[(size_t)(ct0 - 1) * PROJ_LD + C_R + col]) : 0.f;
          asm volatile("s_waitcnt vmcnt(0)" ::: "memory");
          const bf16_t* RAW = (const bf16_t*)(ps + 13312);
          float run = 0.f;
#pragma unroll
          for (int tt = 0; tt < CK; ++tt) {
            run += bf2f(RAW[tt * 64 + j]); cum[tt] = run;
            kkv[tt] = bf2f(RAW[1024 + tt * 64 + j]); bev[tt] = bf2f(RAW[2048 + tt * 64 + j]); kpv[tt] = bf2f(RAW[3072 + tt * 64 + j]);
            const float rr = bf2f(RAW[4096 + tt * 64 + j]);
            rv[tt] = rr + mur * (rprev - rr); rprev = rr;
          }
          const float cumC = cum[CK - 1];
          gamC = __expf(-cumC);
          u32x4 bh0, bh1; float bhv[CK], abv[CK], btv[CK], ktv[CK], rbv[CK];
          float gprev = 1.0f;
#pragma unroll
          for (int tt = 0; tt < CK; ++tt) {
            const float gt_ = __expf(-cum[tt]), gin = __builtin_amdgcn_rcpf(gt_), gh = gamC * gin;
            abv[tt] = -gprev * kkv[tt]; gprev = gt_;
            btv[tt] = bev[tt] * gin; ktv[tt] = kpv[tt] * gin; rbv[tt] = gt_ * rv[tt];
            bhv[tt] = bev[tt] * gh;
            KHT[j * 16 + tt] = kpv[tt] * gh;
          }
#pragma unroll
          for (int tt = 0; tt < CK; tt += 2) {
            const unsigned pa = cvtpk(abv[tt], abv[tt + 1]), pb = cvtpk(btv[tt], btv[tt + 1]), pk = cvtpk(ktv[tt], ktv[tt + 1]), pr = cvtpk(rbv[tt], rbv[tt + 1]);
            AB[tt * 72 + j] = (bf16_t)pa; AB[(tt + 1) * 72 + j] = (bf16_t)(pa >> 16);
            BT[tt * 72 + j] = (bf16_t)pb; BT[(tt + 1) * 72 + j] = (bf16_t)(pb >> 16);
            KT[tt * 72 + j] = (bf16_t)pk; KT[(tt + 1) * 72 + j] = (bf16_t)(pk >> 16);
            RB[tt * 72 + j] = (bf16_t)pr; RB[(tt + 1) * 72 + j] = (bf16_t)(pr >> 16);
          }
          bhw0.x = cvtpk(bhv[0], bhv[1]); bhw0.y = cvtpk(bhv[2], bhv[3]); bhw0.z = cvtpk(bhv[4], bhv[5]); bhw0.w = cvtpk(bhv[6], bhv[7]);
          bhw1.x = cvtpk(bhv[8], bhv[9]); bhw1.y = cvtpk(bhv[10], bhv[11]); bhw1.z = cvtpk(bhv[12], bhv[13]); bhw1.w = cvtpk(bhv[14], bhv[15]);
          bh0.x = cvtpk(abv[0], abv[1]); bh0.y = cvtpk(abv[2], abv[3]); bh0.z = cvtpk(abv[4], abv[5]); bh0.w = cvtpk(abv[6], abv[7]);
          bh1.x = cvtpk(abv[8], abv[9]); bh1.y = cvtpk(abv[10], abv[11]); bh1.z = cvtpk(abv[12], abv[13]); bh1.w = cvtpk(abv[14], abv[15]);
          *(u32x4*)(ABT + j * 24) = bh0; *(u32x4*)(ABT + j * 24 + 8) = bh1;
          const int vi = lane & 31, sh = lane >> 5, vcol = C_V + h * HD + half * 32 + vi;
          const float muv = p.shift_mu[vcol];
          float vprev = (c * CK + sh * 8 > 0) ? bf2f(proj[(size_t)(ct0 + sh * 8 - 1) * PROJ_LD + vcol]) : 0.f;
          float vv[8];
#pragma unroll
          for (int q = 0; q < 8; ++q) { const float vr = bf2f(proj[(size_t)(ct0 + sh * 8 + q) * PROJ_LD + vcol]); vv[q] = vr + muv * (vprev - vr); vprev = vr; }
          vw.x = cvtpk(vv[0], vv[1]); vw.y = cvtpk(vv[2], vv[3]); vw.z = cvtpk(vv[4], vv[5]); vw.w = cvtpk(vv[6], vv[7]);
        }
        {
          bf16x8 fb[2], fk[2], fa[2], fr[2];
#pragma unroll
          for (int ks = 0; ks < 2; ++ks) { const int off = l16 * 72 + 8 * g + 32 * ks;
            fb[ks] = *(const bf16x8*)(BT + off); fk[ks] = *(const bf16x8*)(KT + off); fa[ks] = *(const bf16x8*)(AB + off); fr[ks] = *(const bf16x8*)(RB + off); }
          f32x4v n_ = z4, akb = z4, abr = z4, akr = z4;
#pragma unroll
          for (int ks = 0; ks < 2; ++ks) {
            n_ = __builtin_amdgcn_mfma_f32_16x16x32_bf16(fb[ks], fa[ks], n_, 0, 0, 0);
            akb = __builtin_amdgcn_mfma_f32_16x16x32_bf16(fk[ks], fa[ks], akb, 0, 0, 0);
            abr = __builtin_amdgcn_mfma_f32_16x16x32_bf16(fb[ks], fr[ks], abr, 0, 0, 0);
            akr = __builtin_amdgcn_mfma_f32_16x16x32_bf16(fk[ks], fr[ks], akr, 0, 0, 0);
          }
#pragma unroll
          for (int r = 0; r < 4; ++r) { const int s_ = 4 * g + r, t_ = l16;
            Nf[s_ * 16 + t_] = (s_ < t_) ? n_[r] : 0.f; AKB[s_ * 16 + t_] = (s_ < t_) ? akb[r] : 0.f;
            ABR[s_ * 16 + t_] = (s_ <= t_) ? abr[r] : 0.f; AKR[s_ * 16 + t_] = (s_ <= t_) ? akr[r] : 0.f;
            Pm[s_ * 16 + t_] = ((s_ < t_) ? n_[r] : 0.f) + ((s_ == t_) ? 1.0f : 0.f); }
          { const int t_ = l16; float a4[4];
#pragma unroll
            for (int r = 0; r < 4; ++r) a4[r] = (4 * g + r <= t_) ? abr[r] : 0.f;
            *(u32x2*)(ABRT + t_ * 24 + 4 * g) = pk4(a4[0], a4[1], a4[2], a4[3]); }
        }
        {
          f32x4v c_;
          c_ = cs_mm16(Nf, 16, 1, Nf, 16, 1, z4, l16, g); cs_st16(T0, c_, l16, g);
          c_ = cs_mm16(Pm, 16, 1, T0, 16, 1, cs_ld16(Pm, l16, g), l16, g); cs_st16(Pm, c_, l16, g);
          c_ = cs_mm16(T0, 16, 1, T0, 16, 1, z4, l16, g); cs_st16(T1, c_, l16, g);
          c_ = cs_mm16(Pm, 16, 1, T1, 16, 1, cs_ld16(Pm, l16, g), l16, g); cs_st16(Pm, c_, l16, g);
          c_ = cs_mm16(T1, 16, 1, T1, 16, 1, z4, l16, g); cs_st16(T0, c_, l16, g);
          c_ = cs_mm16(Pm, 16, 1, T0, 16, 1, cs_ld16(Pm, l16, g), l16, g); cs_st16(Mm, c_, l16, g);
          *(u32x2*)(MTb + l16 * 24 + 4 * g) = pk4(c_[0] + 0.0f, c_[1] + 0.0f, c_[2] + 0.0f, c_[3] + 0.0f);
          f32x4v w_ = z4;
#pragma unroll
          for (int q = 0; q < 4; ++q) w_ = __builtin_amdgcn_mfma_f32_16x16x4f32(Mm[(4 * q + g) * 16 + l16], AKB[l16 * 16 + 4 * q + g], w_, 0, 0, 0);
          *(u32x2*)(W1b + l16 * 24 + 4 * g) = pk4(w_[0] + 0.0f, w_[1] + 0.0f, w_[2] + 0.0f, w_[3] + 0.0f);
        }
        cs_wait(fl_done + pw, seq0 + rnd); cs_wait(fl_done + 4 + pw, seq0 + rnd);
        *(u32x4*)(BHT + lane * 24) = bhw0; *(u32x4*)(BHT + lane * 24 + 8) = bhw1;
        GAM[lane] = gamC;
        *(u32x4*)(VT + (lane & 31) * 24 + (lane >> 5) * 8) = vw;
        {
          const bf16x8 mF = (g < 2) ? *(const bf16x8*)(MTb + l16 * 24 + 8 * g) : zf;
          const bf16x8 rF = (g < 2) ? *(const bf16x8*)(ABRT + l16 * 24 + 8 * g) : zf;
          const bf16x8 wF = (g < 2) ? *(const bf16x8*)(W1b + l16 * 24 + 8 * g) : zf;
#pragma unroll
          for (int nt = 0; nt < 4; ++nt) {
            const bf16x8 bF = (g < 2) ? *(const bf16x8*)(ABT + (16 * nt + l16) * 24 + 8 * g) : zf;
            const f32x4v c_ = __builtin_amdgcn_mfma_f32_16x16x32_bf16(mF, bF, z4, 0, 0, 0);
            cs_st4(APT + (4 * g) * 72 + 16 * nt + l16, 72, c_);
            *(u32x2*)(APb + (16 * nt + l16) * 24 + 4 * g) = pk4(c_[0] + 0.0f, c_[1] + 0.0f, c_[2] + 0.0f, c_[3] + 0.0f);
          }
#pragma unroll
          for (int nt = 0; nt < 4; ++nt) {
            f32x4v c_;
#pragma unroll
            for (int r = 0; r < 4; ++r) c_[r] = bf2f(RB[(4 * g + r) * 72 + 16 * nt + l16]);
            const bf16x8 bF = (g < 2) ? *(const bf16x8*)(APb + (16 * nt + l16) * 24 + 8 * g) : zf;
            c_ = __builtin_amdgcn_mfma_f32_16x16x32_bf16(rF, bF, c_, 0, 0, 0);
            cs_st4(QT + (4 * g) * 72 + 16 * nt + l16, 72, c_);
          }
          {
            f32x4v c_;
#pragma unroll
            for (int r = 0; r < 4; ++r) c_[r] = AKR[l16 * 16 + 4 * g + r];
            c_ = __builtin_amdgcn_mfma_f32_16x16x32_bf16(rF, wF, c_, 0, 0, 0);
            cs_st4(HT + (4 * g) * 24 + l16, 24, c_);
          }
#pragma unroll
          for (int mt = 0; mt < 4; ++mt) {
            f32x4v c_;
#pragma unroll
            for (int r = 0; r < 4; ++r) c_[r] = KHT[(16 * mt + 4 * g + r) * 16 + l16];
            const bf16x8 aF = (g < 2) ? *(const bf16x8*)(BHT + (16 * mt + l16) * 24 + 8 * g) : zf;
            c_ = __builtin_amdgcn_mfma_f32_16x16x32_bf16(aF, wF, c_, 0, 0, 0);
            cs_st4(GGT + (16 * mt + 4 * g) * 24 + l16, 24, c_);
          }
        }
        cs_post(fl_ready + pw, seq0 + rnd + 1, lane);
      }
      else if (wid >= 2) {
        float* tl = (float*)(lds + CS_CON + 6144) + (wid - 2) * (64 * 17);
#pragma unroll 1
        for (int q = 0; q < 3; ++q) moe_tr_small(p, ((task * 2 + (wid - 2)) * 96 + rnd * 3 + q), lane, tl);
      }
      else {
#pragma unroll 1
        for (int k = 0; k < 4; ++k) {
          const char* sl = lds + CS_SL0 + k * CS_SLSZ;
          cs_wait(fl_ready + k, seq0 + rnd + 1);
          const bf16_t* QT = (const bf16_t*)sl; const bf16_t* APT = QT + 16 * 72; const bf16_t* BHT = APT + 16 * 72; const bf16_t* GGT = BHT + 64 * 24; const bf16_t* HT = GGT + 64 * 24; const bf16_t* VT = HT + 16 * 24;
          const float* GAM = (const float*)(sl + 2304 * 2 + 3072 * 2 + 768 + 1536);
          bf16x8 sA[2], qF[2], aF[2];
#pragma unroll
          for (int ks = 0; ks < 2; ++ks) { sA[ks] = *(const bf16x8*)(Sb + (i0 + l16) * 144 + (8 * g + 32 * ks) * 2);
            qF[ks] = *(const bf16x8*)(QT + l16 * 72 + 8 * g + 32 * ks); aF[ks] = *(const bf16x8*)(APT + l16 * 72 + 8 * g + 32 * ks); }
          const bf16x8 vF = (g < 2) ? *(const bf16x8*)(VT + (i0 + l16) * 24 + 8 * g) : zf;
          const bf16x8 hF = (g < 2) ? *(const bf16x8*)(HT + l16 * 24 + 8 * g) : zf;
          f32x4v yT = z4;
          yT = __builtin_amdgcn_mfma_f32_16x16x32_bf16(qF[0], sA[0], yT, 0, 0, 0);
          yT = __builtin_amdgcn_mfma_f32_16x16x32_bf16(qF[1], sA[1], yT, 0, 0, 0);
          yT = __builtin_amdgcn_mfma_f32_16x16x32_bf16(hF, vF, yT, 0, 0, 0);
          {
            float* yo = ws_y(p) + (size_t)(tok0 + (rnd * 4 + k) * CK + 4 * g) * RW + h * HD + half * 32 + i0 + l16;
#pragma unroll
            for (int r = 0; r < 4; ++r) yo[(size_t)r * RW] = yT[r];
          }
          f32x4v u = z4;
          u = __builtin_amdgcn_mfma_f32_16x16x32_bf16(sA[0], aF[0], u, 0, 0, 0);
          u = __builtin_amdgcn_mfma_f32_16x16x32_bf16(sA[1], aF[1], u, 0, 0, 0);
          cs_st4((bf16_t*)(Ub + (i0 + 4 * g) * 48 + l16 * 2), 24, u);
          const bf16x8 uF = (g < 2) ? *(const bf16x8*)(Ub + (i0 + l16) * 48 + 16 * g) : zf;
#pragma unroll
          for (int nt = 0; nt < 4; ++nt) {
            const float gm = GAM[16 * nt + l16];
            const bf16x8 bF = (g < 2) ? *(const bf16x8*)(BHT + (16 * nt + l16) * 24 + 8 * g) : zf;
            const bf16x8 gF = (g < 2) ? *(const bf16x8*)(GGT + (16 * nt + l16) * 24 + 8 * g) : zf;
            f32x4v a_ = Sacc[nt] * gm;
            a_ = __builtin_amdgcn_mfma_f32_16x16x32_bf16(uF, bF, a_, 0, 0, 0);
            a_ = __builtin_amdgcn_mfma_f32_16x16x32_bf16(vF, gF, a_, 0, 0, 0);
            Sacc[nt] = a_;
            cs_st4((bf16_t*)(Sb + (i0 + 4 * g) * 144 + (16 * nt + l16) * 2), 72, a_);
          }
          cs_post(fl_done + wid * 4 + k, seq0 + rnd + 1, lane);
        }
      }
    }
  }
  __syncthreads();
}

DI unsigned fkey(float f) { const unsigned u = __float_as_uint(f); return (u & 0x80000000u) ? ~u : (u | 0x80000000u); }
DI int block_sum_i(int v, int* red, int wid, int lane) {
  for (int o = 32; o; o >>= 1) v += __shfl_xor(v, o);
  __syncthreads();
  if (lane == 0) red[wid] = v;
  __syncthreads();
  int s = 0;
#pragma unroll
  for (int w = 0; w < 8; ++w) s += red[w];
  return s;
}
DI void phase4b(const Params& p, int bid, int nb, char* lds) {
  const int t = tid_(), lane = t & 63, wid = t >> 6;
  float* qf = (float*)lds;
  float* wi = qf + 256;
  int* red = (int*)(wi + 4);
  int* wtie = red + 8;
  const bf16_t* proj = ws_proj(p);
  for (int gq = bid; gq < NTOK; gq += nb) {
    const int b = gq >> 11, s = gq & (SEQ - 1);
    const int n = ((s >> 6) + 1) * 64;
    unsigned* mrow = ws_mask(p) + (size_t)gq * 64;
    if (n <= 256) {
      if (t < 64) mrow[t] = (t * 32 < n) ? 0xffffffffu : 0u;
      continue;
    }
    __syncthreads();
    if (t < 256) qf[t] = bf2f(proj[(size_t)gq * PROJ_LD + C_QI + t]) * 0.125f;
    else if (t < 260) wi[t - 256] = bf2f(proj[(size_t)gq * PROJ_LD + C_WI + t - 256]) * 0.5f;
    __syncthreads();
    unsigned uk[4];
#pragma unroll 1
    for (int q = 0; q < 4; ++q) {
      const int key = t * 4 + q;
      uk[q] = 0u;
      if (key < n) {
        float kf[64];
        const bf16_t* kr = ws_kidx(p) + ((size_t)b * SEQ + key) * 64;
#pragma unroll
        for (int d8 = 0; d8 < 8; ++d8) load8(kr + d8 * 8, kf + d8 * 8);
        float sc = 0.f;
#pragma unroll
        for (int hh = 0; hh < 4; ++hh) {
          float dot = 0.f;
#pragma unroll
          for (int d4 = 0; d4 < 16; ++d4) { const f32x4 qv = *(const f32x4*)(qf + hh * 64 + d4 * 4); dot += qv[0] * kf[d4 * 4] + qv[1] * kf[d4 * 4 + 1] + qv[2] * kf[d4 * 4 + 2] + qv[3] * kf[d4 * 4 + 3]; }
          sc += wi[hh] * fmaxf(dot, 0.f);
        }
        sc = sc + 0.0f;
        uk[q] = fkey(sc);
      }
    }
    unsigned T = 0u;
    for (int bit = 31; bit >= 0; --bit) {
      const unsigned cand = T | (1u << bit);
      const int c = (uk[0] >= cand) + (uk[1] >= cand) + (uk[2] >= cand) + (uk[3] >= cand);
      if (block_sum_i(c, red, wid, lane) >= 256) T = cand;
    }
    const int cgt = block_sum_i((uk[0] > T) + (uk[1] > T) + (uk[2] > T) + (uk[3] > T), red, wid, lane);
    const int need = 256 - cgt;
    const int tl = (uk[0] == T) + (uk[1] == T) + (uk[2] == T) + (uk[3] == T);
    int incl = tl;
    for (int o = 1; o < 64; o <<= 1) { const int u = __shfl_up(incl, o); if (lane >= o) incl += u; }
    __syncthreads();
    if (lane == 63) wtie[wid] = incl;
    __syncthreads();
    int before = incl - tl;
    for (int w = 0; w < wid; ++w) before += wtie[w];
    unsigned nib = 0u;
#pragma unroll
    for (int q = 0; q < 4; ++q) {
      bool sel = uk[q] > T;
      if (uk[q] == T) { sel = before < need; ++before; }
      if (sel) nib |= 1u << q;
    }
    unsigned word = nib << ((lane & 7) * 4);
    word |= __shfl_xor(word, 1); word |= __shfl_xor(word, 2); word |= __shfl_xor(word, 4);
    if ((lane & 7) == 0) mrow[t >> 3] = word;
  }
}

constexpr int IDX_LD = 2052;
DI void phase4b_mfma(const Params& p, int bid, int nb, char* lds) {
  const int t = tid_(), lane = t & 63, wid = t >> 6, q16 = lane & 15, g = lane >> 4;
  unsigned* S = (unsigned*)lds;
  const bf16_t* proj = ws_proj(p);
  for (int task = bid; task < NTOK / 16; task += nb) {
    const int b = (task & 255) >> 4, jq = task & 15, kq = task >> 8;
    const int q0 = (((kq & 1) ? 31 - jq : jq) + 32 * (kq >> 1)) * 16;
    const int n = ((q0 >> 6) + 1) * 64, ntile = n >> 4;
    if (n <= 256) {
      unsigned short* mrow = (unsigned short*)(ws_mask(p) + (size_t)(b * SEQ + q0 + q16) * 64);
      if (g == 0) for (int kt = wid; kt < ntile; kt += 8) mrow[kt] = 0xffffu;
      continue;
    }
    const int gq = b * SEQ + q0 + q16;
    const int ntw = (ntile - wid + 7) >> 3;
    const bf16_t* kbase = ws_kidx(p) + (size_t)b * SEQ * 64 + (wid * 16 + q16) * 64 + g * 8;
    bf16x8 qf[4][2]; float wq[4];
#pragma unroll
    for (int h = 0; h < 4; ++h) {
#pragma unroll
      for (int ks = 0; ks < 2; ++ks) qf[h][ks] = *(const bf16x8*)(proj + (size_t)gq * PROJ_LD + C_QI + h * 64 + ks * 32 + g * 8);
      wq[h] = bf2f(proj[(size_t)gq * PROJ_LD + C_WI + h]) * 0.0625f;
    }
    __syncthreads();
    bf16x8 k0 = *(const bf16x8*)kbase, k1 = *(const bf16x8*)(kbase + 32);
#pragma unroll
    for (int tt = 0; tt < 16; ++tt) {
      if (tt < ntw) {
        const bf16x8 c0 = k0, c1 = k1;
        if (tt + 1 < ntw) { int koff = (tt + 1) * 8 * 16 * 64; asm volatile("" : "+v"(koff)); k0 = *(const bf16x8*)(kbase + koff); k1 = *(const bf16x8*)(kbase + koff + 32); }
        float sc[4] = {0.f, 0.f, 0.f, 0.f};
#pragma unroll
        for (int h = 0; h < 4; ++h) {
          f32x4v acc = {0.f, 0.f, 0.f, 0.f};
          acc = __builtin_amdgcn_mfma_f32_16x16x32_bf16(c0, qf[h][0], acc, 0, 0, 0);
          acc = __builtin_amdgcn_mfma_f32_16x16x32_bf16(c1, qf[h][1], acc, 0, 0, 0);
#pragma unroll
          for (int r = 0; r < 4; ++r) sc[r] += wq[h] * fmaxf(acc[r], 0.f);
        }
        u32x4 kv;
#pragma unroll
        for (int r = 0; r < 4; ++r) {
          const unsigned bts = __float_as_uint(sc[r]);
          unsigned key = bts ^ ((unsigned)((int)bts >> 31) | 0x80000000u);
          key += (key == 0x7fffffffu) ? 1u : 0u;
          kv[r] = key;
        }
        *(u32x4*)(S + q16 * IDX_LD + (wid + 8 * tt) * 16 + 4 * g) = kv;
      }
    }
    __syncthreads();
    {
      const int nreg = n >> 6;
      const int qa = 2 * wid;
      unsigned ua[32], ub[32];
#pragma unroll
      for (int j = 0; j < 32; ++j) { ua[j] = (j < nreg) ? S[qa * IDX_LD + 64 * j + lane] : 0u; ub[j] = (j < nreg) ? S[(qa + 1) * IDX_LD + 64 * j + lane] : 0u; }
      unsigned Ta = 0u, Tb = 0u; bool xa = false, xb = false;
      for (int bit = 31; bit >= 0; --bit) {
        const unsigned ca = xa ? Ta : (Ta | (1u << bit)), cb = xb ? Tb : (Tb | (1u << bit));
        int va = 0, vb = 0;
#pragma unroll
        for (int j4 = 0; j4 < 8; ++j4) {
          if (j4 * 4 < nreg) {
#pragma unroll
            for (int j = j4 * 4; j < j4 * 4 + 4; ++j) { va += (ua[j] >= ca) ? 1 : 0; vb += (ub[j] >= cb) ? 1 : 0; }
          }
        }
        int vab = va | (vb << 16);
        vab += __builtin_amdgcn_update_dpp(0, vab, 0xB1, 0xF, 0xF, true);
        vab += __builtin_amdgcn_update_dpp(0, vab, 0x4E, 0xF, 0xF, true);
        vab += __builtin_amdgcn_update_dpp(0, vab, 0x141, 0xF, 0xF, true);
        vab += __builtin_amdgcn_update_dpp(0, vab, 0x140, 0xF, 0xF, true);
        const int tot = __builtin_amdgcn_readlane(vab, 0) + __builtin_amdgcn_readlane(vab, 16) + __builtin_amdgcn_readlane(vab, 32) + __builtin_amdgcn_readlane(vab, 48);
        const int na = tot & 0xffff, nq = tot >> 16;
        if (!xa && na >= 256) { Ta = ca; xa = (na == 256); }
        if (!xb && nq >= 256) { Tb = cb; xb = (nq == 256); }
        if (xa && xb) break;
      }
#pragma unroll 1
      for (int which = 0; which < 2; ++which) {
        const unsigned T = which ? Tb : Ta;
        int cgt = 0;
#pragma unroll
        for (int j = 0; j < 32; ++j) cgt += __popcll(__ballot((which ? ub[j] : ua[j]) > T));
        int need = 256 - cgt;
        unsigned* mrow = ws_mask(p) + (size_t)(b * SEQ + q0 + qa + which) * 64;
#pragma unroll
        for (int j = 0; j < 32; ++j) {
          if (j < nreg) {
            const unsigned uv = which ? ub[j] : ua[j];
            unsigned long long sel = __ballot(uv > T);
            const unsigned long long eq = __ballot(uv == T);
            const int pe = __popcll(eq);
            if (pe <= need) { sel |= eq; need -= pe; }
            else { unsigned long long e = eq; for (int i = 0; i < need; ++i) { const unsigned long long low = e & (0ull - e); sel |= low; e ^= low; } need = 0; }
            if (lane == 0) { mrow[2 * j] = (unsigned)sel; mrow[2 * j + 1] = (unsigned)(sel >> 32); }
          }
        }
      }
    }
  }
}

DI void phase5a(const Params& p, int bid, int nb, char* lds) {
  const int lane = tid_() & 63, wid = tid_() >> 6;
  const bf16_t* proj = ws_proj(p);
  for (int gt = bid * 8 + wid; gt < NTOK; gt += nb * 8) {
    const int c0 = lane * 8, h = lane >> 3;
    const f32x4 y0 = *(const f32x4*)(ws_y(p) + (size_t)gt * RW + c0), y1 = *(const f32x4*)(ws_y(p) + (size_t)gt * RW + c0 + 4);
    float y[8] = {y0[0], y0[1], y0[2], y0[3], y1[0], y1[1], y1[2], y1[3]};
    float s = 0.f;
#pragma unroll
    for (int j = 0; j < 8; ++j) s += y[j];
    s += __shfl_xor(s, 1); s += __shfl_xor(s, 2); s += __shfl_xor(s, 4);
    const float mean = s * (1.0f / 64.0f);
    float q = 0.f;
#pragma unroll
    for (int j = 0; j < 8; ++j) { const float d = y[j] - mean; q += d * d; }
    q += __shfl_xor(q, 1); q += __shfl_xor(q, 2); q += __shfl_xor(q, 4);
    const float rstd = rsqrtf(q * (1.0f / 64.0f) + 64e-5f);
    float g[8], vr[8], vp[8];
    load8(ws_gg(p) + (size_t)gt * RW + c0, g);
    load8(proj + (size_t)gt * PROJ_LD + C_V + c0, vr);
    if (gt & (SEQ - 1)) load8(proj + (size_t)(gt - 1) * PROJ_LD + C_V + c0, vp);
    else {
#pragma unroll
      for (int j = 0; j < 8; ++j) vp[j] = 0.f;
    }
    const float bs = ws_bonus(p)[gt * NH + h];
    float o[8];
#pragma unroll
    for (int j = 0; j < 8; ++j) {
      const float v = vr[j] + p.shift_mu[C_V + c0 + j] * (vp[j] - vr[j]);
      o[j] = ((y[j] - mean) * rstd * p.gn_g[c0 + j] + p.gn_b[c0 + j] + bs * v) * g[j];
    }
    u32x4 w; w.x = pack2(o[0], o[1]); w.y = pack2(o[2], o[3]); w.z = pack2(o[4], o[5]); w.w = pack2(o[6], o[7]);
    *(u32x4*)(ws_mix(p) + (size_t)gt * DM + c0) = w;
  }
}

DI void phase5b(const Params& p, int bid, int nb, char* lds) {
  const int t = tid_(), lane = t & 63, wid = t >> 6;
  float* ql = (float*)lds;
  float* pr = ql + 1024;
  float* ol = pr + 2048;
  int* sel = (int*)(ol + 1024);
  int* nselp = sel + 256;
  for (int gq = bid; gq < NTOK; gq += nb) {
    const int b = gq >> 11;
    const bf16_t* ckv = ws_ckv(p) + (size_t)b * SEQ * 128;
    __syncthreads();
    for (int idx = t; idx < 1024; idx += NTHR) ql[idx] = bf2f(ws_qlat(p)[(size_t)gq * 1024 + idx]);
    if (wid == 0) {
      const int nadm = (((gq & (SEQ - 1)) >> 6) + 1) * 64;
      const unsigned word = (lane * 32 < nadm) ? ws_mask(p)[(size_t)gq * 64 + lane] : 0u;
      const int cnt = __popc(word);
      int incl = cnt;
      for (int o = 1; o < 64; o <<= 1) { const int u = __shfl_up(incl, o); if (lane >= o) incl += u; }
      int pos = incl - cnt;
      unsigned w = word;
      while (w) { const int bit = __ffs(w) - 1; w &= w - 1; if (pos < 256) sel[pos] = lane * 32 + bit; ++pos; }
      if (lane == 63) *nselp = incl < 256 ? incl : 256;
    }
    __syncthreads();
    const int nsel = *nselp;
    const int h = wid;
    float lg[4]; float mx = -1e30f;
#pragma unroll
    for (int q = 0; q < 4; ++q) {
      const int slot = lane + 64 * q;
      lg[q] = -1e30f;
      if (slot < nsel) {
        const bf16_t* kr = ckv + (size_t)sel[slot] * 128;
        float acc = 0.f;
#pragma unroll
        for (int d8 = 0; d8 < 16; ++d8) {
          float kf[8]; load8(kr + d8 * 8, kf);
          const f32x4 q0 = *(const f32x4*)(ql + h * 128 + d8 * 8), q1 = *(const f32x4*)(ql + h * 128 + d8 * 8 + 4);
          acc += q0[0] * kf[0] + q0[1] * kf[1] + q0[2] * kf[2] + q0[3] * kf[3] + q1[0] * kf[4] + q1[1] * kf[5] + q1[2] * kf[6] + q1[3] * kf[7];
        }
        lg[q] = acc;
      }
      mx = fmaxf(mx, lg[q]);
    }
    mx = wave_max(mx);
    float sm = 0.f;
#pragma unroll
    for (int q = 0; q < 4; ++q) { lg[q] = (lane + 64 * q < nsel) ? __expf(lg[q] - mx) : 0.f; sm += lg[q]; }
    sm = wave_sum(sm);
    const float inv = 1.0f / sm;
#pragma unroll
    for (int q = 0; q < 4; ++q) pr[h * 256 + lane + 64 * q] = lg[q] * inv;
    __syncthreads();
    {
      float o0 = 0.f, o1 = 0.f;
      for (int slot = 0; slot < nsel; ++slot) {
        const unsigned kv2 = *(const unsigned*)(ckv + (size_t)sel[slot] * 128 + lane * 2);
        const float pp = pr[h * 256 + slot];
        o0 += pp * __uint_as_float(kv2 << 16); o1 += pp * __uint_as_float(kv2 & 0xffff0000u);
      }
      ol[h * 128 + lane * 2] = o0; ol[h * 128 + lane * 2 + 1] = o1;
    }
    __syncthreads();
    {
      float acc = 0.f;
      for (int cc = 0; cc < 128; ++cc) acc += ol[h * 128 + cc] * p.w_uv[(size_t)(cc * NH + h) * HD + lane];
      ws_mix(p)[(size_t)gq * DM + RW + h * HD + lane] = f2bf(acc);
    }
  }
}

typedef short s16x4 __attribute__((ext_vector_type(4)));
#define KSWZ(row, colB) ((row) * 256 + ((colB) ^ (((row) & 7) << 4)))
DI int v_st(int k, int c) { const int kk = (k & ~0xC) | ((k & 4) << 1) | ((k & 8) >> 1); return ((kk >> 3) * 4 + (c >> 5)) * 512 + ((kk & 7) * 32 + (c & 31)) * 2; }
DI int v_rd_base(int lane) { return ((lane & 3) << 3) | (((lane >> 2) & 3) << 6) | (((lane >> 4) & 1) << 5) | (((lane >> 5) & 1) << 8); }
constexpr int v_rd_off(int d0, int ks, int half) { return d0 * 512 + ks * 4096 + half * 2048; }
template <int OFF> DI s16x4 tr_read(int vb) { s16x4 r; asm volatile("ds_read_b64_tr_b16 %0, %1 offset:%2" : "=&v"(r) : "v"(vb), "i"(OFF) : "memory"); return r; }
template <int D0> DI void pv_one(f32x16& od, int vb, bf16x8 pa0, bf16x8 pa1, bf16x8 pa2, bf16x8 pa3) {
  const s16x4 l0 = tr_read<v_rd_off(D0, 0, 0)>(vb), h0 = tr_read<v_rd_off(D0, 0, 1)>(vb), l1 = tr_read<v_rd_off(D0, 1, 0)>(vb), h1 = tr_read<v_rd_off(D0, 1, 1)>(vb);
  const s16x4 l2 = tr_read<v_rd_off(D0, 2, 0)>(vb), h2 = tr_read<v_rd_off(D0, 2, 1)>(vb), l3 = tr_read<v_rd_off(D0, 3, 0)>(vb), h3 = tr_read<v_rd_off(D0, 3, 1)>(vb);
  asm volatile("s_waitcnt lgkmcnt(0)" ::: "memory"); __builtin_amdgcn_sched_barrier(0);
#define PKV(L, H) (bf16x8){L[0], L[1], L[2], L[3], H[0], H[1], H[2], H[3]}
  od = __builtin_amdgcn_mfma_f32_32x32x16_bf16(pa0, PKV(l0, h0), od, 0, 0, 0);
  od = __builtin_amdgcn_mfma_f32_32x32x16_bf16(pa1, PKV(l1, h1), od, 0, 0, 0);
  od = __builtin_amdgcn_mfma_f32_32x32x16_bf16(pa2, PKV(l2, h2), od, 0, 0, 0);
  od = __builtin_amdgcn_mfma_f32_32x32x16_bf16(pa3, PKV(l3, h3), od, 0, 0, 0);
#undef PKV
}
constexpr int ATT_TILE = 64 * 128 * 2;
constexpr int ATT_LDS = 4 * ATT_TILE + 8 * 64 * 4;
DI void phase5b_mfma(const Params& p, int bid, int nb, char* lds) {
  const int t = tid_(), lane = t & 63, wid = t >> 6, r32 = lane & 31, hi = lane >> 5;
  char* V_lds = lds; char* K_lds = lds + 2 * ATT_TILE;
  float* al_l = (float*)(lds + 4 * ATT_TILE) + wid * 64; float* li_l = al_l + 32;
  const int sr = t >> 4, sc = (t & 15) * 8;
  const int vst0 = v_st(sr, sc), vst1 = v_st(32 + sr, sc), kst0 = KSWZ(sr, sc * 2), kst1 = KSWZ(32 + sr, sc * 2);
  const int vb0 = (int)(uintptr_t)V_lds + v_rd_base(lane);
  const int h = wid;
  constexpr float LOG2E = 1.4426950408889634f, THR = 8.0f;
  for (int task = bid; task < NTOK / 32; task += nb) {
    const int b = (task & 255) >> 4;
    int qt; { const int j = task & 15, k = task >> 8; qt = (k == 0) ? j : (k == 1) ? 31 - j : (k == 2) ? 32 + j : 63 - j; }
    const int q0 = qt * 32, n = ((q0 >> 6) + 1) * 64, NT = n >> 6;
    const int gq = b * SEQ + q0 + r32;
    const bf16_t* ckv = ws_ckv(p) + (size_t)b * SEQ * 128;
    const unsigned* mrow = ws_mask(p) + (size_t)gq * 64;
    bf16x8 qr[8];
    {
      f32x16 qa[4];
#pragma unroll
      for (int mt = 0; mt < 4; ++mt)
#pragma unroll
        for (int r = 0; r < 16; ++r) qa[mt][r] = 0.f;
      const bf16_t* wuk = ws_wukt(p) + (size_t)(h * 128 + r32) * 64 + hi * 8;
#pragma unroll
      for (int ks = 0; ks < 4; ++ks) {
        const bf16x8 bq = *(const bf16x8*)(ws_proj(p) + (size_t)gq * PROJ_LD + C_Q + h * HD + ks * 16 + hi * 8);
#pragma unroll
        for (int mt = 0; mt < 4; ++mt) { const bf16x8 aw = *(const bf16x8*)(wuk + mt * 32 * 64 + ks * 16); qa[mt] = __builtin_amdgcn_mfma_f32_32x32x16_bf16(aw, bq, qa[mt], 0, 0, 0); }
      }
#define QPK(P, BASE, OUT) do { unsigned a0 = cvtpk(P[BASE + 0] * 0.125f, P[BASE + 1] * 0.125f), a1 = cvtpk(P[BASE + 2] * 0.125f, P[BASE + 3] * 0.125f);   \
    unsigned b0 = cvtpk(P[BASE + 4] * 0.125f, P[BASE + 5] * 0.125f), b1 = cvtpk(P[BASE + 6] * 0.125f, P[BASE + 7] * 0.125f);                              \
    auto r0 = __builtin_amdgcn_permlane32_swap(a0, b0, false, false); auto r1 = __builtin_amdgcn_permlane32_swap(a1, b1, false, false); \
    u32x4 w = {r0[0], r1[0], r0[1], r1[1]}; OUT = *reinterpret_cast<bf16x8*>(&w); } while (0)
#pragma unroll
      for (int mt = 0; mt < 4; ++mt) { QPK(qa[mt], 0, qr[2 * mt]); QPK(qa[mt], 8, qr[2 * mt + 1]); }
#undef QPK
    }
    float m_reg = -1e30f, l_reg = 0.f;
    f32x16 o[4];
#pragma unroll
    for (int d = 0; d < 4; ++d)
#pragma unroll
      for (int r = 0; r < 16; ++r) o[d][r] = 0.f;
    u32x4 s0 = *(const u32x4*)(ckv + (size_t)sr * 128 + sc), s1 = *(const u32x4*)(ckv + (size_t)(32 + sr) * 128 + sc);
    __syncthreads();
    *(u32x4*)(V_lds + vst0) = s0; *(u32x4*)(V_lds + vst1) = s1; *(u32x4*)(K_lds + kst0) = s0; *(u32x4*)(K_lds + kst1) = s1;
    __syncthreads();
    for (int j = 0; j < NT; ++j) {
      const int buf = j & 1;
      if (j + 1 < NT) { s0 = *(const u32x4*)(ckv + (size_t)((j + 1) * 64 + sr) * 128 + sc); s1 = *(const u32x4*)(ckv + (size_t)((j + 1) * 64 + 32 + sr) * 128 + sc); }
      const unsigned w0 = mrow[2 * j] >> (4 * hi), w1 = mrow[2 * j + 1] >> (4 * hi);
      f32x16 p0, p1;
#pragma unroll
      for (int r = 0; r < 16; ++r) { p0[r] = 0.f; p1[r] = 0.f; }
      const char* Kb = K_lds + buf * ATT_TILE;
#pragma unroll
      for (int d0 = 0; d0 < 8; ++d0) {
        const int cb = (d0 * 16 + hi * 8) * 2;
        const bf16x8 b0 = *(const bf16x8*)(Kb + KSWZ(r32, cb)), b1 = *(const bf16x8*)(Kb + KSWZ(32 + r32, cb));
        p0 = __builtin_amdgcn_mfma_f32_32x32x16_bf16(b0, qr[d0], p0, 0, 0, 0);
        p1 = __builtin_amdgcn_mfma_f32_32x32x16_bf16(b1, qr[d0], p1, 0, 0, 0);
      }
      float pmax = p0[0];
#pragma unroll
      for (int r = 1; r < 16; ++r) pmax = fmaxf(pmax, p0[r]);
#pragma unroll
      for (int r = 0; r < 16; ++r) pmax = fmaxf(pmax, p1[r]);
      { auto rr = __builtin_amdgcn_permlane32_swap(__float_as_uint(pmax), __float_as_uint(pmax), false, false); pmax = fmaxf(__uint_as_float(rr[0]), __uint_as_float(rr[1])); }
      float alpha = 1.f;
      if (!__all(pmax - m_reg <= THR)) { const float mn = fmaxf(m_reg, pmax); alpha = __builtin_amdgcn_exp2f((m_reg - mn) * LOG2E); m_reg = mn; }
      const float mnC = -m_reg * LOG2E;
      float ps = 0.f;
#pragma unroll
      for (int r = 0; r < 16; ++r) {
        const int bitp = (r & 3) + 8 * (r >> 2);
        float e0 = __builtin_amdgcn_exp2f(fmaf(p0[r], LOG2E, mnC)), e1 = __builtin_amdgcn_exp2f(fmaf(p1[r], LOG2E, mnC));
        e0 = ((w0 >> bitp) & 1u) ? e0 : 0.f; e1 = ((w1 >> bitp) & 1u) ? e1 : 0.f;
        p0[r] = e0; p1[r] = e1; ps += e0 + e1;
      }
      { auto rr = __builtin_amdgcn_permlane32_swap(__float_as_uint(ps), __float_as_uint(ps), false, false); ps = __uint_as_float(rr[0]) + __uint_as_float(rr[1]); }
      l_reg = l_reg * alpha + ps;
      if (__any(alpha < 1.f)) {
        if (hi == 0) al_l[r32] = alpha;
        asm volatile("s_waitcnt lgkmcnt(0)" ::: "memory");
#pragma unroll
        for (int d = 0; d < 4; ++d)
#pragma unroll
          for (int r = 0; r < 16; ++r) o[d][r] *= al_l[crow(r, hi)];
      }
      bf16x8 pa0, pa1, pa2, pa3;
#define PK4(P, BASE, OUT) do { unsigned a0 = cvtpk(P[BASE + 0], P[BASE + 1]), a1 = cvtpk(P[BASE + 2], P[BASE + 3]);   \
    unsigned b0 = cvtpk(P[BASE + 4], P[BASE + 5]), b1 = cvtpk(P[BASE + 6], P[BASE + 7]);                              \
    auto r0 = __builtin_amdgcn_permlane32_swap(a0, b0, false, false); auto r1 = __builtin_amdgcn_permlane32_swap(a1, b1, false, false); \
    u32x4 w = {r0[0], r1[0], r0[1], r1[1]}; OUT = *reinterpret_cast<bf16x8*>(&w); } while (0)
      PK4(p0, 0, pa0); PK4(p0, 8, pa1); PK4(p1, 0, pa2); PK4(p1, 8, pa3);
#undef PK4
      const int vb = vb0 + buf * ATT_TILE;
      pv_one<0>(o[0], vb, pa0, pa1, pa2, pa3); pv_one<1>(o[1], vb, pa0, pa1, pa2, pa3); pv_one<2>(o[2], vb, pa0, pa1, pa2, pa3); pv_one<3>(o[3], vb, pa0, pa1, pa2, pa3);
      if (j + 1 < NT) {
        char* Vn = V_lds + (buf ^ 1) * ATT_TILE; char* Kn = K_lds + (buf ^ 1) * ATT_TILE;
        *(u32x4*)(Vn + vst0) = s0; *(u32x4*)(Vn + vst1) = s1; *(u32x4*)(Kn + kst0) = s0; *(u32x4*)(Kn + kst1) = s1;
      }
      __syncthreads();
    }
    if (hi == 0) li_l[r32] = l_reg;
    asm volatile("s_waitcnt lgkmcnt(0)" ::: "memory");
    int hio = hi, r32o = r32;
    asm volatile("" : "+v"(hio), "+v"(r32o));
    char* Ow = lds + wid * 8192;
#pragma unroll
    for (int r = 0; r < 16; ++r) {
      const int row = crow(r, hio); const float rl = 1.0f / li_l[row];
#pragma unroll
      for (int d = 0; d < 4; ++d) *(bf16_t*)(Ow + KSWZ(row, (d * 32 + r32o) * 2)) = f2bf(o[d][r] * rl);
    }
    asm volatile("s_waitcnt lgkmcnt(0)" ::: "memory");
    f32x16 oa[2];
#pragma unroll
    for (int i = 0; i < 2; ++i)
#pragma unroll
      for (int r = 0; r < 16; ++r) oa[i][r] = 0.f;
    const bf16_t* wuv = ws_wuvt(p) + (size_t)h * 64 * 128 + r32o * 128 + hio * 8;
#pragma unroll
    for (int ks = 0; ks < 8; ++ks) {
      const bf16x8 a = *(const bf16x8*)(Ow + KSWZ(r32o, (ks * 16 + hio * 8) * 2));
#pragma unroll
      for (int i = 0; i < 2; ++i) {
        const bf16x8 bw = *(const bf16x8*)(wuv + i * 32 * 128 + ks * 16);
        oa[i] = __builtin_amdgcn_mfma_f32_32x32x16_bf16(a, bw, oa[i], 0, 0, 0);
      }
    }
    bf16_t* mx = ws_mix(p) + (size_t)(b * SEQ + q0 + 4 * hio) * DM + RW + h * HD + r32o;
#pragma unroll
    for (int i = 0; i < 2; ++i)
#pragma unroll
      for (int r = 0; r < 16; ++r) mx[((r & 3) + 8 * (r >> 2)) * DM + i * 32] = f2bf(oa[i][r]);
  }
}

struct EpiOut { const float* x; const float* mod; float* o; int row0, col0; DI void operator()(int r, int c, float v0, float v1) const {
  const int row = row0 + r, col = col0 + c, b = row >> 11; const size_t idx = (size_t)row * DM + col;
  o[idx] = x[idx] + (1.0f + mod[b * 6144 + 2048 + col]) * v0; o[idx + 32] = x[idx + 32] + (1.0f + mod[b * 6144 + 2048 + col + 32]) * v1; } };
DI void phase6(const Params& p, int bid, int nb, char* lds) {
  constexpr int NT = DM / GBN;
  for (int tile = bid; tile < (NTOK / GBM) * NT; tile += nb) {
    const int mt = tile / NT, nt = tile % NT;
    gemm_tile(ws_mix(p), DM, ARowBase{mt * GBM}, ws_wtout(p), DM, nt * GBN, DM, EpiOut{p.x, ws_mod(p), p.out, mt * GBM, nt * GBN}, lds);
  }
}

namespace pg8 {
#define PG8_LAS __attribute__((address_space(3)))
constexpr int BM = 256, BK = 64, HALF = 128, HTB = HALF * BK * 2  , STAGE_BYTES = 8 * HTB, NXCD = 8, WGM = 8;

__host__ __device__ __forceinline__ int lds_byte(int r, int c) { const int st = (r >> 4) * 2 + (c >> 5), rr = r & 15, cc = c & 31, ob = rr * 64 + cc * 2; return st * 1024 + (ob ^ (((ob >> 9) & 1) << 5)); }
__host__ __device__ __forceinline__ void stage_rc(int b, int& R, int& C) { const int st = b / 1024, sb = b % 1024, swz = sb ^ (((sb >> 9) & 1) << 5); R = (st >> 1) * 16 + swz / 64; C = (st & 1) * 32 + (swz % 64) / 2; }
__host__ __device__ __forceinline__ int perm32(int rho) { const int n = rho >> 4, i = rho & 15; return 8 * (i >> 2) + 4 * n + (i & 3); }

struct Unit { int pm, pn, e; };
struct Gemm { const bf16_t* A; const bf16_t* Bt; int M, N, K; size_t bstride; };

struct StaticOrder {
    static constexpr bool GATHER = false;
    int nM, nN, nwg, G, c;
    __host__ __device__ void init(int M, int N, int G_, int c_) { nM = M / BM; nN = N / BM; nwg = nM * nN; G = G_; c = c_; }
    __host__ __device__ bool next(int i, Unit& u) const {
        const long L = (long)i * G + c; if (L >= nwg) return false;
        int wgid = (int)L; { const int q = nwg / NXCD, r = nwg % NXCD, xcd = wgid % NXCD, off = wgid / NXCD; wgid = (xcd < r ? xcd * (q + 1) : r * (q + 1) + (xcd - r) * q) + off; }
        const int nig = WGM * nN, gid = wgid / nig, fm = gid * WGM, gsz = (nM - fm) < WGM ? (nM - fm) : WGM;
        u.pm = fm + ((wgid % nig) % gsz); u.pn = (wgid % nig) / gsz; u.e = 0; return true;
    }
    __device__ __forceinline__ void a_ready(const Unit&) const {}
    __device__ __forceinline__ void done(const Unit&) const {}
    __device__ __forceinline__ int arow(const Unit&, int) const { return 0; }
};
template <class Epi, class Sched, bool ALIGN_EPI = false, bool SP2 = false>
__device__ __forceinline__ void gemm_phase(PG8_LAS unsigned char* lds, const Gemm g, const Sched& S, const Epi& E) {
    const int tid = threadIdx.x, wid = __builtin_amdgcn_readfirstlane(tid >> 6), lane = tid & 63, wr = wid >> 2, wc = wid & 3, fr = lane & 15, fq = lane >> 4;
    const int K = g.K, nt = K / BK;
    unsigned voffA[2], voffB[2];
#pragma unroll
    for (int i = 0; i < 2; ++i) { int R, C; stage_rc(tid * 16 + i * 8192, R, C); const int Rb = Epi::PERM ? ((R & ~31) + perm32(R & 31)) : R;
        voffA[i] = (unsigned)(R * K + C) * 2u; voffB[i] = (unsigned)(Rb * K + C) * 2u; }
    unsigned vAc[2][2], vAn[2][2];
    const size_t kstep = (size_t)(BK * 2);
    const size_t hstep = (size_t)HALF * K * 2;
    const size_t tstep = 2 * hstep;
    const unsigned ldsw = (unsigned)wid * 1024u;
    const int aoff = lds_byte(wr * 64 + fr, fq * 8), boff = lds_byte(wc * 32 + fr, fq * 8);
#define PG8_SA(b, h) (((b) * 2 + (h)) * HTB)
#define PG8_SB(b, h) ((4 + (b) * 2 + (h)) * HTB)
#define PG8_STAGE(bufoff, gbase, voff) do { _Pragma("unroll") for (int _i = 0; _i < 2; ++_i) \
        __builtin_amdgcn_global_load_lds((const unsigned*)((const char*)(gbase) + (voff)[_i]), (PG8_LAS unsigned*)(lds + (bufoff) + ldsw + _i * 8192), 16, 0, 0); } while (0)
#define PG8_STAGE_A(bufoff, gbase, v0_, v1_) do { \
        __builtin_amdgcn_global_load_lds((const unsigned*)((const char*)(gbase) + (v0_)), (PG8_LAS unsigned*)(lds + (bufoff) + ldsw), 16, 0, 0); \
        __builtin_amdgcn_global_load_lds((const unsigned*)((const char*)(gbase) + (v1_)), (PG8_LAS unsigned*)(lds + (bufoff) + ldsw + 8192), 16, 0, 0); } while (0)
#define PG8_AOFF(u_, dst_) do { if constexpr (Sched::GATHER) { _Pragma("unroll") for (int h_ = 0; h_ < 2; ++h_) _Pragma("unroll") for (int i_ = 0; i_ < 2; ++i_) { int R_, C_; stage_rc(tid * 16 + i_ * 8192, R_, C_); \
            dst_[h_][i_] = (unsigned)(S.arow(u_, h_ * HALF + R_) * K + C_) * 2u; } asm volatile("s_waitcnt vmcnt(0)" ::: "memory"); } \
        else { _Pragma("unroll") for (int h_ = 0; h_ < 2; ++h_) _Pragma("unroll") for (int i_ = 0; i_ < 2; ++i_) dst_[h_][i_] = voffA[i_] + (unsigned)(h_ * hstep); } } while (0)
#define PG8_LDA(dst, b, h) do { _Pragma("unroll") for (int m = 0; m < 4; ++m) _Pragma("unroll") for (int k = 0; k < 2; ++k) dst[m][k] = *(const PG8_LAS bf16x8*)(lds + PG8_SA(b, h) + aoff + m * 2048 + k * 1024); } while (0)
#define PG8_LDB(dst, b, h) do { _Pragma("unroll") for (int n = 0; n < 2; ++n) _Pragma("unroll") for (int k = 0; k < 2; ++k) dst[n][k] = *(const PG8_LAS bf16x8*)(lds + PG8_SB(b, h) + boff + n * 2048 + k * 1024); } while (0)
#define PG8_MMA(ai, bj, At, Bt) do { __builtin_amdgcn_s_setprio(1); _Pragma("unroll") for (int m = 0; m < 4; ++m) _Pragma("unroll") for (int n = 0; n < 2; ++n) _Pragma("unroll") for (int k = 0; k < 2; ++k) \
        acc[ai][bj][m][n] = __builtin_amdgcn_mfma_f32_16x16x32_bf16(Bt[n][k], At[m][k], acc[ai][bj][m][n], 0, 0, 0); __builtin_amdgcn_s_setprio(0); } while (0)
#define PG8_WAIT_V(n) asm volatile("s_waitcnt vmcnt(" #n ")" ::: "memory")
#define PG8_WAIT_L(n) asm volatile("s_waitcnt lgkmcnt(" #n ")" ::: "memory")
#define PG8_BAR __builtin_amdgcn_s_barrier()
#define PG8_SCHED __builtin_amdgcn_sched_barrier(0)
    Unit cur, nxt; int ui = 0;
    if (!S.next(0, cur)) return;
    f32x4 acc[2][2][4][2];
#pragma unroll
    for (int a = 0; a < 2; ++a)
#pragma unroll
        for (int b = 0; b < 2; ++b)
#pragma unroll
            for (int m = 0; m < 4; ++m)
#pragma unroll
                for (int n = 0; n < 2; ++n) acc[a][b][m][n] = (f32x4){0.f, 0.f, 0.f, 0.f};
    bf16x8 At[4][2], B0[2][2], B1[2][2];
    const char* cA = Sched::GATHER ? (const char*)g.A : (const char*)g.A + (size_t)cur.pm * tstep; PG8_AOFF(cur, vAc); const char* cB = (const char*)g.Bt + (size_t)cur.e * g.bstride + (size_t)cur.pn * tstep;
    S.a_ready(cur);
    if constexpr (SP2) {
        PG8_STAGE(PG8_SB(0, 0), cB, voffB); PG8_STAGE(PG8_SB(0, 1), cB + hstep, voffB); PG8_STAGE_A(PG8_SA(0, 0), cA, vAc[0][0], vAc[0][1]); PG8_STAGE_A(PG8_SA(0, 1), cA, vAc[1][0], vAc[1][1]);
        if (wr == 1) PG8_BAR;
        PG8_WAIT_V(2); PG8_BAR;
        PG8_STAGE(PG8_SB(1, 0), cB + kstep, voffB); PG8_STAGE_A(PG8_SA(1, 0), cA + kstep, vAc[0][0], vAc[0][1]); PG8_STAGE(PG8_SB(1, 1), cB + hstep + kstep, voffB);
        PG8_WAIT_V(6); PG8_BAR;
    } else {
        PG8_STAGE(PG8_SB(0, 0), cB, voffB); PG8_STAGE(PG8_SA(0, 0), cA, voffA); PG8_STAGE(PG8_SB(0, 1), cB + hstep, voffB); PG8_STAGE(PG8_SA(0, 1), cA + hstep, voffA);
        if (wr == 1) PG8_BAR;
        PG8_WAIT_V(4); PG8_BAR;
        PG8_STAGE(PG8_SB(1, 0), cB + kstep, voffB); PG8_STAGE(PG8_SA(1, 0), cA + kstep, voffA); PG8_STAGE(PG8_SB(1, 1), cB + hstep + kstep, voffB);
        PG8_WAIT_V(6); PG8_BAR;
    }
    for (;;) {
        const bool has_next = S.next(ui + 1, nxt);
        const char* nA = (has_next && !Sched::GATHER) ? (const char*)g.A + (size_t)nxt.pm * tstep : cA;
        if (has_next) PG8_AOFF(nxt, vAn); else { _Pragma("unroll") for (int h_ = 0; h_ < 2; ++h_) _Pragma("unroll") for (int i_ = 0; i_ < 2; ++i_) vAn[h_][i_] = vAc[h_][i_]; }
        const char* nB = has_next ? (const char*)g.Bt + (size_t)nxt.e * g.bstride + (size_t)nxt.pn * tstep : cB;
        for (int t = 0; t < nt; t += 2) {
            const bool last = (t == nt - 2);
            const char* a1 = cA + (size_t)(t + 1) * kstep;
            const char* a2 = last ? nA : cA + (size_t)(t + 2) * kstep; const char* b2 = last ? nB : cB + (size_t)(t + 2) * kstep;
            const char* a3 = a2 + kstep; const char* b3 = b2 + kstep;
            if (last && has_next) S.a_ready(nxt);
            if constexpr (SP2) {
            PG8_LDB(B0, 0, 0); PG8_LDB(B1, 0, 1); PG8_SCHED; PG8_LDA(At, 0, 0); PG8_STAGE_A(PG8_SA(1, 1), a1, vAc[1][0], vAc[1][1]);
            PG8_WAIT_V(8); PG8_WAIT_L(0); PG8_BAR; PG8_MMA(0, 0, At, B0); PG8_MMA(0, 1, At, B1); PG8_BAR; PG8_SCHED;
            PG8_LDA(At, 0, 1); PG8_STAGE(PG8_SB(0, 0), b2, voffB); PG8_STAGE(PG8_SB(0, 1), b2 + hstep, voffB); PG8_STAGE_A(PG8_SA(0, 0), a2, last ? vAn[0][0] : vAc[0][0], last ? vAn[0][1] : vAc[0][1]);
            PG8_WAIT_V(8); PG8_WAIT_L(0); PG8_BAR; PG8_MMA(1, 0, At, B0); PG8_MMA(1, 1, At, B1); PG8_BAR; PG8_SCHED;
            PG8_LDB(B0, 1, 0); PG8_LDB(B1, 1, 1); PG8_SCHED; PG8_LDA(At, 1, 0); PG8_STAGE_A(PG8_SA(0, 1), a2, last ? vAn[1][0] : vAc[1][0], last ? vAn[1][1] : vAc[1][1]);
            PG8_WAIT_V(8); PG8_WAIT_L(0); PG8_BAR; PG8_MMA(0, 0, At, B0); PG8_MMA(0, 1, At, B1); PG8_BAR; PG8_SCHED;
            PG8_LDA(At, 1, 1); PG8_STAGE(PG8_SB(1, 0), b3, voffB); PG8_STAGE(PG8_SB(1, 1), b3 + hstep, voffB); PG8_STAGE_A(PG8_SA(1, 0), a3, last ? vAn[0][0] : vAc[0][0], last ? vAn[0][1] : vAc[0][1]);
            PG8_WAIT_V(8); PG8_WAIT_L(0); PG8_BAR; PG8_MMA(1, 0, At, B0); PG8_MMA(1, 1, At, B1); PG8_BAR; PG8_SCHED;
            } else {
            PG8_LDB(B0, 0, 0); PG8_SCHED; PG8_LDA(At, 0, 0); PG8_STAGE(PG8_SA(1, 1), a1 + hstep, voffA);
            PG8_WAIT_L(8); PG8_BAR; PG8_WAIT_L(0); PG8_MMA(0, 0, At, B0); PG8_BAR; PG8_SCHED;
            PG8_LDB(B1, 0, 1); PG8_STAGE(PG8_SB(0, 0), b2, voffB);
            PG8_BAR; PG8_WAIT_L(0); PG8_MMA(0, 1, At, B1); PG8_BAR;
            PG8_LDA(At, 0, 1); PG8_STAGE(PG8_SA(0, 0), a2, voffA);
            PG8_BAR; PG8_WAIT_L(0); PG8_MMA(1, 0, At, B0); PG8_BAR; PG8_SCHED;
            PG8_STAGE(PG8_SB(0, 1), b2 + hstep, voffB);
            PG8_WAIT_V(6); PG8_BAR; PG8_MMA(1, 1, At, B1); PG8_BAR;
            PG8_LDB(B0, 1, 0); PG8_SCHED; PG8_LDA(At, 1, 0); PG8_STAGE(PG8_SA(0, 1), a2 + hstep, voffA);
            PG8_WAIT_L(8); PG8_BAR; PG8_WAIT_L(0); PG8_MMA(0, 0, At, B0); PG8_BAR; PG8_SCHED;
            PG8_LDB(B1, 1, 1); PG8_STAGE(PG8_SB(1, 0), b3, voffB);
            PG8_BAR; PG8_WAIT_L(0); PG8_MMA(0, 1, At, B1); PG8_BAR;
            PG8_LDA(At, 1, 1); PG8_STAGE(PG8_SA(1, 0), a3, voffA);
            PG8_BAR; PG8_WAIT_L(0); PG8_MMA(1, 0, At, B0); PG8_BAR; PG8_SCHED;
            PG8_STAGE(PG8_SB(1, 1), b3 + hstep, voffB);
            PG8_WAIT_V(6); PG8_BAR; PG8_MMA(1, 1, At, B1); PG8_BAR;
            }
        }
        if constexpr (ALIGN_EPI) { if (wr == 0) PG8_BAR; }
        if constexpr (!Epi::AFTER_DRAIN) { E(acc, cur, wr, wc, fr, fq); S.done(cur); }
        if (!has_next) break;
#pragma unroll
        for (int a = 0; a < 2; ++a)
#pragma unroll
            for (int b = 0; b < 2; ++b)
#pragma unroll
                for (int m = 0; m < 4; ++m)
#pragma unroll
                    for (int n = 0; n < 2; ++n) acc[a][b][m][n] = (f32x4){0.f, 0.f, 0.f, 0.f};
        cur = nxt; cA = nA; cB = nB; ++ui;
#pragma unroll
        for (int h_ = 0; h_ < 2; ++h_)
#pragma unroll
            for (int i_ = 0; i_ < 2; ++i_) vAc[h_][i_] = vAn[h_][i_];
        if constexpr (ALIGN_EPI) { if (wr == 1) PG8_BAR; }
    }
    PG8_WAIT_V(0);
    if constexpr (!ALIGN_EPI) { if (wr == 0) PG8_BAR; }
    PG8_BAR;
    if constexpr (Epi::AFTER_DRAIN) { E.fused(acc, cur, wr, wc, fr, fq, lds, wid, lane); S.done(cur); }
#undef PG8_SA
#undef PG8_SB
#undef PG8_STAGE
#undef PG8_STAGE_A
#undef PG8_AOFF
#undef PG8_LDA
#undef PG8_LDB
#undef PG8_MMA
#undef PG8_WAIT_V
#undef PG8_WAIT_L
#undef PG8_BAR
#undef PG8_SCHED
}
}


constexpr int TAB_OFF = 131072;
DI void build_tables(const Params& p, char* lds) {
  int* T = (int*)(lds + TAB_OFF); unsigned char* te = (unsigned char*)(T + 80);
  __syncthreads();
  if (tid_() == 0) {
    int acc = 0;
    for (int e = 0; e < NEXP; ++e) { const int c = ws_cnt(p)[e]; T[e] = c; T[32 + e] = acc; const int nt = (c + 255) >> 8; for (int k = 0; k < nt; ++k) te[acc + k] = (unsigned char)e; acc += nt; }
    T[64] = acc;
  }
  __syncthreads();
}
template <bool GATHER_> struct GroupOrderT { static constexpr bool GATHER = GATHER_; const int* T; const unsigned char* te; int G, c; const int* list;
  DI bool next(int i, pg8::Unit& u) const { const int L = i * G + c; if (L >= T[64] * 4) return false; u.pm = L >> 2; u.pn = L & 3; u.e = te[u.pm]; return true; }
  DI void a_ready(const pg8::Unit&) const {}
  DI void done(const pg8::Unit&) const {}
  DI int arow(const pg8::Unit& u, int r) const {
    const int slot = (u.pm - T[32 + u.e]) * 256 + r; return slot < T[u.e] ? (list[u.e * LCAP + slot] >> 1) : 0; } };
typedef GroupOrderT<false> GroupOrder;

struct EpiProjP { static constexpr bool PERM = true, AFTER_DRAIN = false; bf16_t* O; int ldc;
  DI void operator()(const f32x4 (&acc)[2][2][4][2], const pg8::Unit& u, int wr, int wc, int fr, int fq) const {
    const int row0 = u.pm * 256 + wr * 64 + fr, col0 = u.pn * 256 + wc * 32 + 8 * fq;
#pragma unroll
    for (int ai = 0; ai < 2; ++ai)
#pragma unroll
      for (int m = 0; m < 4; ++m) { bf16_t* rowp = O + (size_t)(row0 + ai * 128 + m * 16) * ldc + col0;
#pragma unroll
        for (int bj = 0; bj < 2; ++bj) { const f32x4 v0 = acc[ai][bj][m][0] + 0.0f, v1 = acc[ai][bj][m][1] + 0.0f;
          u32x4 w; w.x = cvtpk(v0[0], v0[1]); w.y = cvtpk(v0[2], v0[3]); w.z = cvtpk(v1[0], v1[1]); w.w = cvtpk(v1[2], v1[3]);
          *(u32x4*)(rowp + bj * 128) = w; } }
  } };
DI void phase2_pg8(const Params& p, int bid, int nb, char* lds) {
  pg8::Gemm g{ws_h1(p), ws_wtin(p), NTOK, PROJ_LD, DM, 0};
  pg8::StaticOrder S; S.init(NTOK, PROJ_LD, nb, bid);
  EpiProjP E{ws_proj(p), PROJ_LD};
  __syncthreads();
  pg8::gemm_phase<EpiProjP, pg8::StaticOrder, true, true>((PG8_LAS unsigned char*)lds, g, S, E);
  __syncthreads();
}
struct EpiResidP { static constexpr bool PERM = false, AFTER_DRAIN = false; const float* x; const float* mod; float* o;
  DI void operator()(const f32x4 (&acc)[2][2][4][2], const pg8::Unit& u, int wr, int wc, int fr, int fq) const {
    const int row0 = u.pm * 256 + wr * 64 + fr, col0 = u.pn * 256 + wc * 32 + 4 * fq;
#pragma unroll
    for (int ai = 0; ai < 2; ++ai)
#pragma unroll
      for (int m = 0; m < 4; ++m) { const int row = row0 + ai * 128 + m * 16, b = row >> 11;
#pragma unroll
        for (int bj = 0; bj < 2; ++bj)
#pragma unroll
          for (int n = 0; n < 2; ++n) { const int col = col0 + bj * 128 + n * 16; const size_t idx = (size_t)row * DM + col;
            const f32x4 xv = *(const f32x4*)(x + idx), gv = *(const f32x4*)(mod + b * 6144 + 2048 + col);
            *(f32x4*)(o + idx) = xv + (gv + 1.0f) * acc[ai][bj][m][n]; } }
  } };
DI void phase6_pg8(const Params& p, int bid, int nb, char* lds) {
  pg8::Gemm g{ws_mix(p), ws_wtout(p), NTOK, DM, DM, 0};
  pg8::StaticOrder S; S.init(NTOK, DM, nb, bid);
  EpiResidP E{p.x, ws_mod(p), ws_x1(p)};
  __syncthreads();
  pg8::gemm_phase<EpiResidP, pg8::StaticOrder, true, true>((PG8_LAS unsigned char*)lds, g, S, E);
  __syncthreads();
}
DI bf16_t* ws_h2s(const Params& p) { return (bf16_t*)(p.ws + OFF_C); }
DI bf16_t* ws_hidp(const Params& p) { return (bf16_t*)(p.ws + OFF_F); }
DI void phase7c(const Params& p, int bid, int nb, char* lds) {
  build_tables(p, lds);
  const int* T = (const int*)(lds + TAB_OFF);
  const int lane = tid_() & 63, gw = bid * 8 + (tid_() >> 6), nw = nb * 8;
  for (int e = 0; e < NEXP; ++e) {
    const int c = T[e]; const size_t r0 = (size_t)T[32 + e] * 256;
    for (int r = gw; r < c; r += nw) {
      const int tok = ws_list(p)[e * LCAP + r] >> 1;
      const u32x4* src = (const u32x4*)(ws_h2(p) + (size_t)tok * DM); u32x4* dst = (u32x4*)(ws_h2s(p) + (r0 + r) * DM);
      dst[lane] = src[lane]; dst[lane + 64] = src[lane + 64];
    }
  }
}
struct EpiSwiGLU { static constexpr bool PERM = true, AFTER_DRAIN = false; bf16_t* O;
  DI void operator()(const f32x4 (&acc)[2][2][4][2], const pg8::Unit& u, int wr, int wc, int fr, int fq) const {
    const int row0 = u.pm * 256 + wr * 64 + fr, col0 = u.pn * 128 + wc * 32 + 8 * fq;
#pragma unroll
    for (int ai = 0; ai < 2; ++ai)
#pragma unroll
      for (int m = 0; m < 4; ++m) {
        float hv[8];
#pragma unroll
        for (int n = 0; n < 2; ++n)
#pragma unroll
          for (int i = 0; i < 4; ++i) { const float gt = acc[ai][0][m][n][i], up = acc[ai][1][m][n][i]; hv[n * 4 + i] = gt / (1.0f + __expf(-gt)) * up; }
        u32x4 w; w.x = cvtpk(hv[0], hv[1]); w.y = cvtpk(hv[2], hv[3]); w.z = cvtpk(hv[4], hv[5]); w.w = cvtpk(hv[6], hv[7]);
        *(u32x4*)(O + (size_t)(row0 + ai * 128 + m * 16) * DEXP + col0) = w; }
  } };
DI void phase8_pg8(const Params& p, int bid, int nb, char* lds) {
  build_tables(p, lds);
  pg8::Gemm g{ws_h2(p), ws_wgu(p), 0, 1024, DM, (size_t)1024 * 1024 * 2};
  GroupOrderT<true> S{(const int*)(lds + TAB_OFF), (const unsigned char*)((const int*)(lds + TAB_OFF) + 80), nb, bid, ws_list(p)};
  EpiSwiGLU E{ws_hidp(p)};
  pg8::gemm_phase<EpiSwiGLU, GroupOrderT<true>, true, true>((PG8_LAS unsigned char*)lds, g, S, E);
  __syncthreads();
}
struct EpiYP { static constexpr bool PERM = true, AFTER_DRAIN = false; bf16_t* O; const int* list; const float* wa; const int* T;
  DI void operator()(const f32x4 (&acc)[2][2][4][2], const pg8::Unit& u, int wr, int wc, int fr, int fq) const {
    const int cnt = T[u.e], rbase = (u.pm - T[32 + u.e]) * 256 + wr * 64 + fr, col0 = u.pn * 256 + wc * 32 + 8 * fq;
#pragma unroll
    for (int ai = 0; ai < 2; ++ai)
#pragma unroll
      for (int m = 0; m < 4; ++m) { const int r = rbase + ai * 128 + m * 16;
        if (r < cnt) { const int aid = list[u.e * LCAP + r]; const float wv = wa[aid]; bf16_t* rowp = O + (size_t)aid * DM + col0;
#pragma unroll
          for (int bj = 0; bj < 2; ++bj) { const f32x4 v0 = acc[ai][bj][m][0] * wv, v1 = acc[ai][bj][m][1] * wv;
            u32x4 w; w.x = cvtpk(v0[0], v0[1]); w.y = cvtpk(v0[2], v0[3]); w.z = cvtpk(v1[0], v1[1]); w.w = cvtpk(v1[2], v1[3]);
            *(u32x4*)(rowp + bj * 128) = w; } } }
  } };
DI void phase9_pg8(const Params& p, int bid, int nb, char* lds) {
  build_tables(p, lds);
  pg8::Gemm g{ws_hidp(p), ws_wd(p), 0, 1024, DEXP, (size_t)1024 * 512 * 2};
  GroupOrder S{(const int*)(lds + TAB_OFF), (const unsigned char*)((const int*)(lds + TAB_OFF) + 80), nb, bid, nullptr};
  EpiYP E{ws_ybuf(p), ws_list(p), ws_wa(p), (const int*)(lds + TAB_OFF)};
  pg8::gemm_phase<EpiYP, GroupOrder, true, true>((PG8_LAS unsigned char*)lds, g, S, E);
  __syncthreads();
}

typedef float f32x4m __attribute__((ext_vector_type(4)));
constexpr int H_LD = 1028;
DI void phase7(const Params& p, int bid, int nb, char* lds) {
  const int t = tid_(), lane = t & 63, wid = t >> 6, l16 = lane & 15, lg4 = lane >> 4;
  float* H = (float*)lds;
  float* part = H + 16 * H_LD;
  float* lgt = part + 8 * 16 * 48;
  int* ecnt = (int*)(lgt + 16 * 48);
  int* ebase = ecnt + 32;
  int* sl_aid = ebase + 32;
  int* sl_e = sl_aid + 512;
  const float* mod = ws_mod(p);
  if (t < NEXP) ecnt[t] = 0;
  int nloc = 0;
  for (int tile = bid; tile < NTOK / 16; tile += nb) {
    __syncthreads();
#pragma unroll
    for (int q = 0; q < 2; ++q) {
      const int tl = wid * 2 + q, gt = tile * 16 + tl, b = gt >> 11;
      const float* xr = ws_x1(p) + (size_t)gt * DM;
      f32x4 v[4]; float ss = 0.f;
#pragma unroll
      for (int i = 0; i < 4; ++i) { v[i] = *(const f32x4*)(xr + lane * 4 + 256 * i); ss += v[i][0] * v[i][0] + v[i][1] * v[i][1] + v[i][2] * v[i][2] + v[i][3] * v[i][3]; }
      ss = wave_sum(ss);
      const float rstd = rsqrtf(ss * (1.0f / DM) + 1e-6f);
#pragma unroll
      for (int i = 0; i < 4; ++i) {
        const int col = lane * 4 + 256 * i;
        const f32x4 g = *(const f32x4*)(p.norm2_g + col), sh = *(const f32x4*)(mod + b * 6144 + 3072 + col), sc = *(const f32x4*)(mod + b * 6144 + 4096 + col);
        f32x4 o;
#pragma unroll
        for (int j = 0; j < 4; ++j) o[j] = v[i][j] * rstd * g[j] * (1.0f + sc[j]) + sh[j];
        *(f32x4*)(H + tl * H_LD + col) = o;
        u32x2 w; w.x = cvtpk(o[0], o[1]); w.y = cvtpk(o[2], o[3]);
        *(u32x2*)(ws_h2(p) + (size_t)gt * DM + col) = w;
      }
    }
    __syncthreads();
    {
      f32x4m acc0 = {0.f, 0.f, 0.f, 0.f}, acc1 = acc0, acc2 = acc0;
      const float* hrow = H + l16 * H_LD + wid * 128 + lg4;
      const float* we = p.w_expert + (size_t)(wid * 128 + lg4) * 32 + l16;
      const float* wg = p.w_group + (size_t)(wid * 128 + lg4) * 4 + (l16 & 3);
#pragma unroll 8
      for (int s4 = 0; s4 < 32; ++s4) {
        const float a = hrow[s4 * 4];
        const float b0 = we[s4 * 128], b1 = we[s4 * 128 + 16];
        const float b2r = wg[s4 * 16];
        const float b2 = (l16 < 4) ? b2r : 0.f;
        acc0 = __builtin_amdgcn_mfma_f32_16x16x4f32(a, b0, acc0, 0, 0, 0);
        acc1 = __builtin_amdgcn_mfma_f32_16x16x4f32(a, b1, acc1, 0, 0, 0);
        acc2 = __builtin_amdgcn_mfma_f32_16x16x4f32(a, b2, acc2, 0, 0, 0);
      }
#pragma unroll
      for (int r = 0; r < 4; ++r) {
        float* pr = part + (wid * 16 + lg4 * 4 + r) * 48;
        pr[l16] = acc0[r]; pr[16 + l16] = acc1[r]; pr[32 + l16] = acc2[r];
      }
    }
    __syncthreads();
    for (int idx = t; idx < 16 * 36; idx += NTHR) {
      const int tok = idx / 36, o = idx % 36;
      float sacc = 0.f;
#pragma unroll
      for (int w = 0; w < 8; ++w) sacc += part[(w * 16 + tok) * 48 + o];
      sacc += (o < 32) ? p.b_expert[o] : p.b_group[o - 32];
      lgt[tok * 48 + o] = sacc;
    }
    __syncthreads();
    if (t < 16) {
      const float* l = lgt + t * 48;
      int gs = 0; float gm = l[32];
      for (int g = 1; g < 4; ++g) if (l[32 + g] > gm) { gm = l[32 + g]; gs = g; }
      float gsum = 0.f;
      for (int g = 0; g < 4; ++g) gsum += expf(l[32 + g] - gm);
      const float pgroup = 1.0f / gsum;
      const float* el = l + gs * 8;
      float em = el[0];
      for (int e = 1; e < 8; ++e) em = fmaxf(em, el[e]);
      float pe[8], esum = 0.f;
      for (int e = 0; e < 8; ++e) { pe[e] = expf(el[e] - em); esum += pe[e]; }
      for (int e = 0; e < 8; ++e) pe[e] /= esum;
      int i0 = 0;
      for (int e = 1; e < 8; ++e) if (pe[e] > pe[i0]) i0 = e;
      int i1 = (i0 == 0) ? 1 : 0;
      for (int e = 0; e < 8; ++e) if (e != i0 && pe[e] > pe[i1]) i1 = e;
      const float den = pe[i0] + pe[i1];
      const int tok = tile * 16 + t;
      const int e0 = gs * 8 + i0, e1 = gs * 8 + i1;
      ws_wa(p)[tok * 2] = pgroup * pe[i0] / den; ws_wa(p)[tok * 2 + 1] = pgroup * pe[i1] / den;
      const int slot = nloc * 32 + t * 2;
      sl_aid[slot] = tok * 2; sl_aid[slot + 1] = tok * 2 + 1;
      sl_e[slot] = e0 | (atomicAdd(ecnt + e0, 1) << 8); sl_e[slot + 1] = e1 | (atomicAdd(ecnt + e1, 1) << 8);
    }
    ++nloc;
  }
  __syncthreads();
  if (t < NEXP) ebase[t] = ecnt[t] ? atomicAdd(ws_cnt(p) + t, ecnt[t]) : 0;
  __syncthreads();
  for (int sidx = t; sidx < nloc * 32; sidx += NTHR) { const int ev = sl_e[sidx], e = ev & 255, r = ev >> 8; ws_list(p)[e * LCAP + ebase[e] + r] = sl_aid[sidx]; }
}
DI void phase7_tr(const Params& p, int bid, int nb, char* lds) {
  const int t = tid_();
  {
    float* tile = (float*)lds;
    const int ln4 = (t & 31) * 4, lkr = t >> 5, snr = t >> 2, skc = (t & 3) * 16;
#define MOE_TSRC(task_, src_, k0_, n0_, N_) const float* src_; int k0_, n0_, N_; { const int wh_ = (task_) >> 11, q_ = (task_) & 2047, e_ = q_ >> 6, r_ = q_ & 63; \
      if (wh_ < 2) { k0_ = (r_ >> 2) * 64; n0_ = (r_ & 3) * 128; N_ = 512; src_ = (wh_ == 0 ? p.e_gate : p.e_up) + (size_t)e_ * 1024 * 512; } \
      else { k0_ = (r_ >> 3) * 64; n0_ = (r_ & 7) * 128; N_ = 1024; src_ = p.e_down + (size_t)e_ * 512 * 1024; } }
    f32x4 g[4];
    int task = bid;
    if (task < 6144) { MOE_TSRC(task, src, k0, n0, N);
#pragma unroll
      for (int i = 0; i < 4; ++i) g[i] = *(const f32x4*)(src + (size_t)(k0 + lkr + 16 * i) * N + n0 + ln4); }
    for (; task < 6144; task += nb) {
      __syncthreads();
#pragma unroll
      for (int i = 0; i < 4; ++i) { float* d = tile + (lkr + 16 * i) * 129 + ln4; d[0] = g[i][0]; d[1] = g[i][1]; d[2] = g[i][2]; d[3] = g[i][3]; }
      if (task + nb < 6144) { MOE_TSRC(task + nb, src, k0, n0, N);
#pragma unroll
        for (int i = 0; i < 4; ++i) g[i] = *(const f32x4*)(src + (size_t)(k0 + lkr + 16 * i) * N + n0 + ln4); }
      __syncthreads();
      const int which = task >> 11, q = task & 2047, e = q >> 6, r = q & 63;
      float v[16];
#pragma unroll
      for (int j = 0; j < 16; ++j) v[j] = tile[(skc + j) * 129 + snr];
      u32x4 w0, w1;
      w0.x = cvtpk(v[0], v[1]); w0.y = cvtpk(v[2], v[3]); w0.z = cvtpk(v[4], v[5]); w0.w = cvtpk(v[6], v[7]);
      w1.x = cvtpk(v[8], v[9]); w1.y = cvtpk(v[10], v[11]); w1.z = cvtpk(v[12], v[13]); w1.w = cvtpk(v[14], v[15]);
      bf16_t* dst;
      if (which < 2) { const int k0 = (r >> 2) * 64, n = (r & 3) * 128 + snr; dst = ws_wgu(p) + (size_t)e * 1024 * 1024 + (size_t)((n >> 7) * 256 + (n & 127) + which * 128) * 1024 + k0 + skc; }
      else { const int k0 = (r >> 3) * 64, n = (r & 7) * 128 + snr; dst = ws_wd(p) + (size_t)e * 1024 * 512 + (size_t)n * 512 + k0 + skc; }
      *(u32x4*)dst = w0; *(u32x4*)(dst + 8) = w1;
    }
  }
}

struct Seg { int e, r0, cnt, start; };
DI Seg find_seg(const int* cnt, int mtile) {
  Seg s; s.e = -1; int acc = 0, start = 0;
  for (int e = 0; e < NEXP; ++e) { const int c = cnt[e], nt = (c + GBM - 1) / GBM; if (mtile < acc + nt) { s.e = e; s.r0 = (mtile - acc) * GBM; s.cnt = c; s.start = start; return s; } acc += nt; start += c; }
  return s;
}
struct ARowList { const int* list; int r0, cnt; DI int operator()(int r) const { int q = r0 + r; q = q < cnt ? q : cnt - 1; return list[q] >> 1; } };
struct EpiHid { bf16_t* o; int row0, nvalid, col0; DI void operator()(int r, int c, float g, float u) const {
  if (r < nvalid) o[(size_t)(row0 + r) * DEXP + ((col0 + c) >> 6) * 32 + (c & 31)] = f2bf(g / (1.0f + __expf(-g)) * u); } };
DI void phase8(const Params& p, int bid, int nb, char* lds) {
  const int* cnt = ws_cnt(p);
  for (int tile = bid; tile < 288 * 8; tile += nb) {
    const Seg s = find_seg(cnt, tile >> 3);
    if (s.e < 0) break;
    const int nt = tile & 7;
    gemm_tile(ws_h2(p), DM, ARowList{ws_list(p) + s.e * LCAP, s.r0, s.cnt}, ws_wgu(p) + (size_t)s.e * 1024 * 1024, DM, nt * GBN, DM,
              EpiHid{ws_hid(p), s.start + s.r0, s.cnt - s.r0, nt * GBN}, lds);
  }
}
struct ARowClamp { int base, r0, cnt; DI int operator()(int r) const { int q = r0 + r; q = q < cnt ? q : cnt - 1; return base + q; } };
struct EpiY { bf16_t* o; const int* list; const float* wa; int r0, cnt, col0; DI void operator()(int r, int c, float v0, float v1) const {
  if (r0 + r < cnt) { const int aid = list[r0 + r]; const float w = wa[aid]; bf16_t* q = o + (size_t)aid * DM + col0 + c; q[0] = f2bf(v0 * w); q[32] = f2bf(v1 * w); } } };
DI void phase9(const Params& p, int bid, int nb, char* lds) {
  const int* cnt = ws_cnt(p);
  for (int tile = bid; tile < 288 * 8; tile += nb) {
    const Seg s = find_seg(cnt, tile >> 3);
    if (s.e < 0) break;
    const int nt = tile & 7;
    gemm_tile(ws_hid(p), DEXP, ARowClamp{s.start, s.r0, s.cnt}, ws_wd(p) + (size_t)s.e * 1024 * 512, DEXP, nt * GBN, DEXP,
              EpiY{ws_ybuf(p), ws_list(p) + s.e * LCAP, ws_wa(p), s.r0, s.cnt, nt * GBN}, lds);
  }
}

DI void phase10(const Params& p, int bid, int nb, char* lds) {
  const int lane = tid_() & 63, wid = tid_() >> 6;
  const float* mod = ws_mod(p); const float* fm = ws_fmod(p);
  for (int gt = bid * 8 + wid; gt < NTOK; gt += nb * 8) {
    const int b = gt >> 11;
    const float* xr = ws_x1(p) + (size_t)gt * DM; float* xo = p.out + (size_t)gt * DM;
    const bf16_t* ya = ws_ybuf(p) + (size_t)(gt * 2) * DM; const bf16_t* yb = ya + DM;
    f32x4 v[4]; float ss = 0.f;
#pragma unroll
    for (int i = 0; i < 4; ++i) {
      const int col = lane * 4 + 256 * i;
      v[i] = *(const f32x4*)(xr + col);
      const u32x2 a = *(const u32x2*)(ya + col), bq = *(const u32x2*)(yb + col);
      const f32x4 g2 = *(const f32x4*)(mod + b * 6144 + 5120 + col);
      const float m0 = __uint_as_float(a.x << 16) + __uint_as_float(bq.x << 16), m1 = __uint_as_float(a.x & 0xffff0000u) + __uint_as_float(bq.x & 0xffff0000u);
      const float m2 = __uint_as_float(a.y << 16) + __uint_as_float(bq.y << 16), m3 = __uint_as_float(a.y & 0xffff0000u) + __uint_as_float(bq.y & 0xffff0000u);
      v[i][0] += (1.0f + g2[0]) * m0; v[i][1] += (1.0f + g2[1]) * m1; v[i][2] += (1.0f + g2[2]) * m2; v[i][3] += (1.0f + g2[3]) * m3;
      ss += v[i][0] * v[i][0] + v[i][1] * v[i][1] + v[i][2] * v[i][2] + v[i][3] * v[i][3];
    }
    ss = wave_sum(ss);
    const float rstd = rsqrtf(ss * (1.0f / DM) + 1e-6f);
#pragma unroll
    for (int i = 0; i < 4; ++i) {
      const int col = lane * 4 + 256 * i;
      const f32x4 g = *(const f32x4*)(p.final_norm_g + col), sh = *(const f32x4*)(fm + b * 2048 + col), sc = *(const f32x4*)(fm + b * 2048 + 1024 + col);
      f32x4 o;
#pragma unroll
      for (int j = 0; j < 4; ++j) o[j] = v[i][j] * rstd * g[j] * (1.0f + sc[j]) + sh[j];
      *(f32x4*)(xo + col) = o;
    }
  }
}

#define XB_TMO      128
#define XB_XCNT(j)  (256  + 64 * (j))
#define XB_XSUB(j)  (1280 + 64 * (j))
#define XB_XGEN(j)  (2304 + 64 * (j))
#define XB_TOP      3328
#define XB_TOPGEN   3392
#define XCD_BAR_WORDS 3456
#define XB_SPIN_CAP (1u << 18)
#define XLAS __attribute__((address_space(3)))

__device__ __forceinline__ unsigned xb_ld(unsigned* p)              { return __hip_atomic_load(p, __ATOMIC_RELAXED, __HIP_MEMORY_SCOPE_AGENT); }
__device__ __forceinline__ unsigned xb_add(unsigned* p, unsigned v) { return __hip_atomic_fetch_add(p, v, __ATOMIC_RELAXED, __HIP_MEMORY_SCOPE_AGENT); }
__device__ __forceinline__ unsigned xb_xcc_id() { return (unsigned)__builtin_amdgcn_s_getreg((3 << 11) | 20) & 0xFu; }
#define XB_SPIN(cond, bar) do { unsigned _sp = 0; while (cond) { __builtin_amdgcn_s_sleep(1); \
    if ((++_sp & 255u) == 0u) { if (xb_ld(&(bar)[XB_TMO])) break; if (_sp > XB_SPIN_CAP) { atomicAdd(&(bar)[XB_TMO], 1u); break; } } } } while (0)

struct XcdBarrier {
    unsigned* bar; unsigned x;
    volatile XLAS unsigned* st;
};

__device__ __forceinline__ XcdBarrier xcd_barrier_post(unsigned* bar, volatile XLAS unsigned* st) {
    XcdBarrier b; b.bar = bar; b.x = xb_xcc_id(); b.st = st;
    if (threadIdx.x == 0) (void)xb_add(&bar[XB_XCNT(b.x)], 1u);
    return b;
}
__device__ __forceinline__ void xcd_barrier_complete(unsigned* bar, unsigned x, unsigned& nloc, unsigned& nx) {
    const unsigned G = gridDim.x * gridDim.y * gridDim.z;
    unsigned sum, cnt, mine, sp = 0u;
    for (;;) {
        sum = 0u; cnt = 0u; mine = 0u;
#pragma unroll
        for (unsigned j = 0; j < 16; ++j) { const unsigned c = xb_ld(&bar[XB_XCNT(j)]); sum += c; cnt += (c > 0u) ? 1u : 0u; mine = (j == x) ? c : mine; }
        if (sum == G) break;
        __builtin_amdgcn_s_sleep(1);
        if ((++sp & 255u) == 0u) { if (xb_ld(&bar[XB_TMO])) break; if (sp > XB_SPIN_CAP) { atomicAdd(&bar[XB_TMO], 1u); break; } }
    }
    nloc = mine > 0u ? mine : 1u; nx = cnt > 0u ? cnt : 1u;
}

__device__ __forceinline__ void xcd_barrier(const XcdBarrier& b) {
    asm volatile("s_waitcnt vmcnt(0)" ::: "memory");
    __syncthreads();
    if (threadIdx.x == 0) {
        unsigned* bar = b.bar;
        __builtin_amdgcn_s_waitcnt(0);
        unsigned nloc = b.st[0], nx = b.st[1];
        if (nloc == 0u) { xcd_barrier_complete(bar, b.x, nloc, nx); b.st[0] = nloc; b.st[1] = nx; }
        const unsigned old = xb_add(&bar[XB_XSUB(b.x)], 1u);
        const unsigned gen = old / nloc;
        if (old + 1u == (gen + 1u) * nloc) {
            __builtin_amdgcn_fence(__ATOMIC_RELEASE, "agent");
            asm volatile("s_waitcnt vmcnt(0)" ::: "memory");
            const unsigned og = xb_add(&bar[XB_TOP], 1u);
            const unsigned tg = og / nx;
            if (og + 1u == (tg + 1u) * nx) xb_add(&bar[XB_TOPGEN], 1u);
            else XB_SPIN(xb_ld(&bar[XB_TOPGEN]) == tg, bar);
            __builtin_amdgcn_fence(__ATOMIC_ACQUIRE, "agent");
            xb_add(&bar[XB_XGEN(b.x)], 1u);
            asm volatile("s_waitcnt vmcnt(0)" ::: "memory");
        } else {
            XB_SPIN(xb_ld(&bar[XB_XGEN(b.x)]) == gen, bar);
            __builtin_amdgcn_fence(__ATOMIC_ACQUIRE, "agent");
            asm volatile("s_waitcnt vmcnt(0)" ::: "memory");
        }
    }
    __syncthreads();
}

#if MEGA
__global__ void __launch_bounds__(NTHR) k_mega(Params p) {
  extern __shared__ __attribute__((aligned(16))) char smem[];
  cg::grid_group grid = cg::this_grid();
  const int bid = blockIdx.x, nb = gridDim.x;
  volatile XLAS unsigned* xst = (volatile XLAS unsigned*)(XLAS char*)(smem + LDS_BYTES - 64);
  if (threadIdx.x < 4) xst[threadIdx.x] = 0u;
  if (bid == 0) for (int i = threadIdx.x; i < XCD_BAR_WORDS; i += NTHR) ws_bar(p)[i] = 0u;
  phase0(p, bid, nb, smem);
  grid.sync();
  XcdBarrier xb = xcd_barrier_post(ws_bar(p), xst);
#define SEAM() xcd_barrier(xb)
  phase1(p, bid, nb, smem); SEAM();
  phase2_pg8(p, bid, nb, smem); SEAM();
  phase3_mfma<3>(p, bid, nb, smem); SEAM();
  phase4a_chunk(p, bid, nb, smem); phase4b_mfma(p, bid, nb, smem); SEAM();
  phase5a(p, bid, nb, smem); phase5b_mfma(p, bid, nb, smem); SEAM();
  phase6_pg8(p, bid, nb, smem); SEAM();
  phase7(p, bid, nb, smem); SEAM();
  phase8_pg8(p, bid, nb, smem); SEAM();
  phase9_pg8(p, bid, nb, smem); SEAM();
  phase10(p, bid, nb, smem);
}
#else
#define PHASE_KERNEL(name, body) __global__ void __launch_bounds__(NTHR) name(Params p) { extern __shared__ __attribute__((aligned(16))) char smem[]; body(p, blockIdx.x, gridDim.x, smem); }
PHASE_KERNEL(k_phase0, phase0)
PHASE_KERNEL(k_phase1, phase1)
PHASE_KERNEL(k_phase2, phase2)
PHASE_KERNEL(k_phase3a, phase3a)
PHASE_KERNEL(k_phase3b, phase3b)
PHASE_KERNEL(k_phase4a, phase4a)
PHASE_KERNEL(k_phase4a2, phase4a_v2)
PHASE_KERNEL(k_phase4a3, phase4a_v3)
PHASE_KERNEL(k_phase4b, phase4b)
PHASE_KERNEL(k_phase4bm, phase4b_mfma)
PHASE_KERNEL(k_phase3m, phase3_mfma<3>)
PHASE_KERNEL(k_phase5a, phase5a)
PHASE_KERNEL(k_phase5b, phase5b)
PHASE_KERNEL(k_phase5bm, phase5b_mfma)
PHASE_KERNEL(k_phase6, phase6)
PHASE_KERNEL(k_phase7, phase7)
PHASE_KERNEL(k_phase8, phase8)
PHASE_KERNEL(k_phase9, phase9)
PHASE_KERNEL(k_phase10, phase10)
#endif

extern "C" void kernel_launch(void* const* d_in, const int* in_sizes, int n_in, void* d_out, int out_size, void* d_ws, size_t ws_size, hipStream_t stream) {
  Params p{};
  const float** f = (const float**)&p;
  for (int i = 0; i < 33; ++i) f[i] = (const float*)d_in[i];
  p.out = (float*)d_out; p.ws = (char*)d_ws;
  if (n_in != 33 || ws_size < (size_t)(OFF_S + 9 * MiB) || out_size != NTOK * DM) { fprintf(stderr, "kernel_launch: unexpected problem shape or workspace (n_in %d, ws %zu, out %d)\n", n_in, ws_size, out_size); return; }
#if MEGA
  static int grid_blocks = 0;
  if (!grid_blocks) {
    int dev = 0, cus = 0, per_cu = 0;
    hipGetDevice(&dev);
    hipDeviceGetAttribute(&cus, hipDeviceAttributeMultiprocessorCount, dev);
    hipFuncSetAttribute((const void*)k_mega, hipFuncAttributeMaxDynamicSharedMemorySize, LDS_BYTES);
    hipOccupancyMaxActiveBlocksPerMultiprocessor(&per_cu, k_mega, NTHR, LDS_BYTES);
    if (per_cu > 1) per_cu = 1;
    grid_blocks = cus * per_cu;
  }
  void* args[] = {&p};
  hipError_t e = hipLaunchCooperativeKernel((void*)k_mega, dim3(grid_blocks), dim3(NTHR), args, LDS_BYTES, stream);
  if (e != hipSuccess) fprintf(stderr, "cooperative launch failed: %s (grid %d)\n", hipGetErrorString(e), grid_blocks);
#else
  const int G = 512;
#define LAUNCH(k, g) hipLaunchKernelGGL(k, dim3(g), dim3(NTHR), LDS_BYTES, stream, p)
  LAUNCH(k_phase0, G);
  LAUNCH(k_phase1, G);
  LAUNCH(k_phase2, G);
  LAUNCH(k_phase3a, G);
  LAUNCH(k_phase3b, G);
  LAUNCH(k_phase4a, 128);
  LAUNCH(k_phase4b, 1024);
  LAUNCH(k_phase5a, G);
  LAUNCH(k_phase5b, 1024);
  LAUNCH(k_phase6, G);
  LAUNCH(k_phase7, G);
  LAUNCH(k_phase8, G);
  LAUNCH(k_phase9, G);
  LAUNCH(k_phase10, G);
#endif
}
```

```cpp
#include <hip/hip_runtime.h>
#include <hip/hip_cooperative_groups.h>
#include <stdint.h>
#include <stdio.h>

namespace cg = cooperative_groups;

#ifndef MEGA
#define MEGA 1
#endif

typedef unsigned short bf16_t;
typedef short bf16x8 __attribute__((ext_vector_type(8)));
typedef float f32x16 __attribute__((ext_vector_type(16)));
typedef float f32x4 __attribute__((ext_vector_type(4)));
typedef float f32x4v __attribute__((ext_vector_type(4)));
typedef unsigned u32x4 __attribute__((ext_vector_type(4)));
typedef unsigned u32x2 __attribute__((ext_vector_type(2)));

#define DI __device__ __forceinline__

constexpr int DM = 1024, BATCH = 16, SEQ = 2048, NTOK = BATCH * SEQ;
constexpr int RW = 512, NH = 8, HD = 64;
constexpr int PROJ_N = 2756, PROJ_LD = 2816;
constexpr int C_R = 0, C_K = 512, C_V = 1024, C_WL = 1536, C_AL = 1600, C_GL = 1664;
constexpr int C_Q = 1792, C_CKV = 2304, C_QI = 2432, C_KI = 2688, C_WI = 2752;
constexpr int NEXP = 32, DEXP = 512, LCAP = 32768;
constexpr int NTHR = 512;
constexpr int LDS_BYTES = 163840;

constexpr size_t MiB = 1048576;
constexpr size_t OFF_A = 0;
constexpr size_t OFF_B = 64 * MiB;
constexpr size_t OFF_C = 240 * MiB;
constexpr size_t OFF_F = 400 * MiB;
constexpr size_t OFF_G = 464 * MiB;
constexpr size_t OFF_W = 484 * MiB;
constexpr size_t OFF_S = 492 * MiB;

struct Params {
  const float *x, *c, *ada_w, *ada_b, *norm1_g, *w_in, *shift_mu, *w0, *w_decay_up, *a0, *w_aaa_up, *w_gate_up;
  const float *k_k, *k_a, *r_k, *gn_g, *gn_b, *kv_norm_g, *k_idx_norm_g, *w_uk, *w_uv, *w_out, *norm2_g;
  const float *w_group, *b_group, *w_expert, *b_expert, *e_gate, *e_up, *e_down, *final_ada_w, *final_ada_b, *final_norm_g;
  float* out;
  char* ws;
};

DI int tid_() { int t = threadIdx.x; asm volatile("" : "+v"(t)); return t; }
DI float bf2f(bf16_t u) { return __uint_as_float(((unsigned)u) << 16); }
DI bf16_t f2bf(float f) { unsigned u = __float_as_uint(f); u += 0x7fffu + ((u >> 16) & 1u); return (bf16_t)(u >> 16); }
DI unsigned pack2(float lo, float hi) { return (unsigned)f2bf(lo) | ((unsigned)f2bf(hi) << 16); }
DI float wave_sum(float v) { for (int o = 32; o; o >>= 1) v += __shfl_xor(v, o); return v; }
DI float wave_max(float v) { for (int o = 32; o; o >>= 1) v = fmaxf(v, __shfl_xor(v, o)); return v; }
DI float sigmoidf_(float v) { return 1.0f / (1.0f + __expf(-v)); }
DI int crow(int r, int hi) { return (r & 3) + 8 * (r >> 2) + 4 * hi; }
DI unsigned cvtpk(float lo, float hi) { unsigned r; asm volatile("v_cvt_pk_bf16_f32 %0, %1, %2" : "=v"(r) : "v"(lo), "v"(hi)); return r; }

DI void unpack8(const u32x4 w, float* o) {
  o[0] = __uint_as_float(w.x << 16); o[1] = __uint_as_float(w.x & 0xffff0000u); o[2] = __uint_as_float(w.y << 16); o[3] = __uint_as_float(w.y & 0xffff0000u);
  o[4] = __uint_as_float(w.z << 16); o[5] = __uint_as_float(w.z & 0xffff0000u); o[6] = __uint_as_float(w.w << 16); o[7] = __uint_as_float(w.w & 0xffff0000u);
}
DI void load8(const bf16_t* p, float* o) { unpack8(*(const u32x4*)p, o); }

DI bf16_t* ws_h1(const Params& p) { return (bf16_t*)(p.ws + OFF_A); }
DI float* ws_y(const Params& p) { return (float*)(p.ws + OFF_A); }
DI bf16_t* ws_h2(const Params& p) { return (bf16_t*)(p.ws + OFF_A); }
DI bf16_t* ws_proj(const Params& p) { return (bf16_t*)(p.ws + OFF_B); }
DI float* ws_x1(const Params& p) { return (float*)(p.ws + OFF_B); }
DI bf16_t* ws_wgu(const Params& p) { return (bf16_t*)p.out; }
DI bf16_t* ws_wd(const Params& p) { return (bf16_t*)((char*)p.out + 64 * MiB); }
DI bf16_t* ws_hid(const Params& p) { return (bf16_t*)(p.ws + OFF_B + 96 * MiB); }
DI bf16_t* ws_kp(const Params& p) { return (bf16_t*)(p.ws + OFF_C); }
DI bf16_t* ws_kk(const Params& p) { return (bf16_t*)(p.ws + OFF_C + 32 * MiB); }
DI bf16_t* ws_bb(const Params& p) { return (bf16_t*)(p.ws + OFF_C + 64 * MiB); }
DI bf16_t* ws_ee(const Params& p) { return (bf16_t*)(p.ws + OFF_C + 96 * MiB); }
DI bf16_t* ws_gg(const Params& p) { return (bf16_t*)(p.ws + OFF_C + 128 * MiB); }
DI bf16_t* ws_mix(const Params& p) { return (bf16_t*)(p.ws + OFF_C); }
DI bf16_t* ws_ybuf(const Params& p) { return (bf16_t*)(p.ws + OFF_C); }
DI bf16_t* ws_qlat(const Params& p) { return (bf16_t*)(p.ws + OFF_F); }
DI bf16_t* ws_ckv(const Params& p) { return (bf16_t*)(p.ws + OFF_G); }
DI bf16_t* ws_kidx(const Params& p) { return (bf16_t*)(p.ws + OFF_G + 8 * MiB); }
DI unsigned* ws_mask(const Params& p) { return (unsigned*)(p.ws + OFF_G + 12 * MiB); }
DI bf16_t* ws_wtin(const Params& p) { return (bf16_t*)(p.ws + OFF_W); }
DI bf16_t* ws_wtout(const Params& p) { return (bf16_t*)(p.ws + OFF_W + 6 * MiB); }
DI bf16_t* ws_wuvt(const Params& p) { return (bf16_t*)(p.ws + OFF_S + 7 * MiB); }
DI bf16_t* ws_wdt(const Params& p) { return (bf16_t*)(p.ws + OFF_S + 8 * MiB + 64 * 1024); }
DI bf16_t* ws_wat(const Params& p) { return (bf16_t*)(p.ws + OFF_S + 8 * MiB + 128 * 1024); }
DI bf16_t* ws_wgt(const Params& p) { return (bf16_t*)(p.ws + OFF_S + 8 * MiB + 192 * 1024); }
DI bf16_t* ws_wukt(const Params& p) { return (bf16_t*)(p.ws + OFF_S + 8 * MiB + 320 * 1024); }
DI unsigned* ws_bar(const Params& p) { return (unsigned*)(p.ws + OFF_S + 8 * MiB); }
DI float* ws_mod(const Params& p) { return (float*)(p.ws + OFF_S); }
DI float* ws_fmod(const Params& p) { return (float*)(p.ws + OFF_S + 512 * 1024); }
DI float* ws_bonus(const Params& p) { return (float*)(p.ws + OFF_S + 1 * MiB); }
DI int* ws_cnt(const Params& p) { return (int*)(p.ws + OFF_S + 2 * MiB); }
DI float* ws_wa(const Params& p) { return (float*)(p.ws + OFF_S + 2 * MiB + 4096); }
DI int* ws_list(const Params& p) { return (int*)(p.ws + OFF_S + 3 * MiB); }

template <class RowMap>
DI void transpose_tile(const float* src, int N, int k0, int n0, bf16_t* dst, int dstld, RowMap rm, char* lds) {
  float* tile = (float*)lds;
  const int t = tid_();
  __syncthreads();
  {
    const int nc = t & 63, krb = t >> 6;
#pragma unroll
    for (int i = 0; i < 8; ++i) {
      const int kr = krb + 8 * i;
      const int n = n0 + nc;
      tile[kr * 65 + nc] = (n < N) ? src[(size_t)(k0 + kr) * N + n] : 0.f;
    }
  }
  __syncthreads();
  {
    const int nr = t >> 3, kc = (t & 7) * 8;
    u32x4 w;
    w.x = pack2(tile[(kc + 0) * 65 + nr], tile[(kc + 1) * 65 + nr]);
    w.y = pack2(tile[(kc + 2) * 65 + nr], tile[(kc + 3) * 65 + nr]);
    w.z = pack2(tile[(kc + 4) * 65 + nr], tile[(kc + 5) * 65 + nr]);
    w.w = pack2(tile[(kc + 6) * 65 + nr], tile[(kc + 7) * 65 + nr]);
    *(u32x4*)(dst + (size_t)rm(n0 + nr) * dstld + k0 + kc) = w;
  }
}
struct RowId { DI int operator()(int n) const { return n; } };
struct RowGU { int add; DI int operator()(int n) const { return (n >> 7) * 256 + (n & 127) + add; } };

DI void phase0(const Params& p, int bid, int nb, char* lds) {
  const int t = tid_();
  if (bid == 0 && t < NEXP) ws_cnt(p)[t] = 0;
  for (int idx = bid * NTHR + t; idx < 8 * 64 * 128; idx += nb * NTHR) {
    const int hh = idx >> 13, d = (idx >> 7) & 63, cc = idx & 127;
    ws_wuvt(p)[idx] = f2bf(p.w_uv[(size_t)(cc * NH + hh) * HD + d]);
    const int h2 = idx >> 13, c2 = (idx >> 6) & 127, d2 = idx & 63;
    ws_wukt(p)[idx] = f2bf(p.w_uk[(size_t)(c2 * NH + h2) * HD + d2]);
  }
  for (int task = bid; task < 32; task += nb) {
    if (task < 8) transpose_tile(p.w_decay_up, RW, 0, task * 64, ws_wdt(p), 64, RowId(), lds);
    else if (task < 16) transpose_tile(p.w_aaa_up, RW, 0, (task - 8) * 64, ws_wat(p), 64, RowId(), lds);
    else { const int q = task - 16; transpose_tile(p.w_gate_up, RW, (q >> 3) * 64, (q & 7) * 64, ws_wgt(p), 128, RowId(), lds); }
  }
  for (int task = bid; task < 256; task += nb) {
    float* cact = (float*)lds;
    __syncthreads();
    for (int i = t; i < 16 * 1024; i += NTHR) { const float v = p.c[i]; cact[i] = v / (1.0f + __expf(-v)); }
    __syncthreads();
    const int col = task * 32 + (t & 31), ks = t >> 5;
    const float* w; int ld, cc;
    if (col < 6144) { w = p.ada_w; ld = 6144; cc = col; } else { w = p.final_ada_w; ld = 2048; cc = col - 6144; }
    float acc[16];
#pragma unroll
    for (int b = 0; b < 16; ++b) acc[b] = 0.f;
    for (int kk = 0; kk < 64; ++kk) {
      const int k = ks * 64 + kk;
      const float wv = w[(size_t)k * ld + cc];
#pragma unroll
      for (int b = 0; b < 16; ++b) acc[b] += cact[b * 1024 + k] * wv;
    }
    __syncthreads();
    float* red = (float*)lds;
#pragma unroll
    for (int b = 0; b < 16; ++b) red[(ks * 16 + b) * 32 + (t & 31)] = acc[b];
    __syncthreads();
    {
      const int b = t >> 5, cl = t & 31, colo = task * 32 + cl;
      float s = 0.f;
      for (int k2 = 0; k2 < 16; ++k2) s += red[(k2 * 16 + b) * 32 + cl];
      if (colo < 6144) ws_mod(p)[b * 6144 + colo] = s + p.ada_b[colo];
      else ws_fmod(p)[b * 2048 + colo - 6144] = s + p.final_ada_b[colo - 6144];
    }
  }
  for (int task = bid; task < 704 + 256; task += nb) {
    if (task < 704) { const int kt = task / 44, nt = task % 44; transpose_tile(p.w_in, PROJ_N, kt * 64, nt * 64, ws_wtin(p), 1024, RowId(), lds); }
    else { const int q = task - 704, kt = q >> 4, nt = q & 15; transpose_tile(p.w_out, 1024, kt * 64, nt * 64, ws_wtout(p), 1024, RowId(), lds); }
  }
}

DI void phase1(const Params& p, int bid, int nb, char* lds) {
  const int lane = tid_() & 63, wid = tid_() >> 6;
  const float* mod = ws_mod(p);
  for (int row = bid * 8 + wid; row < NTOK; row += nb * 8) {
    const int b = row >> 11;
    const float* xr = p.x + (size_t)row * DM;
    f32x4 v[4]; float ss = 0.f;
#pragma unroll
    for (int i = 0; i < 4; ++i) { v[i] = *(const f32x4*)(xr + lane * 4 + 256 * i); ss += v[i][0] * v[i][0] + v[i][1] * v[i][1] + v[i][2] * v[i][2] + v[i][3] * v[i][3]; }
    ss = wave_sum(ss);
    const float rstd = rsqrtf(ss * (1.0f / DM) + 1e-6f);
#pragma unroll
    for (int i = 0; i < 4; ++i) {
      const int col = lane * 4 + 256 * i;
      const f32x4 g = *(const f32x4*)(p.norm1_g + col), sh = *(const f32x4*)(mod + b * 6144 + col), sc = *(const f32x4*)(mod + b * 6144 + 1024 + col);
      float o[4];
#pragma unroll
      for (int j = 0; j < 4; ++j) o[j] = v[i][j] * rstd * g[j] * (1.0f + sc[j]) + sh[j];
      u32x2 w; w.x = pack2(o[0], o[1]); w.y = pack2(o[2], o[3]);
      *(u32x2*)(ws_h1(p) + (size_t)row * DM + col) = w;
    }
  }
}

constexpr int GBM = 256, GBN = 128, GBK = 32, GROW = 80, G_LDSA = GBM * GROW, G_STAGE = (GBM + GBN) * GROW;
template <class ARow, class Epi>
DI void gemm_tile(const bf16_t* A, int lda, ARow arow, const bf16_t* Bt, int ldb, int n0, int K, Epi epi, char* lds) {
  const int t = tid_(), lane = t & 63, wid = t >> 6, wm = wid >> 1, wn = wid & 1, r32 = lane & 31, hi = lane >> 5;
  const int srow = t >> 2, sch = t & 3;
  const bf16_t* a0p = A + (size_t)arow(srow) * lda + sch * 8;
  const bf16_t* a1p = A + (size_t)arow(srow + 128) * lda + sch * 8;
  const bf16_t* bp = Bt + (size_t)(n0 + srow) * ldb + sch * 8;
  const int wa0 = srow * GROW + sch * 16, wa1 = (srow + 128) * GROW + sch * 16, wb = G_LDSA + srow * GROW + sch * 16;
  const int ra = (wm * 64 + r32) * GROW + hi * 16, rb = G_LDSA + (wn * 64 + r32) * GROW + hi * 16;
  f32x16 acc[2][2];
#pragma unroll
  for (int i = 0; i < 2; ++i)
#pragma unroll
    for (int j = 0; j < 2; ++j)
#pragma unroll
      for (int r = 0; r < 16; ++r) acc[i][j][r] = 0.f;
  u32x4 ga0 = *(const u32x4*)a0p, ga1 = *(const u32x4*)a1p, gb = *(const u32x4*)bp;
  __syncthreads();
  *(u32x4*)(lds + wa0) = ga0; *(u32x4*)(lds + wa1) = ga1; *(u32x4*)(lds + wb) = gb;
  __syncthreads();
  const int nk = K / GBK;
  for (int kt = 0; kt < nk; ++kt) {
    char* cur = lds + (kt & 1) * G_STAGE;
    char* nxt = lds + ((kt + 1) & 1) * G_STAGE;
    if (kt + 1 < nk) { ga0 = *(const u32x4*)(a0p + (kt + 1) * GBK); ga1 = *(const u32x4*)(a1p + (kt + 1) * GBK); gb = *(const u32x4*)(bp + (kt + 1) * GBK); }
#pragma unroll
    for (int ks = 0; ks < 2; ++ks) {
      bf16x8 a[2], b[2];
#pragma unroll
      for (int i = 0; i < 2; ++i) { a[i] = *(const bf16x8*)(cur + ra + i * 32 * GROW + ks * 32); b[i] = *(const bf16x8*)(cur + rb + i * 32 * GROW + ks * 32); }
#pragma unroll
      for (int i = 0; i < 2; ++i)
#pragma unroll
        for (int j = 0; j < 2; ++j) acc[i][j] = __builtin_amdgcn_mfma_f32_32x32x16_bf16(a[i], b[j], acc[i][j], 0, 0, 0);
    }
    if (kt + 1 < nk) { *(u32x4*)(nxt + wa0) = ga0; *(u32x4*)(nxt + wa1) = ga1; *(u32x4*)(nxt + wb) = gb; }
    __syncthreads();
  }
#pragma unroll
  for (int i = 0; i < 2; ++i)
#pragma unroll
    for (int r = 0; r < 16; ++r) epi(wm * 64 + i * 32 + crow(r, hi), wn * 64 + r32, acc[i][0][r], acc[i][1][r]);
}

struct ARowBase { int base; DI int operator()(int r) const { return base + r; } };

struct EpiProj { bf16_t* o; int row0, col0; DI void operator()(int r, int c, float v0, float v1) const {
  bf16_t* q = o + (size_t)(row0 + r) * PROJ_LD + col0 + c; q[0] = f2bf(v0); q[32] = f2bf(v1); } };
DI void phase2(const Params& p, int bid, int nb, char* lds) {
  constexpr int NT = PROJ_LD / GBN;
  for (int tile = bid; tile < (NTOK / GBM) * NT; tile += nb) {
    const int mt = tile / NT, nt = tile % NT;
    gemm_tile(ws_h1(p), DM, ARowBase{mt * GBM}, ws_wtin(p), DM, nt * GBN, DM, EpiProj{ws_proj(p), mt * GBM, nt * GBN}, lds);
  }
}

DI float proj_shift(const bf16_t* proj, const float* mu, int gt, int col) {
  const float pv = bf2f(proj[(size_t)gt * PROJ_LD + col]);
  const float pp = (gt & (SEQ - 1)) ? bf2f(proj[(size_t)(gt - 1) * PROJ_LD + col]) : 0.f;
  return pv + mu[col] * (pp - pv);
}
DI void phase3a(const Params& p, int bid, int nb, char* lds) {
  const int t = tid_(), lane = t & 63, wid = t >> 6;
  float* xl = (float*)lds;
  const bf16_t* proj = ws_proj(p);
  for (int tile = bid; tile < NTOK / 16; tile += nb) {
    const int t0 = tile * 16;
    __syncthreads();
    for (int idx = t; idx < 16 * 256; idx += NTHR) {
      const int tok = idx >> 8, col = idx & 255;
      float v = proj_shift(proj, p.shift_mu, t0 + tok, C_WL + col);
      if (col < 64) v = tanhf(v); else if (col >= 128) v = sigmoidf_(v);
      xl[idx] = v;
    }
    __syncthreads();
    const int c = t;
    float acc[16];
#pragma unroll
    for (int i = 0; i < 16; ++i) acc[i] = 0.f;
    for (int k4 = 0; k4 < 16; ++k4) {
      float w[4];
#pragma unroll
      for (int j = 0; j < 4; ++j) w[j] = p.w_decay_up[(k4 * 4 + j) * RW + c];
#pragma unroll
      for (int i = 0; i < 16; ++i) { const f32x4 xv = *(const f32x4*)(xl + i * 256 + k4 * 4); acc[i] += xv[0] * w[0] + xv[1] * w[1] + xv[2] * w[2] + xv[3] * w[3]; }
    }
    {
      const float w0c = p.w0[c];
#pragma unroll
      for (int i = 0; i < 16; ++i) {
        const float z = -(w0c + acc[i]);
        const float sp = fmaxf(z, 0.f) + log1pf(__expf(-fabsf(z)));
        ws_ee(p)[(size_t)(t0 + i) * RW + c] = f2bf(__expf(-sp - 0.5f));
      }
    }
#pragma unroll
    for (int i = 0; i < 16; ++i) acc[i] = 0.f;
    for (int k4 = 0; k4 < 32; ++k4) {
      float w[4];
#pragma unroll
      for (int j = 0; j < 4; ++j) w[j] = p.w_gate_up[(k4 * 4 + j) * RW + c];
#pragma unroll
      for (int i = 0; i < 16; ++i) { const f32x4 xv = *(const f32x4*)(xl + i * 256 + 128 + k4 * 4); acc[i] += xv[0] * w[0] + xv[1] * w[1] + xv[2] * w[2] + xv[3] * w[3]; }
    }
#pragma unroll
    for (int i = 0; i < 16; ++i) ws_gg(p)[(size_t)(t0 + i) * RW + c] = f2bf(acc[i]);
#pragma unroll
    for (int i = 0; i < 16; ++i) acc[i] = 0.f;
    for (int k4 = 0; k4 < 16; ++k4) {
      float w[4];
#pragma unroll
      for (int j = 0; j < 4; ++j) w[j] = p.w_aaa_up[(k4 * 4 + j) * RW + c];
#pragma unroll
      for (int i = 0; i < 16; ++i) { const f32x4 xv = *(const f32x4*)(xl + i * 256 + 64 + k4 * 4); acc[i] += xv[0] * w[0] + xv[1] * w[1] + xv[2] * w[2] + xv[3] * w[3]; }
    }
    {
      const float a0c = p.a0[c], kkc = p.k_k[c], kac = p.k_a[c], rkc = p.r_k[c];
#pragma unroll
      for (int i = 0; i < 16; ++i) {
        const int gt = t0 + i;
        const float a = sigmoidf_(a0c + acc[i]);
        const float r = proj_shift(proj, p.shift_mu, gt, C_R + c);
        const float k = proj_shift(proj, p.shift_mu, gt, C_K + c);
        float kk = k * kkc;
        const float nrm = fmaxf(sqrtf(wave_sum(kk * kk)), 1e-12f);
        kk = kk / nrm;
        const float kp = k * (1.0f + (a - 1.0f) * kac);
        const float bs = wave_sum(r * kp * rkc);
        ws_kp(p)[(size_t)gt * RW + c] = f2bf(kp);
        ws_kk(p)[(size_t)gt * RW + c] = f2bf(kk);
        ws_bb(p)[(size_t)gt * RW + c] = f2bf(kk * a);
        if (lane == 0) ws_bonus(p)[gt * NH + wid] = bs;
      }
    }
  }
}

DI void phase3b(const Params& p, int bid, int nb, char* lds) {
  const int t = tid_(), lane = t & 63, wid = t >> 6;
  float* ql = (float*)lds;
  const bf16_t* proj = ws_proj(p);
  for (int tile = bid; tile < NTOK / 16; tile += nb) {
    const int t0 = tile * 16;
    __syncthreads();
    for (int idx = t; idx < 16 * 512; idx += NTHR) ql[idx] = bf2f(proj[(size_t)(t0 + (idx >> 9)) * PROJ_LD + C_Q + (idx & 511)]);
#pragma unroll
    for (int q = 0; q < 2; ++q) {
      const int gt = t0 + wid * 2 + q;
      const float v0 = bf2f(proj[(size_t)gt * PROJ_LD + C_CKV + lane * 2]), v1 = bf2f(proj[(size_t)gt * PROJ_LD + C_CKV + lane * 2 + 1]);
      const float rs = rsqrtf(wave_sum(v0 * v0 + v1 * v1) * (1.0f / 128.0f) + 1e-6f);
      *(unsigned*)(ws_ckv(p) + (size_t)gt * 128 + lane * 2) = pack2(v0 * rs * p.kv_norm_g[lane * 2], v1 * rs * p.kv_norm_g[lane * 2 + 1]);
      const float u = bf2f(proj[(size_t)gt * PROJ_LD + C_KI + lane]);
      const float rs2 = rsqrtf(wave_sum(u * u) * (1.0f / 64.0f) + 1e-6f);
      ws_kidx(p)[(size_t)gt * 64 + lane] = f2bf(u * rs2 * p.k_idx_norm_g[lane]);
    }
    __syncthreads();
    const int h = wid;
#pragma unroll 1
    for (int ps = 0; ps < 2; ++ps) {
      const int cidx = lane + 64 * ps;
      float w[64];
      const float* wp = p.w_uk + (size_t)(cidx * NH + h) * HD;
#pragma unroll
      for (int d4 = 0; d4 < 16; ++d4) { const f32x4 wv = *(const f32x4*)(wp + d4 * 4); w[d4 * 4] = wv[0]; w[d4 * 4 + 1] = wv[1]; w[d4 * 4 + 2] = wv[2]; w[d4 * 4 + 3] = wv[3]; }
#pragma unroll 1
      for (int i = 0; i < 16; ++i) {
        float acc = 0.f;
#pragma unroll
        for (int d4 = 0; d4 < 16; ++d4) { const f32x4 qv = *(const f32x4*)(ql + i * 512 + h * 64 + d4 * 4); acc += qv[0] * w[d4 * 4] + qv[1] * w[d4 * 4 + 1] + qv[2] * w[d4 * 4 + 2] + qv[3] * w[d4 * 4 + 3]; }
        ws_qlat(p)[((size_t)(t0 + i) * NH + h) * 128 + cidx] = f2bf(acc * 0.125f);
      }
    }
  }
}

DI float xhalf_sum(float v) { auto rr = __builtin_amdgcn_permlane32_swap(__float_as_uint(v), __float_as_uint(v), false, false); return __uint_as_float(rr[0]) + __uint_as_float(rr[1]); }
DI float dpp_sum8(float v) {
  v += __int_as_float(__builtin_amdgcn_update_dpp(0, __float_as_int(v), 0xB1, 0xF, 0xF, true));
  v += __int_as_float(__builtin_amdgcn_update_dpp(0, __float_as_int(v), 0x4E, 0xF, 0xF, true));
  v += __int_as_float(__builtin_amdgcn_update_dpp(0, __float_as_int(v), 0x141, 0xF, 0xF, true));
  return v;
}
DI float dpp_sum16b(float v) { v = dpp_sum8(v); v += __int_as_float(__builtin_amdgcn_update_dpp(0, __float_as_int(v), 0x140, 0xF, 0xF, true)); return v; }
DI u32x2 pk4(float a, float b, float c, float d) { u32x2 w; w.x = cvtpk(a, b); w.y = cvtpk(c, d); return w; }
DI void ld4(const bf16_t* p, float* o) { const u32x2 w = *(const u32x2*)p; o[0] = __uint_as_float(w.x << 16); o[1] = __uint_as_float(w.x & 0xffff0000u); o[2] = __uint_as_float(w.y << 16); o[3] = __uint_as_float(w.y & 0xffff0000u); }
constexpr int XL_ROW = 528;
template <int MODE> DI void phase3_mfma(const Params& p, int bid, int nb, char* lds) {
  const int t_ = tid_(), wid = t_ >> 6, h = wid;
  const bf16_t* proj = ws_proj(p);
  for (int tile = bid; tile < NTOK / 64; tile += nb) {
    const int t0 = tile * 64;
    int t = t_;
    asm volatile("" : "+v"(t));
    const int lane = t & 63, r32_ = lane & 31, hi_ = lane >> 5;
    __syncthreads();
#pragma unroll
    for (int i = 0; i < 4; ++i) {
      const int id = t + 512 * i, tok = id >> 5, cc = (id & 31) * 8, gt = t0 + tok;
      float v[8], pv[8];
      const bool firstt = (gt & (SEQ - 1)) == 0;
      load8(proj + (unsigned)(gt * PROJ_LD + C_WL + cc), v);
      load8(proj + (unsigned)((firstt ? gt : gt - 1) * PROJ_LD + C_WL + cc), pv);
      const f32x4 m0 = *(const f32x4*)(p.shift_mu + C_WL + cc), m1 = *(const f32x4*)(p.shift_mu + C_WL + cc + 4);
      const float esc = (cc < 64) ? 2.0f : -1.0f;
      float x[8];
#pragma unroll
      for (int j = 0; j < 8; ++j) {
        const float mu = j < 4 ? m0[j] : m1[j - 4];
        const float pj = firstt ? 0.f : pv[j];
        const float xv = v[j] + mu * (pj - v[j]);
        const float rc = 1.0f / (__expf(esc * xv) + 1.0f);
        x[j] = (cc < 64) ? (1.0f - 2.0f * rc) : ((cc >= 128) ? rc : xv);
      }
      u32x4 w; w.x = cvtpk(x[0], x[1]); w.y = cvtpk(x[2], x[3]); w.z = cvtpk(x[4], x[5]); w.w = cvtpk(x[6], x[7]);
      *(u32x4*)(lds + tok * XL_ROW + cc * 2) = w;
    }
    if (MODE & 2) {
#pragma unroll
    for (int it = 0; it < 2; ++it) {
      const int gt = t0 + wid * 8 + it * 4 + (lane >> 4), c0 = (lane & 15) * 8;
      float v[8]; load8(proj + (size_t)gt * PROJ_LD + C_CKV + c0, v);
      float ss = 0.f;
#pragma unroll
      for (int j = 0; j < 8; ++j) ss += v[j] * v[j];
      const float rs = rsqrtf(dpp_sum16b(ss) * (1.0f / 128.0f) + 1e-6f);
      const f32x4 g0 = *(const f32x4*)(p.kv_norm_g + c0), g1 = *(const f32x4*)(p.kv_norm_g + c0 + 4);
      u32x4 w; w.x = cvtpk(v[0] * rs * g0[0], v[1] * rs * g0[1]); w.y = cvtpk(v[2] * rs * g0[2], v[3] * rs * g0[3]);
      w.z = cvtpk(v[4] * rs * g1[0], v[5] * rs * g1[1]); w.w = cvtpk(v[6] * rs * g1[2], v[7] * rs * g1[3]);
      *(u32x4*)(ws_ckv(p) + (size_t)gt * 128 + c0) = w;
    }
    {
      const int gt = t0 + wid * 8 + (lane >> 3), c0 = (lane & 7) * 8;
      float v[8]; load8(proj + (size_t)gt * PROJ_LD + C_KI + c0, v);
      float ss = 0.f;
#pragma unroll
      for (int j = 0; j < 8; ++j) ss += v[j] * v[j];
      const float rs = rsqrtf(dpp_sum8(ss) * (1.0f / 64.0f) + 1e-6f);
      const f32x4 g0 = *(const f32x4*)(p.k_idx_norm_g + c0), g1 = *(const f32x4*)(p.k_idx_norm_g + c0 + 4);
      u32x4 w; w.x = cvtpk(v[0] * rs * g0[0], v[1] * rs * g0[1]); w.y = cvtpk(v[2] * rs * g0[2], v[3] * rs * g0[3]);
      w.z = cvtpk(v[4] * rs * g1[0], v[5] * rs * g1[1]); w.w = cvtpk(v[6] * rs * g1[2], v[7] * rs * g1[3]);
      *(u32x4*)(ws_kidx(p) + (size_t)gt * 64 + c0) = w;
    }
    }
    __syncthreads();
#pragma unroll 1
    for (int nt = 0; nt < 2; ++nt) {
      int r32 = r32_, hi = hi_;
      asm volatile("" : "+v"(r32), "+v"(hi));
      const int gt = t0 + nt * 32 + r32;
      const bool first = (gt & (SEQ - 1)) == 0;
      const int gp = first ? gt : gt - 1;
      const char* xrow = lds + (nt * 32 + r32) * XL_ROW + hi * 16;
      const int chb = h * HD + 4 * hi;
      char* RBt = lds + 64 * XL_ROW + wid * 14336; char* KBt = RBt + 4752; char* OBt = KBt + 4752;
      const int t0w = t0 + nt * 32, frow = lane >> 3, fch = lane & 7;
      const int cwo = r32 * 144 + hi * 8;
#define P3_FLUSH(dst_, ld_, col_) do { _Pragma("unroll") for (int i_ = 0; i_ < 4; ++i_) { const int row_ = frow + 8 * i_; \
        *(u32x4*)((dst_) + (unsigned)((t0w + row_) * (ld_) + (col_) + fch * 8)) = *(const u32x4*)(OBt + row_ * 144 + fch * 16); } } while (0)
      if (MODE & 1) {
      f32x16 acc[2];
#pragma unroll
      for (int mt = 0; mt < 2; ++mt)
#pragma unroll
        for (int r = 0; r < 16; ++r) acc[mt][r] = 0.f;
#pragma unroll
      for (int ks = 0; ks < 4; ++ks) {
        const bf16x8 bx = *(const bf16x8*)(xrow + ks * 32);
#pragma unroll
        for (int mt = 0; mt < 2; ++mt) { const bf16x8 aw = *(const bf16x8*)(ws_wdt(p) + (size_t)(h * HD + mt * 32 + r32) * 64 + ks * 16 + hi * 8); acc[mt] = __builtin_amdgcn_mfma_f32_32x32x16_bf16(aw, bx, acc[mt], 0, 0, 0); }
      }
#pragma unroll
      for (int mt = 0; mt < 2; ++mt)
#pragma unroll
        for (int g = 0; g < 4; ++g) {
          const int ch = chb + 32 * mt + 8 * g;
          const f32x4 w0v = *(const f32x4*)(p.w0 + ch);
          float e[4];
#pragma unroll
          for (int i = 0; i < 4; ++i) e[i] = 0.6065306597f / (1.0f + __expf(-(w0v[i] + acc[mt][4 * g + i])));
          *(u32x2*)(OBt + cwo + mt * 64 + g * 16) = pk4(e[0], e[1], e[2], e[3]);
        }
      P3_FLUSH(ws_ee(p), RW, h * HD);
      __builtin_amdgcn_sched_barrier(0);
#pragma unroll
      for (int mt = 0; mt < 2; ++mt)
#pragma unroll
        for (int r = 0; r < 16; ++r) acc[mt][r] = 0.f;
#pragma unroll
      for (int ks = 0; ks < 8; ++ks) {
        const bf16x8 bx = *(const bf16x8*)(xrow + 256 + ks * 32);
#pragma unroll
        for (int mt = 0; mt < 2; ++mt) { const bf16x8 aw = *(const bf16x8*)(ws_wgt(p) + (size_t)(h * HD + mt * 32 + r32) * 128 + ks * 16 + hi * 8); acc[mt] = __builtin_amdgcn_mfma_f32_32x32x16_bf16(aw, bx, acc[mt], 0, 0, 0); }
      }
#pragma unroll
      for (int mt = 0; mt < 2; ++mt)
#pragma unroll
        for (int g = 0; g < 4; ++g)
          *(u32x2*)(OBt + cwo + mt * 64 + g * 16) =
              pk4(acc[mt][4 * g] + 0.0f, acc[mt][4 * g + 1] + 0.0f, acc[mt][4 * g + 2] + 0.0f, acc[mt][4 * g + 3] + 0.0f);
      P3_FLUSH(ws_gg(p), RW, h * HD);
      __builtin_amdgcn_sched_barrier(0);
#pragma unroll
      for (int mt = 0; mt < 2; ++mt)
#pragma unroll
        for (int r = 0; r < 16; ++r) acc[mt][r] = 0.f;
#pragma unroll
      for (int ks = 0; ks < 4; ++ks) {
        const bf16x8 bx = *(const bf16x8*)(xrow + 128 + ks * 32);
#pragma unroll
        for (int mt = 0; mt < 2; ++mt) { const bf16x8 aw = *(const bf16x8*)(ws_wat(p) + (size_t)(h * HD + mt * 32 + r32) * 64 + ks * 16 + hi * 8); acc[mt] = __builtin_amdgcn_mfma_f32_32x32x16_bf16(aw, bx, acc[mt], 0, 0, 0); }
      }
      __builtin_amdgcn_sched_barrier(0);
#pragma unroll
      for (int i_ = 0; i_ < 5; ++i_) {
        const int row_ = frow + 8 * i_;
        if (row_ < 33) {
          int tk_ = t0w - 1 + row_; tk_ = tk_ < 0 ? 0 : tk_;
          *(u32x4*)(RBt + row_ * 144 + fch * 16) = *(const u32x4*)(proj + (unsigned)(tk_ * PROJ_LD + C_R + h * HD + fch * 8));
          *(u32x4*)(KBt + row_ * 144 + fch * 16) = *(const u32x4*)(proj + (unsigned)(tk_ * PROJ_LD + C_K + h * HD + fch * 8));
        }
      }
      float ss = 0.f, bs = 0.f; float av[2][16];
#pragma unroll
      for (int mt = 0; mt < 2; ++mt)
#pragma unroll
        for (int g = 0; g < 4; ++g) {
          const int ch = chb + 32 * mt + 8 * g;
          float rv[4], rp[4], kv[4], kq[4];
          ld4((const bf16_t*)(RBt + 144 + cwo + mt * 64 + g * 16), rv); ld4((const bf16_t*)(KBt + 144 + cwo + mt * 64 + g * 16), kv);
          ld4((const bf16_t*)(RBt + cwo + mt * 64 + g * 16), rp); ld4((const bf16_t*)(KBt + cwo + mt * 64 + g * 16), kq);
          const f32x4 mur = *(const f32x4*)(p.shift_mu + C_R + ch), muk = *(const f32x4*)(p.shift_mu + C_K + ch);
          const f32x4 a0v = *(const f32x4*)(p.a0 + ch), kkc = *(const f32x4*)(p.k_k + ch), kac = *(const f32x4*)(p.k_a + ch), rkc = *(const f32x4*)(p.r_k + ch);
          float kp[4];
#pragma unroll
          for (int i = 0; i < 4; ++i) {
            const float a = 1.0f / (1.0f + __expf(-(a0v[i] + acc[mt][4 * g + i])));
            const float r = rv[i] + mur[i] * ((first ? 0.f : rp[i]) - rv[i]);
            const float k = kv[i] + muk[i] * ((first ? 0.f : kq[i]) - kv[i]);
            const float kk = k * kkc[i];
            ss += kk * kk;
            kp[i] = k * (1.0f + (a - 1.0f) * kac[i]);
            bs += r * kp[i] * rkc[i];
            av[mt][4 * g + i] = a;
          }
          *(u32x2*)(OBt + cwo + mt * 64 + g * 16) = pk4(kp[0], kp[1], kp[2], kp[3]);
        }
      P3_FLUSH(ws_kp(p), RW, h * HD);
      __builtin_amdgcn_sched_barrier(0);
      ss = xhalf_sum(ss); bs = xhalf_sum(bs);
      const float inv = 1.0f / fmaxf(sqrtf(ss), 1e-12f);
#pragma unroll
      for (int mt = 0; mt < 2; ++mt)
#pragma unroll
        for (int g = 0; g < 4; ++g) {
          const int ch = chb + 32 * mt + 8 * g;
          float kv[4], kq[4];
          ld4((const bf16_t*)(KBt + 144 + cwo + mt * 64 + g * 16), kv); ld4((const bf16_t*)(KBt + cwo + mt * 64 + g * 16), kq);
          const f32x4 muk = *(const f32x4*)(p.shift_mu + C_K + ch), kkc = *(const f32x4*)(p.k_k + ch);
          float kn[4];
#pragma unroll
          for (int i = 0; i < 4; ++i) { const float kprev = first ? 0.f : kq[i]; kn[i] = (kv[i] + muk[i] * (kprev - kv[i])) * kkc[i] * inv; }
          *(u32x2*)(OBt + cwo + mt * 64 + g * 16) = pk4(kn[0], kn[1], kn[2], kn[3]);
          *(u32x2*)(RBt + cwo + mt * 64 + g * 16) = pk4(kn[0] * av[mt][4 * g], kn[1] * av[mt][4 * g + 1], kn[2] * av[mt][4 * g + 2], kn[3] * av[mt][4 * g + 3]);
        }
      P3_FLUSH(ws_kk(p), RW, h * HD);
      { char* const OBs = OBt; OBt = RBt; P3_FLUSH(ws_bb(p), RW, h * HD); OBt = OBs; }
      if (hi == 0) ws_bonus(p)[gt * NH + h] = bs;
      }
#undef P3_FLUSH
    }
  }
}

DI void phase4a(const Params& p, int bid, int nb, char* lds) {
  const int t = tid_(), i = t >> 3, cg8 = (t & 7) * 8;
  const bf16_t* proj = ws_proj(p);
  for (int task = bid; task < BATCH * NH; task += nb) {
    const int b = task >> 3, h = task & 7;
    const int cbase = h * HD + cg8;
    float mu_r[8], st[8], rprev[8];
#pragma unroll
    for (int j = 0; j < 8; ++j) { mu_r[j] = p.shift_mu[C_R + cbase + j]; st[j] = 0.f; rprev[j] = 0.f; }
    const float mu_v = p.shift_mu[C_V + h * HD + i];
    float vprev = 0.f;
    const size_t tok0 = (size_t)b * SEQ;
    u32x4 n_kk, n_bb, n_kp, n_ee, n_r; bf16_t n_v;
    {
      const size_t g = tok0;
      n_kk = *(const u32x4*)(ws_kk(p) + g * RW + cbase); n_bb = *(const u32x4*)(ws_bb(p) + g * RW + cbase);
      n_kp = *(const u32x4*)(ws_kp(p) + g * RW + cbase); n_ee = *(const u32x4*)(ws_ee(p) + g * RW + cbase);
      n_r = *(const u32x4*)(proj + g * PROJ_LD + C_R + cbase); n_v = proj[g * PROJ_LD + C_V + h * HD + i];
    }
    for (int s = 0; s < SEQ; ++s) {
      const u32x4 c_kk = n_kk, c_bb = n_bb, c_kp = n_kp, c_ee = n_ee, c_r = n_r; const bf16_t c_v = n_v;
      if (s + 1 < SEQ) {
        const size_t g = tok0 + s + 1;
        n_kk = *(const u32x4*)(ws_kk(p) + g * RW + cbase); n_bb = *(const u32x4*)(ws_bb(p) + g * RW + cbase);
        n_kp = *(const u32x4*)(ws_kp(p) + g * RW + cbase); n_ee = *(const u32x4*)(ws_ee(p) + g * RW + cbase);
        n_r = *(const u32x4*)(proj + g * PROJ_LD + C_R + cbase); n_v = proj[g * PROJ_LD + C_V + h * HD + i];
      }
      float kk[8], bb[8], kp[8], ee[8], rr[8];
      unpack8(c_kk, kk); unpack8(c_bb, bb); unpack8(c_kp, kp); unpack8(c_ee, ee); unpack8(c_r, rr);
      const float vraw = bf2f(c_v);
      const float v = vraw + mu_v * (vprev - vraw); vprev = vraw;
      float sa = 0.f;
#pragma unroll
      for (int j = 0; j < 8; ++j) sa += st[j] * kk[j];
      sa += __shfl_xor(sa, 1); sa += __shfl_xor(sa, 2); sa += __shfl_xor(sa, 4);
      sa = -sa;
      float y = 0.f;
#pragma unroll
      for (int j = 0; j < 8; ++j) {
        const float r = rr[j] + mu_r[j] * (rprev[j] - rr[j]); rprev[j] = rr[j];
        const float w = __expf(-ee[j]);
        st[j] = st[j] * w + sa * bb[j] + v * kp[j];
        y += st[j] * r;
      }
      y += __shfl_xor(y, 1); y += __shfl_xor(y, 2); y += __shfl_xor(y, 4);
      if ((t & 7) == 0) ws_y(p)[(tok0 + s) * RW + h * HD + i] = y;
    }
  }
}

DI float dpp_sum16(float v) {
  v += __int_as_float(__builtin_amdgcn_update_dpp(0, __float_as_int(v), 0xB1, 0xF, 0xF, true));
  v += __int_as_float(__builtin_amdgcn_update_dpp(0, __float_as_int(v), 0x4E, 0xF, 0xF, true));
  v += __int_as_float(__builtin_amdgcn_update_dpp(0, __float_as_int(v), 0x141, 0xF, 0xF, true));
  v += __int_as_float(__builtin_amdgcn_update_dpp(0, __float_as_int(v), 0x140, 0xF, 0xF, true));
  return v;
}
constexpr int CK = 16;
constexpr int SC_CH = 16, SC_BUF = 5 * SC_CH * 64 * 4 + SC_CH * 32 * 4 + SC_CH * 8;
DI void phase4a_v2(const Params& p, int bid, int nb, char* lds) {
  const int t = tid_(), rowl = t >> 4, cg = t & 15;
  const bf16_t* proj = ws_proj(p);
  for (int task = bid; task < BATCH * NH * 2; task += nb) {
    const int b = task >> 4, h = (task >> 1) & 7, half = task & 1;
    const size_t tok0 = (size_t)b * SEQ;
    const int sst = t >> 4, scol = h * HD + cg * 4;
    const int vst = t >> 5, vrow = t & 31, vcol = C_V + h * HD + half * 32 + vrow;
    float mur[4];
#pragma unroll
    for (int j = 0; j < 4; ++j) mur[j] = p.shift_mu[C_R + scol + j];
    const float muv = p.shift_mu[vcol];
    u32x2 g_kk, g_bb, g_kp, g_ee, g_r, g_rp; bf16_t g_v, g_vp;
    auto stage_load = [&](int c) {
      if (t < 256) {
        const size_t g = tok0 + c * SC_CH + sst;
        g_kk = *(const u32x2*)(ws_kk(p) + g * RW + scol); g_bb = *(const u32x2*)(ws_bb(p) + g * RW + scol);
        g_kp = *(const u32x2*)(ws_kp(p) + g * RW + scol); g_ee = *(const u32x2*)(ws_ee(p) + g * RW + scol);
        g_r = *(const u32x2*)(proj + g * PROJ_LD + C_R + scol);
        if (c * SC_CH + sst > 0) g_rp = *(const u32x2*)(proj + (g - 1) * PROJ_LD + C_R + scol); else { g_rp.x = 0u; g_rp.y = 0u; }
      }
      const size_t gv = tok0 + c * SC_CH + vst;
      g_v = proj[gv * PROJ_LD + vcol];
      g_vp = (c * SC_CH + vst > 0) ? proj[(gv - 1) * PROJ_LD + vcol] : (bf16_t)0;
    };
    auto stage_write = [&](char* buf) {
      if (t < 256) {
        float* W = (float*)buf + sst * 64 + cg * 4;
        f32x4 o;
        o[0] = __expf(-__uint_as_float(g_ee.x << 16)); o[1] = __expf(-__uint_as_float(g_ee.x & 0xffff0000u));
        o[2] = __expf(-__uint_as_float(g_ee.y << 16)); o[3] = __expf(-__uint_as_float(g_ee.y & 0xffff0000u));
        *(f32x4*)W = o;
        o[0] = __uint_as_float(g_kk.x << 16); o[1] = __uint_as_float(g_kk.x & 0xffff0000u); o[2] = __uint_as_float(g_kk.y << 16); o[3] = __uint_as_float(g_kk.y & 0xffff0000u);
        *(f32x4*)(W + SC_CH * 64) = o;
        o[0] = __uint_as_float(g_bb.x << 16); o[1] = __uint_as_float(g_bb.x & 0xffff0000u); o[2] = __uint_as_float(g_bb.y << 16); o[3] = __uint_as_float(g_bb.y & 0xffff0000u);
        *(f32x4*)(W + 2 * SC_CH * 64) = o;
        o[0] = __uint_as_float(g_kp.x << 16); o[1] = __uint_as_float(g_kp.x & 0xffff0000u); o[2] = __uint_as_float(g_kp.y << 16); o[3] = __uint_as_float(g_kp.y & 0xffff0000u);
        *(f32x4*)(W + 3 * SC_CH * 64) = o;
        float r[4] = {__uint_as_float(g_r.x << 16), __uint_as_float(g_r.x & 0xffff0000u), __uint_as_float(g_r.y << 16), __uint_as_float(g_r.y & 0xffff0000u)};
        float rp[4] = {__uint_as_float(g_rp.x << 16), __uint_as_float(g_rp.x & 0xffff0000u), __uint_as_float(g_rp.y << 16), __uint_as_float(g_rp.y & 0xffff0000u)};
#pragma unroll
        for (int j = 0; j < 4; ++j) o[j] = r[j] + mur[j] * (rp[j] - r[j]);
        *(f32x4*)(W + 4 * SC_CH * 64) = o;
      }
      const float v = bf2f(g_v), vp = bf2f(g_vp);
      ((float*)buf)[5 * SC_CH * 64 + vst * 32 + vrow] = v + muv * (vp - v);
    };
    float st[4] = {0.f, 0.f, 0.f, 0.f};
    __syncthreads();
    stage_load(0); stage_write(lds);
    __syncthreads();
    float* yout = ws_y(p) + tok0 * RW + h * HD + half * 32 + rowl;
    for (int c = 0; c < SEQ / SC_CH; ++c) {
      const char* cur = lds + (c & 1) * SC_BUF;
      if (c + 1 < SEQ / SC_CH) stage_load(c + 1);
      const float* Wb = (const float*)cur + cg * 4;
      const float* Vb = (const float*)cur + 5 * SC_CH * 64 + rowl;
      float yv[SC_CH];
#pragma unroll
      for (int s = 0; s < SC_CH; ++s) {
        const f32x4 w = *(const f32x4*)(Wb + s * 64), kk = *(const f32x4*)(Wb + SC_CH * 64 + s * 64), bb = *(const f32x4*)(Wb + 2 * SC_CH * 64 + s * 64);
        const f32x4 kp = *(const f32x4*)(Wb + 3 * SC_CH * 64 + s * 64), rr = *(const f32x4*)(Wb + 4 * SC_CH * 64 + s * 64);
        const float v = Vb[s * 32];
        float sa = (st[0] * kk[0] + st[1] * kk[1]) + (st[2] * kk[2] + st[3] * kk[3]);
        sa = -dpp_sum16(sa);
#pragma unroll
        for (int j = 0; j < 4; ++j) st[j] = st[j] * w[j] + (sa * bb[j] + v * kp[j]);
        float y = (st[0] * rr[0] + st[1] * rr[1]) + (st[2] * rr[2] + st[3] * rr[3]);
        yv[s] = dpp_sum16(y);
      }
      if (cg == 0) {
#pragma unroll
        for (int s = 0; s < SC_CH; ++s) yout[(size_t)(c * SC_CH + s) * RW] = yv[s];
      }
      if (c + 1 < SEQ / SC_CH) stage_write(lds + ((c + 1) & 1) * SC_BUF);
      __syncthreads();
    }
  }
}

DI void moe_tr_wave(const Params& p, int id, int lane, float* tl  ) {
  const int which = id >> 12, q = id & 4095, e = q >> 7, r = q & 127;
  const float* src; int N, k0, n0;
  if (which < 2) { src = (which == 0 ? p.e_gate : p.e_up) + (size_t)e * 1024 * 512; N = 512; k0 = (r >> 3) * 64; n0 = (r & 7) * 64; }
  else { src = p.e_down + (size_t)e * 512 * 1024; N = 1024; k0 = (r >> 4) * 64; n0 = (r & 15) * 64; }
  const int lr = lane >> 4, lc = (lane & 15) * 4;
  f32x4 g[16];
#pragma unroll
  for (int i = 0; i < 16; ++i) g[i] = *(const f32x4*)(src + (size_t)(k0 + lr + 4 * i) * N + n0 + lc);
#pragma unroll
  for (int i = 0; i < 16; ++i) { float* d = tl + (lr + 4 * i) * 65 + lc; d[0] = g[i][0]; d[1] = g[i][1]; d[2] = g[i][2]; d[3] = g[i][3]; }
  bf16_t* dst;
  { const int n = n0 + lane;
    if (which < 2) dst = ws_wgu(p) + (size_t)e * 1024 * 1024 + (size_t)((n >> 7) * 256 + (n & 127) + which * 128) * 1024 + k0;
    else dst = ws_wd(p) + (size_t)e * 1024 * 512 + (size_t)n * 512 + k0; }
#pragma unroll
  for (int c8 = 0; c8 < 8; ++c8) {
    float v[8];
#pragma unroll
    for (int j = 0; j < 8; ++j) v[j] = tl[(c8 * 8 + j) * 65 + lane];
    u32x4 w; w.x = cvtpk(v[0], v[1]); w.y = cvtpk(v[2], v[3]); w.z = cvtpk(v[4], v[5]); w.w = cvtpk(v[6], v[7]);
    *(u32x4*)(dst + c8 * 8) = w;
  }
}

typedef float f32x2p __attribute__((ext_vector_type(2)));
DI void phase4a_v3(const Params& p, int bid, int nb, char* lds) {
  const int t = tid_(), wid = __builtin_amdgcn_readfirstlane(t >> 6);
  const int rowl = (t >> 3) & 31, cg = t & 7;
  const int pt = t & 255;
  const bf16_t* proj = ws_proj(p);
  for (int task = bid; task < BATCH * NH * 2; task += nb) {
    const int b = task >> 4, h = (task >> 1) & 7, half = task & 1;
    const size_t tok0 = (size_t)b * SEQ;
    const int sst = pt >> 4, scq = pt & 15, scol = h * HD + scq * 4;
    const int vst = pt >> 5, vrow = pt & 31, vcol = C_V + h * HD + half * 32 + vrow;
    float mur[4];
#pragma unroll
    for (int j = 0; j < 4; ++j) mur[j] = p.shift_mu[C_R + scol + j];
    const float muv = p.shift_mu[vcol];
    u32x2 g_kk, g_bb, g_kp, g_ee, g_r, g_rp; bf16_t g_v0, g_v0p, g_v1, g_v1p;
#define SC_LOAD(c_) do { const int c__ = (c_); const size_t g = tok0 + c__ * SC_CH + sst; \
      g_kk = *(const u32x2*)(ws_kk(p) + g * RW + scol); g_bb = *(const u32x2*)(ws_bb(p) + g * RW + scol); \
      g_kp = *(const u32x2*)(ws_kp(p) + g * RW + scol); g_ee = *(const u32x2*)(ws_ee(p) + g * RW + scol); \
      g_r = *(const u32x2*)(proj + g * PROJ_LD + C_R + scol); \
      g_rp = *(const u32x2*)(proj + (g - ((c__ * SC_CH + sst > 0) ? 1 : 0)) * PROJ_LD + C_R + scol); \
      if (c__ * SC_CH + sst == 0) { g_rp.x = 0u; g_rp.y = 0u; } \
      const size_t gv = tok0 + c__ * SC_CH + vst; \
      g_v0 = proj[gv * PROJ_LD + vcol]; g_v0p = (c__ * SC_CH + vst > 0) ? proj[(gv - 1) * PROJ_LD + vcol] : (bf16_t)0; \
      g_v1 = proj[(gv + 8) * PROJ_LD + vcol]; g_v1p = proj[(gv + 7) * PROJ_LD + vcol]; } while (0)
#define SC_WRITE(buf_) do { float* W = (float*)(buf_) + sst * 64 + scq * 4; f32x4 o; \
      o[0] = __expf(-__uint_as_float(g_ee.x << 16)); o[1] = __expf(-__uint_as_float(g_ee.x & 0xffff0000u)); \
      o[2] = __expf(-__uint_as_float(g_ee.y << 16)); o[3] = __expf(-__uint_as_float(g_ee.y & 0xffff0000u)); *(f32x4*)W = o; \
      o[0] = __uint_as_float(g_kk.x << 16); o[1] = __uint_as_float(g_kk.x & 0xffff0000u); o[2] = __uint_as_float(g_kk.y << 16); o[3] = __uint_as_float(g_kk.y & 0xffff0000u); *(f32x4*)(W + SC_CH * 64) = o; \
      o[0] = __uint_as_float(g_bb.x << 16); o[1] = __uint_as_float(g_bb.x & 0xffff0000u); o[2] = __uint_as_float(g_bb.y << 16); o[3] = __uint_as_float(g_bb.y & 0xffff0000u); *(f32x4*)(W + 2 * SC_CH * 64) = o; \
      o[0] = __uint_as_float(g_kp.x << 16); o[1] = __uint_as_float(g_kp.x & 0xffff0000u); o[2] = __uint_as_float(g_kp.y << 16); o[3] = __uint_as_float(g_kp.y & 0xffff0000u); *(f32x4*)(W + 3 * SC_CH * 64) = o; \
      { const float r0 = __uint_as_float(g_r.x << 16), r1 = __uint_as_float(g_r.x & 0xffff0000u), r2 = __uint_as_float(g_r.y << 16), r3 = __uint_as_float(g_r.y & 0xffff0000u); \
        const float q0 = __uint_as_float(g_rp.x << 16), q1 = __uint_as_float(g_rp.x & 0xffff0000u), q2 = __uint_as_float(g_rp.y << 16), q3 = __uint_as_float(g_rp.y & 0xffff0000u); \
        o[0] = r0 + mur[0] * (q0 - r0); o[1] = r1 + mur[1] * (q1 - r1); o[2] = r2 + mur[2] * (q2 - r2); o[3] = r3 + mur[3] * (q3 - r3); \
        const f32x4 wv_ = *(const f32x4*)W, bv_ = *(const f32x4*)(W + 2 * SC_CH * 64), kv_ = *(const f32x4*)(W + 3 * SC_CH * 64); \
        const float br_ = dpp_sum16((bv_[0] * o[0] + bv_[1] * o[1]) + (bv_[2] * o[2] + bv_[3] * o[3])), kr_ = dpp_sum16((kv_[0] * o[0] + kv_[1] * o[1]) + (kv_[2] * o[2] + kv_[3] * o[3])); \
        if (scq == 0) { float* X_ = (float*)(buf_) + 5 * SC_CH * 64 + SC_CH * 32 + sst * 2; X_[0] = br_; X_[1] = kr_; } \
        o[0] *= wv_[0]; o[1] *= wv_[1]; o[2] *= wv_[2]; o[3] *= wv_[3]; *(f32x4*)(W + 4 * SC_CH * 64) = o; } \
      { const float v0 = bf2f(g_v0), v0p = bf2f(g_v0p), v1 = bf2f(g_v1), v1p = bf2f(g_v1p); float* Vw = (float*)(buf_) + 5 * SC_CH * 64 + vst * 32 + vrow; \
        Vw[0] = v0 + muv * (v0p - v0); Vw[8 * 32] = v1 + muv * (v1p - v1); } } while (0)
    f32x2p st2[4];
#pragma unroll
    for (int j = 0; j < 4; ++j) st2[j] = (f32x2p){0.f, 0.f};
    __syncthreads();
    if (wid >= 4) { SC_LOAD(0); SC_WRITE(lds); SC_LOAD(1); }
    __syncthreads();
    float* yout = ws_y(p) + tok0 * RW + h * HD + half * 32 + rowl;
    for (int c = 0; c < SEQ / SC_CH; ++c) {
      const char* cur = lds + (c & 1) * SC_BUF;
      if (wid >= 4) {
        if (c + 1 < SEQ / SC_CH) SC_WRITE(lds + ((c + 1) & 1) * SC_BUF);
        if (c + 2 < SEQ / SC_CH) SC_LOAD(c + 2);
        if ((c & 7) == 3) {
          const int tid_tr = (task * 4 + (wid - 4)) + (BATCH * NH * 2 * 4) * (c >> 3);
          if (tid_tr < 3 * 4096) moe_tr_wave(p, tid_tr, t & 63, (float*)(lds + 2 * SC_BUF + 128) + (wid - 4) * (64 * 65));
        }
      } else {
        const float* Wb = (const float*)cur + cg * 8;
        const float* Vb = (const float*)cur + 5 * SC_CH * 64 + rowl;
        float yv[SC_CH];
#pragma unroll
        for (int s = 0; s < SC_CH; ++s) {
          const f32x4 w0 = *(const f32x4*)(Wb + s * 64), w1 = *(const f32x4*)(Wb + s * 64 + 4);
          const f32x4 k0 = *(const f32x4*)(Wb + SC_CH * 64 + s * 64), k1 = *(const f32x4*)(Wb + SC_CH * 64 + s * 64 + 4);
          const f32x4 b0 = *(const f32x4*)(Wb + 2 * SC_CH * 64 + s * 64), b1 = *(const f32x4*)(Wb + 2 * SC_CH * 64 + s * 64 + 4);
          const f32x4 p0 = *(const f32x4*)(Wb + 3 * SC_CH * 64 + s * 64), p1 = *(const f32x4*)(Wb + 3 * SC_CH * 64 + s * 64 + 4);
          const f32x4 r0 = *(const f32x4*)(Wb + 4 * SC_CH * 64 + s * 64), r1 = *(const f32x4*)(Wb + 4 * SC_CH * 64 + s * 64 + 4);
          const float v = Vb[s * 32];
#define LO2(x) __builtin_shufflevector(x, x, 0, 1)
#define HI2(x) __builtin_shufflevector(x, x, 2, 3)
          const f32x2p xs = *(const f32x2p*)((const float*)cur + 5 * SC_CH * 64 + SC_CH * 32 + s * 2);
          f32x2p sa2 = st2[0] * LO2(k0), yd2 = st2[0] * LO2(r0);
          sa2 = st2[1] * HI2(k0) + sa2; yd2 = st2[1] * HI2(r0) + yd2;
          sa2 = st2[2] * LO2(k1) + sa2; yd2 = st2[2] * LO2(r1) + yd2;
          sa2 = st2[3] * HI2(k1) + sa2; yd2 = st2[3] * HI2(r1) + yd2;
          const float sa = -dpp_sum8(sa2[0] + sa2[1]);
          const float yd = dpp_sum8(yd2[0] + yd2[1]);
          yv[s] = yd + sa * xs[0] + v * xs[1];
          const f32x2p sav = {sa, sa}, vv = {v, v};
          st2[0] = st2[0] * LO2(w0) + (sav * LO2(b0) + vv * LO2(p0));
          st2[1] = st2[1] * HI2(w0) + (sav * HI2(b0) + vv * HI2(p0));
          st2[2] = st2[2] * LO2(w1) + (sav * LO2(b1) + vv * LO2(p1));
          st2[3] = st2[3] * HI2(w1) + (sav * HI2(b1) + vv * HI2(p1));
#undef LO2
#undef HI2
        }
        if (cg == 0) {
#pragma unroll
          for (int s = 0; s < SC_CH; ++s) yout[(size_t)(c * SC_CH + s) * RW] = yv[s];
        }
      }
      __syncthreads();
    }
#undef SC_LOAD
#undef SC_WRITE
  }
}

DI void moe_tr_small(const Params& p, int id, int lane, float* tl  ) {
  const int which = id >> 14, r_ = id & 16383, e = r_ >> 9, rr = r_ & 511;
  const float* src; int N, k0, n0;
  if (which < 2) { src = (which == 0 ? p.e_gate : p.e_up) + (size_t)e * 1024 * 512; N = 512; k0 = (rr >> 5) * 64; n0 = (rr & 31) * 16; }
  else { src = p.e_down + (size_t)e * 512 * 1024; N = 1024; k0 = (rr >> 6) * 64; n0 = (rr & 63) * 16; }
  const float* sp = src + (size_t)(k0 + lane) * N + n0;
  const f32x4 g0 = *(const f32x4*)sp, g1 = *(const f32x4*)(sp + 4), g2 = *(const f32x4*)(sp + 8), g3 = *(const f32x4*)(sp + 12);
  float* d = tl + lane * 17;
  d[0] = g0[0]; d[1] = g0[1]; d[2] = g0[2]; d[3] = g0[3]; d[4] = g1[0]; d[5] = g1[1]; d[6] = g1[2]; d[7] = g1[3];
  d[8] = g2[0]; d[9] = g2[1]; d[10] = g2[2]; d[11] = g2[3]; d[12] = g3[0]; d[13] = g3[1]; d[14] = g3[2]; d[15] = g3[3];
  const int nn = lane & 15, kq = lane >> 4;
  float v[16];
#pragma unroll
  for (int i = 0; i < 16; ++i) v[i] = tl[(kq * 16 + i) * 17 + nn];
  u32x4 w0, w1;
  w0.x = cvtpk(v[0], v[1]); w0.y = cvtpk(v[2], v[3]); w0.z = cvtpk(v[4], v[5]); w0.w = cvtpk(v[6], v[7]);
  w1.x = cvtpk(v[8], v[9]); w1.y = cvtpk(v[10], v[11]); w1.z = cvtpk(v[12], v[13]); w1.w = cvtpk(v[14], v[15]);
  const int n = n0 + nn;
  bf16_t* dst;
  if (which < 2) dst = ws_wgu(p) + (size_t)e * 1024 * 1024 + (size_t)((n >> 7) * 256 + (n & 127) + which * 128) * 1024 + k0 + kq * 16;
  else dst = ws_wd(p) + (size_t)e * 1024 * 512 + (size_t)n * 512 + k0 + kq * 16;
  *(u32x4*)dst = w0; *(u32x4*)(dst + 8) = w1;
}

constexpr int CS_PSZ = 23552, CS_SLSZ = 13312, CS_SL0 = 4 * CS_PSZ, CS_CON = CS_SL0 + 4 * CS_SLSZ;
DI f32x4v cs_mm16(const float* A, int sam, int sak, const float* B, int sbk, int sbn, f32x4v c, int l16, int g) {
#pragma unroll
  for (int q = 0; q < 4; ++q) c = __builtin_amdgcn_mfma_f32_16x16x4f32(A[l16 * sam + (4 * q + g) * sak], B[(4 * q + g) * sbk + l16 * sbn], c, 0, 0, 0);
  return c;
}
DI void cs_st16(float* D, f32x4v c, int l16, int g) {
#pragma unroll
  for (int r = 0; r < 4; ++r) D[(4 * g + r) * 16 + l16] = c[r];
}
DI f32x4v cs_ld16(const float* D, int l16, int g) { f32x4v c;
#pragma unroll
  for (int r = 0; r < 4; ++r) c[r] = D[(4 * g + r) * 16 + l16];
  return c; }
DI void cs_st4(bf16_t* base, int ld, f32x4v c) {
  const unsigned p01 = cvtpk(c[0] + 0.0f, c[1] + 0.0f), p23 = cvtpk(c[2] + 0.0f, c[3] + 0.0f);
  base[0] = (bf16_t)p01; base[ld] = (bf16_t)(p01 >> 16); base[2 * ld] = (bf16_t)p23; base[3 * ld] = (bf16_t)(p23 >> 16);
}
constexpr int CS_FLG = CS_CON + 6144 + 2 * 64 * 17 * 4;
DI void cs_wait(volatile int* f, int v) {
  while (__builtin_amdgcn_readfirstlane(*f) < v) __builtin_amdgcn_s_sleep(2);
  __builtin_amdgcn_fence(__ATOMIC_ACQUIRE, "workgroup");
}
DI void cs_post(volatile int* f, int v, int lane) {
  __builtin_amdgcn_fence(__ATOMIC_RELEASE, "workgroup");
  if (lane == 0) *f = v;
}
static_assert(CS_FLG + 48 <= LDS_BYTES - 64, "chunked scan LDS map");
#define CS_LAS __attribute__((address_space(3)))
DI void phase4a_chunk(const Params& p, int bid, int nb, char* lds) {
  const int t = tid_(), wid = __builtin_amdgcn_readfirstlane(t >> 6), lane = t & 63, l16 = lane & 15, g = lane >> 4;
  const bf16_t* proj = ws_proj(p);
  const f32x4v z4 = {0.f, 0.f, 0.f, 0.f};
  const bf16x8 zf = {0, 0, 0, 0, 0, 0, 0, 0};
  volatile int* fl_ready = (volatile int*)(lds + CS_FLG); volatile int* fl_done = fl_ready + 4;
  if (t < 12) fl_ready[t] = 0;
  int seq0 = 0;
  for (int task = bid; task < BATCH * NH * 2; task += nb, seq0 += SEQ / CK / 4) {
    const int b = task >> 4, h = (task >> 1) & 7, half = task & 1;
    const int tok0 = b * SEQ;
    f32x4v Sacc[4] = {z4, z4, z4, z4};
    char* Sb = lds + CS_CON; char* Ub = Sb + 4608;
    const int i0 = (wid & 1) * 16;
    __syncthreads();
    if (wid < 2) { for (int i = lane; i < 16 * 144 / 4; i += 64) ((unsigned*)(Sb + i0 * 144))[i] = 0u; }
    u32x4 pf[10]; bf16_t pf_rp = 0, pf_v[9];
#define CS_PF(cc) do { const int ct_ = tok0 + (cc) * CK; \
      const unsigned ro_ = (unsigned)((ct_ + (lane >> 3)) * RW + h * HD + (lane & 7) * 8) * 2u; \
      const unsigned rp_ = (unsigned)((ct_ + (lane >> 3)) * PROJ_LD + C_R + h * HD + (lane & 7) * 8) * 2u; \
      pf[0] = *(const u32x4*)((const char*)ws_ee(p) + ro_); pf[1] = *(const u32x4*)((const char*)ws_ee(p) + ro_ + 8 * RW * 2); \
      pf[2] = *(const u32x4*)((const char*)ws_kk(p) + ro_); pf[3] = *(const u32x4*)((const char*)ws_kk(p) + ro_ + 8 * RW * 2); \
      pf[4] = *(const u32x4*)((const char*)ws_bb(p) + ro_); pf[5] = *(const u32x4*)((const char*)ws_bb(p) + ro_ + 8 * RW * 2); \
      pf[6] = *(const u32x4*)((const char*)ws_kp(p) + ro_); pf[7] = *(const u32x4*)((const char*)ws_kp(p) + ro_ + 8 * RW * 2); \
      pf[8] = *(const u32x4*)((const char*)proj + rp_); pf[9] = *(const u32x4*)((const char*)proj + rp_ + 8 * PROJ_LD * 2); \
      { const int tp_ = (ct_ - 1 < tok0) ? tok0 : ct_ - 1; pf_rp = proj[(unsigned)(tp_ * PROJ_LD + C_R + h * HD + lane)]; } \
      _Pragma("unroll") for (int q_ = 0; q_ < 9; ++q_) { int tv_ = ct_ + (lane >> 5) * 8 + q_ - 1; tv_ = (tv_ < tok0) ? tok0 : tv_; \
        pf_v[q_] = proj[(unsigned)(tv_ * PROJ_LD + C_V + h * HD + half * 32 + (lane & 31))]; } } while (0)
    if (wid >= 4) CS_PF(wid - 4);
    const float mur = p.shift_mu[C_R + h * HD + lane], muv = p.shift_mu[C_V + h * HD + half * 32 + (lane & 31)];
    if (wid < 2) __builtin_amdgcn_s_setprio(3);
    for (int rnd = 0; rnd < SEQ / CK / 4; ++rnd) {
      if (wid >= 4) {
        const int pw = wid - 4, c = rnd * 4 + pw, ct0 = tok0 + c * CK;
        char* ps = lds + pw * CS_PSZ;
        bf16_t* AB = (bf16_t*)ps; bf16_t* BT = AB + 16 * 72; bf16_t* KT = BT + 16 * 72; bf16_t* RB = KT + 16 * 72;
        float* KHT = (float*)(ps + 9216);
        float* Nf = (float*)(ps + 13312); float* AKB = Nf + 256; float* ABR = AKB + 256; float* AKR = ABR + 256;
        float* T0 = AKR + 256; float* T1 = Nf; float* Pm = T0 + 256; float* Mm = Pm + 256;
        bf16_t* ABT = (bf16_t*)(Mm + 256);
        bf16_t* APb = (bf16_t*)BT;
        bf16_t* MTb = (bf16_t*)KT;
        bf16_t* W1b = MTb + 16 * 24;
        bf16_t* ABRT = W1b + 16 * 24;
        char* sl = lds + CS_SL0 + pw * CS_SLSZ;
        bf16_t* QT = (bf16_t*)sl; bf16_t* APT = QT + 16 * 72; bf16_t* BHT = APT + 16 * 72; bf16_t* GGT = BHT + 64 * 24; bf16_t* HT = GGT + 64 * 24; bf16_t* VT = HT + 16 * 24;
        float* GAM = (float*)(sl + 2304 * 2 + 3072 * 2 + 768 + 1536);
        u32x4 bhw0, bhw1, vw; float gamC;
        {
          const int j = lane, col = h * HD + j;
          float cum[CK];
          {
            char* rawl = ps + 13312 + lane * 16;
#pragma unroll
            for (int i = 0; i < 10; ++i) *(u32x4*)(rawl + i * 1024) = pf[i];
          }
          float rprev = (c * CK > 0) ? bf2f(pf_rp) : 0.f;
          {
            const int vi = lane & 31, sh = lane >> 5, vcol = C_V + h * HD + half * 32 + vi;
            float vprev = (c * CK + sh * 8 > 0) ? bf2f(pf_v[0]) : 0.f;
            float vv[8];
#pragma unroll
            for (int q = 0; q < 8; ++q) { const float vr = bf2f(pf_v[q + 1]); vv[q] = vr + muv * (vprev - vr); vprev = vr; }
            vw.x = cvtpk(vv[0], vv[1]); vw.y = cvtpk(vv[2], vv[3]); vw.z = cvtpk(vv[4], vv[5]); vw.w = cvtpk(vv[6], vv[7]);
          }
          if (rnd + 1 < SEQ / CK / 4) CS_PF(c + 4);
          const bf16_t* RAW = (const bf16_t*)(ps + 13312);
          float run = 0.f;
#pragma unroll
          for (int tt = 0; tt < CK; ++tt) { run += bf2f(RAW[tt * 64 + j]); cum[tt] = run; }
          gamC = __expf(-run);
          float bhv[CK], abv[CK];
          float gprev = 1.0f;
#pragma unroll
          for (int tt = 0; tt < CK; tt += 2) {
            float bt2[2], kt2[2], rb2[2];
#pragma unroll
            for (int u = 0; u < 2; ++u) { const int t_ = tt + u;
              const float kkr = bf2f(RAW[1024 + t_ * 64 + j]), ber = bf2f(RAW[2048 + t_ * 64 + j]), kpr = bf2f(RAW[3072 + t_ * 64 + j]), rr = bf2f(RAW[4096 + t_ * 64 + j]);
              const float rsh = rr + mur * (rprev - rr); rprev = rr;
              const float gt_ = __expf(-cum[t_]), gin = __builtin_amdgcn_rcpf(gt_), gh = gamC * gin;
              abv[t_] = -gprev * kkr; gprev = gt_;
              bt2[u] = ber * gin; kt2[u] = kpr * gin; rb2[u] = gt_ * rsh; bhv[t_] = ber * gh;
              KHT[j * 16 + t_] = kpr * gh; }
            const unsigned pa = cvtpk(abv[tt], abv[tt + 1]), pb = cvtpk(bt2[0], bt2[1]), pk = cvtpk(kt2[0], kt2[1]), pr = cvtpk(rb2[0], rb2[1]);
            AB[tt * 72 + j] = (bf16_t)pa; AB[(tt + 1) * 72 + j] = (bf16_t)(pa >> 16);
            BT[tt * 72 + j] = (bf16_t)pb; BT[(tt + 1) * 72 + j] = (bf16_t)(pb >> 16);
            KT[tt * 72 + j] = (bf16_t)pk; KT[(tt + 1) * 72 + j] = (bf16_t)(pk >> 16);
            RB[tt * 72 + j] = (bf16_t)pr; RB[(tt + 1) * 72 + j] = (bf16_t)(pr >> 16);
          }
          u32x4 bh0, bh1;
          bhw0.x = cvtpk(bhv[0], bhv[1]); bhw0.y = cvtpk(bhv[2], bhv[3]); bhw0.z = cvtpk(bhv[4], bhv[5]); bhw0.w = cvtpk(bhv[6], bhv[7]);
          bhw1.x = cvtpk(bhv[8], bhv[9]); bhw1.y = cvtpk(bhv[10], bhv[11]); bhw1.z = cvtpk(bhv[12], bhv[13]); bhw1.w = cvtpk(bhv[14], bhv[15]);
          bh0.x = cvtpk(abv[0], abv[1]); bh0.y = cvtpk(abv[2], abv[3]); bh0.z = cvtpk(abv[4], abv[5]); bh0.w = cvtpk(abv[6], abv[7]);
          bh1.x = cvtpk(abv[8], abv[9]); bh1.y = cvtpk(abv[10], abv[11]); bh1.z = cvtpk(abv[12], abv[13]); bh1.w = cvtpk(abv[14], abv[15]);
          *(u32x4*)(ABT + j * 24) = bh0; *(u32x4*)(ABT + j * 24 + 8) = bh1;
        }
        {
          bf16x8 fb[2], fk[2], fa[2], fr[2];
#pragma unroll
          for (int ks = 0; ks < 2; ++ks) { const int off = l16 * 72 + 8 * g + 32 * ks;
            fb[ks] = *(const bf16x8*)(BT + off); fk[ks] = *(const bf16x8*)(KT + off); fa[ks] = *(const bf16x8*)(AB + off); fr[ks] = *(const bf16x8*)(RB + off); }
          f32x4v n_ = z4, akb = z4, abr = z4, akr = z4;
#pragma unroll
          for (int ks = 0; ks < 2; ++ks) {
            n_ = __builtin_amdgcn_mfma_f32_16x16x32_bf16(fb[ks], fa[ks], n_, 0, 0, 0);
            akb = __builtin_amdgcn_mfma_f32_16x16x32_bf16(fk[ks], fa[ks], akb, 0, 0, 0);
            abr = __builtin_amdgcn_mfma_f32_16x16x32_bf16(fb[ks], fr[ks], abr, 0, 0, 0);
            akr = __builtin_amdgcn_mfma_f32_16x16x32_bf16(fk[ks], fr[ks], akr, 0, 0, 0);
          }
#pragma unroll
          for (int r = 0; r < 4; ++r) { const int s_ = 4 * g + r, t_ = l16;
            Nf[s_ * 16 + t_] = (s_ < t_) ? n_[r] : 0.f; AKB[s_ * 16 + t_] = (s_ < t_) ? akb[r] : 0.f;
            ABR[s_ * 16 + t_] = (s_ <= t_) ? abr[r] : 0.f; AKR[s_ * 16 + t_] = (s_ <= t_) ? akr[r] : 0.f;
            Pm[s_ * 16 + t_] = ((s_ < t_) ? n_[r] : 0.f) + ((s_ == t_) ? 1.0f : 0.f); }
          { const int t_ = l16; float a4[4];
#pragma unroll
            for (int r = 0; r < 4; ++r) a4[r] = (4 * g + r <= t_) ? abr[r] : 0.f;
            *(u32x2*)(ABRT + t_ * 24 + 4 * g) = pk4(a4[0], a4[1], a4[2], a4[3]); }
        }
        {
          f32x4v c_;
          c_ = cs_mm16(Nf, 16, 1, Nf, 16, 1, z4, l16, g); cs_st16(T0, c_, l16, g);
          c_ = cs_mm16(Pm, 16, 1, T0, 16, 1, cs_ld16(Pm, l16, g), l16, g); cs_st16(Pm, c_, l16, g);
          c_ = cs_mm16(T0, 16, 1, T0, 16, 1, z4, l16, g); cs_st16(T1, c_, l16, g);
          c_ = cs_mm16(Pm, 16, 1, T1, 16, 1, cs_ld16(Pm, l16, g), l16, g); cs_st16(Pm, c_, l16, g);
          c_ = cs_mm16(T1, 16, 1, T1, 16, 1, z4, l16, g); cs_st16(T0, c_, l16, g);
          c_ = cs_mm16(Pm, 16, 1, T0, 16, 1, cs_ld16(Pm, l16, g), l16, g); cs_st16(Mm, c_, l16, g);
          *(u32x2*)(MTb + l16 * 24 + 4 * g) = pk4(c_[0] + 0.0f, c_[1] + 0.0f, c_[2] + 0.0f, c_[3] + 0.0f);
          f32x4v w_ = z4;
#pragma unroll
          for (int q = 0; q < 4; ++q) w_ = __builtin_amdgcn_mfma_f32_16x16x4f32(Mm[(4 * q + g) * 16 + l16], AKB[l16 * 16 + 4 * q + g], w_, 0, 0, 0);
          *(u32x2*)(W1b + l16 * 24 + 4 * g) = pk4(w_[0] + 0.0f, w_[1] + 0.0f, w_[2] + 0.0f, w_[3] + 0.0f);
        }
        cs_wait(fl_done + pw, seq0 + rnd); cs_wait(fl_done + 4 + pw, seq0 + rnd);
        *(u32x4*)(BHT + lane * 24) = bhw0; *(u32x4*)(BHT + lane * 24 + 8) = bhw1;
        GAM[lane] = gamC;
        *(u32x4*)(VT + (lane & 31) * 24 + (lane >> 5) * 8) = vw;
        {
          const bf16x8 mF = (g < 2) ? *(const bf16x8*)(MTb + l16 * 24 + 8 * g) : zf;
          const bf16x8 rF = (g < 2) ? *(const bf16x8*)(ABRT + l16 * 24 + 8 * g) : zf;
          const bf16x8 wF = (g < 2) ? *(const bf16x8*)(W1b + l16 * 24 + 8 * g) : zf;
#pragma unroll
          for (int nt = 0; nt < 4; ++nt) {
            const bf16x8 bF = (g < 2) ? *(const bf16x8*)(ABT + (16 * nt + l16) * 24 + 8 * g) : zf;
            const f32x4v c_ = __builtin_amdgcn_mfma_f32_16x16x32_bf16(mF, bF, z4, 0, 0, 0);
            cs_st4(APT + (4 * g) * 72 + 16 * nt + l16, 72, c_);
            *(u32x2*)(APb + (16 * nt + l16) * 24 + 4 * g) = pk4(c_[0] + 0.0f, c_[1] + 0.0f, c_[2] + 0.0f, c_[3] + 0.0f);
          }
#pragma unroll
          for (int nt = 0; nt < 4; ++nt) {
            f32x4v c_;
#pragma unroll
            for (int r = 0; r < 4; ++r) c_[r] = bf2f(RB[(4 * g + r) * 72 + 16 * nt + l16]);
            const bf16x8 bF = (g < 2) ? *(const bf16x8*)(APb + (16 * nt + l16) * 24 + 8 * g) : zf;
            c_ = __builtin_amdgcn_mfma_f32_16x16x32_bf16(rF, bF, c_, 0, 0, 0);
            cs_st4(QT + (4 * g) * 72 + 16 * nt + l16, 72, c_);
          }
          {
            f32x4v c_;
#pragma unroll
            for (int r = 0; r < 4; ++r) c_[r] = AKR[l16 * 16 + 4 * g + r];
            c_ = __builtin_amdgcn_mfma_f32_16x16x32_bf16(rF, wF, c_, 0, 0, 0);
            cs_st4(HT + (4 * g) * 24 + l16, 24, c_);
          }
#pragma unroll
          for (int mt = 0; mt < 4; ++mt) {
            f32x4v c_;
#pragma unroll
            for (int r = 0; r < 4; ++r) c_[r] = KHT[(16 * mt + 4 * g + r) * 16 + l16];
            const bf16x8 aF = (g < 2) ? *(const bf16x8*)(BHT + (16 * mt + l16) * 24 + 8 * g) : zf;
            c_ = __builtin_amdgcn_mfma_f32_16x16x32_bf16(aF, wF, c_, 0, 0, 0);
            cs_st4(GGT + (16 * mt + 4 * g) * 24 + l16, 24, c_);
          }
        }
        cs_post(fl_ready + pw, seq0 + rnd + 1, lane);
      }
      else if (wid >= 2) {
        float* tl = (float*)(lds + CS_CON + 6144) + (wid - 2) * (64 * 17);
#pragma unroll 1
        for (int q = 0; q < 3; ++q) moe_tr_small(p, ((task * 2 + (wid - 2)) * 96 + rnd * 3 + q), lane, tl);
      }
      else {
#pragma unroll 1
        for (int k = 0; k < 4; ++k) {
          const char* sl = lds + CS_SL0 + k * CS_SLSZ;
          cs_wait(fl_ready + k, seq0 + rnd + 1);
          const bf16_t* QT = (const bf16_t*)sl; const bf16_t* APT = QT + 16 * 72; const bf16_t* BHT = APT + 16 * 72; const bf16_t* GGT = BHT + 64 * 24; const bf16_t* HT = GGT + 64 * 24; const bf16_t* VT = HT + 16 * 24;
          const float* GAM = (const float*)(sl + 2304 * 2 + 3072 * 2 + 768 + 1536);
          bf16x8 sA[2], qF[2], aF[2];
#pragma unroll
          for (int ks = 0; ks < 2; ++ks) { sA[ks] = *(const bf16x8*)(Sb + (i0 + l16) * 144 + (8 * g + 32 * ks) * 2);
            qF[ks] = *(const bf16x8*)(QT + l16 * 72 + 8 * g + 32 * ks); aF[ks] = *(const bf16x8*)(APT + l16 * 72 + 8 * g + 32 * ks); }
          const bf16x8 vF = (g < 2) ? *(const bf16x8*)(VT + (i0 + l16) * 24 + 8 * g) : zf;
          const bf16x8 hF = (g < 2) ? *(const bf16x8*)(HT + l16 * 24 + 8 * g) : zf;
          f32x4v yT = z4;
          yT = __builtin_amdgcn_mfma_f32_16x16x32_bf16(qF[0], sA[0], yT, 0, 0, 0);
          yT = __builtin_amdgcn_mfma_f32_16x16x32_bf16(qF[1], sA[1], yT, 0, 0, 0);
          yT = __builtin_amdgcn_mfma_f32_16x16x32_bf16(hF, vF, yT, 0, 0, 0);
          {
            float* yo = ws_y(p) + (size_t)(tok0 + (rnd * 4 + k) * CK + 4 * g) * RW + h * HD + half * 32 + i0 + l16;
#pragma unroll
            for (int r = 0; r < 4; ++r) yo[(size_t)r * RW] = yT[r];
          }
          f32x4v u = z4;
          u = __builtin_amdgcn_mfma_f32_16x16x32_bf16(sA[0], aF[0], u, 0, 0, 0);
          u = __builtin_amdgcn_mfma_f32_16x16x32_bf16(sA[1], aF[1], u, 0, 0, 0);
          cs_st4((bf16_t*)(Ub + (i0 + 4 * g) * 48 + l16 * 2), 24, u);
          const bf16x8 uF = (g < 2) ? *(const bf16x8*)(Ub + (i0 + l16) * 48 + 16 * g) : zf;
#pragma unroll
          for (int nt = 0; nt < 4; ++nt) {
            const float gm = GAM[16 * nt + l16];
            const bf16x8 bF = (g < 2) ? *(const bf16x8*)(BHT + (16 * nt + l16) * 24 + 8 * g) : zf;
            const bf16x8 gF = (g < 2) ? *(const bf16x8*)(GGT + (16 * nt + l16) * 24 + 8 * g) : zf;
            f32x4v a_ = Sacc[nt] * gm;
            a_ = __builtin_amdgcn_mfma_f32_16x16x32_bf16(uF, bF, a_, 0, 0, 0);
            a_ = __builtin_amdgcn_mfma_f32_16x16x32_bf16(vF, gF, a_, 0, 0, 0);
            Sacc[nt] = a_;
            cs_st4((bf16_t*)(Sb + (i0 + 4 * g) * 144 + (16 * nt + l16) * 2), 72, a_);
          }
          cs_post(fl_done + wid * 4 + k, seq0 + rnd + 1, lane);
        }
      }
    }
  }
  __builtin_amdgcn_s_setprio(0);
  __syncthreads();
}

DI unsigned fkey(float f) { const unsigned u = __float_as_uint(f); return (u & 0x80000000u) ? ~u : (u | 0x80000000u); }
DI int block_sum_i(int v, int* red, int wid, int lane) {
  for (int o = 32; o; o >>= 1) v += __shfl_xor(v, o);
  __syncthreads();
  if (lane == 0) red[wid] = v;
  __syncthreads();
  int s = 0;
#pragma unroll
  for (int w = 0; w < 8; ++w) s += red[w];
  return s;
}
DI void phase4b(const Params& p, int bid, int nb, char* lds) {
  const int t = tid_(), lane = t & 63, wid = t >> 6;
  float* qf = (float*)lds;
  float* wi = qf + 256;
  int* red = (int*)(wi + 4);
  int* wtie = red + 8;
  const bf16_t* proj = ws_proj(p);
  for (int gq = bid; gq < NTOK; gq += nb) {
    const int b = gq >> 11, s = gq & (SEQ - 1);
    const int n = ((s >> 6) + 1) * 64;
    unsigned* mrow = ws_mask(p) + (size_t)gq * 64;
    if (n <= 256) {
      if (t < 64) mrow[t] = (t * 32 < n) ? 0xffffffffu : 0u;
      continue;
    }
    __syncthreads();
    if (t < 256) qf[t] = bf2f(proj[(size_t)gq * PROJ_LD + C_QI + t]) * 0.125f;
    else if (t < 260) wi[t - 256] = bf2f(proj[(size_t)gq * PROJ_LD + C_WI + t - 256]) * 0.5f;
    __syncthreads();
    unsigned uk[4];
#pragma unroll 1
    for (int q = 0; q < 4; ++q) {
      const int key = t * 4 + q;
      uk[q] = 0u;
      if (key < n) {
        float kf[64];
        const bf16_t* kr = ws_kidx(p) + ((size_t)b * SEQ + key) * 64;
#pragma unroll
        for (int d8 = 0; d8 < 8; ++d8) load8(kr + d8 * 8, kf + d8 * 8);
        float sc = 0.f;
#pragma unroll
        for (int hh = 0; hh < 4; ++hh) {
          float dot = 0.f;
#pragma unroll
          for (int d4 = 0; d4 < 16; ++d4) { const f32x4 qv = *(const f32x4*)(qf + hh * 64 + d4 * 4); dot += qv[0] * kf[d4 * 4] + qv[1] * kf[d4 * 4 + 1] + qv[2] * kf[d4 * 4 + 2] + qv[3] * kf[d4 * 4 + 3]; }
          sc += wi[hh] * fmaxf(dot, 0.f);
        }
        sc = sc + 0.0f;
        uk[q] = fkey(sc);
      }
    }
    unsigned T = 0u;
    for (int bit = 31; bit >= 0; --bit) {
      const unsigned cand = T | (1u << bit);
      const int c = (uk[0] >= cand) + (uk[1] >= cand) + (uk[2] >= cand) + (uk[3] >= cand);
      if (block_sum_i(c, red, wid, lane) >= 256) T = cand;
    }
    const int cgt = block_sum_i((uk[0] > T) + (uk[1] > T) + (uk[2] > T) + (uk[3] > T), red, wid, lane);
    const int need = 256 - cgt;
    const int tl = (uk[0] == T) + (uk[1] == T) + (uk[2] == T) + (uk[3] == T);
    int incl = tl;
    for (int o = 1; o < 64; o <<= 1) { const int u = __shfl_up(incl, o); if (lane >= o) incl += u; }
    __syncthreads();
    if (lane == 63) wtie[wid] = incl;
    __syncthreads();
    int before = incl - tl;
    for (int w = 0; w < wid; ++w) before += wtie[w];
    unsigned nib = 0u;
#pragma unroll
    for (int q = 0; q < 4; ++q) {
      bool sel = uk[q] > T;
      if (uk[q] == T) { sel = before < need; ++before; }
      if (sel) nib |= 1u << q;
    }
    unsigned word = nib << ((lane & 7) * 4);
    word |= __shfl_xor(word, 1); word |= __shfl_xor(word, 2); word |= __shfl_xor(word, 4);
    if ((lane & 7) == 0) mrow[t >> 3] = word;
  }
}

constexpr int IDX_LD = 2052;
DI void phase4b_mfma(const Params& p, int bid, int nb, char* lds) {
  const int t = tid_(), lane = t & 63, wid = t >> 6, q16 = lane & 15, g = lane >> 4;
  unsigned* S = (unsigned*)lds;
  const bf16_t* proj = ws_proj(p);
  for (int task = bid; task < NTOK / 16; task += nb) {
    const int b = (task & 255) >> 4, jq = task & 15, kq = task >> 8;
    const int q0 = (((kq & 1) ? 31 - jq : jq) + 32 * (kq >> 1)) * 16;
    const int n = ((q0 >> 6) + 1) * 64, ntile = n >> 4;
    if (n <= 256) {
      unsigned short* mrow = (unsigned short*)(ws_mask(p) + (size_t)(b * SEQ + q0 + q16) * 64);
      if (g == 0) for (int kt = wid; kt < ntile; kt += 8) mrow[kt] = 0xffffu;
      continue;
    }
    const int gq = b * SEQ + q0 + q16;
    const int ntw = (ntile - wid + 7) >> 3;
    const bf16_t* kbase = ws_kidx(p) + (size_t)b * SEQ * 64 + (wid * 16 + q16) * 64 + g * 8;
    bf16x8 qf[4][2]; float wq[4];
#pragma unroll
    for (int h = 0; h < 4; ++h) {
#pragma unroll
      for (int ks = 0; ks < 2; ++ks) qf[h][ks] = *(const bf16x8*)(proj + (size_t)gq * PROJ_LD + C_QI + h * 64 + ks * 32 + g * 8);
      wq[h] = bf2f(proj[(size_t)gq * PROJ_LD + C_WI + h]) * 0.0625f;
    }
    __syncthreads();
    bf16x8 k0 = *(const bf16x8*)kbase, k1 = *(const bf16x8*)(kbase + 32);
#pragma unroll
    for (int tt = 0; tt < 16; ++tt) {
      if (tt < ntw) {
        const bf16x8 c0 = k0, c1 = k1;
        if (tt + 1 < ntw) { int koff = (tt + 1) * 8 * 16 * 64; asm volatile("" : "+v"(koff)); k0 = *(const bf16x8*)(kbase + koff); k1 = *(const bf16x8*)(kbase + koff + 32); }
        float sc[4] = {0.f, 0.f, 0.f, 0.f};
#pragma unroll
        for (int h = 0; h < 4; ++h) {
          f32x4v acc = {0.f, 0.f, 0.f, 0.f};
          acc = __builtin_amdgcn_mfma_f32_16x16x32_bf16(c0, qf[h][0], acc, 0, 0, 0);
          acc = __builtin_amdgcn_mfma_f32_16x16x32_bf16(c1, qf[h][1], acc, 0, 0, 0);
#pragma unroll
          for (int r = 0; r < 4; ++r) sc[r] += wq[h] * fmaxf(acc[r], 0.f);
        }
        u32x4 kv;
#pragma unroll
        for (int r = 0; r < 4; ++r) {
          const unsigned bts = __float_as_uint(sc[r]);
          unsigned key = bts ^ ((unsigned)((int)bts >> 31) | 0x80000000u);
          key += (key == 0x7fffffffu) ? 1u : 0u;
          kv[r] = key;
        }
        *(u32x4*)(S + q16 * IDX_LD + (wid + 8 * tt) * 16 + 4 * g) = kv;
      }
    }
    __syncthreads();
    {
      const int nreg = n >> 6;
      const int qa = 2 * wid;
      unsigned ua[32], ub[32];
#pragma unroll
      for (int j = 0; j < 32; ++j) { ua[j] = (j < nreg) ? S[qa * IDX_LD + 64 * j + lane] : 0u; ub[j] = (j < nreg) ? S[(qa + 1) * IDX_LD + 64 * j + lane] : 0u; }
      unsigned Ta = 0u, Tb = 0u; bool xa = false, xb = false;
      for (int bit = 31; bit >= 0; --bit) {
        const unsigned ca = xa ? Ta : (Ta | (1u << bit)), cb = xb ? Tb : (Tb | (1u << bit));
        int va = 0, vb = 0;
#pragma unroll
        for (int j4 = 0; j4 < 8; ++j4) {
          if (j4 * 4 < nreg) {
#pragma unroll
            for (int j = j4 * 4; j < j4 * 4 + 4; ++j) { va += (ua[j] >= ca) ? 1 : 0; vb += (ub[j] >= cb) ? 1 : 0; }
          }
        }
        int vab = va | (vb << 16);
        vab += __builtin_amdgcn_update_dpp(0, vab, 0xB1, 0xF, 0xF, true);
        vab += __builtin_amdgcn_update_dpp(0, vab, 0x4E, 0xF, 0xF, true);
        vab += __builtin_amdgcn_update_dpp(0, vab, 0x141, 0xF, 0xF, true);
        vab += __builtin_amdgcn_update_dpp(0, vab, 0x140, 0xF, 0xF, true);
        const int tot = __builtin_amdgcn_readlane(vab, 0) + __builtin_amdgcn_readlane(vab, 16) + __builtin_amdgcn_readlane(vab, 32) + __builtin_amdgcn_readlane(vab, 48);
        const int na = tot & 0xffff, nq = tot >> 16;
        if (!xa && na >= 256) { Ta = ca; xa = (na == 256); }
        if (!xb && nq >= 256) { Tb = cb; xb = (nq == 256); }
        if (xa && xb) break;
      }
#pragma unroll 1
      for (int which = 0; which < 2; ++which) {
        const unsigned T = which ? Tb : Ta;
        int cgt = 0;
#pragma unroll
        for (int j = 0; j < 32; ++j) cgt += __popcll(__ballot((which ? ub[j] : ua[j]) > T));
        int need = 256 - cgt;
        unsigned* mrow = ws_mask(p) + (size_t)(b * SEQ + q0 + qa + which) * 64;
#pragma unroll
        for (int j = 0; j < 32; ++j) {
          if (j < nreg) {
            const unsigned uv = which ? ub[j] : ua[j];
            unsigned long long sel = __ballot(uv > T);
            const unsigned long long eq = __ballot(uv == T);
            const int pe = __popcll(eq);
            if (pe <= need) { sel |= eq; need -= pe; }
            else { unsigned long long e = eq; for (int i = 0; i < need; ++i) { const unsigned long long low = e & (0ull - e); sel |= low; e ^= low; } need = 0; }
            if (lane == 0) { mrow[2 * j] = (unsigned)sel; mrow[2 * j + 1] = (unsigned)(sel >> 32); }
          }
        }
      }
    }
  }
}

DI void phase5a(const Params& p, int bid, int nb, char* lds) {
  const int lane = tid_() & 63, wid = tid_() >> 6;
  const bf16_t* proj = ws_proj(p);
  for (int gt = bid * 8 + wid; gt < NTOK; gt += nb * 8) {
    const int c0 = lane * 8, h = lane >> 3;
    const f32x4 y0 = *(const f32x4*)(ws_y(p) + (size_t)gt * RW + c0), y1 = *(const f32x4*)(ws_y(p) + (size_t)gt * RW + c0 + 4);
    float y[8] = {y0[0], y0[1], y0[2], y0[3], y1[0], y1[1], y1[2], y1[3]};
    float s = 0.f;
#pragma unroll
    for (int j = 0; j < 8; ++j) s += y[j];
    s += __shfl_xor(s, 1); s += __shfl_xor(s, 2); s += __shfl_xor(s, 4);
    const float mean = s * (1.0f / 64.0f);
    float q = 0.f;
#pragma unroll
    for (int j = 0; j < 8; ++j) { const float d = y[j] - mean; q += d * d; }
    q += __shfl_xor(q, 1); q += __shfl_xor(q, 2); q += __shfl_xor(q, 4);
    const float rstd = rsqrtf(q * (1.0f / 64.0f) + 64e-5f);
    float g[8], vr[8], vp[8];
    load8(ws_gg(p) + (size_t)gt * RW + c0, g);
    load8(proj + (size_t)gt * PROJ_LD + C_V + c0, vr);
    if (gt & (SEQ - 1)) load8(proj + (size_t)(gt - 1) * PROJ_LD + C_V + c0, vp);
    else {
#pragma unroll
      for (int j = 0; j < 8; ++j) vp[j] = 0.f;
    }
    const float bs = ws_bonus(p)[gt * NH + h];
    float o[8];
#pragma unroll
    for (int j = 0; j < 8; ++j) {
      const float v = vr[j] + p.shift_mu[C_V + c0 + j] * (vp[j] - vr[j]);
      o[j] = ((y[j] - mean) * rstd * p.gn_g[c0 + j] + p.gn_b[c0 + j] + bs * v) * g[j];
    }
    u32x4 w; w.x = pack2(o[0], o[1]); w.y = pack2(o[2], o[3]); w.z = pack2(o[4], o[5]); w.w = pack2(o[6], o[7]);
    *(u32x4*)(ws_mix(p) + (size_t)gt * DM + c0) = w;
  }
}

DI void phase5b(const Params& p, int bid, int nb, char* lds) {
  const int t = tid_(), lane = t & 63, wid = t >> 6;
  float* ql = (float*)lds;
  float* pr = ql + 1024;
  float* ol = pr + 2048;
  int* sel = (int*)(ol + 1024);
  int* nselp = sel + 256;
  for (int gq = bid; gq < NTOK; gq += nb) {
    const int b = gq >> 11;
    const bf16_t* ckv = ws_ckv(p) + (size_t)b * SEQ * 128;
    __syncthreads();
    for (int idx = t; idx < 1024; idx += NTHR) ql[idx] = bf2f(ws_qlat(p)[(size_t)gq * 1024 + idx]);
    if (wid == 0) {
      const int nadm = (((gq & (SEQ - 1)) >> 6) + 1) * 64;
      const unsigned word = (lane * 32 < nadm) ? ws_mask(p)[(size_t)gq * 64 + lane] : 0u;
      const int cnt = __popc(word);
      int incl = cnt;
      for (int o = 1; o < 64; o <<= 1) { const int u = __shfl_up(incl, o); if (lane >= o) incl += u; }
      int pos = incl - cnt;
      unsigned w = word;
      while (w) { const int bit = __ffs(w) - 1; w &= w - 1; if (pos < 256) sel[pos] = lane * 32 + bit; ++pos; }
      if (lane == 63) *nselp = incl < 256 ? incl : 256;
    }
    __syncthreads();
    const int nsel = *nselp;
    const int h = wid;
    float lg[4]; float mx = -1e30f;
#pragma unroll
    for (int q = 0; q < 4; ++q) {
      const int slot = lane + 64 * q;
      lg[q] = -1e30f;
      if (slot < nsel) {
        const bf16_t* kr = ckv + (size_t)sel[slot] * 128;
        float acc = 0.f;
#pragma unroll
        for (int d8 = 0; d8 < 16; ++d8) {
          float kf[8]; load8(kr + d8 * 8, kf);
          const f32x4 q0 = *(const f32x4*)(ql + h * 128 + d8 * 8), q1 = *(const f32x4*)(ql + h * 128 + d8 * 8 + 4);
          acc += q0[0] * kf[0] + q0[1] * kf[1] + q0[2] * kf[2] + q0[3] * kf[3] + q1[0] * kf[4] + q1[1] * kf[5] + q1[2] * kf[6] + q1[3] * kf[7];
        }
        lg[q] = acc;
      }
      mx = fmaxf(mx, lg[q]);
    }
    mx = wave_max(mx);
    float sm = 0.f;
#pragma unroll
    for (int q = 0; q < 4; ++q) { lg[q] = (lane + 64 * q < nsel) ? __expf(lg[q] - mx) : 0.f; sm += lg[q]; }
    sm = wave_sum(sm);
    const float inv = 1.0f / sm;
#pragma unroll
    for (int q = 0; q < 4; ++q) pr[h * 256 + lane + 64 * q] = lg[q] * inv;
    __syncthreads();
    {
      float o0 = 0.f, o1 = 0.f;
      for (int slot = 0; slot < nsel; ++slot) {
        const unsigned kv2 = *(const unsigned*)(ckv + (size_t)sel[slot] * 128 + lane * 2);
        const float pp = pr[h * 256 + slot];
        o0 += pp * __uint_as_float(kv2 << 16); o1 += pp * __uint_as_float(kv2 & 0xffff0000u);
      }
      ol[h * 128 + lane * 2] = o0; ol[h * 128 + lane * 2 + 1] = o1;
    }
    __syncthreads();
    {
      float acc = 0.f;
      for (int cc = 0; cc < 128; ++cc) acc += ol[h * 128 + cc] * p.w_uv[(size_t)(cc * NH + h) * HD + lane];
      ws_mix(p)[(size_t)gq * DM + RW + h * HD + lane] = f2bf(acc);
    }
  }
}

typedef short s16x4 __attribute__((ext_vector_type(4)));
#define KSWZ(row, colB) ((row) * 256 + ((colB) ^ (((row) & 7) << 4)))
DI int v_st(int k, int c) { const int kk = (k & ~0xC) | ((k & 4) << 1) | ((k & 8) >> 1); return ((kk >> 3) * 4 + (c >> 5)) * 512 + ((kk & 7) * 32 + (c & 31)) * 2; }
DI int v_rd_base(int lane) { return ((lane & 3) << 3) | (((lane >> 2) & 3) << 6) | (((lane >> 4) & 1) << 5) | (((lane >> 5) & 1) << 8); }
constexpr int v_rd_off(int d0, int ks, int half) { return d0 * 512 + ks * 4096 + half * 2048; }
template <int OFF> DI s16x4 tr_read(int vb) { s16x4 r; asm volatile("ds_read_b64_tr_b16 %0, %1 offset:%2" : "=&v"(r) : "v"(vb), "i"(OFF) : "memory"); return r; }
template <int D0> DI void pv_one(f32x16& od, int vb, bf16x8 pa0, bf16x8 pa1, bf16x8 pa2, bf16x8 pa3) {
  const s16x4 l0 = tr_read<v_rd_off(D0, 0, 0)>(vb), h0 = tr_read<v_rd_off(D0, 0, 1)>(vb), l1 = tr_read<v_rd_off(D0, 1, 0)>(vb), h1 = tr_read<v_rd_off(D0, 1, 1)>(vb);
  const s16x4 l2 = tr_read<v_rd_off(D0, 2, 0)>(vb), h2 = tr_read<v_rd_off(D0, 2, 1)>(vb), l3 = tr_read<v_rd_off(D0, 3, 0)>(vb), h3 = tr_read<v_rd_off(D0, 3, 1)>(vb);
  asm volatile("s_waitcnt lgkmcnt(0)" ::: "memory"); __builtin_amdgcn_sched_barrier(0);
#define PKV(L, H) (bf16x8){L[0], L[1], L[2], L[3], H[0], H[1], H[2], H[3]}
  od = __builtin_amdgcn_mfma_f32_32x32x16_bf16(pa0, PKV(l0, h0), od, 0, 0, 0);
  od = __builtin_amdgcn_mfma_f32_32x32x16_bf16(pa1, PKV(l1, h1), od, 0, 0, 0);
  od = __builtin_amdgcn_mfma_f32_32x32x16_bf16(pa2, PKV(l2, h2), od, 0, 0, 0);
  od = __builtin_amdgcn_mfma_f32_32x32x16_bf16(pa3, PKV(l3, h3), od, 0, 0, 0);
#undef PKV
}
constexpr int ATT_TILE = 64 * 128 * 2;
constexpr int ATT_LDS = 4 * ATT_TILE + 8 * 64 * 4;
DI void phase5b_mfma(const Params& p, int bid, int nb, char* lds) {
  const int t = tid_(), lane = t & 63, wid = t >> 6, r32 = lane & 31, hi = lane >> 5;
  char* V_lds = lds; char* K_lds = lds + 2 * ATT_TILE;
  float* al_l = (float*)(lds + 4 * ATT_TILE) + wid * 64; float* li_l = al_l + 32;
  const int sr = t >> 4, sc = (t & 15) * 8;
  const int vst0 = v_st(sr, sc), vst1 = v_st(32 + sr, sc), kst0 = KSWZ(sr, sc * 2), kst1 = KSWZ(32 + sr, sc * 2);
  const int vb0 = (int)(uintptr_t)V_lds + v_rd_base(lane);
  const int h = wid;
  constexpr float LOG2E = 1.4426950408889634f, THR = 8.0f;
  for (int task = bid; task < NTOK / 32; task += nb) {
    const int b = (task & 255) >> 4;
    int qt; { const int j = task & 15, k = task >> 8; qt = (k == 0) ? j : (k == 1) ? 31 - j : (k == 2) ? 32 + j : 63 - j; }
    const int q0 = qt * 32, n = ((q0 >> 6) + 1) * 64, NT = n >> 6;
    const int gq = b * SEQ + q0 + r32;
    const bf16_t* ckv = ws_ckv(p) + (size_t)b * SEQ * 128;
    const unsigned* mrow = ws_mask(p) + (size_t)gq * 64;
    bf16x8 qr[8];
    {
      f32x16 qa[4];
#pragma unroll
      for (int mt = 0; mt < 4; ++mt)
#pragma unroll
        for (int r = 0; r < 16; ++r) qa[mt][r] = 0.f;
      const bf16_t* wuk = ws_wukt(p) + (size_t)(h * 128 + r32) * 64 + hi * 8;
#pragma unroll
      for (int ks = 0; ks < 4; ++ks) {
        const bf16x8 bq = *(const bf16x8*)(ws_proj(p) + (size_t)gq * PROJ_LD + C_Q + h * HD + ks * 16 + hi * 8);
#pragma unroll
        for (int mt = 0; mt < 4; ++mt) { const bf16x8 aw = *(const bf16x8*)(wuk + mt * 32 * 64 + ks * 16); qa[mt] = __builtin_amdgcn_mfma_f32_32x32x16_bf16(aw, bq, qa[mt], 0, 0, 0); }
      }
#define QPK(P, BASE, OUT) do { unsigned a0 = cvtpk(P[BASE + 0] * 0.125f, P[BASE + 1] * 0.125f), a1 = cvtpk(P[BASE + 2] * 0.125f, P[BASE + 3] * 0.125f);   \
    unsigned b0 = cvtpk(P[BASE + 4] * 0.125f, P[BASE + 5] * 0.125f), b1 = cvtpk(P[BASE + 6] * 0.125f, P[BASE + 7] * 0.125f);                              \
    auto r0 = __builtin_amdgcn_permlane32_swap(a0, b0, false, false); auto r1 = __builtin_amdgcn_permlane32_swap(a1, b1, false, false); \
    u32x4 w = {r0[0], r1[0], r0[1], r1[1]}; OUT = *reinterpret_cast<bf16x8*>(&w); } while (0)
#pragma unroll
      for (int mt = 0; mt < 4; ++mt) { QPK(qa[mt], 0, qr[2 * mt]); QPK(qa[mt], 8, qr[2 * mt + 1]); }
#undef QPK
    }
    float m_reg = -1e30f, l_reg = 0.f;
    f32x16 o[4];
#pragma unroll
    for (int d = 0; d < 4; ++d)
#pragma unroll
      for (int r = 0; r < 16; ++r) o[d][r] = 0.f;
    u32x4 s0 = *(const u32x4*)(ckv + (size_t)sr * 128 + sc), s1 = *(const u32x4*)(ckv + (size_t)(32 + sr) * 128 + sc);
    __syncthreads();
    *(u32x4*)(V_lds + vst0) = s0; *(u32x4*)(V_lds + vst1) = s1; *(u32x4*)(K_lds + kst0) = s0; *(u32x4*)(K_lds + kst1) = s1;
    __syncthreads();
    for (int j = 0; j < NT; ++j) {
      const int buf = j & 1;
      if (j + 1 < NT) { s0 = *(const u32x4*)(ckv + (size_t)((j + 1) * 64 + sr) * 128 + sc); s1 = *(const u32x4*)(ckv + (size_t)((j + 1) * 64 + 32 + sr) * 128 + sc); }
      const unsigned w0 = mrow[2 * j] >> (4 * hi), w1 = mrow[2 * j + 1] >> (4 * hi);
      f32x16 p0, p1;
#pragma unroll
      for (int r = 0; r < 16; ++r) { p0[r] = 0.f; p1[r] = 0.f; }
      const char* Kb = K_lds + buf * ATT_TILE;
#pragma unroll
      for (int d0 = 0; d0 < 8; ++d0) {
        const int cb = (d0 * 16 + hi * 8) * 2;
        const bf16x8 b0 = *(const bf16x8*)(Kb + KSWZ(r32, cb)), b1 = *(const bf16x8*)(Kb + KSWZ(32 + r32, cb));
        p0 = __builtin_amdgcn_mfma_f32_32x32x16_bf16(b0, qr[d0], p0, 0, 0, 0);
        p1 = __builtin_amdgcn_mfma_f32_32x32x16_bf16(b1, qr[d0], p1, 0, 0, 0);
      }
      float pmax = p0[0];
#pragma unroll
      for (int r = 1; r < 16; ++r) pmax = fmaxf(pmax, p0[r]);
#pragma unroll
      for (int r = 0; r < 16; ++r) pmax = fmaxf(pmax, p1[r]);
      { auto rr = __builtin_amdgcn_permlane32_swap(__float_as_uint(pmax), __float_as_uint(pmax), false, false); pmax = fmaxf(__uint_as_float(rr[0]), __uint_as_float(rr[1])); }
      float alpha = 1.f;
      if (!__all(pmax - m_reg <= THR)) { const float mn = fmaxf(m_reg, pmax); alpha = __builtin_amdgcn_exp2f((m_reg - mn) * LOG2E); m_reg = mn; }
      const float mnC = -m_reg * LOG2E;
      float ps = 0.f;
#pragma unroll
      for (int r = 0; r < 16; ++r) {
        const int bitp = (r & 3) + 8 * (r >> 2);
        float e0 = __builtin_amdgcn_exp2f(fmaf(p0[r], LOG2E, mnC)), e1 = __builtin_amdgcn_exp2f(fmaf(p1[r], LOG2E, mnC));
        e0 = ((w0 >> bitp) & 1u) ? e0 : 0.f; e1 = ((w1 >> bitp) & 1u) ? e1 : 0.f;
        p0[r] = e0; p1[r] = e1; ps += e0 + e1;
      }
      { auto rr = __builtin_amdgcn_permlane32_swap(__float_as_uint(ps), __float_as_uint(ps), false, false); ps = __uint_as_float(rr[0]) + __uint_as_float(rr[1]); }
      l_reg = l_reg * alpha + ps;
      if (__any(alpha < 1.f)) {
        if (hi == 0) al_l[r32] = alpha;
        asm volatile("s_waitcnt lgkmcnt(0)" ::: "memory");
#pragma unroll
        for (int d = 0; d < 4; ++d)
#pragma unroll
          for (int r = 0; r < 16; ++r) o[d][r] *= al_l[crow(r, hi)];
      }
      bf16x8 pa0, pa1, pa2, pa3;
#define PK4(P, BASE, OUT) do { unsigned a0 = cvtpk(P[BASE + 0], P[BASE + 1]), a1 = cvtpk(P[BASE + 2], P[BASE + 3]);   \
    unsigned b0 = cvtpk(P[BASE + 4], P[BASE + 5]), b1 = cvtpk(P[BASE + 6], P[BASE + 7]);                              \
    auto r0 = __builtin_amdgcn_permlane32_swap(a0, b0, false, false); auto r1 = __builtin_amdgcn_permlane32_swap(a1, b1, false, false); \
    u32x4 w = {r0[0], r1[0], r0[1], r1[1]}; OUT = *reinterpret_cast<bf16x8*>(&w); } while (0)
      PK4(p0, 0, pa0); PK4(p0, 8, pa1); PK4(p1, 0, pa2); PK4(p1, 8, pa3);
#undef PK4
      const int vb = vb0 + buf * ATT_TILE;
      pv_one<0>(o[0], vb, pa0, pa1, pa2, pa3); pv_one<1>(o[1], vb, pa0, pa1, pa2, pa3); pv_one<2>(o[2], vb, pa0, pa1, pa2, pa3); pv_one<3>(o[3], vb, pa0, pa1, pa2, pa3);
      if (j + 1 < NT) {
        char* Vn = V_lds + (buf ^ 1) * ATT_TILE; char* Kn = K_lds + (buf ^ 1) * ATT_TILE;
        *(u32x4*)(Vn + vst0) = s0; *(u32x4*)(Vn + vst1) = s1; *(u32x4*)(Kn + kst0) = s0; *(u32x4*)(Kn + kst1) = s1;
      }
      __syncthreads();
    }
    if (hi == 0) li_l[r32] = l_reg;
    asm volatile("s_waitcnt lgkmcnt(0)" ::: "memory");
    int hio = hi, r32o = r32;
    asm volatile("" : "+v"(hio), "+v"(r32o));
    char* Ow = lds + wid * 8192;
#pragma unroll
    for (int r = 0; r < 16; ++r) {
      const int row = crow(r, hio); const float rl = 1.0f / li_l[row];
#pragma unroll
      for (int d = 0; d < 4; ++d) *(bf16_t*)(Ow + KSWZ(row, (d * 32 + r32o) * 2)) = f2bf(o[d][r] * rl);
    }
    asm volatile("s_waitcnt lgkmcnt(0)" ::: "memory");
    f32x16 oa[2];
#pragma unroll
    for (int i = 0; i < 2; ++i)
#pragma unroll
      for (int r = 0; r < 16; ++r) oa[i][r] = 0.f;
    const bf16_t* wuv = ws_wuvt(p) + (size_t)h * 64 * 128 + r32o * 128 + hio * 8;
#pragma unroll
    for (int ks = 0; ks < 8; ++ks) {
      const bf16x8 a = *(const bf16x8*)(Ow + KSWZ(r32o, (ks * 16 + hio * 8) * 2));
#pragma unroll
      for (int i = 0; i < 2; ++i) {
        const bf16x8 bw = *(const bf16x8*)(wuv + i * 32 * 128 + ks * 16);
        oa[i] = __builtin_amdgcn_mfma_f32_32x32x16_bf16(a, bw, oa[i], 0, 0, 0);
      }
    }
    bf16_t* mx = ws_mix(p) + (size_t)(b * SEQ + q0 + 4 * hio) * DM + RW + h * HD + r32o;
#pragma unroll
    for (int i = 0; i < 2; ++i)
#pragma unroll
      for (int r = 0; r < 16; ++r) mx[((r & 3) + 8 * (r >> 2)) * DM + i * 32] = f2bf(oa[i][r]);
  }
}

struct EpiOut { const float* x; const float* mod; float* o; int row0, col0; DI void operator()(int r, int c, float v0, float v1) const {
  const int row = row0 + r, col = col0 + c, b = row >> 11; const size_t idx = (size_t)row * DM + col;
  o[idx] = x[idx] + (1.0f + mod[b * 6144 + 2048 + col]) * v0; o[idx + 32] = x[idx + 32] + (1.0f + mod[b * 6144 + 2048 + col + 32]) * v1; } };
DI void phase6(const Params& p, int bid, int nb, char* lds) {
  constexpr int NT = DM / GBN;
  for (int tile = bid; tile < (NTOK / GBM) * NT; tile += nb) {
    const int mt = tile / NT, nt = tile % NT;
    gemm_tile(ws_mix(p), DM, ARowBase{mt * GBM}, ws_wtout(p), DM, nt * GBN, DM, EpiOut{p.x, ws_mod(p), p.out, mt * GBM, nt * GBN}, lds);
  }
}

namespace pg8 {
#define PG8_LAS __attribute__((address_space(3)))
constexpr int BM = 256, BK = 64, HALF = 128, HTB = HALF * BK * 2  , STAGE_BYTES = 8 * HTB, NXCD = 8, WGM = 8;

__host__ __device__ __forceinline__ int lds_byte(int r, int c) { const int st = (r >> 4) * 2 + (c >> 5), rr = r & 15, cc = c & 31, ob = rr * 64 + cc * 2; return st * 1024 + (ob ^ (((ob >> 9) & 1) << 5)); }
__host__ __device__ __forceinline__ void stage_rc(int b, int& R, int& C) { const int st = b / 1024, sb = b % 1024, swz = sb ^ (((sb >> 9) & 1) << 5); R = (st >> 1) * 16 + swz / 64; C = (st & 1) * 32 + (swz % 64) / 2; }
__host__ __device__ __forceinline__ int perm32(int rho) { const int n = rho >> 4, i = rho & 15; return 8 * (i >> 2) + 4 * n + (i & 3); }

struct Unit { int pm, pn, e; };
struct Gemm { const bf16_t* A; const bf16_t* Bt; int M, N, K; size_t bstride; };

struct StaticOrder {
    static constexpr bool GATHER = false;
    int nM, nN, nwg, G, c;
    __host__ __device__ void init(int M, int N, int G_, int c_) { nM = M / BM; nN = N / BM; nwg = nM * nN; G = G_; c = c_; }
    __host__ __device__ bool next(int i, Unit& u) const {
        const long L = (long)i * G + c; if (L >= nwg) return false;
        int wgid = (int)L; { const int q = nwg / NXCD, r = nwg % NXCD, xcd = wgid % NXCD, off = wgid / NXCD; wgid = (xcd < r ? xcd * (q + 1) : r * (q + 1) + (xcd - r) * q) + off; }
        const int nig = WGM * nN, gid = wgid / nig, fm = gid * WGM, gsz = (nM - fm) < WGM ? (nM - fm) : WGM;
        u.pm = fm + ((wgid % nig) % gsz); u.pn = (wgid % nig) / gsz; u.e = 0; return true;
    }
    __device__ __forceinline__ void a_ready(const Unit&) const {}
    __device__ __forceinline__ void done(const Unit&) const {}
    __device__ __forceinline__ int arow(const Unit&, int) const { return 0; }
};
template <class Epi, class Sched, bool ALIGN_EPI = false, bool SP2 = false>
__device__ __forceinline__ void gemm_phase(PG8_LAS unsigned char* lds, const Gemm g, const Sched& S, const Epi& E) {
    const int tid = threadIdx.x, wid = __builtin_amdgcn_readfirstlane(tid >> 6), lane = tid & 63, wr = wid >> 2, wc = wid & 3, fr = lane & 15, fq = lane >> 4;
    const int K = g.K, nt = K / BK;
    unsigned voffA[2], voffB[2];
#pragma unroll
    for (int i = 0; i < 2; ++i) { int R, C; stage_rc(tid * 16 + i * 8192, R, C); const int Rb = Epi::PERM ? ((R & ~31) + perm32(R & 31)) : R;
        voffA[i] = (unsigned)(R * K + C) * 2u; voffB[i] = (unsigned)(Rb * K + C) * 2u; }
    unsigned vAc[2][2], vAn[2][2];
    const size_t kstep = (size_t)(BK * 2);
    const size_t hstep = (size_t)HALF * K * 2;
    const size_t tstep = 2 * hstep;
    const unsigned ldsw = (unsigned)wid * 1024u;
    const int aoff = lds_byte(wr * 64 + fr, fq * 8), boff = lds_byte(wc * 32 + fr, fq * 8);
#define PG8_SA(b, h) (((b) * 2 + (h)) * HTB)
#define PG8_SB(b, h) ((4 + (b) * 2 + (h)) * HTB)
#define PG8_STAGE(bufoff, gbase, voff) do { _Pragma("unroll") for (int _i = 0; _i < 2; ++_i) \
        __builtin_amdgcn_global_load_lds((const unsigned*)((const char*)(gbase) + (voff)[_i]), (PG8_LAS unsigned*)(lds + (bufoff) + ldsw + _i * 8192), 16, 0, 0); } while (0)
#define PG8_STAGE_A(bufoff, gbase, v0_, v1_) do { \
        __builtin_amdgcn_global_load_lds((const unsigned*)((const char*)(gbase) + (v0_)), (PG8_LAS unsigned*)(lds + (bufoff) + ldsw), 16, 0, 0); \
        __builtin_amdgcn_global_load_lds((const unsigned*)((const char*)(gbase) + (v1_)), (PG8_LAS unsigned*)(lds + (bufoff) + ldsw + 8192), 16, 0, 0); } while (0)
#define PG8_AOFF(u_, dst_) do { if constexpr (Sched::GATHER) { _Pragma("unroll") for (int h_ = 0; h_ < 2; ++h_) _Pragma("unroll") for (int i_ = 0; i_ < 2; ++i_) { int R_, C_; stage_rc(tid * 16 + i_ * 8192, R_, C_); \
            dst_[h_][i_] = (unsigned)(S.arow(u_, h_ * HALF + R_) * K + C_) * 2u; } asm volatile("s_waitcnt vmcnt(0)" ::: "memory"); } \
        else { _Pragma("unroll") for (int h_ = 0; h_ < 2; ++h_) _Pragma("unroll") for (int i_ = 0; i_ < 2; ++i_) dst_[h_][i_] = voffA[i_] + (unsigned)(h_ * hstep); } } while (0)
#define PG8_LDA(dst, b, h) do { _Pragma("unroll") for (int m = 0; m < 4; ++m) _Pragma("unroll") for (int k = 0; k < 2; ++k) dst[m][k] = *(const PG8_LAS bf16x8*)(lds + PG8_SA(b, h) + aoff + m * 2048 + k * 1024); } while (0)
#define PG8_LDB(dst, b, h) do { _Pragma("unroll") for (int n = 0; n < 2; ++n) _Pragma("unroll") for (int k = 0; k < 2; ++k) dst[n][k] = *(const PG8_LAS bf16x8*)(lds + PG8_SB(b, h) + boff + n * 2048 + k * 1024); } while (0)
#define PG8_MMA(ai, bj, At, Bt) do { __builtin_amdgcn_s_setprio(1); _Pragma("unroll") for (int m = 0; m < 4; ++m) _Pragma("unroll") for (int n = 0; n < 2; ++n) _Pragma("unroll") for (int k = 0; k < 2; ++k) \
        acc[ai][bj][m][n] = __builtin_amdgcn_mfma_f32_16x16x32_bf16(Bt[n][k], At[m][k], acc[ai][bj][m][n], 0, 0, 0); __builtin_amdgcn_s_setprio(0); } while (0)
#define PG8_WAIT_V(n) asm volatile("s_waitcnt vmcnt(" #n ")" ::: "memory")
#define PG8_WAIT_L(n) asm volatile("s_waitcnt lgkmcnt(" #n ")" ::: "memory")
#define PG8_BAR __builtin_amdgcn_s_barrier()
#define PG8_SCHED __builtin_amdgcn_sched_barrier(0)
    Unit cur, nxt; int ui = 0;
    if (!S.next(0, cur)) return;
    f32x4 acc[2][2][4][2];
#pragma unroll
    for (int a = 0; a < 2; ++a)
#pragma unroll
        for (int b = 0; b < 2; ++b)
#pragma unroll
            for (int m = 0; m < 4; ++m)
#pragma unroll
                for (int n = 0; n < 2; ++n) acc[a][b][m][n] = (f32x4){0.f, 0.f, 0.f, 0.f};
    bf16x8 At[4][2], B0[2][2], B1[2][2];
    const char* cA = Sched::GATHER ? (const char*)g.A : (const char*)g.A + (size_t)cur.pm * tstep; PG8_AOFF(cur, vAc); const char* cB = (const char*)g.Bt + (size_t)cur.e * g.bstride + (size_t)cur.pn * tstep;
    S.a_ready(cur);
    if constexpr (SP2) {
        PG8_STAGE(PG8_SB(0, 0), cB, voffB); PG8_STAGE(PG8_SB(0, 1), cB + hstep, voffB); PG8_STAGE_A(PG8_SA(0, 0), cA, vAc[0][0], vAc[0][1]); PG8_STAGE_A(PG8_SA(0, 1), cA, vAc[1][0], vAc[1][1]);
        if (wr == 1) PG8_BAR;
        PG8_WAIT_V(2); PG8_BAR;
        PG8_STAGE(PG8_SB(1, 0), cB + kstep, voffB); PG8_STAGE_A(PG8_SA(1, 0), cA + kstep, vAc[0][0], vAc[0][1]); PG8_STAGE(PG8_SB(1, 1), cB + hstep + kstep, voffB);
        PG8_WAIT_V(6); PG8_BAR;
    } else {
        PG8_STAGE(PG8_SB(0, 0), cB, voffB); PG8_STAGE(PG8_SA(0, 0), cA, voffA); PG8_STAGE(PG8_SB(0, 1), cB + hstep, voffB); PG8_STAGE(PG8_SA(0, 1), cA + hstep, voffA);
        if (wr == 1) PG8_BAR;
        PG8_WAIT_V(4); PG8_BAR;
        PG8_STAGE(PG8_SB(1, 0), cB + kstep, voffB); PG8_STAGE(PG8_SA(1, 0), cA + kstep, voffA); PG8_STAGE(PG8_SB(1, 1), cB + hstep + kstep, voffB);
        PG8_WAIT_V(6); PG8_BAR;
    }
    for (;;) {
        const bool has_next = S.next(ui + 1, nxt);
        const char* nA = (has_next && !Sched::GATHER) ? (const char*)g.A + (size_t)nxt.pm * tstep : cA;
        if (has_next) PG8_AOFF(nxt, vAn); else { _Pragma("unroll") for (int h_ = 0; h_ < 2; ++h_) _Pragma("unroll") for (int i_ = 0; i_ < 2; ++i_) vAn[h_][i_] = vAc[h_][i_]; }
        const char* nB = has_next ? (const char*)g.Bt + (size_t)nxt.e * g.bstride + (size_t)nxt.pn * tstep : cB;
        for (int t = 0; t < nt; t += 2) {
            const bool last = (t == nt - 2);
            const char* a1 = cA + (size_t)(t + 1) * kstep;
            const char* a2 = last ? nA : cA + (size_t)(t + 2) * kstep; const char* b2 = last ? nB : cB + (size_t)(t + 2) * kstep;
            const char* a3 = a2 + kstep; const char* b3 = b2 + kstep;
            if (last && has_next) S.a_ready(nxt);
            if constexpr (SP2) {
            PG8_LDB(B0, 0, 0); PG8_LDB(B1, 0, 1); PG8_SCHED; PG8_LDA(At, 0, 0); PG8_STAGE_A(PG8_SA(1, 1), a1, vAc[1][0], vAc[1][1]);
            PG8_WAIT_V(8); PG8_WAIT_L(0); PG8_BAR; PG8_MMA(0, 0, At, B0); PG8_MMA(0, 1, At, B1); PG8_BAR; PG8_SCHED;
            PG8_LDA(At, 0, 1); PG8_STAGE(PG8_SB(0, 0), b2, voffB); PG8_STAGE(PG8_SB(0, 1), b2 + hstep, voffB); PG8_STAGE_A(PG8_SA(0, 0), a2, last ? vAn[0][0] : vAc[0][0], last ? vAn[0][1] : vAc[0][1]);
            PG8_WAIT_V(8); PG8_WAIT_L(0); PG8_BAR; PG8_MMA(1, 0, At, B0); PG8_MMA(1, 1, At, B1); PG8_BAR; PG8_SCHED;
            PG8_LDB(B0, 1, 0); PG8_LDB(B1, 1, 1); PG8_SCHED; PG8_LDA(At, 1, 0); PG8_STAGE_A(PG8_SA(0, 1), a2, last ? vAn[1][0] : vAc[1][0], last ? vAn[1][1] : vAc[1][1]);
            PG8_WAIT_V(8); PG8_WAIT_L(0); PG8_BAR; PG8_MMA(0, 0, At, B0); PG8_MMA(0, 1, At, B1); PG8_BAR; PG8_SCHED;
            PG8_LDA(At, 1, 1); PG8_STAGE(PG8_SB(1, 0), b3, voffB); PG8_STAGE(PG8_SB(1, 1), b3 + hstep, voffB); PG8_STAGE_A(PG8_SA(1, 0), a3, last ? vAn[0][0] : vAc[0][0], last ? vAn[0][1] : vAc[0][1]);
            PG8_WAIT_V(8); PG8_WAIT_L(0); PG8_BAR; PG8_MMA(1, 0, At, B0); PG8_MMA(1, 1, At, B1); PG8_BAR; PG8_SCHED;
            } else {
            PG8_LDB(B0, 0, 0); PG8_SCHED; PG8_LDA(At, 0, 0); PG8_STAGE(PG8_SA(1, 1), a1 + hstep, voffA);
            PG8_WAIT_L(8); PG8_BAR; PG8_WAIT_L(0); PG8_MMA(0, 0, At, B0); PG8_BAR; PG8_SCHED;
            PG8_LDB(B1, 0, 1); PG8_STAGE(PG8_SB(0, 0), b2, voffB);
            PG8_BAR; PG8_WAIT_L(0); PG8_MMA(0, 1, At, B1); PG8_BAR;
            PG8_LDA(At, 0, 1); PG8_STAGE(PG8_SA(0, 0), a2, voffA);
            PG8_BAR; PG8_WAIT_L(0); PG8_MMA(1, 0, At, B0); PG8_BAR; PG8_SCHED;
            PG8_STAGE(PG8_SB(0, 1), b2 + hstep, voffB);
            PG8_WAIT_V(6); PG8_BAR; PG8_MMA(1, 1, At, B1); PG8_BAR;
            PG8_LDB(B0, 1, 0); PG8_SCHED; PG8_LDA(At, 1, 0); PG8_STAGE(PG8_SA(0, 1), a2 + hstep, voffA);
            PG8_WAIT_L(8); PG8_BAR; PG8_WAIT_L(0); PG8_MMA(0, 0, At, B0); PG8_BAR; PG8_SCHED;
            PG8_LDB(B1, 1, 1); PG8_STAGE(PG8_SB(1, 0), b3, voffB);
            PG8_BAR; PG8_WAIT_L(0); PG8_MMA(0, 1, At, B1); PG8_BAR;
            PG8_LDA(At, 1, 1); PG8_STAGE(PG8_SA(1, 0), a3, voffA);
            PG8_BAR; PG8_WAIT_L(0); PG8_MMA(1, 0, At, B0); PG8_BAR; PG8_SCHED;
            PG8_STAGE(PG8_SB(1, 1), b3 + hstep, voffB);
            PG8_WAIT_V(6); PG8_BAR; PG8_MMA(1, 1, At, B1); PG8_BAR;
            }
        }
        if constexpr (ALIGN_EPI) { if (wr == 0) PG8_BAR; }
        if constexpr (!Epi::AFTER_DRAIN) { E(acc, cur, wr, wc, fr, fq); S.done(cur); }
        if (!has_next) break;
#pragma unroll
        for (int a = 0; a < 2; ++a)
#pragma unroll
            for (int b = 0; b < 2; ++b)
#pragma unroll
                for (int m = 0; m < 4; ++m)
#pragma unroll
                    for (int n = 0; n < 2; ++n) acc[a][b][m][n] = (f32x4){0.f, 0.f, 0.f, 0.f};
        cur = nxt; cA = nA; cB = nB; ++ui;
#pragma unroll
        for (int h_ = 0; h_ < 2; ++h_)
#pragma unroll
            for (int i_ = 0; i_ < 2; ++i_) vAc[h_][i_] = vAn[h_][i_];
        if constexpr (ALIGN_EPI) { if (wr == 1) PG8_BAR; }
    }
    PG8_WAIT_V(0);
    if constexpr (!ALIGN_EPI) { if (wr == 0) PG8_BAR; }
    PG8_BAR;
    if constexpr (Epi::AFTER_DRAIN) { E.fused(acc, cur, wr, wc, fr, fq, lds, wid, lane); S.done(cur); }
#undef PG8_SA
#undef PG8_SB
#undef PG8_STAGE
#undef PG8_STAGE_A
#undef PG8_AOFF
#undef PG8_LDA
#undef PG8_LDB
#undef PG8_MMA
#undef PG8_WAIT_V
#undef PG8_WAIT_L
#undef PG8_BAR
#undef PG8_SCHED
}
}


constexpr int TAB_OFF = 131072;
DI void build_tables(const Params& p, char* lds) {
  int* T = (int*)(lds + TAB_OFF); unsigned char* te = (unsigned char*)(T + 80);
  __syncthreads();
  if (tid_() == 0) {
    int acc = 0;
    for (int e = 0; e < NEXP; ++e) { const int c = ws_cnt(p)[e]; T[e] = c; T[32 + e] = acc; const int nt = (c + 255) >> 8; for (int k = 0; k < nt; ++k) te[acc + k] = (unsigned char)e; acc += nt; }
    T[64] = acc;
  }
  __syncthreads();
}
template <bool GATHER_> struct GroupOrderT { static constexpr bool GATHER = GATHER_; const int* T; const unsigned char* te; int G, c; const int* list;
  DI bool next(int i, pg8::Unit& u) const { const int L = i * G + c; if (L >= T[64] * 4) return false; u.pm = L >> 2; u.pn = L & 3; u.e = te[u.pm]; return true; }
  DI void a_ready(const pg8::Unit&) const {}
  DI void done(const pg8::Unit&) const {}
  DI int arow(const pg8::Unit& u, int r) const {
    const int slot = (u.pm - T[32 + u.e]) * 256 + r; return slot < T[u.e] ? (list[u.e * LCAP + slot] >> 1) : 0; } };
typedef GroupOrderT<false> GroupOrder;

struct EpiProjP { static constexpr bool PERM = true, AFTER_DRAIN = false; bf16_t* O; int ldc;
  DI void operator()(const f32x4 (&acc)[2][2][4][2], const pg8::Unit& u, int wr, int wc, int fr, int fq) const {
    const int row0 = u.pm * 256 + wr * 64 + fr, col0 = u.pn * 256 + wc * 32 + 8 * fq;
#pragma unroll
    for (int ai = 0; ai < 2; ++ai)
#pragma unroll
      for (int m = 0; m < 4; ++m) { bf16_t* rowp = O + (size_t)(row0 + ai * 128 + m * 16) * ldc + col0;
#pragma unroll
        for (int bj = 0; bj < 2; ++bj) { const f32x4 v0 = acc[ai][bj][m][0] + 0.0f, v1 = acc[ai][bj][m][1] + 0.0f;
          u32x4 w; w.x = cvtpk(v0[0], v0[1]); w.y = cvtpk(v0[2], v0[3]); w.z = cvtpk(v1[0], v1[1]); w.w = cvtpk(v1[2], v1[3]);
          *(u32x4*)(rowp + bj * 128) = w; } }
  } };
DI void phase2_pg8(const Params& p, int bid, int nb, char* lds) {
  pg8::Gemm g{ws_h1(p), ws_wtin(p), NTOK, PROJ_LD, DM, 0};
  pg8::StaticOrder S; S.init(NTOK, PROJ_LD, nb, bid);
  EpiProjP E{ws_proj(p), PROJ_LD};
  __syncthreads();
  pg8::gemm_phase<EpiProjP, pg8::StaticOrder, true, true>((PG8_LAS unsigned char*)lds, g, S, E);
  __syncthreads();
}
struct EpiResidP { static constexpr bool PERM = false, AFTER_DRAIN = false; const float* x; const float* mod; float* o;
  DI void operator()(const f32x4 (&acc)[2][2][4][2], const pg8::Unit& u, int wr, int wc, int fr, int fq) const {
    const int row0 = u.pm * 256 + wr * 64 + fr, col0 = u.pn * 256 + wc * 32 + 4 * fq;
#pragma unroll
    for (int ai = 0; ai < 2; ++ai)
#pragma unroll
      for (int m = 0; m < 4; ++m) { const int row = row0 + ai * 128 + m * 16, b = row >> 11;
#pragma unroll
        for (int bj = 0; bj < 2; ++bj)
#pragma unroll
          for (int n = 0; n < 2; ++n) { const int col = col0 + bj * 128 + n * 16; const size_t idx = (size_t)row * DM + col;
            const f32x4 xv = *(const f32x4*)(x + idx), gv = *(const f32x4*)(mod + b * 6144 + 2048 + col);
            *(f32x4*)(o + idx) = xv + (gv + 1.0f) * acc[ai][bj][m][n]; } }
  } };
DI void phase6_pg8(const Params& p, int bid, int nb, char* lds) {
  pg8::Gemm g{ws_mix(p), ws_wtout(p), NTOK, DM, DM, 0};
  pg8::StaticOrder S; S.init(NTOK, DM, nb, bid);
  EpiResidP E{p.x, ws_mod(p), ws_x1(p)};
  __syncthreads();
  pg8::gemm_phase<EpiResidP, pg8::StaticOrder, true, true>((PG8_LAS unsigned char*)lds, g, S, E);
  __syncthreads();
}
DI bf16_t* ws_h2s(const Params& p) { return (bf16_t*)(p.ws + OFF_C); }
DI bf16_t* ws_hidp(const Params& p) { return (bf16_t*)(p.ws + OFF_F); }
DI void phase7c(const Params& p, int bid, int nb, char* lds) {
  build_tables(p, lds);
  const int* T = (const int*)(lds + TAB_OFF);
  const int lane = tid_() & 63, gw = bid * 8 + (tid_() >> 6), nw = nb * 8;
  for (int e = 0; e < NEXP; ++e) {
    const int c = T[e]; const size_t r0 = (size_t)T[32 + e] * 256;
    for (int r = gw; r < c; r += nw) {
      const int tok = ws_list(p)[e * LCAP + r] >> 1;
      const u32x4* src = (const u32x4*)(ws_h2(p) + (size_t)tok * DM); u32x4* dst = (u32x4*)(ws_h2s(p) + (r0 + r) * DM);
      dst[lane] = src[lane]; dst[lane + 64] = src[lane + 64];
    }
  }
}
struct EpiSwiGLU { static constexpr bool PERM = true, AFTER_DRAIN = false; bf16_t* O;
  DI void operator()(const f32x4 (&acc)[2][2][4][2], const pg8::Unit& u, int wr, int wc, int fr, int fq) const {
    const int row0 = u.pm * 256 + wr * 64 + fr, col0 = u.pn * 128 + wc * 32 + 8 * fq;
#pragma unroll
    for (int ai = 0; ai < 2; ++ai)
#pragma unroll
      for (int m = 0; m < 4; ++m) {
        float hv[8];
#pragma unroll
        for (int n = 0; n < 2; ++n)
#pragma unroll
          for (int i = 0; i < 4; ++i) { const float gt = acc[ai][0][m][n][i], up = acc[ai][1][m][n][i]; hv[n * 4 + i] = gt / (1.0f + __expf(-gt)) * up; }
        u32x4 w; w.x = cvtpk(hv[0], hv[1]); w.y = cvtpk(hv[2], hv[3]); w.z = cvtpk(hv[4], hv[5]); w.w = cvtpk(hv[6], hv[7]);
        *(u32x4*)(O + (size_t)(row0 + ai * 128 + m * 16) * DEXP + col0) = w; }
  } };
DI void phase8_pg8(const Params& p, int bid, int nb, char* lds) {
  build_tables(p, lds);
  pg8::Gemm g{ws_h2(p), ws_wgu(p), 0, 1024, DM, (size_t)1024 * 1024 * 2};
  GroupOrderT<true> S{(const int*)(lds + TAB_OFF), (const unsigned char*)((const int*)(lds + TAB_OFF) + 80), nb, bid, ws_list(p)};
  EpiSwiGLU E{ws_hidp(p)};
  pg8::gemm_phase<EpiSwiGLU, GroupOrderT<true>, true, true>((PG8_LAS unsigned char*)lds, g, S, E);
  __syncthreads();
}
struct EpiYP { static constexpr bool PERM = true, AFTER_DRAIN = false; bf16_t* O; const int* list; const float* wa; const int* T;
  DI void operator()(const f32x4 (&acc)[2][2][4][2], const pg8::Unit& u, int wr, int wc, int fr, int fq) const {
    const int cnt = T[u.e], rbase = (u.pm - T[32 + u.e]) * 256 + wr * 64 + fr, col0 = u.pn * 256 + wc * 32 + 8 * fq;
#pragma unroll
    for (int ai = 0; ai < 2; ++ai)
#pragma unroll
      for (int m = 0; m < 4; ++m) { const int r = rbase + ai * 128 + m * 16;
        if (r < cnt) { const int aid = list[u.e * LCAP + r]; const float wv = wa[aid]; bf16_t* rowp = O + (size_t)aid * DM + col0;
#pragma unroll
          for (int bj = 0; bj < 2; ++bj) { const f32x4 v0 = acc[ai][bj][m][0] * wv, v1 = acc[ai][bj][m][1] * wv;
            u32x4 w; w.x = cvtpk(v0[0], v0[1]); w.y = cvtpk(v0[2], v0[3]); w.z = cvtpk(v1[0], v1[1]); w.w = cvtpk(v1[2], v1[3]);
            *(u32x4*)(rowp + bj * 128) = w; } } }
  } };
DI void phase9_pg8(const Params& p, int bid, int nb, char* lds) {
  build_tables(p, lds);
  pg8::Gemm g{ws_hidp(p), ws_wd(p), 0, 1024, DEXP, (size_t)1024 * 512 * 2};
  GroupOrder S{(const int*)(lds + TAB_OFF), (const unsigned char*)((const int*)(lds + TAB_OFF) + 80), nb, bid, nullptr};
  EpiYP E{ws_ybuf(p), ws_list(p), ws_wa(p), (const int*)(lds + TAB_OFF)};
  pg8::gemm_phase<EpiYP, GroupOrder, true, true>((PG8_LAS unsigned char*)lds, g, S, E);
  __syncthreads();
}

typedef float f32x4m __attribute__((ext_vector_type(4)));
constexpr int H_LD = 1028;
DI void phase7(const Params& p, int bid, int nb, char* lds) {
  const int t = tid_(), lane = t & 63, wid = t >> 6, l16 = lane & 15, lg4 = lane >> 4;
  float* H = (float*)lds;
  float* part = H + 16 * H_LD;
  float* lgt = part + 8 * 16 * 48;
  int* ecnt = (int*)(lgt + 16 * 48);
  int* ebase = ecnt + 32;
  int* sl_aid = ebase + 32;
  int* sl_e = sl_aid + 512;
  const float* mod = ws_mod(p);
  if (t < NEXP) ecnt[t] = 0;
  int nloc = 0;
  for (int tile = bid; tile < NTOK / 16; tile += nb) {
    __syncthreads();
#pragma unroll
    for (int q = 0; q < 2; ++q) {
      const int tl = wid * 2 + q, gt = tile * 16 + tl, b = gt >> 11;
      const float* xr = ws_x1(p) + (size_t)gt * DM;
      f32x4 v[4]; float ss = 0.f;
#pragma unroll
      for (int i = 0; i < 4; ++i) { v[i] = *(const f32x4*)(xr + lane * 4 + 256 * i); ss += v[i][0] * v[i][0] + v[i][1] * v[i][1] + v[i][2] * v[i][2] + v[i][3] * v[i][3]; }
      ss = wave_sum(ss);
      const float rstd = rsqrtf(ss * (1.0f / DM) + 1e-6f);
#pragma unroll
      for (int i = 0; i < 4; ++i) {
        const int col = lane * 4 + 256 * i;
        const f32x4 g = *(const f32x4*)(p.norm2_g + col), sh = *(const f32x4*)(mod + b * 6144 + 3072 + col), sc = *(const f32x4*)(mod + b * 6144 + 4096 + col);
        f32x4 o;
#pragma unroll
        for (int j = 0; j < 4; ++j) o[j] = v[i][j] * rstd * g[j] * (1.0f + sc[j]) + sh[j];
        *(f32x4*)(H + tl * H_LD + col) = o;
        u32x2 w; w.x = cvtpk(o[0], o[1]); w.y = cvtpk(o[2], o[3]);
        *(u32x2*)(ws_h2(p) + (size_t)gt * DM + col) = w;
      }
    }
    __syncthreads();
    {
      f32x4m acc0 = {0.f, 0.f, 0.f, 0.f}, acc1 = acc0, acc2 = acc0;
      const float* hrow = H + l16 * H_LD + wid * 128 + lg4;
      const float* we = p.w_expert + (size_t)(wid * 128 + lg4) * 32 + l16;
      const float* wg = p.w_group + (size_t)(wid * 128 + lg4) * 4 + (l16 & 3);
#pragma unroll 8
      for (int s4 = 0; s4 < 32; ++s4) {
        const float a = hrow[s4 * 4];
        const float b0 = we[s4 * 128], b1 = we[s4 * 128 + 16];
        const float b2r = wg[s4 * 16];
        const float b2 = (l16 < 4) ? b2r : 0.f;
        acc0 = __builtin_amdgcn_mfma_f32_16x16x4f32(a, b0, acc0, 0, 0, 0);
        acc1 = __builtin_amdgcn_mfma_f32_16x16x4f32(a, b1, acc1, 0, 0, 0);
        acc2 = __builtin_amdgcn_mfma_f32_16x16x4f32(a, b2, acc2, 0, 0, 0);
      }
#pragma unroll
      for (int r = 0; r < 4; ++r) {
        float* pr = part + (wid * 16 + lg4 * 4 + r) * 48;
        pr[l16] = acc0[r]; pr[16 + l16] = acc1[r]; pr[32 + l16] = acc2[r];
      }
    }
    __syncthreads();
    for (int idx = t; idx < 16 * 36; idx += NTHR) {
      const int tok = idx / 36, o = idx % 36;
      float sacc = 0.f;
#pragma unroll
      for (int w = 0; w < 8; ++w) sacc += part[(w * 16 + tok) * 48 + o];
      sacc += (o < 32) ? p.b_expert[o] : p.b_group[o - 32];
      lgt[tok * 48 + o] = sacc;
    }
    __syncthreads();
    if (t < 16) {
      const float* l = lgt + t * 48;
      int gs = 0; float gm = l[32];
      for (int g = 1; g < 4; ++g) if (l[32 + g] > gm) { gm = l[32 + g]; gs = g; }
      float gsum = 0.f;
      for (int g = 0; g < 4; ++g) gsum += expf(l[32 + g] - gm);
      const float pgroup = 1.0f / gsum;
      const float* el = l + gs * 8;
      float em = el[0];
      for (int e = 1; e < 8; ++e) em = fmaxf(em, el[e]);
      float pe[8], esum = 0.f;
      for (int e = 0; e < 8; ++e) { pe[e] = expf(el[e] - em); esum += pe[e]; }
      for (int e = 0; e < 8; ++e) pe[e] /= esum;
      int i0 = 0;
      for (int e = 1; e < 8; ++e) if (pe[e] > pe[i0]) i0 = e;
      int i1 = (i0 == 0) ? 1 : 0;
      for (int e = 0; e < 8; ++e) if (e != i0 && pe[e] > pe[i1]) i1 = e;
      const float den = pe[i0] + pe[i1];
      const int tok = tile * 16 + t;
      const int e0 = gs * 8 + i0, e1 = gs * 8 + i1;
      ws_wa(p)[tok * 2] = pgroup * pe[i0] / den; ws_wa(p)[tok * 2 + 1] = pgroup * pe[i1] / den;
      const int slot = nloc * 32 + t * 2;
      sl_aid[slot] = tok * 2; sl_aid[slot + 1] = tok * 2 + 1;
      sl_e[slot] = e0 | (atomicAdd(ecnt + e0, 1) << 8); sl_e[slot + 1] = e1 | (atomicAdd(ecnt + e1, 1) << 8);
    }
    ++nloc;
  }
  __syncthreads();
  if (t < NEXP) ebase[t] = ecnt[t] ? atomicAdd(ws_cnt(p) + t, ecnt[t]) : 0;
  __syncthreads();
  for (int sidx = t; sidx < nloc * 32; sidx += NTHR) { const int ev = sl_e[sidx], e = ev & 255, r = ev >> 8; ws_list(p)[e * LCAP + ebase[e] + r] = sl_aid[sidx]; }
}
DI void phase7_tr(const Params& p, int bid, int nb, char* lds) {
  const int t = tid_();
  {
    float* tile = (float*)lds;
    const int ln4 = (t & 31) * 4, lkr = t >> 5, snr = t >> 2, skc = (t & 3) * 16;
#define MOE_TSRC(task_, src_, k0_, n0_, N_) const float* src_; int k0_, n0_, N_; { const int wh_ = (task_) >> 11, q_ = (task_) & 2047, e_ = q_ >> 6, r_ = q_ & 63; \
      if (wh_ < 2) { k0_ = (r_ >> 2) * 64; n0_ = (r_ & 3) * 128; N_ = 512; src_ = (wh_ == 0 ? p.e_gate : p.e_up) + (size_t)e_ * 1024 * 512; } \
      else { k0_ = (r_ >> 3) * 64; n0_ = (r_ & 7) * 128; N_ = 1024; src_ = p.e_down + (size_t)e_ * 512 * 1024; } }
    f32x4 g[4];
    int task = bid;
    if (task < 6144) { MOE_TSRC(task, src, k0, n0, N);
#pragma unroll
      for (int i = 0; i < 4; ++i) g[i] = *(const f32x4*)(src + (size_t)(k0 + lkr + 16 * i) * N + n0 + ln4); }
    for (; task < 6144; task += nb) {
      __syncthreads();
#pragma unroll
      for (int i = 0; i < 4; ++i) { float* d = tile + (lkr + 16 * i) * 129 + ln4; d[0] = g[i][0]; d[1] = g[i][1]; d[2] = g[i][2]; d[3] = g[i][3]; }
      if (task + nb < 6144) { MOE_TSRC(task + nb, src, k0, n0, N);
#pragma unroll
        for (int i = 0; i < 4; ++i) g[i] = *(const f32x4*)(src + (size_t)(k0 + lkr + 16 * i) * N + n0 + ln4); }
      __syncthreads();
      const int which = task >> 11, q = task & 2047, e = q >> 6, r = q & 63;
      float v[16];
#pragma unroll
      for (int j = 0; j < 16; ++j) v[j] = tile[(skc + j) * 129 + snr];
      u32x4 w0, w1;
      w0.x = cvtpk(v[0], v[1]); w0.y = cvtpk(v[2], v[3]); w0.z = cvtpk(v[4], v[5]); w0.w = cvtpk(v[6], v[7]);
      w1.x = cvtpk(v[8], v[9]); w1.y = cvtpk(v[10], v[11]); w1.z = cvtpk(v[12], v[13]); w1.w = cvtpk(v[14], v[15]);
      bf16_t* dst;
      if (which < 2) { const int k0 = (r >> 2) * 64, n = (r & 3) * 128 + snr; dst = ws_wgu(p) + (size_t)e * 1024 * 1024 + (size_t)((n >> 7) * 256 + (n & 127) + which * 128) * 1024 + k0 + skc; }
      else { const int k0 = (r >> 3) * 64, n = (r & 7) * 128 + snr; dst = ws_wd(p) + (size_t)e * 1024 * 512 + (size_t)n * 512 + k0 + skc; }
      *(u32x4*)dst = w0; *(u32x4*)(dst + 8) = w1;
    }
  }
}

struct Seg { int e, r0, cnt, start; };
DI Seg find_seg(const int* cnt, int mtile) {
  Seg s; s.e = -1; int acc = 0, start = 0;
  for (int e = 0; e < NEXP; ++e) { const int c = cnt[e], nt = (c + GBM - 1) / GBM; if (mtile < acc + nt) { s.e = e; s.r0 = (mtile - acc) * GBM; s.cnt = c; s.start = start; return s; } acc += nt; start += c; }
  return s;
}
struct ARowList { const int* list; int r0, cnt; DI int operator()(int r) const { int q = r0 + r; q = q < cnt ? q : cnt - 1; return list[q] >> 1; } };
struct EpiHid { bf16_t* o; int row0, nvalid, col0; DI void operator()(int r, int c, float g, float u) const {
  if (r < nvalid) o[(size_t)(row0 + r) * DEXP + ((col0 + c) >> 6) * 32 + (c & 31)] = f2bf(g / (1.0f + __expf(-g)) * u); } };
DI void phase8(const Params& p, int bid, int nb, char* lds) {
  const int* cnt = ws_cnt(p);
  for (int tile = bid; tile < 288 * 8; tile += nb) {
    const Seg s = find_seg(cnt, tile >> 3);
    if (s.e < 0) break;
    const int nt = tile & 7;
    gemm_tile(ws_h2(p), DM, ARowList{ws_list(p) + s.e * LCAP, s.r0, s.cnt}, ws_wgu(p) + (size_t)s.e * 1024 * 1024, DM, nt * GBN, DM,
              EpiHid{ws_hid(p), s.start + s.r0, s.cnt - s.r0, nt * GBN}, lds);
  }
}
struct ARowClamp { int base, r0, cnt; DI int operator()(int r) const { int q = r0 + r; q = q < cnt ? q : cnt - 1; return base + q; } };
struct EpiY { bf16_t* o; const int* list; const float* wa; int r0, cnt, col0; DI void operator()(int r, int c, float v0, float v1) const {
  if (r0 + r < cnt) { const int aid = list[r0 + r]; const float w = wa[aid]; bf16_t* q = o + (size_t)aid * DM + col0 + c; q[0] = f2bf(v0 * w); q[32] = f2bf(v1 * w); } } };
DI void phase9(const Params& p, int bid, int nb, char* lds) {
  const int* cnt = ws_cnt(p);
  for (int tile = bid; tile < 288 * 8; tile += nb) {
    const Seg s = find_seg(cnt, tile >> 3);
    if (s.e < 0) break;
    const int nt = tile & 7;
    gemm_tile(ws_hid(p), DEXP, ARowClamp{s.start, s.r0, s.cnt}, ws_wd(p) + (size_t)s.e * 1024 * 512, DEXP, nt * GBN, DEXP,
              EpiY{ws_ybuf(p), ws_list(p) + s.e * LCAP, ws_wa(p), s.r0, s.cnt, nt * GBN}, lds);
  }
}

DI void phase10(const Params& p, int bid, int nb, char* lds) {
  const int lane = tid_() & 63, wid = tid_() >> 6;
  const float* mod = ws_mod(p); const float* fm = ws_fmod(p);
  for (int gt = bid * 8 + wid; gt < NTOK; gt += nb * 8) {
    const int b = gt >> 11;
    const float* xr = ws_x1(p) + (size_t)gt * DM; float* xo = p.out + (size_t)gt * DM;
    const bf16_t* ya = ws_ybuf(p) + (size_t)(gt * 2) * DM; const bf16_t* yb = ya + DM;
    f32x4 v[4]; float ss = 0.f;
#pragma unroll
    for (int i = 0; i < 4; ++i) {
      const int col = lane * 4 + 256 * i;
      v[i] = *(const f32x4*)(xr + col);
      const u32x2 a = *(const u32x2*)(ya + col), bq = *(const u32x2*)(yb + col);
      const f32x4 g2 = *(const f32x4*)(mod + b * 6144 + 5120 + col);
      const float m0 = __uint_as_float(a.x << 16) + __uint_as_float(bq.x << 16), m1 = __uint_as_float(a.x & 0xffff0000u) + __uint_as_float(bq.x & 0xffff0000u);
      const float m2 = __uint_as_float(a.y << 16) + __uint_as_float(bq.y << 16), m3 = __uint_as_float(a.y & 0xffff0000u) + __uint_as_float(bq.y & 0xffff0000u);
      v[i][0] += (1.0f + g2[0]) * m0; v[i][1] += (1.0f + g2[1]) * m1; v[i][2] += (1.0f + g2[2]) * m2; v[i][3] += (1.0f + g2[3]) * m3;
      ss += v[i][0] * v[i][0] + v[i][1] * v[i][1] + v[i][2] * v[i][2] + v[i][3] * v[i][3];
    }
    ss = wave_sum(ss);
    const float rstd = rsqrtf(ss * (1.0f / DM) + 1e-6f);
#pragma unroll
    for (int i = 0; i < 4; ++i) {
      const int col = lane * 4 + 256 * i;
      const f32x4 g = *(const f32x4*)(p.final_norm_g + col), sh = *(const f32x4*)(fm + b * 2048 + col), sc = *(const f32x4*)(fm + b * 2048 + 1024 + col);
      f32x4 o;
#pragma unroll
      for (int j = 0; j < 4; ++j) o[j] = v[i][j] * rstd * g[j] * (1.0f + sc[j]) + sh[j];
      *(f32x4*)(xo + col) = o;
    }
  }
}

#define XB_TMO      128
#define XB_XCNT(j)  (256  + 64 * (j))
#define XB_XSUB(j)  (1280 + 64 * (j))
#define XB_XGEN(j)  (2304 + 64 * (j))
#define XB_TOP      3328
#define XB_TOPGEN   3392
#define XCD_BAR_WORDS 3456
#define XB_SPIN_CAP (1u << 18)
#define XLAS __attribute__((address_space(3)))

__device__ __forceinline__ unsigned xb_ld(unsigned* p)              { return __hip_atomic_load(p, __ATOMIC_RELAXED, __HIP_MEMORY_SCOPE_AGENT); }
__device__ __forceinline__ unsigned xb_add(unsigned* p, unsigned v) { return __hip_atomic_fetch_add(p, v, __ATOMIC_RELAXED, __HIP_MEMORY_SCOPE_AGENT); }
__device__ __forceinline__ unsigned xb_xcc_id() { return (unsigned)__builtin_amdgcn_s_getreg((3 << 11) | 20) & 0xFu; }
#define XB_SPIN(cond, bar) do { unsigned _sp = 0; while (cond) { __builtin_amdgcn_s_sleep(1); \
    if ((++_sp & 255u) == 0u) { if (xb_ld(&(bar)[XB_TMO])) break; if (_sp > XB_SPIN_CAP) { atomicAdd(&(bar)[XB_TMO], 1u); break; } } } } while (0)

struct XcdBarrier {
    unsigned* bar; unsigned x;
    volatile XLAS unsigned* st;
};

__device__ __forceinline__ XcdBarrier xcd_barrier_post(unsigned* bar, volatile XLAS unsigned* st) {
    XcdBarrier b; b.bar = bar; b.x = xb_xcc_id(); b.st = st;
    if (threadIdx.x == 0) (void)xb_add(&bar[XB_XCNT(b.x)], 1u);
    return b;
}
__device__ __forceinline__ void xcd_barrier_complete(unsigned* bar, unsigned x, unsigned& nloc, unsigned& nx) {
    const unsigned G = gridDim.x * gridDim.y * gridDim.z;
    unsigned sum, cnt, mine, sp = 0u;
    for (;;) {
        sum = 0u; cnt = 0u; mine = 0u;
#pragma unroll
        for (unsigned j = 0; j < 16; ++j) { const unsigned c = xb_ld(&bar[XB_XCNT(j)]); sum += c; cnt += (c > 0u) ? 1u : 0u; mine = (j == x) ? c : mine; }
        if (sum == G) break;
        __builtin_amdgcn_s_sleep(1);
        if ((++sp & 255u) == 0u) { if (xb_ld(&bar[XB_TMO])) break; if (sp > XB_SPIN_CAP) { atomicAdd(&bar[XB_TMO], 1u); break; } }
    }
    nloc = mine > 0u ? mine : 1u; nx = cnt > 0u ? cnt : 1u;
}

__device__ __forceinline__ void xcd_barrier(const XcdBarrier& b) {
    asm volatile("s_waitcnt vmcnt(0)" ::: "memory");
    __syncthreads();
    if (threadIdx.x == 0) {
        unsigned* bar = b.bar;
        __builtin_amdgcn_s_waitcnt(0);
        unsigned nloc = b.st[0], nx = b.st[1];
        if (nloc == 0u) { xcd_barrier_complete(bar, b.x, nloc, nx); b.st[0] = nloc; b.st[1] = nx; }
        const unsigned old = xb_add(&bar[XB_XSUB(b.x)], 1u);
        const unsigned gen = old / nloc;
        if (old + 1u == (gen + 1u) * nloc) {
            __builtin_amdgcn_fence(__ATOMIC_RELEASE, "agent");
            asm volatile("s_waitcnt vmcnt(0)" ::: "memory");
            const unsigned og = xb_add(&bar[XB_TOP], 1u);
            const unsigned tg = og / nx;
            if (og + 1u == (tg + 1u) * nx) xb_add(&bar[XB_TOPGEN], 1u);
            else XB_SPIN(xb_ld(&bar[XB_TOPGEN]) == tg, bar);
            __builtin_amdgcn_fence(__ATOMIC_ACQUIRE, "agent");
            xb_add(&bar[XB_XGEN(b.x)], 1u);
            asm volatile("s_waitcnt vmcnt(0)" ::: "memory");
        } else {
            XB_SPIN(xb_ld(&bar[XB_XGEN(b.x)]) == gen, bar);
            __builtin_amdgcn_fence(__ATOMIC_ACQUIRE, "agent");
            asm volatile("s_waitcnt vmcnt(0)" ::: "memory");
        }
    }
    __syncthreads();
}

#if MEGA
__global__ void __launch_bounds__(NTHR) k_mega(Params p) {
  extern __shared__ __attribute__((aligned(16))) char smem[];
  cg::grid_group grid = cg::this_grid();
  const int bid = blockIdx.x, nb = gridDim.x;
  volatile XLAS unsigned* xst = (volatile XLAS unsigned*)(XLAS char*)(smem + LDS_BYTES - 64);
  if (threadIdx.x < 4) xst[threadIdx.x] = 0u;
  if (bid == 0) for (int i = threadIdx.x; i < XCD_BAR_WORDS; i += NTHR) ws_bar(p)[i] = 0u;
  phase0(p, bid, nb, smem);
  grid.sync();
  XcdBarrier xb = xcd_barrier_post(ws_bar(p), xst);
#define SEAM() xcd_barrier(xb)
  phase1(p, bid, nb, smem); SEAM();
  phase2_pg8(p, bid, nb, smem); SEAM();
  phase3_mfma<3>(p, bid, nb, smem); SEAM();
  phase4a_chunk(p, bid, nb, smem); phase4b_mfma(p, bid, nb, smem); SEAM();
  phase5a(p, bid, nb, smem); phase5b_mfma(p, bid, nb, smem); SEAM();
  phase6_pg8(p, bid, nb, smem); SEAM();
  phase7(p, bid, nb, smem); SEAM();
  phase8_pg8(p, bid, nb, smem); SEAM();
  phase9_pg8(p, bid, nb, smem); SEAM();
  phase10(p, bid, nb, smem);
}
#else
#define PHASE_KERNEL(name, body) __global__ void __launch_bounds__(NTHR) name(Params p) { extern __shared__ __attribute__((aligned(16))) char smem[]; body(p, blockIdx.x, gridDim.x, smem); }
PHASE_KERNEL(k_phase0, phase0)
PHASE_KERNEL(k_phase1, phase1)
PHASE_KERNEL(k_phase2, phase2)
PHASE_KERNEL(k_phase3a, phase3a)
PHASE_KERNEL(k_phase3b, phase3b)
PHASE_KERNEL(k_phase4a, phase4a)
PHASE_KERNEL(k_phase4a2, phase4a_v2)
PHASE_KERNEL(k_phase4a3, phase4a_v3)
PHASE_KERNEL(k_phase4b, phase4b)
PHASE_KERNEL(k_phase4bm, phase4b_mfma)
PHASE_KERNEL(k_phase3m, phase3_mfma<3>)
PHASE_KERNEL(k_phase5a, phase5a)
PHASE_KERNEL(k_phase5b, phase5b)
PHASE_KERNEL(k_phase5bm, phase5b_mfma)
PHASE_KERNEL(k_phase6, phase6)
PHASE_KERNEL(k_phase7, phase7)
PHASE_KERNEL(k_phase8, phase8)
PHASE_KERNEL(k_phase9, phase9)
PHASE_KERNEL(k_phase10, phase10)
#endif

extern "C" void kernel_launch(void* const* d_in, const int* in_sizes, int n_in, void* d_out, int out_size, void* d_ws, size_t ws_size, hipStream_t stream) {
  Params p{};
  const float** f = (const float**)&p;
  for (int i = 0; i < 33; ++i) f[i] = (const float*)d_in[i];
  p.out = (float*)d_out; p.ws = (char*)d_ws;
  if (n_in != 33 || ws_size < (size_t)(OFF_S + 9 * MiB) || out_size != NTOK * DM) { fprintf(stderr, "kernel_launch: unexpected problem shape or workspace (n_in %d, ws %zu, out %d)\n", n_in, ws_size, out_size); return; }
#if MEGA
  static int grid_blocks = 0;
  if (!grid_blocks) {
    int dev = 0, cus = 0, per_cu = 0;
    hipGetDevice(&dev);
    hipDeviceGetAttribute(&cus, hipDeviceAttributeMultiprocessorCount, dev);
    hipFuncSetAttribute((const void*)k_mega, hipFuncAttributeMaxDynamicSharedMemorySize, LDS_BYTES);
    hipOccupancyMaxActiveBlocksPerMultiprocessor(&per_cu, k_mega, NTHR, LDS_BYTES);
    if (per_cu > 1) per_cu = 1;
    grid_blocks = cus * per_cu;
  }
  void* args[] = {&p};
  hipError_t e = hipLaunchCooperativeKernel((void*)k_mega, dim3(grid_blocks), dim3(NTHR), args, LDS_BYTES, stream);
  if (e != hipSuccess) fprintf(stderr, "cooperative launch failed: %s (grid %d)\n", hipGetErrorString(e), grid_blocks);
#else
  const int G = 512;
#define LAUNCH(k, g) hipLaunchKernelGGL(k, dim3(g), dim3(NTHR), LDS_BYTES, stream, p)
  LAUNCH(k_phase0, G);
  LAUNCH(k_phase1, G);
  LAUNCH(k_phase2, G);
  LAUNCH(k_phase3a, G);
  LAUNCH(k_phase3b, G);
  LAUNCH(k_phase4a, 128);
  LAUNCH(k_phase4b, 1024);
  LAUNCH(k_phase5a, G);
  LAUNCH(k_phase5b, 1024);
  LAUNCH(k_phase6, G);
  LAUNCH(k_phase7, G);
  LAUNCH(k_phase8, G);
  LAUNCH(k_phase9, G);
  LAUNCH(k_phase10, G);
#endif
}
```

```cpp
#include <hip/hip_runtime.h>
#include <hip/hip_cooperative_groups.h>
#include <stdint.h>
#include <stdio.h>

namespace cg = cooperative_groups;

#ifndef MEGA
#define MEGA 1
#endif

typedef unsigned short bf16_t;
typedef short bf16x8 __attribute__((ext_vector_type(8)));
typedef float f32x16 __attribute__((ext_vector_type(16)));
typedef float f32x4 __attribute__((ext_vector_type(4)));
typedef float f32x4v __attribute__((ext_vector_type(4)));
typedef unsigned u32x4 __attribute__((ext_vector_type(4)));
typedef unsigned u32x2 __attribute__((ext_vector_type(2)));

#define DI __device__ __forceinline__

constexpr int DM = 1024, BATCH = 16, SEQ = 2048, NTOK = BATCH * SEQ;
constexpr int RW = 512, NH = 8, HD = 64;
constexpr int PROJ_N = 2756, PROJ_LD = 2816;
constexpr int C_R = 0, C_K = 512, C_V = 1024, C_WL = 1536, C_AL = 1600, C_GL = 1664;
constexpr int C_Q = 1792, C_CKV = 2304, C_QI = 2432, C_KI = 2688, C_WI = 2752;
constexpr int NEXP = 32, DEXP = 512, LCAP = 32768;
constexpr int NTHR = 512;
constexpr int LDS_BYTES = 163840;

constexpr size_t MiB = 1048576;
constexpr size_t OFF_A = 0;
constexpr size_t OFF_B = 64 * MiB;
constexpr size_t OFF_C = 240 * MiB;
constexpr size_t OFF_F = 400 * MiB;
constexpr size_t OFF_G = 464 * MiB;
constexpr size_t OFF_W = 484 * MiB;
constexpr size_t OFF_S = 492 * MiB;

struct Params {
  const float *x, *c, *ada_w, *ada_b, *norm1_g, *w_in, *shift_mu, *w0, *w_decay_up, *a0, *w_aaa_up, *w_gate_up;
  const float *k_k, *k_a, *r_k, *gn_g, *gn_b, *kv_norm_g, *k_idx_norm_g, *w_uk, *w_uv, *w_out, *norm2_g;
  const float *w_group, *b_group, *w_expert, *b_expert, *e_gate, *e_up, *e_down, *final_ada_w, *final_ada_b, *final_norm_g;
  float* out;
  char* ws;
};

DI int tid_() { int t = threadIdx.x; asm volatile("" : "+v"(t)); return t; }
DI float bf2f(bf16_t u) { return __uint_as_float(((unsigned)u) << 16); }
DI bf16_t f2bf(float f) { unsigned u = __float_as_uint(f); u += 0x7fffu + ((u >> 16) & 1u); return (bf16_t)(u >> 16); }
DI unsigned pack2(float lo, float hi) { return (unsigned)f2bf(lo) | ((unsigned)f2bf(hi) << 16); }
DI float wave_sum(float v) { for (int o = 32; o; o >>= 1) v += __shfl_xor(v, o); return v; }
DI float wave_max(float v) { for (int o = 32; o; o >>= 1) v = fmaxf(v, __shfl_xor(v, o)); return v; }
DI float sigmoidf_(float v) { return 1.0f / (1.0f + __expf(-v)); }
DI int crow(int r, int hi) { return (r & 3) + 8 * (r >> 2) + 4 * hi; }
DI unsigned cvtpk(float lo, float hi) { unsigned r; asm volatile("v_cvt_pk_bf16_f32 %0, %1, %2" : "=v"(r) : "v"(lo), "v"(hi)); return r; }

DI void unpack8(const u32x4 w, float* o) {
  o[0] = __uint_as_float(w.x << 16); o[1] = __uint_as_float(w.x & 0xffff0000u); o[2] = __uint_as_float(w.y << 16); o[3] = __uint_as_float(w.y & 0xffff0000u);
  o[4] = __uint_as_float(w.z << 16); o[5] = __uint_as_float(w.z & 0xffff0000u); o[6] = __uint_as_float(w.w << 16); o[7] = __uint_as_float(w.w & 0xffff0000u);
}
DI void load8(const bf16_t* p, float* o) { unpack8(*(const u32x4*)p, o); }

DI bf16_t* ws_h1(const Params& p) { return (bf16_t*)(p.ws + OFF_A); }
DI float* ws_y(const Params& p) { return (float*)(p.ws + OFF_A); }
DI bf16_t* ws_h2(const Params& p) { return (bf16_t*)(p.ws + OFF_A); }
DI bf16_t* ws_proj(const Params& p) { return (bf16_t*)(p.ws + OFF_B); }
DI float* ws_x1(const Params& p) { return (float*)(p.ws + OFF_B); }
DI bf16_t* ws_wgu(const Params& p) { return (bf16_t*)p.out; }
DI bf16_t* ws_wd(const Params& p) { return (bf16_t*)((char*)p.out + 64 * MiB); }
DI bf16_t* ws_hid(const Params& p) { return (bf16_t*)(p.ws + OFF_B + 96 * MiB); }
DI bf16_t* ws_kp(const Params& p) { return (bf16_t*)(p.ws + OFF_C); }
DI bf16_t* ws_kk(const Params& p) { return (bf16_t*)(p.ws + OFF_C + 32 * MiB); }
DI bf16_t* ws_bb(const Params& p) { return (bf16_t*)(p.ws + OFF_C + 64 * MiB); }
DI bf16_t* ws_ee(const Params& p) { return (bf16_t*)(p.ws + OFF_C + 96 * MiB); }
DI bf16_t* ws_gg(const Params& p) { return (bf16_t*)(p.ws + OFF_C + 128 * MiB); }
DI bf16_t* ws_mix(const Params& p) { return (bf16_t*)(p.ws + OFF_C); }
DI bf16_t* ws_ybuf(const Params& p) { return (bf16_t*)(p.ws + OFF_C); }
DI bf16_t* ws_qlat(const Params& p) { return (bf16_t*)(p.ws + OFF_F); }
DI bf16_t* ws_ckv(const Params& p) { return (bf16_t*)(p.ws + OFF_G); }
DI bf16_t* ws_kidx(const Params& p) { return (bf16_t*)(p.ws + OFF_G + 8 * MiB); }
DI unsigned* ws_mask(const Params& p) { return (unsigned*)(p.ws + OFF_G + 12 * MiB); }
DI bf16_t* ws_wtin(const Params& p) { return (bf16_t*)(p.ws + OFF_W); }
DI bf16_t* ws_wtout(const Params& p) { return (bf16_t*)(p.ws + OFF_W + 6 * MiB); }
DI bf16_t* ws_wuvt(const Params& p) { return (bf16_t*)(p.ws + OFF_S + 7 * MiB); }
DI bf16_t* ws_wdt(const Params& p) { return (bf16_t*)(p.ws + OFF_S + 8 * MiB + 64 * 1024); }
DI bf16_t* ws_wat(const Params& p) { return (bf16_t*)(p.ws + OFF_S + 8 * MiB + 128 * 1024); }
DI bf16_t* ws_wgt(const Params& p) { return (bf16_t*)(p.ws + OFF_S + 8 * MiB + 192 * 1024); }
DI bf16_t* ws_wukt(const Params& p) { return (bf16_t*)(p.ws + OFF_S + 8 * MiB + 320 * 1024); }
DI unsigned* ws_bar(const Params& p) { return (unsigned*)(p.ws + OFF_S + 8 * MiB); }
DI float* ws_mod(const Params& p) { return (float*)(p.ws + OFF_S); }
DI float* ws_fmod(const Params& p) { return (float*)(p.ws + OFF_S + 512 * 1024); }
DI float* ws_bonus(const Params& p) { return (float*)(p.ws + OFF_S + 1 * MiB); }
DI int* ws_cnt(const Params& p) { return (int*)(p.ws + OFF_S + 2 * MiB); }
DI float* ws_wa(const Params& p) { return (float*)(p.ws + OFF_S + 2 * MiB + 4096); }
DI int* ws_list(const Params& p) { return (int*)(p.ws + OFF_S + 3 * MiB); }

template <class RowMap>
DI void transpose_tile(const float* src, int N, int k0, int n0, bf16_t* dst, int dstld, RowMap rm, char* lds) {
  float* tile = (float*)lds;
  const int t = tid_();
  __syncthreads();
  {
    const int nc = t & 63, krb = t >> 6;
#pragma unroll
    for (int i = 0; i < 8; ++i) {
      const int kr = krb + 8 * i;
      const int n = n0 + nc;
      tile[kr * 65 + nc] = (n < N) ? src[(size_t)(k0 + kr) * N + n] : 0.f;
    }
  }
  __syncthreads();
  {
    const int nr = t >> 3, kc = (t & 7) * 8;
    u32x4 w;
    w.x = pack2(tile[(kc + 0) * 65 + nr], tile[(kc + 1) * 65 + nr]);
    w.y = pack2(tile[(kc + 2) * 65 + nr], tile[(kc + 3) * 65 + nr]);
    w.z = pack2(tile[(kc + 4) * 65 + nr], tile[(kc + 5) * 65 + nr]);
    w.w = pack2(tile[(kc + 6) * 65 + nr], tile[(kc + 7) * 65 + nr]);
    *(u32x4*)(dst + (size_t)rm(n0 + nr) * dstld + k0 + kc) = w;
  }
}
struct RowId { DI int operator()(int n) const { return n; } };
struct RowGU { int add; DI int operator()(int n) const { return (n >> 7) * 256 + (n & 127) + add; } };

DI void phase0(const Params& p, int bid, int nb, char* lds) {
  const int t = tid_();
  if (bid == 0 && t < NEXP) ws_cnt(p)[t] = 0;
  for (int idx = bid * NTHR + t; idx < 8 * 64 * 128; idx += nb * NTHR) {
    const int e8 = idx & 7, ln = (idx >> 3) & 63, l32 = ln & 31, lh = ln >> 5;
    { const int hh = idx >> 13, i2 = (idx >> 12) & 1, ks = (idx >> 9) & 7, d = i2 * 32 + l32, cc = ks * 16 + lh * 8 + e8;
      ws_wuvt(p)[idx] = f2bf(p.w_uv[(size_t)(cc * NH + hh) * HD + d]); }
    { const int h2 = idx >> 13, mt = (idx >> 11) & 3, ks = (idx >> 9) & 3, c2 = mt * 32 + l32, d2 = ks * 16 + lh * 8 + e8;
      ws_wukt(p)[idx] = f2bf(p.w_uk[(size_t)(c2 * NH + h2) * HD + d2]); }
  }
  for (int task = bid; task < 32; task += nb) {
    if (task < 8) transpose_tile(p.w_decay_up, RW, 0, task * 64, ws_wdt(p), 64, RowId(), lds);
    else if (task < 16) transpose_tile(p.w_aaa_up, RW, 0, (task - 8) * 64, ws_wat(p), 64, RowId(), lds);
    else { const int q = task - 16; transpose_tile(p.w_gate_up, RW, (q >> 3) * 64, (q & 7) * 64, ws_wgt(p), 128, RowId(), lds); }
  }
  for (int task = bid; task < 256; task += nb) {
    float* cact = (float*)lds;
    __syncthreads();
    for (int i = t; i < 16 * 1024; i += NTHR) { const float v = p.c[i]; cact[i] = v / (1.0f + __expf(-v)); }
    __syncthreads();
    const int col = task * 32 + (t & 31), ks = t >> 5;
    const float* w; int ld, cc;
    if (col < 6144) { w = p.ada_w; ld = 6144; cc = col; } else { w = p.final_ada_w; ld = 2048; cc = col - 6144; }
    float acc[16];
#pragma unroll
    for (int b = 0; b < 16; ++b) acc[b] = 0.f;
    for (int kk = 0; kk < 64; ++kk) {
      const int k = ks * 64 + kk;
      const float wv = w[(size_t)k * ld + cc];
#pragma unroll
      for (int b = 0; b < 16; ++b) acc[b] += cact[b * 1024 + k] * wv;
    }
    __syncthreads();
    float* red = (float*)lds;
#pragma unroll
    for (int b = 0; b < 16; ++b) red[(ks * 16 + b) * 32 + (t & 31)] = acc[b];
    __syncthreads();
    {
      const int b = t >> 5, cl = t & 31, colo = task * 32 + cl;
      float s = 0.f;
      for (int k2 = 0; k2 < 16; ++k2) s += red[(k2 * 16 + b) * 32 + cl];
      if (colo < 6144) ws_mod(p)[b * 6144 + colo] = s + p.ada_b[colo];
      else ws_fmod(p)[b * 2048 + colo - 6144] = s + p.final_ada_b[colo - 6144];
    }
  }
  for (int task = bid; task < 704 + 256; task += nb) {
    if (task < 704) { const int kt = task / 44, nt = task % 44; transpose_tile(p.w_in, PROJ_N, kt * 64, nt * 64, ws_wtin(p), 1024, RowId(), lds); }
    else { const int q = task - 704, kt = q >> 4, nt = q & 15; transpose_tile(p.w_out, 1024, kt * 64, nt * 64, ws_wtout(p), 1024, RowId(), lds); }
  }
}

DI void phase1(const Params& p, int bid, int nb, char* lds) {
  const int lane = tid_() & 63, wid = tid_() >> 6;
  const float* mod = ws_mod(p);
  for (int row = bid * 8 + wid; row < NTOK; row += nb * 8) {
    const int b = row >> 11;
    const float* xr = p.x + (size_t)row * DM;
    f32x4 v[4]; float ss = 0.f;
#pragma unroll
    for (int i = 0; i < 4; ++i) { v[i] = *(const f32x4*)(xr + lane * 4 + 256 * i); ss += v[i][0] * v[i][0] + v[i][1] * v[i][1] + v[i][2] * v[i][2] + v[i][3] * v[i][3]; }
    ss = wave_sum(ss);
    const float rstd = rsqrtf(ss * (1.0f / DM) + 1e-6f);
#pragma unroll
    for (int i = 0; i < 4; ++i) {
      const int col = lane * 4 + 256 * i;
      const f32x4 g = *(const f32x4*)(p.norm1_g + col), sh = *(const f32x4*)(mod + b * 6144 + col), sc = *(const f32x4*)(mod + b * 6144 + 1024 + col);
      float o[4];
#pragma unroll
      for (int j = 0; j < 4; ++j) o[j] = v[i][j] * rstd * g[j] * (1.0f + sc[j]) + sh[j];
      u32x2 w; w.x = pack2(o[0], o[1]); w.y = pack2(o[2], o[3]);
      *(u32x2*)(ws_h1(p) + (size_t)row * DM + col) = w;
    }
  }
}

constexpr int GBM = 256, GBN = 128, GBK = 32, GROW = 80, G_LDSA = GBM * GROW, G_STAGE = (GBM + GBN) * GROW;
template <class ARow, class Epi>
DI void gemm_tile(const bf16_t* A, int lda, ARow arow, const bf16_t* Bt, int ldb, int n0, int K, Epi epi, char* lds) {
  const int t = tid_(), lane = t & 63, wid = t >> 6, wm = wid >> 1, wn = wid & 1, r32 = lane & 31, hi = lane >> 5;
  const int srow = t >> 2, sch = t & 3;
  const bf16_t* a0p = A + (size_t)arow(srow) * lda + sch * 8;
  const bf16_t* a1p = A + (size_t)arow(srow + 128) * lda + sch * 8;
  const bf16_t* bp = Bt + (size_t)(n0 + srow) * ldb + sch * 8;
  const int wa0 = srow * GROW + sch * 16, wa1 = (srow + 128) * GROW + sch * 16, wb = G_LDSA + srow * GROW + sch * 16;
  const int ra = (wm * 64 + r32) * GROW + hi * 16, rb = G_LDSA + (wn * 64 + r32) * GROW + hi * 16;
  f32x16 acc[2][2];
#pragma unroll
  for (int i = 0; i < 2; ++i)
#pragma unroll
    for (int j = 0; j < 2; ++j)
#pragma unroll
      for (int r = 0; r < 16; ++r) acc[i][j][r] = 0.f;
  u32x4 ga0 = *(const u32x4*)a0p, ga1 = *(const u32x4*)a1p, gb = *(const u32x4*)bp;
  __syncthreads();
  *(u32x4*)(lds + wa0) = ga0; *(u32x4*)(lds + wa1) = ga1; *(u32x4*)(lds + wb) = gb;
  __syncthreads();
  const int nk = K / GBK;
  for (int kt = 0; kt < nk; ++kt) {
    char* cur = lds + (kt & 1) * G_STAGE;
    char* nxt = lds + ((kt + 1) & 1) * G_STAGE;
    if (kt + 1 < nk) { ga0 = *(const u32x4*)(a0p + (kt + 1) * GBK); ga1 = *(const u32x4*)(a1p + (kt + 1) * GBK); gb = *(const u32x4*)(bp + (kt + 1) * GBK); }
#pragma unroll
    for (int ks = 0; ks < 2; ++ks) {
      bf16x8 a[2], b[2];
#pragma unroll
      for (int i = 0; i < 2; ++i) { a[i] = *(const bf16x8*)(cur + ra + i * 32 * GROW + ks * 32); b[i] = *(const bf16x8*)(cur + rb + i * 32 * GROW + ks * 32); }
#pragma unroll
      for (int i = 0; i < 2; ++i)
#pragma unroll
        for (int j = 0; j < 2; ++j) acc[i][j] = __builtin_amdgcn_mfma_f32_32x32x16_bf16(a[i], b[j], acc[i][j], 0, 0, 0);
    }
    if (kt + 1 < nk) { *(u32x4*)(nxt + wa0) = ga0; *(u32x4*)(nxt + wa1) = ga1; *(u32x4*)(nxt + wb) = gb; }
    __syncthreads();
  }
#pragma unroll
  for (int i = 0; i < 2; ++i)
#pragma unroll
    for (int r = 0; r < 16; ++r) epi(wm * 64 + i * 32 + crow(r, hi), wn * 64 + r32, acc[i][0][r], acc[i][1][r]);
}

struct ARowBase { int base; DI int operator()(int r) const { return base + r; } };

struct EpiProj { bf16_t* o; int row0, col0; DI void operator()(int r, int c, float v0, float v1) const {
  bf16_t* q = o + (size_t)(row0 + r) * PROJ_LD + col0 + c; q[0] = f2bf(v0); q[32] = f2bf(v1); } };
DI void phase2(const Params& p, int bid, int nb, char* lds) {
  constexpr int NT = PROJ_LD / GBN;
  for (int tile = bid; tile < (NTOK / GBM) * NT; tile += nb) {
    const int mt = tile / NT, nt = tile % NT;
    gemm_tile(ws_h1(p), DM, ARowBase{mt * GBM}, ws_wtin(p), DM, nt * GBN, DM, EpiProj{ws_proj(p), mt * GBM, nt * GBN}, lds);
  }
}

DI float proj_shift(const bf16_t* proj, const float* mu, int gt, int col) {
  const float pv = bf2f(proj[(size_t)gt * PROJ_LD + col]);
  const float pp = (gt & (SEQ - 1)) ? bf2f(proj[(size_t)(gt - 1) * PROJ_LD + col]) : 0.f;
  return pv + mu[col] * (pp - pv);
}
DI void phase3a(const Params& p, int bid, int nb, char* lds) {
  const int t = tid_(), lane = t & 63, wid = t >> 6;
  float* xl = (float*)lds;
  const bf16_t* proj = ws_proj(p);
  for (int tile = bid; tile < NTOK / 16; tile += nb) {
    const int t0 = tile * 16;
    __syncthreads();
    for (int idx = t; idx < 16 * 256; idx += NTHR) {
      const int tok = idx >> 8, col = idx & 255;
      float v = proj_shift(proj, p.shift_mu, t0 + tok, C_WL + col);
      if (col < 64) v = tanhf(v); else if (col >= 128) v = sigmoidf_(v);
      xl[idx] = v;
    }
    __syncthreads();
    const int c = t;
    float acc[16];
#pragma unroll
    for (int i = 0; i < 16; ++i) acc[i] = 0.f;
    for (int k4 = 0; k4 < 16; ++k4) {
      float w[4];
#pragma unroll
      for (int j = 0; j < 4; ++j) w[j] = p.w_decay_up[(k4 * 4 + j) * RW + c];
#pragma unroll
      for (int i = 0; i < 16; ++i) { const f32x4 xv = *(const f32x4*)(xl + i * 256 + k4 * 4); acc[i] += xv[0] * w[0] + xv[1] * w[1] + xv[2] * w[2] + xv[3] * w[3]; }
    }
    {
      const float w0c = p.w0[c];
#pragma unroll
      for (int i = 0; i < 16; ++i) {
        const float z = -(w0c + acc[i]);
        const float sp = fmaxf(z, 0.f) + log1pf(__expf(-fabsf(z)));
        ws_ee(p)[(size_t)(t0 + i) * RW + c] = f2bf(__expf(-sp - 0.5f));
      }
    }
#pragma unroll
    for (int i = 0; i < 16; ++i) acc[i] = 0.f;
    for (int k4 = 0; k4 < 32; ++k4) {
      float w[4];
#pragma unroll
      for (int j = 0; j < 4; ++j) w[j] = p.w_gate_up[(k4 * 4 + j) * RW + c];
#pragma unroll
      for (int i = 0; i < 16; ++i) { const f32x4 xv = *(const f32x4*)(xl + i * 256 + 128 + k4 * 4); acc[i] += xv[0] * w[0] + xv[1] * w[1] + xv[2] * w[2] + xv[3] * w[3]; }
    }
#pragma unroll
    for (int i = 0; i < 16; ++i) ws_gg(p)[(size_t)(t0 + i) * RW + c] = f2bf(acc[i]);
#pragma unroll
    for (int i = 0; i < 16; ++i) acc[i] = 0.f;
    for (int k4 = 0; k4 < 16; ++k4) {
      float w[4];
#pragma unroll
      for (int j = 0; j < 4; ++j) w[j] = p.w_aaa_up[(k4 * 4 + j) * RW + c];
#pragma unroll
      for (int i = 0; i < 16; ++i) { const f32x4 xv = *(const f32x4*)(xl + i * 256 + 64 + k4 * 4); acc[i] += xv[0] * w[0] + xv[1] * w[1] + xv[2] * w[2] + xv[3] * w[3]; }
    }
    {
      const float a0c = p.a0[c], kkc = p.k_k[c], kac = p.k_a[c], rkc = p.r_k[c];
#pragma unroll
      for (int i = 0; i < 16; ++i) {
        const int gt = t0 + i;
        const float a = sigmoidf_(a0c + acc[i]);
        const float r = proj_shift(proj, p.shift_mu, gt, C_R + c);
        const float k = proj_shift(proj, p.shift_mu, gt, C_K + c);
        float kk = k * kkc;
        const float nrm = fmaxf(sqrtf(wave_sum(kk * kk)), 1e-12f);
        kk = kk / nrm;
        const float kp = k * (1.0f + (a - 1.0f) * kac);
        const float bs = wave_sum(r * kp * rkc);
        ws_kp(p)[(size_t)gt * RW + c] = f2bf(kp);
        ws_kk(p)[(size_t)gt * RW + c] = f2bf(kk);
        ws_bb(p)[(size_t)gt * RW + c] = f2bf(kk * a);
        if (lane == 0) ws_bonus(p)[gt * NH + wid] = bs;
      }
    }
  }
}

DI void phase3b(const Params& p, int bid, int nb, char* lds) {
  const int t = tid_(), lane = t & 63, wid = t >> 6;
  float* ql = (float*)lds;
  const bf16_t* proj = ws_proj(p);
  for (int tile = bid; tile < NTOK / 16; tile += nb) {
    const int t0 = tile * 16;
    __syncthreads();
    for (int idx = t; idx < 16 * 512; idx += NTHR) ql[idx] = bf2f(proj[(size_t)(t0 + (idx >> 9)) * PROJ_LD + C_Q + (idx & 511)]);
#pragma unroll
    for (int q = 0; q < 2; ++q) {
      const int gt = t0 + wid * 2 + q;
      const float v0 = bf2f(proj[(size_t)gt * PROJ_LD + C_CKV + lane * 2]), v1 = bf2f(proj[(size_t)gt * PROJ_LD + C_CKV + lane * 2 + 1]);
      const float rs = rsqrtf(wave_sum(v0 * v0 + v1 * v1) * (1.0f / 128.0f) + 1e-6f);
      *(unsigned*)(ws_ckv(p) + (size_t)gt * 128 + lane * 2) = pack2(v0 * rs * p.kv_norm_g[lane * 2], v1 * rs * p.kv_norm_g[lane * 2 + 1]);
      const float u = bf2f(proj[(size_t)gt * PROJ_LD + C_KI + lane]);
      const float rs2 = rsqrtf(wave_sum(u * u) * (1.0f / 64.0f) + 1e-6f);
      ws_kidx(p)[(size_t)gt * 64 + lane] = f2bf(u * rs2 * p.k_idx_norm_g[lane]);
    }
    __syncthreads();
    const int h = wid;
#pragma unroll 1
    for (int ps = 0; ps < 2; ++ps) {
      const int cidx = lane + 64 * ps;
      float w[64];
      const float* wp = p.w_uk + (size_t)(cidx * NH + h) * HD;
#pragma unroll
      for (int d4 = 0; d4 < 16; ++d4) { const f32x4 wv = *(const f32x4*)(wp + d4 * 4); w[d4 * 4] = wv[0]; w[d4 * 4 + 1] = wv[1]; w[d4 * 4 + 2] = wv[2]; w[d4 * 4 + 3] = wv[3]; }
#pragma unroll 1
      for (int i = 0; i < 16; ++i) {
        float acc = 0.f;
#pragma unroll
        for (int d4 = 0; d4 < 16; ++d4) { const f32x4 qv = *(const f32x4*)(ql + i * 512 + h * 64 + d4 * 4); acc += qv[0] * w[d4 * 4] + qv[1] * w[d4 * 4 + 1] + qv[2] * w[d4 * 4 + 2] + qv[3] * w[d4 * 4 + 3]; }
        ws_qlat(p)[((size_t)(t0 + i) * NH + h) * 128 + cidx] = f2bf(acc * 0.125f);
      }
    }
  }
}

DI float xhalf_sum(float v) { auto rr = __builtin_amdgcn_permlane32_swap(__float_as_uint(v), __float_as_uint(v), false, false); return __uint_as_float(rr[0]) + __uint_as_float(rr[1]); }
DI float dpp_sum8(float v) {
  v += __int_as_float(__builtin_amdgcn_update_dpp(0, __float_as_int(v), 0xB1, 0xF, 0xF, true));
  v += __int_as_float(__builtin_amdgcn_update_dpp(0, __float_as_int(v), 0x4E, 0xF, 0xF, true));
  v += __int_as_float(__builtin_amdgcn_update_dpp(0, __float_as_int(v), 0x141, 0xF, 0xF, true));
  return v;
}
DI float dpp_sum16b(float v) { v = dpp_sum8(v); v += __int_as_float(__builtin_amdgcn_update_dpp(0, __float_as_int(v), 0x140, 0xF, 0xF, true)); return v; }
DI u32x2 pk4(float a, float b, float c, float d) { u32x2 w; w.x = cvtpk(a, b); w.y = cvtpk(c, d); return w; }
DI void ld4(const bf16_t* p, float* o) { const u32x2 w = *(const u32x2*)p; o[0] = __uint_as_float(w.x << 16); o[1] = __uint_as_float(w.x & 0xffff0000u); o[2] = __uint_as_float(w.y << 16); o[3] = __uint_as_float(w.y & 0xffff0000u); }
constexpr int XL_ROW = 528;
template <int MODE> DI void phase3_mfma(const Params& p, int bid, int nb, char* lds) {
  const int t_ = tid_(), wid = t_ >> 6, h = wid;
  const bf16_t* proj = ws_proj(p);
  for (int tile = bid; tile < NTOK / 64; tile += nb) {
    const int t0 = tile * 64;
    int t = t_;
    asm volatile("" : "+v"(t));
    const int lane = t & 63, r32_ = lane & 31, hi_ = lane >> 5;
    __syncthreads();
#pragma unroll
    for (int i = 0; i < 4; ++i) {
      const int id = t + 512 * i, tok = id >> 5, cc = (id & 31) * 8, gt = t0 + tok;
      float v[8], pv[8];
      const bool firstt = (gt & (SEQ - 1)) == 0;
      load8(proj + (unsigned)(gt * PROJ_LD + C_WL + cc), v);
      load8(proj + (unsigned)((firstt ? gt : gt - 1) * PROJ_LD + C_WL + cc), pv);
      const f32x4 m0 = *(const f32x4*)(p.shift_mu + C_WL + cc), m1 = *(const f32x4*)(p.shift_mu + C_WL + cc + 4);
      const float esc = (cc < 64) ? 2.0f : -1.0f;
      float x[8];
#pragma unroll
      for (int j = 0; j < 8; ++j) {
        const float mu = j < 4 ? m0[j] : m1[j - 4];
        const float pj = firstt ? 0.f : pv[j];
        const float xv = v[j] + mu * (pj - v[j]);
        const float rc = 1.0f / (__expf(esc * xv) + 1.0f);
        x[j] = (cc < 64) ? (1.0f - 2.0f * rc) : ((cc >= 128) ? rc : xv);
      }
      u32x4 w; w.x = cvtpk(x[0], x[1]); w.y = cvtpk(x[2], x[3]); w.z = cvtpk(x[4], x[5]); w.w = cvtpk(x[6], x[7]);
      *(u32x4*)(lds + tok * XL_ROW + cc * 2) = w;
    }
    if (MODE & 2) {
#pragma unroll
    for (int it = 0; it < 2; ++it) {
      const int gt = t0 + wid * 8 + it * 4 + (lane >> 4), c0 = (lane & 15) * 8;
      float v[8]; load8(proj + (size_t)gt * PROJ_LD + C_CKV + c0, v);
      float ss = 0.f;
#pragma unroll
      for (int j = 0; j < 8; ++j) ss += v[j] * v[j];
      const float rs = rsqrtf(dpp_sum16b(ss) * (1.0f / 128.0f) + 1e-6f);
      const f32x4 g0 = *(const f32x4*)(p.kv_norm_g + c0), g1 = *(const f32x4*)(p.kv_norm_g + c0 + 4);
      u32x4 w; w.x = cvtpk(v[0] * rs * g0[0], v[1] * rs * g0[1]); w.y = cvtpk(v[2] * rs * g0[2], v[3] * rs * g0[3]);
      w.z = cvtpk(v[4] * rs * g1[0], v[5] * rs * g1[1]); w.w = cvtpk(v[6] * rs * g1[2], v[7] * rs * g1[3]);
      *(u32x4*)(ws_ckv(p) + (size_t)gt * 128 + c0) = w;
    }
    {
      const int gt = t0 + wid * 8 + (lane >> 3), c0 = (lane & 7) * 8;
      float v[8]; load8(proj + (size_t)gt * PROJ_LD + C_KI + c0, v);
      float ss = 0.f;
#pragma unroll
      for (int j = 0; j < 8; ++j) ss += v[j] * v[j];
      const float rs = rsqrtf(dpp_sum8(ss) * (1.0f / 64.0f) + 1e-6f);
      const f32x4 g0 = *(const f32x4*)(p.k_idx_norm_g + c0), g1 = *(const f32x4*)(p.k_idx_norm_g + c0 + 4);
      u32x4 w; w.x = cvtpk(v[0] * rs * g0[0], v[1] * rs * g0[1]); w.y = cvtpk(v[2] * rs * g0[2], v[3] * rs * g0[3]);
      w.z = cvtpk(v[4] * rs * g1[0], v[5] * rs * g1[1]); w.w = cvtpk(v[6] * rs * g1[2], v[7] * rs * g1[3]);
      *(u32x4*)(ws_kidx(p) + (size_t)gt * 64 + c0) = w;
    }
    }
    __syncthreads();
#pragma unroll 1
    for (int nt = 0; nt < 2; ++nt) {
      int r32 = r32_, hi = hi_;
      asm volatile("" : "+v"(r32), "+v"(hi));
      const int gt = t0 + nt * 32 + r32;
      const bool first = (gt & (SEQ - 1)) == 0;
      const int gp = first ? gt : gt - 1;
      const char* xrow = lds + (nt * 32 + r32) * XL_ROW + hi * 16;
      const int chb = h * HD + 4 * hi;
      char* RBt = lds + 64 * XL_ROW + wid * 14336; char* KBt = RBt + 4752; char* OBt = KBt + 4752;
      const int t0w = t0 + nt * 32, frow = lane >> 3, fch = lane & 7;
      const int cwo = r32 * 144 + hi * 8;
#define P3_FLUSH(dst_, ld_, col_) do { _Pragma("unroll") for (int i_ = 0; i_ < 4; ++i_) { const int row_ = frow + 8 * i_; \
        *(u32x4*)((dst_) + (unsigned)((t0w + row_) * (ld_) + (col_) + fch * 8)) = *(const u32x4*)(OBt + row_ * 144 + fch * 16); } } while (0)
      if (MODE & 1) {
      f32x16 acc[2];
#pragma unroll
      for (int mt = 0; mt < 2; ++mt)
#pragma unroll
        for (int r = 0; r < 16; ++r) acc[mt][r] = 0.f;
#pragma unroll
      for (int ks = 0; ks < 4; ++ks) {
        const bf16x8 bx = *(const bf16x8*)(xrow + ks * 32);
#pragma unroll
        for (int mt = 0; mt < 2; ++mt) { const bf16x8 aw = *(const bf16x8*)(ws_wdt(p) + (size_t)(h * HD + mt * 32 + r32) * 64 + ks * 16 + hi * 8); acc[mt] = __builtin_amdgcn_mfma_f32_32x32x16_bf16(aw, bx, acc[mt], 0, 0, 0); }
      }
#pragma unroll
      for (int mt = 0; mt < 2; ++mt)
#pragma unroll
        for (int g = 0; g < 4; ++g) {
          const int ch = chb + 32 * mt + 8 * g;
          const f32x4 w0v = *(const f32x4*)(p.w0 + ch);
          float e[4];
#pragma unroll
          for (int i = 0; i < 4; ++i) e[i] = 0.6065306597f / (1.0f + __expf(-(w0v[i] + acc[mt][4 * g + i])));
          *(u32x2*)(OBt + cwo + mt * 64 + g * 16) = pk4(e[0], e[1], e[2], e[3]);
        }
      P3_FLUSH(ws_ee(p), RW, h * HD);
      __builtin_amdgcn_sched_barrier(0);
#pragma unroll
      for (int mt = 0; mt < 2; ++mt)
#pragma unroll
        for (int r = 0; r < 16; ++r) acc[mt][r] = 0.f;
#pragma unroll
      for (int ks = 0; ks < 8; ++ks) {
        const bf16x8 bx = *(const bf16x8*)(xrow + 256 + ks * 32);
#pragma unroll
        for (int mt = 0; mt < 2; ++mt) { const bf16x8 aw = *(const bf16x8*)(ws_wgt(p) + (size_t)(h * HD + mt * 32 + r32) * 128 + ks * 16 + hi * 8); acc[mt] = __builtin_amdgcn_mfma_f32_32x32x16_bf16(aw, bx, acc[mt], 0, 0, 0); }
      }
#pragma unroll
      for (int mt = 0; mt < 2; ++mt)
#pragma unroll
        for (int g = 0; g < 4; ++g)
          *(u32x2*)(OBt + cwo + mt * 64 + g * 16) =
              pk4(acc[mt][4 * g] + 0.0f, acc[mt][4 * g + 1] + 0.0f, acc[mt][4 * g + 2] + 0.0f, acc[mt][4 * g + 3] + 0.0f);
      P3_FLUSH(ws_gg(p), RW, h * HD);
      __builtin_amdgcn_sched_barrier(0);
#pragma unroll
      for (int mt = 0; mt < 2; ++mt)
#pragma unroll
        for (int r = 0; r < 16; ++r) acc[mt][r] = 0.f;
#pragma unroll
      for (int ks = 0; ks < 4; ++ks) {
        const bf16x8 bx = *(const bf16x8*)(xrow + 128 + ks * 32);
#pragma unroll
        for (int mt = 0; mt < 2; ++mt) { const bf16x8 aw = *(const bf16x8*)(ws_wat(p) + (size_t)(h * HD + mt * 32 + r32) * 64 + ks * 16 + hi * 8); acc[mt] = __builtin_amdgcn_mfma_f32_32x32x16_bf16(aw, bx, acc[mt], 0, 0, 0); }
      }
      __builtin_amdgcn_sched_barrier(0);
#pragma unroll
      for (int i_ = 0; i_ < 5; ++i_) {
        const int row_ = frow + 8 * i_;
        if (row_ < 33) {
          int tk_ = t0w - 1 + row_; tk_ = tk_ < 0 ? 0 : tk_;
          *(u32x4*)(RBt + row_ * 144 + fch * 16) = *(const u32x4*)(proj + (unsigned)(tk_ * PROJ_LD + C_R + h * HD + fch * 8));
          *(u32x4*)(KBt + row_ * 144 + fch * 16) = *(const u32x4*)(proj + (unsigned)(tk_ * PROJ_LD + C_K + h * HD + fch * 8));
        }
      }
      float ss = 0.f, bs = 0.f; float av[2][16];
#pragma unroll
      for (int mt = 0; mt < 2; ++mt)
#pragma unroll
        for (int g = 0; g < 4; ++g) {
          const int ch = chb + 32 * mt + 8 * g;
          float rv[4], rp[4], kv[4], kq[4];
          ld4((const bf16_t*)(RBt + 144 + cwo + mt * 64 + g * 16), rv); ld4((const bf16_t*)(KBt + 144 + cwo + mt * 64 + g * 16), kv);
          ld4((const bf16_t*)(RBt + cwo + mt * 64 + g * 16), rp); ld4((const bf16_t*)(KBt + cwo + mt * 64 + g * 16), kq);
          const f32x4 mur = *(const f32x4*)(p.shift_mu + C_R + ch), muk = *(const f32x4*)(p.shift_mu + C_K + ch);
          const f32x4 a0v = *(const f32x4*)(p.a0 + ch), kkc = *(const f32x4*)(p.k_k + ch), kac = *(const f32x4*)(p.k_a + ch), rkc = *(const f32x4*)(p.r_k + ch);
          float kp[4];
#pragma unroll
          for (int i = 0; i < 4; ++i) {
            const float a = 1.0f / (1.0f + __expf(-(a0v[i] + acc[mt][4 * g + i])));
            const float r = rv[i] + mur[i] * ((first ? 0.f : rp[i]) - rv[i]);
            const float k = kv[i] + muk[i] * ((first ? 0.f : kq[i]) - kv[i]);
            const float kk = k * kkc[i];
            ss += kk * kk;
            kp[i] = k * (1.0f + (a - 1.0f) * kac[i]);
            bs += r * kp[i] * rkc[i];
            av[mt][4 * g + i] = a;
          }
          *(u32x2*)(OBt + cwo + mt * 64 + g * 16) = pk4(kp[0], kp[1], kp[2], kp[3]);
        }
      P3_FLUSH(ws_kp(p), RW, h * HD);
      __builtin_amdgcn_sched_barrier(0);
      ss = xhalf_sum(ss); bs = xhalf_sum(bs);
      const float inv = 1.0f / fmaxf(sqrtf(ss), 1e-12f);
#pragma unroll
      for (int mt = 0; mt < 2; ++mt)
#pragma unroll
        for (int g = 0; g < 4; ++g) {
          const int ch = chb + 32 * mt + 8 * g;
          float kv[4], kq[4];
          ld4((const bf16_t*)(KBt + 144 + cwo + mt * 64 + g * 16), kv); ld4((const bf16_t*)(KBt + cwo + mt * 64 + g * 16), kq);
          const f32x4 muk = *(const f32x4*)(p.shift_mu + C_K + ch), kkc = *(const f32x4*)(p.k_k + ch);
          float kn[4];
#pragma unroll
          for (int i = 0; i < 4; ++i) { const float kprev = first ? 0.f : kq[i]; kn[i] = (kv[i] + muk[i] * (kprev - kv[i])) * kkc[i] * inv; }
          *(u32x2*)(OBt + cwo + mt * 64 + g * 16) = pk4(kn[0], kn[1], kn[2], kn[3]);
          *(u32x2*)(RBt + cwo + mt * 64 + g * 16) = pk4(kn[0] * av[mt][4 * g], kn[1] * av[mt][4 * g + 1], kn[2] * av[mt][4 * g + 2], kn[3] * av[mt][4 * g + 3]);
        }
      P3_FLUSH(ws_kk(p), RW, h * HD);
      { char* const OBs = OBt; OBt = RBt; P3_FLUSH(ws_bb(p), RW, h * HD); OBt = OBs; }
      if (hi == 0) ws_bonus(p)[gt * NH + h] = bs;
      }
#undef P3_FLUSH
    }
  }
}

DI void phase4a(const Params& p, int bid, int nb, char* lds) {
  const int t = tid_(), i = t >> 3, cg8 = (t & 7) * 8;
  const bf16_t* proj = ws_proj(p);
  for (int task = bid; task < BATCH * NH; task += nb) {
    const int b = task >> 3, h = task & 7;
    const int cbase = h * HD + cg8;
    float mu_r[8], st[8], rprev[8];
#pragma unroll
    for (int j = 0; j < 8; ++j) { mu_r[j] = p.shift_mu[C_R + cbase + j]; st[j] = 0.f; rprev[j] = 0.f; }
    const float mu_v = p.shift_mu[C_V + h * HD + i];
    float vprev = 0.f;
    const size_t tok0 = (size_t)b * SEQ;
    u32x4 n_kk, n_bb, n_kp, n_ee, n_r; bf16_t n_v;
    {
      const size_t g = tok0;
      n_kk = *(const u32x4*)(ws_kk(p) + g * RW + cbase); n_bb = *(const u32x4*)(ws_bb(p) + g * RW + cbase);
      n_kp = *(const u32x4*)(ws_kp(p) + g * RW + cbase); n_ee = *(const u32x4*)(ws_ee(p) + g * RW + cbase);
      n_r = *(const u32x4*)(proj + g * PROJ_LD + C_R + cbase); n_v = proj[g * PROJ_LD + C_V + h * HD + i];
    }
    for (int s = 0; s < SEQ; ++s) {
      const u32x4 c_kk = n_kk, c_bb = n_bb, c_kp = n_kp, c_ee = n_ee, c_r = n_r; const bf16_t c_v = n_v;
      if (s + 1 < SEQ) {
        const size_t g = tok0 + s + 1;
        n_kk = *(const u32x4*)(ws_kk(p) + g * RW + cbase); n_bb = *(const u32x4*)(ws_bb(p) + g * RW + cbase);
        n_kp = *(const u32x4*)(ws_kp(p) + g * RW + cbase); n_ee = *(const u32x4*)(ws_ee(p) + g * RW + cbase);
        n_r = *(const u32x4*)(proj + g * PROJ_LD + C_R + cbase); n_v = proj[g * PROJ_LD + C_V + h * HD + i];
      }
      float kk[8], bb[8], kp[8], ee[8], rr[8];
      unpack8(c_kk, kk); unpack8(c_bb, bb); unpack8(c_kp, kp); unpack8(c_ee, ee); unpack8(c_r, rr);
      const float vraw = bf2f(c_v);
      const float v = vraw + mu_v * (vprev - vraw); vprev = vraw;
      float sa = 0.f;
#pragma unroll
      for (int j = 0; j < 8; ++j) sa += st[j] * kk[j];
      sa += __shfl_xor(sa, 1); sa += __shfl_xor(sa, 2); sa += __shfl_xor(sa, 4);
      sa = -sa;
      float y = 0.f;
#pragma unroll
      for (int j = 0; j < 8; ++j) {
        const float r = rr[j] + mu_r[j] * (rprev[j] - rr[j]); rprev[j] = rr[j];
        const float w = __expf(-ee[j]);
        st[j] = st[j] * w + sa * bb[j] + v * kp[j];
        y += st[j] * r;
      }
      y += __shfl_xor(y, 1); y += __shfl_xor(y, 2); y += __shfl_xor(y, 4);
      if ((t & 7) == 0) ws_y(p)[(tok0 + s) * RW + h * HD + i] = y;
    }
  }
}

DI float dpp_sum16(float v) {
  v += __int_as_float(__builtin_amdgcn_update_dpp(0, __float_as_int(v), 0xB1, 0xF, 0xF, true));
  v += __int_as_float(__builtin_amdgcn_update_dpp(0, __float_as_int(v), 0x4E, 0xF, 0xF, true));
  v += __int_as_float(__builtin_amdgcn_update_dpp(0, __float_as_int(v), 0x141, 0xF, 0xF, true));
  v += __int_as_float(__builtin_amdgcn_update_dpp(0, __float_as_int(v), 0x140, 0xF, 0xF, true));
  return v;
}
constexpr int CK = 16;
constexpr int SC_CH = 16, SC_BUF = 5 * SC_CH * 64 * 4 + SC_CH * 32 * 4 + SC_CH * 8;
DI void phase4a_v2(const Params& p, int bid, int nb, char* lds) {
  const int t = tid_(), rowl = t >> 4, cg = t & 15;
  const bf16_t* proj = ws_proj(p);
  for (int task = bid; task < BATCH * NH * 2; task += nb) {
    const int b = task >> 4, h = (task >> 1) & 7, half = task & 1;
    const size_t tok0 = (size_t)b * SEQ;
    const int sst = t >> 4, scol = h * HD + cg * 4;
    const int vst = t >> 5, vrow = t & 31, vcol = C_V + h * HD + half * 32 + vrow;
    float mur[4];
#pragma unroll
    for (int j = 0; j < 4; ++j) mur[j] = p.shift_mu[C_R + scol + j];
    const float muv = p.shift_mu[vcol];
    u32x2 g_kk, g_bb, g_kp, g_ee, g_r, g_rp; bf16_t g_v, g_vp;
    auto stage_load = [&](int c) {
      if (t < 256) {
        const size_t g = tok0 + c * SC_CH + sst;
        g_kk = *(const u32x2*)(ws_kk(p) + g * RW + scol); g_bb = *(const u32x2*)(ws_bb(p) + g * RW + scol);
        g_kp = *(const u32x2*)(ws_kp(p) + g * RW + scol); g_ee = *(const u32x2*)(ws_ee(p) + g * RW + scol);
        g_r = *(const u32x2*)(proj + g * PROJ_LD + C_R + scol);
        if (c * SC_CH + sst > 0) g_rp = *(const u32x2*)(proj + (g - 1) * PROJ_LD + C_R + scol); else { g_rp.x = 0u; g_rp.y = 0u; }
      }
      const size_t gv = tok0 + c * SC_CH + vst;
      g_v = proj[gv * PROJ_LD + vcol];
      g_vp = (c * SC_CH + vst > 0) ? proj[(gv - 1) * PROJ_LD + vcol] : (bf16_t)0;
    };
    auto stage_write = [&](char* buf) {
      if (t < 256) {
        float* W = (float*)buf + sst * 64 + cg * 4;
        f32x4 o;
        o[0] = __expf(-__uint_as_float(g_ee.x << 16)); o[1] = __expf(-__uint_as_float(g_ee.x & 0xffff0000u));
        o[2] = __expf(-__uint_as_float(g_ee.y << 16)); o[3] = __expf(-__uint_as_float(g_ee.y & 0xffff0000u));
        *(f32x4*)W = o;
        o[0] = __uint_as_float(g_kk.x << 16); o[1] = __uint_as_float(g_kk.x & 0xffff0000u); o[2] = __uint_as_float(g_kk.y << 16); o[3] = __uint_as_float(g_kk.y & 0xffff0000u);
        *(f32x4*)(W + SC_CH * 64) = o;
        o[0] = __uint_as_float(g_bb.x << 16); o[1] = __uint_as_float(g_bb.x & 0xffff0000u); o[2] = __uint_as_float(g_bb.y << 16); o[3] = __uint_as_float(g_bb.y & 0xffff0000u);
        *(f32x4*)(W + 2 * SC_CH * 64) = o;
        o[0] = __uint_as_float(g_kp.x << 16); o[1] = __uint_as_float(g_kp.x & 0xffff0000u); o[2] = __uint_as_float(g_kp.y << 16); o[3] = __uint_as_float(g_kp.y & 0xffff0000u);
        *(f32x4*)(W + 3 * SC_CH * 64) = o;
        float r[4] = {__uint_as_float(g_r.x << 16), __uint_as_float(g_r.x & 0xffff0000u), __uint_as_float(g_r.y << 16), __uint_as_float(g_r.y & 0xffff0000u)};
        float rp[4] = {__uint_as_float(g_rp.x << 16), __uint_as_float(g_rp.x & 0xffff0000u), __uint_as_float(g_rp.y << 16), __uint_as_float(g_rp.y & 0xffff0000u)};
#pragma unroll
        for (int j = 0; j < 4; ++j) o[j] = r[j] + mur[j] * (rp[j] - r[j]);
        *(f32x4*)(W + 4 * SC_CH * 64) = o;
      }
      const float v = bf2f(g_v), vp = bf2f(g_vp);
      ((float*)buf)[5 * SC_CH * 64 + vst * 32 + vrow] = v + muv * (vp - v);
    };
    float st[4] = {0.f, 0.f, 0.f, 0.f};
    __syncthreads();
    stage_load(0); stage_write(lds);
    __syncthreads();
    float* yout = ws_y(p) + tok0 * RW + h * HD + half * 32 + rowl;
    for (int c = 0; c < SEQ / SC_CH; ++c) {
      const char* cur = lds + (c & 1) * SC_BUF;
      if (c + 1 < SEQ / SC_CH) stage_load(c + 1);
      const float* Wb = (const float*)cur + cg * 4;
      const float* Vb = (const float*)cur + 5 * SC_CH * 64 + rowl;
      float yv[SC_CH];
#pragma unroll
      for (int s = 0; s < SC_CH; ++s) {
        const f32x4 w = *(const f32x4*)(Wb + s * 64), kk = *(const f32x4*)(Wb + SC_CH * 64 + s * 64), bb = *(const f32x4*)(Wb + 2 * SC_CH * 64 + s * 64);
        const f32x4 kp = *(const f32x4*)(Wb + 3 * SC_CH * 64 + s * 64), rr = *(const f32x4*)(Wb + 4 * SC_CH * 64 + s * 64);
        const float v = Vb[s * 32];
        float sa = (st[0] * kk[0] + st[1] * kk[1]) + (st[2] * kk[2] + st[3] * kk[3]);
        sa = -dpp_sum16(sa);
#pragma unroll
        for (int j = 0; j < 4; ++j) st[j] = st[j] * w[j] + (sa * bb[j] + v * kp[j]);
        float y = (st[0] * rr[0] + st[1] * rr[1]) + (st[2] * rr[2] + st[3] * rr[3]);
        yv[s] = dpp_sum16(y);
      }
      if (cg == 0) {
#pragma unroll
        for (int s = 0; s < SC_CH; ++s) yout[(size_t)(c * SC_CH + s) * RW] = yv[s];
      }
      if (c + 1 < SEQ / SC_CH) stage_write(lds + ((c + 1) & 1) * SC_BUF);
      __syncthreads();
    }
  }
}

DI void moe_tr_wave(const Params& p, int id, int lane, float* tl  ) {
  const int which = id >> 12, q = id & 4095, e = q >> 7, r = q & 127;
  const float* src; int N, k0, n0;
  if (which < 2) { src = (which == 0 ? p.e_gate : p.e_up) + (size_t)e * 1024 * 512; N = 512; k0 = (r >> 3) * 64; n0 = (r & 7) * 64; }
  else { src = p.e_down + (size_t)e * 512 * 1024; N = 1024; k0 = (r >> 4) * 64; n0 = (r & 15) * 64; }
  const int lr = lane >> 4, lc = (lane & 15) * 4;
  f32x4 g[16];
#pragma unroll
  for (int i = 0; i < 16; ++i) g[i] = *(const f32x4*)(src + (size_t)(k0 + lr + 4 * i) * N + n0 + lc);
#pragma unroll
  for (int i = 0; i < 16; ++i) { float* d = tl + (lr + 4 * i) * 65 + lc; d[0] = g[i][0]; d[1] = g[i][1]; d[2] = g[i][2]; d[3] = g[i][3]; }
  bf16_t* dst;
  { const int n = n0 + lane;
    if (which < 2) dst = ws_wgu(p) + (size_t)e * 1024 * 1024 + (size_t)((n >> 7) * 256 + (n & 127) + which * 128) * 1024 + k0;
    else dst = ws_wd(p) + (size_t)e * 1024 * 512 + (size_t)n * 512 + k0; }
#pragma unroll
  for (int c8 = 0; c8 < 8; ++c8) {
    float v[8];
#pragma unroll
    for (int j = 0; j < 8; ++j) v[j] = tl[(c8 * 8 + j) * 65 + lane];
    u32x4 w; w.x = cvtpk(v[0], v[1]); w.y = cvtpk(v[2], v[3]); w.z = cvtpk(v[4], v[5]); w.w = cvtpk(v[6], v[7]);
    *(u32x4*)(dst + c8 * 8) = w;
  }
}

typedef float f32x2p __attribute__((ext_vector_type(2)));
DI void phase4a_v3(const Params& p, int bid, int nb, char* lds) {
  const int t = tid_(), wid = __builtin_amdgcn_readfirstlane(t >> 6);
  const int rowl = (t >> 3) & 31, cg = t & 7;
  const int pt = t & 255;
  const bf16_t* proj = ws_proj(p);
  for (int task = bid; task < BATCH * NH * 2; task += nb) {
    const int b = task >> 4, h = (task >> 1) & 7, half = task & 1;
    const size_t tok0 = (size_t)b * SEQ;
    const int sst = pt >> 4, scq = pt & 15, scol = h * HD + scq * 4;
    const int vst = pt >> 5, vrow = pt & 31, vcol = C_V + h * HD + half * 32 + vrow;
    float mur[4];
#pragma unroll
    for (int j = 0; j < 4; ++j) mur[j] = p.shift_mu[C_R + scol + j];
    const float muv = p.shift_mu[vcol];
    u32x2 g_kk, g_bb, g_kp, g_ee, g_r, g_rp; bf16_t g_v0, g_v0p, g_v1, g_v1p;
#define SC_LOAD(c_) do { const int c__ = (c_); const size_t g = tok0 + c__ * SC_CH + sst; \
      g_kk = *(const u32x2*)(ws_kk(p) + g * RW + scol); g_bb = *(const u32x2*)(ws_bb(p) + g * RW + scol); \
      g_kp = *(const u32x2*)(ws_kp(p) + g * RW + scol); g_ee = *(const u32x2*)(ws_ee(p) + g * RW + scol); \
      g_r = *(const u32x2*)(proj + g * PROJ_LD + C_R + scol); \
      g_rp = *(const u32x2*)(proj + (g - ((c__ * SC_CH + sst > 0) ? 1 : 0)) * PROJ_LD + C_R + scol); \
      if (c__ * SC_CH + sst == 0) { g_rp.x = 0u; g_rp.y = 0u; } \
      const size_t gv = tok0 + c__ * SC_CH + vst; \
      g_v0 = proj[gv * PROJ_LD + vcol]; g_v0p = (c__ * SC_CH + vst > 0) ? proj[(gv - 1) * PROJ_LD + vcol] : (bf16_t)0; \
      g_v1 = proj[(gv + 8) * PROJ_LD + vcol]; g_v1p = proj[(gv + 7) * PROJ_LD + vcol]; } while (0)
#define SC_WRITE(buf_) do { float* W = (float*)(buf_) + sst * 64 + scq * 4; f32x4 o; \
      o[0] = __expf(-__uint_as_float(g_ee.x << 16)); o[1] = __expf(-__uint_as_float(g_ee.x & 0xffff0000u)); \
      o[2] = __expf(-__uint_as_float(g_ee.y << 16)); o[3] = __expf(-__uint_as_float(g_ee.y & 0xffff0000u)); *(f32x4*)W = o; \
      o[0] = __uint_as_float(g_kk.x << 16); o[1] = __uint_as_float(g_kk.x & 0xffff0000u); o[2] = __uint_as_float(g_kk.y << 16); o[3] = __uint_as_float(g_kk.y & 0xffff0000u); *(f32x4*)(W + SC_CH * 64) = o; \
      o[0] = __uint_as_float(g_bb.x << 16); o[1] = __uint_as_float(g_bb.x & 0xffff0000u); o[2] = __uint_as_float(g_bb.y << 16); o[3] = __uint_as_float(g_bb.y & 0xffff0000u); *(f32x4*)(W + 2 * SC_CH * 64) = o; \
      o[0] = __uint_as_float(g_kp.x << 16); o[1] = __uint_as_float(g_kp.x & 0xffff0000u); o[2] = __uint_as_float(g_kp.y << 16); o[3] = __uint_as_float(g_kp.y & 0xffff0000u); *(f32x4*)(W + 3 * SC_CH * 64) = o; \
      { const float r0 = __uint_as_float(g_r.x << 16), r1 = __uint_as_float(g_r.x & 0xffff0000u), r2 = __uint_as_float(g_r.y << 16), r3 = __uint_as_float(g_r.y & 0xffff0000u); \
        const float q0 = __uint_as_float(g_rp.x << 16), q1 = __uint_as_float(g_rp.x & 0xffff0000u), q2 = __uint_as_float(g_rp.y << 16), q3 = __uint_as_float(g_rp.y & 0xffff0000u); \
        o[0] = r0 + mur[0] * (q0 - r0); o[1] = r1 + mur[1] * (q1 - r1); o[2] = r2 + mur[2] * (q2 - r2); o[3] = r3 + mur[3] * (q3 - r3); \
        const f32x4 wv_ = *(const f32x4*)W, bv_ = *(const f32x4*)(W + 2 * SC_CH * 64), kv_ = *(const f32x4*)(W + 3 * SC_CH * 64); \
        const float br_ = dpp_sum16((bv_[0] * o[0] + bv_[1] * o[1]) + (bv_[2] * o[2] + bv_[3] * o[3])), kr_ = dpp_sum16((kv_[0] * o[0] + kv_[1] * o[1]) + (kv_[2] * o[2] + kv_[3] * o[3])); \
        if (scq == 0) { float* X_ = (float*)(buf_) + 5 * SC_CH * 64 + SC_CH * 32 + sst * 2; X_[0] = br_; X_[1] = kr_; } \
        o[0] *= wv_[0]; o[1] *= wv_[1]; o[2] *= wv_[2]; o[3] *= wv_[3]; *(f32x4*)(W + 4 * SC_CH * 64) = o; } \
      { const float v0 = bf2f(g_v0), v0p = bf2f(g_v0p), v1 = bf2f(g_v1), v1p = bf2f(g_v1p); float* Vw = (float*)(buf_) + 5 * SC_CH * 64 + vst * 32 + vrow; \
        Vw[0] = v0 + muv * (v0p - v0); Vw[8 * 32] = v1 + muv * (v1p - v1); } } while (0)
    f32x2p st2[4];
#pragma unroll
    for (int j = 0; j < 4; ++j) st2[j] = (f32x2p){0.f, 0.f};
    __syncthreads();
    if (wid >= 4) { SC_LOAD(0); SC_WRITE(lds); SC_LOAD(1); }
    __syncthreads();
    float* yout = ws_y(p) + tok0 * RW + h * HD + half * 32 + rowl;
    for (int c = 0; c < SEQ / SC_CH; ++c) {
      const char* cur = lds + (c & 1) * SC_BUF;
      if (wid >= 4) {
        if (c + 1 < SEQ / SC_CH) SC_WRITE(lds + ((c + 1) & 1) * SC_BUF);
        if (c + 2 < SEQ / SC_CH) SC_LOAD(c + 2);
        if ((c & 7) == 3) {
          const int tid_tr = (task * 4 + (wid - 4)) + (BATCH * NH * 2 * 4) * (c >> 3);
          if (tid_tr < 3 * 4096) moe_tr_wave(p, tid_tr, t & 63, (float*)(lds + 2 * SC_BUF + 128) + (wid - 4) * (64 * 65));
        }
      } else {
        const float* Wb = (const float*)cur + cg * 8;
        const float* Vb = (const float*)cur + 5 * SC_CH * 64 + rowl;
        float yv[SC_CH];
#pragma unroll
        for (int s = 0; s < SC_CH; ++s) {
          const f32x4 w0 = *(const f32x4*)(Wb + s * 64), w1 = *(const f32x4*)(Wb + s * 64 + 4);
          const f32x4 k0 = *(const f32x4*)(Wb + SC_CH * 64 + s * 64), k1 = *(const f32x4*)(Wb + SC_CH * 64 + s * 64 + 4);
          const f32x4 b0 = *(const f32x4*)(Wb + 2 * SC_CH * 64 + s * 64), b1 = *(const f32x4*)(Wb + 2 * SC_CH * 64 + s * 64 + 4);
          const f32x4 p0 = *(const f32x4*)(Wb + 3 * SC_CH * 64 + s * 64), p1 = *(const f32x4*)(Wb + 3 * SC_CH * 64 + s * 64 + 4);
          const f32x4 r0 = *(const f32x4*)(Wb + 4 * SC_CH * 64 + s * 64), r1 = *(const f32x4*)(Wb + 4 * SC_CH * 64 + s * 64 + 4);
          const float v = Vb[s * 32];
#define LO2(x) __builtin_shufflevector(x, x, 0, 1)
#define HI2(x) __builtin_shufflevector(x, x, 2, 3)
          const f32x2p xs = *(const f32x2p*)((const float*)cur + 5 * SC_CH * 64 + SC_CH * 32 + s * 2);
          f32x2p sa2 = st2[0] * LO2(k0), yd2 = st2[0] * LO2(r0);
          sa2 = st2[1] * HI2(k0) + sa2; yd2 = st2[1] * HI2(r0) + yd2;
          sa2 = st2[2] * LO2(k1) + sa2; yd2 = st2[2] * LO2(r1) + yd2;
          sa2 = st2[3] * HI2(k1) + sa2; yd2 = st2[3] * HI2(r1) + yd2;
          const float sa = -dpp_sum8(sa2[0] + sa2[1]);
          const float yd = dpp_sum8(yd2[0] + yd2[1]);
          yv[s] = yd + sa * xs[0] + v * xs[1];
          const f32x2p sav = {sa, sa}, vv = {v, v};
          st2[0] = st2[0] * LO2(w0) + (sav * LO2(b0) + vv * LO2(p0));
          st2[1] = st2[1] * HI2(w0) + (sav * HI2(b0) + vv * HI2(p0));
          st2[2] = st2[2] * LO2(w1) + (sav * LO2(b1) + vv * LO2(p1));
          st2[3] = st2[3] * HI2(w1) + (sav * HI2(b1) + vv * HI2(p1));
#undef LO2
#undef HI2
        }
        if (cg == 0) {
#pragma unroll
          for (int s = 0; s < SC_CH; ++s) yout[(size_t)(c * SC_CH + s) * RW] = yv[s];
        }
      }
      __syncthreads();
    }
#undef SC_LOAD
#undef SC_WRITE
  }
}

DI void moe_tr_small(const Params& p, int id, int lane, float* tl  ) {
  const int which = id >> 14, r_ = id & 16383, e = r_ >> 9, rr = r_ & 511;
  const float* src; int N, k0, n0;
  if (which < 2) { src = (which == 0 ? p.e_gate : p.e_up) + (size_t)e * 1024 * 512; N = 512; k0 = (rr >> 5) * 64; n0 = (rr & 31) * 16; }
  else { src = p.e_down + (size_t)e * 512 * 1024; N = 1024; k0 = (rr >> 6) * 64; n0 = (rr & 63) * 16; }
  const float* sp = src + (size_t)(k0 + lane) * N + n0;
  const f32x4 g0 = *(const f32x4*)sp, g1 = *(const f32x4*)(sp + 4), g2 = *(const f32x4*)(sp + 8), g3 = *(const f32x4*)(sp + 12);
  float* d = tl + lane * 17;
  d[0] = g0[0]; d[1] = g0[1]; d[2] = g0[2]; d[3] = g0[3]; d[4] = g1[0]; d[5] = g1[1]; d[6] = g1[2]; d[7] = g1[3];
  d[8] = g2[0]; d[9] = g2[1]; d[10] = g2[2]; d[11] = g2[3]; d[12] = g3[0]; d[13] = g3[1]; d[14] = g3[2]; d[15] = g3[3];
  const int nn = lane & 15, kq = lane >> 4;
  float v[16];
#pragma unroll
  for (int i = 0; i < 16; ++i) v[i] = tl[(kq * 16 + i) * 17 + nn];
  u32x4 w0, w1;
  w0.x = cvtpk(v[0], v[1]); w0.y = cvtpk(v[2], v[3]); w0.z = cvtpk(v[4], v[5]); w0.w = cvtpk(v[6], v[7]);
  w1.x = cvtpk(v[8], v[9]); w1.y = cvtpk(v[10], v[11]); w1.z = cvtpk(v[12], v[13]); w1.w = cvtpk(v[14], v[15]);
  const int n = n0 + nn;
  bf16_t* dst;
  if (which < 2) dst = ws_wgu(p) + (size_t)e * 1024 * 1024 + (size_t)((n >> 7) * 256 + (n & 127) + which * 128) * 1024 + k0 + kq * 16;
  else dst = ws_wd(p) + (size_t)e * 1024 * 512 + (size_t)n * 512 + k0 + kq * 16;
  *(u32x4*)dst = w0; *(u32x4*)(dst + 8) = w1;
}

constexpr int CS_PSZ = 23552, CS_SLSZ = 13312, CS_SL0 = 4 * CS_PSZ, CS_CON = CS_SL0 + 4 * CS_SLSZ;
DI f32x4v cs_mm16(const float* A, int sam, int sak, const float* B, int sbk, int sbn, f32x4v c, int l16, int g) {
#pragma unroll
  for (int q = 0; q < 4; ++q) c = __builtin_amdgcn_mfma_f32_16x16x4f32(A[l16 * sam + (4 * q + g) * sak], B[(4 * q + g) * sbk + l16 * sbn], c, 0, 0, 0);
  return c;
}
DI void cs_st16(float* D, f32x4v c, int l16, int g) {
#pragma unroll
  for (int r = 0; r < 4; ++r) D[(4 * g + r) * 16 + l16] = c[r];
}
DI f32x4v cs_ld16(const float* D, int l16, int g) { f32x4v c;
#pragma unroll
  for (int r = 0; r < 4; ++r) c[r] = D[(4 * g + r) * 16 + l16];
  return c; }
DI void cs_st4(bf16_t* base, int ld, f32x4v c) {
  const unsigned p01 = cvtpk(c[0] + 0.0f, c[1] + 0.0f), p23 = cvtpk(c[2] + 0.0f, c[3] + 0.0f);
  base[0] = (bf16_t)p01; base[ld] = (bf16_t)(p01 >> 16); base[2 * ld] = (bf16_t)p23; base[3 * ld] = (bf16_t)(p23 >> 16);
}
constexpr int CS_FLG = CS_CON + 6144 + 2 * 64 * 17 * 4;
DI void cs_wait(volatile int* f, int v) {
  while (__builtin_amdgcn_readfirstlane(*f) < v) __builtin_amdgcn_s_sleep(2);
  __builtin_amdgcn_fence(__ATOMIC_ACQUIRE, "workgroup");
}
DI void cs_post(volatile int* f, int v, int lane) {
  __builtin_amdgcn_fence(__ATOMIC_RELEASE, "workgroup");
  if (lane == 0) *f = v;
}
static_assert(CS_FLG + 48 <= LDS_BYTES - 64, "chunked scan LDS map");
#define CS_LAS __attribute__((address_space(3)))
DI void phase4a_chunk(const Params& p, int bid, int nb, char* lds) {
  const int t = tid_(), wid = __builtin_amdgcn_readfirstlane(t >> 6), lane = t & 63, l16 = lane & 15, g = lane >> 4;
  const bf16_t* proj = ws_proj(p);
  const f32x4v z4 = {0.f, 0.f, 0.f, 0.f};
  const bf16x8 zf = {0, 0, 0, 0, 0, 0, 0, 0};
  volatile int* fl_ready = (volatile int*)(lds + CS_FLG); volatile int* fl_done = fl_ready + 4;
  if (t < 12) fl_ready[t] = 0;
  int seq0 = 0;
  for (int task = bid; task < BATCH * NH * 2; task += nb, seq0 += SEQ / CK / 4) {
    const int b = task >> 4, h = (task >> 1) & 7, half = task & 1;
    const int tok0 = b * SEQ;
    f32x4v Sacc[4] = {z4, z4, z4, z4};
    char* Sb = lds + CS_CON; char* Ub = Sb + 4608;
    const int i0 = (wid & 1) * 16;
    __syncthreads();
    if (wid < 2) { for (int i = lane; i < 16 * 144 / 4; i += 64) ((unsigned*)(Sb + i0 * 144))[i] = 0u; }
    u32x4 pf[10]; bf16_t pf_rp = 0, pf_v[9];
#define CS_PF(cc) do { const int ct_ = tok0 + (cc) * CK; \
      const unsigned ro_ = (unsigned)((ct_ + (lane >> 3)) * RW + h * HD + (lane & 7) * 8) * 2u; \
      const unsigned rp_ = (unsigned)((ct_ + (lane >> 3)) * PROJ_LD + C_R + h * HD + (lane & 7) * 8) * 2u; \
      pf[0] = *(const u32x4*)((const char*)ws_ee(p) + ro_); pf[1] = *(const u32x4*)((const char*)ws_ee(p) + ro_ + 8 * RW * 2); \
      pf[2] = *(const u32x4*)((const char*)ws_kk(p) + ro_); pf[3] = *(const u32x4*)((const char*)ws_kk(p) + ro_ + 8 * RW * 2); \
      pf[4] = *(const u32x4*)((const char*)ws_bb(p) + ro_); pf[5] = *(const u32x4*)((const char*)ws_bb(p) + ro_ + 8 * RW * 2); \
      pf[6] = *(const u32x4*)((const char*)ws_kp(p) + ro_); pf[7] = *(const u32x4*)((const char*)ws_kp(p) + ro_ + 8 * RW * 2); \
      pf[8] = *(const u32x4*)((const char*)proj + rp_); pf[9] = *(const u32x4*)((const char*)proj + rp_ + 8 * PROJ_LD * 2); \
      { const int tp_ = (ct_ - 1 < tok0) ? tok0 : ct_ - 1; pf_rp = proj[(unsigned)(tp_ * PROJ_LD + C_R + h * HD + lane)]; } \
      _Pragma("unroll") for (int q_ = 0; q_ < 9; ++q_) { int tv_ = ct_ + (lane >> 5) * 8 + q_ - 1; tv_ = (tv_ < tok0) ? tok0 : tv_; \
        pf_v[q_] = proj[(unsigned)(tv_ * PROJ_LD + C_V + h * HD + half * 32 + (lane & 31))]; } } while (0)
    if (wid >= 4) CS_PF(wid - 4);
    const float mur = p.shift_mu[C_R + h * HD + lane], muv = p.shift_mu[C_V + h * HD + half * 32 + (lane & 31)];
    if (wid < 2) __builtin_amdgcn_s_setprio(3);
    for (int rnd = 0; rnd < SEQ / CK / 4; ++rnd) {
      if (wid >= 4) {
        const int pw = wid - 4, c = rnd * 4 + pw, ct0 = tok0 + c * CK;
        char* ps = lds + pw * CS_PSZ;
        bf16_t* AB = (bf16_t*)ps; bf16_t* BT = AB + 16 * 72; bf16_t* KT = BT + 16 * 72; bf16_t* RB = KT + 16 * 72;
        float* KHT = (float*)(ps + 9216);
        float* Nf = (float*)(ps + 13312); float* AKB = Nf + 256; float* ABR = AKB + 256; float* AKR = ABR + 256;
        float* T0 = AKR + 256; float* T1 = Nf; float* Pm = T0 + 256; float* Mm = Pm + 256;
        bf16_t* ABT = (bf16_t*)(Mm + 256);
        bf16_t* APb = (bf16_t*)BT;
        bf16_t* MTb = (bf16_t*)KT;
        bf16_t* W1b = MTb + 16 * 24;
        bf16_t* ABRT = W1b + 16 * 24;
        char* sl = lds + CS_SL0 + pw * CS_SLSZ;
        bf16_t* QT = (bf16_t*)sl; bf16_t* APT = QT + 16 * 72; bf16_t* BHT = APT + 16 * 72; bf16_t* GGT = BHT + 64 * 24; bf16_t* HT = GGT + 64 * 24; bf16_t* VT = HT + 16 * 24;
        float* GAM = (float*)(sl + 2304 * 2 + 3072 * 2 + 768 + 1536);
        u32x4 bhw0, bhw1, vw; float gamC;
        {
          const int j = lane, col = h * HD + j;
          float cum[CK];
          {
            char* rawl = ps + 13312 + lane * 16;
#pragma unroll
            for (int i = 0; i < 10; ++i) *(u32x4*)(rawl + i * 1024) = pf[i];
          }
          float rprev = (c * CK > 0) ? bf2f(pf_rp) : 0.f;
          {
            const int vi = lane & 31, sh = lane >> 5, vcol = C_V + h * HD + half * 32 + vi;
            float vprev = (c * CK + sh * 8 > 0) ? bf2f(pf_v[0]) : 0.f;
            float vv[8];
#pragma unroll
            for (int q = 0; q < 8; ++q) { const float vr = bf2f(pf_v[q + 1]); vv[q] = vr + muv * (vprev - vr); vprev = vr; }
            vw.x = cvtpk(vv[0], vv[1]); vw.y = cvtpk(vv[2], vv[3]); vw.z = cvtpk(vv[4], vv[5]); vw.w = cvtpk(vv[6], vv[7]);
          }
          if (rnd + 1 < SEQ / CK / 4) CS_PF(c + 4);
          const bf16_t* RAW = (const bf16_t*)(ps + 13312);
          float run = 0.f;
#pragma unroll
          for (int tt = 0; tt < CK; ++tt) { run += bf2f(RAW[tt * 64 + j]); cum[tt] = run; }
          gamC = __expf(-run);
          float bhv[CK], abv[CK];
          float gprev = 1.0f;
#pragma unroll
          for (int tt = 0; tt < CK; tt += 2) {
            float bt2[2], kt2[2], rb2[2];
#pragma unroll
            for (int u = 0; u < 2; ++u) { const int t_ = tt + u;
              const float kkr = bf2f(RAW[1024 + t_ * 64 + j]), ber = bf2f(RAW[2048 + t_ * 64 + j]), kpr = bf2f(RAW[3072 + t_ * 64 + j]), rr = bf2f(RAW[4096 + t_ * 64 + j]);
              const float rsh = rr + mur * (rprev - rr); rprev = rr;
              const float gt_ = __expf(-cum[t_]), gin = __builtin_amdgcn_rcpf(gt_), gh = gamC * gin;
              abv[t_] = -gprev * kkr; gprev = gt_;
              bt2[u] = ber * gin; kt2[u] = kpr * gin; rb2[u] = gt_ * rsh; bhv[t_] = ber * gh;
              KHT[j * 16 + t_] = kpr * gh; }
            const unsigned pa = cvtpk(abv[tt], abv[tt + 1]), pb = cvtpk(bt2[0], bt2[1]), pk = cvtpk(kt2[0], kt2[1]), pr = cvtpk(rb2[0], rb2[1]);
            AB[tt * 72 + j] = (bf16_t)pa; AB[(tt + 1) * 72 + j] = (bf16_t)(pa >> 16);
            BT[tt * 72 + j] = (bf16_t)pb; BT[(tt + 1) * 72 + j] = (bf16_t)(pb >> 16);
            KT[tt * 72 + j] = (bf16_t)pk; KT[(tt + 1) * 72 + j] = (bf16_t)(pk >> 16);
            RB[tt * 72 + j] = (bf16_t)pr; RB[(tt + 1) * 72 + j] = (bf16_t)(pr >> 16);
          }
          u32x4 bh0, bh1;
          bhw0.x = cvtpk(bhv[0], bhv[1]); bhw0.y = cvtpk(bhv[2], bhv[3]); bhw0.z = cvtpk(bhv[4], bhv[5]); bhw0.w = cvtpk(bhv[6], bhv[7]);
          bhw1.x = cvtpk(bhv[8], bhv[9]); bhw1.y = cvtpk(bhv[10], bhv[11]); bhw1.z = cvtpk(bhv[12], bhv[13]); bhw1.w = cvtpk(bhv[14], bhv[15]);
          bh0.x = cvtpk(abv[0], abv[1]); bh0.y = cvtpk(abv[2], abv[3]); bh0.z = cvtpk(abv[4], abv[5]); bh0.w = cvtpk(abv[6], abv[7]);
          bh1.x = cvtpk(abv[8], abv[9]); bh1.y = cvtpk(abv[10], abv[11]); bh1.z = cvtpk(abv[12], abv[13]); bh1.w = cvtpk(abv[14], abv[15]);
          *(u32x4*)(ABT + j * 24) = bh0; *(u32x4*)(ABT + j * 24 + 8) = bh1;
        }
        {
          bf16x8 fb[2], fk[2], fa[2], fr[2];
#pragma unroll
          for (int ks = 0; ks < 2; ++ks) { const int off = l16 * 72 + 8 * g + 32 * ks;
            fb[ks] = *(const bf16x8*)(BT + off); fk[ks] = *(const bf16x8*)(KT + off); fa[ks] = *(const bf16x8*)(AB + off); fr[ks] = *(const bf16x8*)(RB + off); }
          f32x4v n_ = z4, akb = z4, abr = z4, akr = z4;
#pragma unroll
          for (int ks = 0; ks < 2; ++ks) {
            n_ = __builtin_amdgcn_mfma_f32_16x16x32_bf16(fb[ks], fa[ks], n_, 0, 0, 0);
            akb = __builtin_amdgcn_mfma_f32_16x16x32_bf16(fk[ks], fa[ks], akb, 0, 0, 0);
            abr = __builtin_amdgcn_mfma_f32_16x16x32_bf16(fb[ks], fr[ks], abr, 0, 0, 0);
            akr = __builtin_amdgcn_mfma_f32_16x16x32_bf16(fk[ks], fr[ks], akr, 0, 0, 0);
          }
#pragma unroll
          for (int r = 0; r < 4; ++r) { const int s_ = 4 * g + r, t_ = l16;
            Nf[s_ * 16 + t_] = (s_ < t_) ? n_[r] : 0.f; AKB[s_ * 16 + t_] = (s_ < t_) ? akb[r] : 0.f;
            ABR[s_ * 16 + t_] = (s_ <= t_) ? abr[r] : 0.f; AKR[s_ * 16 + t_] = (s_ <= t_) ? akr[r] : 0.f;
            Pm[s_ * 16 + t_] = ((s_ < t_) ? n_[r] : 0.f) + ((s_ == t_) ? 1.0f : 0.f); }
          { const int t_ = l16; float a4[4];
#pragma unroll
            for (int r = 0; r < 4; ++r) a4[r] = (4 * g + r <= t_) ? abr[r] : 0.f;
            *(u32x2*)(ABRT + t_ * 24 + 4 * g) = pk4(a4[0], a4[1], a4[2], a4[3]); }
        }
        {
          f32x4v c_;
          c_ = cs_mm16(Nf, 16, 1, Nf, 16, 1, z4, l16, g); cs_st16(T0, c_, l16, g);
          c_ = cs_mm16(Pm, 16, 1, T0, 16, 1, cs_ld16(Pm, l16, g), l16, g); cs_st16(Pm, c_, l16, g);
          c_ = cs_mm16(T0, 16, 1, T0, 16, 1, z4, l16, g); cs_st16(T1, c_, l16, g);
          c_ = cs_mm16(Pm, 16, 1, T1, 16, 1, cs_ld16(Pm, l16, g), l16, g); cs_st16(Pm, c_, l16, g);
          c_ = cs_mm16(T1, 16, 1, T1, 16, 1, z4, l16, g); cs_st16(T0, c_, l16, g);
          c_ = cs_mm16(Pm, 16, 1, T0, 16, 1, cs_ld16(Pm, l16, g), l16, g); cs_st16(Mm, c_, l16, g);
          *(u32x2*)(MTb + l16 * 24 + 4 * g) = pk4(c_[0] + 0.0f, c_[1] + 0.0f, c_[2] + 0.0f, c_[3] + 0.0f);
          f32x4v w_ = z4;
#pragma unroll
          for (int q = 0; q < 4; ++q) w_ = __builtin_amdgcn_mfma_f32_16x16x4f32(Mm[(4 * q + g) * 16 + l16], AKB[l16 * 16 + 4 * q + g], w_, 0, 0, 0);
          *(u32x2*)(W1b + l16 * 24 + 4 * g) = pk4(w_[0] + 0.0f, w_[1] + 0.0f, w_[2] + 0.0f, w_[3] + 0.0f);
        }
        cs_wait(fl_done + pw, seq0 + rnd); cs_wait(fl_done + 4 + pw, seq0 + rnd);
        *(u32x4*)(BHT + lane * 24) = bhw0; *(u32x4*)(BHT + lane * 24 + 8) = bhw1;
        GAM[lane] = gamC;
        *(u32x4*)(VT + (lane & 31) * 24 + (lane >> 5) * 8) = vw;
        {
          const bf16x8 mF = (g < 2) ? *(const bf16x8*)(MTb + l16 * 24 + 8 * g) : zf;
          const bf16x8 rF = (g < 2) ? *(const bf16x8*)(ABRT + l16 * 24 + 8 * g) : zf;
          const bf16x8 wF = (g < 2) ? *(const bf16x8*)(W1b + l16 * 24 + 8 * g) : zf;
#pragma unroll
          for (int nt = 0; nt < 4; ++nt) {
            const bf16x8 bF = (g < 2) ? *(const bf16x8*)(ABT + (16 * nt + l16) * 24 + 8 * g) : zf;
            const f32x4v c_ = __builtin_amdgcn_mfma_f32_16x16x32_bf16(mF, bF, z4, 0, 0, 0);
            cs_st4(APT + (4 * g) * 72 + 16 * nt + l16, 72, c_);
            *(u32x2*)(APb + (16 * nt + l16) * 24 + 4 * g) = pk4(c_[0] + 0.0f, c_[1] + 0.0f, c_[2] + 0.0f, c_[3] + 0.0f);
          }
#pragma unroll
          for (int nt = 0; nt < 4; ++nt) {
            f32x4v c_;
#pragma unroll
            for (int r = 0; r < 4; ++r) c_[r] = bf2f(RB[(4 * g + r) * 72 + 16 * nt + l16]);
            const bf16x8 bF = (g < 2) ? *(const bf16x8*)(APb + (16 * nt + l16) * 24 + 8 * g) : zf;
            c_ = __builtin_amdgcn_mfma_f32_16x16x32_bf16(rF, bF, c_, 0, 0, 0);
            cs_st4(QT + (4 * g) * 72 + 16 * nt + l16, 72, c_);
          }
          {
            f32x4v c_;
#pragma unroll
            for (int r = 0; r < 4; ++r) c_[r] = AKR[l16 * 16 + 4 * g + r];
            c_ = __builtin_amdgcn_mfma_f32_16x16x32_bf16(rF, wF, c_, 0, 0, 0);
            cs_st4(HT + (4 * g) * 24 + l16, 24, c_);
          }
#pragma unroll
          for (int mt = 0; mt < 4; ++mt) {
            f32x4v c_;
#pragma unroll
            for (int r = 0; r < 4; ++r) c_[r] = KHT[(16 * mt + 4 * g + r) * 16 + l16];
            const bf16x8 aF = (g < 2) ? *(const bf16x8*)(BHT + (16 * mt + l16) * 24 + 8 * g) : zf;
            c_ = __builtin_amdgcn_mfma_f32_16x16x32_bf16(aF, wF, c_, 0, 0, 0);
            cs_st4(GGT + (16 * mt + 4 * g) * 24 + l16, 24, c_);
          }
        }
        cs_post(fl_ready + pw, seq0 + rnd + 1, lane);
      }
      else if (wid >= 2) {
        float* tl = (float*)(lds + CS_CON + 6144) + (wid - 2) * (64 * 17);
#pragma unroll 1
        for (int q = 0; q < 3; ++q) moe_tr_small(p, ((task * 2 + (wid - 2)) * 96 + rnd * 3 + q), lane, tl);
      }
      else {
#pragma unroll 1
        for (int k = 0; k < 4; ++k) {
          const char* sl = lds + CS_SL0 + k * CS_SLSZ;
          cs_wait(fl_ready + k, seq0 + rnd + 1);
          const bf16_t* QT = (const bf16_t*)sl; const bf16_t* APT = QT + 16 * 72; const bf16_t* BHT = APT + 16 * 72; const bf16_t* GGT = BHT + 64 * 24; const bf16_t* HT = GGT + 64 * 24; const bf16_t* VT = HT + 16 * 24;
          const float* GAM = (const float*)(sl + 2304 * 2 + 3072 * 2 + 768 + 1536);
          bf16x8 sA[2], qF[2], aF[2];
#pragma unroll
          for (int ks = 0; ks < 2; ++ks) { sA[ks] = *(const bf16x8*)(Sb + (i0 + l16) * 144 + (8 * g + 32 * ks) * 2);
            qF[ks] = *(const bf16x8*)(QT + l16 * 72 + 8 * g + 32 * ks); aF[ks] = *(const bf16x8*)(APT + l16 * 72 + 8 * g + 32 * ks); }
          const bf16x8 vF = (g < 2) ? *(const bf16x8*)(VT + (i0 + l16) * 24 + 8 * g) : zf;
          const bf16x8 hF = (g < 2) ? *(const bf16x8*)(HT + l16 * 24 + 8 * g) : zf;
          f32x4v yT = z4;
          yT = __builtin_amdgcn_mfma_f32_16x16x32_bf16(qF[0], sA[0], yT, 0, 0, 0);
          yT = __builtin_amdgcn_mfma_f32_16x16x32_bf16(qF[1], sA[1], yT, 0, 0, 0);
          yT = __builtin_amdgcn_mfma_f32_16x16x32_bf16(hF, vF, yT, 0, 0, 0);
          {
            float* yo = ws_y(p) + (size_t)(tok0 + (rnd * 4 + k) * CK + 4 * g) * RW + h * HD + half * 32 + i0 + l16;
#pragma unroll
            for (int r = 0; r < 4; ++r) yo[(size_t)r * RW] = yT[r];
          }
          f32x4v u = z4;
          u = __builtin_amdgcn_mfma_f32_16x16x32_bf16(sA[0], aF[0], u, 0, 0, 0);
          u = __builtin_amdgcn_mfma_f32_16x16x32_bf16(sA[1], aF[1], u, 0, 0, 0);
          cs_st4((bf16_t*)(Ub + (i0 + 4 * g) * 48 + l16 * 2), 24, u);
          const bf16x8 uF = (g < 2) ? *(const bf16x8*)(Ub + (i0 + l16) * 48 + 16 * g) : zf;
#pragma unroll
          for (int nt = 0; nt < 4; ++nt) {
            const float gm = GAM[16 * nt + l16];
            const bf16x8 bF = (g < 2) ? *(const bf16x8*)(BHT + (16 * nt + l16) * 24 + 8 * g) : zf;
            const bf16x8 gF = (g < 2) ? *(const bf16x8*)(GGT + (16 * nt + l16) * 24 + 8 * g) : zf;
            f32x4v a_ = Sacc[nt] * gm;
            a_ = __builtin_amdgcn_mfma_f32_16x16x32_bf16(uF, bF, a_, 0, 0, 0);
            a_ = __builtin_amdgcn_mfma_f32_16x16x32_bf16(vF, gF, a_, 0, 0, 0);
            Sacc[nt] = a_;
            cs_st4((bf16_t*)(Sb + (i0 + 4 * g) * 144 + (16 * nt + l16) * 2), 72, a_);
          }
          cs_post(fl_done + wid * 4 + k, seq0 + rnd + 1, lane);
        }
      }
    }
  }
  __builtin_amdgcn_s_setprio(0);
  __syncthreads();
}

DI unsigned fkey(float f) { const unsigned u = __float_as_uint(f); return (u & 0x80000000u) ? ~u : (u | 0x80000000u); }
DI int block_sum_i(int v, int* red, int wid, int lane) {
  for (int o = 32; o; o >>= 1) v += __shfl_xor(v, o);
  __syncthreads();
  if (lane == 0) red[wid] = v;
  __syncthreads();
  int s = 0;
#pragma unroll
  for (int w = 0; w < 8; ++w) s += red[w];
  return s;
}
DI void phase4b(const Params& p, int bid, int nb, char* lds) {
  const int t = tid_(), lane = t & 63, wid = t >> 6;
  float* qf = (float*)lds;
  float* wi = qf + 256;
  int* red = (int*)(wi + 4);
  int* wtie = red + 8;
  const bf16_t* proj = ws_proj(p);
  for (int gq = bid; gq < NTOK; gq += nb) {
    const int b = gq >> 11, s = gq & (SEQ - 1);
    const int n = ((s >> 6) + 1) * 64;
    unsigned* mrow = ws_mask(p) + (size_t)gq * 64;
    if (n <= 256) {
      if (t < 64) mrow[t] = (t * 32 < n) ? 0xffffffffu : 0u;
      continue;
    }
    __syncthreads();
    if (t < 256) qf[t] = bf2f(proj[(size_t)gq * PROJ_LD + C_QI + t]) * 0.125f;
    else if (t < 260) wi[t - 256] = bf2f(proj[(size_t)gq * PROJ_LD + C_WI + t - 256]) * 0.5f;
    __syncthreads();
    unsigned uk[4];
#pragma unroll 1
    for (int q = 0; q < 4; ++q) {
      const int key = t * 4 + q;
      uk[q] = 0u;
      if (key < n) {
        float kf[64];
        const bf16_t* kr = ws_kidx(p) + ((size_t)b * SEQ + key) * 64;
#pragma unroll
        for (int d8 = 0; d8 < 8; ++d8) load8(kr + d8 * 8, kf + d8 * 8);
        float sc = 0.f;
#pragma unroll
        for (int hh = 0; hh < 4; ++hh) {
          float dot = 0.f;
#pragma unroll
          for (int d4 = 0; d4 < 16; ++d4) { const f32x4 qv = *(const f32x4*)(qf + hh * 64 + d4 * 4); dot += qv[0] * kf[d4 * 4] + qv[1] * kf[d4 * 4 + 1] + qv[2] * kf[d4 * 4 + 2] + qv[3] * kf[d4 * 4 + 3]; }
          sc += wi[hh] * fmaxf(dot, 0.f);
        }
        sc = sc + 0.0f;
        uk[q] = fkey(sc);
      }
    }
    unsigned T = 0u;
    for (int bit = 31; bit >= 0; --bit) {
      const unsigned cand = T | (1u << bit);
      const int c = (uk[0] >= cand) + (uk[1] >= cand) + (uk[2] >= cand) + (uk[3] >= cand);
      if (block_sum_i(c, red, wid, lane) >= 256) T = cand;
    }
    const int cgt = block_sum_i((uk[0] > T) + (uk[1] > T) + (uk[2] > T) + (uk[3] > T), red, wid, lane);
    const int need = 256 - cgt;
    const int tl = (uk[0] == T) + (uk[1] == T) + (uk[2] == T) + (uk[3] == T);
    int incl = tl;
    for (int o = 1; o < 64; o <<= 1) { const int u = __shfl_up(incl, o); if (lane >= o) incl += u; }
    __syncthreads();
    if (lane == 63) wtie[wid] = incl;
    __syncthreads();
    int before = incl - tl;
    for (int w = 0; w < wid; ++w) before += wtie[w];
    unsigned nib = 0u;
#pragma unroll
    for (int q = 0; q < 4; ++q) {
      bool sel = uk[q] > T;
      if (uk[q] == T) { sel = before < need; ++before; }
      if (sel) nib |= 1u << q;
    }
    unsigned word = nib << ((lane & 7) * 4);
    word |= __shfl_xor(word, 1); word |= __shfl_xor(word, 2); word |= __shfl_xor(word, 4);
    if ((lane & 7) == 0) mrow[t >> 3] = word;
  }
}

constexpr int IDX_LD = 2052;
DI void phase4b_mfma(const Params& p, int bid, int nb, char* lds) {
  const int t = tid_(), lane = t & 63, wid = t >> 6, q16 = lane & 15, g = lane >> 4;
  unsigned* S = (unsigned*)lds;
  const bf16_t* proj = ws_proj(p);
  for (int task = bid; task < NTOK / 16; task += nb) {
    const int b = (task & 255) >> 4, jq = task & 15, kq = task >> 8;
    const int q0 = (((kq & 1) ? 31 - jq : jq) + 32 * (kq >> 1)) * 16;
    const int n = ((q0 >> 6) + 1) * 64, ntile = n >> 4;
    if (n <= 256) {
      unsigned short* mrow = (unsigned short*)(ws_mask(p) + (size_t)(b * SEQ + q0 + q16) * 64);
      if (g == 0) for (int kt = wid; kt < ntile; kt += 8) mrow[kt] = 0xffffu;
      continue;
    }
    const int gq = b * SEQ + q0 + q16;
    const int ntw = (ntile - wid + 7) >> 3;
    const bf16_t* kbase = ws_kidx(p) + (size_t)b * SEQ * 64 + (wid * 16 + q16) * 64 + g * 8;
    bf16x8 qf[4][2]; float wq[4];
#pragma unroll
    for (int h = 0; h < 4; ++h) {
#pragma unroll
      for (int ks = 0; ks < 2; ++ks) qf[h][ks] = *(const bf16x8*)(proj + (size_t)gq * PROJ_LD + C_QI + h * 64 + ks * 32 + g * 8);
      wq[h] = bf2f(proj[(size_t)gq * PROJ_LD + C_WI + h]) * 0.0625f;
    }
    __syncthreads();
    bf16x8 k0 = *(const bf16x8*)kbase, k1 = *(const bf16x8*)(kbase + 32);
#pragma unroll
    for (int tt = 0; tt < 16; ++tt) {
      if (tt < ntw) {
        const bf16x8 c0 = k0, c1 = k1;
        if (tt + 1 < ntw) { int koff = (tt + 1) * 8 * 16 * 64; asm volatile("" : "+v"(koff)); k0 = *(const bf16x8*)(kbase + koff); k1 = *(const bf16x8*)(kbase + koff + 32); }
        float sc[4] = {0.f, 0.f, 0.f, 0.f};
#pragma unroll
        for (int h = 0; h < 4; ++h) {
          f32x4v acc = {0.f, 0.f, 0.f, 0.f};
          acc = __builtin_amdgcn_mfma_f32_16x16x32_bf16(c0, qf[h][0], acc, 0, 0, 0);
          acc = __builtin_amdgcn_mfma_f32_16x16x32_bf16(c1, qf[h][1], acc, 0, 0, 0);
#pragma unroll
          for (int r = 0; r < 4; ++r) sc[r] += wq[h] * fmaxf(acc[r], 0.f);
        }
        u32x4 kv;
#pragma unroll
        for (int r = 0; r < 4; ++r) {
          const unsigned bts = __float_as_uint(sc[r]);
          unsigned key = bts ^ ((unsigned)((int)bts >> 31) | 0x80000000u);
          key += (key == 0x7fffffffu) ? 1u : 0u;
          kv[r] = key;
        }
        *(u32x4*)(S + q16 * IDX_LD + (wid + 8 * tt) * 16 + 4 * g) = kv;
      }
    }
    __syncthreads();
    {
      const int nreg = n >> 6;
      const int qa = 2 * wid;
      unsigned ua[32], ub[32];
#pragma unroll
      for (int j = 0; j < 32; ++j) { ua[j] = (j < nreg) ? S[qa * IDX_LD + 64 * j + lane] : 0u; ub[j] = (j < nreg) ? S[(qa + 1) * IDX_LD + 64 * j + lane] : 0u; }
      unsigned Ta = 0u, Tb = 0u; bool xa = false, xb = false;
      for (int bit = 31; bit >= 0; --bit) {
        const unsigned ca = xa ? Ta : (Ta | (1u << bit)), cb = xb ? Tb : (Tb | (1u << bit));
        int va = 0, vb = 0;
#pragma unroll
        for (int j4 = 0; j4 < 8; ++j4) {
          if (j4 * 4 < nreg) {
#pragma unroll
            for (int j = j4 * 4; j < j4 * 4 + 4; ++j) { va += (ua[j] >= ca) ? 1 : 0; vb += (ub[j] >= cb) ? 1 : 0; }
          }
        }
        int vab = va | (vb << 16);
        vab += __builtin_amdgcn_update_dpp(0, vab, 0xB1, 0xF, 0xF, true);
        vab += __builtin_amdgcn_update_dpp(0, vab, 0x4E, 0xF, 0xF, true);
        vab += __builtin_amdgcn_update_dpp(0, vab, 0x141, 0xF, 0xF, true);
        vab += __builtin_amdgcn_update_dpp(0, vab, 0x140, 0xF, 0xF, true);
        const int tot = __builtin_amdgcn_readlane(vab, 0) + __builtin_amdgcn_readlane(vab, 16) + __builtin_amdgcn_readlane(vab, 32) + __builtin_amdgcn_readlane(vab, 48);
        const int na = tot & 0xffff, nq = tot >> 16;
        if (!xa && na >= 256) { Ta = ca; xa = (na == 256); }
        if (!xb && nq >= 256) { Tb = cb; xb = (nq == 256); }
        if (xa && xb) break;
      }
#pragma unroll 1
      for (int which = 0; which < 2; ++which) {
        const unsigned T = which ? Tb : Ta;
        int cgt = 0;
#pragma unroll
        for (int j = 0; j < 32; ++j) cgt += __popcll(__ballot((which ? ub[j] : ua[j]) > T));
        int need = 256 - cgt;
        unsigned* mrow = ws_mask(p) + (size_t)(b * SEQ + q0 + qa + which) * 64;
#pragma unroll
        for (int j = 0; j < 32; ++j) {
          if (j < nreg) {
            const unsigned uv = which ? ub[j] : ua[j];
            unsigned long long sel = __ballot(uv > T);
            const unsigned long long eq = __ballot(uv == T);
            const int pe = __popcll(eq);
            if (pe <= need) { sel |= eq; need -= pe; }
            else { unsigned long long e = eq; for (int i = 0; i < need; ++i) { const unsigned long long low = e & (0ull - e); sel |= low; e ^= low; } need = 0; }
            if (lane == 0) { mrow[2 * j] = (unsigned)sel; mrow[2 * j + 1] = (unsigned)(sel >> 32); }
          }
        }
      }
    }
  }
}

DI void phase5a(const Params& p, int bid, int nb, char* lds) {
  const int lane = tid_() & 63, wid = tid_() >> 6;
  const bf16_t* proj = ws_proj(p);
  for (int gt = bid * 8 + wid; gt < NTOK; gt += nb * 8) {
    const int c0 = lane * 8, h = lane >> 3;
    const f32x4 y0 = *(const f32x4*)(ws_y(p) + (size_t)gt * RW + c0), y1 = *(const f32x4*)(ws_y(p) + (size_t)gt * RW + c0 + 4);
    float y[8] = {y0[0], y0[1], y0[2], y0[3], y1[0], y1[1], y1[2], y1[3]};
    float s = 0.f;
#pragma unroll
    for (int j = 0; j < 8; ++j) s += y[j];
    s += __shfl_xor(s, 1); s += __shfl_xor(s, 2); s += __shfl_xor(s, 4);
    const float mean = s * (1.0f / 64.0f);
    float q = 0.f;
#pragma unroll
    for (int j = 0; j < 8; ++j) { const float d = y[j] - mean; q += d * d; }
    q += __shfl_xor(q, 1); q += __shfl_xor(q, 2); q += __shfl_xor(q, 4);
    const float rstd = rsqrtf(q * (1.0f / 64.0f) + 64e-5f);
    float g[8], vr[8], vp[8];
    load8(ws_gg(p) + (size_t)gt * RW + c0, g);
    load8(proj + (size_t)gt * PROJ_LD + C_V + c0, vr);
    if (gt & (SEQ - 1)) load8(proj + (size_t)(gt - 1) * PROJ_LD + C_V + c0, vp);
    else {
#pragma unroll
      for (int j = 0; j < 8; ++j) vp[j] = 0.f;
    }
    const float bs = ws_bonus(p)[gt * NH + h];
    float o[8];
#pragma unroll
    for (int j = 0; j < 8; ++j) {
      const float v = vr[j] + p.shift_mu[C_V + c0 + j] * (vp[j] - vr[j]);
      o[j] = ((y[j] - mean) * rstd * p.gn_g[c0 + j] + p.gn_b[c0 + j] + bs * v) * g[j];
    }
    u32x4 w; w.x = pack2(o[0], o[1]); w.y = pack2(o[2], o[3]); w.z = pack2(o[4], o[5]); w.w = pack2(o[6], o[7]);
    *(u32x4*)(ws_mix(p) + (size_t)gt * DM + c0) = w;
  }
}

DI void phase5b(const Params& p, int bid, int nb, char* lds) {
  const int t = tid_(), lane = t & 63, wid = t >> 6;
  float* ql = (float*)lds;
  float* pr = ql + 1024;
  float* ol = pr + 2048;
  int* sel = (int*)(ol + 1024);
  int* nselp = sel + 256;
  for (int gq = bid; gq < NTOK; gq += nb) {
    const int b = gq >> 11;
    const bf16_t* ckv = ws_ckv(p) + (size_t)b * SEQ * 128;
    __syncthreads();
    for (int idx = t; idx < 1024; idx += NTHR) ql[idx] = bf2f(ws_qlat(p)[(size_t)gq * 1024 + idx]);
    if (wid == 0) {
      const int nadm = (((gq & (SEQ - 1)) >> 6) + 1) * 64;
      const unsigned word = (lane * 32 < nadm) ? ws_mask(p)[(size_t)gq * 64 + lane] : 0u;
      const int cnt = __popc(word);
      int incl = cnt;
      for (int o = 1; o < 64; o <<= 1) { const int u = __shfl_up(incl, o); if (lane >= o) incl += u; }
      int pos = incl - cnt;
      unsigned w = word;
      while (w) { const int bit = __ffs(w) - 1; w &= w - 1; if (pos < 256) sel[pos] = lane * 32 + bit; ++pos; }
      if (lane == 63) *nselp = incl < 256 ? incl : 256;
    }
    __syncthreads();
    const int nsel = *nselp;
    const int h = wid;
    float lg[4]; float mx = -1e30f;
#pragma unroll
    for (int q = 0; q < 4; ++q) {
      const int slot = lane + 64 * q;
      lg[q] = -1e30f;
      if (slot < nsel) {
        const bf16_t* kr = ckv + (size_t)sel[slot] * 128;
        float acc = 0.f;
#pragma unroll
        for (int d8 = 0; d8 < 16; ++d8) {
          float kf[8]; load8(kr + d8 * 8, kf);
          const f32x4 q0 = *(const f32x4*)(ql + h * 128 + d8 * 8), q1 = *(const f32x4*)(ql + h * 128 + d8 * 8 + 4);
          acc += q0[0] * kf[0] + q0[1] * kf[1] + q0[2] * kf[2] + q0[3] * kf[3] + q1[0] * kf[4] + q1[1] * kf[5] + q1[2] * kf[6] + q1[3] * kf[7];
        }
        lg[q] = acc;
      }
      mx = fmaxf(mx, lg[q]);
    }
    mx = wave_max(mx);
    float sm = 0.f;
#pragma unroll
    for (int q = 0; q < 4; ++q) { lg[q] = (lane + 64 * q < nsel) ? __expf(lg[q] - mx) : 0.f; sm += lg[q]; }
    sm = wave_sum(sm);
    const float inv = 1.0f / sm;
#pragma unroll
    for (int q = 0; q < 4; ++q) pr[h * 256 + lane + 64 * q] = lg[q] * inv;
    __syncthreads();
    {
      float o0 = 0.f, o1 = 0.f;
      for (int slot = 0; slot < nsel; ++slot) {
        const unsigned kv2 = *(const unsigned*)(ckv + (size_t)sel[slot] * 128 + lane * 2);
        const float pp = pr[h * 256 + slot];
        o0 += pp * __uint_as_float(kv2 << 16); o1 += pp * __uint_as_float(kv2 & 0xffff0000u);
      }
      ol[h * 128 + lane * 2] = o0; ol[h * 128 + lane * 2 + 1] = o1;
    }
    __syncthreads();
    {
      float acc = 0.f;
      for (int cc = 0; cc < 128; ++cc) acc += ol[h * 128 + cc] * p.w_uv[(size_t)(cc * NH + h) * HD + lane];
      ws_mix(p)[(size_t)gq * DM + RW + h * HD + lane] = f2bf(acc);
    }
  }
}

typedef short s16x4 __attribute__((ext_vector_type(4)));
#define KSWZ(row, colB) ((row) * 256 + ((colB) ^ (((row) & 7) << 4)))
DI int v_st(int k, int c) { const int kk = (k & ~0xC) | ((k & 4) << 1) | ((k & 8) >> 1); return ((kk >> 3) * 4 + (c >> 5)) * 512 + ((kk & 7) * 32 + (c & 31)) * 2; }
DI int v_rd_base(int lane) { return ((lane & 3) << 3) | (((lane >> 2) & 3) << 6) | (((lane >> 4) & 1) << 5) | (((lane >> 5) & 1) << 8); }
constexpr int v_rd_off(int d0, int ks, int half) { return d0 * 512 + ks * 4096 + half * 2048; }
template <int OFF> DI s16x4 tr_read(int vb) { s16x4 r; asm volatile("ds_read_b64_tr_b16 %0, %1 offset:%2" : "=&v"(r) : "v"(vb), "i"(OFF) : "memory"); return r; }
template <int D0> DI void pv_one(f32x16& od, int vb, bf16x8 pa0, bf16x8 pa1, bf16x8 pa2, bf16x8 pa3) {
  const s16x4 l0 = tr_read<v_rd_off(D0, 0, 0)>(vb), h0 = tr_read<v_rd_off(D0, 0, 1)>(vb), l1 = tr_read<v_rd_off(D0, 1, 0)>(vb), h1 = tr_read<v_rd_off(D0, 1, 1)>(vb);
  const s16x4 l2 = tr_read<v_rd_off(D0, 2, 0)>(vb), h2 = tr_read<v_rd_off(D0, 2, 1)>(vb), l3 = tr_read<v_rd_off(D0, 3, 0)>(vb), h3 = tr_read<v_rd_off(D0, 3, 1)>(vb);
  asm volatile("s_waitcnt lgkmcnt(0)" ::: "memory"); __builtin_amdgcn_sched_barrier(0);
#define PKV(L, H) (bf16x8){L[0], L[1], L[2], L[3], H[0], H[1], H[2], H[3]}
  od = __builtin_amdgcn_mfma_f32_32x32x16_bf16(pa0, PKV(l0, h0), od, 0, 0, 0);
  od = __builtin_amdgcn_mfma_f32_32x32x16_bf16(pa1, PKV(l1, h1), od, 0, 0, 0);
  od = __builtin_amdgcn_mfma_f32_32x32x16_bf16(pa2, PKV(l2, h2), od, 0, 0, 0);
  od = __builtin_amdgcn_mfma_f32_32x32x16_bf16(pa3, PKV(l3, h3), od, 0, 0, 0);
#undef PKV
}
constexpr int ATT_TILE = 64 * 128 * 2;
constexpr int ATT_LDS = 4 * ATT_TILE + 8 * 64 * 4;
DI void phase5b_mfma(const Params& p, int bid, int nb, char* lds) {
  const int t = tid_(), lane = t & 63, wid = t >> 6, r32 = lane & 31, hi = lane >> 5;
  char* V_lds = lds; char* K_lds = lds + 2 * ATT_TILE;
  float* al_l = (float*)(lds + 4 * ATT_TILE) + wid * 64; float* li_l = al_l + 32;
  const int sr = t >> 4, sc = (t & 15) * 8;
  const int vst0 = v_st(sr, sc), vst1 = v_st(32 + sr, sc), kst0 = KSWZ(sr, sc * 2), kst1 = KSWZ(32 + sr, sc * 2);
  const int vb0 = (int)(uintptr_t)V_lds + v_rd_base(lane);
  const int h = wid;
  constexpr float LOG2E = 1.4426950408889634f, THR = 8.0f;
  for (int task = bid; task < NTOK / 32; task += nb) {
    const int b = (task & 255) >> 4;
    int qt; { const int j = task & 15, k = task >> 8; qt = (k == 0) ? j : (k == 1) ? 31 - j : (k == 2) ? 32 + j : 63 - j; }
    const int q0 = qt * 32, n = ((q0 >> 6) + 1) * 64, NT = n >> 6;
    const int gq = b * SEQ + q0 + r32;
    const bf16_t* ckv = ws_ckv(p) + (size_t)b * SEQ * 128;
    const unsigned* mrow = ws_mask(p) + (size_t)gq * 64;
    bf16x8 qr[8];
    {
      f32x16 qa[4];
#pragma unroll
      for (int mt = 0; mt < 4; ++mt)
#pragma unroll
        for (int r = 0; r < 16; ++r) qa[mt][r] = 0.f;
      const bf16_t* wuk = ws_wukt(p) + (size_t)h * 8192 + lane * 8;
#pragma unroll
      for (int ks = 0; ks < 4; ++ks) {
        const bf16x8 bq = *(const bf16x8*)(ws_proj(p) + (size_t)gq * PROJ_LD + C_Q + h * HD + ks * 16 + hi * 8);
#pragma unroll
        for (int mt = 0; mt < 4; ++mt) { const bf16x8 aw = *(const bf16x8*)(wuk + (mt * 4 + ks) * 512); qa[mt] = __builtin_amdgcn_mfma_f32_32x32x16_bf16(aw, bq, qa[mt], 0, 0, 0); }
      }
#define QPK(P, BASE, OUT) do { unsigned a0 = cvtpk(P[BASE + 0] * 0.125f, P[BASE + 1] * 0.125f), a1 = cvtpk(P[BASE + 2] * 0.125f, P[BASE + 3] * 0.125f);   \
    unsigned b0 = cvtpk(P[BASE + 4] * 0.125f, P[BASE + 5] * 0.125f), b1 = cvtpk(P[BASE + 6] * 0.125f, P[BASE + 7] * 0.125f);                              \
    auto r0 = __builtin_amdgcn_permlane32_swap(a0, b0, false, false); auto r1 = __builtin_amdgcn_permlane32_swap(a1, b1, false, false); \
    u32x4 w = {r0[0], r1[0], r0[1], r1[1]}; OUT = *reinterpret_cast<bf16x8*>(&w); } while (0)
#pragma unroll
      for (int mt = 0; mt < 4; ++mt) { QPK(qa[mt], 0, qr[2 * mt]); QPK(qa[mt], 8, qr[2 * mt + 1]); }
#undef QPK
    }
    float m_reg = -1e30f, l_reg = 0.f;
    f32x16 o[4];
#pragma unroll
    for (int d = 0; d < 4; ++d)
#pragma unroll
      for (int r = 0; r < 16; ++r) o[d][r] = 0.f;
    u32x4 s0 = *(const u32x4*)(ckv + (size_t)sr * 128 + sc), s1 = *(const u32x4*)(ckv + (size_t)(32 + sr) * 128 + sc);
    __syncthreads();
    *(u32x4*)(V_lds + vst0) = s0; *(u32x4*)(V_lds + vst1) = s1; *(u32x4*)(K_lds + kst0) = s0; *(u32x4*)(K_lds + kst1) = s1;
    __syncthreads();
    unsigned mw0 = mrow[0], mw1 = mrow[1];
    for (int j = 0; j < NT; ++j) {
      const int buf = j & 1;
      const unsigned w0 = mw0 >> (4 * hi), w1 = mw1 >> (4 * hi);
      if (j + 1 < NT) { mw0 = mrow[2 * j + 2]; mw1 = mrow[2 * j + 3]; }
      if (j + 1 < NT) { s0 = *(const u32x4*)(ckv + (size_t)((j + 1) * 64 + sr) * 128 + sc); s1 = *(const u32x4*)(ckv + (size_t)((j + 1) * 64 + 32 + sr) * 128 + sc); }
      f32x16 p0, p1;
#pragma unroll
      for (int r = 0; r < 16; ++r) { p0[r] = 0.f; p1[r] = 0.f; }
      const char* Kb = K_lds + buf * ATT_TILE;
#pragma unroll
      for (int d0 = 0; d0 < 8; ++d0) {
        const int cb = (d0 * 16 + hi * 8) * 2;
        const bf16x8 b0 = *(const bf16x8*)(Kb + KSWZ(r32, cb)), b1 = *(const bf16x8*)(Kb + KSWZ(32 + r32, cb));
        p0 = __builtin_amdgcn_mfma_f32_32x32x16_bf16(b0, qr[d0], p0, 0, 0, 0);
        p1 = __builtin_amdgcn_mfma_f32_32x32x16_bf16(b1, qr[d0], p1, 0, 0, 0);
      }
      float pmax = p0[0];
#pragma unroll
      for (int r = 1; r < 16; ++r) pmax = fmaxf(pmax, p0[r]);
#pragma unroll
      for (int r = 0; r < 16; ++r) pmax = fmaxf(pmax, p1[r]);
      { auto rr = __builtin_amdgcn_permlane32_swap(__float_as_uint(pmax), __float_as_uint(pmax), false, false); pmax = fmaxf(__uint_as_float(rr[0]), __uint_as_float(rr[1])); }
      float alpha = 1.f;
      if (!__all(pmax - m_reg <= THR)) { const float mn = fmaxf(m_reg, pmax); alpha = __builtin_amdgcn_exp2f((m_reg - mn) * LOG2E); m_reg = mn; }
      const float mnC = -m_reg * LOG2E;
      float ps = 0.f;
#pragma unroll
      for (int r = 0; r < 16; ++r) {
        const int bitp = (r & 3) + 8 * (r >> 2);
        float e0 = __builtin_amdgcn_exp2f(fmaf(p0[r], LOG2E, mnC)), e1 = __builtin_amdgcn_exp2f(fmaf(p1[r], LOG2E, mnC));
        e0 = ((w0 >> bitp) & 1u) ? e0 : 0.f; e1 = ((w1 >> bitp) & 1u) ? e1 : 0.f;
        p0[r] = e0; p1[r] = e1; ps += e0 + e1;
      }
      { auto rr = __builtin_amdgcn_permlane32_swap(__float_as_uint(ps), __float_as_uint(ps), false, false); ps = __uint_as_float(rr[0]) + __uint_as_float(rr[1]); }
      l_reg = l_reg * alpha + ps;
      if (__any(alpha < 1.f)) {
        if (hi == 0) al_l[r32] = alpha;
        asm volatile("s_waitcnt lgkmcnt(0)" ::: "memory");
#pragma unroll
        for (int d = 0; d < 4; ++d)
#pragma unroll
          for (int r = 0; r < 16; ++r) o[d][r] *= al_l[crow(r, hi)];
      }
      bf16x8 pa0, pa1, pa2, pa3;
#define PK4(P, BASE, OUT) do { unsigned a0 = cvtpk(P[BASE + 0], P[BASE + 1]), a1 = cvtpk(P[BASE + 2], P[BASE + 3]);   \
    unsigned b0 = cvtpk(P[BASE + 4], P[BASE + 5]), b1 = cvtpk(P[BASE + 6], P[BASE + 7]);                              \
    auto r0 = __builtin_amdgcn_permlane32_swap(a0, b0, false, false); auto r1 = __builtin_amdgcn_permlane32_swap(a1, b1, false, false); \
    u32x4 w = {r0[0], r1[0], r0[1], r1[1]}; OUT = *reinterpret_cast<bf16x8*>(&w); } while (0)
      PK4(p0, 0, pa0); PK4(p0, 8, pa1); PK4(p1, 0, pa2); PK4(p1, 8, pa3);
#undef PK4
      const int vb = vb0 + buf * ATT_TILE;
      pv_one<0>(o[0], vb, pa0, pa1, pa2, pa3); pv_one<1>(o[1], vb, pa0, pa1, pa2, pa3); pv_one<2>(o[2], vb, pa0, pa1, pa2, pa3); pv_one<3>(o[3], vb, pa0, pa1, pa2, pa3);
      if (j + 1 < NT) {
        char* Vn = V_lds + (buf ^ 1) * ATT_TILE; char* Kn = K_lds + (buf ^ 1) * ATT_TILE;
        *(u32x4*)(Vn + vst0) = s0; *(u32x4*)(Vn + vst1) = s1; *(u32x4*)(Kn + kst0) = s0; *(u32x4*)(Kn + kst1) = s1;
      }
      __syncthreads();
    }
    if (hi == 0) li_l[r32] = l_reg;
    asm volatile("s_waitcnt lgkmcnt(0)" ::: "memory");
    int hio = hi, r32o = r32;
    asm volatile("" : "+v"(hio), "+v"(r32o));
    char* Ow = lds + wid * 8192;
#pragma unroll
    for (int r = 0; r < 16; ++r) {
      const int row = crow(r, hio); const float rl = 1.0f / li_l[row];
#pragma unroll
      for (int d = 0; d < 4; ++d) *(bf16_t*)(Ow + KSWZ(row, (d * 32 + r32o) * 2)) = f2bf(o[d][r] * rl);
    }
    asm volatile("s_waitcnt lgkmcnt(0)" ::: "memory");
    f32x16 oa[2];
#pragma unroll
    for (int i = 0; i < 2; ++i)
#pragma unroll
      for (int r = 0; r < 16; ++r) oa[i][r] = 0.f;
    const bf16_t* wuv = ws_wuvt(p) + (size_t)h * 8192 + (hio * 32 + r32o) * 8;
#pragma unroll
    for (int ks = 0; ks < 8; ++ks) {
      const bf16x8 a = *(const bf16x8*)(Ow + KSWZ(r32o, (ks * 16 + hio * 8) * 2));
#pragma unroll
      for (int i = 0; i < 2; ++i) {
        const bf16x8 bw = *(const bf16x8*)(wuv + (i * 8 + ks) * 512);
        oa[i] = __builtin_amdgcn_mfma_f32_32x32x16_bf16(a, bw, oa[i], 0, 0, 0);
      }
    }
    bf16_t* mx = ws_mix(p) + (size_t)(b * SEQ + q0 + 4 * hio) * DM + RW + h * HD + r32o;
#pragma unroll
    for (int i = 0; i < 2; ++i)
#pragma unroll
      for (int r = 0; r < 16; ++r) mx[((r & 3) + 8 * (r >> 2)) * DM + i * 32] = f2bf(oa[i][r]);
  }
}

struct EpiOut { const float* x; const float* mod; float* o; int row0, col0; DI void operator()(int r, int c, float v0, float v1) const {
  const int row = row0 + r, col = col0 + c, b = row >> 11; const size_t idx = (size_t)row * DM + col;
  o[idx] = x[idx] + (1.0f + mod[b * 6144 + 2048 + col]) * v0; o[idx + 32] = x[idx + 32] + (1.0f + mod[b * 6144 + 2048 + col + 32]) * v1; } };
DI void phase6(const Params& p, int bid, int nb, char* lds) {
  constexpr int NT = DM / GBN;
  for (int tile = bid; tile < (NTOK / GBM) * NT; tile += nb) {
    const int mt = tile / NT, nt = tile % NT;
    gemm_tile(ws_mix(p), DM, ARowBase{mt * GBM}, ws_wtout(p), DM, nt * GBN, DM, EpiOut{p.x, ws_mod(p), p.out, mt * GBM, nt * GBN}, lds);
  }
}

namespace pg8 {
#define PG8_LAS __attribute__((address_space(3)))
constexpr int BM = 256, BK = 64, HALF = 128, HTB = HALF * BK * 2  , STAGE_BYTES = 8 * HTB, NXCD = 8, WGM = 8;

__host__ __device__ __forceinline__ int lds_byte(int r, int c) { const int st = (r >> 4) * 2 + (c >> 5), rr = r & 15, cc = c & 31, ob = rr * 64 + cc * 2; return st * 1024 + (ob ^ (((ob >> 9) & 1) << 5)); }
__host__ __device__ __forceinline__ void stage_rc(int b, int& R, int& C) { const int st = b / 1024, sb = b % 1024, swz = sb ^ (((sb >> 9) & 1) << 5); R = (st >> 1) * 16 + swz / 64; C = (st & 1) * 32 + (swz % 64) / 2; }
__host__ __device__ __forceinline__ int perm32(int rho) { const int n = rho >> 4, i = rho & 15; return 8 * (i >> 2) + 4 * n + (i & 3); }

struct Unit { int pm, pn, e; };
struct Gemm { const bf16_t* A; const bf16_t* Bt; int M, N, K; size_t bstride; };

struct StaticOrder {
    static constexpr bool GATHER = false;
    int nM, nN, nwg, G, c;
    __host__ __device__ void init(int M, int N, int G_, int c_) { nM = M / BM; nN = N / BM; nwg = nM * nN; G = G_; c = c_; }
    __host__ __device__ bool next(int i, Unit& u) const {
        const long L = (long)i * G + c; if (L >= nwg) return false;
        int wgid = (int)L; { const int q = nwg / NXCD, r = nwg % NXCD, xcd = wgid % NXCD, off = wgid / NXCD; wgid = (xcd < r ? xcd * (q + 1) : r * (q + 1) + (xcd - r) * q) + off; }
        const int nig = WGM * nN, gid = wgid / nig, fm = gid * WGM, gsz = (nM - fm) < WGM ? (nM - fm) : WGM;
        u.pm = fm + ((wgid % nig) % gsz); u.pn = (wgid % nig) / gsz; u.e = 0; return true;
    }
    __device__ __forceinline__ void a_ready(const Unit&) const {}
    __device__ __forceinline__ void done(const Unit&) const {}
    __device__ __forceinline__ int arow(const Unit&, int) const { return 0; }
};
template <class Epi, class Sched, bool ALIGN_EPI = false, bool SP2 = false>
__device__ __forceinline__ void gemm_phase(PG8_LAS unsigned char* lds, const Gemm g, const Sched& S, const Epi& E) {
    const int tid = threadIdx.x, wid = __builtin_amdgcn_readfirstlane(tid >> 6), lane = tid & 63, wr = wid >> 2, wc = wid & 3, fr = lane & 15, fq = lane >> 4;
    const int K = g.K, nt = K / BK;
    unsigned voffA[2], voffB[2];
#pragma unroll
    for (int i = 0; i < 2; ++i) { int R, C; stage_rc(tid * 16 + i * 8192, R, C); const int Rb = Epi::PERM ? ((R & ~31) + perm32(R & 31)) : R;
        voffA[i] = (unsigned)(R * K + C) * 2u; voffB[i] = (unsigned)(Rb * K + C) * 2u; }
    unsigned vAc[2][2], vAn[2][2];
    const size_t kstep = (size_t)(BK * 2);
    const size_t hstep = (size_t)HALF * K * 2;
    const size_t tstep = 2 * hstep;
    const unsigned ldsw = (unsigned)wid * 1024u;
    const int aoff = lds_byte(wr * 64 + fr, fq * 8), boff = lds_byte(wc * 32 + fr, fq * 8);
#define PG8_SA(b, h) (((b) * 2 + (h)) * HTB)
#define PG8_SB(b, h) ((4 + (b) * 2 + (h)) * HTB)
#define PG8_STAGE(bufoff, gbase, voff) do { _Pragma("unroll") for (int _i = 0; _i < 2; ++_i) \
        __builtin_amdgcn_global_load_lds((const unsigned*)((const char*)(gbase) + (voff)[_i]), (PG8_LAS unsigned*)(lds + (bufoff) + ldsw + _i * 8192), 16, 0, 0); } while (0)
#define PG8_STAGE_A(bufoff, gbase, v0_, v1_) do { \
        __builtin_amdgcn_global_load_lds((const unsigned*)((const char*)(gbase) + (v0_)), (PG8_LAS unsigned*)(lds + (bufoff) + ldsw), 16, 0, 0); \
        __builtin_amdgcn_global_load_lds((const unsigned*)((const char*)(gbase) + (v1_)), (PG8_LAS unsigned*)(lds + (bufoff) + ldsw + 8192), 16, 0, 0); } while (0)
#define PG8_AOFF(u_, dst_) do { if constexpr (Sched::GATHER) { _Pragma("unroll") for (int h_ = 0; h_ < 2; ++h_) _Pragma("unroll") for (int i_ = 0; i_ < 2; ++i_) { int R_, C_; stage_rc(tid * 16 + i_ * 8192, R_, C_); \
            dst_[h_][i_] = (unsigned)(S.arow(u_, h_ * HALF + R_) * K + C_) * 2u; } asm volatile("s_waitcnt vmcnt(0)" ::: "memory"); } \
        else { _Pragma("unroll") for (int h_ = 0; h_ < 2; ++h_) _Pragma("unroll") for (int i_ = 0; i_ < 2; ++i_) dst_[h_][i_] = voffA[i_] + (unsigned)(h_ * hstep); } } while (0)
#define PG8_LDA(dst, b, h) do { _Pragma("unroll") for (int m = 0; m < 4; ++m) _Pragma("unroll") for (int k = 0; k < 2; ++k) dst[m][k] = *(const PG8_LAS bf16x8*)(lds + PG8_SA(b, h) + aoff + m * 2048 + k * 1024); } while (0)
#define PG8_LDB(dst, b, h) do { _Pragma("unroll") for (int n = 0; n < 2; ++n) _Pragma("unroll") for (int k = 0; k < 2; ++k) dst[n][k] = *(const PG8_LAS bf16x8*)(lds + PG8_SB(b, h) + boff + n * 2048 + k * 1024); } while (0)
#define PG8_MMA(ai, bj, At, Bt) do { __builtin_amdgcn_s_setprio(1); _Pragma("unroll") for (int m = 0; m < 4; ++m) _Pragma("unroll") for (int n = 0; n < 2; ++n) _Pragma("unroll") for (int k = 0; k < 2; ++k) \
        acc[ai][bj][m][n] = __builtin_amdgcn_mfma_f32_16x16x32_bf16(Bt[n][k], At[m][k], acc[ai][bj][m][n], 0, 0, 0); __builtin_amdgcn_s_setprio(0); } while (0)
#define PG8_WAIT_V(n) asm volatile("s_waitcnt vmcnt(" #n ")" ::: "memory")
#define PG8_WAIT_L(n) asm volatile("s_waitcnt lgkmcnt(" #n ")" ::: "memory")
#define PG8_BAR __builtin_amdgcn_s_barrier()
#define PG8_SCHED __builtin_amdgcn_sched_barrier(0)
    Unit cur, nxt; int ui = 0;
    if (!S.next(0, cur)) return;
    f32x4 acc[2][2][4][2];
#pragma unroll
    for (int a = 0; a < 2; ++a)
#pragma unroll
        for (int b = 0; b < 2; ++b)
#pragma unroll
            for (int m = 0; m < 4; ++m)
#pragma unroll
                for (int n = 0; n < 2; ++n) acc[a][b][m][n] = (f32x4){0.f, 0.f, 0.f, 0.f};
    bf16x8 At[4][2], B0[2][2], B1[2][2];
    const char* cA = Sched::GATHER ? (const char*)g.A : (const char*)g.A + (size_t)cur.pm * tstep; PG8_AOFF(cur, vAc); const char* cB = (const char*)g.Bt + (size_t)cur.e * g.bstride + (size_t)cur.pn * tstep;
    S.a_ready(cur);
    if constexpr (SP2) {
        PG8_STAGE(PG8_SB(0, 0), cB, voffB); PG8_STAGE(PG8_SB(0, 1), cB + hstep, voffB); PG8_STAGE_A(PG8_SA(0, 0), cA, vAc[0][0], vAc[0][1]); PG8_STAGE_A(PG8_SA(0, 1), cA, vAc[1][0], vAc[1][1]);
        if (wr == 1) PG8_BAR;
        PG8_WAIT_V(2); PG8_BAR;
        PG8_STAGE(PG8_SB(1, 0), cB + kstep, voffB); PG8_STAGE_A(PG8_SA(1, 0), cA + kstep, vAc[0][0], vAc[0][1]); PG8_STAGE(PG8_SB(1, 1), cB + hstep + kstep, voffB);
        PG8_WAIT_V(6); PG8_BAR;
    } else {
        PG8_STAGE(PG8_SB(0, 0), cB, voffB); PG8_STAGE(PG8_SA(0, 0), cA, voffA); PG8_STAGE(PG8_SB(0, 1), cB + hstep, voffB); PG8_STAGE(PG8_SA(0, 1), cA + hstep, voffA);
        if (wr == 1) PG8_BAR;
        PG8_WAIT_V(4); PG8_BAR;
        PG8_STAGE(PG8_SB(1, 0), cB + kstep, voffB); PG8_STAGE(PG8_SA(1, 0), cA + kstep, voffA); PG8_STAGE(PG8_SB(1, 1), cB + hstep + kstep, voffB);
        PG8_WAIT_V(6); PG8_BAR;
    }
    for (;;) {
        const bool has_next = S.next(ui + 1, nxt);
        const char* nA = (has_next && !Sched::GATHER) ? (const char*)g.A + (size_t)nxt.pm * tstep : cA;
        if (has_next) PG8_AOFF(nxt, vAn); else { _Pragma("unroll") for (int h_ = 0; h_ < 2; ++h_) _Pragma("unroll") for (int i_ = 0; i_ < 2; ++i_) vAn[h_][i_] = vAc[h_][i_]; }
        const char* nB = has_next ? (const char*)g.Bt + (size_t)nxt.e * g.bstride + (size_t)nxt.pn * tstep : cB;
        for (int t = 0; t < nt; t += 2) {
            const bool last = (t == nt - 2);
            const char* a1 = cA + (size_t)(t + 1) * kstep;
            const char* a2 = last ? nA : cA + (size_t)(t + 2) * kstep; const char* b2 = last ? nB : cB + (size_t)(t + 2) * kstep;
            const char* a3 = a2 + kstep; const char* b3 = b2 + kstep;
            if (last && has_next) S.a_ready(nxt);
            if constexpr (SP2) {
            PG8_LDB(B0, 0, 0); PG8_LDB(B1, 0, 1); PG8_SCHED; PG8_LDA(At, 0, 0); PG8_STAGE_A(PG8_SA(1, 1), a1, vAc[1][0], vAc[1][1]);
            PG8_WAIT_V(8); PG8_WAIT_L(0); PG8_BAR; PG8_MMA(0, 0, At, B0); PG8_MMA(0, 1, At, B1); PG8_BAR; PG8_SCHED;
            PG8_LDA(At, 0, 1); PG8_STAGE(PG8_SB(0, 0), b2, voffB); PG8_STAGE(PG8_SB(0, 1), b2 + hstep, voffB); PG8_STAGE_A(PG8_SA(0, 0), a2, last ? vAn[0][0] : vAc[0][0], last ? vAn[0][1] : vAc[0][1]);
            PG8_WAIT_V(8); PG8_WAIT_L(0); PG8_BAR; PG8_MMA(1, 0, At, B0); PG8_MMA(1, 1, At, B1); PG8_BAR; PG8_SCHED;
            PG8_LDB(B0, 1, 0); PG8_LDB(B1, 1, 1); PG8_SCHED; PG8_LDA(At, 1, 0); PG8_STAGE_A(PG8_SA(0, 1), a2, last ? vAn[1][0] : vAc[1][0], last ? vAn[1][1] : vAc[1][1]);
            PG8_WAIT_V(8); PG8_WAIT_L(0); PG8_BAR; PG8_MMA(0, 0, At, B0); PG8_MMA(0, 1, At, B1); PG8_BAR; PG8_SCHED;
            PG8_LDA(At, 1, 1); PG8_STAGE(PG8_SB(1, 0), b3, voffB); PG8_STAGE(PG8_SB(1, 1), b3 + hstep, voffB); PG8_STAGE_A(PG8_SA(1, 0), a3, last ? vAn[0][0] : vAc[0][0], last ? vAn[0][1] : vAc[0][1]);
            PG8_WAIT_V(8); PG8_WAIT_L(0); PG8_BAR; PG8_MMA(1, 0, At, B0); PG8_MMA(1, 1, At, B1); PG8_BAR; PG8_SCHED;
            } else {
            PG8_LDB(B0, 0, 0); PG8_SCHED; PG8_LDA(At, 0, 0); PG8_STAGE(PG8_SA(1, 1), a1 + hstep, voffA);
            PG8_WAIT_L(8); PG8_BAR; PG8_WAIT_L(0); PG8_MMA(0, 0, At, B0); PG8_BAR; PG8_SCHED;
            PG8_LDB(B1, 0, 1); PG8_STAGE(PG8_SB(0, 0), b2, voffB);
            PG8_BAR; PG8_WAIT_L(0); PG8_MMA(0, 1, At, B1); PG8_BAR;
            PG8_LDA(At, 0, 1); PG8_STAGE(PG8_SA(0, 0), a2, voffA);
            PG8_BAR; PG8_WAIT_L(0); PG8_MMA(1, 0, At, B0); PG8_BAR; PG8_SCHED;
            PG8_STAGE(PG8_SB(0, 1), b2 + hstep, voffB);
            PG8_WAIT_V(6); PG8_BAR; PG8_MMA(1, 1, At, B1); PG8_BAR;
            PG8_LDB(B0, 1, 0); PG8_SCHED; PG8_LDA(At, 1, 0); PG8_STAGE(PG8_SA(0, 1), a2 + hstep, voffA);
            PG8_WAIT_L(8); PG8_BAR; PG8_WAIT_L(0); PG8_MMA(0, 0, At, B0); PG8_BAR; PG8_SCHED;
            PG8_LDB(B1, 1, 1); PG8_STAGE(PG8_SB(1, 0), b3, voffB);
            PG8_BAR; PG8_WAIT_L(0); PG8_MMA(0, 1, At, B1); PG8_BAR;
            PG8_LDA(At, 1, 1); PG8_STAGE(PG8_SA(1, 0), a3, voffA);
            PG8_BAR; PG8_WAIT_L(0); PG8_MMA(1, 0, At, B0); PG8_BAR; PG8_SCHED;
            PG8_STAGE(PG8_SB(1, 1), b3 + hstep, voffB);
            PG8_WAIT_V(6); PG8_BAR; PG8_MMA(1, 1, At, B1); PG8_BAR;
            }
        }
        if constexpr (ALIGN_EPI) { if (wr == 0) PG8_BAR; }
        if constexpr (!Epi::AFTER_DRAIN) { E(acc, cur, wr, wc, fr, fq); S.done(cur); }
        if (!has_next) break;
#pragma unroll
        for (int a = 0; a < 2; ++a)
#pragma unroll
            for (int b = 0; b < 2; ++b)
#pragma unroll
                for (int m = 0; m < 4; ++m)
#pragma unroll
                    for (int n = 0; n < 2; ++n) acc[a][b][m][n] = (f32x4){0.f, 0.f, 0.f, 0.f};
        cur = nxt; cA = nA; cB = nB; ++ui;
#pragma unroll
        for (int h_ = 0; h_ < 2; ++h_)
#pragma unroll
            for (int i_ = 0; i_ < 2; ++i_) vAc[h_][i_] = vAn[h_][i_];
        if constexpr (ALIGN_EPI) { if (wr == 1) PG8_BAR; }
    }
    PG8_WAIT_V(0);
    if constexpr (!ALIGN_EPI) { if (wr == 0) PG8_BAR; }
    PG8_BAR;
    if constexpr (Epi::AFTER_DRAIN) { E.fused(acc, cur, wr, wc, fr, fq, lds, wid, lane); S.done(cur); }
#undef PG8_SA
#undef PG8_SB
#undef PG8_STAGE
#undef PG8_STAGE_A
#undef PG8_AOFF
#undef PG8_LDA
#undef PG8_LDB
#undef PG8_MMA
#undef PG8_WAIT_V
#undef PG8_WAIT_L
#undef PG8_BAR
#undef PG8_SCHED
}
}


constexpr int TAB_OFF = 131072;
DI void build_tables(const Params& p, char* lds) {
  int* T = (int*)(lds + TAB_OFF); unsigned char* te = (unsigned char*)(T + 80);
  __syncthreads();
  if (tid_() == 0) {
    int acc = 0;
    for (int e = 0; e < NEXP; ++e) { const int c = ws_cnt(p)[e]; T[e] = c; T[32 + e] = acc; const int nt = (c + 255) >> 8; for (int k = 0; k < nt; ++k) te[acc + k] = (unsigned char)e; acc += nt; }
    T[64] = acc;
  }
  __syncthreads();
}
template <bool GATHER_> struct GroupOrderT { static constexpr bool GATHER = GATHER_; const int* T; const unsigned char* te; int G, c; const int* list;
  DI bool next(int i, pg8::Unit& u) const { const int L = i * G + c; if (L >= T[64] * 4) return false; u.pm = L >> 2; u.pn = L & 3; u.e = te[u.pm]; return true; }
  DI void a_ready(const pg8::Unit&) const {}
  DI void done(const pg8::Unit&) const {}
  DI int arow(const pg8::Unit& u, int r) const {
    const int slot = (u.pm - T[32 + u.e]) * 256 + r; return slot < T[u.e] ? (list[u.e * LCAP + slot] >> 1) : 0; } };
typedef GroupOrderT<false> GroupOrder;

struct EpiProjP { static constexpr bool PERM = true, AFTER_DRAIN = false; bf16_t* O; int ldc;
  DI void operator()(const f32x4 (&acc)[2][2][4][2], const pg8::Unit& u, int wr, int wc, int fr, int fq) const {
    const int row0 = u.pm * 256 + wr * 64 + fr, col0 = u.pn * 256 + wc * 32 + 8 * fq;
#pragma unroll
    for (int ai = 0; ai < 2; ++ai)
#pragma unroll
      for (int m = 0; m < 4; ++m) { bf16_t* rowp = O + (size_t)(row0 + ai * 128 + m * 16) * ldc + col0;
#pragma unroll
        for (int bj = 0; bj < 2; ++bj) { const f32x4 v0 = acc[ai][bj][m][0] + 0.0f, v1 = acc[ai][bj][m][1] + 0.0f;
          u32x4 w; w.x = cvtpk(v0[0], v0[1]); w.y = cvtpk(v0[2], v0[3]); w.z = cvtpk(v1[0], v1[1]); w.w = cvtpk(v1[2], v1[3]);
          *(u32x4*)(rowp + bj * 128) = w; } }
  } };
DI void phase2_pg8(const Params& p, int bid, int nb, char* lds) {
  pg8::Gemm g{ws_h1(p), ws_wtin(p), NTOK, PROJ_LD, DM, 0};
  pg8::StaticOrder S; S.init(NTOK, PROJ_LD, nb, bid);
  EpiProjP E{ws_proj(p), PROJ_LD};
  __syncthreads();
  pg8::gemm_phase<EpiProjP, pg8::StaticOrder, true, true>((PG8_LAS unsigned char*)lds, g, S, E);
  __syncthreads();
}
struct EpiResidP { static constexpr bool PERM = false, AFTER_DRAIN = false; const float* x; const float* mod; float* o;
  DI void operator()(const f32x4 (&acc)[2][2][4][2], const pg8::Unit& u, int wr, int wc, int fr, int fq) const {
    const int row0 = u.pm * 256 + wr * 64 + fr, col0 = u.pn * 256 + wc * 32 + 4 * fq;
#pragma unroll
    for (int ai = 0; ai < 2; ++ai)
#pragma unroll
      for (int m = 0; m < 4; ++m) { const int row = row0 + ai * 128 + m * 16, b = row >> 11;
#pragma unroll
        for (int bj = 0; bj < 2; ++bj)
#pragma unroll
          for (int n = 0; n < 2; ++n) { const int col = col0 + bj * 128 + n * 16; const size_t idx = (size_t)row * DM + col;
            const f32x4 xv = *(const f32x4*)(x + idx), gv = *(const f32x4*)(mod + b * 6144 + 2048 + col);
            *(f32x4*)(o + idx) = xv + (gv + 1.0f) * acc[ai][bj][m][n]; } }
  } };
DI void phase6_pg8(const Params& p, int bid, int nb, char* lds) {
  pg8::Gemm g{ws_mix(p), ws_wtout(p), NTOK, DM, DM, 0};
  pg8::StaticOrder S; S.init(NTOK, DM, nb, bid);
  EpiResidP E{p.x, ws_mod(p), ws_x1(p)};
  __syncthreads();
  pg8::gemm_phase<EpiResidP, pg8::StaticOrder, true, true>((PG8_LAS unsigned char*)lds, g, S, E);
  __syncthreads();
}
DI bf16_t* ws_h2s(const Params& p) { return (bf16_t*)(p.ws + OFF_C); }
DI bf16_t* ws_hidp(const Params& p) { return (bf16_t*)(p.ws + OFF_F); }
DI void phase7c(const Params& p, int bid, int nb, char* lds) {
  build_tables(p, lds);
  const int* T = (const int*)(lds + TAB_OFF);
  const int lane = tid_() & 63, gw = bid * 8 + (tid_() >> 6), nw = nb * 8;
  for (int e = 0; e < NEXP; ++e) {
    const int c = T[e]; const size_t r0 = (size_t)T[32 + e] * 256;
    for (int r = gw; r < c; r += nw) {
      const int tok = ws_list(p)[e * LCAP + r] >> 1;
      const u32x4* src = (const u32x4*)(ws_h2(p) + (size_t)tok * DM); u32x4* dst = (u32x4*)(ws_h2s(p) + (r0 + r) * DM);
      dst[lane] = src[lane]; dst[lane + 64] = src[lane + 64];
    }
  }
}
struct EpiSwiGLU { static constexpr bool PERM = true, AFTER_DRAIN = false; bf16_t* O;
  DI void operator()(const f32x4 (&acc)[2][2][4][2], const pg8::Unit& u, int wr, int wc, int fr, int fq) const {
    const int row0 = u.pm * 256 + wr * 64 + fr, col0 = u.pn * 128 + wc * 32 + 8 * fq;
#pragma unroll
    for (int ai = 0; ai < 2; ++ai)
#pragma unroll
      for (int m = 0; m < 4; ++m) {
        float hv[8];
#pragma unroll
        for (int n = 0; n < 2; ++n)
#pragma unroll
          for (int i = 0; i < 4; ++i) { const float gt = acc[ai][0][m][n][i], up = acc[ai][1][m][n][i]; hv[n * 4 + i] = gt / (1.0f + __expf(-gt)) * up; }
        u32x4 w; w.x = cvtpk(hv[0], hv[1]); w.y = cvtpk(hv[2], hv[3]); w.z = cvtpk(hv[4], hv[5]); w.w = cvtpk(hv[6], hv[7]);
        *(u32x4*)(O + (size_t)(row0 + ai * 128 + m * 16) * DEXP + col0) = w; }
  } };
DI void phase8_pg8(const Params& p, int bid, int nb, char* lds) {
  build_tables(p, lds);
  pg8::Gemm g{ws_h2(p), ws_wgu(p), 0, 1024, DM, (size_t)1024 * 1024 * 2};
  GroupOrderT<true> S{(const int*)(lds + TAB_OFF), (const unsigned char*)((const int*)(lds + TAB_OFF) + 80), nb, bid, ws_list(p)};
  EpiSwiGLU E{ws_hidp(p)};
  pg8::gemm_phase<EpiSwiGLU, GroupOrderT<true>, true, true>((PG8_LAS unsigned char*)lds, g, S, E);
  __syncthreads();
}
struct EpiYP { static constexpr bool PERM = true, AFTER_DRAIN = false; bf16_t* O; const int* list; const float* wa; const int* T;
  DI void operator()(const f32x4 (&acc)[2][2][4][2], const pg8::Unit& u, int wr, int wc, int fr, int fq) const {
    const int cnt = T[u.e], rbase = (u.pm - T[32 + u.e]) * 256 + wr * 64 + fr, col0 = u.pn * 256 + wc * 32 + 8 * fq;
#pragma unroll
    for (int ai = 0; ai < 2; ++ai)
#pragma unroll
      for (int m = 0; m < 4; ++m) { const int r = rbase + ai * 128 + m * 16;
        if (r < cnt) { const int aid = list[u.e * LCAP + r]; const float wv = wa[aid]; bf16_t* rowp = O + (size_t)aid * DM + col0;
#pragma unroll
          for (int bj = 0; bj < 2; ++bj) { const f32x4 v0 = acc[ai][bj][m][0] * wv, v1 = acc[ai][bj][m][1] * wv;
            u32x4 w; w.x = cvtpk(v0[0], v0[1]); w.y = cvtpk(v0[2], v0[3]); w.z = cvtpk(v1[0], v1[1]); w.w = cvtpk(v1[2], v1[3]);
            *(u32x4*)(rowp + bj * 128) = w; } } }
  } };
DI void phase9_pg8(const Params& p, int bid, int nb, char* lds) {
  build_tables(p, lds);
  pg8::Gemm g{ws_hidp(p), ws_wd(p), 0, 1024, DEXP, (size_t)1024 * 512 * 2};
  GroupOrder S{(const int*)(lds + TAB_OFF), (const unsigned char*)((const int*)(lds + TAB_OFF) + 80), nb, bid, nullptr};
  EpiYP E{ws_ybuf(p), ws_list(p), ws_wa(p), (const int*)(lds + TAB_OFF)};
  pg8::gemm_phase<EpiYP, GroupOrder, true, true>((PG8_LAS unsigned char*)lds, g, S, E);
  __syncthreads();
}

typedef float f32x4m __attribute__((ext_vector_type(4)));
constexpr int H_LD = 1028;
DI void phase7(const Params& p, int bid, int nb, char* lds) {
  const int t = tid_(), lane = t & 63, wid = t >> 6, l16 = lane & 15, lg4 = lane >> 4;
  float* H = (float*)lds;
  float* part = H + 16 * H_LD;
  float* lgt = part + 8 * 16 * 48;
  int* ecnt = (int*)(lgt + 16 * 16 * 48);
  int* ebase = ecnt + 32;
  int* sl_aid = ebase + 32;
  int* sl_e = sl_aid + 512;
  const float* mod = ws_mod(p);
  if (t < NEXP) ecnt[t] = 0;
  int nloc = 0;
  float rb0[32], rb1[32], rb2[32];
  {
    const float* we = p.w_expert + (size_t)(wid * 128 + lg4) * 32 + l16;
    const float* wg = p.w_group + (size_t)(wid * 128 + lg4) * 4 + (l16 & 3);
#pragma unroll
    for (int s4 = 0; s4 < 32; ++s4) { rb0[s4] = we[s4 * 128]; rb1[s4] = we[s4 * 128 + 16]; const float b2r = wg[s4 * 16]; rb2[s4] = (l16 < 4) ? b2r : 0.f; }
  }
  f32x4 pv[2][4];
#define P7_PF(tile_) do { _Pragma("unroll") for (int q_ = 0; q_ < 2; ++q_) { const float* xr_ = ws_x1(p) + (size_t)((tile_) * 16 + wid * 2 + q_) * DM + lane * 4; \
      _Pragma("unroll") for (int i_ = 0; i_ < 4; ++i_) pv[q_][i_] = *(const f32x4*)(xr_ + 256 * i_); } } while (0)
  if (bid < NTOK / 16) P7_PF(bid);
  for (int tile = bid; tile < NTOK / 16; tile += nb) {
    __syncthreads();
#pragma unroll
    for (int q = 0; q < 2; ++q) {
      const int tl = wid * 2 + q, gt = tile * 16 + tl, b = gt >> 11;
      f32x4 v[4]; float ss = 0.f;
#pragma unroll
      for (int i = 0; i < 4; ++i) { v[i] = pv[q][i]; ss += v[i][0] * v[i][0] + v[i][1] * v[i][1] + v[i][2] * v[i][2] + v[i][3] * v[i][3]; }
      ss = wave_sum(ss);
      const float rstd = rsqrtf(ss * (1.0f / DM) + 1e-6f);
#pragma unroll
      for (int i = 0; i < 4; ++i) {
        const int col = lane * 4 + 256 * i;
        const f32x4 g = *(const f32x4*)(p.norm2_g + col), sh = *(const f32x4*)(mod + b * 6144 + 3072 + col), sc = *(const f32x4*)(mod + b * 6144 + 4096 + col);
        f32x4 o;
#pragma unroll
        for (int j = 0; j < 4; ++j) o[j] = v[i][j] * rstd * g[j] * (1.0f + sc[j]) + sh[j];
        *(f32x4*)(H + tl * H_LD + col) = o;
        u32x2 w; w.x = cvtpk(o[0], o[1]); w.y = cvtpk(o[2], o[3]);
        *(u32x2*)(ws_h2(p) + (size_t)gt * DM + col) = w;
      }
    }
    if (tile + nb < NTOK / 16) P7_PF(tile + nb);
    __syncthreads();
    {
      f32x4m acc0 = {0.f, 0.f, 0.f, 0.f}, acc1 = acc0, acc2 = acc0;
      const float* hrow = H + l16 * H_LD + wid * 128 + lg4;
#pragma unroll
      for (int s4 = 0; s4 < 32; ++s4) {
        const float a = hrow[s4 * 4];
        acc0 = __builtin_amdgcn_mfma_f32_16x16x4f32(a, rb0[s4], acc0, 0, 0, 0);
        acc1 = __builtin_amdgcn_mfma_f32_16x16x4f32(a, rb1[s4], acc1, 0, 0, 0);
        acc2 = __builtin_amdgcn_mfma_f32_16x16x4f32(a, rb2[s4], acc2, 0, 0, 0);
      }
#pragma unroll
      for (int r = 0; r < 4; ++r) {
        float* pr = part + (wid * 16 + lg4 * 4 + r) * 48;
        pr[l16] = acc0[r]; pr[16 + l16] = acc1[r]; pr[32 + l16] = acc2[r];
      }
    }
    __syncthreads();
    for (int idx = t; idx < 16 * 36; idx += NTHR) {
      const int tok = idx / 36, o = idx % 36;
      float sacc = 0.f;
#pragma unroll
      for (int w = 0; w < 8; ++w) sacc += part[(w * 16 + tok) * 48 + o];
      sacc += (o < 32) ? p.b_expert[o] : p.b_group[o - 32];
      lgt[(nloc * 16 + tok) * 48 + o] = sacc;
    }
    ++nloc;
  }
  __syncthreads();
  for (int idx = t; idx < nloc * 16; idx += NTHR) {
    {
      const int kl = idx >> 4, t16 = idx & 15, tile = bid + kl * nb;
      const float* l = lgt + idx * 48;
      int gs = 0; float gm = l[32];
      for (int g = 1; g < 4; ++g) if (l[32 + g] > gm) { gm = l[32 + g]; gs = g; }
      float gsum = 0.f;
      for (int g = 0; g < 4; ++g) gsum += expf(l[32 + g] - gm);
      const float pgroup = 1.0f / gsum;
      const float* el = l + gs * 8;
      float em = el[0];
      for (int e = 1; e < 8; ++e) em = fmaxf(em, el[e]);
      float pe[8], esum = 0.f;
      for (int e = 0; e < 8; ++e) { pe[e] = expf(el[e] - em); esum += pe[e]; }
      for (int e = 0; e < 8; ++e) pe[e] /= esum;
      int i0 = 0;
      for (int e = 1; e < 8; ++e) if (pe[e] > pe[i0]) i0 = e;
      int i1 = (i0 == 0) ? 1 : 0;
      for (int e = 0; e < 8; ++e) if (e != i0 && pe[e] > pe[i1]) i1 = e;
      const float den = pe[i0] + pe[i1];
      const int tok = tile * 16 + t16;
      const int e0 = gs * 8 + i0, e1 = gs * 8 + i1;
      ws_wa(p)[tok * 2] = pgroup * pe[i0] / den; ws_wa(p)[tok * 2 + 1] = pgroup * pe[i1] / den;
      const int slot = kl * 32 + t16 * 2;
      sl_aid[slot] = tok * 2; sl_aid[slot + 1] = tok * 2 + 1;
      sl_e[slot] = e0 | (atomicAdd(ecnt + e0, 1) << 8); sl_e[slot + 1] = e1 | (atomicAdd(ecnt + e1, 1) << 8);
    }
  }
  __syncthreads();
  if (t < NEXP) ebase[t] = ecnt[t] ? atomicAdd(ws_cnt(p) + t, ecnt[t]) : 0;
  __syncthreads();
  for (int sidx = t; sidx < nloc * 32; sidx += NTHR) { const int ev = sl_e[sidx], e = ev & 255, r = ev >> 8; ws_list(p)[e * LCAP + ebase[e] + r] = sl_aid[sidx]; }
}
DI void phase7_tr(const Params& p, int bid, int nb, char* lds) {
  const int t = tid_();
  {
    float* tile = (float*)lds;
    const int ln4 = (t & 31) * 4, lkr = t >> 5, snr = t >> 2, skc = (t & 3) * 16;
#define MOE_TSRC(task_, src_, k0_, n0_, N_) const float* src_; int k0_, n0_, N_; { const int wh_ = (task_) >> 11, q_ = (task_) & 2047, e_ = q_ >> 6, r_ = q_ & 63; \
      if (wh_ < 2) { k0_ = (r_ >> 2) * 64; n0_ = (r_ & 3) * 128; N_ = 512; src_ = (wh_ == 0 ? p.e_gate : p.e_up) + (size_t)e_ * 1024 * 512; } \
      else { k0_ = (r_ >> 3) * 64; n0_ = (r_ & 7) * 128; N_ = 1024; src_ = p.e_down + (size_t)e_ * 512 * 1024; } }
    f32x4 g[4];
    int task = bid;
    if (task < 6144) { MOE_TSRC(task, src, k0, n0, N);
#pragma unroll
      for (int i = 0; i < 4; ++i) g[i] = *(const f32x4*)(src + (size_t)(k0 + lkr + 16 * i) * N + n0 + ln4); }
    for (; task < 6144; task += nb) {
      __syncthreads();
#pragma unroll
      for (int i = 0; i < 4; ++i) { float* d = tile + (lkr + 16 * i) * 129 + ln4; d[0] = g[i][0]; d[1] = g[i][1]; d[2] = g[i][2]; d[3] = g[i][3]; }
      if (task + nb < 6144) { MOE_TSRC(task + nb, src, k0, n0, N);
#pragma unroll
        for (int i = 0; i < 4; ++i) g[i] = *(const f32x4*)(src + (size_t)(k0 + lkr + 16 * i) * N + n0 + ln4); }
      __syncthreads();
      const int which = task >> 11, q = task & 2047, e = q >> 6, r = q & 63;
      float v[16];
#pragma unroll
      for (int j = 0; j < 16; ++j) v[j] = tile[(skc + j) * 129 + snr];
      u32x4 w0, w1;
      w0.x = cvtpk(v[0], v[1]); w0.y = cvtpk(v[2], v[3]); w0.z = cvtpk(v[4], v[5]); w0.w = cvtpk(v[6], v[7]);
      w1.x = cvtpk(v[8], v[9]); w1.y = cvtpk(v[10], v[11]); w1.z = cvtpk(v[12], v[13]); w1.w = cvtpk(v[14], v[15]);
      bf16_t* dst;
      if (which < 2) { const int k0 = (r >> 2) * 64, n = (r & 3) * 128 + snr; dst = ws_wgu(p) + (size_t)e * 1024 * 1024 + (size_t)((n >> 7) * 256 + (n & 127) + which * 128) * 1024 + k0 + skc; }
      else { const int k0 = (r >> 3) * 64, n = (r & 7) * 128 + snr; dst = ws_wd(p) + (size_t)e * 1024 * 512 + (size_t)n * 512 + k0 + skc; }
      *(u32x4*)dst = w0; *(u32x4*)(dst + 8) = w1;
    }
  }
}

struct Seg { int e, r0, cnt, start; };
DI Seg find_seg(const int* cnt, int mtile) {
  Seg s; s.e = -1; int acc = 0, start = 0;
  for (int e = 0; e < NEXP; ++e) { const int c = cnt[e], nt = (c + GBM - 1) / GBM; if (mtile < acc + nt) { s.e = e; s.r0 = (mtile - acc) * GBM; s.cnt = c; s.start = start; return s; } acc += nt; start += c; }
  return s;
}
struct ARowList { const int* list; int r0, cnt; DI int operator()(int r) const { int q = r0 + r; q = q < cnt ? q : cnt - 1; return list[q] >> 1; } };
struct EpiHid { bf16_t* o; int row0, nvalid, col0; DI void operator()(int r, int c, float g, float u) const {
  if (r < nvalid) o[(size_t)(row0 + r) * DEXP + ((col0 + c) >> 6) * 32 + (c & 31)] = f2bf(g / (1.0f + __expf(-g)) * u); } };
DI void phase8(const Params& p, int bid, int nb, char* lds) {
  const int* cnt = ws_cnt(p);
  for (int tile = bid; tile < 288 * 8; tile += nb) {
    const Seg s = find_seg(cnt, tile >> 3);
    if (s.e < 0) break;
    const int nt = tile & 7;
    gemm_tile(ws_h2(p), DM, ARowList{ws_list(p) + s.e * LCAP, s.r0, s.cnt}, ws_wgu(p) + (size_t)s.e * 1024 * 1024, DM, nt * GBN, DM,
              EpiHid{ws_hid(p), s.start + s.r0, s.cnt - s.r0, nt * GBN}, lds);
  }
}
struct ARowClamp { int base, r0, cnt; DI int operator()(int r) const { int q = r0 + r; q = q < cnt ? q : cnt - 1; return base + q; } };
struct EpiY { bf16_t* o; const int* list; const float* wa; int r0, cnt, col0; DI void operator()(int r, int c, float v0, float v1) const {
  if (r0 + r < cnt) { const int aid = list[r0 + r]; const float w = wa[aid]; bf16_t* q = o + (size_t)aid * DM + col0 + c; q[0] = f2bf(v0 * w); q[32] = f2bf(v1 * w); } } };
DI void phase9(const Params& p, int bid, int nb, char* lds) {
  const int* cnt = ws_cnt(p);
  for (int tile = bid; tile < 288 * 8; tile += nb) {
    const Seg s = find_seg(cnt, tile >> 3);
    if (s.e < 0) break;
    const int nt = tile & 7;
    gemm_tile(ws_hid(p), DEXP, ARowClamp{s.start, s.r0, s.cnt}, ws_wd(p) + (size_t)s.e * 1024 * 512, DEXP, nt * GBN, DEXP,
              EpiY{ws_ybuf(p), ws_list(p) + s.e * LCAP, ws_wa(p), s.r0, s.cnt, nt * GBN}, lds);
  }
}

DI void phase10(const Params& p, int bid, int nb, char* lds) {
  const int lane = tid_() & 63, wid = tid_() >> 6;
  const float* mod = ws_mod(p); const float* fm = ws_fmod(p);
  for (int gt = bid * 8 + wid; gt < NTOK; gt += nb * 8) {
    const int b = gt >> 11;
    const float* xr = ws_x1(p) + (size_t)gt * DM; float* xo = p.out + (size_t)gt * DM;
    const bf16_t* ya = ws_ybuf(p) + (size_t)(gt * 2) * DM; const bf16_t* yb = ya + DM;
    f32x4 v[4]; float ss = 0.f;
#pragma unroll
    for (int i = 0; i < 4; ++i) {
      const int col = lane * 4 + 256 * i;
      v[i] = *(const f32x4*)(xr + col);
      const u32x2 a = *(const u32x2*)(ya + col), bq = *(const u32x2*)(yb + col);
      const f32x4 g2 = *(const f32x4*)(mod + b * 6144 + 5120 + col);
      const float m0 = __uint_as_float(a.x << 16) + __uint_as_float(bq.x << 16), m1 = __uint_as_float(a.x & 0xffff0000u) + __uint_as_float(bq.x & 0xffff0000u);
      const float m2 = __uint_as_float(a.y << 16) + __uint_as_float(bq.y << 16), m3 = __uint_as_float(a.y & 0xffff0000u) + __uint_as_float(bq.y & 0xffff0000u);
      v[i][0] += (1.0f + g2[0]) * m0; v[i][1] += (1.0f + g2[1]) * m1; v[i][2] += (1.0f + g2[2]) * m2; v[i][3] += (1.0f + g2[3]) * m3;
      ss += v[i][0] * v[i][0] + v[i][1] * v[i][1] + v[i][2] * v[i][2] + v[i][3] * v[i][3];
    }
    ss = wave_sum(ss);
    const float rstd = rsqrtf(ss * (1.0f / DM) + 1e-6f);
#pragma unroll
    for (int i = 0; i < 4; ++i) {
      const int col = lane * 4 + 256 * i;
      const f32x4 g = *(const f32x4*)(p.final_norm_g + col), sh = *(const f32x4*)(fm + b * 2048 + col), sc = *(const f32x4*)(fm + b * 2048 + 1024 + col);
      f32x4 o;
#pragma unroll
      for (int j = 0; j < 4; ++j) o[j] = v[i][j] * rstd * g[j] * (1.0f + sc[j]) + sh[j];
      *(f32x4*)(xo + col) = o;
    }
  }
}

#define XB_TMO      128
#define XB_XCNT(j)  (256  + 64 * (j))
#define XB_XSUB(j)  (1280 + 64 * (j))
#define XB_XGEN(j)  (2304 + 64 * (j))
#define XB_TOP      3328
#define XB_TOPGEN   3392
#define XCD_BAR_WORDS 3456
#define XB_SPIN_CAP (1u << 18)
#define XLAS __attribute__((address_space(3)))

__device__ __forceinline__ unsigned xb_ld(unsigned* p)              { return __hip_atomic_load(p, __ATOMIC_RELAXED, __HIP_MEMORY_SCOPE_AGENT); }
__device__ __forceinline__ unsigned xb_add(unsigned* p, unsigned v) { return __hip_atomic_fetch_add(p, v, __ATOMIC_RELAXED, __HIP_MEMORY_SCOPE_AGENT); }
__device__ __forceinline__ unsigned xb_xcc_id() { return (unsigned)__builtin_amdgcn_s_getreg((3 << 11) | 20) & 0xFu; }
#define XB_SPIN(cond, bar) do { unsigned _sp = 0; while (cond) { __builtin_amdgcn_s_sleep(1); \
    if ((++_sp & 255u) == 0u) { if (xb_ld(&(bar)[XB_TMO])) break; if (_sp > XB_SPIN_CAP) { atomicAdd(&(bar)[XB_TMO], 1u); break; } } } } while (0)

struct XcdBarrier {
    unsigned* bar; unsigned x;
    volatile XLAS unsigned* st;
};

__device__ __forceinline__ XcdBarrier xcd_barrier_post(unsigned* bar, volatile XLAS unsigned* st) {
    XcdBarrier b; b.bar = bar; b.x = xb_xcc_id(); b.st = st;
    if (threadIdx.x == 0) (void)xb_add(&bar[XB_XCNT(b.x)], 1u);
    return b;
}
__device__ __forceinline__ void xcd_barrier_complete(unsigned* bar, unsigned x, unsigned& nloc, unsigned& nx) {
    const unsigned G = gridDim.x * gridDim.y * gridDim.z;
    unsigned sum, cnt, mine, sp = 0u;
    for (;;) {
        sum = 0u; cnt = 0u; mine = 0u;
#pragma unroll
        for (unsigned j = 0; j < 16; ++j) { const unsigned c = xb_ld(&bar[XB_XCNT(j)]); sum += c; cnt += (c > 0u) ? 1u : 0u; mine = (j == x) ? c : mine; }
        if (sum == G) break;
        __builtin_amdgcn_s_sleep(1);
        if ((++sp & 255u) == 0u) { if (xb_ld(&bar[XB_TMO])) break; if (sp > XB_SPIN_CAP) { atomicAdd(&bar[XB_TMO], 1u); break; } }
    }
    nloc = mine > 0u ? mine : 1u; nx = cnt > 0u ? cnt : 1u;
}

__device__ __forceinline__ void xcd_barrier(const XcdBarrier& b) {
    asm volatile("s_waitcnt vmcnt(0)" ::: "memory");
    __syncthreads();
    if (threadIdx.x == 0) {
        unsigned* bar = b.bar;
        __builtin_amdgcn_s_waitcnt(0);
        unsigned nloc = b.st[0], nx = b.st[1];
        if (nloc == 0u) { xcd_barrier_complete(bar, b.x, nloc, nx); b.st[0] = nloc; b.st[1] = nx; }
        const unsigned old = xb_add(&bar[XB_XSUB(b.x)], 1u);
        const unsigned gen = old / nloc;
        if (old + 1u == (gen + 1u) * nloc) {
            __builtin_amdgcn_fence(__ATOMIC_RELEASE, "agent");
            asm volatile("s_waitcnt vmcnt(0)" ::: "memory");
            const unsigned og = xb_add(&bar[XB_TOP], 1u);
            const unsigned tg = og / nx;
            if (og + 1u == (tg + 1u) * nx) xb_add(&bar[XB_TOPGEN], 1u);
            else XB_SPIN(xb_ld(&bar[XB_TOPGEN]) == tg, bar);
            __builtin_amdgcn_fence(__ATOMIC_ACQUIRE, "agent");
            xb_add(&bar[XB_XGEN(b.x)], 1u);
            asm volatile("s_waitcnt vmcnt(0)" ::: "memory");
        } else {
            XB_SPIN(xb_ld(&bar[XB_XGEN(b.x)]) == gen, bar);
            __builtin_amdgcn_fence(__ATOMIC_ACQUIRE, "agent");
            asm volatile("s_waitcnt vmcnt(0)" ::: "memory");
        }
    }
    __syncthreads();
}

#if MEGA
__global__ void __launch_bounds__(NTHR) k_mega(Params p) {
  extern __shared__ __attribute__((aligned(16))) char smem[];
  cg::grid_group grid = cg::this_grid();
  const int bid = blockIdx.x, nb = gridDim.x;
  volatile XLAS unsigned* xst = (volatile XLAS unsigned*)(XLAS char*)(smem + LDS_BYTES - 64);
  if (threadIdx.x < 4) xst[threadIdx.x] = 0u;
  if (bid == 0) for (int i = threadIdx.x; i < XCD_BAR_WORDS; i += NTHR) ws_bar(p)[i] = 0u;
  phase0(p, bid, nb, smem);
  grid.sync();
  XcdBarrier xb = xcd_barrier_post(ws_bar(p), xst);
#define SEAM() xcd_barrier(xb)
  phase1(p, bid, nb, smem); SEAM();
  phase2_pg8(p, bid, nb, smem); SEAM();
  phase3_mfma<3>(p, bid, nb, smem); SEAM();
  phase4a_chunk(p, bid, nb, smem); phase4b_mfma(p, bid, nb, smem); SEAM();
  phase5a(p, bid, nb, smem); phase5b_mfma(p, bid, nb, smem); SEAM();
  phase6_pg8(p, bid, nb, smem); SEAM();
  phase7(p, bid, nb, smem); SEAM();
  phase8_pg8(p, bid, nb, smem); SEAM();
  phase9_pg8(p, bid, nb, smem); SEAM();
  phase10(p, bid, nb, smem);
}
#else
#define PHASE_KERNEL(name, body) __global__ void __launch_bounds__(NTHR) name(Params p) { extern __shared__ __attribute__((aligned(16))) char smem[]; body(p, blockIdx.x, gridDim.x, smem); }
PHASE_KERNEL(k_phase0, phase0)
PHASE_KERNEL(k_phase1, phase1)
PHASE_KERNEL(k_phase2, phase2)
PHASE_KERNEL(k_phase3a, phase3a)
PHASE_KERNEL(k_phase3b, phase3b)
PHASE_KERNEL(k_phase4a, phase4a)
PHASE_KERNEL(k_phase4a2, phase4a_v2)
PHASE_KERNEL(k_phase4a3, phase4a_v3)
PHASE_KERNEL(k_phase4b, phase4b)
PHASE_KERNEL(k_phase4bm, phase4b_mfma)
PHASE_KERNEL(k_phase3m, phase3_mfma<3>)
PHASE_KERNEL(k_phase5a, phase5a)
PHASE_KERNEL(k_phase5b, phase5b)
PHASE_KERNEL(k_phase5bm, phase5b_mfma)
PHASE_KERNEL(k_phase6, phase6)
PHASE_KERNEL(k_phase7, phase7)
PHASE_KERNEL(k_phase8, phase8)
PHASE_KERNEL(k_phase9, phase9)
PHASE_KERNEL(k_phase10, phase10)
#endif

extern "C" void kernel_launch(void* const* d_in, const int* in_sizes, int n_in, void* d_out, int out_size, void* d_ws, size_t ws_size, hipStream_t stream) {
  Params p{};
  const float** f = (const float**)&p;
  for (int i = 0; i < 33; ++i) f[i] = (const float*)d_in[i];
  p.out = (float*)d_out; p.ws = (char*)d_ws;
  if (n_in != 33 || ws_size < (size_t)(OFF_S + 9 * MiB) || out_size != NTOK * DM) { fprintf(stderr, "kernel_launch: unexpected problem shape or workspace (n_in %d, ws %zu, out %d)\n", n_in, ws_size, out_size); return; }
#if MEGA
  static int grid_blocks = 0;
  if (!grid_blocks) {
    int dev = 0, cus = 0, per_cu = 0;
    hipGetDevice(&dev);
    hipDeviceGetAttribute(&cus, hipDeviceAttributeMultiprocessorCount, dev);
    hipFuncSetAttribute((const void*)k_mega, hipFuncAttributeMaxDynamicSharedMemorySize, LDS_BYTES);
    hipOccupancyMaxActiveBlocksPerMultiprocessor(&per_cu, k_mega, NTHR, LDS_BYTES);
    if (per_cu > 1) per_cu = 1;
    grid_blocks = cus * per_cu;
  }
  void* args[] = {&p};
  hipError_t e = hipLaunchCooperativeKernel((void*)k_mega, dim3(grid_blocks), dim3(NTHR), args, LDS_BYTES, stream);
  if (e != hipSuccess) fprintf(stderr, "cooperative launch failed: %s (grid %d)\n", hipGetErrorString(e), grid_blocks);
#else
  const int G = 512;
#define LAUNCH(k, g) hipLaunchKernelGGL(k, dim3(g), dim3(NTHR), LDS_BYTES, stream, p)
  LAUNCH(k_phase0, G);
  LAUNCH(k_phase1, G);
  LAUNCH(k_phase2, G);
  LAUNCH(k_phase3a, G);
  LAUNCH(k_phase3b, G);
  LAUNCH(k_phase4a, 128);
  LAUNCH(k_phase4b, 1024);
  LAUNCH(k_phase5a, G);
  LAUNCH(k_phase5b, 1024);
  LAUNCH(k_phase6, G);
  LAUNCH(k_phase7, G);
  LAUNCH(k_phase8, G);
  LAUNCH(k_phase9, G);
  LAUNCH(k_phase10, G);
#endif
}
```

```cpp
#include <hip/hip_runtime.h>
#include <hip/hip_cooperative_groups.h>
#include <stdint.h>
#include <stdio.h>

namespace cg = cooperative_groups;

#ifndef MEGA
#define MEGA 1
#endif

typedef unsigned short bf16_t;
typedef short bf16x8 __attribute__((ext_vector_type(8)));
typedef float f32x16 __attribute__((ext_vector_type(16)));
typedef float f32x4 __attribute__((ext_vector_type(4)));
typedef float f32x4v __attribute__((ext_vector_type(4)));
typedef unsigned u32x4 __attribute__((ext_vector_type(4)));
typedef unsigned u32x2 __attribute__((ext_vector_type(2)));

#define DI __device__ __forceinline__

constexpr int DM = 1024, BATCH = 16, SEQ = 2048, NTOK = BATCH * SEQ;
constexpr int RW = 512, NH = 8, HD = 64;
constexpr int PROJ_N = 2756, PROJ_LD = 2816;
constexpr int C_R = 0, C_K = 512, C_V = 1024, C_WL = 1536, C_AL = 1600, C_GL = 1664;
constexpr int C_Q = 1792, C_CKV = 2304, C_QI = 2432, C_KI = 2688, C_WI = 2752;
constexpr int NEXP = 32, DEXP = 512, LCAP = 32768;
constexpr int NTHR = 512;
constexpr int LDS_BYTES = 163840;

constexpr size_t MiB = 1048576;
constexpr size_t OFF_A = 0;
constexpr size_t OFF_B = 64 * MiB;
constexpr size_t OFF_C = 240 * MiB;
constexpr size_t OFF_F = 400 * MiB;
constexpr size_t OFF_G = 464 * MiB;
constexpr size_t OFF_W = 484 * MiB;
constexpr size_t OFF_S = 492 * MiB;

struct Params {
  const float *x, *c, *ada_w, *ada_b, *norm1_g, *w_in, *shift_mu, *w0, *w_decay_up, *a0, *w_aaa_up, *w_gate_up;
  const float *k_k, *k_a, *r_k, *gn_g, *gn_b, *kv_norm_g, *k_idx_norm_g, *w_uk, *w_uv, *w_out, *norm2_g;
  const float *w_group, *b_group, *w_expert, *b_expert, *e_gate, *e_up, *e_down, *final_ada_w, *final_ada_b, *final_norm_g;
  float* out;
  char* ws;
};

DI int tid_() { int t = threadIdx.x; asm volatile("" : "+v"(t)); return t; }
DI float bf2f(bf16_t u) { return __uint_as_float(((unsigned)u) << 16); }
DI bf16_t f2bf(float f) { unsigned u = __float_as_uint(f); u += 0x7fffu + ((u >> 16) & 1u); return (bf16_t)(u >> 16); }
DI unsigned pack2(float lo, float hi) { return (unsigned)f2bf(lo) | ((unsigned)f2bf(hi) << 16); }
DI float wave_sum(float v) { for (int o = 32; o; o >>= 1) v += __shfl_xor(v, o); return v; }
DI float wave_max(float v) { for (int o = 32; o; o >>= 1) v = fmaxf(v, __shfl_xor(v, o)); return v; }
DI float sigmoidf_(float v) { return 1.0f / (1.0f + __expf(-v)); }
DI int crow(int r, int hi) { return (r & 3) + 8 * (r >> 2) + 4 * hi; }
DI unsigned cvtpk(float lo, float hi) { unsigned r; asm volatile("v_cvt_pk_bf16_f32 %0, %1, %2" : "=v"(r) : "v"(lo), "v"(hi)); return r; }

DI void unpack8(const u32x4 w, float* o) {
  o[0] = __uint_as_float(w.x << 16); o[1] = __uint_as_float(w.x & 0xffff0000u); o[2] = __uint_as_float(w.y << 16); o[3] = __uint_as_float(w.y & 0xffff0000u);
  o[4] = __uint_as_float(w.z << 16); o[5] = __uint_as_float(w.z & 0xffff0000u); o[6] = __uint_as_float(w.w << 16); o[7] = __uint_as_float(w.w & 0xffff0000u);
}
DI void load8(const bf16_t* p, float* o) { unpack8(*(const u32x4*)p, o); }

DI bf16_t* ws_h1(const Params& p) { return (bf16_t*)(p.ws + OFF_A); }
DI float* ws_y(const Params& p) { return (float*)(p.ws + OFF_A); }
DI bf16_t* ws_h2(const Params& p) { return (bf16_t*)(p.ws + OFF_A); }
DI bf16_t* ws_proj(const Params& p) { return (bf16_t*)(p.ws + OFF_B); }
DI float* ws_x1(const Params& p) { return (float*)(p.ws + OFF_B); }
DI bf16_t* ws_wgu(const Params& p) { return (bf16_t*)p.out; }
DI bf16_t* ws_wd(const Params& p) { return (bf16_t*)((char*)p.out + 64 * MiB); }
DI bf16_t* ws_hid(const Params& p) { return (bf16_t*)(p.ws + OFF_B + 96 * MiB); }
DI bf16_t* ws_kp(const Params& p) { return (bf16_t*)(p.ws + OFF_C); }
DI bf16_t* ws_kk(const Params& p) { return (bf16_t*)(p.ws + OFF_C + 32 * MiB); }
DI bf16_t* ws_bb(const Params& p) { return (bf16_t*)(p.ws + OFF_C + 64 * MiB); }
DI bf16_t* ws_ee(const Params& p) { return (bf16_t*)(p.ws + OFF_C + 96 * MiB); }
DI bf16_t* ws_gg(const Params& p) { return (bf16_t*)(p.ws + OFF_C + 128 * MiB); }
DI bf16_t* ws_mix(const Params& p) { return (bf16_t*)(p.ws + OFF_C); }
DI bf16_t* ws_ybuf(const Params& p) { return (bf16_t*)(p.ws + OFF_C); }
DI bf16_t* ws_qlat(const Params& p) { return (bf16_t*)(p.ws + OFF_F); }
DI bf16_t* ws_ckv(const Params& p) { return (bf16_t*)(p.ws + OFF_G); }
DI bf16_t* ws_kidx(const Params& p) { return (bf16_t*)(p.ws + OFF_G + 8 * MiB); }
DI unsigned* ws_mask(const Params& p) { return (unsigned*)(p.ws + OFF_G + 12 * MiB); }
DI bf16_t* ws_wtin(const Params& p) { return (bf16_t*)(p.ws + OFF_W); }
DI bf16_t* ws_wtout(const Params& p) { return (bf16_t*)(p.ws + OFF_W + 6 * MiB); }
DI bf16_t* ws_wuvt(const Params& p) { return (bf16_t*)(p.ws + OFF_S + 7 * MiB); }
DI bf16_t* ws_wdt(const Params& p) { return (bf16_t*)(p.ws + OFF_S + 8 * MiB + 64 * 1024); }
DI bf16_t* ws_wat(const Params& p) { return (bf16_t*)(p.ws + OFF_S + 8 * MiB + 128 * 1024); }
DI bf16_t* ws_wgt(const Params& p) { return (bf16_t*)(p.ws + OFF_S + 8 * MiB + 192 * 1024); }
DI bf16_t* ws_wukt(const Params& p) { return (bf16_t*)(p.ws + OFF_S + 8 * MiB + 320 * 1024); }
DI unsigned* ws_bar(const Params& p) { return (unsigned*)(p.ws + OFF_S + 8 * MiB); }
DI float* ws_mod(const Params& p) { return (float*)(p.ws + OFF_S); }
DI float* ws_fmod(const Params& p) { return (float*)(p.ws + OFF_S + 512 * 1024); }
DI float* ws_bonus(const Params& p) { return (float*)(p.ws + OFF_S + 1 * MiB); }
DI int* ws_cnt(const Params& p) { return (int*)(p.ws + OFF_S + 2 * MiB); }
DI float* ws_wa(const Params& p) { return (float*)(p.ws + OFF_S + 2 * MiB + 4096); }
DI int* ws_list(const Params& p) { return (int*)(p.ws + OFF_S + 3 * MiB); }

template <class RowMap>
DI void transpose_tile(const float* src, int N, int k0, int n0, bf16_t* dst, int dstld, RowMap rm, char* lds) {
  float* tile = (float*)lds;
  const int t = tid_();
  __syncthreads();
  {
    const int nc = t & 63, krb = t >> 6;
#pragma unroll
    for (int i = 0; i < 8; ++i) {
      const int kr = krb + 8 * i;
      const int n = n0 + nc;
      tile[kr * 65 + nc] = (n < N) ? src[(size_t)(k0 + kr) * N + n] : 0.f;
    }
  }
  __syncthreads();
  {
    const int nr = t >> 3, kc = (t & 7) * 8;
    u32x4 w;
    w.x = pack2(tile[(kc + 0) * 65 + nr], tile[(kc + 1) * 65 + nr]);
    w.y = pack2(tile[(kc + 2) * 65 + nr], tile[(kc + 3) * 65 + nr]);
    w.z = pack2(tile[(kc + 4) * 65 + nr], tile[(kc + 5) * 65 + nr]);
    w.w = pack2(tile[(kc + 6) * 65 + nr], tile[(kc + 7) * 65 + nr]);
    *(u32x4*)(dst + (size_t)rm(n0 + nr) * dstld + k0 + kc) = w;
  }
}
struct RowId { DI int operator()(int n) const { return n; } };
struct RowGU { int add; DI int operator()(int n) const { return (n >> 7) * 256 + (n & 127) + add; } };

DI void phase0(const Params& p, int bid, int nb, char* lds) {
  const int t = tid_();
  if (bid == 0 && t < NEXP) ws_cnt(p)[t] = 0;
  for (int idx = bid * NTHR + t; idx < 8 * 64 * 128; idx += nb * NTHR) {
    const int e8 = idx & 7, ln = (idx >> 3) & 63, l32 = ln & 31, lh = ln >> 5;
    { const int hh = idx >> 13, i2 = (idx >> 12) & 1, ks = (idx >> 9) & 7, d = i2 * 32 + l32, cc = ks * 16 + lh * 8 + e8;
      ws_wuvt(p)[idx] = f2bf(p.w_uv[(size_t)(cc * NH + hh) * HD + d]); }
    { const int h2 = idx >> 13, mt = (idx >> 11) & 3, ks = (idx >> 9) & 3, c2 = mt * 32 + l32, d2 = ks * 16 + lh * 8 + e8;
      ws_wukt(p)[idx] = f2bf(p.w_uk[(size_t)(c2 * NH + h2) * HD + d2]); }
  }
  for (int idx = bid * NTHR + t; idx < 512 * 128; idx += nb * NTHR) {
    const int e8 = idx & 7, ln = (idx >> 3) & 63, l32 = ln & 31, lh = ln >> 5;
    { const int ks = (idx >> 9) & 7, mt = (idx >> 12) & 1, hh = idx >> 13, ch = hh * HD + mt * 32 + l32, k = ks * 16 + lh * 8 + e8;
      ws_wgt(p)[idx] = f2bf(p.w_gate_up[(size_t)k * RW + ch]); }
    if (idx < 512 * 64) { const int ks = (idx >> 9) & 3, mt = (idx >> 11) & 1, hh = idx >> 12, ch = hh * HD + mt * 32 + l32, k = ks * 16 + lh * 8 + e8;
      ws_wdt(p)[idx] = f2bf(p.w_decay_up[(size_t)k * RW + ch]); ws_wat(p)[idx] = f2bf(p.w_aaa_up[(size_t)k * RW + ch]); }
  }
  for (int task = bid; task < 256; task += nb) {
    float* cact = (float*)lds;
    __syncthreads();
    for (int i = t; i < 16 * 1024; i += NTHR) { const float v = p.c[i]; cact[i] = v / (1.0f + __expf(-v)); }
    __syncthreads();
    const int col = task * 32 + (t & 31), ks = t >> 5;
    const float* w; int ld, cc;
    if (col < 6144) { w = p.ada_w; ld = 6144; cc = col; } else { w = p.final_ada_w; ld = 2048; cc = col - 6144; }
    float acc[16];
#pragma unroll
    for (int b = 0; b < 16; ++b) acc[b] = 0.f;
    for (int kk = 0; kk < 64; ++kk) {
      const int k = ks * 64 + kk;
      const float wv = w[(size_t)k * ld + cc];
#pragma unroll
      for (int b = 0; b < 16; ++b) acc[b] += cact[b * 1024 + k] * wv;
    }
    __syncthreads();
    float* red = (float*)lds;
#pragma unroll
    for (int b = 0; b < 16; ++b) red[(ks * 16 + b) * 32 + (t & 31)] = acc[b];
    __syncthreads();
    {
      const int b = t >> 5, cl = t & 31, colo = task * 32 + cl;
      float s = 0.f;
      for (int k2 = 0; k2 < 16; ++k2) s += red[(k2 * 16 + b) * 32 + cl];
      if (colo < 6144) ws_mod(p)[b * 6144 + colo] = s + p.ada_b[colo];
      else ws_fmod(p)[b * 2048 + colo - 6144] = s + p.final_ada_b[colo - 6144];
    }
  }
  for (int task = bid; task < 704 + 256; task += nb) {
    if (task < 704) { const int kt = task / 44, nt = task % 44; transpose_tile(p.w_in, PROJ_N, kt * 64, nt * 64, ws_wtin(p), 1024, RowId(), lds); }
    else { const int q = task - 704, kt = q >> 4, nt = q & 15; transpose_tile(p.w_out, 1024, kt * 64, nt * 64, ws_wtout(p), 1024, RowId(), lds); }
  }
}

DI void phase1(const Params& p, int bid, int nb, char* lds) {
  const int lane = tid_() & 63, wid = tid_() >> 6;
  const float* mod = ws_mod(p);
  for (int row = bid * 8 + wid; row < NTOK; row += nb * 8) {
    const int b = row >> 11;
    const float* xr = p.x + (size_t)row * DM;
    f32x4 v[4]; float ss = 0.f;
#pragma unroll
    for (int i = 0; i < 4; ++i) { v[i] = *(const f32x4*)(xr + lane * 4 + 256 * i); ss += v[i][0] * v[i][0] + v[i][1] * v[i][1] + v[i][2] * v[i][2] + v[i][3] * v[i][3]; }
    ss = wave_sum(ss);
    const float rstd = rsqrtf(ss * (1.0f / DM) + 1e-6f);
#pragma unroll
    for (int i = 0; i < 4; ++i) {
      const int col = lane * 4 + 256 * i;
      const f32x4 g = *(const f32x4*)(p.norm1_g + col), sh = *(const f32x4*)(mod + b * 6144 + col), sc = *(const f32x4*)(mod + b * 6144 + 1024 + col);
      float o[4];
#pragma unroll
      for (int j = 0; j < 4; ++j) o[j] = v[i][j] * rstd * g[j] * (1.0f + sc[j]) + sh[j];
      u32x2 w; w.x = pack2(o[0], o[1]); w.y = pack2(o[2], o[3]);
      *(u32x2*)(ws_h1(p) + (size_t)row * DM + col) = w;
    }
  }
}

constexpr int GBM = 256, GBN = 128, GBK = 32, GROW = 80, G_LDSA = GBM * GROW, G_STAGE = (GBM + GBN) * GROW;
template <class ARow, class Epi>
DI void gemm_tile(const bf16_t* A, int lda, ARow arow, const bf16_t* Bt, int ldb, int n0, int K, Epi epi, char* lds) {
  const int t = tid_(), lane = t & 63, wid = t >> 6, wm = wid >> 1, wn = wid & 1, r32 = lane & 31, hi = lane >> 5;
  const int srow = t >> 2, sch = t & 3;
  const bf16_t* a0p = A + (size_t)arow(srow) * lda + sch * 8;
  const bf16_t* a1p = A + (size_t)arow(srow + 128) * lda + sch * 8;
  const bf16_t* bp = Bt + (size_t)(n0 + srow) * ldb + sch * 8;
  const int wa0 = srow * GROW + sch * 16, wa1 = (srow + 128) * GROW + sch * 16, wb = G_LDSA + srow * GROW + sch * 16;
  const int ra = (wm * 64 + r32) * GROW + hi * 16, rb = G_LDSA + (wn * 64 + r32) * GROW + hi * 16;
  f32x16 acc[2][2];
#pragma unroll
  for (int i = 0; i < 2; ++i)
#pragma unroll
    for (int j = 0; j < 2; ++j)
#pragma unroll
      for (int r = 0; r < 16; ++r) acc[i][j][r] = 0.f;
  u32x4 ga0 = *(const u32x4*)a0p, ga1 = *(const u32x4*)a1p, gb = *(const u32x4*)bp;
  __syncthreads();
  *(u32x4*)(lds + wa0) = ga0; *(u32x4*)(lds + wa1) = ga1; *(u32x4*)(lds + wb) = gb;
  __syncthreads();
  const int nk = K / GBK;
  for (int kt = 0; kt < nk; ++kt) {
    char* cur = lds + (kt & 1) * G_STAGE;
    char* nxt = lds + ((kt + 1) & 1) * G_STAGE;
    if (kt + 1 < nk) { ga0 = *(const u32x4*)(a0p + (kt + 1) * GBK); ga1 = *(const u32x4*)(a1p + (kt + 1) * GBK); gb = *(const u32x4*)(bp + (kt + 1) * GBK); }
#pragma unroll
    for (int ks = 0; ks < 2; ++ks) {
      bf16x8 a[2], b[2];
#pragma unroll
      for (int i = 0; i < 2; ++i) { a[i] = *(const bf16x8*)(cur + ra + i * 32 * GROW + ks * 32); b[i] = *(const bf16x8*)(cur + rb + i * 32 * GROW + ks * 32); }
#pragma unroll
      for (int i = 0; i < 2; ++i)
#pragma unroll
        for (int j = 0; j < 2; ++j) acc[i][j] = __builtin_amdgcn_mfma_f32_32x32x16_bf16(a[i], b[j], acc[i][j], 0, 0, 0);
    }
    if (kt + 1 < nk) { *(u32x4*)(nxt + wa0) = ga0; *(u32x4*)(nxt + wa1) = ga1; *(u32x4*)(nxt + wb) = gb; }
    __syncthreads();
  }
#pragma unroll
  for (int i = 0; i < 2; ++i)
#pragma unroll
    for (int r = 0; r < 16; ++r) epi(wm * 64 + i * 32 + crow(r, hi), wn * 64 + r32, acc[i][0][r], acc[i][1][r]);
}

struct ARowBase { int base; DI int operator()(int r) const { return base + r; } };

struct EpiProj { bf16_t* o; int row0, col0; DI void operator()(int r, int c, float v0, float v1) const {
  bf16_t* q = o + (size_t)(row0 + r) * PROJ_LD + col0 + c; q[0] = f2bf(v0); q[32] = f2bf(v1); } };
DI void phase2(const Params& p, int bid, int nb, char* lds) {
  constexpr int NT = PROJ_LD / GBN;
  for (int tile = bid; tile < (NTOK / GBM) * NT; tile += nb) {
    const int mt = tile / NT, nt = tile % NT;
    gemm_tile(ws_h1(p), DM, ARowBase{mt * GBM}, ws_wtin(p), DM, nt * GBN, DM, EpiProj{ws_proj(p), mt * GBM, nt * GBN}, lds);
  }
}

DI float proj_shift(const bf16_t* proj, const float* mu, int gt, int col) {
  const float pv = bf2f(proj[(size_t)gt * PROJ_LD + col]);
  const float pp = (gt & (SEQ - 1)) ? bf2f(proj[(size_t)(gt - 1) * PROJ_LD + col]) : 0.f;
  return pv + mu[col] * (pp - pv);
}
DI void phase3a(const Params& p, int bid, int nb, char* lds) {
  const int t = tid_(), lane = t & 63, wid = t >> 6;
  float* xl = (float*)lds;
  const bf16_t* proj = ws_proj(p);
  for (int tile = bid; tile < NTOK / 16; tile += nb) {
    const int t0 = tile * 16;
    __syncthreads();
    for (int idx = t; idx < 16 * 256; idx += NTHR) {
      const int tok = idx >> 8, col = idx & 255;
      float v = proj_shift(proj, p.shift_mu, t0 + tok, C_WL + col);
      if (col < 64) v = tanhf(v); else if (col >= 128) v = sigmoidf_(v);
      xl[idx] = v;
    }
    __syncthreads();
    const int c = t;
    float acc[16];
#pragma unroll
    for (int i = 0; i < 16; ++i) acc[i] = 0.f;
    for (int k4 = 0; k4 < 16; ++k4) {
      float w[4];
#pragma unroll
      for (int j = 0; j < 4; ++j) w[j] = p.w_decay_up[(k4 * 4 + j) * RW + c];
#pragma unroll
      for (int i = 0; i < 16; ++i) { const f32x4 xv = *(const f32x4*)(xl + i * 256 + k4 * 4); acc[i] += xv[0] * w[0] + xv[1] * w[1] + xv[2] * w[2] + xv[3] * w[3]; }
    }
    {
      const float w0c = p.w0[c];
#pragma unroll
      for (int i = 0; i < 16; ++i) {
        const float z = -(w0c + acc[i]);
        const float sp = fmaxf(z, 0.f) + log1pf(__expf(-fabsf(z)));
        ws_ee(p)[(size_t)(t0 + i) * RW + c] = f2bf(__expf(-sp - 0.5f));
      }
    }
#pragma unroll
    for (int i = 0; i < 16; ++i) acc[i] = 0.f;
    for (int k4 = 0; k4 < 32; ++k4) {
      float w[4];
#pragma unroll
      for (int j = 0; j < 4; ++j) w[j] = p.w_gate_up[(k4 * 4 + j) * RW + c];
#pragma unroll
      for (int i = 0; i < 16; ++i) { const f32x4 xv = *(const f32x4*)(xl + i * 256 + 128 + k4 * 4); acc[i] += xv[0] * w[0] + xv[1] * w[1] + xv[2] * w[2] + xv[3] * w[3]; }
    }
#pragma unroll
    for (int i = 0; i < 16; ++i) ws_gg(p)[(size_t)(t0 + i) * RW + c] = f2bf(acc[i]);
#pragma unroll
    for (int i = 0; i < 16; ++i) acc[i] = 0.f;
    for (int k4 = 0; k4 < 16; ++k4) {
      float w[4];
#pragma unroll
      for (int j = 0; j < 4; ++j) w[j] = p.w_aaa_up[(k4 * 4 + j) * RW + c];
#pragma unroll
      for (int i = 0; i < 16; ++i) { const f32x4 xv = *(const f32x4*)(xl + i * 256 + 64 + k4 * 4); acc[i] += xv[0] * w[0] + xv[1] * w[1] + xv[2] * w[2] + xv[3] * w[3]; }
    }
    {
      const float a0c = p.a0[c], kkc = p.k_k[c], kac = p.k_a[c], rkc = p.r_k[c];
#pragma unroll
      for (int i = 0; i < 16; ++i) {
        const int gt = t0 + i;
        const float a = sigmoidf_(a0c + acc[i]);
        const float r = proj_shift(proj, p.shift_mu, gt, C_R + c);
        const float k = proj_shift(proj, p.shift_mu, gt, C_K + c);
        float kk = k * kkc;
        const float nrm = fmaxf(sqrtf(wave_sum(kk * kk)), 1e-12f);
        kk = kk / nrm;
        const float kp = k * (1.0f + (a - 1.0f) * kac);
        const float bs = wave_sum(r * kp * rkc);
        ws_kp(p)[(size_t)gt * RW + c] = f2bf(kp);
        ws_kk(p)[(size_t)gt * RW + c] = f2bf(kk);
        ws_bb(p)[(size_t)gt * RW + c] = f2bf(kk * a);
        if (lane == 0) ws_bonus(p)[gt * NH + wid] = bs;
      }
    }
  }
}

DI void phase3b(const Params& p, int bid, int nb, char* lds) {
  const int t = tid_(), lane = t & 63, wid = t >> 6;
  float* ql = (float*)lds;
  const bf16_t* proj = ws_proj(p);
  for (int tile = bid; tile < NTOK / 16; tile += nb) {
    const int t0 = tile * 16;
    __syncthreads();
    for (int idx = t; idx < 16 * 512; idx += NTHR) ql[idx] = bf2f(proj[(size_t)(t0 + (idx >> 9)) * PROJ_LD + C_Q + (idx & 511)]);
#pragma unroll
    for (int q = 0; q < 2; ++q) {
      const int gt = t0 + wid * 2 + q;
      const float v0 = bf2f(proj[(size_t)gt * PROJ_LD + C_CKV + lane * 2]), v1 = bf2f(proj[(size_t)gt * PROJ_LD + C_CKV + lane * 2 + 1]);
      const float rs = rsqrtf(wave_sum(v0 * v0 + v1 * v1) * (1.0f / 128.0f) + 1e-6f);
      *(unsigned*)(ws_ckv(p) + (size_t)gt * 128 + lane * 2) = pack2(v0 * rs * p.kv_norm_g[lane * 2], v1 * rs * p.kv_norm_g[lane * 2 + 1]);
      const float u = bf2f(proj[(size_t)gt * PROJ_LD + C_KI + lane]);
      const float rs2 = rsqrtf(wave_sum(u * u) * (1.0f / 64.0f) + 1e-6f);
      ws_kidx(p)[(size_t)gt * 64 + lane] = f2bf(u * rs2 * p.k_idx_norm_g[lane]);
    }
    __syncthreads();
    const int h = wid;
#pragma unroll 1
    for (int ps = 0; ps < 2; ++ps) {
      const int cidx = lane + 64 * ps;
      float w[64];
      const float* wp = p.w_uk + (size_t)(cidx * NH + h) * HD;
#pragma unroll
      for (int d4 = 0; d4 < 16; ++d4) { const f32x4 wv = *(const f32x4*)(wp + d4 * 4); w[d4 * 4] = wv[0]; w[d4 * 4 + 1] = wv[1]; w[d4 * 4 + 2] = wv[2]; w[d4 * 4 + 3] = wv[3]; }
#pragma unroll 1
      for (int i = 0; i < 16; ++i) {
        float acc = 0.f;
#pragma unroll
        for (int d4 = 0; d4 < 16; ++d4) { const f32x4 qv = *(const f32x4*)(ql + i * 512 + h * 64 + d4 * 4); acc += qv[0] * w[d4 * 4] + qv[1] * w[d4 * 4 + 1] + qv[2] * w[d4 * 4 + 2] + qv[3] * w[d4 * 4 + 3]; }
        ws_qlat(p)[((size_t)(t0 + i) * NH + h) * 128 + cidx] = f2bf(acc * 0.125f);
      }
    }
  }
}

DI float xhalf_sum(float v) { auto rr = __builtin_amdgcn_permlane32_swap(__float_as_uint(v), __float_as_uint(v), false, false); return __uint_as_float(rr[0]) + __uint_as_float(rr[1]); }
DI float dpp_sum8(float v) {
  v += __int_as_float(__builtin_amdgcn_update_dpp(0, __float_as_int(v), 0xB1, 0xF, 0xF, true));
  v += __int_as_float(__builtin_amdgcn_update_dpp(0, __float_as_int(v), 0x4E, 0xF, 0xF, true));
  v += __int_as_float(__builtin_amdgcn_update_dpp(0, __float_as_int(v), 0x141, 0xF, 0xF, true));
  return v;
}
DI float dpp_sum16b(float v) { v = dpp_sum8(v); v += __int_as_float(__builtin_amdgcn_update_dpp(0, __float_as_int(v), 0x140, 0xF, 0xF, true)); return v; }
DI u32x2 pk4(float a, float b, float c, float d) { u32x2 w; w.x = cvtpk(a, b); w.y = cvtpk(c, d); return w; }
DI void ld4(const bf16_t* p, float* o) { const u32x2 w = *(const u32x2*)p; o[0] = __uint_as_float(w.x << 16); o[1] = __uint_as_float(w.x & 0xffff0000u); o[2] = __uint_as_float(w.y << 16); o[3] = __uint_as_float(w.y & 0xffff0000u); }
constexpr int XL_ROW = 528;
template <int MODE> DI void phase3_mfma(const Params& p, int bid, int nb, char* lds) {
  const int t_ = tid_(), wid = t_ >> 6, h = wid;
  const bf16_t* proj = ws_proj(p);
  float* PL = (float*)(lds + 64 * XL_ROW + 8 * 14336);
  static_assert(64 * XL_ROW + 8 * 14336 + 7 * 512 * 4 <= LDS_BYTES - 64, "prep LDS map");
  for (int i = t_; i < RW; i += NTHR) { PL[i] = p.w0[i]; PL[512 + i] = p.a0[i]; PL[1024 + i] = p.k_k[i]; PL[1536 + i] = p.k_a[i]; PL[2048 + i] = p.r_k[i]; PL[2560 + i] = p.shift_mu[C_R + i]; PL[3072 + i] = p.shift_mu[C_K + i]; }
  for (int tile = bid; tile < NTOK / 64; tile += nb) {
    const int t0 = tile * 64;
    int t = t_;
    asm volatile("" : "+v"(t));
    const int lane = t & 63, r32_ = lane & 31, hi_ = lane >> 5;
    __syncthreads();
#pragma unroll
    for (int i = 0; i < 4; ++i) {
      const int id = t + 512 * i, tok = id >> 5, cc = (id & 31) * 8, gt = t0 + tok;
      float v[8], pv[8];
      const bool firstt = (gt & (SEQ - 1)) == 0;
      load8(proj + (unsigned)(gt * PROJ_LD + C_WL + cc), v);
      load8(proj + (unsigned)((firstt ? gt : gt - 1) * PROJ_LD + C_WL + cc), pv);
      const f32x4 m0 = *(const f32x4*)(p.shift_mu + C_WL + cc), m1 = *(const f32x4*)(p.shift_mu + C_WL + cc + 4);
      const float esc = (cc < 64) ? 2.0f : -1.0f;
      float x[8];
#pragma unroll
      for (int j = 0; j < 8; ++j) {
        const float mu = j < 4 ? m0[j] : m1[j - 4];
        const float pj = firstt ? 0.f : pv[j];
        const float xv = v[j] + mu * (pj - v[j]);
        const float rc = 1.0f / (__expf(esc * xv) + 1.0f);
        x[j] = (cc < 64) ? (1.0f - 2.0f * rc) : ((cc >= 128) ? rc : xv);
      }
      u32x4 w; w.x = cvtpk(x[0], x[1]); w.y = cvtpk(x[2], x[3]); w.z = cvtpk(x[4], x[5]); w.w = cvtpk(x[6], x[7]);
      *(u32x4*)(lds + tok * XL_ROW + cc * 2) = w;
    }
    if (MODE & 2) {
#pragma unroll
    for (int it = 0; it < 2; ++it) {
      const int gt = t0 + wid * 8 + it * 4 + (lane >> 4), c0 = (lane & 15) * 8;
      float v[8]; load8(proj + (size_t)gt * PROJ_LD + C_CKV + c0, v);
      float ss = 0.f;
#pragma unroll
      for (int j = 0; j < 8; ++j) ss += v[j] * v[j];
      const float rs = rsqrtf(dpp_sum16b(ss) * (1.0f / 128.0f) + 1e-6f);
      const f32x4 g0 = *(const f32x4*)(p.kv_norm_g + c0), g1 = *(const f32x4*)(p.kv_norm_g + c0 + 4);
      u32x4 w; w.x = cvtpk(v[0] * rs * g0[0], v[1] * rs * g0[1]); w.y = cvtpk(v[2] * rs * g0[2], v[3] * rs * g0[3]);
      w.z = cvtpk(v[4] * rs * g1[0], v[5] * rs * g1[1]); w.w = cvtpk(v[6] * rs * g1[2], v[7] * rs * g1[3]);
      *(u32x4*)(ws_ckv(p) + (size_t)gt * 128 + c0) = w;
    }
    {
      const int gt = t0 + wid * 8 + (lane >> 3), c0 = (lane & 7) * 8;
      float v[8]; load8(proj + (size_t)gt * PROJ_LD + C_KI + c0, v);
      float ss = 0.f;
#pragma unroll
      for (int j = 0; j < 8; ++j) ss += v[j] * v[j];
      const float rs = rsqrtf(dpp_sum8(ss) * (1.0f / 64.0f) + 1e-6f);
      const f32x4 g0 = *(const f32x4*)(p.k_idx_norm_g + c0), g1 = *(const f32x4*)(p.k_idx_norm_g + c0 + 4);
      u32x4 w; w.x = cvtpk(v[0] * rs * g0[0], v[1] * rs * g0[1]); w.y = cvtpk(v[2] * rs * g0[2], v[3] * rs * g0[3]);
      w.z = cvtpk(v[4] * rs * g1[0], v[5] * rs * g1[1]); w.w = cvtpk(v[6] * rs * g1[2], v[7] * rs * g1[3]);
      *(u32x4*)(ws_kidx(p) + (size_t)gt * 64 + c0) = w;
    }
    }
    __syncthreads();
#pragma unroll 1
    for (int nt = 0; nt < 2; ++nt) {
      int r32 = r32_, hi = hi_;
      asm volatile("" : "+v"(r32), "+v"(hi));
      const int gt = t0 + nt * 32 + r32;
      const bool first = (gt & (SEQ - 1)) == 0;
      const int gp = first ? gt : gt - 1;
      const char* xrow = lds + (nt * 32 + r32) * XL_ROW + hi * 16;
      const int chb = h * HD + 4 * hi;
      char* RBt = lds + 64 * XL_ROW + wid * 14336; char* KBt = RBt + 4752; char* OBt = KBt + 4752;
      const int t0w = t0 + nt * 32, frow = lane >> 3, fch = lane & 7;
      const int cwo = r32 * 144 + hi * 8;
#define P3_FLUSH(dst_, ld_, col_) do { _Pragma("unroll") for (int i_ = 0; i_ < 4; ++i_) { const int row_ = frow + 8 * i_; \
        *(u32x4*)((dst_) + (unsigned)((t0w + row_) * (ld_) + (col_) + fch * 8)) = *(const u32x4*)(OBt + row_ * 144 + fch * 16); } } while (0)
      if (MODE & 1) {
      f32x16 acc[2];
#pragma unroll
      for (int mt = 0; mt < 2; ++mt)
#pragma unroll
        for (int r = 0; r < 16; ++r) acc[mt][r] = 0.f;
#pragma unroll
      for (int ks = 0; ks < 4; ++ks) {
        const bf16x8 bx = *(const bf16x8*)(xrow + ks * 32);
#pragma unroll
        for (int mt = 0; mt < 2; ++mt) { const bf16x8 aw = *(const bf16x8*)(ws_wdt(p) + (unsigned)(((h * 2 + mt) * 4 + ks) * 512 + (hi * 32 + r32) * 8)); acc[mt] = __builtin_amdgcn_mfma_f32_32x32x16_bf16(aw, bx, acc[mt], 0, 0, 0); }
      }
#pragma unroll
      for (int mt = 0; mt < 2; ++mt)
#pragma unroll
        for (int g = 0; g < 4; ++g) {
          const int ch = chb + 32 * mt + 8 * g;
          const f32x4 w0v = *(const f32x4*)(PL + ch);
          float e[4];
#pragma unroll
          for (int i = 0; i < 4; ++i) e[i] = 0.6065306597f / (1.0f + __expf(-(w0v[i] + acc[mt][4 * g + i])));
          *(u32x2*)(OBt + cwo + mt * 64 + g * 16) = pk4(e[0], e[1], e[2], e[3]);
        }
      P3_FLUSH(ws_ee(p), RW, h * HD);
      __builtin_amdgcn_sched_barrier(0);
#pragma unroll
      for (int mt = 0; mt < 2; ++mt)
#pragma unroll
        for (int r = 0; r < 16; ++r) acc[mt][r] = 0.f;
#pragma unroll
      for (int ks = 0; ks < 8; ++ks) {
        const bf16x8 bx = *(const bf16x8*)(xrow + 256 + ks * 32);
#pragma unroll
        for (int mt = 0; mt < 2; ++mt) { const bf16x8 aw = *(const bf16x8*)(ws_wgt(p) + (unsigned)(((h * 2 + mt) * 8 + ks) * 512 + (hi * 32 + r32) * 8)); acc[mt] = __builtin_amdgcn_mfma_f32_32x32x16_bf16(aw, bx, acc[mt], 0, 0, 0); }
      }
#pragma unroll
      for (int mt = 0; mt < 2; ++mt)
#pragma unroll
        for (int g = 0; g < 4; ++g)
          *(u32x2*)(OBt + cwo + mt * 64 + g * 16) =
              pk4(acc[mt][4 * g] + 0.0f, acc[mt][4 * g + 1] + 0.0f, acc[mt][4 * g + 2] + 0.0f, acc[mt][4 * g + 3] + 0.0f);
      P3_FLUSH(ws_gg(p), RW, h * HD);
      __builtin_amdgcn_sched_barrier(0);
#pragma unroll
      for (int mt = 0; mt < 2; ++mt)
#pragma unroll
        for (int r = 0; r < 16; ++r) acc[mt][r] = 0.f;
#pragma unroll
      for (int ks = 0; ks < 4; ++ks) {
        const bf16x8 bx = *(const bf16x8*)(xrow + 128 + ks * 32);
#pragma unroll
        for (int mt = 0; mt < 2; ++mt) { const bf16x8 aw = *(const bf16x8*)(ws_wat(p) + (unsigned)(((h * 2 + mt) * 4 + ks) * 512 + (hi * 32 + r32) * 8)); acc[mt] = __builtin_amdgcn_mfma_f32_32x32x16_bf16(aw, bx, acc[mt], 0, 0, 0); }
      }
      __builtin_amdgcn_sched_barrier(0);
#pragma unroll
      for (int i_ = 0; i_ < 5; ++i_) {
        const int row_ = frow + 8 * i_;
        if (row_ < 33) {
          int tk_ = t0w - 1 + row_; tk_ = tk_ < 0 ? 0 : tk_;
          *(u32x4*)(RBt + row_ * 144 + fch * 16) = *(const u32x4*)(proj + (unsigned)(tk_ * PROJ_LD + C_R + h * HD + fch * 8));
          *(u32x4*)(KBt + row_ * 144 + fch * 16) = *(const u32x4*)(proj + (unsigned)(tk_ * PROJ_LD + C_K + h * HD + fch * 8));
        }
      }
      float ss = 0.f, bs = 0.f; float av[2][16];
#pragma unroll
      for (int mt = 0; mt < 2; ++mt)
#pragma unroll
        for (int g = 0; g < 4; ++g) {
          const int ch = chb + 32 * mt + 8 * g;
          float rv[4], rp[4], kv[4], kq[4];
          ld4((const bf16_t*)(RBt + 144 + cwo + mt * 64 + g * 16), rv); ld4((const bf16_t*)(KBt + 144 + cwo + mt * 64 + g * 16), kv);
          ld4((const bf16_t*)(RBt + cwo + mt * 64 + g * 16), rp); ld4((const bf16_t*)(KBt + cwo + mt * 64 + g * 16), kq);
          const f32x4 mur = *(const f32x4*)(PL + 2560 + ch), muk = *(const f32x4*)(PL + 3072 + ch);
          const f32x4 a0v = *(const f32x4*)(PL + 512 + ch), kkc = *(const f32x4*)(PL + 1024 + ch), kac = *(const f32x4*)(PL + 1536 + ch), rkc = *(const f32x4*)(PL + 2048 + ch);
          float kp[4];
#pragma unroll
          for (int i = 0; i < 4; ++i) {
            const float a = 1.0f / (1.0f + __expf(-(a0v[i] + acc[mt][4 * g + i])));
            const float r = rv[i] + mur[i] * ((first ? 0.f : rp[i]) - rv[i]);
            const float k = kv[i] + muk[i] * ((first ? 0.f : kq[i]) - kv[i]);
            const float kk = k * kkc[i];
            ss += kk * kk;
            kp[i] = k * (1.0f + (a - 1.0f) * kac[i]);
            bs += r * kp[i] * rkc[i];
            av[mt][4 * g + i] = a;
          }
          *(u32x2*)(OBt + cwo + mt * 64 + g * 16) = pk4(kp[0], kp[1], kp[2], kp[3]);
        }
      P3_FLUSH(ws_kp(p), RW, h * HD);
      __builtin_amdgcn_sched_barrier(0);
      ss = xhalf_sum(ss); bs = xhalf_sum(bs);
      const float inv = 1.0f / fmaxf(sqrtf(ss), 1e-12f);
#pragma unroll
      for (int mt = 0; mt < 2; ++mt)
#pragma unroll
        for (int g = 0; g < 4; ++g) {
          const int ch = chb + 32 * mt + 8 * g;
          float kv[4], kq[4];
          ld4((const bf16_t*)(KBt + 144 + cwo + mt * 64 + g * 16), kv); ld4((const bf16_t*)(KBt + cwo + mt * 64 + g * 16), kq);
          const f32x4 muk = *(const f32x4*)(PL + 3072 + ch), kkc = *(const f32x4*)(PL + 1024 + ch);
          float kn[4];
#pragma unroll
          for (int i = 0; i < 4; ++i) { const float kprev = first ? 0.f : kq[i]; kn[i] = (kv[i] + muk[i] * (kprev - kv[i])) * kkc[i] * inv; }
          *(u32x2*)(OBt + cwo + mt * 64 + g * 16) = pk4(kn[0], kn[1], kn[2], kn[3]);
          *(u32x2*)(RBt + cwo + mt * 64 + g * 16) = pk4(kn[0] * av[mt][4 * g], kn[1] * av[mt][4 * g + 1], kn[2] * av[mt][4 * g + 2], kn[3] * av[mt][4 * g + 3]);
        }
      P3_FLUSH(ws_kk(p), RW, h * HD);
      { char* const OBs = OBt; OBt = RBt; P3_FLUSH(ws_bb(p), RW, h * HD); OBt = OBs; }
      if (hi == 0) ws_bonus(p)[gt * NH + h] = bs;
      }
#undef P3_FLUSH
    }
  }
}

DI void phase4a(const Params& p, int bid, int nb, char* lds) {
  const int t = tid_(), i = t >> 3, cg8 = (t & 7) * 8;
  const bf16_t* proj = ws_proj(p);
  for (int task = bid; task < BATCH * NH; task += nb) {
    const int b = task >> 3, h = task & 7;
    const int cbase = h * HD + cg8;
    float mu_r[8], st[8], rprev[8];
#pragma unroll
    for (int j = 0; j < 8; ++j) { mu_r[j] = p.shift_mu[C_R + cbase + j]; st[j] = 0.f; rprev[j] = 0.f; }
    const float mu_v = p.shift_mu[C_V + h * HD + i];
    float vprev = 0.f;
    const size_t tok0 = (size_t)b * SEQ;
    u32x4 n_kk, n_bb, n_kp, n_ee, n_r; bf16_t n_v;
    {
      const size_t g = tok0;
      n_kk = *(const u32x4*)(ws_kk(p) + g * RW + cbase); n_bb = *(const u32x4*)(ws_bb(p) + g * RW + cbase);
      n_kp = *(const u32x4*)(ws_kp(p) + g * RW + cbase); n_ee = *(const u32x4*)(ws_ee(p) + g * RW + cbase);
      n_r = *(const u32x4*)(proj + g * PROJ_LD + C_R + cbase); n_v = proj[g * PROJ_LD + C_V + h * HD + i];
    }
    for (int s = 0; s < SEQ; ++s) {
      const u32x4 c_kk = n_kk, c_bb = n_bb, c_kp = n_kp, c_ee = n_ee, c_r = n_r; const bf16_t c_v = n_v;
      if (s + 1 < SEQ) {
        const size_t g = tok0 + s + 1;
        n_kk = *(const u32x4*)(ws_kk(p) + g * RW + cbase); n_bb = *(const u32x4*)(ws_bb(p) + g * RW + cbase);
        n_kp = *(const u32x4*)(ws_kp(p) + g * RW + cbase); n_ee = *(const u32x4*)(ws_ee(p) + g * RW + cbase);
        n_r = *(const u32x4*)(proj + g * PROJ_LD + C_R + cbase); n_v = proj[g * PROJ_LD + C_V + h * HD + i];
      }
      float kk[8], bb[8], kp[8], ee[8], rr[8];
      unpack8(c_kk, kk); unpack8(c_bb, bb); unpack8(c_kp, kp); unpack8(c_ee, ee); unpack8(c_r, rr);
      const float vraw = bf2f(c_v);
      const float v = vraw + mu_v * (vprev - vraw); vprev = vraw;
      float sa = 0.f;
#pragma unroll
      for (int j = 0; j < 8; ++j) sa += st[j] * kk[j];
      sa += __shfl_xor(sa, 1); sa += __shfl_xor(sa, 2); sa += __shfl_xor(sa, 4);
      sa = -sa;
      float y = 0.f;
#pragma unroll
      for (int j = 0; j < 8; ++j) {
        const float r = rr[j] + mu_r[j] * (rprev[j] - rr[j]); rprev[j] = rr[j];
        const float w = __expf(-ee[j]);
        st[j] = st[j] * w + sa * bb[j] + v * kp[j];
        y += st[j] * r;
      }
      y += __shfl_xor(y, 1); y += __shfl_xor(y, 2); y += __shfl_xor(y, 4);
      if ((t & 7) == 0) ws_y(p)[(tok0 + s) * RW + h * HD + i] = y;
    }
  }
}

DI float dpp_sum16(float v) {
  v += __int_as_float(__builtin_amdgcn_update_dpp(0, __float_as_int(v), 0xB1, 0xF, 0xF, true));
  v += __int_as_float(__builtin_amdgcn_update_dpp(0, __float_as_int(v), 0x4E, 0xF, 0xF, true));
  v += __int_as_float(__builtin_amdgcn_update_dpp(0, __float_as_int(v), 0x141, 0xF, 0xF, true));
  v += __int_as_float(__builtin_amdgcn_update_dpp(0, __float_as_int(v), 0x140, 0xF, 0xF, true));
  return v;
}
constexpr int CK = 16;
constexpr int SC_CH = 16, SC_BUF = 5 * SC_CH * 64 * 4 + SC_CH * 32 * 4 + SC_CH * 8;
DI void phase4a_v2(const Params& p, int bid, int nb, char* lds) {
  const int t = tid_(), rowl = t >> 4, cg = t & 15;
  const bf16_t* proj = ws_proj(p);
  for (int task = bid; task < BATCH * NH * 2; task += nb) {
    const int b = task >> 4, h = (task >> 1) & 7, half = task & 1;
    const size_t tok0 = (size_t)b * SEQ;
    const int sst = t >> 4, scol = h * HD + cg * 4;
    const int vst = t >> 5, vrow = t & 31, vcol = C_V + h * HD + half * 32 + vrow;
    float mur[4];
#pragma unroll
    for (int j = 0; j < 4; ++j) mur[j] = p.shift_mu[C_R + scol + j];
    const float muv = p.shift_mu[vcol];
    u32x2 g_kk, g_bb, g_kp, g_ee, g_r, g_rp; bf16_t g_v, g_vp;
    auto stage_load = [&](int c) {
      if (t < 256) {
        const size_t g = tok0 + c * SC_CH + sst;
        g_kk = *(const u32x2*)(ws_kk(p) + g * RW + scol); g_bb = *(const u32x2*)(ws_bb(p) + g * RW + scol);
        g_kp = *(const u32x2*)(ws_kp(p) + g * RW + scol); g_ee = *(const u32x2*)(ws_ee(p) + g * RW + scol);
        g_r = *(const u32x2*)(proj + g * PROJ_LD + C_R + scol);
        if (c * SC_CH + sst > 0) g_rp = *(const u32x2*)(proj + (g - 1) * PROJ_LD + C_R + scol); else { g_rp.x = 0u; g_rp.y = 0u; }
      }
      const size_t gv = tok0 + c * SC_CH + vst;
      g_v = proj[gv * PROJ_LD + vcol];
      g_vp = (c * SC_CH + vst > 0) ? proj[(gv - 1) * PROJ_LD + vcol] : (bf16_t)0;
    };
    auto stage_write = [&](char* buf) {
      if (t < 256) {
        float* W = (float*)buf + sst * 64 + cg * 4;
        f32x4 o;
        o[0] = __expf(-__uint_as_float(g_ee.x << 16)); o[1] = __expf(-__uint_as_float(g_ee.x & 0xffff0000u));
        o[2] = __expf(-__uint_as_float(g_ee.y << 16)); o[3] = __expf(-__uint_as_float(g_ee.y & 0xffff0000u));
        *(f32x4*)W = o;
        o[0] = __uint_as_float(g_kk.x << 16); o[1] = __uint_as_float(g_kk.x & 0xffff0000u); o[2] = __uint_as_float(g_kk.y << 16); o[3] = __uint_as_float(g_kk.y & 0xffff0000u);
        *(f32x4*)(W + SC_CH * 64) = o;
        o[0] = __uint_as_float(g_bb.x << 16); o[1] = __uint_as_float(g_bb.x & 0xffff0000u); o[2] = __uint_as_float(g_bb.y << 16); o[3] = __uint_as_float(g_bb.y & 0xffff0000u);
        *(f32x4*)(W + 2 * SC_CH * 64) = o;
        o[0] = __uint_as_float(g_kp.x << 16); o[1] = __uint_as_float(g_kp.x & 0xffff0000u); o[2] = __uint_as_float(g_kp.y << 16); o[3] = __uint_as_float(g_kp.y & 0xffff0000u);
        *(f32x4*)(W + 3 * SC_CH * 64) = o;
        float r[4] = {__uint_as_float(g_r.x << 16), __uint_as_float(g_r.x & 0xffff0000u), __uint_as_float(g_r.y << 16), __uint_as_float(g_r.y & 0xffff0000u)};
        float rp[4] = {__uint_as_float(g_rp.x << 16), __uint_as_float(g_rp.x & 0xffff0000u), __uint_as_float(g_rp.y << 16), __uint_as_float(g_rp.y & 0xffff0000u)};
#pragma unroll
        for (int j = 0; j < 4; ++j) o[j] = r[j] + mur[j] * (rp[j] - r[j]);
        *(f32x4*)(W + 4 * SC_CH * 64) = o;
      }
      const float v = bf2f(g_v), vp = bf2f(g_vp);
      ((float*)buf)[5 * SC_CH * 64 + vst * 32 + vrow] = v + muv * (vp - v);
    };
    float st[4] = {0.f, 0.f, 0.f, 0.f};
    __syncthreads();
    stage_load(0); stage_write(lds);
    __syncthreads();
    float* yout = ws_y(p) + tok0 * RW + h * HD + half * 32 + rowl;
    for (int c = 0; c < SEQ / SC_CH; ++c) {
      const char* cur = lds + (c & 1) * SC_BUF;
      if (c + 1 < SEQ / SC_CH) stage_load(c + 1);
      const float* Wb = (const float*)cur + cg * 4;
      const float* Vb = (const float*)cur + 5 * SC_CH * 64 + rowl;
      float yv[SC_CH];
#pragma unroll
      for (int s = 0; s < SC_CH; ++s) {
        const f32x4 w = *(const f32x4*)(Wb + s * 64), kk = *(const f32x4*)(Wb + SC_CH * 64 + s * 64), bb = *(const f32x4*)(Wb + 2 * SC_CH * 64 + s * 64);
        const f32x4 kp = *(const f32x4*)(Wb + 3 * SC_CH * 64 + s * 64), rr = *(const f32x4*)(Wb + 4 * SC_CH * 64 + s * 64);
        const float v = Vb[s * 32];
        float sa = (st[0] * kk[0] + st[1] * kk[1]) + (st[2] * kk[2] + st[3] * kk[3]);
        sa = -dpp_sum16(sa);
#pragma unroll
        for (int j = 0; j < 4; ++j) st[j] = st[j] * w[j] + (sa * bb[j] + v * kp[j]);
        float y = (st[0] * rr[0] + st[1] * rr[1]) + (st[2] * rr[2] + st[3] * rr[3]);
        yv[s] = dpp_sum16(y);
      }
      if (cg == 0) {
#pragma unroll
        for (int s = 0; s < SC_CH; ++s) yout[(size_t)(c * SC_CH + s) * RW] = yv[s];
      }
      if (c + 1 < SEQ / SC_CH) stage_write(lds + ((c + 1) & 1) * SC_BUF);
      __syncthreads();
    }
  }
}

DI void moe_tr_wave(const Params& p, int id, int lane, float* tl  ) {
  const int which = id >> 12, q = id & 4095, e = q >> 7, r = q & 127;
  const float* src; int N, k0, n0;
  if (which < 2) { src = (which == 0 ? p.e_gate : p.e_up) + (size_t)e * 1024 * 512; N = 512; k0 = (r >> 3) * 64; n0 = (r & 7) * 64; }
  else { src = p.e_down + (size_t)e * 512 * 1024; N = 1024; k0 = (r >> 4) * 64; n0 = (r & 15) * 64; }
  const int lr = lane >> 4, lc = (lane & 15) * 4;
  f32x4 g[16];
#pragma unroll
  for (int i = 0; i < 16; ++i) g[i] = *(const f32x4*)(src + (size_t)(k0 + lr + 4 * i) * N + n0 + lc);
#pragma unroll
  for (int i = 0; i < 16; ++i) { float* d = tl + (lr + 4 * i) * 65 + lc; d[0] = g[i][0]; d[1] = g[i][1]; d[2] = g[i][2]; d[3] = g[i][3]; }
  bf16_t* dst;
  { const int n = n0 + lane;
    if (which < 2) dst = ws_wgu(p) + (size_t)e * 1024 * 1024 + (size_t)((n >> 7) * 256 + (n & 127) + which * 128) * 1024 + k0;
    else dst = ws_wd(p) + (size_t)e * 1024 * 512 + (size_t)n * 512 + k0; }
#pragma unroll
  for (int c8 = 0; c8 < 8; ++c8) {
    float v[8];
#pragma unroll
    for (int j = 0; j < 8; ++j) v[j] = tl[(c8 * 8 + j) * 65 + lane];
    u32x4 w; w.x = cvtpk(v[0], v[1]); w.y = cvtpk(v[2], v[3]); w.z = cvtpk(v[4], v[5]); w.w = cvtpk(v[6], v[7]);
    *(u32x4*)(dst + c8 * 8) = w;
  }
}

typedef float f32x2p __attribute__((ext_vector_type(2)));
DI void phase4a_v3(const Params& p, int bid, int nb, char* lds) {
  const int t = tid_(), wid = __builtin_amdgcn_readfirstlane(t >> 6);
  const int rowl = (t >> 3) & 31, cg = t & 7;
  const int pt = t & 255;
  const bf16_t* proj = ws_proj(p);
  for (int task = bid; task < BATCH * NH * 2; task += nb) {
    const int b = task >> 4, h = (task >> 1) & 7, half = task & 1;
    const size_t tok0 = (size_t)b * SEQ;
    const int sst = pt >> 4, scq = pt & 15, scol = h * HD + scq * 4;
    const int vst = pt >> 5, vrow = pt & 31, vcol = C_V + h * HD + half * 32 + vrow;
    float mur[4];
#pragma unroll
    for (int j = 0; j < 4; ++j) mur[j] = p.shift_mu[C_R + scol + j];
    const float muv = p.shift_mu[vcol];
    u32x2 g_kk, g_bb, g_kp, g_ee, g_r, g_rp; bf16_t g_v0, g_v0p, g_v1, g_v1p;
#define SC_LOAD(c_) do { const int c__ = (c_); const size_t g = tok0 + c__ * SC_CH + sst; \
      g_kk = *(const u32x2*)(ws_kk(p) + g * RW + scol); g_bb = *(const u32x2*)(ws_bb(p) + g * RW + scol); \
      g_kp = *(const u32x2*)(ws_kp(p) + g * RW + scol); g_ee = *(const u32x2*)(ws_ee(p) + g * RW + scol); \
      g_r = *(const u32x2*)(proj + g * PROJ_LD + C_R + scol); \
      g_rp = *(const u32x2*)(proj + (g - ((c__ * SC_CH + sst > 0) ? 1 : 0)) * PROJ_LD + C_R + scol); \
      if (c__ * SC_CH + sst == 0) { g_rp.x = 0u; g_rp.y = 0u; } \
      const size_t gv = tok0 + c__ * SC_CH + vst; \
      g_v0 = proj[gv * PROJ_LD + vcol]; g_v0p = (c__ * SC_CH + vst > 0) ? proj[(gv - 1) * PROJ_LD + vcol] : (bf16_t)0; \
      g_v1 = proj[(gv + 8) * PROJ_LD + vcol]; g_v1p = proj[(gv + 7) * PROJ_LD + vcol]; } while (0)
#define SC_WRITE(buf_) do { float* W = (float*)(buf_) + sst * 64 + scq * 4; f32x4 o; \
      o[0] = __expf(-__uint_as_float(g_ee.x << 16)); o[1] = __expf(-__uint_as_float(g_ee.x & 0xffff0000u)); \
      o[2] = __expf(-__uint_as_float(g_ee.y << 16)); o[3] = __expf(-__uint_as_float(g_ee.y & 0xffff0000u)); *(f32x4*)W = o; \
      o[0] = __uint_as_float(g_kk.x << 16); o[1] = __uint_as_float(g_kk.x & 0xffff0000u); o[2] = __uint_as_float(g_kk.y << 16); o[3] = __uint_as_float(g_kk.y & 0xffff0000u); *(f32x4*)(W + SC_CH * 64) = o; \
      o[0] = __uint_as_float(g_bb.x << 16); o[1] = __uint_as_float(g_bb.x & 0xffff0000u); o[2] = __uint_as_float(g_bb.y << 16); o[3] = __uint_as_float(g_bb.y & 0xffff0000u); *(f32x4*)(W + 2 * SC_CH * 64) = o; \
      o[0] = __uint_as_float(g_kp.x << 16); o[1] = __uint_as_float(g_kp.x & 0xffff0000u); o[2] = __uint_as_float(g_kp.y << 16); o[3] = __uint_as_float(g_kp.y & 0xffff0000u); *(f32x4*)(W + 3 * SC_CH * 64) = o; \
      { const float r0 = __uint_as_float(g_r.x << 16), r1 = __uint_as_float(g_r.x & 0xffff0000u), r2 = __uint_as_float(g_r.y << 16), r3 = __uint_as_float(g_r.y & 0xffff0000u); \
        const float q0 = __uint_as_float(g_rp.x << 16), q1 = __uint_as_float(g_rp.x & 0xffff0000u), q2 = __uint_as_float(g_rp.y << 16), q3 = __uint_as_float(g_rp.y & 0xffff0000u); \
        o[0] = r0 + mur[0] * (q0 - r0); o[1] = r1 + mur[1] * (q1 - r1); o[2] = r2 + mur[2] * (q2 - r2); o[3] = r3 + mur[3] * (q3 - r3); \
        const f32x4 wv_ = *(const f32x4*)W, bv_ = *(const f32x4*)(W + 2 * SC_CH * 64), kv_ = *(const f32x4*)(W + 3 * SC_CH * 64); \
        const float br_ = dpp_sum16((bv_[0] * o[0] + bv_[1] * o[1]) + (bv_[2] * o[2] + bv_[3] * o[3])), kr_ = dpp_sum16((kv_[0] * o[0] + kv_[1] * o[1]) + (kv_[2] * o[2] + kv_[3] * o[3])); \
        if (scq == 0) { float* X_ = (float*)(buf_) + 5 * SC_CH * 64 + SC_CH * 32 + sst * 2; X_[0] = br_; X_[1] = kr_; } \
        o[0] *= wv_[0]; o[1] *= wv_[1]; o[2] *= wv_[2]; o[3] *= wv_[3]; *(f32x4*)(W + 4 * SC_CH * 64) = o; } \
      { const float v0 = bf2f(g_v0), v0p = bf2f(g_v0p), v1 = bf2f(g_v1), v1p = bf2f(g_v1p); float* Vw = (float*)(buf_) + 5 * SC_CH * 64 + vst * 32 + vrow; \
        Vw[0] = v0 + muv * (v0p - v0); Vw[8 * 32] = v1 + muv * (v1p - v1); } } while (0)
    f32x2p st2[4];
#pragma unroll
    for (int j = 0; j < 4; ++j) st2[j] = (f32x2p){0.f, 0.f};
    __syncthreads();
    if (wid >= 4) { SC_LOAD(0); SC_WRITE(lds); SC_LOAD(1); }
    __syncthreads();
    float* yout = ws_y(p) + tok0 * RW + h * HD + half * 32 + rowl;
    for (int c = 0; c < SEQ / SC_CH; ++c) {
      const char* cur = lds + (c & 1) * SC_BUF;
      if (wid >= 4) {
        if (c + 1 < SEQ / SC_CH) SC_WRITE(lds + ((c + 1) & 1) * SC_BUF);
        if (c + 2 < SEQ / SC_CH) SC_LOAD(c + 2);
        if ((c & 7) == 3) {
          const int tid_tr = (task * 4 + (wid - 4)) + (BATCH * NH * 2 * 4) * (c >> 3);
          if (tid_tr < 3 * 4096) moe_tr_wave(p, tid_tr, t & 63, (float*)(lds + 2 * SC_BUF + 128) + (wid - 4) * (64 * 65));
        }
      } else {
        const float* Wb = (const float*)cur + cg * 8;
        const float* Vb = (const float*)cur + 5 * SC_CH * 64 + rowl;
        float yv[SC_CH];
#pragma unroll
        for (int s = 0; s < SC_CH; ++s) {
          const f32x4 w0 = *(const f32x4*)(Wb + s * 64), w1 = *(const f32x4*)(Wb + s * 64 + 4);
          const f32x4 k0 = *(const f32x4*)(Wb + SC_CH * 64 + s * 64), k1 = *(const f32x4*)(Wb + SC_CH * 64 + s * 64 + 4);
          const f32x4 b0 = *(const f32x4*)(Wb + 2 * SC_CH * 64 + s * 64), b1 = *(const f32x4*)(Wb + 2 * SC_CH * 64 + s * 64 + 4);
          const f32x4 p0 = *(const f32x4*)(Wb + 3 * SC_CH * 64 + s * 64), p1 = *(const f32x4*)(Wb + 3 * SC_CH * 64 + s * 64 + 4);
          const f32x4 r0 = *(const f32x4*)(Wb + 4 * SC_CH * 64 + s * 64), r1 = *(const f32x4*)(Wb + 4 * SC_CH * 64 + s * 64 + 4);
          const float v = Vb[s * 32];
#define LO2(x) __builtin_shufflevector(x, x, 0, 1)
#define HI2(x) __builtin_shufflevector(x, x, 2, 3)
          const f32x2p xs = *(const f32x2p*)((const float*)cur + 5 * SC_CH * 64 + SC_CH * 32 + s * 2);
          f32x2p sa2 = st2[0] * LO2(k0), yd2 = st2[0] * LO2(r0);
          sa2 = st2[1] * HI2(k0) + sa2; yd2 = st2[1] * HI2(r0) + yd2;
          sa2 = st2[2] * LO2(k1) + sa2; yd2 = st2[2] * LO2(r1) + yd2;
          sa2 = st2[3] * HI2(k1) + sa2; yd2 = st2[3] * HI2(r1) + yd2;
          const float sa = -dpp_sum8(sa2[0] + sa2[1]);
          const float yd = dpp_sum8(yd2[0] + yd2[1]);
          yv[s] = yd + sa * xs[0] + v * xs[1];
          const f32x2p sav = {sa, sa}, vv = {v, v};
          st2[0] = st2[0] * LO2(w0) + (sav * LO2(b0) + vv * LO2(p0));
          st2[1] = st2[1] * HI2(w0) + (sav * HI2(b0) + vv * HI2(p0));
          st2[2] = st2[2] * LO2(w1) + (sav * LO2(b1) + vv * LO2(p1));
          st2[3] = st2[3] * HI2(w1) + (sav * HI2(b1) + vv * HI2(p1));
#undef LO2
#undef HI2
        }
        if (cg == 0) {
#pragma unroll
          for (int s = 0; s < SC_CH; ++s) yout[(size_t)(c * SC_CH + s) * RW] = yv[s];
        }
      }
      __syncthreads();
    }
#undef SC_LOAD
#undef SC_WRITE
  }
}

DI void moe_tr_small(const Params& p, int id, int lane, float* tl  ) {
  const int which = id >> 14, r_ = id & 16383, e = r_ >> 9, rr = r_ & 511;
  const float* src; int N, k0, n0;
  if (which < 2) { src = (which == 0 ? p.e_gate : p.e_up) + (size_t)e * 1024 * 512; N = 512; k0 = (rr >> 5) * 64; n0 = (rr & 31) * 16; }
  else { src = p.e_down + (size_t)e * 512 * 1024; N = 1024; k0 = (rr >> 6) * 64; n0 = (rr & 63) * 16; }
  const float* sp = src + (size_t)(k0 + lane) * N + n0;
  const f32x4 g0 = *(const f32x4*)sp, g1 = *(const f32x4*)(sp + 4), g2 = *(const f32x4*)(sp + 8), g3 = *(const f32x4*)(sp + 12);
  float* d = tl + lane * 17;
  d[0] = g0[0]; d[1] = g0[1]; d[2] = g0[2]; d[3] = g0[3]; d[4] = g1[0]; d[5] = g1[1]; d[6] = g1[2]; d[7] = g1[3];
  d[8] = g2[0]; d[9] = g2[1]; d[10] = g2[2]; d[11] = g2[3]; d[12] = g3[0]; d[13] = g3[1]; d[14] = g3[2]; d[15] = g3[3];
  const int nn = lane & 15, kq = lane >> 4;
  float v[16];
#pragma unroll
  for (int i = 0; i < 16; ++i) v[i] = tl[(kq * 16 + i) * 17 + nn];
  u32x4 w0, w1;
  w0.x = cvtpk(v[0], v[1]); w0.y = cvtpk(v[2], v[3]); w0.z = cvtpk(v[4], v[5]); w0.w = cvtpk(v[6], v[7]);
  w1.x = cvtpk(v[8], v[9]); w1.y = cvtpk(v[10], v[11]); w1.z = cvtpk(v[12], v[13]); w1.w = cvtpk(v[14], v[15]);
  const int n = n0 + nn;
  bf16_t* dst;
  if (which < 2) dst = ws_wgu(p) + (size_t)e * 1024 * 1024 + (size_t)((n >> 7) * 256 + (n & 127) + which * 128) * 1024 + k0 + kq * 16;
  else dst = ws_wd(p) + (size_t)e * 1024 * 512 + (size_t)n * 512 + k0 + kq * 16;
  *(u32x4*)dst = w0; *(u32x4*)(dst + 8) = w1;
}

constexpr int CS_PSZ = 23552, CS_SLSZ = 13312, CS_SL0 = 4 * CS_PSZ, CS_CON = CS_SL0 + 4 * CS_SLSZ;
DI f32x4v cs_mm16(const float* A, int sam, int sak, const float* B, int sbk, int sbn, f32x4v c, int l16, int g) {
#pragma unroll
  for (int q = 0; q < 4; ++q) c = __builtin_amdgcn_mfma_f32_16x16x4f32(A[l16 * sam + (4 * q + g) * sak], B[(4 * q + g) * sbk + l16 * sbn], c, 0, 0, 0);
  return c;
}
DI void cs_st16(float* D, f32x4v c, int l16, int g) {
#pragma unroll
  for (int r = 0; r < 4; ++r) D[(4 * g + r) * 16 + l16] = c[r];
}
DI f32x4v cs_ld16(const float* D, int l16, int g) { f32x4v c;
#pragma unroll
  for (int r = 0; r < 4; ++r) c[r] = D[(4 * g + r) * 16 + l16];
  return c; }
DI void cs_st4(bf16_t* base, int ld, f32x4v c) {
  const unsigned p01 = cvtpk(c[0] + 0.0f, c[1] + 0.0f), p23 = cvtpk(c[2] + 0.0f, c[3] + 0.0f);
  base[0] = (bf16_t)p01; base[ld] = (bf16_t)(p01 >> 16); base[2 * ld] = (bf16_t)p23; base[3 * ld] = (bf16_t)(p23 >> 16);
}
constexpr int CS_FLG = CS_CON + 6144 + 2 * 64 * 17 * 4;
DI void cs_wait(volatile int* f, int v) {
  while (__builtin_amdgcn_readfirstlane(*f) < v) __builtin_amdgcn_s_sleep(2);
  __builtin_amdgcn_fence(__ATOMIC_ACQUIRE, "workgroup");
}
DI void cs_post(volatile int* f, int v, int lane) {
  __builtin_amdgcn_fence(__ATOMIC_RELEASE, "workgroup");
  if (lane == 0) *f = v;
}
static_assert(CS_FLG + 48 <= LDS_BYTES - 64, "chunked scan LDS map");
#define CS_LAS __attribute__((address_space(3)))
DI void phase4a_chunk(const Params& p, int bid, int nb, char* lds) {
  const int t = tid_(), wid = __builtin_amdgcn_readfirstlane(t >> 6), lane = t & 63, l16 = lane & 15, g = lane >> 4;
  const bf16_t* proj = ws_proj(p);
  const f32x4v z4 = {0.f, 0.f, 0.f, 0.f};
  const bf16x8 zf = {0, 0, 0, 0, 0, 0, 0, 0};
  volatile int* fl_ready = (volatile int*)(lds + CS_FLG); volatile int* fl_done = fl_ready + 4;
  if (t < 12) fl_ready[t] = 0;
  int seq0 = 0;
  for (int task = bid; task < BATCH * NH * 2; task += nb, seq0 += SEQ / CK / 4) {
    const int b = task >> 4, h = (task >> 1) & 7, half = task & 1;
    const int tok0 = b * SEQ;
    f32x4v Sacc[4] = {z4, z4, z4, z4};
    char* Sb = lds + CS_CON; char* Ub = Sb + 4608;
    const int i0 = (wid & 1) * 16;
    __syncthreads();
    if (wid < 2) { for (int i = lane; i < 16 * 144 / 4; i += 64) ((unsigned*)(Sb + i0 * 144))[i] = 0u; }
    u32x4 pf[10]; bf16_t pf_rp = 0, pf_v[9];
#define CS_PF(cc) do { const int ct_ = tok0 + (cc) * CK; \
      const unsigned ro_ = (unsigned)((ct_ + (lane >> 3)) * RW + h * HD + (lane & 7) * 8) * 2u; \
      const unsigned rp_ = (unsigned)((ct_ + (lane >> 3)) * PROJ_LD + C_R + h * HD + (lane & 7) * 8) * 2u; \
      pf[0] = *(const u32x4*)((const char*)ws_ee(p) + ro_); pf[1] = *(const u32x4*)((const char*)ws_ee(p) + ro_ + 8 * RW * 2); \
      pf[2] = *(const u32x4*)((const char*)ws_kk(p) + ro_); pf[3] = *(const u32x4*)((const char*)ws_kk(p) + ro_ + 8 * RW * 2); \
      pf[4] = *(const u32x4*)((const char*)ws_bb(p) + ro_); pf[5] = *(const u32x4*)((const char*)ws_bb(p) + ro_ + 8 * RW * 2); \
      pf[6] = *(const u32x4*)((const char*)ws_kp(p) + ro_); pf[7] = *(const u32x4*)((const char*)ws_kp(p) + ro_ + 8 * RW * 2); \
      pf[8] = *(const u32x4*)((const char*)proj + rp_); pf[9] = *(const u32x4*)((const char*)proj + rp_ + 8 * PROJ_LD * 2); \
      { const int tp_ = (ct_ - 1 < tok0) ? tok0 : ct_ - 1; pf_rp = proj[(unsigned)(tp_ * PROJ_LD + C_R + h * HD + lane)]; } \
      _Pragma("unroll") for (int q_ = 0; q_ < 9; ++q_) { int tv_ = ct_ + (lane >> 5) * 8 + q_ - 1; tv_ = (tv_ < tok0) ? tok0 : tv_; \
        pf_v[q_] = proj[(unsigned)(tv_ * PROJ_LD + C_V + h * HD + half * 32 + (lane & 31))]; } } while (0)
    if (wid >= 4) CS_PF(wid - 4);
    const float mur = p.shift_mu[C_R + h * HD + lane], muv = p.shift_mu[C_V + h * HD + half * 32 + (lane & 31)];
    if (wid < 2) __builtin_amdgcn_s_setprio(3);
    for (int rnd = 0; rnd < SEQ / CK / 4; ++rnd) {
      if (wid >= 4) {
        const int pw = wid - 4, c = rnd * 4 + pw, ct0 = tok0 + c * CK;
        char* ps = lds + pw * CS_PSZ;
        bf16_t* AB = (bf16_t*)ps; bf16_t* BT = AB + 16 * 72; bf16_t* KT = BT + 16 * 72; bf16_t* RB = KT + 16 * 72;
        float* KHT = (float*)(ps + 9216);
        float* Nf = (float*)(ps + 13312); float* AKB = Nf + 256; float* ABR = AKB + 256; float* AKR = ABR + 256;
        float* T0 = AKR + 256; float* T1 = Nf; float* Pm = T0 + 256; float* Mm = Pm + 256;
        bf16_t* ABT = (bf16_t*)(Mm + 256);
        bf16_t* APb = (bf16_t*)BT;
        bf16_t* MTb = (bf16_t*)KT;
        bf16_t* W1b = MTb + 16 * 24;
        bf16_t* ABRT = W1b + 16 * 24;
        char* sl = lds + CS_SL0 + pw * CS_SLSZ;
        bf16_t* QT = (bf16_t*)sl; bf16_t* APT = QT + 16 * 72; bf16_t* BHT = APT + 16 * 72; bf16_t* GGT = BHT + 64 * 24; bf16_t* HT = GGT + 64 * 24; bf16_t* VT = HT + 16 * 24;
        float* GAM = (float*)(sl + 2304 * 2 + 3072 * 2 + 768 + 1536);
        u32x4 bhw0, bhw1, vw; float gamC;
        {
          const int j = lane, col = h * HD + j;
          float cum[CK];
          {
            char* rawl = ps + 13312 + lane * 16;
#pragma unroll
            for (int i = 0; i < 10; ++i) *(u32x4*)(rawl + i * 1024) = pf[i];
          }
          float rprev = (c * CK > 0) ? bf2f(pf_rp) : 0.f;
          {
            const int vi = lane & 31, sh = lane >> 5, vcol = C_V + h * HD + half * 32 + vi;
            float vprev = (c * CK + sh * 8 > 0) ? bf2f(pf_v[0]) : 0.f;
            float vv[8];
#pragma unroll
            for (int q = 0; q < 8; ++q) { const float vr = bf2f(pf_v[q + 1]); vv[q] = vr + muv * (vprev - vr); vprev = vr; }
            vw.x = cvtpk(vv[0], vv[1]); vw.y = cvtpk(vv[2], vv[3]); vw.z = cvtpk(vv[4], vv[5]); vw.w = cvtpk(vv[6], vv[7]);
          }
          if (rnd + 1 < SEQ / CK / 4) CS_PF(c + 4);
          const bf16_t* RAW = (const bf16_t*)(ps + 13312);
          float run = 0.f;
#pragma unroll
          for (int tt = 0; tt < CK; ++tt) { run += bf2f(RAW[tt * 64 + j]); cum[tt] = run; }
          gamC = __expf(-run);
          float bhv[CK], abv[CK];
          float gprev = 1.0f;
#pragma unroll
          for (int tt = 0; tt < CK; tt += 2) {
            float bt2[2], kt2[2], rb2[2];
#pragma unroll
            for (int u = 0; u < 2; ++u) { const int t_ = tt + u;
              const float kkr = bf2f(RAW[1024 + t_ * 64 + j]), ber = bf2f(RAW[2048 + t_ * 64 + j]), kpr = bf2f(RAW[3072 + t_ * 64 + j]), rr = bf2f(RAW[4096 + t_ * 64 + j]);
              const float rsh = rr + mur * (rprev - rr); rprev = rr;
              const float gt_ = __expf(-cum[t_]), gin = __builtin_amdgcn_rcpf(gt_), gh = gamC * gin;
              abv[t_] = -gprev * kkr; gprev = gt_;
              bt2[u] = ber * gin; kt2[u] = kpr * gin; rb2[u] = gt_ * rsh; bhv[t_] = ber * gh;
              KHT[j * 16 + t_] = kpr * gh; }
            const unsigned pa = cvtpk(abv[tt], abv[tt + 1]), pb = cvtpk(bt2[0], bt2[1]), pk = cvtpk(kt2[0], kt2[1]), pr = cvtpk(rb2[0], rb2[1]);
            AB[tt * 72 + j] = (bf16_t)pa; AB[(tt + 1) * 72 + j] = (bf16_t)(pa >> 16);
            BT[tt * 72 + j] = (bf16_t)pb; BT[(tt + 1) * 72 + j] = (bf16_t)(pb >> 16);
            KT[tt * 72 + j] = (bf16_t)pk; KT[(tt + 1) * 72 + j] = (bf16_t)(pk >> 16);
            RB[tt * 72 + j] = (bf16_t)pr; RB[(tt + 1) * 72 + j] = (bf16_t)(pr >> 16);
          }
          u32x4 bh0, bh1;
          bhw0.x = cvtpk(bhv[0], bhv[1]); bhw0.y = cvtpk(bhv[2], bhv[3]); bhw0.z = cvtpk(bhv[4], bhv[5]); bhw0.w = cvtpk(bhv[6], bhv[7]);
          bhw1.x = cvtpk(bhv[8], bhv[9]); bhw1.y = cvtpk(bhv[10], bhv[11]); bhw1.z = cvtpk(bhv[12], bhv[13]); bhw1.w = cvtpk(bhv[14], bhv[15]);
          bh0.x = cvtpk(abv[0], abv[1]); bh0.y = cvtpk(abv[2], abv[3]); bh0.z = cvtpk(abv[4], abv[5]); bh0.w = cvtpk(abv[6], abv[7]);
          bh1.x = cvtpk(abv[8], abv[9]); bh1.y = cvtpk(abv[10], abv[11]); bh1.z = cvtpk(abv[12], abv[13]); bh1.w = cvtpk(abv[14], abv[15]);
          *(u32x4*)(ABT + j * 24) = bh0; *(u32x4*)(ABT + j * 24 + 8) = bh1;
        }
        {
          bf16x8 fb[2], fk[2], fa[2], fr[2];
#pragma unroll
          for (int ks = 0; ks < 2; ++ks) { const int off = l16 * 72 + 8 * g + 32 * ks;
            fb[ks] = *(const bf16x8*)(BT + off); fk[ks] = *(const bf16x8*)(KT + off); fa[ks] = *(const bf16x8*)(AB + off); fr[ks] = *(const bf16x8*)(RB + off); }
          f32x4v n_ = z4, akb = z4, abr = z4, akr = z4;
#pragma unroll
          for (int ks = 0; ks < 2; ++ks) {
            n_ = __builtin_amdgcn_mfma_f32_16x16x32_bf16(fb[ks], fa[ks], n_, 0, 0, 0);
            akb = __builtin_amdgcn_mfma_f32_16x16x32_bf16(fk[ks], fa[ks], akb, 0, 0, 0);
            abr = __builtin_amdgcn_mfma_f32_16x16x32_bf16(fb[ks], fr[ks], abr, 0, 0, 0);
            akr = __builtin_amdgcn_mfma_f32_16x16x32_bf16(fk[ks], fr[ks], akr, 0, 0, 0);
          }
#pragma unroll
          for (int r = 0; r < 4; ++r) { const int s_ = 4 * g + r, t_ = l16;
            Nf[s_ * 16 + t_] = (s_ < t_) ? n_[r] : 0.f; AKB[s_ * 16 + t_] = (s_ < t_) ? akb[r] : 0.f;
            ABR[s_ * 16 + t_] = (s_ <= t_) ? abr[r] : 0.f; AKR[s_ * 16 + t_] = (s_ <= t_) ? akr[r] : 0.f;
            Pm[s_ * 16 + t_] = ((s_ < t_) ? n_[r] : 0.f) + ((s_ == t_) ? 1.0f : 0.f); }
          { const int t_ = l16; float a4[4];
#pragma unroll
            for (int r = 0; r < 4; ++r) a4[r] = (4 * g + r <= t_) ? abr[r] : 0.f;
            *(u32x2*)(ABRT + t_ * 24 + 4 * g) = pk4(a4[0], a4[1], a4[2], a4[3]); }
        }
        {
          f32x4v c_;
          c_ = cs_mm16(Nf, 16, 1, Nf, 16, 1, z4, l16, g); cs_st16(T0, c_, l16, g);
          c_ = cs_mm16(Pm, 16, 1, T0, 16, 1, cs_ld16(Pm, l16, g), l16, g); cs_st16(Pm, c_, l16, g);
          c_ = cs_mm16(T0, 16, 1, T0, 16, 1, z4, l16, g); cs_st16(T1, c_, l16, g);
          c_ = cs_mm16(Pm, 16, 1, T1, 16, 1, cs_ld16(Pm, l16, g), l16, g); cs_st16(Pm, c_, l16, g);
          c_ = cs_mm16(T1, 16, 1, T1, 16, 1, z4, l16, g); cs_st16(T0, c_, l16, g);
          c_ = cs_mm16(Pm, 16, 1, T0, 16, 1, cs_ld16(Pm, l16, g), l16, g); cs_st16(Mm, c_, l16, g);
          *(u32x2*)(MTb + l16 * 24 + 4 * g) = pk4(c_[0] + 0.0f, c_[1] + 0.0f, c_[2] + 0.0f, c_[3] + 0.0f);
          f32x4v w_ = z4;
#pragma unroll
          for (int q = 0; q < 4; ++q) w_ = __builtin_amdgcn_mfma_f32_16x16x4f32(Mm[(4 * q + g) * 16 + l16], AKB[l16 * 16 + 4 * q + g], w_, 0, 0, 0);
          *(u32x2*)(W1b + l16 * 24 + 4 * g) = pk4(w_[0] + 0.0f, w_[1] + 0.0f, w_[2] + 0.0f, w_[3] + 0.0f);
        }
        cs_wait(fl_done + pw, seq0 + rnd); cs_wait(fl_done + 4 + pw, seq0 + rnd);
        *(u32x4*)(BHT + lane * 24) = bhw0; *(u32x4*)(BHT + lane * 24 + 8) = bhw1;
        GAM[lane] = gamC;
        *(u32x4*)(VT + (lane & 31) * 24 + (lane >> 5) * 8) = vw;
        {
          const bf16x8 mF = (g < 2) ? *(const bf16x8*)(MTb + l16 * 24 + 8 * g) : zf;
          const bf16x8 rF = (g < 2) ? *(const bf16x8*)(ABRT + l16 * 24 + 8 * g) : zf;
          const bf16x8 wF = (g < 2) ? *(const bf16x8*)(W1b + l16 * 24 + 8 * g) : zf;
#pragma unroll
          for (int nt = 0; nt < 4; ++nt) {
            const bf16x8 bF = (g < 2) ? *(const bf16x8*)(ABT + (16 * nt + l16) * 24 + 8 * g) : zf;
            const f32x4v c_ = __builtin_amdgcn_mfma_f32_16x16x32_bf16(mF, bF, z4, 0, 0, 0);
            cs_st4(APT + (4 * g) * 72 + 16 * nt + l16, 72, c_);
            *(u32x2*)(APb + (16 * nt + l16) * 24 + 4 * g) = pk4(c_[0] + 0.0f, c_[1] + 0.0f, c_[2] + 0.0f, c_[3] + 0.0f);
          }
#pragma unroll
          for (int nt = 0; nt < 4; ++nt) {
            f32x4v c_;
#pragma unroll
            for (int r = 0; r < 4; ++r) c_[r] = bf2f(RB[(4 * g + r) * 72 + 16 * nt + l16]);
            const bf16x8 bF = (g < 2) ? *(const bf16x8*)(APb + (16 * nt + l16) * 24 + 8 * g) : zf;
            c_ = __builtin_amdgcn_mfma_f32_16x16x32_bf16(rF, bF, c_, 0, 0, 0);
            cs_st4(QT + (4 * g) * 72 + 16 * nt + l16, 72, c_);
          }
          {
            f32x4v c_;
#pragma unroll
            for (int r = 0; r < 4; ++r) c_[r] = AKR[l16 * 16 + 4 * g + r];
            c_ = __builtin_amdgcn_mfma_f32_16x16x32_bf16(rF, wF, c_, 0, 0, 0);
            cs_st4(HT + (4 * g) * 24 + l16, 24, c_);
          }
#pragma unroll
          for (int mt = 0; mt < 4; ++mt) {
            f32x4v c_;
#pragma unroll
            for (int r = 0; r < 4; ++r) c_[r] = KHT[(16 * mt + 4 * g + r) * 16 + l16];
            const bf16x8 aF = (g < 2) ? *(const bf16x8*)(BHT + (16 * mt + l16) * 24 + 8 * g) : zf;
            c_ = __builtin_amdgcn_mfma_f32_16x16x32_bf16(aF, wF, c_, 0, 0, 0);
            cs_st4(GGT + (16 * mt + 4 * g) * 24 + l16, 24, c_);
          }
        }
        cs_post(fl_ready + pw, seq0 + rnd + 1, lane);
      }
      else if (wid >= 2) {
        float* tl = (float*)(lds + CS_CON + 6144) + (wid - 2) * (64 * 17);
#pragma unroll 1
        for (int q = 0; q < 3; ++q) moe_tr_small(p, ((task * 2 + (wid - 2)) * 96 + rnd * 3 + q), lane, tl);
      }
      else {
#pragma unroll 1
        for (int k = 0; k < 4; ++k) {
          const char* sl = lds + CS_SL0 + k * CS_SLSZ;
          cs_wait(fl_ready + k, seq0 + rnd + 1);
          const bf16_t* QT = (const bf16_t*)sl; const bf16_t* APT = QT + 16 * 72; const bf16_t* BHT = APT + 16 * 72; const bf16_t* GGT = BHT + 64 * 24; const bf16_t* HT = GGT + 64 * 24; const bf16_t* VT = HT + 16 * 24;
          const float* GAM = (const float*)(sl + 2304 * 2 + 3072 * 2 + 768 + 1536);
          bf16x8 sA[2], qF[2], aF[2];
#pragma unroll
          for (int ks = 0; ks < 2; ++ks) { sA[ks] = *(const bf16x8*)(Sb + (i0 + l16) * 144 + (8 * g + 32 * ks) * 2);
            qF[ks] = *(const bf16x8*)(QT + l16 * 72 + 8 * g + 32 * ks); aF[ks] = *(const bf16x8*)(APT + l16 * 72 + 8 * g + 32 * ks); }
          const bf16x8 vF = (g < 2) ? *(const bf16x8*)(VT + (i0 + l16) * 24 + 8 * g) : zf;
          const bf16x8 hF = (g < 2) ? *(const bf16x8*)(HT + l16 * 24 + 8 * g) : zf;
          f32x4v yT = z4;
          yT = __builtin_amdgcn_mfma_f32_16x16x32_bf16(qF[0], sA[0], yT, 0, 0, 0);
          yT = __builtin_amdgcn_mfma_f32_16x16x32_bf16(qF[1], sA[1], yT, 0, 0, 0);
          yT = __builtin_amdgcn_mfma_f32_16x16x32_bf16(hF, vF, yT, 0, 0, 0);
          {
            float* yo = ws_y(p) + (size_t)(tok0 + (rnd * 4 + k) * CK + 4 * g) * RW + h * HD + half * 32 + i0 + l16;
#pragma unroll
            for (int r = 0; r < 4; ++r) yo[(size_t)r * RW] = yT[r];
          }
          f32x4v u = z4;
          u = __builtin_amdgcn_mfma_f32_16x16x32_bf16(sA[0], aF[0], u, 0, 0, 0);
          u = __builtin_amdgcn_mfma_f32_16x16x32_bf16(sA[1], aF[1], u, 0, 0, 0);
          cs_st4((bf16_t*)(Ub + (i0 + 4 * g) * 48 + l16 * 2), 24, u);
          const bf16x8 uF = (g < 2) ? *(const bf16x8*)(Ub + (i0 + l16) * 48 + 16 * g) : zf;
#pragma unroll
          for (int nt = 0; nt < 4; ++nt) {
            const float gm = GAM[16 * nt + l16];
            const bf16x8 bF = (g < 2) ? *(const bf16x8*)(BHT + (16 * nt + l16) * 24 + 8 * g) : zf;
            const bf16x8 gF = (g < 2) ? *(const bf16x8*)(GGT + (16 * nt + l16) * 24 + 8 * g) : zf;
            f32x4v a_ = Sacc[nt] * gm;
            a_ = __builtin_amdgcn_mfma_f32_16x16x32_bf16(uF, bF, a_, 0, 0, 0);
            a_ = __builtin_amdgcn_mfma_f32_16x16x32_bf16(vF, gF, a_, 0, 0, 0);
            Sacc[nt] = a_;
            cs_st4((bf16_t*)(Sb + (i0 + 4 * g) * 144 + (16 * nt + l16) * 2), 72, a_);
          }
          cs_post(fl_done + wid * 4 + k, seq0 + rnd + 1, lane);
        }
      }
    }
  }
  __builtin_amdgcn_s_setprio(0);
  __syncthreads();
}

DI unsigned fkey(float f) { const unsigned u = __float_as_uint(f); return (u & 0x80000000u) ? ~u : (u | 0x80000000u); }
DI int block_sum_i(int v, int* red, int wid, int lane) {
  for (int o = 32; o; o >>= 1) v += __shfl_xor(v, o);
  __syncthreads();
  if (lane == 0) red[wid] = v;
  __syncthreads();
  int s = 0;
#pragma unroll
  for (int w = 0; w < 8; ++w) s += red[w];
  return s;
}
DI void phase4b(const Params& p, int bid, int nb, char* lds) {
  const int t = tid_(), lane = t & 63, wid = t >> 6;
  float* qf = (float*)lds;
  float* wi = qf + 256;
  int* red = (int*)(wi + 4);
  int* wtie = red + 8;
  const bf16_t* proj = ws_proj(p);
  for (int gq = bid; gq < NTOK; gq += nb) {
    const int b = gq >> 11, s = gq & (SEQ - 1);
    const int n = ((s >> 6) + 1) * 64;
    unsigned* mrow = ws_mask(p) + (size_t)gq * 64;
    if (n <= 256) {
      if (t < 64) mrow[t] = (t * 32 < n) ? 0xffffffffu : 0u;
      continue;
    }
    __syncthreads();
    if (t < 256) qf[t] = bf2f(proj[(size_t)gq * PROJ_LD + C_QI + t]) * 0.125f;
    else if (t < 260) wi[t - 256] = bf2f(proj[(size_t)gq * PROJ_LD + C_WI + t - 256]) * 0.5f;
    __syncthreads();
    unsigned uk[4];
#pragma unroll 1
    for (int q = 0; q < 4; ++q) {
      const int key = t * 4 + q;
      uk[q] = 0u;
      if (key < n) {
        float kf[64];
        const bf16_t* kr = ws_kidx(p) + ((size_t)b * SEQ + key) * 64;
#pragma unroll
        for (int d8 = 0; d8 < 8; ++d8) load8(kr + d8 * 8, kf + d8 * 8);
        float sc = 0.f;
#pragma unroll
        for (int hh = 0; hh < 4; ++hh) {
          float dot = 0.f;
#pragma unroll
          for (int d4 = 0; d4 < 16; ++d4) { const f32x4 qv = *(const f32x4*)(qf + hh * 64 + d4 * 4); dot += qv[0] * kf[d4 * 4] + qv[1] * kf[d4 * 4 + 1] + qv[2] * kf[d4 * 4 + 2] + qv[3] * kf[d4 * 4 + 3]; }
          sc += wi[hh] * fmaxf(dot, 0.f);
        }
        sc = sc + 0.0f;
        uk[q] = fkey(sc);
      }
    }
    unsigned T = 0u;
    for (int bit = 31; bit >= 0; --bit) {
      const unsigned cand = T | (1u << bit);
      const int c = (uk[0] >= cand) + (uk[1] >= cand) + (uk[2] >= cand) + (uk[3] >= cand);
      if (block_sum_i(c, red, wid, lane) >= 256) T = cand;
    }
    const int cgt = block_sum_i((uk[0] > T) + (uk[1] > T) + (uk[2] > T) + (uk[3] > T), red, wid, lane);
    const int need = 256 - cgt;
    const int tl = (uk[0] == T) + (uk[1] == T) + (uk[2] == T) + (uk[3] == T);
    int incl = tl;
    for (int o = 1; o < 64; o <<= 1) { const int u = __shfl_up(incl, o); if (lane >= o) incl += u; }
    __syncthreads();
    if (lane == 63) wtie[wid] = incl;
    __syncthreads();
    int before = incl - tl;
    for (int w = 0; w < wid; ++w) before += wtie[w];
    unsigned nib = 0u;
#pragma unroll
    for (int q = 0; q < 4; ++q) {
      bool sel = uk[q] > T;
      if (uk[q] == T) { sel = before < need; ++before; }
      if (sel) nib |= 1u << q;
    }
    unsigned word = nib << ((lane & 7) * 4);
    word |= __shfl_xor(word, 1); word |= __shfl_xor(word, 2); word |= __shfl_xor(word, 4);
    if ((lane & 7) == 0) mrow[t >> 3] = word;
  }
}

constexpr int IDX_LD = 2052;
DI void phase4b_mfma(const Params& p, int bid, int nb, char* lds) {
  const int t = tid_(), lane = t & 63, wid = t >> 6, q16 = lane & 15, g = lane >> 4;
  unsigned* S = (unsigned*)lds;
  const bf16_t* proj = ws_proj(p);
  for (int task = bid; task < NTOK / 16; task += nb) {
    const int b = (task & 255) >> 4, jq = task & 15, kq = task >> 8;
    const int q0 = (((kq & 1) ? 31 - jq : jq) + 32 * (kq >> 1)) * 16;
    const int n = ((q0 >> 6) + 1) * 64, ntile = n >> 4;
    if (n <= 256) {
      unsigned short* mrow = (unsigned short*)(ws_mask(p) + (size_t)(b * SEQ + q0 + q16) * 64);
      if (g == 0) for (int kt = wid; kt < ntile; kt += 8) mrow[kt] = 0xffffu;
      continue;
    }
    const int gq = b * SEQ + q0 + q16;
    const int ntw = (ntile - wid + 7) >> 3;
    const bf16_t* kbase = ws_kidx(p) + (size_t)b * SEQ * 64 + (wid * 16 + q16) * 64 + g * 8;
    bf16x8 qf[4][2]; float wq[4];
#pragma unroll
    for (int h = 0; h < 4; ++h) {
#pragma unroll
      for (int ks = 0; ks < 2; ++ks) qf[h][ks] = *(const bf16x8*)(proj + (size_t)gq * PROJ_LD + C_QI + h * 64 + ks * 32 + g * 8);
      wq[h] = bf2f(proj[(size_t)gq * PROJ_LD + C_WI + h]) * 0.0625f;
    }
    __syncthreads();
    bf16x8 k0 = *(const bf16x8*)kbase, k1 = *(const bf16x8*)(kbase + 32);
#pragma unroll
    for (int tt = 0; tt < 16; ++tt) {
      if (tt < ntw) {
        const bf16x8 c0 = k0, c1 = k1;
        if (tt + 1 < ntw) { int koff = (tt + 1) * 8 * 16 * 64; asm volatile("" : "+v"(koff)); k0 = *(const bf16x8*)(kbase + koff); k1 = *(const bf16x8*)(kbase + koff + 32); }
        float sc[4] = {0.f, 0.f, 0.f, 0.f};
#pragma unroll
        for (int h = 0; h < 4; ++h) {
          f32x4v acc = {0.f, 0.f, 0.f, 0.f};
          acc = __builtin_amdgcn_mfma_f32_16x16x32_bf16(c0, qf[h][0], acc, 0, 0, 0);
          acc = __builtin_amdgcn_mfma_f32_16x16x32_bf16(c1, qf[h][1], acc, 0, 0, 0);
#pragma unroll
          for (int r = 0; r < 4; ++r) sc[r] += wq[h] * fmaxf(acc[r], 0.f);
        }
        u32x4 kv;
#pragma unroll
        for (int r = 0; r < 4; ++r) {
          const unsigned bts = __float_as_uint(sc[r]);
          unsigned key = bts ^ ((unsigned)((int)bts >> 31) | 0x80000000u);
          key += (key == 0x7fffffffu) ? 1u : 0u;
          kv[r] = key;
        }
        *(u32x4*)(S + q16 * IDX_LD + (wid + 8 * tt) * 16 + 4 * g) = kv;
      }
    }
    __syncthreads();
    {
      const int nreg = n >> 6;
      const int qa = 2 * wid;
      unsigned ua[32], ub[32];
#pragma unroll
      for (int j = 0; j < 32; ++j) { ua[j] = (j < nreg) ? S[qa * IDX_LD + 64 * j + lane] : 0u; ub[j] = (j < nreg) ? S[(qa + 1) * IDX_LD + 64 * j + lane] : 0u; }
      unsigned Ta = 0u, Tb = 0u; bool xa = false, xb = false;
      for (int bit = 31; bit >= 0; --bit) {
        const unsigned ca = xa ? Ta : (Ta | (1u << bit)), cb = xb ? Tb : (Tb | (1u << bit));
        int va = 0, vb = 0;
#pragma unroll
        for (int j4 = 0; j4 < 8; ++j4) {
          if (j4 * 4 < nreg) {
#pragma unroll
            for (int j = j4 * 4; j < j4 * 4 + 4; ++j) { va += (ua[j] >= ca) ? 1 : 0; vb += (ub[j] >= cb) ? 1 : 0; }
          }
        }
        int vab = va | (vb << 16);
        vab += __builtin_amdgcn_update_dpp(0, vab, 0xB1, 0xF, 0xF, true);
        vab += __builtin_amdgcn_update_dpp(0, vab, 0x4E, 0xF, 0xF, true);
        vab += __builtin_amdgcn_update_dpp(0, vab, 0x141, 0xF, 0xF, true);
        vab += __builtin_amdgcn_update_dpp(0, vab, 0x140, 0xF, 0xF, true);
        const int tot = __builtin_amdgcn_readlane(vab, 0) + __builtin_amdgcn_readlane(vab, 16) + __builtin_amdgcn_readlane(vab, 32) + __builtin_amdgcn_readlane(vab, 48);
        const int na = tot & 0xffff, nq = tot >> 16;
        if (!xa && na >= 256) { Ta = ca; xa = (na == 256); }
        if (!xb && nq >= 256) { Tb = cb; xb = (nq == 256); }
        if (xa && xb) break;
      }
#pragma unroll 1
      for (int which = 0; which < 2; ++which) {
        const unsigned T = which ? Tb : Ta;
        int cgt = 0;
#pragma unroll
        for (int j = 0; j < 32; ++j) cgt += __popcll(__ballot((which ? ub[j] : ua[j]) > T));
        int need = 256 - cgt;
        unsigned* mrow = ws_mask(p) + (size_t)(b * SEQ + q0 + qa + which) * 64;
#pragma unroll
        for (int j = 0; j < 32; ++j) {
          if (j < nreg) {
            const unsigned uv = which ? ub[j] : ua[j];
            unsigned long long sel = __ballot(uv > T);
            const unsigned long long eq = __ballot(uv == T);
            const int pe = __popcll(eq);
            if (pe <= need) { sel |= eq; need -= pe; }
            else { unsigned long long e = eq; for (int i = 0; i < need; ++i) { const unsigned long long low = e & (0ull - e); sel |= low; e ^= low; } need = 0; }
            if (lane == 0) { mrow[2 * j] = (unsigned)sel; mrow[2 * j + 1] = (unsigned)(sel >> 32); }
          }
        }
      }
    }
  }
}

DI void phase5a(const Params& p, int bid, int nb, char* lds) {
  const int lane = tid_() & 63, wid = tid_() >> 6;
  const bf16_t* proj = ws_proj(p);
  for (int gt = bid * 8 + wid; gt < NTOK; gt += nb * 8) {
    const int c0 = lane * 8, h = lane >> 3;
    const f32x4 y0 = *(const f32x4*)(ws_y(p) + (size_t)gt * RW + c0), y1 = *(const f32x4*)(ws_y(p) + (size_t)gt * RW + c0 + 4);
    float y[8] = {y0[0], y0[1], y0[2], y0[3], y1[0], y1[1], y1[2], y1[3]};
    float s = 0.f;
#pragma unroll
    for (int j = 0; j < 8; ++j) s += y[j];
    s += __shfl_xor(s, 1); s += __shfl_xor(s, 2); s += __shfl_xor(s, 4);
    const float mean = s * (1.0f / 64.0f);
    float q = 0.f;
#pragma unroll
    for (int j = 0; j < 8; ++j) { const float d = y[j] - mean; q += d * d; }
    q += __shfl_xor(q, 1); q += __shfl_xor(q, 2); q += __shfl_xor(q, 4);
    const float rstd = rsqrtf(q * (1.0f / 64.0f) + 64e-5f);
    float g[8], vr[8], vp[8];
    load8(ws_gg(p) + (size_t)gt * RW + c0, g);
    load8(proj + (size_t)gt * PROJ_LD + C_V + c0, vr);
    if (gt & (SEQ - 1)) load8(proj + (size_t)(gt - 1) * PROJ_LD + C_V + c0, vp);
    else {
#pragma unroll
      for (int j = 0; j < 8; ++j) vp[j] = 0.f;
    }
    const float bs = ws_bonus(p)[gt * NH + h];
    float o[8];
#pragma unroll
    for (int j = 0; j < 8; ++j) {
      const float v = vr[j] + p.shift_mu[C_V + c0 + j] * (vp[j] - vr[j]);
      o[j] = ((y[j] - mean) * rstd * p.gn_g[c0 + j] + p.gn_b[c0 + j] + bs * v) * g[j];
    }
    u32x4 w; w.x = pack2(o[0], o[1]); w.y = pack2(o[2], o[3]); w.z = pack2(o[4], o[5]); w.w = pack2(o[6], o[7]);
    *(u32x4*)(ws_mix(p) + (size_t)gt * DM + c0) = w;
  }
}

DI void phase5b(const Params& p, int bid, int nb, char* lds) {
  const int t = tid_(), lane = t & 63, wid = t >> 6;
  float* ql = (float*)lds;
  float* pr = ql + 1024;
  float* ol = pr + 2048;
  int* sel = (int*)(ol + 1024);
  int* nselp = sel + 256;
  for (int gq = bid; gq < NTOK; gq += nb) {
    const int b = gq >> 11;
    const bf16_t* ckv = ws_ckv(p) + (size_t)b * SEQ * 128;
    __syncthreads();
    for (int idx = t; idx < 1024; idx += NTHR) ql[idx] = bf2f(ws_qlat(p)[(size_t)gq * 1024 + idx]);
    if (wid == 0) {
      const int nadm = (((gq & (SEQ - 1)) >> 6) + 1) * 64;
      const unsigned word = (lane * 32 < nadm) ? ws_mask(p)[(size_t)gq * 64 + lane] : 0u;
      const int cnt = __popc(word);
      int incl = cnt;
      for (int o = 1; o < 64; o <<= 1) { const int u = __shfl_up(incl, o); if (lane >= o) incl += u; }
      int pos = incl - cnt;
      unsigned w = word;
      while (w) { const int bit = __ffs(w) - 1; w &= w - 1; if (pos < 256) sel[pos] = lane * 32 + bit; ++pos; }
      if (lane == 63) *nselp = incl < 256 ? incl : 256;
    }
    __syncthreads();
    const int nsel = *nselp;
    const int h = wid;
    float lg[4]; float mx = -1e30f;
#pragma unroll
    for (int q = 0; q < 4; ++q) {
      const int slot = lane + 64 * q;
      lg[q] = -1e30f;
      if (slot < nsel) {
        const bf16_t* kr = ckv + (size_t)sel[slot] * 128;
        float acc = 0.f;
#pragma unroll
        for (int d8 = 0; d8 < 16; ++d8) {
          float kf[8]; load8(kr + d8 * 8, kf);
          const f32x4 q0 = *(const f32x4*)(ql + h * 128 + d8 * 8), q1 = *(const f32x4*)(ql + h * 128 + d8 * 8 + 4);
          acc += q0[0] * kf[0] + q0[1] * kf[1] + q0[2] * kf[2] + q0[3] * kf[3] + q1[0] * kf[4] + q1[1] * kf[5] + q1[2] * kf[6] + q1[3] * kf[7];
        }
        lg[q] = acc;
      }
      mx = fmaxf(mx, lg[q]);
    }
    mx = wave_max(mx);
    float sm = 0.f;
#pragma unroll
    for (int q = 0; q < 4; ++q) { lg[q] = (lane + 64 * q < nsel) ? __expf(lg[q] - mx) : 0.f; sm += lg[q]; }
    sm = wave_sum(sm);
    const float inv = 1.0f / sm;
#pragma unroll
    for (int q = 0; q < 4; ++q) pr[h * 256 + lane + 64 * q] = lg[q] * inv;
    __syncthreads();
    {
      float o0 = 0.f, o1 = 0.f;
      for (int slot = 0; slot < nsel; ++slot) {
        const unsigned kv2 = *(const unsigned*)(ckv + (size_t)sel[slot] * 128 + lane * 2);
        const float pp = pr[h * 256 + slot];
        o0 += pp * __uint_as_float(kv2 << 16); o1 += pp * __uint_as_float(kv2 & 0xffff0000u);
      }
      ol[h * 128 + lane * 2] = o0; ol[h * 128 + lane * 2 + 1] = o1;
    }
    __syncthreads();
    {
      float acc = 0.f;
      for (int cc = 0; cc < 128; ++cc) acc += ol[h * 128 + cc] * p.w_uv[(size_t)(cc * NH + h) * HD + lane];
      ws_mix(p)[(size_t)gq * DM + RW + h * HD + lane] = f2bf(acc);
    }
  }
}

typedef short s16x4 __attribute__((ext_vector_type(4)));
#define KSWZ(row, colB) ((row) * 256 + ((colB) ^ (((row) & 7) << 4)))
DI int v_st(int k, int c) { const int kk = (k & ~0xC) | ((k & 4) << 1) | ((k & 8) >> 1); return ((kk >> 3) * 4 + (c >> 5)) * 512 + ((kk & 7) * 32 + (c & 31)) * 2; }
DI int v_rd_base(int lane) { return ((lane & 3) << 3) | (((lane >> 2) & 3) << 6) | (((lane >> 4) & 1) << 5) | (((lane >> 5) & 1) << 8); }
constexpr int v_rd_off(int d0, int ks, int half) { return d0 * 512 + ks * 4096 + half * 2048; }
template <int OFF> DI s16x4 tr_read(int vb) { s16x4 r; asm volatile("ds_read_b64_tr_b16 %0, %1 offset:%2" : "=&v"(r) : "v"(vb), "i"(OFF) : "memory"); return r; }
template <int D0> DI void pv_one(f32x16& od, int vb, bf16x8 pa0, bf16x8 pa1, bf16x8 pa2, bf16x8 pa3) {
  const s16x4 l0 = tr_read<v_rd_off(D0, 0, 0)>(vb), h0 = tr_read<v_rd_off(D0, 0, 1)>(vb), l1 = tr_read<v_rd_off(D0, 1, 0)>(vb), h1 = tr_read<v_rd_off(D0, 1, 1)>(vb);
  const s16x4 l2 = tr_read<v_rd_off(D0, 2, 0)>(vb), h2 = tr_read<v_rd_off(D0, 2, 1)>(vb), l3 = tr_read<v_rd_off(D0, 3, 0)>(vb), h3 = tr_read<v_rd_off(D0, 3, 1)>(vb);
  asm volatile("s_waitcnt lgkmcnt(0)" ::: "memory"); __builtin_amdgcn_sched_barrier(0);
#define PKV(L, H) (bf16x8){L[0], L[1], L[2], L[3], H[0], H[1], H[2], H[3]}
  od = __builtin_amdgcn_mfma_f32_32x32x16_bf16(pa0, PKV(l0, h0), od, 0, 0, 0);
  od = __builtin_amdgcn_mfma_f32_32x32x16_bf16(pa1, PKV(l1, h1), od, 0, 0, 0);
  od = __builtin_amdgcn_mfma_f32_32x32x16_bf16(pa2, PKV(l2, h2), od, 0, 0, 0);
  od = __builtin_amdgcn_mfma_f32_32x32x16_bf16(pa3, PKV(l3, h3), od, 0, 0, 0);
#undef PKV
}
constexpr int ATT_TILE = 64 * 128 * 2;
constexpr int ATT_LDS = 4 * ATT_TILE + 8 * 64 * 4;
DI void phase5b_mfma(const Params& p, int bid, int nb, char* lds) {
  const int t = tid_(), lane = t & 63, wid = t >> 6, r32 = lane & 31, hi = lane >> 5;
  char* V_lds = lds; char* K_lds = lds + 2 * ATT_TILE;
  float* al_l = (float*)(lds + 4 * ATT_TILE) + wid * 64; float* li_l = al_l + 32;
  const int sr = t >> 4, sc = (t & 15) * 8;
  const int vst0 = v_st(sr, sc), vst1 = v_st(32 + sr, sc), kst0 = KSWZ(sr, sc * 2), kst1 = KSWZ(32 + sr, sc * 2);
  const int vb0 = (int)(uintptr_t)V_lds + v_rd_base(lane);
  const int h = wid;
  constexpr float LOG2E = 1.4426950408889634f, THR = 8.0f;
  for (int task = bid; task < NTOK / 32; task += nb) {
    const int b = (task & 255) >> 4;
    int qt; { const int j = task & 15, k = task >> 8; qt = (k == 0) ? j : (k == 1) ? 31 - j : (k == 2) ? 32 + j : 63 - j; }
    const int q0 = qt * 32, n = ((q0 >> 6) + 1) * 64, NT = n >> 6;
    const int gq = b * SEQ + q0 + r32;
    const bf16_t* ckv = ws_ckv(p) + (size_t)b * SEQ * 128;
    const unsigned* mrow = ws_mask(p) + (size_t)gq * 64;
    bf16x8 qr[8];
    {
      f32x16 qa[4];
#pragma unroll
      for (int mt = 0; mt < 4; ++mt)
#pragma unroll
        for (int r = 0; r < 16; ++r) qa[mt][r] = 0.f;
      const bf16_t* wuk = ws_wukt(p) + (size_t)h * 8192 + lane * 8;
#pragma unroll
      for (int ks = 0; ks < 4; ++ks) {
        const bf16x8 bq = *(const bf16x8*)(ws_proj(p) + (size_t)gq * PROJ_LD + C_Q + h * HD + ks * 16 + hi * 8);
#pragma unroll
        for (int mt = 0; mt < 4; ++mt) { const bf16x8 aw = *(const bf16x8*)(wuk + (mt * 4 + ks) * 512); qa[mt] = __builtin_amdgcn_mfma_f32_32x32x16_bf16(aw, bq, qa[mt], 0, 0, 0); }
      }
#define QPK(P, BASE, OUT) do { unsigned a0 = cvtpk(P[BASE + 0] * 0.125f, P[BASE + 1] * 0.125f), a1 = cvtpk(P[BASE + 2] * 0.125f, P[BASE + 3] * 0.125f);   \
    unsigned b0 = cvtpk(P[BASE + 4] * 0.125f, P[BASE + 5] * 0.125f), b1 = cvtpk(P[BASE + 6] * 0.125f, P[BASE + 7] * 0.125f);                              \
    auto r0 = __builtin_amdgcn_permlane32_swap(a0, b0, false, false); auto r1 = __builtin_amdgcn_permlane32_swap(a1, b1, false, false); \
    u32x4 w = {r0[0], r1[0], r0[1], r1[1]}; OUT = *reinterpret_cast<bf16x8*>(&w); } while (0)
#pragma unroll
      for (int mt = 0; mt < 4; ++mt) { QPK(qa[mt], 0, qr[2 * mt]); QPK(qa[mt], 8, qr[2 * mt + 1]); }
#undef QPK
    }
    float m_reg = -1e30f, l_reg = 0.f;
    f32x16 o[4];
#pragma unroll
    for (int d = 0; d < 4; ++d)
#pragma unroll
      for (int r = 0; r < 16; ++r) o[d][r] = 0.f;
    u32x4 s0 = *(const u32x4*)(ckv + (size_t)sr * 128 + sc), s1 = *(const u32x4*)(ckv + (size_t)(32 + sr) * 128 + sc);
    __syncthreads();
    *(u32x4*)(V_lds + vst0) = s0; *(u32x4*)(V_lds + vst1) = s1; *(u32x4*)(K_lds + kst0) = s0; *(u32x4*)(K_lds + kst1) = s1;
    __syncthreads();
    unsigned mw0 = mrow[0], mw1 = mrow[1];
    for (int j = 0; j < NT; ++j) {
      const int buf = j & 1;
      const unsigned w0 = mw0 >> (4 * hi), w1 = mw1 >> (4 * hi);
      if (j + 1 < NT) { mw0 = mrow[2 * j + 2]; mw1 = mrow[2 * j + 3]; }
      if (j + 1 < NT) { s0 = *(const u32x4*)(ckv + (size_t)((j + 1) * 64 + sr) * 128 + sc); s1 = *(const u32x4*)(ckv + (size_t)((j + 1) * 64 + 32 + sr) * 128 + sc); }
      f32x16 p0, p1;
#pragma unroll
      for (int r = 0; r < 16; ++r) { p0[r] = 0.f; p1[r] = 0.f; }
      const char* Kb = K_lds + buf * ATT_TILE;
#pragma unroll
      for (int d0 = 0; d0 < 8; ++d0) {
        const int cb = (d0 * 16 + hi * 8) * 2;
        const bf16x8 b0 = *(const bf16x8*)(Kb + KSWZ(r32, cb)), b1 = *(const bf16x8*)(Kb + KSWZ(32 + r32, cb));
        p0 = __builtin_amdgcn_mfma_f32_32x32x16_bf16(b0, qr[d0], p0, 0, 0, 0);
        p1 = __builtin_amdgcn_mfma_f32_32x32x16_bf16(b1, qr[d0], p1, 0, 0, 0);
      }
      float pmax = p0[0];
#pragma unroll
      for (int r = 1; r < 16; ++r) pmax = fmaxf(pmax, p0[r]);
#pragma unroll
      for (int r = 0; r < 16; ++r) pmax = fmaxf(pmax, p1[r]);
      { auto rr = __builtin_amdgcn_permlane32_swap(__float_as_uint(pmax), __float_as_uint(pmax), false, false); pmax = fmaxf(__uint_as_float(rr[0]), __uint_as_float(rr[1])); }
      float alpha = 1.f;
      if (!__all(pmax - m_reg <= THR)) { const float mn = fmaxf(m_reg, pmax); alpha = __builtin_amdgcn_exp2f((m_reg - mn) * LOG2E); m_reg = mn; }
      const float mnC = -m_reg * LOG2E;
      float ps = 0.f;
#pragma unroll
      for (int r = 0; r < 16; ++r) {
        const int bitp = (r & 3) + 8 * (r >> 2);
        float e0 = __builtin_amdgcn_exp2f(fmaf(p0[r], LOG2E, mnC)), e1 = __builtin_amdgcn_exp2f(fmaf(p1[r], LOG2E, mnC));
        e0 = ((w0 >> bitp) & 1u) ? e0 : 0.f; e1 = ((w1 >> bitp) & 1u) ? e1 : 0.f;
        p0[r] = e0; p1[r] = e1; ps += e0 + e1;
      }
      { auto rr = __builtin_amdgcn_permlane32_swap(__float_as_uint(ps), __float_as_uint(ps), false, false); ps = __uint_as_float(rr[0]) + __uint_as_float(rr[1]); }
      l_reg = l_reg * alpha + ps;
      if (__any(alpha < 1.f)) {
        if (hi == 0) al_l[r32] = alpha;
        asm volatile("s_waitcnt lgkmcnt(0)" ::: "memory");
#pragma unroll
        for (int d = 0; d < 4; ++d)
#pragma unroll
          for (int r = 0; r < 16; ++r) o[d][r] *= al_l[crow(r, hi)];
      }
      bf16x8 pa0, pa1, pa2, pa3;
#define PK4(P, BASE, OUT) do { unsigned a0 = cvtpk(P[BASE + 0], P[BASE + 1]), a1 = cvtpk(P[BASE + 2], P[BASE + 3]);   \
    unsigned b0 = cvtpk(P[BASE + 4], P[BASE + 5]), b1 = cvtpk(P[BASE + 6], P[BASE + 7]);                              \
    auto r0 = __builtin_amdgcn_permlane32_swap(a0, b0, false, false); auto r1 = __builtin_amdgcn_permlane32_swap(a1, b1, false, false); \
    u32x4 w = {r0[0], r1[0], r0[1], r1[1]}; OUT = *reinterpret_cast<bf16x8*>(&w); } while (0)
      PK4(p0, 0, pa0); PK4(p0, 8, pa1); PK4(p1, 0, pa2); PK4(p1, 8, pa3);
#undef PK4
      const int vb = vb0 + buf * ATT_TILE;
      pv_one<0>(o[0], vb, pa0, pa1, pa2, pa3); pv_one<1>(o[1], vb, pa0, pa1, pa2, pa3); pv_one<2>(o[2], vb, pa0, pa1, pa2, pa3); pv_one<3>(o[3], vb, pa0, pa1, pa2, pa3);
      if (j + 1 < NT) {
        char* Vn = V_lds + (buf ^ 1) * ATT_TILE; char* Kn = K_lds + (buf ^ 1) * ATT_TILE;
        *(u32x4*)(Vn + vst0) = s0; *(u32x4*)(Vn + vst1) = s1; *(u32x4*)(Kn + kst0) = s0; *(u32x4*)(Kn + kst1) = s1;
      }
      __syncthreads();
    }
    if (hi == 0) li_l[r32] = l_reg;
    asm volatile("s_waitcnt lgkmcnt(0)" ::: "memory");
    int hio = hi, r32o = r32;
    asm volatile("" : "+v"(hio), "+v"(r32o));
    char* Ow = lds + wid * 8192;
#pragma unroll
    for (int r = 0; r < 16; ++r) {
      const int row = crow(r, hio); const float rl = 1.0f / li_l[row];
#pragma unroll
      for (int d = 0; d < 4; ++d) *(bf16_t*)(Ow + KSWZ(row, (d * 32 + r32o) * 2)) = f2bf(o[d][r] * rl);
    }
    asm volatile("s_waitcnt lgkmcnt(0)" ::: "memory");
    f32x16 oa[2];
#pragma unroll
    for (int i = 0; i < 2; ++i)
#pragma unroll
      for (int r = 0; r < 16; ++r) oa[i][r] = 0.f;
    const bf16_t* wuv = ws_wuvt(p) + (size_t)h * 8192 + (hio * 32 + r32o) * 8;
#pragma unroll
    for (int ks = 0; ks < 8; ++ks) {
      const bf16x8 a = *(const bf16x8*)(Ow + KSWZ(r32o, (ks * 16 + hio * 8) * 2));
#pragma unroll
      for (int i = 0; i < 2; ++i) {
        const bf16x8 bw = *(const bf16x8*)(wuv + (i * 8 + ks) * 512);
        oa[i] = __builtin_amdgcn_mfma_f32_32x32x16_bf16(a, bw, oa[i], 0, 0, 0);
      }
    }
    bf16_t* mx = ws_mix(p) + (size_t)(b * SEQ + q0 + 4 * hio) * DM + RW + h * HD + r32o;
#pragma unroll
    for (int i = 0; i < 2; ++i)
#pragma unroll
      for (int r = 0; r < 16; ++r) mx[((r & 3) + 8 * (r >> 2)) * DM + i * 32] = f2bf(oa[i][r]);
  }
}

struct EpiOut { const float* x; const float* mod; float* o; int row0, col0; DI void operator()(int r, int c, float v0, float v1) const {
  const int row = row0 + r, col = col0 + c, b = row >> 11; const size_t idx = (size_t)row * DM + col;
  o[idx] = x[idx] + (1.0f + mod[b * 6144 + 2048 + col]) * v0; o[idx + 32] = x[idx + 32] + (1.0f + mod[b * 6144 + 2048 + col + 32]) * v1; } };
DI void phase6(const Params& p, int bid, int nb, char* lds) {
  constexpr int NT = DM / GBN;
  for (int tile = bid; tile < (NTOK / GBM) * NT; tile += nb) {
    const int mt = tile / NT, nt = tile % NT;
    gemm_tile(ws_mix(p), DM, ARowBase{mt * GBM}, ws_wtout(p), DM, nt * GBN, DM, EpiOut{p.x, ws_mod(p), p.out, mt * GBM, nt * GBN}, lds);
  }
}

namespace pg8 {
#define PG8_LAS __attribute__((address_space(3)))
constexpr int BM = 256, BK = 64, HALF = 128, HTB = HALF * BK * 2  , STAGE_BYTES = 8 * HTB, NXCD = 8, WGM = 8;

__host__ __device__ __forceinline__ int lds_byte(int r, int c) { const int st = (r >> 4) * 2 + (c >> 5), rr = r & 15, cc = c & 31, ob = rr * 64 + cc * 2; return st * 1024 + (ob ^ (((ob >> 9) & 1) << 5)); }
__host__ __device__ __forceinline__ void stage_rc(int b, int& R, int& C) { const int st = b / 1024, sb = b % 1024, swz = sb ^ (((sb >> 9) & 1) << 5); R = (st >> 1) * 16 + swz / 64; C = (st & 1) * 32 + (swz % 64) / 2; }
__host__ __device__ __forceinline__ int perm32(int rho) { const int n = rho >> 4, i = rho & 15; return 8 * (i >> 2) + 4 * n + (i & 3); }

struct Unit { int pm, pn, e; };
struct Gemm { const bf16_t* A; const bf16_t* Bt; int M, N, K; size_t bstride; };

struct StaticOrder {
    static constexpr bool GATHER = false;
    int nM, nN, nwg, G, c;
    __host__ __device__ void init(int M, int N, int G_, int c_) { nM = M / BM; nN = N / BM; nwg = nM * nN; G = G_; c = c_; }
    __host__ __device__ bool next(int i, Unit& u) const {
        const long L = (long)i * G + c; if (L >= nwg) return false;
        int wgid = (int)L; { const int q = nwg / NXCD, r = nwg % NXCD, xcd = wgid % NXCD, off = wgid / NXCD; wgid = (xcd < r ? xcd * (q + 1) : r * (q + 1) + (xcd - r) * q) + off; }
        const int nig = WGM * nN, gid = wgid / nig, fm = gid * WGM, gsz = (nM - fm) < WGM ? (nM - fm) : WGM;
        u.pm = fm + ((wgid % nig) % gsz); u.pn = (wgid % nig) / gsz; u.e = 0; return true;
    }
    __device__ __forceinline__ void a_ready(const Unit&) const {}
    __device__ __forceinline__ void done(const Unit&) const {}
    __device__ __forceinline__ int arow(const Unit&, int) const { return 0; }
};
template <class Epi, class Sched, bool ALIGN_EPI = false, bool SP2 = false>
__device__ __forceinline__ void gemm_phase(PG8_LAS unsigned char* lds, const Gemm g, const Sched& S, const Epi& E) {
    const int tid = threadIdx.x, wid = __builtin_amdgcn_readfirstlane(tid >> 6), lane = tid & 63, wr = wid >> 2, wc = wid & 3, fr = lane & 15, fq = lane >> 4;
    const int K = g.K, nt = K / BK;
    unsigned voffA[2], voffB[2];
#pragma unroll
    for (int i = 0; i < 2; ++i) { int R, C; stage_rc(tid * 16 + i * 8192, R, C); const int Rb = Epi::PERM ? ((R & ~31) + perm32(R & 31)) : R;
        voffA[i] = (unsigned)(R * K + C) * 2u; voffB[i] = (unsigned)(Rb * K + C) * 2u; }
    unsigned vAc[2][2], vAn[2][2];
    const size_t kstep = (size_t)(BK * 2);
    const size_t hstep = (size_t)HALF * K * 2;
    const size_t tstep = 2 * hstep;
    const unsigned ldsw = (unsigned)wid * 1024u;
    const int aoff = lds_byte(wr * 64 + fr, fq * 8), boff = lds_byte(wc * 32 + fr, fq * 8);
#define PG8_SA(b, h) (((b) * 2 + (h)) * HTB)
#define PG8_SB(b, h) ((4 + (b) * 2 + (h)) * HTB)
#define PG8_STAGE(bufoff, gbase, voff) do { _Pragma("unroll") for (int _i = 0; _i < 2; ++_i) \
        __builtin_amdgcn_global_load_lds((const unsigned*)((const char*)(gbase) + (voff)[_i]), (PG8_LAS unsigned*)(lds + (bufoff) + ldsw + _i * 8192), 16, 0, 0); } while (0)
#define PG8_STAGE_A(bufoff, gbase, v0_, v1_) do { \
        __builtin_amdgcn_global_load_lds((const unsigned*)((const char*)(gbase) + (v0_)), (PG8_LAS unsigned*)(lds + (bufoff) + ldsw), 16, 0, 0); \
        __builtin_amdgcn_global_load_lds((const unsigned*)((const char*)(gbase) + (v1_)), (PG8_LAS unsigned*)(lds + (bufoff) + ldsw + 8192), 16, 0, 0); } while (0)
#define PG8_AOFF(u_, dst_) do { if constexpr (Sched::GATHER) { _Pragma("unroll") for (int h_ = 0; h_ < 2; ++h_) _Pragma("unroll") for (int i_ = 0; i_ < 2; ++i_) { int R_, C_; stage_rc(tid * 16 + i_ * 8192, R_, C_); \
            dst_[h_][i_] = (unsigned)(S.arow(u_, h_ * HALF + R_) * K + C_) * 2u; } asm volatile("s_waitcnt vmcnt(0)" ::: "memory"); } \
        else { _Pragma("unroll") for (int h_ = 0; h_ < 2; ++h_) _Pragma("unroll") for (int i_ = 0; i_ < 2; ++i_) dst_[h_][i_] = voffA[i_] + (unsigned)(h_ * hstep); } } while (0)
#define PG8_LDA(dst, b, h) do { _Pragma("unroll") for (int m = 0; m < 4; ++m) _Pragma("unroll") for (int k = 0; k < 2; ++k) dst[m][k] = *(const PG8_LAS bf16x8*)(lds + PG8_SA(b, h) + aoff + m * 2048 + k * 1024); } while (0)
#define PG8_LDB(dst, b, h) do { _Pragma("unroll") for (int n = 0; n < 2; ++n) _Pragma("unroll") for (int k = 0; k < 2; ++k) dst[n][k] = *(const PG8_LAS bf16x8*)(lds + PG8_SB(b, h) + boff + n * 2048 + k * 1024); } while (0)
#define PG8_MMA(ai, bj, At, Bt) do { __builtin_amdgcn_s_setprio(1); _Pragma("unroll") for (int m = 0; m < 4; ++m) _Pragma("unroll") for (int n = 0; n < 2; ++n) _Pragma("unroll") for (int k = 0; k < 2; ++k) \
        acc[ai][bj][m][n] = __builtin_amdgcn_mfma_f32_16x16x32_bf16(Bt[n][k], At[m][k], acc[ai][bj][m][n], 0, 0, 0); __builtin_amdgcn_s_setprio(0); } while (0)
#define PG8_WAIT_V(n) asm volatile("s_waitcnt vmcnt(" #n ")" ::: "memory")
#define PG8_WAIT_L(n) asm volatile("s_waitcnt lgkmcnt(" #n ")" ::: "memory")
#define PG8_BAR __builtin_amdgcn_s_barrier()
#define PG8_SCHED __builtin_amdgcn_sched_barrier(0)
    Unit cur, nxt; int ui = 0;
    if (!S.next(0, cur)) return;
    f32x4 acc[2][2][4][2];
#pragma unroll
    for (int a = 0; a < 2; ++a)
#pragma unroll
        for (int b = 0; b < 2; ++b)
#pragma unroll
            for (int m = 0; m < 4; ++m)
#pragma unroll
                for (int n = 0; n < 2; ++n) acc[a][b][m][n] = (f32x4){0.f, 0.f, 0.f, 0.f};
    bf16x8 At[4][2], B0[2][2], B1[2][2];
    const char* cA = Sched::GATHER ? (const char*)g.A : (const char*)g.A + (size_t)cur.pm * tstep; PG8_AOFF(cur, vAc); const char* cB = (const char*)g.Bt + (size_t)cur.e * g.bstride + (size_t)cur.pn * tstep;
    S.a_ready(cur);
    if constexpr (SP2) {
        PG8_STAGE(PG8_SB(0, 0), cB, voffB); PG8_STAGE(PG8_SB(0, 1), cB + hstep, voffB); PG8_STAGE_A(PG8_SA(0, 0), cA, vAc[0][0], vAc[0][1]); PG8_STAGE_A(PG8_SA(0, 1), cA, vAc[1][0], vAc[1][1]);
        if (wr == 1) PG8_BAR;
        PG8_WAIT_V(2); PG8_BAR;
        PG8_STAGE(PG8_SB(1, 0), cB + kstep, voffB); PG8_STAGE_A(PG8_SA(1, 0), cA + kstep, vAc[0][0], vAc[0][1]); PG8_STAGE(PG8_SB(1, 1), cB + hstep + kstep, voffB);
        PG8_WAIT_V(6); PG8_BAR;
    } else {
        PG8_STAGE(PG8_SB(0, 0), cB, voffB); PG8_STAGE(PG8_SA(0, 0), cA, voffA); PG8_STAGE(PG8_SB(0, 1), cB + hstep, voffB); PG8_STAGE(PG8_SA(0, 1), cA + hstep, voffA);
        if (wr == 1) PG8_BAR;
        PG8_WAIT_V(4); PG8_BAR;
        PG8_STAGE(PG8_SB(1, 0), cB + kstep, voffB); PG8_STAGE(PG8_SA(1, 0), cA + kstep, voffA); PG8_STAGE(PG8_SB(1, 1), cB + hstep + kstep, voffB);
        PG8_WAIT_V(6); PG8_BAR;
    }
    for (;;) {
        const bool has_next = S.next(ui + 1, nxt);
        const char* nA = (has_next && !Sched::GATHER) ? (const char*)g.A + (size_t)nxt.pm * tstep : cA;
        if (has_next) PG8_AOFF(nxt, vAn); else { _Pragma("unroll") for (int h_ = 0; h_ < 2; ++h_) _Pragma("unroll") for (int i_ = 0; i_ < 2; ++i_) vAn[h_][i_] = vAc[h_][i_]; }
        const char* nB = has_next ? (const char*)g.Bt + (size_t)nxt.e * g.bstride + (size_t)nxt.pn * tstep : cB;
        for (int t = 0; t < nt; t += 2) {
            const bool last = (t == nt - 2);
            const char* a1 = cA + (size_t)(t + 1) * kstep;
            const char* a2 = last ? nA : cA + (size_t)(t + 2) * kstep; const char* b2 = last ? nB : cB + (size_t)(t + 2) * kstep;
            const char* a3 = a2 + kstep; const char* b3 = b2 + kstep;
            if (last && has_next) S.a_ready(nxt);
            if constexpr (SP2) {
            PG8_LDB(B0, 0, 0); PG8_LDB(B1, 0, 1); PG8_SCHED; PG8_LDA(At, 0, 0); PG8_STAGE_A(PG8_SA(1, 1), a1, vAc[1][0], vAc[1][1]);
            PG8_WAIT_V(8); PG8_WAIT_L(0); PG8_BAR; PG8_MMA(0, 0, At, B0); PG8_MMA(0, 1, At, B1); PG8_BAR; PG8_SCHED;
            PG8_LDA(At, 0, 1); PG8_STAGE(PG8_SB(0, 0), b2, voffB); PG8_STAGE(PG8_SB(0, 1), b2 + hstep, voffB); PG8_STAGE_A(PG8_SA(0, 0), a2, last ? vAn[0][0] : vAc[0][0], last ? vAn[0][1] : vAc[0][1]);
            PG8_WAIT_V(8); PG8_WAIT_L(0); PG8_BAR; PG8_MMA(1, 0, At, B0); PG8_MMA(1, 1, At, B1); PG8_BAR; PG8_SCHED;
            PG8_LDB(B0, 1, 0); PG8_LDB(B1, 1, 1); PG8_SCHED; PG8_LDA(At, 1, 0); PG8_STAGE_A(PG8_SA(0, 1), a2, last ? vAn[1][0] : vAc[1][0], last ? vAn[1][1] : vAc[1][1]);
            PG8_WAIT_V(8); PG8_WAIT_L(0); PG8_BAR; PG8_MMA(0, 0, At, B0); PG8_MMA(0, 1, At, B1); PG8_BAR; PG8_SCHED;
            PG8_LDA(At, 1, 1); PG8_STAGE(PG8_SB(1, 0), b3, voffB); PG8_STAGE(PG8_SB(1, 1), b3 + hstep, voffB); PG8_STAGE_A(PG8_SA(1, 0), a3, last ? vAn[0][0] : vAc[0][0], last ? vAn[0][1] : vAc[0][1]);
            PG8_WAIT_V(8); PG8_WAIT_L(0); PG8_BAR; PG8_MMA(1, 0, At, B0); PG8_MMA(1, 1, At, B1); PG8_BAR; PG8_SCHED;
            } else {
            PG8_LDB(B0, 0, 0); PG8_SCHED; PG8_LDA(At, 0, 0); PG8_STAGE(PG8_SA(1, 1), a1 + hstep, voffA);
            PG8_WAIT_L(8); PG8_BAR; PG8_WAIT_L(0); PG8_MMA(0, 0, At, B0); PG8_BAR; PG8_SCHED;
            PG8_LDB(B1, 0, 1); PG8_STAGE(PG8_SB(0, 0), b2, voffB);
            PG8_BAR; PG8_WAIT_L(0); PG8_MMA(0, 1, At, B1); PG8_BAR;
            PG8_LDA(At, 0, 1); PG8_STAGE(PG8_SA(0, 0), a2, voffA);
            PG8_BAR; PG8_WAIT_L(0); PG8_MMA(1, 0, At, B0); PG8_BAR; PG8_SCHED;
            PG8_STAGE(PG8_SB(0, 1), b2 + hstep, voffB);
            PG8_WAIT_V(6); PG8_BAR; PG8_MMA(1, 1, At, B1); PG8_BAR;
            PG8_LDB(B0, 1, 0); PG8_SCHED; PG8_LDA(At, 1, 0); PG8_STAGE(PG8_SA(0, 1), a2 + hstep, voffA);
            PG8_WAIT_L(8); PG8_BAR; PG8_WAIT_L(0); PG8_MMA(0, 0, At, B0); PG8_BAR; PG8_SCHED;
            PG8_LDB(B1, 1, 1); PG8_STAGE(PG8_SB(1, 0), b3, voffB);
            PG8_BAR; PG8_WAIT_L(0); PG8_MMA(0, 1, At, B1); PG8_BAR;
            PG8_LDA(At, 1, 1); PG8_STAGE(PG8_SA(1, 0), a3, voffA);
            PG8_BAR; PG8_WAIT_L(0); PG8_MMA(1, 0, At, B0); PG8_BAR; PG8_SCHED;
            PG8_STAGE(PG8_SB(1, 1), b3 + hstep, voffB);
            PG8_WAIT_V(6); PG8_BAR; PG8_MMA(1, 1, At, B1); PG8_BAR;
            }
        }
        if constexpr (ALIGN_EPI) { if (wr == 0) PG8_BAR; }
        if constexpr (!Epi::AFTER_DRAIN) { E(acc, cur, wr, wc, fr, fq); S.done(cur); }
        if (!has_next) break;
#pragma unroll
        for (int a = 0; a < 2; ++a)
#pragma unroll
            for (int b = 0; b < 2; ++b)
#pragma unroll
                for (int m = 0; m < 4; ++m)
#pragma unroll
                    for (int n = 0; n < 2; ++n) acc[a][b][m][n] = (f32x4){0.f, 0.f, 0.f, 0.f};
        cur = nxt; cA = nA; cB = nB; ++ui;
#pragma unroll
        for (int h_ = 0; h_ < 2; ++h_)
#pragma unroll
            for (int i_ = 0; i_ < 2; ++i_) vAc[h_][i_] = vAn[h_][i_];
        if constexpr (ALIGN_EPI) { if (wr == 1) PG8_BAR; }
    }
    PG8_WAIT_V(0);
    if constexpr (!ALIGN_EPI) { if (wr == 0) PG8_BAR; }
    PG8_BAR;
    if constexpr (Epi::AFTER_DRAIN) { E.fused(acc, cur, wr, wc, fr, fq, lds, wid, lane); S.done(cur); }
#undef PG8_SA
#undef PG8_SB
#undef PG8_STAGE
#undef PG8_STAGE_A
#undef PG8_AOFF
#undef PG8_LDA
#undef PG8_LDB
#undef PG8_MMA
#undef PG8_WAIT_V
#undef PG8_WAIT_L
#undef PG8_BAR
#undef PG8_SCHED
}
}


constexpr int TAB_OFF = 131072;
DI void build_tables(const Params& p, char* lds) {
  int* T = (int*)(lds + TAB_OFF); unsigned char* te = (unsigned char*)(T + 80);
  __syncthreads();
  if (tid_() == 0) {
    int acc = 0;
    for (int e = 0; e < NEXP; ++e) { const int c = ws_cnt(p)[e]; T[e] = c; T[32 + e] = acc; const int nt = (c + 255) >> 8; for (int k = 0; k < nt; ++k) te[acc + k] = (unsigned char)e; acc += nt; }
    T[64] = acc;
  }
  __syncthreads();
}
template <bool GATHER_> struct GroupOrderT { static constexpr bool GATHER = GATHER_; const int* T; const unsigned char* te; int G, c; const int* list;
  DI bool next(int i, pg8::Unit& u) const { const int L = i * G + c; if (L >= T[64] * 4) return false; u.pm = L >> 2; u.pn = L & 3; u.e = te[u.pm]; return true; }
  DI void a_ready(const pg8::Unit&) const {}
  DI void done(const pg8::Unit&) const {}
  DI int arow(const pg8::Unit& u, int r) const {
    const int slot = (u.pm - T[32 + u.e]) * 256 + r; return slot < T[u.e] ? (list[u.e * LCAP + slot] >> 1) : 0; } };
typedef GroupOrderT<false> GroupOrder;

struct EpiProjP { static constexpr bool PERM = true, AFTER_DRAIN = false; bf16_t* O; int ldc;
  DI void operator()(const f32x4 (&acc)[2][2][4][2], const pg8::Unit& u, int wr, int wc, int fr, int fq) const {
    const int row0 = u.pm * 256 + wr * 64 + fr, col0 = u.pn * 256 + wc * 32 + 8 * fq;
#pragma unroll
    for (int ai = 0; ai < 2; ++ai)
#pragma unroll
      for (int m = 0; m < 4; ++m) { bf16_t* rowp = O + (size_t)(row0 + ai * 128 + m * 16) * ldc + col0;
#pragma unroll
        for (int bj = 0; bj < 2; ++bj) { const f32x4 v0 = acc[ai][bj][m][0] + 0.0f, v1 = acc[ai][bj][m][1] + 0.0f;
          u32x4 w; w.x = cvtpk(v0[0], v0[1]); w.y = cvtpk(v0[2], v0[3]); w.z = cvtpk(v1[0], v1[1]); w.w = cvtpk(v1[2], v1[3]);
          *(u32x4*)(rowp + bj * 128) = w; } }
  } };
DI void phase2_pg8(const Params& p, int bid, int nb, char* lds) {
  pg8::Gemm g{ws_h1(p), ws_wtin(p), NTOK, PROJ_LD, DM, 0};
  pg8::StaticOrder S; S.init(NTOK, PROJ_LD, nb, bid);
  EpiProjP E{ws_proj(p), PROJ_LD};
  __syncthreads();
  pg8::gemm_phase<EpiProjP, pg8::StaticOrder, true, true>((PG8_LAS unsigned char*)lds, g, S, E);
  __syncthreads();
}
struct EpiResidP { static constexpr bool PERM = false, AFTER_DRAIN = false; const float* x; const float* mod; float* o;
  DI void operator()(const f32x4 (&acc)[2][2][4][2], const pg8::Unit& u, int wr, int wc, int fr, int fq) const {
    const int row0 = u.pm * 256 + wr * 64 + fr, col0 = u.pn * 256 + wc * 32 + 4 * fq;
#pragma unroll
    for (int ai = 0; ai < 2; ++ai)
#pragma unroll
      for (int m = 0; m < 4; ++m) { const int row = row0 + ai * 128 + m * 16, b = row >> 11;
#pragma unroll
        for (int bj = 0; bj < 2; ++bj)
#pragma unroll
          for (int n = 0; n < 2; ++n) { const int col = col0 + bj * 128 + n * 16; const size_t idx = (size_t)row * DM + col;
            const f32x4 xv = *(const f32x4*)(x + idx), gv = *(const f32x4*)(mod + b * 6144 + 2048 + col);
            *(f32x4*)(o + idx) = xv + (gv + 1.0f) * acc[ai][bj][m][n]; } }
  } };
DI void phase6_pg8(const Params& p, int bid, int nb, char* lds) {
  pg8::Gemm g{ws_mix(p), ws_wtout(p), NTOK, DM, DM, 0};
  pg8::StaticOrder S; S.init(NTOK, DM, nb, bid);
  EpiResidP E{p.x, ws_mod(p), ws_x1(p)};
  __syncthreads();
  pg8::gemm_phase<EpiResidP, pg8::StaticOrder, true, true>((PG8_LAS unsigned char*)lds, g, S, E);
  __syncthreads();
}
DI bf16_t* ws_h2s(const Params& p) { return (bf16_t*)(p.ws + OFF_C); }
DI bf16_t* ws_hidp(const Params& p) { return (bf16_t*)(p.ws + OFF_F); }
DI void phase7c(const Params& p, int bid, int nb, char* lds) {
  build_tables(p, lds);
  const int* T = (const int*)(lds + TAB_OFF);
  const int lane = tid_() & 63, gw = bid * 8 + (tid_() >> 6), nw = nb * 8;
  for (int e = 0; e < NEXP; ++e) {
    const int c = T[e]; const size_t r0 = (size_t)T[32 + e] * 256;
    for (int r = gw; r < c; r += nw) {
      const int tok = ws_list(p)[e * LCAP + r] >> 1;
      const u32x4* src = (const u32x4*)(ws_h2(p) + (size_t)tok * DM); u32x4* dst = (u32x4*)(ws_h2s(p) + (r0 + r) * DM);
      dst[lane] = src[lane]; dst[lane + 64] = src[lane + 64];
    }
  }
}
struct EpiSwiGLU { static constexpr bool PERM = true, AFTER_DRAIN = false; bf16_t* O;
  DI void operator()(const f32x4 (&acc)[2][2][4][2], const pg8::Unit& u, int wr, int wc, int fr, int fq) const {
    const int row0 = u.pm * 256 + wr * 64 + fr, col0 = u.pn * 128 + wc * 32 + 8 * fq;
#pragma unroll
    for (int ai = 0; ai < 2; ++ai)
#pragma unroll
      for (int m = 0; m < 4; ++m) {
        float hv[8];
#pragma unroll
        for (int n = 0; n < 2; ++n)
#pragma unroll
          for (int i = 0; i < 4; ++i) { const float gt = acc[ai][0][m][n][i], up = acc[ai][1][m][n][i]; hv[n * 4 + i] = gt / (1.0f + __expf(-gt)) * up; }
        u32x4 w; w.x = cvtpk(hv[0], hv[1]); w.y = cvtpk(hv[2], hv[3]); w.z = cvtpk(hv[4], hv[5]); w.w = cvtpk(hv[6], hv[7]);
        *(u32x4*)(O + (size_t)(row0 + ai * 128 + m * 16) * DEXP + col0) = w; }
  } };
DI void phase8_pg8(const Params& p, int bid, int nb, char* lds) {
  build_tables(p, lds);
  pg8::Gemm g{ws_h2(p), ws_wgu(p), 0, 1024, DM, (size_t)1024 * 1024 * 2};
  GroupOrderT<true> S{(const int*)(lds + TAB_OFF), (const unsigned char*)((const int*)(lds + TAB_OFF) + 80), nb, bid, ws_list(p)};
  EpiSwiGLU E{ws_hidp(p)};
  pg8::gemm_phase<EpiSwiGLU, GroupOrderT<true>, true, true>((PG8_LAS unsigned char*)lds, g, S, E);
  __syncthreads();
}
struct EpiYP { static constexpr bool PERM = true, AFTER_DRAIN = false; bf16_t* O; const int* list; const float* wa; const int* T;
  DI void operator()(const f32x4 (&acc)[2][2][4][2], const pg8::Unit& u, int wr, int wc, int fr, int fq) const {
    const int cnt = T[u.e], rbase = (u.pm - T[32 + u.e]) * 256 + wr * 64 + fr, col0 = u.pn * 256 + wc * 32 + 8 * fq;
#pragma unroll
    for (int ai = 0; ai < 2; ++ai)
#pragma unroll
      for (int m = 0; m < 4; ++m) { const int r = rbase + ai * 128 + m * 16;
        if (r < cnt) { const int aid = list[u.e * LCAP + r]; const float wv = wa[aid]; bf16_t* rowp = O + (size_t)aid * DM + col0;
#pragma unroll
          for (int bj = 0; bj < 2; ++bj) { const f32x4 v0 = acc[ai][bj][m][0] * wv, v1 = acc[ai][bj][m][1] * wv;
            u32x4 w; w.x = cvtpk(v0[0], v0[1]); w.y = cvtpk(v0[2], v0[3]); w.z = cvtpk(v1[0], v1[1]); w.w = cvtpk(v1[2], v1[3]);
            *(u32x4*)(rowp + bj * 128) = w; } } }
  } };
DI void phase9_pg8(const Params& p, int bid, int nb, char* lds) {
  build_tables(p, lds);
  pg8::Gemm g{ws_hidp(p), ws_wd(p), 0, 1024, DEXP, (size_t)1024 * 512 * 2};
  GroupOrder S{(const int*)(lds + TAB_OFF), (const unsigned char*)((const int*)(lds + TAB_OFF) + 80), nb, bid, nullptr};
  EpiYP E{ws_ybuf(p), ws_list(p), ws_wa(p), (const int*)(lds + TAB_OFF)};
  pg8::gemm_phase<EpiYP, GroupOrder, true, true>((PG8_LAS unsigned char*)lds, g, S, E);
  __syncthreads();
}

typedef float f32x4m __attribute__((ext_vector_type(4)));
constexpr int H_LD = 1028;
DI void phase7(const Params& p, int bid, int nb, char* lds) {
  const int t = tid_(), lane = t & 63, wid = t >> 6, l16 = lane & 15, lg4 = lane >> 4;
  float* H = (float*)lds;
  float* part = H + 16 * H_LD;
  float* lgt = part + 8 * 16 * 48;
  int* ecnt = (int*)(lgt + 16 * 16 * 48);
  int* ebase = ecnt + 32;
  int* sl_aid = ebase + 32;
  int* sl_e = sl_aid + 512;
  const float* mod = ws_mod(p);
  if (t < NEXP) ecnt[t] = 0;
  int nloc = 0;
  float rb0[32], rb1[32], rb2[32];
  {
    const float* we = p.w_expert + (size_t)(wid * 128 + lg4) * 32 + l16;
    const float* wg = p.w_group + (size_t)(wid * 128 + lg4) * 4 + (l16 & 3);
#pragma unroll
    for (int s4 = 0; s4 < 32; ++s4) { rb0[s4] = we[s4 * 128]; rb1[s4] = we[s4 * 128 + 16]; const float b2r = wg[s4 * 16]; rb2[s4] = (l16 < 4) ? b2r : 0.f; }
  }
  f32x4 pv[2][4];
#define P7_PF(tile_) do { _Pragma("unroll") for (int q_ = 0; q_ < 2; ++q_) { const float* xr_ = ws_x1(p) + (size_t)((tile_) * 16 + wid * 2 + q_) * DM + lane * 4; \
      _Pragma("unroll") for (int i_ = 0; i_ < 4; ++i_) pv[q_][i_] = *(const f32x4*)(xr_ + 256 * i_); } } while (0)
  if (bid < NTOK / 16) P7_PF(bid);
  for (int tile = bid; tile < NTOK / 16; tile += nb) {
    __syncthreads();
#pragma unroll
    for (int q = 0; q < 2; ++q) {
      const int tl = wid * 2 + q, gt = tile * 16 + tl, b = gt >> 11;
      f32x4 v[4]; float ss = 0.f;
#pragma unroll
      for (int i = 0; i < 4; ++i) { v[i] = pv[q][i]; ss += v[i][0] * v[i][0] + v[i][1] * v[i][1] + v[i][2] * v[i][2] + v[i][3] * v[i][3]; }
      ss = wave_sum(ss);
      const float rstd = rsqrtf(ss * (1.0f / DM) + 1e-6f);
#pragma unroll
      for (int i = 0; i < 4; ++i) {
        const int col = lane * 4 + 256 * i;
        const f32x4 g = *(const f32x4*)(p.norm2_g + col), sh = *(const f32x4*)(mod + b * 6144 + 3072 + col), sc = *(const f32x4*)(mod + b * 6144 + 4096 + col);
        f32x4 o;
#pragma unroll
        for (int j = 0; j < 4; ++j) o[j] = v[i][j] * rstd * g[j] * (1.0f + sc[j]) + sh[j];
        *(f32x4*)(H + tl * H_LD + col) = o;
        u32x2 w; w.x = cvtpk(o[0], o[1]); w.y = cvtpk(o[2], o[3]);
        *(u32x2*)(ws_h2(p) + (size_t)gt * DM + col) = w;
      }
    }
    if (tile + nb < NTOK / 16) P7_PF(tile + nb);
    __syncthreads();
    {
      f32x4m acc0 = {0.f, 0.f, 0.f, 0.f}, acc1 = acc0, acc2 = acc0;
      const float* hrow = H + l16 * H_LD + wid * 128 + lg4;
#pragma unroll
      for (int s4 = 0; s4 < 32; ++s4) {
        const float a = hrow[s4 * 4];
        acc0 = __builtin_amdgcn_mfma_f32_16x16x4f32(a, rb0[s4], acc0, 0, 0, 0);
        acc1 = __builtin_amdgcn_mfma_f32_16x16x4f32(a, rb1[s4], acc1, 0, 0, 0);
        acc2 = __builtin_amdgcn_mfma_f32_16x16x4f32(a, rb2[s4], acc2, 0, 0, 0);
      }
#pragma unroll
      for (int r = 0; r < 4; ++r) {
        float* pr = part + (wid * 16 + lg4 * 4 + r) * 48;
        pr[l16] = acc0[r]; pr[16 + l16] = acc1[r]; pr[32 + l16] = acc2[r];
      }
    }
    __syncthreads();
    for (int idx = t; idx < 16 * 36; idx += NTHR) {
      const int tok = idx / 36, o = idx % 36;
      float sacc = 0.f;
#pragma unroll
      for (int w = 0; w < 8; ++w) sacc += part[(w * 16 + tok) * 48 + o];
      sacc += (o < 32) ? p.b_expert[o] : p.b_group[o - 32];
      lgt[(nloc * 16 + tok) * 48 + o] = sacc;
    }
    ++nloc;
  }
  __syncthreads();
  for (int idx = t; idx < nloc * 16; idx += NTHR) {
    {
      const int kl = idx >> 4, t16 = idx & 15, tile = bid + kl * nb;
      const float* l = lgt + idx * 48;
      int gs = 0; float gm = l[32];
      for (int g = 1; g < 4; ++g) if (l[32 + g] > gm) { gm = l[32 + g]; gs = g; }
      float gsum = 0.f;
      for (int g = 0; g < 4; ++g) gsum += expf(l[32 + g] - gm);
      const float pgroup = 1.0f / gsum;
      const float* el = l + gs * 8;
      float em = el[0];
      for (int e = 1; e < 8; ++e) em = fmaxf(em, el[e]);
      float pe[8], esum = 0.f;
      for (int e = 0; e < 8; ++e) { pe[e] = expf(el[e] - em); esum += pe[e]; }
      for (int e = 0; e < 8; ++e) pe[e] /= esum;
      int i0 = 0;
      for (int e = 1; e < 8; ++e) if (pe[e] > pe[i0]) i0 = e;
      int i1 = (i0 == 0) ? 1 : 0;
      for (int e = 0; e < 8; ++e) if (e != i0 && pe[e] > pe[i1]) i1 = e;
      const float den = pe[i0] + pe[i1];
      const int tok = tile * 16 + t16;
      const int e0 = gs * 8 + i0, e1 = gs * 8 + i1;
      ws_wa(p)[tok * 2] = pgroup * pe[i0] / den; ws_wa(p)[tok * 2 + 1] = pgroup * pe[i1] / den;
      const int slot = kl * 32 + t16 * 2;
      sl_aid[slot] = tok * 2; sl_aid[slot + 1] = tok * 2 + 1;
      sl_e[slot] = e0 | (atomicAdd(ecnt + e0, 1) << 8); sl_e[slot + 1] = e1 | (atomicAdd(ecnt + e1, 1) << 8);
    }
  }
  __syncthreads();
  if (t < NEXP) ebase[t] = ecnt[t] ? atomicAdd(ws_cnt(p) + t, ecnt[t]) : 0;
  __syncthreads();
  for (int sidx = t; sidx < nloc * 32; sidx += NTHR) { const int ev = sl_e[sidx], e = ev & 255, r = ev >> 8; ws_list(p)[e * LCAP + ebase[e] + r] = sl_aid[sidx]; }
}
DI void phase7_tr(const Params& p, int bid, int nb, char* lds) {
  const int t = tid_();
  {
    float* tile = (float*)lds;
    const int ln4 = (t & 31) * 4, lkr = t >> 5, snr = t >> 2, skc = (t & 3) * 16;
#define MOE_TSRC(task_, src_, k0_, n0_, N_) const float* src_; int k0_, n0_, N_; { const int wh_ = (task_) >> 11, q_ = (task_) & 2047, e_ = q_ >> 6, r_ = q_ & 63; \
      if (wh_ < 2) { k0_ = (r_ >> 2) * 64; n0_ = (r_ & 3) * 128; N_ = 512; src_ = (wh_ == 0 ? p.e_gate : p.e_up) + (size_t)e_ * 1024 * 512; } \
      else { k0_ = (r_ >> 3) * 64; n0_ = (r_ & 7) * 128; N_ = 1024; src_ = p.e_down + (size_t)e_ * 512 * 1024; } }
    f32x4 g[4];
    int task = bid;
    if (task < 6144) { MOE_TSRC(task, src, k0, n0, N);
#pragma unroll
      for (int i = 0; i < 4; ++i) g[i] = *(const f32x4*)(src + (size_t)(k0 + lkr + 16 * i) * N + n0 + ln4); }
    for (; task < 6144; task += nb) {
      __syncthreads();
#pragma unroll
      for (int i = 0; i < 4; ++i) { float* d = tile + (lkr + 16 * i) * 129 + ln4; d[0] = g[i][0]; d[1] = g[i][1]; d[2] = g[i][2]; d[3] = g[i][3]; }
      if (task + nb < 6144) { MOE_TSRC(task + nb, src, k0, n0, N);
#pragma unroll
        for (int i = 0; i < 4; ++i) g[i] = *(const f32x4*)(src + (size_t)(k0 + lkr + 16 * i) * N + n0 + ln4); }
      __syncthreads();
      const int which = task >> 11, q = task & 2047, e = q >> 6, r = q & 63;
      float v[16];
#pragma unroll
      for (int j = 0; j < 16; ++j) v[j] = tile[(skc + j) * 129 + snr];
      u32x4 w0, w1;
      w0.x = cvtpk(v[0], v[1]); w0.y = cvtpk(v[2], v[3]); w0.z = cvtpk(v[4], v[5]); w0.w = cvtpk(v[6], v[7]);
      w1.x = cvtpk(v[8], v[9]); w1.y = cvtpk(v[10], v[11]); w1.z = cvtpk(v[12], v[13]); w1.w = cvtpk(v[14], v[15]);
      bf16_t* dst;
      if (which < 2) { const int k0 = (r >> 2) * 64, n = (r & 3) * 128 + snr; dst = ws_wgu(p) + (size_t)e * 1024 * 1024 + (size_t)((n >> 7) * 256 + (n & 127) + which * 128) * 1024 + k0 + skc; }
      else { const int k0 = (r >> 3) * 64, n = (r & 7) * 128 + snr; dst = ws_wd(p) + (size_t)e * 1024 * 512 + (size_t)n * 512 + k0 + skc; }
      *(u32x4*)dst = w0; *(u32x4*)(dst + 8) = w1;
    }
  }
}

struct Seg { int e, r0, cnt, start; };
DI Seg find_seg(const int* cnt, int mtile) {
  Seg s; s.e = -1; int acc = 0, start = 0;
  for (int e = 0; e < NEXP; ++e) { const int c = cnt[e], nt = (c + GBM - 1) / GBM; if (mtile < acc + nt) { s.e = e; s.r0 = (mtile - acc) * GBM; s.cnt = c; s.start = start; return s; } acc += nt; start += c; }
  return s;
}
struct ARowList { const int* list; int r0, cnt; DI int operator()(int r) const { int q = r0 + r; q = q < cnt ? q : cnt - 1; return list[q] >> 1; } };
struct EpiHid { bf16_t* o; int row0, nvalid, col0; DI void operator()(int r, int c, float g, float u) const {
  if (r < nvalid) o[(size_t)(row0 + r) * DEXP + ((col0 + c) >> 6) * 32 + (c & 31)] = f2bf(g / (1.0f + __expf(-g)) * u); } };
DI void phase8(const Params& p, int bid, int nb, char* lds) {
  const int* cnt = ws_cnt(p);
  for (int tile = bid; tile < 288 * 8; tile += nb) {
    const Seg s = find_seg(cnt, tile >> 3);
    if (s.e < 0) break;
    const int nt = tile & 7;
    gemm_tile(ws_h2(p), DM, ARowList{ws_list(p) + s.e * LCAP, s.r0, s.cnt}, ws_wgu(p) + (size_t)s.e * 1024 * 1024, DM, nt * GBN, DM,
              EpiHid{ws_hid(p), s.start + s.r0, s.cnt - s.r0, nt * GBN}, lds);
  }
}
struct ARowClamp { int base, r0, cnt; DI int operator()(int r) const { int q = r0 + r; q = q < cnt ? q : cnt - 1; return base + q; } };
struct EpiY { bf16_t* o; const int* list; const float* wa; int r0, cnt, col0; DI void operator()(int r, int c, float v0, float v1) const {
  if (r0 + r < cnt) { const int aid = list[r0 + r]; const float w = wa[aid]; bf16_t* q = o + (size_t)aid * DM + col0 + c; q[0] = f2bf(v0 * w); q[32] = f2bf(v1 * w); } } };
DI void phase9(const Params& p, int bid, int nb, char* lds) {
  const int* cnt = ws_cnt(p);
  for (int tile = bid; tile < 288 * 8; tile += nb) {
    const Seg s = find_seg(cnt, tile >> 3);
    if (s.e < 0) break;
    const int nt = tile & 7;
    gemm_tile(ws_hid(p), DEXP, ARowClamp{s.start, s.r0, s.cnt}, ws_wd(p) + (size_t)s.e * 1024 * 512, DEXP, nt * GBN, DEXP,
              EpiY{ws_ybuf(p), ws_list(p) + s.e * LCAP, ws_wa(p), s.r0, s.cnt, nt * GBN}, lds);
  }
}

DI void phase10(const Params& p, int bid, int nb, char* lds) {
  const int lane = tid_() & 63, wid = tid_() >> 6;
  const float* mod = ws_mod(p); const float* fm = ws_fmod(p);
  for (int gt = bid * 8 + wid; gt < NTOK; gt += nb * 8) {
    const int b = gt >> 11;
    const float* xr = ws_x1(p) + (size_t)gt * DM; float* xo = p.out + (size_t)gt * DM;
    const bf16_t* ya = ws_ybuf(p) + (size_t)(gt * 2) * DM; const bf16_t* yb = ya + DM;
    f32x4 v[4]; float ss = 0.f;
#pragma unroll
    for (int i = 0; i < 4; ++i) {
      const int col = lane * 4 + 256 * i;
      v[i] = *(const f32x4*)(xr + col);
      const u32x2 a = *(const u32x2*)(ya + col), bq = *(const u32x2*)(yb + col);
      const f32x4 g2 = *(const f32x4*)(mod + b * 6144 + 5120 + col);
      const float m0 = __uint_as_float(a.x << 16) + __uint_as_float(bq.x << 16), m1 = __uint_as_float(a.x & 0xffff0000u) + __uint_as_float(bq.x & 0xffff0000u);
      const float m2 = __uint_as_float(a.y << 16) + __uint_as_float(bq.y << 16), m3 = __uint_as_float(a.y & 0xffff0000u) + __uint_as_float(bq.y & 0xffff0000u);
      v[i][0] += (1.0f + g2[0]) * m0; v[i][1] += (1.0f + g2[1]) * m1; v[i][2] += (1.0f + g2[2]) * m2; v[i][3] += (1.0f + g2[3]) * m3;
      ss += v[i][0] * v[i][0] + v[i][1] * v[i][1] + v[i][2] * v[i][2] + v[i][3] * v[i][3];
    }
    ss = wave_sum(ss);
    const float rstd = rsqrtf(ss * (1.0f / DM) + 1e-6f);
#pragma unroll
    for (int i = 0; i < 4; ++i) {
      const int col = lane * 4 + 256 * i;
      const f32x4 g = *(const f32x4*)(p.final_norm_g + col), sh = *(const f32x4*)(fm + b * 2048 + col), sc = *(const f32x4*)(fm + b * 2048 + 1024 + col);
      f32x4 o;
#pragma unroll
      for (int j = 0; j < 4; ++j) o[j] = v[i][j] * rstd * g[j] * (1.0f + sc[j]) + sh[j];
      *(f32x4*)(xo + col) = o;
    }
  }
}

#define XB_TMO      128
#define XB_XCNT(j)  (256  + 64 * (j))
#define XB_XSUB(j)  (1280 + 64 * (j))
#define XB_XGEN(j)  (2304 + 64 * (j))
#define XB_TOP      3328
#define XB_TOPGEN   3392
#define XCD_BAR_WORDS 3456
#define XB_SPIN_CAP (1u << 18)
#define XLAS __attribute__((address_space(3)))

__device__ __forceinline__ unsigned xb_ld(unsigned* p)              { return __hip_atomic_load(p, __ATOMIC_RELAXED, __HIP_MEMORY_SCOPE_AGENT); }
__device__ __forceinline__ unsigned xb_add(unsigned* p, unsigned v) { return __hip_atomic_fetch_add(p, v, __ATOMIC_RELAXED, __HIP_MEMORY_SCOPE_AGENT); }
__device__ __forceinline__ unsigned xb_xcc_id() { return (unsigned)__builtin_amdgcn_s_getreg((3 << 11) | 20) & 0xFu; }
#define XB_SPIN(cond, bar) do { unsigned _sp = 0; while (cond) { __builtin_amdgcn_s_sleep(1); \
    if ((++_sp & 255u) == 0u) { if (xb_ld(&(bar)[XB_TMO])) break; if (_sp > XB_SPIN_CAP) { atomicAdd(&(bar)[XB_TMO], 1u); break; } } } } while (0)

struct XcdBarrier {
    unsigned* bar; unsigned x;
    volatile XLAS unsigned* st;
};

__device__ __forceinline__ XcdBarrier xcd_barrier_post(unsigned* bar, volatile XLAS unsigned* st) {
    XcdBarrier b; b.bar = bar; b.x = xb_xcc_id(); b.st = st;
    if (threadIdx.x == 0) (void)xb_add(&bar[XB_XCNT(b.x)], 1u);
    return b;
}
__device__ __forceinline__ void xcd_barrier_complete(unsigned* bar, unsigned x, unsigned& nloc, unsigned& nx) {
    const unsigned G = gridDim.x * gridDim.y * gridDim.z;
    unsigned sum, cnt, mine, sp = 0u;
    for (;;) {
        sum = 0u; cnt = 0u; mine = 0u;
#pragma unroll
        for (unsigned j = 0; j < 16; ++j) { const unsigned c = xb_ld(&bar[XB_XCNT(j)]); sum += c; cnt += (c > 0u) ? 1u : 0u; mine = (j == x) ? c : mine; }
        if (sum == G) break;
        __builtin_amdgcn_s_sleep(1);
        if ((++sp & 255u) == 0u) { if (xb_ld(&bar[XB_TMO])) break; if (sp > XB_SPIN_CAP) { atomicAdd(&bar[XB_TMO], 1u); break; } }
    }
    nloc = mine > 0u ? mine : 1u; nx = cnt > 0u ? cnt : 1u;
}

__device__ __forceinline__ void xcd_barrier(const XcdBarrier& b) {
    asm volatile("s_waitcnt vmcnt(0)" ::: "memory");
    __syncthreads();
    if (threadIdx.x == 0) {
        unsigned* bar = b.bar;
        __builtin_amdgcn_s_waitcnt(0);
        unsigned nloc = b.st[0], nx = b.st[1];
        if (nloc == 0u) { xcd_barrier_complete(bar, b.x, nloc, nx); b.st[0] = nloc; b.st[1] = nx; }
        const unsigned old = xb_add(&bar[XB_XSUB(b.x)], 1u);
        const unsigned gen = old / nloc;
        if (old + 1u == (gen + 1u) * nloc) {
            __builtin_amdgcn_fence(__ATOMIC_RELEASE, "agent");
            asm volatile("s_waitcnt vmcnt(0)" ::: "memory");
            const unsigned og = xb_add(&bar[XB_TOP], 1u);
            const unsigned tg = og / nx;
            if (og + 1u == (tg + 1u) * nx) xb_add(&bar[XB_TOPGEN], 1u);
            else XB_SPIN(xb_ld(&bar[XB_TOPGEN]) == tg, bar);
            __builtin_amdgcn_fence(__ATOMIC_ACQUIRE, "agent");
            xb_add(&bar[XB_XGEN(b.x)], 1u);
            asm volatile("s_waitcnt vmcnt(0)" ::: "memory");
        } else {
            XB_SPIN(xb_ld(&bar[XB_XGEN(b.x)]) == gen, bar);
            __builtin_amdgcn_fence(__ATOMIC_ACQUIRE, "agent");
            asm volatile("s_waitcnt vmcnt(0)" ::: "memory");
        }
    }
    __syncthreads();
}

#if MEGA
__global__ void __launch_bounds__(NTHR) k_mega(Params p) {
  extern __shared__ __attribute__((aligned(16))) char smem[];
  cg::grid_group grid = cg::this_grid();
  const int bid = blockIdx.x, nb = gridDim.x;
  volatile XLAS unsigned* xst = (volatile XLAS unsigned*)(XLAS char*)(smem + LDS_BYTES - 64);
  if (threadIdx.x < 4) xst[threadIdx.x] = 0u;
  if (bid == 0) for (int i = threadIdx.x; i < XCD_BAR_WORDS; i += NTHR) ws_bar(p)[i] = 0u;
  phase0(p, bid, nb, smem);
  grid.sync();
  XcdBarrier xb = xcd_barrier_post(ws_bar(p), xst);
#define SEAM() xcd_barrier(xb)
  phase1(p, bid, nb, smem); SEAM();
  phase2_pg8(p, bid, nb, smem); SEAM();
  phase3_mfma<3>(p, bid, nb, smem); SEAM();
  phase4a_chunk(p, bid, nb, smem); phase4b_mfma(p, bid, nb, smem); SEAM();
  phase5a(p, bid, nb, smem); phase5b_mfma(p, bid, nb, smem); SEAM();
  phase6_pg8(p, bid, nb, smem); SEAM();
  phase7(p, bid, nb, smem); SEAM();
  phase8_pg8(p, bid, nb, smem); SEAM();
  phase9_pg8(p, bid, nb, smem); SEAM();
  phase10(p, bid, nb, smem);
}
#else
#define PHASE_KERNEL(name, body) __global__ void __launch_bounds__(NTHR) name(Params p) { extern __shared__ __attribute__((aligned(16))) char smem[]; body(p, blockIdx.x, gridDim.x, smem); }
PHASE_KERNEL(k_phase0, phase0)
PHASE_KERNEL(k_phase1, phase1)
PHASE_KERNEL(k_phase2, phase2)
PHASE_KERNEL(k_phase3a, phase3a)
PHASE_KERNEL(k_phase3b, phase3b)
PHASE_KERNEL(k_phase4a, phase4a)
PHASE_KERNEL(k_phase4a2, phase4a_v2)
PHASE_KERNEL(k_phase4a3, phase4a_v3)
PHASE_KERNEL(k_phase4b, phase4b)
PHASE_KERNEL(k_phase4bm, phase4b_mfma)
PHASE_KERNEL(k_phase3m, phase3_mfma<3>)
PHASE_KERNEL(k_phase5a, phase5a)
PHASE_KERNEL(k_phase5b, phase5b)
PHASE_KERNEL(k_phase5bm, phase5b_mfma)
PHASE_KERNEL(k_phase6, phase6)
PHASE_KERNEL(k_phase7, phase7)
PHASE_KERNEL(k_phase8, phase8)
PHASE_KERNEL(k_phase9, phase9)
PHASE_KERNEL(k_phase10, phase10)
#endif

extern "C" void kernel_launch(void* const* d_in, const int* in_sizes, int n_in, void* d_out, int out_size, void* d_ws, size_t ws_size, hipStream_t stream) {
  Params p{};
  const float** f = (const float**)&p;
  for (int i = 0; i < 33; ++i) f[i] = (const float*)d_in[i];
  p.out = (float*)d_out; p.ws = (char*)d_ws;
  if (n_in != 33 || ws_size < (size_t)(OFF_S + 9 * MiB) || out_size != NTOK * DM) { fprintf(stderr, "kernel_launch: unexpected problem shape or workspace (n_in %d, ws %zu, out %d)\n", n_in, ws_size, out_size); return; }
#if MEGA
  static int grid_blocks = 0;
  if (!grid_blocks) {
    int dev = 0, cus = 0, per_cu = 0;
    hipGetDevice(&dev);
    hipDeviceGetAttribute(&cus, hipDeviceAttributeMultiprocessorCount, dev);
    hipFuncSetAttribute((const void*)k_mega, hipFuncAttributeMaxDynamicSharedMemorySize, LDS_BYTES);
    hipOccupancyMaxActiveBlocksPerMultiprocessor(&per_cu, k_mega, NTHR, LDS_BYTES);
    if (per_cu > 1) per_cu = 1;
    grid_blocks = cus * per_cu;
  }
  void* args[] = {&p};
  hipError_t e = hipLaunchCooperativeKernel((void*)k_mega, dim3(grid_blocks), dim3(NTHR), args, LDS_BYTES, stream);
  if (e != hipSuccess) fprintf(stderr, "cooperative launch failed: %s (grid %d)\n", hipGetErrorString(e), grid_blocks);
#else
  const int G = 512;
#define LAUNCH(k, g) hipLaunchKernelGGL(k, dim3(g), dim3(NTHR), LDS_BYTES, stream, p)
  LAUNCH(k_phase0, G);
  LAUNCH(k_phase1, G);
  LAUNCH(k_phase2, G);
  LAUNCH(k_phase3a, G);
  LAUNCH(k_phase3b, G);
  LAUNCH(k_phase4a, 128);
  LAUNCH(k_phase4b, 1024);
  LAUNCH(k_phase5a, G);
  LAUNCH(k_phase5b, 1024);
  LAUNCH(k_phase6, G);
  LAUNCH(k_phase7, G);
  LAUNCH(k_phase8, G);
  LAUNCH(k_phase9, G);
  LAUNCH(k_phase10, G);
#endif
}
```

```cpp
#include <hip/hip_runtime.h>
#include <hip/hip_cooperative_groups.h>
#include <stdint.h>
#include <stdio.h>

namespace cg = cooperative_groups;

#ifndef MEGA
#define MEGA 1
#endif

typedef unsigned short bf16_t;
typedef short bf16x8 __attribute__((ext_vector_type(8)));
typedef float f32x16 __attribute__((ext_vector_type(16)));
typedef float f32x4 __attribute__((ext_vector_type(4)));
typedef float f32x4v __attribute__((ext_vector_type(4)));
typedef unsigned u32x4 __attribute__((ext_vector_type(4)));
typedef unsigned u32x2 __attribute__((ext_vector_type(2)));

#define DI __device__ __forceinline__

constexpr int DM = 1024, BATCH = 16, SEQ = 2048, NTOK = BATCH * SEQ;
constexpr int RW = 512, NH = 8, HD = 64;
constexpr int PROJ_N = 2756, PROJ_LD = 2816;
constexpr int C_R = 0, C_K = 512, C_V = 1024, C_WL = 1536, C_AL = 1600, C_GL = 1664;
constexpr int C_Q = 1792, C_CKV = 2304, C_QI = 2432, C_KI = 2688, C_WI = 2752;
constexpr int NEXP = 32, DEXP = 512, LCAP = 32768;
constexpr int NTHR = 512;
constexpr int LDS_BYTES = 163840;

constexpr size_t MiB = 1048576;
constexpr size_t OFF_A = 0;
constexpr size_t OFF_B = 64 * MiB;
constexpr size_t OFF_C = 240 * MiB;
constexpr size_t OFF_F = 400 * MiB;
constexpr size_t OFF_G = 464 * MiB;
constexpr size_t OFF_W = 484 * MiB;
constexpr size_t OFF_S = 492 * MiB;

struct Params {
  const float *x, *c, *ada_w, *ada_b, *norm1_g, *w_in, *shift_mu, *w0, *w_decay_up, *a0, *w_aaa_up, *w_gate_up;
  const float *k_k, *k_a, *r_k, *gn_g, *gn_b, *kv_norm_g, *k_idx_norm_g, *w_uk, *w_uv, *w_out, *norm2_g;
  const float *w_group, *b_group, *w_expert, *b_expert, *e_gate, *e_up, *e_down, *final_ada_w, *final_ada_b, *final_norm_g;
  float* out;
  char* ws;
};

DI int tid_() { int t = threadIdx.x; asm volatile("" : "+v"(t)); return t; }
DI float bf2f(bf16_t u) { return __uint_as_float(((unsigned)u) << 16); }
DI bf16_t f2bf(float f) { unsigned u = __float_as_uint(f); u += 0x7fffu + ((u >> 16) & 1u); return (bf16_t)(u >> 16); }
DI unsigned pack2(float lo, float hi) { return (unsigned)f2bf(lo) | ((unsigned)f2bf(hi) << 16); }
DI float wave_sum(float v) { for (int o = 32; o; o >>= 1) v += __shfl_xor(v, o); return v; }
DI float wave_max(float v) { for (int o = 32; o; o >>= 1) v = fmaxf(v, __shfl_xor(v, o)); return v; }
DI float sigmoidf_(float v) { return 1.0f / (1.0f + __expf(-v)); }
DI int crow(int r, int hi) { return (r & 3) + 8 * (r >> 2) + 4 * hi; }
DI unsigned cvtpk(float lo, float hi) { unsigned r; asm volatile("v_cvt_pk_bf16_f32 %0, %1, %2" : "=v"(r) : "v"(lo), "v"(hi)); return r; }

DI void unpack8(const u32x4 w, float* o) {
  o[0] = __uint_as_float(w.x << 16); o[1] = __uint_as_float(w.x & 0xffff0000u); o[2] = __uint_as_float(w.y << 16); o[3] = __uint_as_float(w.y & 0xffff0000u);
  o[4] = __uint_as_float(w.z << 16); o[5] = __uint_as_float(w.z & 0xffff0000u); o[6] = __uint_as_float(w.w << 16); o[7] = __uint_as_float(w.w & 0xffff0000u);
}
DI void load8(const bf16_t* p, float* o) { unpack8(*(const u32x4*)p, o); }

DI bf16_t* ws_h1(const Params& p) { return (bf16_t*)(p.ws + OFF_A); }
DI float* ws_y(const Params& p) { return (float*)(p.ws + OFF_A); }
DI bf16_t* ws_h2(const Params& p) { return (bf16_t*)(p.ws + OFF_A); }
DI bf16_t* ws_proj(const Params& p) { return (bf16_t*)(p.ws + OFF_B); }
DI float* ws_x1(const Params& p) { return (float*)(p.ws + OFF_B); }
DI bf16_t* ws_wgu(const Params& p) { return (bf16_t*)p.out; }
DI bf16_t* ws_wd(const Params& p) { return (bf16_t*)((char*)p.out + 64 * MiB); }
DI bf16_t* ws_hid(const Params& p) { return (bf16_t*)(p.ws + OFF_B + 96 * MiB); }
DI bf16_t* ws_kp(const Params& p) { return (bf16_t*)(p.ws + OFF_C); }
DI bf16_t* ws_kk(const Params& p) { return (bf16_t*)(p.ws + OFF_C + 32 * MiB); }
DI bf16_t* ws_bb(const Params& p) { return (bf16_t*)(p.ws + OFF_C + 64 * MiB); }
DI bf16_t* ws_ee(const Params& p) { return (bf16_t*)(p.ws + OFF_C + 96 * MiB); }
DI bf16_t* ws_gg(const Params& p) { return (bf16_t*)(p.ws + OFF_C + 128 * MiB); }
DI bf16_t* ws_mix(const Params& p) { return (bf16_t*)(p.ws + OFF_C); }
DI bf16_t* ws_ybuf(const Params& p) { return (bf16_t*)(p.ws + OFF_C); }
DI bf16_t* ws_qlat(const Params& p) { return (bf16_t*)(p.ws + OFF_F); }
DI bf16_t* ws_ckv(const Params& p) { return (bf16_t*)(p.ws + OFF_G); }
DI bf16_t* ws_kidx(const Params& p) { return (bf16_t*)(p.ws + OFF_G + 8 * MiB); }
DI unsigned* ws_mask(const Params& p) { return (unsigned*)(p.ws + OFF_G + 12 * MiB); }
DI bf16_t* ws_wtin(const Params& p) { return (bf16_t*)(p.ws + OFF_W); }
DI bf16_t* ws_wtout(const Params& p) { return (bf16_t*)(p.ws + OFF_W + 6 * MiB); }
DI bf16_t* ws_wuvt(const Params& p) { return (bf16_t*)(p.ws + OFF_S + 7 * MiB); }
DI bf16_t* ws_wdt(const Params& p) { return (bf16_t*)(p.ws + OFF_S + 8 * MiB + 64 * 1024); }
DI bf16_t* ws_wat(const Params& p) { return (bf16_t*)(p.ws + OFF_S + 8 * MiB + 128 * 1024); }
DI bf16_t* ws_wgt(const Params& p) { return (bf16_t*)(p.ws + OFF_S + 8 * MiB + 192 * 1024); }
DI bf16_t* ws_wukt(const Params& p) { return (bf16_t*)(p.ws + OFF_S + 8 * MiB + 320 * 1024); }
DI unsigned* ws_bar(const Params& p) { return (unsigned*)(p.ws + OFF_S + 8 * MiB); }
DI float* ws_mod(const Params& p) { return (float*)(p.ws + OFF_S); }
DI float* ws_fmod(const Params& p) { return (float*)(p.ws + OFF_S + 512 * 1024); }
DI float* ws_bonus(const Params& p) { return (float*)(p.ws + OFF_S + 1 * MiB); }
DI int* ws_cnt(const Params& p) { return (int*)(p.ws + OFF_S + 2 * MiB); }
DI float* ws_wa(const Params& p) { return (float*)(p.ws + OFF_S + 2 * MiB + 4096); }
DI int* ws_list(const Params& p) { return (int*)(p.ws + OFF_S + 3 * MiB); }

template <class RowMap>
DI void transpose_tile(const float* src, int N, int k0, int n0, bf16_t* dst, int dstld, RowMap rm, char* lds) {
  float* tile = (float*)lds;
  const int t = tid_();
  __syncthreads();
  {
    const int nc = t & 63, krb = t >> 6;
#pragma unroll
    for (int i = 0; i < 8; ++i) {
      const int kr = krb + 8 * i;
      const int n = n0 + nc;
      tile[kr * 65 + nc] = (n < N) ? src[(size_t)(k0 + kr) * N + n] : 0.f;
    }
  }
  __syncthreads();
  {
    const int nr = t >> 3, kc = (t & 7) * 8;
    u32x4 w;
    w.x = pack2(tile[(kc + 0) * 65 + nr], tile[(kc + 1) * 65 + nr]);
    w.y = pack2(tile[(kc + 2) * 65 + nr], tile[(kc + 3) * 65 + nr]);
    w.z = pack2(tile[(kc + 4) * 65 + nr], tile[(kc + 5) * 65 + nr]);
    w.w = pack2(tile[(kc + 6) * 65 + nr], tile[(kc + 7) * 65 + nr]);
    *(u32x4*)(dst + (size_t)rm(n0 + nr) * dstld + k0 + kc) = w;
  }
}
struct RowId { DI int operator()(int n) const { return n; } };
struct RowGU { int add; DI int operator()(int n) const { return (n >> 7) * 256 + (n & 127) + add; } };

DI void phase0(const Params& p, int bid, int nb, char* lds) {
  const int t = tid_();
  if (bid == 0 && t < NEXP) ws_cnt(p)[t] = 0;
  for (int idx = bid * NTHR + t; idx < 8 * 64 * 128; idx += nb * NTHR) {
    const int e8 = idx & 7, ln = (idx >> 3) & 63, l32 = ln & 31, lh = ln >> 5;
    { const int hh = idx >> 13, i2 = (idx >> 12) & 1, ks = (idx >> 9) & 7, d = i2 * 32 + l32, cc = ks * 16 + lh * 8 + e8;
      ws_wuvt(p)[idx] = f2bf(p.w_uv[(size_t)(cc * NH + hh) * HD + d]); }
    { const int h2 = idx >> 13, mt = (idx >> 11) & 3, ks = (idx >> 9) & 3, c2 = mt * 32 + l32, d2 = ks * 16 + lh * 8 + e8;
      ws_wukt(p)[idx] = f2bf(p.w_uk[(size_t)(c2 * NH + h2) * HD + d2]); }
  }
  for (int idx = bid * NTHR + t; idx < 512 * 128; idx += nb * NTHR) {
    const int e8 = idx & 7, ln = (idx >> 3) & 63, l32 = ln & 31, lh = ln >> 5;
    { const int ks = (idx >> 9) & 7, mt = (idx >> 12) & 1, hh = idx >> 13, ch = hh * HD + mt * 32 + l32, k = ks * 16 + lh * 8 + e8;
      ws_wgt(p)[idx] = f2bf(p.w_gate_up[(size_t)k * RW + ch]); }
    if (idx < 512 * 64) { const int ks = (idx >> 9) & 3, mt = (idx >> 11) & 1, hh = idx >> 12, ch = hh * HD + mt * 32 + l32, k = ks * 16 + lh * 8 + e8;
      ws_wdt(p)[idx] = f2bf(p.w_decay_up[(size_t)k * RW + ch]); ws_wat(p)[idx] = f2bf(p.w_aaa_up[(size_t)k * RW + ch]); }
  }
  for (int task = bid; task < 256; task += nb) {
    float* cact = (float*)lds;
    __syncthreads();
    for (int i = t; i < 16 * 1024; i += NTHR) { const float v = p.c[i]; cact[i] = v / (1.0f + __expf(-v)); }
    __syncthreads();
    const int col = task * 32 + (t & 31), ks = t >> 5;
    const float* w; int ld, cc;
    if (col < 6144) { w = p.ada_w; ld = 6144; cc = col; } else { w = p.final_ada_w; ld = 2048; cc = col - 6144; }
    float acc[16];
#pragma unroll
    for (int b = 0; b < 16; ++b) acc[b] = 0.f;
    for (int kk = 0; kk < 64; ++kk) {
      const int k = ks * 64 + kk;
      const float wv = w[(size_t)k * ld + cc];
#pragma unroll
      for (int b = 0; b < 16; ++b) acc[b] += cact[b * 1024 + k] * wv;
    }
    __syncthreads();
    float* red = (float*)lds;
#pragma unroll
    for (int b = 0; b < 16; ++b) red[(ks * 16 + b) * 32 + (t & 31)] = acc[b];
    __syncthreads();
    {
      const int b = t >> 5, cl = t & 31, colo = task * 32 + cl;
      float s = 0.f;
      for (int k2 = 0; k2 < 16; ++k2) s += red[(k2 * 16 + b) * 32 + cl];
      if (colo < 6144) ws_mod(p)[b * 6144 + colo] = s + p.ada_b[colo];
      else ws_fmod(p)[b * 2048 + colo - 6144] = s + p.final_ada_b[colo - 6144];
    }
  }
  for (int task = bid; task < 704 + 256; task += nb) {
    if (task < 704) { const int kt = task / 44, nt = task % 44; transpose_tile(p.w_in, PROJ_N, kt * 64, nt * 64, ws_wtin(p), 1024, RowId(), lds); }
    else { const int q = task - 704, kt = q >> 4, nt = q & 15; transpose_tile(p.w_out, 1024, kt * 64, nt * 64, ws_wtout(p), 1024, RowId(), lds); }
  }
}

DI void phase1(const Params& p, int bid, int nb, char* lds) {
  const int lane = tid_() & 63, wid = tid_() >> 6;
  const float* mod = ws_mod(p);
  for (int row = bid * 8 + wid; row < NTOK; row += nb * 8) {
    const int b = row >> 11;
    const float* xr = p.x + (size_t)row * DM;
    f32x4 v[4]; float ss = 0.f;
#pragma unroll
    for (int i = 0; i < 4; ++i) { v[i] = *(const f32x4*)(xr + lane * 4 + 256 * i); ss += v[i][0] * v[i][0] + v[i][1] * v[i][1] + v[i][2] * v[i][2] + v[i][3] * v[i][3]; }
    ss = wave_sum(ss);
    const float rstd = rsqrtf(ss * (1.0f / DM) + 1e-6f);
#pragma unroll
    for (int i = 0; i < 4; ++i) {
      const int col = lane * 4 + 256 * i;
      const f32x4 g = *(const f32x4*)(p.norm1_g + col), sh = *(const f32x4*)(mod + b * 6144 + col), sc = *(const f32x4*)(mod + b * 6144 + 1024 + col);
      float o[4];
#pragma unroll
      for (int j = 0; j < 4; ++j) o[j] = v[i][j] * rstd * g[j] * (1.0f + sc[j]) + sh[j];
      u32x2 w; w.x = pack2(o[0], o[1]); w.y = pack2(o[2], o[3]);
      *(u32x2*)(ws_h1(p) + (size_t)row * DM + col) = w;
    }
  }
}

constexpr int GBM = 256, GBN = 128, GBK = 32, GROW = 80, G_LDSA = GBM * GROW, G_STAGE = (GBM + GBN) * GROW;
template <class ARow, class Epi>
DI void gemm_tile(const bf16_t* A, int lda, ARow arow, const bf16_t* Bt, int ldb, int n0, int K, Epi epi, char* lds) {
  const int t = tid_(), lane = t & 63, wid = t >> 6, wm = wid >> 1, wn = wid & 1, r32 = lane & 31, hi = lane >> 5;
  const int srow = t >> 2, sch = t & 3;
  const bf16_t* a0p = A + (size_t)arow(srow) * lda + sch * 8;
  const bf16_t* a1p = A + (size_t)arow(srow + 128) * lda + sch * 8;
  const bf16_t* bp = Bt + (size_t)(n0 + srow) * ldb + sch * 8;
  const int wa0 = srow * GROW + sch * 16, wa1 = (srow + 128) * GROW + sch * 16, wb = G_LDSA + srow * GROW + sch * 16;
  const int ra = (wm * 64 + r32) * GROW + hi * 16, rb = G_LDSA + (wn * 64 + r32) * GROW + hi * 16;
  f32x16 acc[2][2];
#pragma unroll
  for (int i = 0; i < 2; ++i)
#pragma unroll
    for (int j = 0; j < 2; ++j)
#pragma unroll
      for (int r = 0; r < 16; ++r) acc[i][j][r] = 0.f;
  u32x4 ga0 = *(const u32x4*)a0p, ga1 = *(const u32x4*)a1p, gb = *(const u32x4*)bp;
  __syncthreads();
  *(u32x4*)(lds + wa0) = ga0; *(u32x4*)(lds + wa1) = ga1; *(u32x4*)(lds + wb) = gb;
  __syncthreads();
  const int nk = K / GBK;
  for (int kt = 0; kt < nk; ++kt) {
    char* cur = lds + (kt & 1) * G_STAGE;
    char* nxt = lds + ((kt + 1) & 1) * G_STAGE;
    if (kt + 1 < nk) { ga0 = *(const u32x4*)(a0p + (kt + 1) * GBK); ga1 = *(const u32x4*)(a1p + (kt + 1) * GBK); gb = *(const u32x4*)(bp + (kt + 1) * GBK); }
#pragma unroll
    for (int ks = 0; ks < 2; ++ks) {
      bf16x8 a[2], b[2];
#pragma unroll
      for (int i = 0; i < 2; ++i) { a[i] = *(const bf16x8*)(cur + ra + i * 32 * GROW + ks * 32); b[i] = *(const bf16x8*)(cur + rb + i * 32 * GROW + ks * 32); }
#pragma unroll
      for (int i = 0; i < 2; ++i)
#pragma unroll
        for (int j = 0; j < 2; ++j) acc[i][j] = __builtin_amdgcn_mfma_f32_32x32x16_bf16(a[i], b[j], acc[i][j], 0, 0, 0);
    }
    if (kt + 1 < nk) { *(u32x4*)(nxt + wa0) = ga0; *(u32x4*)(nxt + wa1) = ga1; *(u32x4*)(nxt + wb) = gb; }
    __syncthreads();
  }
#pragma unroll
  for (int i = 0; i < 2; ++i)
#pragma unroll
    for (int r = 0; r < 16; ++r) epi(wm * 64 + i * 32 + crow(r, hi), wn * 64 + r32, acc[i][0][r], acc[i][1][r]);
}

struct ARowBase { int base; DI int operator()(int r) const { return base + r; } };

struct EpiProj { bf16_t* o; int row0, col0; DI void operator()(int r, int c, float v0, float v1) const {
  bf16_t* q = o + (size_t)(row0 + r) * PROJ_LD + col0 + c; q[0] = f2bf(v0); q[32] = f2bf(v1); } };
DI void phase2(const Params& p, int bid, int nb, char* lds) {
  constexpr int NT = PROJ_LD / GBN;
  for (int tile = bid; tile < (NTOK / GBM) * NT; tile += nb) {
    const int mt = tile / NT, nt = tile % NT;
    gemm_tile(ws_h1(p), DM, ARowBase{mt * GBM}, ws_wtin(p), DM, nt * GBN, DM, EpiProj{ws_proj(p), mt * GBM, nt * GBN}, lds);
  }
}

DI float proj_shift(const bf16_t* proj, const float* mu, int gt, int col) {
  const float pv = bf2f(proj[(size_t)gt * PROJ_LD + col]);
  const float pp = (gt & (SEQ - 1)) ? bf2f(proj[(size_t)(gt - 1) * PROJ_LD + col]) : 0.f;
  return pv + mu[col] * (pp - pv);
}
DI void phase3a(const Params& p, int bid, int nb, char* lds) {
  const int t = tid_(), lane = t & 63, wid = t >> 6;
  float* xl = (float*)lds;
  const bf16_t* proj = ws_proj(p);
  for (int tile = bid; tile < NTOK / 16; tile += nb) {
    const int t0 = tile * 16;
    __syncthreads();
    for (int idx = t; idx < 16 * 256; idx += NTHR) {
      const int tok = idx >> 8, col = idx & 255;
      float v = proj_shift(proj, p.shift_mu, t0 + tok, C_WL + col);
      if (col < 64) v = tanhf(v); else if (col >= 128) v = sigmoidf_(v);
      xl[idx] = v;
    }
    __syncthreads();
    const int c = t;
    float acc[16];
#pragma unroll
    for (int i = 0; i < 16; ++i) acc[i] = 0.f;
    for (int k4 = 0; k4 < 16; ++k4) {
      float w[4];
#pragma unroll
      for (int j = 0; j < 4; ++j) w[j] = p.w_decay_up[(k4 * 4 + j) * RW + c];
#pragma unroll
      for (int i = 0; i < 16; ++i) { const f32x4 xv = *(const f32x4*)(xl + i * 256 + k4 * 4); acc[i] += xv[0] * w[0] + xv[1] * w[1] + xv[2] * w[2] + xv[3] * w[3]; }
    }
    {
      const float w0c = p.w0[c];
#pragma unroll
      for (int i = 0; i < 16; ++i) {
        const float z = -(w0c + acc[i]);
        const float sp = fmaxf(z, 0.f) + log1pf(__expf(-fabsf(z)));
        ws_ee(p)[(size_t)(t0 + i) * RW + c] = f2bf(__expf(-sp - 0.5f));
      }
    }
#pragma unroll
    for (int i = 0; i < 16; ++i) acc[i] = 0.f;
    for (int k4 = 0; k4 < 32; ++k4) {
      float w[4];
#pragma unroll
      for (int j = 0; j < 4; ++j) w[j] = p.w_gate_up[(k4 * 4 + j) * RW + c];
#pragma unroll
      for (int i = 0; i < 16; ++i) { const f32x4 xv = *(const f32x4*)(xl + i * 256 + 128 + k4 * 4); acc[i] += xv[0] * w[0] + xv[1] * w[1] + xv[2] * w[2] + xv[3] * w[3]; }
    }
#pragma unroll
    for (int i = 0; i < 16; ++i) ws_gg(p)[(size_t)(t0 + i) * RW + c] = f2bf(acc[i]);
#pragma unroll
    for (int i = 0; i < 16; ++i) acc[i] = 0.f;
    for (int k4 = 0; k4 < 16; ++k4) {
      float w[4];
#pragma unroll
      for (int j = 0; j < 4; ++j) w[j] = p.w_aaa_up[(k4 * 4 + j) * RW + c];
#pragma unroll
      for (int i = 0; i < 16; ++i) { const f32x4 xv = *(const f32x4*)(xl + i * 256 + 64 + k4 * 4); acc[i] += xv[0] * w[0] + xv[1] * w[1] + xv[2] * w[2] + xv[3] * w[3]; }
    }
    {
      const float a0c = p.a0[c], kkc = p.k_k[c], kac = p.k_a[c], rkc = p.r_k[c];
#pragma unroll
      for (int i = 0; i < 16; ++i) {
        const int gt = t0 + i;
        const float a = sigmoidf_(a0c + acc[i]);
        const float r = proj_shift(proj, p.shift_mu, gt, C_R + c);
        const float k = proj_shift(proj, p.shift_mu, gt, C_K + c);
        float kk = k * kkc;
        const float nrm = fmaxf(sqrtf(wave_sum(kk * kk)), 1e-12f);
        kk = kk / nrm;
        const float kp = k * (1.0f + (a - 1.0f) * kac);
        const float bs = wave_sum(r * kp * rkc);
        ws_kp(p)[(size_t)gt * RW + c] = f2bf(kp);
        ws_kk(p)[(size_t)gt * RW + c] = f2bf(kk);
        ws_bb(p)[(size_t)gt * RW + c] = f2bf(kk * a);
        if (lane == 0) ws_bonus(p)[gt * NH + wid] = bs;
      }
    }
  }
}

DI void phase3b(const Params& p, int bid, int nb, char* lds) {
  const int t = tid_(), lane = t & 63, wid = t >> 6;
  float* ql = (float*)lds;
  const bf16_t* proj = ws_proj(p);
  for (int tile = bid; tile < NTOK / 16; tile += nb) {
    const int t0 = tile * 16;
    __syncthreads();
    for (int idx = t; idx < 16 * 512; idx += NTHR) ql[idx] = bf2f(proj[(size_t)(t0 + (idx >> 9)) * PROJ_LD + C_Q + (idx & 511)]);
#pragma unroll
    for (int q = 0; q < 2; ++q) {
      const int gt = t0 + wid * 2 + q;
      const float v0 = bf2f(proj[(size_t)gt * PROJ_LD + C_CKV + lane * 2]), v1 = bf2f(proj[(size_t)gt * PROJ_LD + C_CKV + lane * 2 + 1]);
      const float rs = rsqrtf(wave_sum(v0 * v0 + v1 * v1) * (1.0f / 128.0f) + 1e-6f);
      *(unsigned*)(ws_ckv(p) + (size_t)gt * 128 + lane * 2) = pack2(v0 * rs * p.kv_norm_g[lane * 2], v1 * rs * p.kv_norm_g[lane * 2 + 1]);
      const float u = bf2f(proj[(size_t)gt * PROJ_LD + C_KI + lane]);
      const float rs2 = rsqrtf(wave_sum(u * u) * (1.0f / 64.0f) + 1e-6f);
      ws_kidx(p)[(size_t)gt * 64 + lane] = f2bf(u * rs2 * p.k_idx_norm_g[lane]);
    }
    __syncthreads();
    const int h = wid;
#pragma unroll 1
    for (int ps = 0; ps < 2; ++ps) {
      const int cidx = lane + 64 * ps;
      float w[64];
      const float* wp = p.w_uk + (size_t)(cidx * NH + h) * HD;
#pragma unroll
      for (int d4 = 0; d4 < 16; ++d4) { const f32x4 wv = *(const f32x4*)(wp + d4 * 4); w[d4 * 4] = wv[0]; w[d4 * 4 + 1] = wv[1]; w[d4 * 4 + 2] = wv[2]; w[d4 * 4 + 3] = wv[3]; }
#pragma unroll 1
      for (int i = 0; i < 16; ++i) {
        float acc = 0.f;
#pragma unroll
        for (int d4 = 0; d4 < 16; ++d4) { const f32x4 qv = *(const f32x4*)(ql + i * 512 + h * 64 + d4 * 4); acc += qv[0] * w[d4 * 4] + qv[1] * w[d4 * 4 + 1] + qv[2] * w[d4 * 4 + 2] + qv[3] * w[d4 * 4 + 3]; }
        ws_qlat(p)[((size_t)(t0 + i) * NH + h) * 128 + cidx] = f2bf(acc * 0.125f);
      }
    }
  }
}

DI float xhalf_sum(float v) { auto rr = __builtin_amdgcn_permlane32_swap(__float_as_uint(v), __float_as_uint(v), false, false); return __uint_as_float(rr[0]) + __uint_as_float(rr[1]); }
DI float dpp_sum8(float v) {
  v += __int_as_float(__builtin_amdgcn_update_dpp(0, __float_as_int(v), 0xB1, 0xF, 0xF, true));
  v += __int_as_float(__builtin_amdgcn_update_dpp(0, __float_as_int(v), 0x4E, 0xF, 0xF, true));
  v += __int_as_float(__builtin_amdgcn_update_dpp(0, __float_as_int(v), 0x141, 0xF, 0xF, true));
  return v;
}
DI float dpp_sum16b(float v) { v = dpp_sum8(v); v += __int_as_float(__builtin_amdgcn_update_dpp(0, __float_as_int(v), 0x140, 0xF, 0xF, true)); return v; }
DI u32x2 pk4(float a, float b, float c, float d) { u32x2 w; w.x = cvtpk(a, b); w.y = cvtpk(c, d); return w; }
DI void ld4(const bf16_t* p, float* o) { const u32x2 w = *(const u32x2*)p; o[0] = __uint_as_float(w.x << 16); o[1] = __uint_as_float(w.x & 0xffff0000u); o[2] = __uint_as_float(w.y << 16); o[3] = __uint_as_float(w.y & 0xffff0000u); }
constexpr int XL_ROW = 528;
template <int MODE> DI void phase3_mfma(const Params& p, int bid, int nb, char* lds) {
  const int t_ = tid_(), wid = t_ >> 6, h = wid;
  const bf16_t* proj = ws_proj(p);
  float* PL = (float*)(lds + 64 * XL_ROW + 8 * 14336);
  static_assert(64 * XL_ROW + 8 * 14336 + 7 * 512 * 4 <= LDS_BYTES - 64, "prep LDS map");
  for (int i = t_; i < RW; i += NTHR) { PL[i] = p.w0[i]; PL[512 + i] = p.a0[i]; PL[1024 + i] = p.k_k[i]; PL[1536 + i] = p.k_a[i]; PL[2048 + i] = p.r_k[i]; PL[2560 + i] = p.shift_mu[C_R + i]; PL[3072 + i] = p.shift_mu[C_K + i]; }
  for (int tile = bid; tile < NTOK / 64; tile += nb) {
    const int t0 = tile * 64;
    int t = t_;
    asm volatile("" : "+v"(t));
    const int lane = t & 63, r32_ = lane & 31, hi_ = lane >> 5;
    __syncthreads();
#pragma unroll
    for (int i = 0; i < 4; ++i) {
      const int id = t + 512 * i, tok = id >> 5, cc = (id & 31) * 8, gt = t0 + tok;
      float v[8], pv[8];
      const bool firstt = (gt & (SEQ - 1)) == 0;
      load8(proj + (unsigned)(gt * PROJ_LD + C_WL + cc), v);
      load8(proj + (unsigned)((firstt ? gt : gt - 1) * PROJ_LD + C_WL + cc), pv);
      const f32x4 m0 = *(const f32x4*)(p.shift_mu + C_WL + cc), m1 = *(const f32x4*)(p.shift_mu + C_WL + cc + 4);
      const float esc = (cc < 64) ? 2.0f : -1.0f;
      float x[8];
#pragma unroll
      for (int j = 0; j < 8; ++j) {
        const float mu = j < 4 ? m0[j] : m1[j - 4];
        const float pj = firstt ? 0.f : pv[j];
        const float xv = v[j] + mu * (pj - v[j]);
        const float rc = 1.0f / (__expf(esc * xv) + 1.0f);
        x[j] = (cc < 64) ? (1.0f - 2.0f * rc) : ((cc >= 128) ? rc : xv);
      }
      u32x4 w; w.x = cvtpk(x[0], x[1]); w.y = cvtpk(x[2], x[3]); w.z = cvtpk(x[4], x[5]); w.w = cvtpk(x[6], x[7]);
      *(u32x4*)(lds + tok * XL_ROW + cc * 2) = w;
    }
    if (MODE & 2) {
#pragma unroll
    for (int it = 0; it < 2; ++it) {
      const int gt = t0 + wid * 8 + it * 4 + (lane >> 4), c0 = (lane & 15) * 8;
      float v[8]; load8(proj + (size_t)gt * PROJ_LD + C_CKV + c0, v);
      float ss = 0.f;
#pragma unroll
      for (int j = 0; j < 8; ++j) ss += v[j] * v[j];
      const float rs = rsqrtf(dpp_sum16b(ss) * (1.0f / 128.0f) + 1e-6f);
      const f32x4 g0 = *(const f32x4*)(p.kv_norm_g + c0), g1 = *(const f32x4*)(p.kv_norm_g + c0 + 4);
      u32x4 w; w.x = cvtpk(v[0] * rs * g0[0], v[1] * rs * g0[1]); w.y = cvtpk(v[2] * rs * g0[2], v[3] * rs * g0[3]);
      w.z = cvtpk(v[4] * rs * g1[0], v[5] * rs * g1[1]); w.w = cvtpk(v[6] * rs * g1[2], v[7] * rs * g1[3]);
      *(u32x4*)(ws_ckv(p) + (size_t)gt * 128 + c0) = w;
    }
    {
      const int gt = t0 + wid * 8 + (lane >> 3), c0 = (lane & 7) * 8;
      float v[8]; load8(proj + (size_t)gt * PROJ_LD + C_KI + c0, v);
      float ss = 0.f;
#pragma unroll
      for (int j = 0; j < 8; ++j) ss += v[j] * v[j];
      const float rs = rsqrtf(dpp_sum8(ss) * (1.0f / 64.0f) + 1e-6f);
      const f32x4 g0 = *(const f32x4*)(p.k_idx_norm_g + c0), g1 = *(const f32x4*)(p.k_idx_norm_g + c0 + 4);
      u32x4 w; w.x = cvtpk(v[0] * rs * g0[0], v[1] * rs * g0[1]); w.y = cvtpk(v[2] * rs * g0[2], v[3] * rs * g0[3]);
      w.z = cvtpk(v[4] * rs * g1[0], v[5] * rs * g1[1]); w.w = cvtpk(v[6] * rs * g1[2], v[7] * rs * g1[3]);
      *(u32x4*)(ws_kidx(p) + (size_t)gt * 64 + c0) = w;
    }
    }
    __syncthreads();
#pragma unroll 1
    for (int nt = 0; nt < 2; ++nt) {
      int r32 = r32_, hi = hi_;
      asm volatile("" : "+v"(r32), "+v"(hi));
      const int gt = t0 + nt * 32 + r32;
      const bool first = (gt & (SEQ - 1)) == 0;
      const int gp = first ? gt : gt - 1;
      const char* xrow = lds + (nt * 32 + r32) * XL_ROW + hi * 16;
      const int chb = h * HD + 4 * hi;
      char* RBt = lds + 64 * XL_ROW + wid * 14336; char* KBt = RBt + 4752; char* OBt = KBt + 4752;
      const int t0w = t0 + nt * 32, frow = lane >> 3, fch = lane & 7;
      const int cwo = r32 * 144 + hi * 8;
#define P3_FLUSH(dst_, ld_, col_) do { _Pragma("unroll") for (int i_ = 0; i_ < 4; ++i_) { const int row_ = frow + 8 * i_; \
        *(u32x4*)((dst_) + (unsigned)((t0w + row_) * (ld_) + (col_) + fch * 8)) = *(const u32x4*)(OBt + row_ * 144 + fch * 16); } } while (0)
      if (MODE & 1) {
      f32x16 acc[2];
#pragma unroll
      for (int mt = 0; mt < 2; ++mt)
#pragma unroll
        for (int r = 0; r < 16; ++r) acc[mt][r] = 0.f;
#pragma unroll
      for (int ks = 0; ks < 4; ++ks) {
        const bf16x8 bx = *(const bf16x8*)(xrow + ks * 32);
#pragma unroll
        for (int mt = 0; mt < 2; ++mt) { const bf16x8 aw = *(const bf16x8*)(ws_wdt(p) + (unsigned)(((h * 2 + mt) * 4 + ks) * 512 + (hi * 32 + r32) * 8)); acc[mt] = __builtin_amdgcn_mfma_f32_32x32x16_bf16(aw, bx, acc[mt], 0, 0, 0); }
      }
#pragma unroll
      for (int mt = 0; mt < 2; ++mt)
#pragma unroll
        for (int g = 0; g < 4; ++g) {
          const int ch = chb + 32 * mt + 8 * g;
          const f32x4 w0v = *(const f32x4*)(PL + ch);
          float e[4];
#pragma unroll
          for (int i = 0; i < 4; ++i) e[i] = 0.6065306597f / (1.0f + __expf(-(w0v[i] + acc[mt][4 * g + i])));
          *(u32x2*)(OBt + cwo + mt * 64 + g * 16) = pk4(e[0], e[1], e[2], e[3]);
        }
      P3_FLUSH(ws_ee(p), RW, h * HD);
      __builtin_amdgcn_sched_barrier(0);
#pragma unroll
      for (int mt = 0; mt < 2; ++mt)
#pragma unroll
        for (int r = 0; r < 16; ++r) acc[mt][r] = 0.f;
#pragma unroll
      for (int ks = 0; ks < 8; ++ks) {
        const bf16x8 bx = *(const bf16x8*)(xrow + 256 + ks * 32);
#pragma unroll
        for (int mt = 0; mt < 2; ++mt) { const bf16x8 aw = *(const bf16x8*)(ws_wgt(p) + (unsigned)(((h * 2 + mt) * 8 + ks) * 512 + (hi * 32 + r32) * 8)); acc[mt] = __builtin_amdgcn_mfma_f32_32x32x16_bf16(aw, bx, acc[mt], 0, 0, 0); }
      }
#pragma unroll
      for (int mt = 0; mt < 2; ++mt)
#pragma unroll
        for (int g = 0; g < 4; ++g)
          *(u32x2*)(OBt + cwo + mt * 64 + g * 16) =
              pk4(acc[mt][4 * g] + 0.0f, acc[mt][4 * g + 1] + 0.0f, acc[mt][4 * g + 2] + 0.0f, acc[mt][4 * g + 3] + 0.0f);
      P3_FLUSH(ws_gg(p), RW, h * HD);
      __builtin_amdgcn_sched_barrier(0);
#pragma unroll
      for (int mt = 0; mt < 2; ++mt)
#pragma unroll
        for (int r = 0; r < 16; ++r) acc[mt][r] = 0.f;
#pragma unroll
      for (int ks = 0; ks < 4; ++ks) {
        const bf16x8 bx = *(const bf16x8*)(xrow + 128 + ks * 32);
#pragma unroll
        for (int mt = 0; mt < 2; ++mt) { const bf16x8 aw = *(const bf16x8*)(ws_wat(p) + (unsigned)(((h * 2 + mt) * 4 + ks) * 512 + (hi * 32 + r32) * 8)); acc[mt] = __builtin_amdgcn_mfma_f32_32x32x16_bf16(aw, bx, acc[mt], 0, 0, 0); }
      }
      __builtin_amdgcn_sched_barrier(0);
#pragma unroll
      for (int i_ = 0; i_ < 5; ++i_) {
        const int row_ = frow + 8 * i_;
        if (row_ < 33) {
          int tk_ = t0w - 1 + row_; tk_ = tk_ < 0 ? 0 : tk_;
          *(u32x4*)(RBt + row_ * 144 + fch * 16) = *(const u32x4*)(proj + (unsigned)(tk_ * PROJ_LD + C_R + h * HD + fch * 8));
          *(u32x4*)(KBt + row_ * 144 + fch * 16) = *(const u32x4*)(proj + (unsigned)(tk_ * PROJ_LD + C_K + h * HD + fch * 8));
        }
      }
      float ss = 0.f, bs = 0.f; float av[2][16];
#pragma unroll
      for (int mt = 0; mt < 2; ++mt)
#pragma unroll
        for (int g = 0; g < 4; ++g) {
          const int ch = chb + 32 * mt + 8 * g;
          float rv[4], rp[4], kv[4], kq[4];
          ld4((const bf16_t*)(RBt + 144 + cwo + mt * 64 + g * 16), rv); ld4((const bf16_t*)(KBt + 144 + cwo + mt * 64 + g * 16), kv);
          ld4((const bf16_t*)(RBt + cwo + mt * 64 + g * 16), rp); ld4((const bf16_t*)(KBt + cwo + mt * 64 + g * 16), kq);
          const f32x4 mur = *(const f32x4*)(PL + 2560 + ch), muk = *(const f32x4*)(PL + 3072 + ch);
          const f32x4 a0v = *(const f32x4*)(PL + 512 + ch), kkc = *(const f32x4*)(PL + 1024 + ch), kac = *(const f32x4*)(PL + 1536 + ch), rkc = *(const f32x4*)(PL + 2048 + ch);
          float kp[4];
#pragma unroll
          for (int i = 0; i < 4; ++i) {
            const float a = 1.0f / (1.0f + __expf(-(a0v[i] + acc[mt][4 * g + i])));
            const float r = rv[i] + mur[i] * ((first ? 0.f : rp[i]) - rv[i]);
            const float k = kv[i] + muk[i] * ((first ? 0.f : kq[i]) - kv[i]);
            const float kk = k * kkc[i];
            ss += kk * kk;
            kp[i] = k * (1.0f + (a - 1.0f) * kac[i]);
            bs += r * kp[i] * rkc[i];
            av[mt][4 * g + i] = a;
          }
          *(u32x2*)(OBt + cwo + mt * 64 + g * 16) = pk4(kp[0], kp[1], kp[2], kp[3]);
        }
      P3_FLUSH(ws_kp(p), RW, h * HD);
      __builtin_amdgcn_sched_barrier(0);
      ss = xhalf_sum(ss); bs = xhalf_sum(bs);
      const float inv = 1.0f / fmaxf(sqrtf(ss), 1e-12f);
#pragma unroll
      for (int mt = 0; mt < 2; ++mt)
#pragma unroll
        for (int g = 0; g < 4; ++g) {
          const int ch = chb + 32 * mt + 8 * g;
          float kv[4], kq[4];
          ld4((const bf16_t*)(KBt + 144 + cwo + mt * 64 + g * 16), kv); ld4((const bf16_t*)(KBt + cwo + mt * 64 + g * 16), kq);
          const f32x4 muk = *(const f32x4*)(PL + 3072 + ch), kkc = *(const f32x4*)(PL + 1024 + ch);
          float kn[4];
#pragma unroll
          for (int i = 0; i < 4; ++i) { const float kprev = first ? 0.f : kq[i]; kn[i] = (kv[i] + muk[i] * (kprev - kv[i])) * kkc[i] * inv; }
          *(u32x2*)(OBt + cwo + mt * 64 + g * 16) = pk4(kn[0], kn[1], kn[2], kn[3]);
          *(u32x2*)(RBt + cwo + mt * 64 + g * 16) = pk4(kn[0] * av[mt][4 * g], kn[1] * av[mt][4 * g + 1], kn[2] * av[mt][4 * g + 2], kn[3] * av[mt][4 * g + 3]);
        }
      P3_FLUSH(ws_kk(p), RW, h * HD);
      { char* const OBs = OBt; OBt = RBt; P3_FLUSH(ws_bb(p), RW, h * HD); OBt = OBs; }
      if (hi == 0) ws_bonus(p)[gt * NH + h] = bs;
      }
#undef P3_FLUSH
    }
  }
}

DI void phase4a(const Params& p, int bid, int nb, char* lds) {
  const int t = tid_(), i = t >> 3, cg8 = (t & 7) * 8;
  const bf16_t* proj = ws_proj(p);
  for (int task = bid; task < BATCH * NH; task += nb) {
    const int b = task >> 3, h = task & 7;
    const int cbase = h * HD + cg8;
    float mu_r[8], st[8], rprev[8];
#pragma unroll
    for (int j = 0; j < 8; ++j) { mu_r[j] = p.shift_mu[C_R + cbase + j]; st[j] = 0.f; rprev[j] = 0.f; }
    const float mu_v = p.shift_mu[C_V + h * HD + i];
    float vprev = 0.f;
    const size_t tok0 = (size_t)b * SEQ;
    u32x4 n_kk, n_bb, n_kp, n_ee, n_r; bf16_t n_v;
    {
      const size_t g = tok0;
      n_kk = *(const u32x4*)(ws_kk(p) + g * RW + cbase); n_bb = *(const u32x4*)(ws_bb(p) + g * RW + cbase);
      n_kp = *(const u32x4*)(ws_kp(p) + g * RW + cbase); n_ee = *(const u32x4*)(ws_ee(p) + g * RW + cbase);
      n_r = *(const u32x4*)(proj + g * PROJ_LD + C_R + cbase); n_v = proj[g * PROJ_LD + C_V + h * HD + i];
    }
    for (int s = 0; s < SEQ; ++s) {
      const u32x4 c_kk = n_kk, c_bb = n_bb, c_kp = n_kp, c_ee = n_ee, c_r = n_r; const bf16_t c_v = n_v;
      if (s + 1 < SEQ) {
        const size_t g = tok0 + s + 1;
        n_kk = *(const u32x4*)(ws_kk(p) + g * RW + cbase); n_bb = *(const u32x4*)(ws_bb(p) + g * RW + cbase);
        n_kp = *(const u32x4*)(ws_kp(p) + g * RW + cbase); n_ee = *(const u32x4*)(ws_ee(p) + g * RW + cbase);
        n_r = *(const u32x4*)(proj + g * PROJ_LD + C_R + cbase); n_v = proj[g * PROJ_LD + C_V + h * HD + i];
      }
      float kk[8], bb[8], kp[8], ee[8], rr[8];
      unpack8(c_kk, kk); unpack8(c_bb, bb); unpack8(c_kp, kp); unpack8(c_ee, ee); unpack8(c_r, rr);
      const float vraw = bf2f(c_v);
      const float v = vraw + mu_v * (vprev - vraw); vprev = vraw;
      float sa = 0.f;
#pragma unroll
      for (int j = 0; j < 8; ++j) sa += st[j] * kk[j];
      sa += __shfl_xor(sa, 1); sa += __shfl_xor(sa, 2); sa += __shfl_xor(sa, 4);
      sa = -sa;
      float y = 0.f;
#pragma unroll
      for (int j = 0; j < 8; ++j) {
        const float r = rr[j] + mu_r[j] * (rprev[j] - rr[j]); rprev[j] = rr[j];
        const float w = __expf(-ee[j]);
        st[j] = st[j] * w + sa * bb[j] + v * kp[j];
        y += st[j] * r;
      }
      y += __shfl_xor(y, 1); y += __shfl_xor(y, 2); y += __shfl_xor(y, 4);
      if ((t & 7) == 0) ws_y(p)[(tok0 + s) * RW + h * HD + i] = y;
    }
  }
}

DI float dpp_sum16(float v) {
  v += __int_as_float(__builtin_amdgcn_update_dpp(0, __float_as_int(v), 0xB1, 0xF, 0xF, true));
  v += __int_as_float(__builtin_amdgcn_update_dpp(0, __float_as_int(v), 0x4E, 0xF, 0xF, true));
  v += __int_as_float(__builtin_amdgcn_update_dpp(0, __float_as_int(v), 0x141, 0xF, 0xF, true));
  v += __int_as_float(__builtin_amdgcn_update_dpp(0, __float_as_int(v), 0x140, 0xF, 0xF, true));
  return v;
}
constexpr int CK = 16;
constexpr int SC_CH = 16, SC_BUF = 5 * SC_CH * 64 * 4 + SC_CH * 32 * 4 + SC_CH * 8;
DI void phase4a_v2(const Params& p, int bid, int nb, char* lds) {
  const int t = tid_(), rowl = t >> 4, cg = t & 15;
  const bf16_t* proj = ws_proj(p);
  for (int task = bid; task < BATCH * NH * 2; task += nb) {
    const int b = task >> 4, h = (task >> 1) & 7, half = task & 1;
    const size_t tok0 = (size_t)b * SEQ;
    const int sst = t >> 4, scol = h * HD + cg * 4;
    const int vst = t >> 5, vrow = t & 31, vcol = C_V + h * HD + half * 32 + vrow;
    float mur[4];
#pragma unroll
    for (int j = 0; j < 4; ++j) mur[j] = p.shift_mu[C_R + scol + j];
    const float muv = p.shift_mu[vcol];
    u32x2 g_kk, g_bb, g_kp, g_ee, g_r, g_rp; bf16_t g_v, g_vp;
    auto stage_load = [&](int c) {
      if (t < 256) {
        const size_t g = tok0 + c * SC_CH + sst;
        g_kk = *(const u32x2*)(ws_kk(p) + g * RW + scol); g_bb = *(const u32x2*)(ws_bb(p) + g * RW + scol);
        g_kp = *(const u32x2*)(ws_kp(p) + g * RW + scol); g_ee = *(const u32x2*)(ws_ee(p) + g * RW + scol);
        g_r = *(const u32x2*)(proj + g * PROJ_LD + C_R + scol);
        if (c * SC_CH + sst > 0) g_rp = *(const u32x2*)(proj + (g - 1) * PROJ_LD + C_R + scol); else { g_rp.x = 0u; g_rp.y = 0u; }
      }
      const size_t gv = tok0 + c * SC_CH + vst;
      g_v = proj[gv * PROJ_LD + vcol];
      g_vp = (c * SC_CH + vst > 0) ? proj[(gv - 1) * PROJ_LD + vcol] : (bf16_t)0;
    };
    auto stage_write = [&](char* buf) {
      if (t < 256) {
        float* W = (float*)buf + sst * 64 + cg * 4;
        f32x4 o;
        o[0] = __expf(-__uint_as_float(g_ee.x << 16)); o[1] = __expf(-__uint_as_float(g_ee.x & 0xffff0000u));
        o[2] = __expf(-__uint_as_float(g_ee.y << 16)); o[3] = __expf(-__uint_as_float(g_ee.y & 0xffff0000u));
        *(f32x4*)W = o;
        o[0] = __uint_as_float(g_kk.x << 16); o[1] = __uint_as_float(g_kk.x & 0xffff0000u); o[2] = __uint_as_float(g_kk.y << 16); o[3] = __uint_as_float(g_kk.y & 0xffff0000u);
        *(f32x4*)(W + SC_CH * 64) = o;
        o[0] = __uint_as_float(g_bb.x << 16); o[1] = __uint_as_float(g_bb.x & 0xffff0000u); o[2] = __uint_as_float(g_bb.y << 16); o[3] = __uint_as_float(g_bb.y & 0xffff0000u);
        *(f32x4*)(W + 2 * SC_CH * 64) = o;
        o[0] = __uint_as_float(g_kp.x << 16); o[1] = __uint_as_float(g_kp.x & 0xffff0000u); o[2] = __uint_as_float(g_kp.y << 16); o[3] = __uint_as_float(g_kp.y & 0xffff0000u);
        *(f32x4*)(W + 3 * SC_CH * 64) = o;
        float r[4] = {__uint_as_float(g_r.x << 16), __uint_as_float(g_r.x & 0xffff0000u), __uint_as_float(g_r.y << 16), __uint_as_float(g_r.y & 0xffff0000u)};
        float rp[4] = {__uint_as_float(g_rp.x << 16), __uint_as_float(g_rp.x & 0xffff0000u), __uint_as_float(g_rp.y << 16), __uint_as_float(g_rp.y & 0xffff0000u)};
#pragma unroll
        for (int j = 0; j < 4; ++j) o[j] = r[j] + mur[j] * (rp[j] - r[j]);
        *(f32x4*)(W + 4 * SC_CH * 64) = o;
      }
      const float v = bf2f(g_v), vp = bf2f(g_vp);
      ((float*)buf)[5 * SC_CH * 64 + vst * 32 + vrow] = v + muv * (vp - v);
    };
    float st[4] = {0.f, 0.f, 0.f, 0.f};
    __syncthreads();
    stage_load(0); stage_write(lds);
    __syncthreads();
    float* yout = ws_y(p) + tok0 * RW + h * HD + half * 32 + rowl;
    for (int c = 0; c < SEQ / SC_CH; ++c) {
      const char* cur = lds + (c & 1) * SC_BUF;
      if (c + 1 < SEQ / SC_CH) stage_load(c + 1);
      const float* Wb = (const float*)cur + cg * 4;
      const float* Vb = (const float*)cur + 5 * SC_CH * 64 + rowl;
      float yv[SC_CH];
#pragma unroll
      for (int s = 0; s < SC_CH; ++s) {
        const f32x4 w = *(const f32x4*)(Wb + s * 64), kk = *(const f32x4*)(Wb + SC_CH * 64 + s * 64), bb = *(const f32x4*)(Wb + 2 * SC_CH * 64 + s * 64);
        const f32x4 kp = *(const f32x4*)(Wb + 3 * SC_CH * 64 + s * 64), rr = *(const f32x4*)(Wb + 4 * SC_CH * 64 + s * 64);
        const float v = Vb[s * 32];
        float sa = (st[0] * kk[0] + st[1] * kk[1]) + (st[2] * kk[2] + st[3] * kk[3]);
        sa = -dpp_sum16(sa);
#pragma unroll
        for (int j = 0; j < 4; ++j) st[j] = st[j] * w[j] + (sa * bb[j] + v * kp[j]);
        float y = (st[0] * rr[0] + st[1] * rr[1]) + (st[2] * rr[2] + st[3] * rr[3]);
        yv[s] = dpp_sum16(y);
      }
      if (cg == 0) {
#pragma unroll
        for (int s = 0; s < SC_CH; ++s) yout[(size_t)(c * SC_CH + s) * RW] = yv[s];
      }
      if (c + 1 < SEQ / SC_CH) stage_write(lds + ((c + 1) & 1) * SC_BUF);
      __syncthreads();
    }
  }
}

DI void moe_tr_wave(const Params& p, int id, int lane, float* tl  ) {
  const int which = id >> 12, q = id & 4095, e = q >> 7, r = q & 127;
  const float* src; int N, k0, n0;
  if (which < 2) { src = (which == 0 ? p.e_gate : p.e_up) + (size_t)e * 1024 * 512; N = 512; k0 = (r >> 3) * 64; n0 = (r & 7) * 64; }
  else { src = p.e_down + (size_t)e * 512 * 1024; N = 1024; k0 = (r >> 4) * 64; n0 = (r & 15) * 64; }
  const int lr = lane >> 4, lc = (lane & 15) * 4;
  f32x4 g[16];
#pragma unroll
  for (int i = 0; i < 16; ++i) g[i] = *(const f32x4*)(src + (size_t)(k0 + lr + 4 * i) * N + n0 + lc);
#pragma unroll
  for (int i = 0; i < 16; ++i) { float* d = tl + (lr + 4 * i) * 65 + lc; d[0] = g[i][0]; d[1] = g[i][1]; d[2] = g[i][2]; d[3] = g[i][3]; }
  bf16_t* dst;
  { const int n = n0 + lane;
    if (which < 2) dst = ws_wgu(p) + (size_t)e * 1024 * 1024 + (size_t)((n >> 7) * 256 + (n & 127) + which * 128) * 1024 + k0;
    else dst = ws_wd(p) + (size_t)e * 1024 * 512 + (size_t)n * 512 + k0; }
#pragma unroll
  for (int c8 = 0; c8 < 8; ++c8) {
    float v[8];
#pragma unroll
    for (int j = 0; j < 8; ++j) v[j] = tl[(c8 * 8 + j) * 65 + lane];
    u32x4 w; w.x = cvtpk(v[0], v[1]); w.y = cvtpk(v[2], v[3]); w.z = cvtpk(v[4], v[5]); w.w = cvtpk(v[6], v[7]);
    *(u32x4*)(dst + c8 * 8) = w;
  }
}

typedef float f32x2p __attribute__((ext_vector_type(2)));
DI void phase4a_v3(const Params& p, int bid, int nb, char* lds) {
  const int t = tid_(), wid = __builtin_amdgcn_readfirstlane(t >> 6);
  const int rowl = (t >> 3) & 31, cg = t & 7;
  const int pt = t & 255;
  const bf16_t* proj = ws_proj(p);
  for (int task = bid; task < BATCH * NH * 2; task += nb) {
    const int b = task >> 4, h = (task >> 1) & 7, half = task & 1;
    const size_t tok0 = (size_t)b * SEQ;
    const int sst = pt >> 4, scq = pt & 15, scol = h * HD + scq * 4;
    const int vst = pt >> 5, vrow = pt & 31, vcol = C_V + h * HD + half * 32 + vrow;
    float mur[4];
#pragma unroll
    for (int j = 0; j < 4; ++j) mur[j] = p.shift_mu[C_R + scol + j];
    const float muv = p.shift_mu[vcol];
    u32x2 g_kk, g_bb, g_kp, g_ee, g_r, g_rp; bf16_t g_v0, g_v0p, g_v1, g_v1p;
#define SC_LOAD(c_) do { const int c__ = (c_); const size_t g = tok0 + c__ * SC_CH + sst; \
      g_kk = *(const u32x2*)(ws_kk(p) + g * RW + scol); g_bb = *(const u32x2*)(ws_bb(p) + g * RW + scol); \
      g_kp = *(const u32x2*)(ws_kp(p) + g * RW + scol); g_ee = *(const u32x2*)(ws_ee(p) + g * RW + scol); \
      g_r = *(const u32x2*)(proj + g * PROJ_LD + C_R + scol); \
      g_rp = *(const u32x2*)(proj + (g - ((c__ * SC_CH + sst > 0) ? 1 : 0)) * PROJ_LD + C_R + scol); \
      if (c__ * SC_CH + sst == 0) { g_rp.x = 0u; g_rp.y = 0u; } \
      const size_t gv = tok0 + c__ * SC_CH + vst; \
      g_v0 = proj[gv * PROJ_LD + vcol]; g_v0p = (c__ * SC_CH + vst > 0) ? proj[(gv - 1) * PROJ_LD + vcol] : (bf16_t)0; \
      g_v1 = proj[(gv + 8) * PROJ_LD + vcol]; g_v1p = proj[(gv + 7) * PROJ_LD + vcol]; } while (0)
#define SC_WRITE(buf_) do { float* W = (float*)(buf_) + sst * 64 + scq * 4; f32x4 o; \
      o[0] = __expf(-__uint_as_float(g_ee.x << 16)); o[1] = __expf(-__uint_as_float(g_ee.x & 0xffff0000u)); \
      o[2] = __expf(-__uint_as_float(g_ee.y << 16)); o[3] = __expf(-__uint_as_float(g_ee.y & 0xffff0000u)); *(f32x4*)W = o; \
      o[0] = __uint_as_float(g_kk.x << 16); o[1] = __uint_as_float(g_kk.x & 0xffff0000u); o[2] = __uint_as_float(g_kk.y << 16); o[3] = __uint_as_float(g_kk.y & 0xffff0000u); *(f32x4*)(W + SC_CH * 64) = o; \
      o[0] = __uint_as_float(g_bb.x << 16); o[1] = __uint_as_float(g_bb.x & 0xffff0000u); o[2] = __uint_as_float(g_bb.y << 16); o[3] = __uint_as_float(g_bb.y & 0xffff0000u); *(f32x4*)(W + 2 * SC_CH * 64) = o; \
      o[0] = __uint_as_float(g_kp.x << 16); o[1] = __uint_as_float(g_kp.x & 0xffff0000u); o[2] = __uint_as_float(g_kp.y << 16); o[3] = __uint_as_float(g_kp.y & 0xffff0000u); *(f32x4*)(W + 3 * SC_CH * 64) = o; \
      { const float r0 = __uint_as_float(g_r.x << 16), r1 = __uint_as_float(g_r.x & 0xffff0000u), r2 = __uint_as_float(g_r.y << 16), r3 = __uint_as_float(g_r.y & 0xffff0000u); \
        const float q0 = __uint_as_float(g_rp.x << 16), q1 = __uint_as_float(g_rp.x & 0xffff0000u), q2 = __uint_as_float(g_rp.y << 16), q3 = __uint_as_float(g_rp.y & 0xffff0000u); \
        o[0] = r0 + mur[0] * (q0 - r0); o[1] = r1 + mur[1] * (q1 - r1); o[2] = r2 + mur[2] * (q2 - r2); o[3] = r3 + mur[3] * (q3 - r3); \
        const f32x4 wv_ = *(const f32x4*)W, bv_ = *(const f32x4*)(W + 2 * SC_CH * 64), kv_ = *(const f32x4*)(W + 3 * SC_CH * 64); \
        const float br_ = dpp_sum16((bv_[0] * o[0] + bv_[1] * o[1]) + (bv_[2] * o[2] + bv_[3] * o[3])), kr_ = dpp_sum16((kv_[0] * o[0] + kv_[1] * o[1]) + (kv_[2] * o[2] + kv_[3] * o[3])); \
        if (scq == 0) { float* X_ = (float*)(buf_) + 5 * SC_CH * 64 + SC_CH * 32 + sst * 2; X_[0] = br_; X_[1] = kr_; } \
        o[0] *= wv_[0]; o[1] *= wv_[1]; o[2] *= wv_[2]; o[3] *= wv_[3]; *(f32x4*)(W + 4 * SC_CH * 64) = o; } \
      { const float v0 = bf2f(g_v0), v0p = bf2f(g_v0p), v1 = bf2f(g_v1), v1p = bf2f(g_v1p); float* Vw = (float*)(buf_) + 5 * SC_CH * 64 + vst * 32 + vrow; \
        Vw[0] = v0 + muv * (v0p - v0); Vw[8 * 32] = v1 + muv * (v1p - v1); } } while (0)
    f32x2p st2[4];
#pragma unroll
    for (int j = 0; j < 4; ++j) st2[j] = (f32x2p){0.f, 0.f};
    __syncthreads();
    if (wid >= 4) { SC_LOAD(0); SC_WRITE(lds); SC_LOAD(1); }
    __syncthreads();
    float* yout = ws_y(p) + tok0 * RW + h * HD + half * 32 + rowl;
    for (int c = 0; c < SEQ / SC_CH; ++c) {
      const char* cur = lds + (c & 1) * SC_BUF;
      if (wid >= 4) {
        if (c + 1 < SEQ / SC_CH) SC_WRITE(lds + ((c + 1) & 1) * SC_BUF);
        if (c + 2 < SEQ / SC_CH) SC_LOAD(c + 2);
        if ((c & 7) == 3) {
          const int tid_tr = (task * 4 + (wid - 4)) + (BATCH * NH * 2 * 4) * (c >> 3);
          if (tid_tr < 3 * 4096) moe_tr_wave(p, tid_tr, t & 63, (float*)(lds + 2 * SC_BUF + 128) + (wid - 4) * (64 * 65));
        }
      } else {
        const float* Wb = (const float*)cur + cg * 8;
        const float* Vb = (const float*)cur + 5 * SC_CH * 64 + rowl;
        float yv[SC_CH];
#pragma unroll
        for (int s = 0; s < SC_CH; ++s) {
          const f32x4 w0 = *(const f32x4*)(Wb + s * 64), w1 = *(const f32x4*)(Wb + s * 64 + 4);
          const f32x4 k0 = *(const f32x4*)(Wb + SC_CH * 64 + s * 64), k1 = *(const f32x4*)(Wb + SC_CH * 64 + s * 64 + 4);
          const f32x4 b0 = *(const f32x4*)(Wb + 2 * SC_CH * 64 + s * 64), b1 = *(const f32x4*)(Wb + 2 * SC_CH * 64 + s * 64 + 4);
          const f32x4 p0 = *(const f32x4*)(Wb + 3 * SC_CH * 64 + s * 64), p1 = *(const f32x4*)(Wb + 3 * SC_CH * 64 + s * 64 + 4);
          const f32x4 r0 = *(const f32x4*)(Wb + 4 * SC_CH * 64 + s * 64), r1 = *(const f32x4*)(Wb + 4 * SC_CH * 64 + s * 64 + 4);
          const float v = Vb[s * 32];
#define LO2(x) __builtin_shufflevector(x, x, 0, 1)
#define HI2(x) __builtin_shufflevector(x, x, 2, 3)
          const f32x2p xs = *(const f32x2p*)((const float*)cur + 5 * SC_CH * 64 + SC_CH * 32 + s * 2);
          f32x2p sa2 = st2[0] * LO2(k0), yd2 = st2[0] * LO2(r0);
          sa2 = st2[1] * HI2(k0) + sa2; yd2 = st2[1] * HI2(r0) + yd2;
          sa2 = st2[2] * LO2(k1) + sa2; yd2 = st2[2] * LO2(r1) + yd2;
          sa2 = st2[3] * HI2(k1) + sa2; yd2 = st2[3] * HI2(r1) + yd2;
          const float sa = -dpp_sum8(sa2[0] + sa2[1]);
          const float yd = dpp_sum8(yd2[0] + yd2[1]);
          yv[s] = yd + sa * xs[0] + v * xs[1];
          const f32x2p sav = {sa, sa}, vv = {v, v};
          st2[0] = st2[0] * LO2(w0) + (sav * LO2(b0) + vv * LO2(p0));
          st2[1] = st2[1] * HI2(w0) + (sav * HI2(b0) + vv * HI2(p0));
          st2[2] = st2[2] * LO2(w1) + (sav * LO2(b1) + vv * LO2(p1));
          st2[3] = st2[3] * HI2(w1) + (sav * HI2(b1) + vv * HI2(p1));
#undef LO2
#undef HI2
        }
        if (cg == 0) {
#pragma unroll
          for (int s = 0; s < SC_CH; ++s) yout[(size_t)(c * SC_CH + s) * RW] = yv[s];
        }
      }
      __syncthreads();
    }
#undef SC_LOAD
#undef SC_WRITE
  }
}

DI void moe_tr_small(const Params& p, int id, int lane, float* tl  ) {
  const int which = id >> 14, r_ = id & 16383, e = r_ >> 9, rr = r_ & 511;
  const float* src; int N, k0, n0;
  if (which < 2) { src = (which == 0 ? p.e_gate : p.e_up) + (size_t)e * 1024 * 512; N = 512; k0 = (rr >> 5) * 64; n0 = (rr & 31) * 16; }
  else { src = p.e_down + (size_t)e * 512 * 1024; N = 1024; k0 = (rr >> 6) * 64; n0 = (rr & 63) * 16; }
  const float* sp = src + (size_t)(k0 + lane) * N + n0;
  const f32x4 g0 = *(const f32x4*)sp, g1 = *(const f32x4*)(sp + 4), g2 = *(const f32x4*)(sp + 8), g3 = *(const f32x4*)(sp + 12);
  float* d = tl + lane * 17;
  d[0] = g0[0]; d[1] = g0[1]; d[2] = g0[2]; d[3] = g0[3]; d[4] = g1[0]; d[5] = g1[1]; d[6] = g1[2]; d[7] = g1[3];
  d[8] = g2[0]; d[9] = g2[1]; d[10] = g2[2]; d[11] = g2[3]; d[12] = g3[0]; d[13] = g3[1]; d[14] = g3[2]; d[15] = g3[3];
  const int nn = lane & 15, kq = lane >> 4;
  float v[16];
#pragma unroll
  for (int i = 0; i < 16; ++i) v[i] = tl[(kq * 16 + i) * 17 + nn];
  u32x4 w0, w1;
  w0.x = cvtpk(v[0], v[1]); w0.y = cvtpk(v[2], v[3]); w0.z = cvtpk(v[4], v[5]); w0.w = cvtpk(v[6], v[7]);
  w1.x = cvtpk(v[8], v[9]); w1.y = cvtpk(v[10], v[11]); w1.z = cvtpk(v[12], v[13]); w1.w = cvtpk(v[14], v[15]);
  const int n = n0 + nn;
  bf16_t* dst;
  if (which < 2) dst = ws_wgu(p) + (size_t)e * 1024 * 1024 + (size_t)((n >> 7) * 256 + (n & 127) + which * 128) * 1024 + k0 + kq * 16;
  else dst = ws_wd(p) + (size_t)e * 1024 * 512 + (size_t)n * 512 + k0 + kq * 16;
  *(u32x4*)dst = w0; *(u32x4*)(dst + 8) = w1;
}

constexpr int CS_PSZ = 23552, CS_SLSZ = 13312, CS_SL0 = 4 * CS_PSZ, CS_CON = CS_SL0 + 4 * CS_SLSZ;
DI f32x4v cs_mm16(const float* A, int sam, int sak, const float* B, int sbk, int sbn, f32x4v c, int l16, int g) {
#pragma unroll
  for (int q = 0; q < 4; ++q) c = __builtin_amdgcn_mfma_f32_16x16x4f32(A[l16 * sam + (4 * q + g) * sak], B[(4 * q + g) * sbk + l16 * sbn], c, 0, 0, 0);
  return c;
}
DI void cs_st16(float* D, f32x4v c, int l16, int g) {
#pragma unroll
  for (int r = 0; r < 4; ++r) D[(4 * g + r) * 16 + l16] = c[r];
}
DI f32x4v cs_ld16(const float* D, int l16, int g) { f32x4v c;
#pragma unroll
  for (int r = 0; r < 4; ++r) c[r] = D[(4 * g + r) * 16 + l16];
  return c; }
DI void cs_st4(bf16_t* base, int ld, f32x4v c) {
  const unsigned p01 = cvtpk(c[0] + 0.0f, c[1] + 0.0f), p23 = cvtpk(c[2] + 0.0f, c[3] + 0.0f);
  base[0] = (bf16_t)p01; base[ld] = (bf16_t)(p01 >> 16); base[2 * ld] = (bf16_t)p23; base[3 * ld] = (bf16_t)(p23 >> 16);
}
constexpr int CS_FLG = CS_CON + 6144 + 2 * 64 * 17 * 4;
DI void cs_wait(volatile int* f, int v) {
  while (__builtin_amdgcn_readfirstlane(*f) < v) __builtin_amdgcn_s_sleep(2);
  __builtin_amdgcn_fence(__ATOMIC_ACQUIRE, "workgroup");
}
DI void cs_post(volatile int* f, int v, int lane) {
  __builtin_amdgcn_fence(__ATOMIC_RELEASE, "workgroup");
  if (lane == 0) *f = v;
}
static_assert(CS_FLG + 48 <= LDS_BYTES - 64, "chunked scan LDS map");
#define CS_LAS __attribute__((address_space(3)))
DI void phase4a_chunk(const Params& p, int bid, int nb, char* lds) {
  const int t = tid_(), wid = __builtin_amdgcn_readfirstlane(t >> 6), lane = t & 63, l16 = lane & 15, g = lane >> 4;
  const bf16_t* proj = ws_proj(p);
  const f32x4v z4 = {0.f, 0.f, 0.f, 0.f};
  const bf16x8 zf = {0, 0, 0, 0, 0, 0, 0, 0};
  volatile int* fl_ready = (volatile int*)(lds + CS_FLG); volatile int* fl_done = fl_ready + 4;
  if (t < 12) fl_ready[t] = 0;
  int seq0 = 0;
  for (int task = bid; task < BATCH * NH * 2; task += nb, seq0 += SEQ / CK / 4) {
    const int b = task >> 4, h = (task >> 1) & 7, half = task & 1;
    const int tok0 = b * SEQ;
    f32x4v Sacc[4] = {z4, z4, z4, z4};
    char* Sb = lds + CS_CON; char* Ub = Sb + 4608;
    const int i0 = (wid & 1) * 16;
    __syncthreads();
    if (wid < 2) { for (int i = lane; i < 16 * 144 / 4; i += 64) ((unsigned*)(Sb + i0 * 144))[i] = 0u; }
    u32x4 pf[10]; bf16_t pf_rp = 0, pf_v[9];
#define CS_PF(cc) do { const int ct_ = tok0 + (cc) * CK; \
      const unsigned ro_ = (unsigned)((ct_ + (lane >> 3)) * RW + h * HD + (lane & 7) * 8) * 2u; \
      const unsigned rp_ = (unsigned)((ct_ + (lane >> 3)) * PROJ_LD + C_R + h * HD + (lane & 7) * 8) * 2u; \
      pf[0] = *(const u32x4*)((const char*)ws_ee(p) + ro_); pf[1] = *(const u32x4*)((const char*)ws_ee(p) + ro_ + 8 * RW * 2); \
      pf[2] = *(const u32x4*)((const char*)ws_kk(p) + ro_); pf[3] = *(const u32x4*)((const char*)ws_kk(p) + ro_ + 8 * RW * 2); \
      pf[4] = *(const u32x4*)((const char*)ws_bb(p) + ro_); pf[5] = *(const u32x4*)((const char*)ws_bb(p) + ro_ + 8 * RW * 2); \
      pf[6] = *(const u32x4*)((const char*)ws_kp(p) + ro_); pf[7] = *(const u32x4*)((const char*)ws_kp(p) + ro_ + 8 * RW * 2); \
      pf[8] = *(const u32x4*)((const char*)proj + rp_); pf[9] = *(const u32x4*)((const char*)proj + rp_ + 8 * PROJ_LD * 2); \
      { const int tp_ = (ct_ - 1 < tok0) ? tok0 : ct_ - 1; pf_rp = proj[(unsigned)(tp_ * PROJ_LD + C_R + h * HD + lane)]; } \
      _Pragma("unroll") for (int q_ = 0; q_ < 9; ++q_) { int tv_ = ct_ + (lane >> 5) * 8 + q_ - 1; tv_ = (tv_ < tok0) ? tok0 : tv_; \
        pf_v[q_] = proj[(unsigned)(tv_ * PROJ_LD + C_V + h * HD + half * 32 + (lane & 31))]; } } while (0)
    if (wid >= 4) CS_PF(wid - 4);
    const float mur = p.shift_mu[C_R + h * HD + lane], muv = p.shift_mu[C_V + h * HD + half * 32 + (lane & 31)];
    if (wid < 2) __builtin_amdgcn_s_setprio(3);
    for (int rnd = 0; rnd < SEQ / CK / 4; ++rnd) {
      if (wid >= 4) {
        const int pw = wid - 4, c = rnd * 4 + pw, ct0 = tok0 + c * CK;
        char* ps = lds + pw * CS_PSZ;
        bf16_t* AB = (bf16_t*)ps; bf16_t* BT = AB + 16 * 72; bf16_t* KT = BT + 16 * 72; bf16_t* RB = KT + 16 * 72;
        float* KHT = (float*)(ps + 9216);
        float* Nf = (float*)(ps + 13312); float* AKB = Nf + 256; float* ABR = AKB + 256; float* AKR = ABR + 256;
        float* T0 = AKR + 256; float* T1 = Nf; float* Pm = T0 + 256; float* Mm = Pm + 256;
        bf16_t* ABT = (bf16_t*)(Mm + 256);
        bf16_t* APb = (bf16_t*)BT;
        bf16_t* MTb = (bf16_t*)KT;
        bf16_t* W1b = MTb + 16 * 24;
        bf16_t* ABRT = W1b + 16 * 24;
        char* sl = lds + CS_SL0 + pw * CS_SLSZ;
        bf16_t* QT = (bf16_t*)sl; bf16_t* APT = QT + 16 * 72; bf16_t* BHT = APT + 16 * 72; bf16_t* GGT = BHT + 64 * 24; bf16_t* HT = GGT + 64 * 24; bf16_t* VT = HT + 16 * 24;
        float* GAM = (float*)(sl + 2304 * 2 + 3072 * 2 + 768 + 1536);
        u32x4 bhw0, bhw1, vw; float gamC;
        {
          const int j = lane, col = h * HD + j;
          float cum[CK];
          {
            char* rawl = ps + 13312 + lane * 16;
#pragma unroll
            for (int i = 0; i < 10; ++i) *(u32x4*)(rawl + i * 1024) = pf[i];
          }
          float rprev = (c * CK > 0) ? bf2f(pf_rp) : 0.f;
          {
            const int vi = lane & 31, sh = lane >> 5, vcol = C_V + h * HD + half * 32 + vi;
            float vprev = (c * CK + sh * 8 > 0) ? bf2f(pf_v[0]) : 0.f;
            float vv[8];
#pragma unroll
            for (int q = 0; q < 8; ++q) { const float vr = bf2f(pf_v[q + 1]); vv[q] = vr + muv * (vprev - vr); vprev = vr; }
            vw.x = cvtpk(vv[0], vv[1]); vw.y = cvtpk(vv[2], vv[3]); vw.z = cvtpk(vv[4], vv[5]); vw.w = cvtpk(vv[6], vv[7]);
          }
          if (rnd + 1 < SEQ / CK / 4) CS_PF(c + 4);
          const bf16_t* RAW = (const bf16_t*)(ps + 13312);
          float run = 0.f;
#pragma unroll
          for (int tt = 0; tt < CK; ++tt) { run += bf2f(RAW[tt * 64 + j]); cum[tt] = run; }
          gamC = __expf(-run);
          float bhv[CK], abv[CK];
          float gprev = 1.0f;
#pragma unroll
          for (int tt = 0; tt < CK; tt += 2) {
            float bt2[2], kt2[2], rb2[2];
#pragma unroll
            for (int u = 0; u < 2; ++u) { const int t_ = tt + u;
              const float kkr = bf2f(RAW[1024 + t_ * 64 + j]), ber = bf2f(RAW[2048 + t_ * 64 + j]), kpr = bf2f(RAW[3072 + t_ * 64 + j]), rr = bf2f(RAW[4096 + t_ * 64 + j]);
              const float rsh = rr + mur * (rprev - rr); rprev = rr;
              const float gt_ = __expf(-cum[t_]), gin = __builtin_amdgcn_rcpf(gt_), gh = gamC * gin;
              abv[t_] = -gprev * kkr; gprev = gt_;
              bt2[u] = ber * gin; kt2[u] = kpr * gin; rb2[u] = gt_ * rsh; bhv[t_] = ber * gh;
              KHT[j * 16 + t_] = kpr * gh; }
            const unsigned pa = cvtpk(abv[tt], abv[tt + 1]), pb = cvtpk(bt2[0], bt2[1]), pk = cvtpk(kt2[0], kt2[1]), pr = cvtpk(rb2[0], rb2[1]);
            AB[tt * 72 + j] = (bf16_t)pa; AB[(tt + 1) * 72 + j] = (bf16_t)(pa >> 16);
            BT[tt * 72 + j] = (bf16_t)pb; BT[(tt + 1) * 72 + j] = (bf16_t)(pb >> 16);
            KT[tt * 72 + j] = (bf16_t)pk; KT[(tt + 1) * 72 + j] = (bf16_t)(pk >> 16);
            RB[tt * 72 + j] = (bf16_t)pr; RB[(tt + 1) * 72 + j] = (bf16_t)(pr >> 16);
          }
          u32x4 bh0, bh1;
          bhw0.x = cvtpk(bhv[0], bhv[1]); bhw0.y = cvtpk(bhv[2], bhv[3]); bhw0.z = cvtpk(bhv[4], bhv[5]); bhw0.w = cvtpk(bhv[6], bhv[7]);
          bhw1.x = cvtpk(bhv[8], bhv[9]); bhw1.y = cvtpk(bhv[10], bhv[11]); bhw1.z = cvtpk(bhv[12], bhv[13]); bhw1.w = cvtpk(bhv[14], bhv[15]);
          bh0.x = cvtpk(abv[0], abv[1]); bh0.y = cvtpk(abv[2], abv[3]); bh0.z = cvtpk(abv[4], abv[5]); bh0.w = cvtpk(abv[6], abv[7]);
          bh1.x = cvtpk(abv[8], abv[9]); bh1.y = cvtpk(abv[10], abv[11]); bh1.z = cvtpk(abv[12], abv[13]); bh1.w = cvtpk(abv[14], abv[15]);
          *(u32x4*)(ABT + j * 24) = bh0; *(u32x4*)(ABT + j * 24 + 8) = bh1;
        }
        {
          bf16x8 fb[2], fk[2], fa[2], fr[2];
#pragma unroll
          for (int ks = 0; ks < 2; ++ks) { const int off = l16 * 72 + 8 * g + 32 * ks;
            fb[ks] = *(const bf16x8*)(BT + off); fk[ks] = *(const bf16x8*)(KT + off); fa[ks] = *(const bf16x8*)(AB + off); fr[ks] = *(const bf16x8*)(RB + off); }
          f32x4v n_ = z4, akb = z4, abr = z4, akr = z4;
#pragma unroll
          for (int ks = 0; ks < 2; ++ks) {
            n_ = __builtin_amdgcn_mfma_f32_16x16x32_bf16(fb[ks], fa[ks], n_, 0, 0, 0);
            akb = __builtin_amdgcn_mfma_f32_16x16x32_bf16(fk[ks], fa[ks], akb, 0, 0, 0);
            abr = __builtin_amdgcn_mfma_f32_16x16x32_bf16(fb[ks], fr[ks], abr, 0, 0, 0);
            akr = __builtin_amdgcn_mfma_f32_16x16x32_bf16(fk[ks], fr[ks], akr, 0, 0, 0);
          }
#pragma unroll
          for (int r = 0; r < 4; ++r) { const int s_ = 4 * g + r, t_ = l16;
            Nf[s_ * 16 + t_] = (s_ < t_) ? n_[r] : 0.f; AKB[s_ * 16 + t_] = (s_ < t_) ? akb[r] : 0.f;
            ABR[s_ * 16 + t_] = (s_ <= t_) ? abr[r] : 0.f; AKR[s_ * 16 + t_] = (s_ <= t_) ? akr[r] : 0.f;
            Pm[s_ * 16 + t_] = ((s_ < t_) ? n_[r] : 0.f) + ((s_ == t_) ? 1.0f : 0.f); }
          { const int t_ = l16; float a4[4];
#pragma unroll
            for (int r = 0; r < 4; ++r) a4[r] = (4 * g + r <= t_) ? abr[r] : 0.f;
            *(u32x2*)(ABRT + t_ * 24 + 4 * g) = pk4(a4[0], a4[1], a4[2], a4[3]); }
        }
        {
          f32x4v c_;
          c_ = cs_mm16(Nf, 16, 1, Nf, 16, 1, z4, l16, g); cs_st16(T0, c_, l16, g);
          c_ = cs_mm16(Pm, 16, 1, T0, 16, 1, cs_ld16(Pm, l16, g), l16, g); cs_st16(Pm, c_, l16, g);
          c_ = cs_mm16(T0, 16, 1, T0, 16, 1, z4, l16, g); cs_st16(T1, c_, l16, g);
          c_ = cs_mm16(Pm, 16, 1, T1, 16, 1, cs_ld16(Pm, l16, g), l16, g); cs_st16(Pm, c_, l16, g);
          c_ = cs_mm16(T1, 16, 1, T1, 16, 1, z4, l16, g); cs_st16(T0, c_, l16, g);
          c_ = cs_mm16(Pm, 16, 1, T0, 16, 1, cs_ld16(Pm, l16, g), l16, g); cs_st16(Mm, c_, l16, g);
          *(u32x2*)(MTb + l16 * 24 + 4 * g) = pk4(c_[0] + 0.0f, c_[1] + 0.0f, c_[2] + 0.0f, c_[3] + 0.0f);
          f32x4v w_ = z4;
#pragma unroll
          for (int q = 0; q < 4; ++q) w_ = __builtin_amdgcn_mfma_f32_16x16x4f32(Mm[(4 * q + g) * 16 + l16], AKB[l16 * 16 + 4 * q + g], w_, 0, 0, 0);
          *(u32x2*)(W1b + l16 * 24 + 4 * g) = pk4(w_[0] + 0.0f, w_[1] + 0.0f, w_[2] + 0.0f, w_[3] + 0.0f);
        }
        cs_wait(fl_done + pw, seq0 + rnd); cs_wait(fl_done + 4 + pw, seq0 + rnd);
        *(u32x4*)(BHT + lane * 24) = bhw0; *(u32x4*)(BHT + lane * 24 + 8) = bhw1;
        GAM[lane] = gamC;
        *(u32x4*)(VT + (lane & 31) * 24 + (lane >> 5) * 8) = vw;
        {
          const bf16x8 mF = (g < 2) ? *(const bf16x8*)(MTb + l16 * 24 + 8 * g) : zf;
          const bf16x8 rF = (g < 2) ? *(const bf16x8*)(ABRT + l16 * 24 + 8 * g) : zf;
          const bf16x8 wF = (g < 2) ? *(const bf16x8*)(W1b + l16 * 24 + 8 * g) : zf;
#pragma unroll
          for (int nt = 0; nt < 4; ++nt) {
            const bf16x8 bF = (g < 2) ? *(const bf16x8*)(ABT + (16 * nt + l16) * 24 + 8 * g) : zf;
            const f32x4v c_ = __builtin_amdgcn_mfma_f32_16x16x32_bf16(mF, bF, z4, 0, 0, 0);
            cs_st4(APT + (4 * g) * 72 + 16 * nt + l16, 72, c_);
            *(u32x2*)(APb + (16 * nt + l16) * 24 + 4 * g) = pk4(c_[0] + 0.0f, c_[1] + 0.0f, c_[2] + 0.0f, c_[3] + 0.0f);
          }
#pragma unroll
          for (int nt = 0; nt < 4; ++nt) {
            f32x4v c_;
#pragma unroll
            for (int r = 0; r < 4; ++r) c_[r] = bf2f(RB[(4 * g + r) * 72 + 16 * nt + l16]);
            const bf16x8 bF = (g < 2) ? *(const bf16x8*)(APb + (16 * nt + l16) * 24 + 8 * g) : zf;
            c_ = __builtin_amdgcn_mfma_f32_16x16x32_bf16(rF, bF, c_, 0, 0, 0);
            cs_st4(QT + (4 * g) * 72 + 16 * nt + l16, 72, c_);
          }
          {
            f32x4v c_;
#pragma unroll
            for (int r = 0; r < 4; ++r) c_[r] = AKR[l16 * 16 + 4 * g + r];
            c_ = __builtin_amdgcn_mfma_f32_16x16x32_bf16(rF, wF, c_, 0, 0, 0);
            cs_st4(HT + (4 * g) * 24 + l16, 24, c_);
          }
#pragma unroll
          for (int mt = 0; mt < 4; ++mt) {
            f32x4v c_;
#pragma unroll
            for (int r = 0; r < 4; ++r) c_[r] = KHT[(16 * mt + 4 * g + r) * 16 + l16];
            const bf16x8 aF = (g < 2) ? *(const bf16x8*)(BHT + (16 * mt + l16) * 24 + 8 * g) : zf;
            c_ = __builtin_amdgcn_mfma_f32_16x16x32_bf16(aF, wF, c_, 0, 0, 0);
            cs_st4(GGT + (16 * mt + 4 * g) * 24 + l16, 24, c_);
          }
        }
        cs_post(fl_ready + pw, seq0 + rnd + 1, lane);
      }
      else if (wid >= 2) {
        float* tl = (float*)(lds + CS_CON + 6144) + (wid - 2) * (64 * 17);
#pragma unroll 1
        for (int q = 0; q < 3; ++q) moe_tr_small(p, ((task * 2 + (wid - 2)) * 96 + rnd * 3 + q), lane, tl);
      }
      else {
#pragma unroll 1
        for (int k = 0; k < 4; ++k) {
          const char* sl = lds + CS_SL0 + k * CS_SLSZ;
          cs_wait(fl_ready + k, seq0 + rnd + 1);
          const bf16_t* QT = (const bf16_t*)sl; const bf16_t* APT = QT + 16 * 72; const bf16_t* BHT = APT + 16 * 72; const bf16_t* GGT = BHT + 64 * 24; const bf16_t* HT = GGT + 64 * 24; const bf16_t* VT = HT + 16 * 24;
          const float* GAM = (const float*)(sl + 2304 * 2 + 3072 * 2 + 768 + 1536);
          bf16x8 sA[2], qF[2], aF[2];
#pragma unroll
          for (int ks = 0; ks < 2; ++ks) { sA[ks] = *(const bf16x8*)(Sb + (i0 + l16) * 144 + (8 * g + 32 * ks) * 2);
            qF[ks] = *(const bf16x8*)(QT + l16 * 72 + 8 * g + 32 * ks); aF[ks] = *(const bf16x8*)(APT + l16 * 72 + 8 * g + 32 * ks); }
          const bf16x8 vF = (g < 2) ? *(const bf16x8*)(VT + (i0 + l16) * 24 + 8 * g) : zf;
          const bf16x8 hF = (g < 2) ? *(const bf16x8*)(HT + l16 * 24 + 8 * g) : zf;
          f32x4v yT = z4;
          yT = __builtin_amdgcn_mfma_f32_16x16x32_bf16(qF[0], sA[0], yT, 0, 0, 0);
          yT = __builtin_amdgcn_mfma_f32_16x16x32_bf16(qF[1], sA[1], yT, 0, 0, 0);
          yT = __builtin_amdgcn_mfma_f32_16x16x32_bf16(hF, vF, yT, 0, 0, 0);
          {
            float* yo = ws_y(p) + (size_t)(tok0 + (rnd * 4 + k) * CK + 4 * g) * RW + h * HD + half * 32 + i0 + l16;
#pragma unroll
            for (int r = 0; r < 4; ++r) yo[(size_t)r * RW] = yT[r];
          }
          f32x4v u = z4;
          u = __builtin_amdgcn_mfma_f32_16x16x32_bf16(sA[0], aF[0], u, 0, 0, 0);
          u = __builtin_amdgcn_mfma_f32_16x16x32_bf16(sA[1], aF[1], u, 0, 0, 0);
          cs_st4((bf16_t*)(Ub + (i0 + 4 * g) * 48 + l16 * 2), 24, u);
          const bf16x8 uF = (g < 2) ? *(const bf16x8*)(Ub + (i0 + l16) * 48 + 16 * g) : zf;
#pragma unroll
          for (int nt = 0; nt < 4; ++nt) {
            const float gm = GAM[16 * nt + l16];
            const bf16x8 bF = (g < 2) ? *(const bf16x8*)(BHT + (16 * nt + l16) * 24 + 8 * g) : zf;
            const bf16x8 gF = (g < 2) ? *(const bf16x8*)(GGT + (16 * nt + l16) * 24 + 8 * g) : zf;
            f32x4v a_ = Sacc[nt] * gm;
            a_ = __builtin_amdgcn_mfma_f32_16x16x32_bf16(uF, bF, a_, 0, 0, 0);
            a_ = __builtin_amdgcn_mfma_f32_16x16x32_bf16(vF, gF, a_, 0, 0, 0);
            Sacc[nt] = a_;
            cs_st4((bf16_t*)(Sb + (i0 + 4 * g) * 144 + (16 * nt + l16) * 2), 72, a_);
          }
          cs_post(fl_done + wid * 4 + k, seq0 + rnd + 1, lane);
        }
      }
    }
  }
  __builtin_amdgcn_s_setprio(0);
  __syncthreads();
}

DI unsigned fkey(float f) { const unsigned u = __float_as_uint(f); return (u & 0x80000000u) ? ~u : (u | 0x80000000u); }
DI int block_sum_i(int v, int* red, int wid, int lane) {
  for (int o = 32; o; o >>= 1) v += __shfl_xor(v, o);
  __syncthreads();
  if (lane == 0) red[wid] = v;
  __syncthreads();
  int s = 0;
#pragma unroll
  for (int w = 0; w < 8; ++w) s += red[w];
  return s;
}
DI void phase4b(const Params& p, int bid, int nb, char* lds) {
  const int t = tid_(), lane = t & 63, wid = t >> 6;
  float* qf = (float*)lds;
  float* wi = qf + 256;
  int* red = (int*)(wi + 4);
  int* wtie = red + 8;
  const bf16_t* proj = ws_proj(p);
  for (int gq = bid; gq < NTOK; gq += nb) {
    const int b = gq >> 11, s = gq & (SEQ - 1);
    const int n = ((s >> 6) + 1) * 64;
    unsigned* mrow = ws_mask(p) + (size_t)gq * 64;
    if (n <= 256) {
      if (t < 64) mrow[t] = (t * 32 < n) ? 0xffffffffu : 0u;
      continue;
    }
    __syncthreads();
    if (t < 256) qf[t] = bf2f(proj[(size_t)gq * PROJ_LD + C_QI + t]) * 0.125f;
    else if (t < 260) wi[t - 256] = bf2f(proj[(size_t)gq * PROJ_LD + C_WI + t - 256]) * 0.5f;
    __syncthreads();
    unsigned uk[4];
#pragma unroll 1
    for (int q = 0; q < 4; ++q) {
      const int key = t * 4 + q;
      uk[q] = 0u;
      if (key < n) {
        float kf[64];
        const bf16_t* kr = ws_kidx(p) + ((size_t)b * SEQ + key) * 64;
#pragma unroll
        for (int d8 = 0; d8 < 8; ++d8) load8(kr + d8 * 8, kf + d8 * 8);
        float sc = 0.f;
#pragma unroll
        for (int hh = 0; hh < 4; ++hh) {
          float dot = 0.f;
#pragma unroll
          for (int d4 = 0; d4 < 16; ++d4) { const f32x4 qv = *(const f32x4*)(qf + hh * 64 + d4 * 4); dot += qv[0] * kf[d4 * 4] + qv[1] * kf[d4 * 4 + 1] + qv[2] * kf[d4 * 4 + 2] + qv[3] * kf[d4 * 4 + 3]; }
          sc += wi[hh] * fmaxf(dot, 0.f);
        }
        sc = sc + 0.0f;
        uk[q] = fkey(sc);
      }
    }
    unsigned T = 0u;
    for (int bit = 31; bit >= 0; --bit) {
      const unsigned cand = T | (1u << bit);
      const int c = (uk[0] >= cand) + (uk[1] >= cand) + (uk[2] >= cand) + (uk[3] >= cand);
      if (block_sum_i(c, red, wid, lane) >= 256) T = cand;
    }
    const int cgt = block_sum_i((uk[0] > T) + (uk[1] > T) + (uk[2] > T) + (uk[3] > T), red, wid, lane);
    const int need = 256 - cgt;
    const int tl = (uk[0] == T) + (uk[1] == T) + (uk[2] == T) + (uk[3] == T);
    int incl = tl;
    for (int o = 1; o < 64; o <<= 1) { const int u = __shfl_up(incl, o); if (lane >= o) incl += u; }
    __syncthreads();
    if (lane == 63) wtie[wid] = incl;
    __syncthreads();
    int before = incl - tl;
    for (int w = 0; w < wid; ++w) before += wtie[w];
    unsigned nib = 0u;
#pragma unroll
    for (int q = 0; q < 4; ++q) {
      bool sel = uk[q] > T;
      if (uk[q] == T) { sel = before < need; ++before; }
      if (sel) nib |= 1u << q;
    }
    unsigned word = nib << ((lane & 7) * 4);
    word |= __shfl_xor(word, 1); word |= __shfl_xor(word, 2); word |= __shfl_xor(word, 4);
    if ((lane & 7) == 0) mrow[t >> 3] = word;
  }
}

constexpr int IDX_LD = 2052;
DI void phase4b_mfma(const Params& p, int bid, int nb, char* lds) {
  const int t = tid_(), lane = t & 63, wid = t >> 6, q16 = lane & 15, g = lane >> 4;
  unsigned* S = (unsigned*)lds;
  const bf16_t* proj = ws_proj(p);
  for (int task = bid; task < NTOK / 16; task += nb) {
    const int b = (task & 255) >> 4, jq = task & 15, kq = task >> 8;
    const int q0 = (((kq & 1) ? 31 - jq : jq) + 32 * (kq >> 1)) * 16;
    const int n = ((q0 >> 6) + 1) * 64, ntile = n >> 4;
    if (n <= 256) {
      unsigned short* mrow = (unsigned short*)(ws_mask(p) + (size_t)(b * SEQ + q0 + q16) * 64);
      if (g == 0) for (int kt = wid; kt < ntile; kt += 8) mrow[kt] = 0xffffu;
      continue;
    }
    const int gq = b * SEQ + q0 + q16;
    const int ntw = (ntile - wid + 7) >> 3;
    const bf16_t* kbase = ws_kidx(p) + (size_t)b * SEQ * 64 + (wid * 16 + q16) * 64 + g * 8;
    bf16x8 qf[4][2]; float wq[4];
#pragma unroll
    for (int h = 0; h < 4; ++h) {
#pragma unroll
      for (int ks = 0; ks < 2; ++ks) qf[h][ks] = *(const bf16x8*)(proj + (size_t)gq * PROJ_LD + C_QI + h * 64 + ks * 32 + g * 8);
      wq[h] = bf2f(proj[(size_t)gq * PROJ_LD + C_WI + h]) * 0.0625f;
    }
    __syncthreads();
    bf16x8 k0 = *(const bf16x8*)kbase, k1 = *(const bf16x8*)(kbase + 32);
#pragma unroll
    for (int tt = 0; tt < 16; ++tt) {
      if (tt < ntw) {
        const bf16x8 c0 = k0, c1 = k1;
        if (tt + 1 < ntw) { int koff = (tt + 1) * 8 * 16 * 64; asm volatile("" : "+v"(koff)); k0 = *(const bf16x8*)(kbase + koff); k1 = *(const bf16x8*)(kbase + koff + 32); }
        float sc[4] = {0.f, 0.f, 0.f, 0.f};
#pragma unroll
        for (int h = 0; h < 4; ++h) {
          f32x4v acc = {0.f, 0.f, 0.f, 0.f};
          acc = __builtin_amdgcn_mfma_f32_16x16x32_bf16(c0, qf[h][0], acc, 0, 0, 0);
          acc = __builtin_amdgcn_mfma_f32_16x16x32_bf16(c1, qf[h][1], acc, 0, 0, 0);
#pragma unroll
          for (int r = 0; r < 4; ++r) sc[r] += wq[h] * fmaxf(acc[r], 0.f);
        }
        u32x4 kv;
#pragma unroll
        for (int r = 0; r < 4; ++r) {
          const unsigned bts = __float_as_uint(sc[r]);
          unsigned key = bts ^ ((unsigned)((int)bts >> 31) | 0x80000000u);
          key += (key == 0x7fffffffu) ? 1u : 0u;
          kv[r] = key;
        }
        *(u32x4*)(S + q16 * IDX_LD + (wid + 8 * tt) * 16 + 4 * g) = kv;
      }
    }
    __syncthreads();
    {
      const int nreg = n >> 6;
      const int qa = 2 * wid;
      unsigned ua[32], ub[32];
#pragma unroll
      for (int j = 0; j < 32; ++j) { ua[j] = (j < nreg) ? S[qa * IDX_LD + 64 * j + lane] : 0u; ub[j] = (j < nreg) ? S[(qa + 1) * IDX_LD + 64 * j + lane] : 0u; }
      unsigned Ta = 0u, Tb = 0u; bool xa = false, xb = false;
      for (int bit = 31; bit >= 0; --bit) {
        const unsigned ca = xa ? Ta : (Ta | (1u << bit)), cb = xb ? Tb : (Tb | (1u << bit));
        int va = 0, vb = 0;
#pragma unroll
        for (int j4 = 0; j4 < 8; ++j4) {
          if (j4 * 4 < nreg) {
#pragma unroll
            for (int j = j4 * 4; j < j4 * 4 + 4; ++j) { va += (ua[j] >= ca) ? 1 : 0; vb += (ub[j] >= cb) ? 1 : 0; }
          }
        }
        int vab = va | (vb << 16);
        vab += __builtin_amdgcn_update_dpp(0, vab, 0xB1, 0xF, 0xF, true);
        vab += __builtin_amdgcn_update_dpp(0, vab, 0x4E, 0xF, 0xF, true);
        vab += __builtin_amdgcn_update_dpp(0, vab, 0x141, 0xF, 0xF, true);
        vab += __builtin_amdgcn_update_dpp(0, vab, 0x140, 0xF, 0xF, true);
        const int tot = __builtin_amdgcn_readlane(vab, 0) + __builtin_amdgcn_readlane(vab, 16) + __builtin_amdgcn_readlane(vab, 32) + __builtin_amdgcn_readlane(vab, 48);
        const int na = tot & 0xffff, nq = tot >> 16;
        if (!xa && na >= 256) { Ta = ca; xa = (na == 256); }
        if (!xb && nq >= 256) { Tb = cb; xb = (nq == 256); }
        if (xa && xb) break;
      }
#pragma unroll 1
      for (int which = 0; which < 2; ++which) {
        const unsigned T = which ? Tb : Ta;
        if (which ? xb : xa) {
          unsigned* mrow = ws_mask(p) + (size_t)(b * SEQ + q0 + qa + which) * 64;
#pragma unroll
          for (int j = 0; j < 32; ++j) {
            if (j < nreg) {
              const unsigned long long sel = __ballot((which ? ub[j] : ua[j]) >= T);
              if (lane == 0) { mrow[2 * j] = (unsigned)sel; mrow[2 * j + 1] = (unsigned)(sel >> 32); }
            }
          }
          continue;
        }
        int cgt = 0;
#pragma unroll
        for (int j = 0; j < 32; ++j) cgt += __popcll(__ballot((which ? ub[j] : ua[j]) > T));
        int need = 256 - cgt;
        unsigned* mrow = ws_mask(p) + (size_t)(b * SEQ + q0 + qa + which) * 64;
#pragma unroll
        for (int j = 0; j < 32; ++j) {
          if (j < nreg) {
            const unsigned uv = which ? ub[j] : ua[j];
            unsigned long long sel = __ballot(uv > T);
            const unsigned long long eq = __ballot(uv == T);
            const int pe = __popcll(eq);
            if (pe <= need) { sel |= eq; need -= pe; }
            else { unsigned long long e = eq; for (int i = 0; i < need; ++i) { const unsigned long long low = e & (0ull - e); sel |= low; e ^= low; } need = 0; }
            if (lane == 0) { mrow[2 * j] = (unsigned)sel; mrow[2 * j + 1] = (unsigned)(sel >> 32); }
          }
        }
      }
    }
  }
}

DI void phase5a(const Params& p, int bid, int nb, char* lds) {
  const int lane = tid_() & 63, wid = tid_() >> 6;
  const bf16_t* proj = ws_proj(p);
  for (int gt = bid * 8 + wid; gt < NTOK; gt += nb * 8) {
    const int c0 = lane * 8, h = lane >> 3;
    const f32x4 y0 = *(const f32x4*)(ws_y(p) + (size_t)gt * RW + c0), y1 = *(const f32x4*)(ws_y(p) + (size_t)gt * RW + c0 + 4);
    float y[8] = {y0[0], y0[1], y0[2], y0[3], y1[0], y1[1], y1[2], y1[3]};
    float s = 0.f;
#pragma unroll
    for (int j = 0; j < 8; ++j) s += y[j];
    s += __shfl_xor(s, 1); s += __shfl_xor(s, 2); s += __shfl_xor(s, 4);
    const float mean = s * (1.0f / 64.0f);
    float q = 0.f;
#pragma unroll
    for (int j = 0; j < 8; ++j) { const float d = y[j] - mean; q += d * d; }
    q += __shfl_xor(q, 1); q += __shfl_xor(q, 2); q += __shfl_xor(q, 4);
    const float rstd = rsqrtf(q * (1.0f / 64.0f) + 64e-5f);
    float g[8], vr[8], vp[8];
    load8(ws_gg(p) + (size_t)gt * RW + c0, g);
    load8(proj + (size_t)gt * PROJ_LD + C_V + c0, vr);
    if (gt & (SEQ - 1)) load8(proj + (size_t)(gt - 1) * PROJ_LD + C_V + c0, vp);
    else {
#pragma unroll
      for (int j = 0; j < 8; ++j) vp[j] = 0.f;
    }
    const float bs = ws_bonus(p)[gt * NH + h];
    float o[8];
#pragma unroll
    for (int j = 0; j < 8; ++j) {
      const float v = vr[j] + p.shift_mu[C_V + c0 + j] * (vp[j] - vr[j]);
      o[j] = ((y[j] - mean) * rstd * p.gn_g[c0 + j] + p.gn_b[c0 + j] + bs * v) * g[j];
    }
    u32x4 w; w.x = pack2(o[0], o[1]); w.y = pack2(o[2], o[3]); w.z = pack2(o[4], o[5]); w.w = pack2(o[6], o[7]);
    *(u32x4*)(ws_mix(p) + (size_t)gt * DM + c0) = w;
  }
}

DI void phase5b(const Params& p, int bid, int nb, char* lds) {
  const int t = tid_(), lane = t & 63, wid = t >> 6;
  float* ql = (float*)lds;
  float* pr = ql + 1024;
  float* ol = pr + 2048;
  int* sel = (int*)(ol + 1024);
  int* nselp = sel + 256;
  for (int gq = bid; gq < NTOK; gq += nb) {
    const int b = gq >> 11;
    const bf16_t* ckv = ws_ckv(p) + (size_t)b * SEQ * 128;
    __syncthreads();
    for (int idx = t; idx < 1024; idx += NTHR) ql[idx] = bf2f(ws_qlat(p)[(size_t)gq * 1024 + idx]);
    if (wid == 0) {
      const int nadm = (((gq & (SEQ - 1)) >> 6) + 1) * 64;
      const unsigned word = (lane * 32 < nadm) ? ws_mask(p)[(size_t)gq * 64 + lane] : 0u;
      const int cnt = __popc(word);
      int incl = cnt;
      for (int o = 1; o < 64; o <<= 1) { const int u = __shfl_up(incl, o); if (lane >= o) incl += u; }
      int pos = incl - cnt;
      unsigned w = word;
      while (w) { const int bit = __ffs(w) - 1; w &= w - 1; if (pos < 256) sel[pos] = lane * 32 + bit; ++pos; }
      if (lane == 63) *nselp = incl < 256 ? incl : 256;
    }
    __syncthreads();
    const int nsel = *nselp;
    const int h = wid;
    float lg[4]; float mx = -1e30f;
#pragma unroll
    for (int q = 0; q < 4; ++q) {
      const int slot = lane + 64 * q;
      lg[q] = -1e30f;
      if (slot < nsel) {
        const bf16_t* kr = ckv + (size_t)sel[slot] * 128;
        float acc = 0.f;
#pragma unroll
        for (int d8 = 0; d8 < 16; ++d8) {
          float kf[8]; load8(kr + d8 * 8, kf);
          const f32x4 q0 = *(const f32x4*)(ql + h * 128 + d8 * 8), q1 = *(const f32x4*)(ql + h * 128 + d8 * 8 + 4);
          acc += q0[0] * kf[0] + q0[1] * kf[1] + q0[2] * kf[2] + q0[3] * kf[3] + q1[0] * kf[4] + q1[1] * kf[5] + q1[2] * kf[6] + q1[3] * kf[7];
        }
        lg[q] = acc;
      }
      mx = fmaxf(mx, lg[q]);
    }
    mx = wave_max(mx);
    float sm = 0.f;
#pragma unroll
    for (int q = 0; q < 4; ++q) { lg[q] = (lane + 64 * q < nsel) ? __expf(lg[q] - mx) : 0.f; sm += lg[q]; }
    sm = wave_sum(sm);
    const float inv = 1.0f / sm;
#pragma unroll
    for (int q = 0; q < 4; ++q) pr[h * 256 + lane + 64 * q] = lg[q] * inv;
    __syncthreads();
    {
      float o0 = 0.f, o1 = 0.f;
      for (int slot = 0; slot < nsel; ++slot) {
        const unsigned kv2 = *(const unsigned*)(ckv + (size_t)sel[slot] * 128 + lane * 2);
        const float pp = pr[h * 256 + slot];
        o0 += pp * __uint_as_float(kv2 << 16); o1 += pp * __uint_as_float(kv2 & 0xffff0000u);
      }
      ol[h * 128 + lane * 2] = o0; ol[h * 128 + lane * 2 + 1] = o1;
    }
    __syncthreads();
    {
      float acc = 0.f;
      for (int cc = 0; cc < 128; ++cc) acc += ol[h * 128 + cc] * p.w_uv[(size_t)(cc * NH + h) * HD + lane];
      ws_mix(p)[(size_t)gq * DM + RW + h * HD + lane] = f2bf(acc);
    }
  }
}

typedef short s16x4 __attribute__((ext_vector_type(4)));
#define KSWZ(row, colB) ((row) * 256 + ((colB) ^ (((row) & 7) << 4)))
DI int v_st(int k, int c) { const int kk = (k & ~0xC) | ((k & 4) << 1) | ((k & 8) >> 1); return ((kk >> 3) * 4 + (c >> 5)) * 512 + ((kk & 7) * 32 + (c & 31)) * 2; }
DI int v_rd_base(int lane) { return ((lane & 3) << 3) | (((lane >> 2) & 3) << 6) | (((lane >> 4) & 1) << 5) | (((lane >> 5) & 1) << 8); }
constexpr int v_rd_off(int d0, int ks, int half) { return d0 * 512 + ks * 4096 + half * 2048; }
template <int OFF> DI s16x4 tr_read(int vb) { s16x4 r; asm volatile("ds_read_b64_tr_b16 %0, %1 offset:%2" : "=&v"(r) : "v"(vb), "i"(OFF) : "memory"); return r; }
template <int D0> DI void pv_one(f32x16& od, int vb, bf16x8 pa0, bf16x8 pa1, bf16x8 pa2, bf16x8 pa3) {
  const s16x4 l0 = tr_read<v_rd_off(D0, 0, 0)>(vb), h0 = tr_read<v_rd_off(D0, 0, 1)>(vb), l1 = tr_read<v_rd_off(D0, 1, 0)>(vb), h1 = tr_read<v_rd_off(D0, 1, 1)>(vb);
  const s16x4 l2 = tr_read<v_rd_off(D0, 2, 0)>(vb), h2 = tr_read<v_rd_off(D0, 2, 1)>(vb), l3 = tr_read<v_rd_off(D0, 3, 0)>(vb), h3 = tr_read<v_rd_off(D0, 3, 1)>(vb);
  asm volatile("s_waitcnt lgkmcnt(0)" ::: "memory"); __builtin_amdgcn_sched_barrier(0);
#define PKV(L, H) (bf16x8){L[0], L[1], L[2], L[3], H[0], H[1], H[2], H[3]}
  od = __builtin_amdgcn_mfma_f32_32x32x16_bf16(pa0, PKV(l0, h0), od, 0, 0, 0);
  od = __builtin_amdgcn_mfma_f32_32x32x16_bf16(pa1, PKV(l1, h1), od, 0, 0, 0);
  od = __builtin_amdgcn_mfma_f32_32x32x16_bf16(pa2, PKV(l2, h2), od, 0, 0, 0);
  od = __builtin_amdgcn_mfma_f32_32x32x16_bf16(pa3, PKV(l3, h3), od, 0, 0, 0);
#undef PKV
}
constexpr int ATT_TILE = 64 * 128 * 2;
constexpr int ATT_LDS = 4 * ATT_TILE + 8 * 64 * 4;
DI void phase5b_mfma(const Params& p, int bid, int nb, char* lds) {
  const int t = tid_(), lane = t & 63, wid = t >> 6, r32 = lane & 31, hi = lane >> 5;
  char* V_lds = lds; char* K_lds = lds + 2 * ATT_TILE;
  float* al_l = (float*)(lds + 4 * ATT_TILE) + wid * 64; float* li_l = al_l + 32;
  const int sr = t >> 4, sc = (t & 15) * 8;
  const int vst0 = v_st(sr, sc), vst1 = v_st(32 + sr, sc), kst0 = KSWZ(sr, sc * 2), kst1 = KSWZ(32 + sr, sc * 2);
  const int vb0 = (int)(uintptr_t)V_lds + v_rd_base(lane);
  const int h = wid;
  constexpr float LOG2E = 1.4426950408889634f, THR = 8.0f;
  for (int task = bid; task < NTOK / 32; task += nb) {
    const int b = (task & 255) >> 4;
    int qt; { const int j = task & 15, k = task >> 8; qt = (k == 0) ? j : (k == 1) ? 31 - j : (k == 2) ? 32 + j : 63 - j; }
    const int q0 = qt * 32, n = ((q0 >> 6) + 1) * 64, NT = n >> 6;
    const int gq = b * SEQ + q0 + r32;
    const bf16_t* ckv = ws_ckv(p) + (size_t)b * SEQ * 128;
    const unsigned* mrow = ws_mask(p) + (size_t)gq * 64;
    bf16x8 qr[8];
    {
      f32x16 qa[4];
#pragma unroll
      for (int mt = 0; mt < 4; ++mt)
#pragma unroll
        for (int r = 0; r < 16; ++r) qa[mt][r] = 0.f;
      const bf16_t* wuk = ws_wukt(p) + (size_t)h * 8192 + lane * 8;
#pragma unroll
      for (int ks = 0; ks < 4; ++ks) {
        const bf16x8 bq = *(const bf16x8*)(ws_proj(p) + (size_t)gq * PROJ_LD + C_Q + h * HD + ks * 16 + hi * 8);
#pragma unroll
        for (int mt = 0; mt < 4; ++mt) { const bf16x8 aw = *(const bf16x8*)(wuk + (mt * 4 + ks) * 512); qa[mt] = __builtin_amdgcn_mfma_f32_32x32x16_bf16(aw, bq, qa[mt], 0, 0, 0); }
      }
#define QPK(P, BASE, OUT) do { unsigned a0 = cvtpk(P[BASE + 0] * 0.125f, P[BASE + 1] * 0.125f), a1 = cvtpk(P[BASE + 2] * 0.125f, P[BASE + 3] * 0.125f);   \
    unsigned b0 = cvtpk(P[BASE + 4] * 0.125f, P[BASE + 5] * 0.125f), b1 = cvtpk(P[BASE + 6] * 0.125f, P[BASE + 7] * 0.125f);                              \
    auto r0 = __builtin_amdgcn_permlane32_swap(a0, b0, false, false); auto r1 = __builtin_amdgcn_permlane32_swap(a1, b1, false, false); \
    u32x4 w = {r0[0], r1[0], r0[1], r1[1]}; OUT = *reinterpret_cast<bf16x8*>(&w); } while (0)
#pragma unroll
      for (int mt = 0; mt < 4; ++mt) { QPK(qa[mt], 0, qr[2 * mt]); QPK(qa[mt], 8, qr[2 * mt + 1]); }
#undef QPK
    }
    float m_reg = -1e30f, l_reg = 0.f;
    f32x16 o[4];
#pragma unroll
    for (int d = 0; d < 4; ++d)
#pragma unroll
      for (int r = 0; r < 16; ++r) o[d][r] = 0.f;
    u32x4 s0 = *(const u32x4*)(ckv + (size_t)sr * 128 + sc), s1 = *(const u32x4*)(ckv + (size_t)(32 + sr) * 128 + sc);
    __syncthreads();
    *(u32x4*)(V_lds + vst0) = s0; *(u32x4*)(V_lds + vst1) = s1; *(u32x4*)(K_lds + kst0) = s0; *(u32x4*)(K_lds + kst1) = s1;
    __syncthreads();
    unsigned mw0 = mrow[0], mw1 = mrow[1];
    for (int j = 0; j < NT; ++j) {
      const int buf = j & 1;
      const unsigned w0 = mw0 >> (4 * hi), w1 = mw1 >> (4 * hi);
      if (j + 1 < NT) { mw0 = mrow[2 * j + 2]; mw1 = mrow[2 * j + 3]; }
      if (j + 1 < NT) { s0 = *(const u32x4*)(ckv + (size_t)((j + 1) * 64 + sr) * 128 + sc); s1 = *(const u32x4*)(ckv + (size_t)((j + 1) * 64 + 32 + sr) * 128 + sc); }
      f32x16 p0, p1;
#pragma unroll
      for (int r = 0; r < 16; ++r) { p0[r] = 0.f; p1[r] = 0.f; }
      const char* Kb = K_lds + buf * ATT_TILE;
#pragma unroll
      for (int d0 = 0; d0 < 8; ++d0) {
        const int cb = (d0 * 16 + hi * 8) * 2;
        const bf16x8 b0 = *(const bf16x8*)(Kb + KSWZ(r32, cb)), b1 = *(const bf16x8*)(Kb + KSWZ(32 + r32, cb));
        p0 = __builtin_amdgcn_mfma_f32_32x32x16_bf16(b0, qr[d0], p0, 0, 0, 0);
        p1 = __builtin_amdgcn_mfma_f32_32x32x16_bf16(b1, qr[d0], p1, 0, 0, 0);
      }
      float pmax = p0[0];
#pragma unroll
      for (int r = 1; r < 16; ++r) pmax = fmaxf(pmax, p0[r]);
#pragma unroll
      for (int r = 0; r < 16; ++r) pmax = fmaxf(pmax, p1[r]);
      { auto rr = __builtin_amdgcn_permlane32_swap(__float_as_uint(pmax), __float_as_uint(pmax), false, false); pmax = fmaxf(__uint_as_float(rr[0]), __uint_as_float(rr[1])); }
      float alpha = 1.f;
      if (!__all(pmax - m_reg <= THR)) { const float mn = fmaxf(m_reg, pmax); alpha = __builtin_amdgcn_exp2f((m_reg - mn) * LOG2E); m_reg = mn; }
      const float mnC = -m_reg * LOG2E;
      float ps = 0.f;
#pragma unroll
      for (int r = 0; r < 16; ++r) {
        const int bitp = (r & 3) + 8 * (r >> 2);
        float e0 = __builtin_amdgcn_exp2f(fmaf(p0[r], LOG2E, mnC)), e1 = __builtin_amdgcn_exp2f(fmaf(p1[r], LOG2E, mnC));
        e0 = __uint_as_float(__float_as_uint(e0) & (unsigned)(((int)(w0 << (31 - bitp))) >> 31));
        e1 = __uint_as_float(__float_as_uint(e1) & (unsigned)(((int)(w1 << (31 - bitp))) >> 31));
        p0[r] = e0; p1[r] = e1; ps += e0 + e1;
      }
      { auto rr = __builtin_amdgcn_permlane32_swap(__float_as_uint(ps), __float_as_uint(ps), false, false); ps = __uint_as_float(rr[0]) + __uint_as_float(rr[1]); }
      l_reg = l_reg * alpha + ps;
      if (__any(alpha < 1.f)) {
        if (hi == 0) al_l[r32] = alpha;
        asm volatile("s_waitcnt lgkmcnt(0)" ::: "memory");
#pragma unroll
        for (int d = 0; d < 4; ++d)
#pragma unroll
          for (int r = 0; r < 16; ++r) o[d][r] *= al_l[crow(r, hi)];
      }
      bf16x8 pa0, pa1, pa2, pa3;
#define PK4(P, BASE, OUT) do { unsigned a0 = cvtpk(P[BASE + 0], P[BASE + 1]), a1 = cvtpk(P[BASE + 2], P[BASE + 3]);   \
    unsigned b0 = cvtpk(P[BASE + 4], P[BASE + 5]), b1 = cvtpk(P[BASE + 6], P[BASE + 7]);                              \
    auto r0 = __builtin_amdgcn_permlane32_swap(a0, b0, false, false); auto r1 = __builtin_amdgcn_permlane32_swap(a1, b1, false, false); \
    u32x4 w = {r0[0], r1[0], r0[1], r1[1]}; OUT = *reinterpret_cast<bf16x8*>(&w); } while (0)
      PK4(p0, 0, pa0); PK4(p0, 8, pa1); PK4(p1, 0, pa2); PK4(p1, 8, pa3);
#undef PK4
      const int vb = vb0 + buf * ATT_TILE;
      pv_one<0>(o[0], vb, pa0, pa1, pa2, pa3); pv_one<1>(o[1], vb, pa0, pa1, pa2, pa3); pv_one<2>(o[2], vb, pa0, pa1, pa2, pa3); pv_one<3>(o[3], vb, pa0, pa1, pa2, pa3);
      if (j + 1 < NT) {
        char* Vn = V_lds + (buf ^ 1) * ATT_TILE; char* Kn = K_lds + (buf ^ 1) * ATT_TILE;
        *(u32x4*)(Vn + vst0) = s0; *(u32x4*)(Vn + vst1) = s1; *(u32x4*)(Kn + kst0) = s0; *(u32x4*)(Kn + kst1) = s1;
      }
      __syncthreads();
    }
    if (hi == 0) li_l[r32] = l_reg;
    asm volatile("s_waitcnt lgkmcnt(0)" ::: "memory");
    int hio = hi, r32o = r32;
    asm volatile("" : "+v"(hio), "+v"(r32o));
    char* Ow = lds + wid * 8192;
#pragma unroll
    for (int r = 0; r < 16; ++r) {
      const int row = crow(r, hio); const float rl = 1.0f / li_l[row];
#pragma unroll
      for (int d = 0; d < 4; ++d) *(bf16_t*)(Ow + KSWZ(row, (d * 32 + r32o) * 2)) = f2bf(o[d][r] * rl);
    }
    asm volatile("s_waitcnt lgkmcnt(0)" ::: "memory");
    f32x16 oa[2];
#pragma unroll
    for (int i = 0; i < 2; ++i)
#pragma unroll
      for (int r = 0; r < 16; ++r) oa[i][r] = 0.f;
    const bf16_t* wuv = ws_wuvt(p) + (size_t)h * 8192 + (hio * 32 + r32o) * 8;
#pragma unroll
    for (int ks = 0; ks < 8; ++ks) {
      const bf16x8 a = *(const bf16x8*)(Ow + KSWZ(r32o, (ks * 16 + hio * 8) * 2));
#pragma unroll
      for (int i = 0; i < 2; ++i) {
        const bf16x8 bw = *(const bf16x8*)(wuv + (i * 8 + ks) * 512);
        oa[i] = __builtin_amdgcn_mfma_f32_32x32x16_bf16(a, bw, oa[i], 0, 0, 0);
      }
    }
    asm volatile("s_waitcnt lgkmcnt(0)" ::: "memory");
#pragma unroll
    for (int i = 0; i < 2; ++i)
#pragma unroll
      for (int r = 0; r < 16; ++r) *(bf16_t*)(Ow + ((r & 3) + 8 * (r >> 2) + 4 * hio) * 144 + (i * 32 + r32o) * 2) = f2bf(oa[i][r]);
    asm volatile("s_waitcnt lgkmcnt(0)" ::: "memory");
    {
      const int lo = hio * 32 + r32o;
      bf16_t* mx = ws_mix(p) + (size_t)(b * SEQ + q0) * DM + RW + h * HD;
#pragma unroll
      for (int k = 0; k < 4; ++k) { const int row = k * 8 + (lo >> 3), sg = lo & 7; *(u32x4*)(mx + (size_t)row * DM + sg * 8) = *(const u32x4*)(Ow + row * 144 + sg * 16); }
    }
  }
}

struct EpiOut { const float* x; const float* mod; float* o; int row0, col0; DI void operator()(int r, int c, float v0, float v1) const {
  const int row = row0 + r, col = col0 + c, b = row >> 11; const size_t idx = (size_t)row * DM + col;
  o[idx] = x[idx] + (1.0f + mod[b * 6144 + 2048 + col]) * v0; o[idx + 32] = x[idx + 32] + (1.0f + mod[b * 6144 + 2048 + col + 32]) * v1; } };
DI void phase6(const Params& p, int bid, int nb, char* lds) {
  constexpr int NT = DM / GBN;
  for (int tile = bid; tile < (NTOK / GBM) * NT; tile += nb) {
    const int mt = tile / NT, nt = tile % NT;
    gemm_tile(ws_mix(p), DM, ARowBase{mt * GBM}, ws_wtout(p), DM, nt * GBN, DM, EpiOut{p.x, ws_mod(p), p.out, mt * GBM, nt * GBN}, lds);
  }
}

namespace pg8 {
#define PG8_LAS __attribute__((address_space(3)))
constexpr int BM = 256, BK = 64, HALF = 128, HTB = HALF * BK * 2  , STAGE_BYTES = 8 * HTB, NXCD = 8, WGM = 8;

__host__ __device__ __forceinline__ int lds_byte(int r, int c) { const int st = (r >> 4) * 2 + (c >> 5), rr = r & 15, cc = c & 31, ob = rr * 64 + cc * 2; return st * 1024 + (ob ^ (((ob >> 9) & 1) << 5)); }
__host__ __device__ __forceinline__ void stage_rc(int b, int& R, int& C) { const int st = b / 1024, sb = b % 1024, swz = sb ^ (((sb >> 9) & 1) << 5); R = (st >> 1) * 16 + swz / 64; C = (st & 1) * 32 + (swz % 64) / 2; }
__host__ __device__ __forceinline__ int perm32(int rho) { const int n = rho >> 4, i = rho & 15; return 8 * (i >> 2) + 4 * n + (i & 3); }

struct Unit { int pm, pn, e; };
struct Gemm { const bf16_t* A; const bf16_t* Bt; int M, N, K; size_t bstride; };

struct StaticOrder {
    static constexpr bool GATHER = false;
    int nM, nN, nwg, G, c;
    __host__ __device__ void init(int M, int N, int G_, int c_) { nM = M / BM; nN = N / BM; nwg = nM * nN; G = G_; c = c_; }
    __host__ __device__ bool next(int i, Unit& u) const {
        const long L = (long)i * G + c; if (L >= nwg) return false;
        int wgid = (int)L; { const int q = nwg / NXCD, r = nwg % NXCD, xcd = wgid % NXCD, off = wgid / NXCD; wgid = (xcd < r ? xcd * (q + 1) : r * (q + 1) + (xcd - r) * q) + off; }
        const int nig = WGM * nN, gid = wgid / nig, fm = gid * WGM, gsz = (nM - fm) < WGM ? (nM - fm) : WGM;
        u.pm = fm + ((wgid % nig) % gsz); u.pn = (wgid % nig) / gsz; u.e = 0; return true;
    }
    __device__ __forceinline__ void a_ready(const Unit&) const {}
    __device__ __forceinline__ void done(const Unit&) const {}
    __device__ __forceinline__ int arow(const Unit&, int) const { return 0; }
};
template <class Epi, class Sched, bool ALIGN_EPI = false, bool SP2 = false>
__device__ __forceinline__ void gemm_phase(PG8_LAS unsigned char* lds, const Gemm g, const Sched& S, const Epi& E) {
    const int tid = tid_(), wid = __builtin_amdgcn_readfirstlane(tid >> 6), lane = tid & 63, wr = wid >> 2, wc = wid & 3, fr = lane & 15, fq = lane >> 4;
    const int K = g.K, nt = K / BK;
    unsigned voffA[2], voffB[2];
#pragma unroll
    for (int i = 0; i < 2; ++i) { int R, C; stage_rc(tid * 16 + i * 8192, R, C); const int Rb = Epi::PERM ? ((R & ~31) + perm32(R & 31)) : R;
        voffA[i] = (unsigned)(R * K + C) * 2u; voffB[i] = (unsigned)(Rb * K + C) * 2u; }
    unsigned vAc[2][2], vAn[2][2];
    const size_t kstep = (size_t)(BK * 2);
    const size_t hstep = (size_t)HALF * K * 2;
    const size_t tstep = 2 * hstep;
    const unsigned ldsw = (unsigned)wid * 1024u;
    const int aoff = lds_byte(wr * 64 + fr, fq * 8), boff = lds_byte(wc * 32 + fr, fq * 8);
#define PG8_SA(b, h) (((b) * 2 + (h)) * HTB)
#define PG8_SB(b, h) ((4 + (b) * 2 + (h)) * HTB)
#define PG8_STAGE(bufoff, gbase, voff) do { _Pragma("unroll") for (int _i = 0; _i < 2; ++_i) \
        __builtin_amdgcn_global_load_lds((const unsigned*)((const char*)(gbase) + (voff)[_i]), (PG8_LAS unsigned*)(lds + (bufoff) + ldsw + _i * 8192), 16, 0, 0); } while (0)
#define PG8_STAGE_A(bufoff, gbase, v0_, v1_) do { \
        __builtin_amdgcn_global_load_lds((const unsigned*)((const char*)(gbase) + (v0_)), (PG8_LAS unsigned*)(lds + (bufoff) + ldsw), 16, 0, 0); \
        __builtin_amdgcn_global_load_lds((const unsigned*)((const char*)(gbase) + (v1_)), (PG8_LAS unsigned*)(lds + (bufoff) + ldsw + 8192), 16, 0, 0); } while (0)
#define PG8_AOFF(u_, dst_) do { if constexpr (Sched::GATHER) { _Pragma("unroll") for (int h_ = 0; h_ < 2; ++h_) _Pragma("unroll") for (int i_ = 0; i_ < 2; ++i_) { int R_, C_; stage_rc(tid * 16 + i_ * 8192, R_, C_); \
            dst_[h_][i_] = (unsigned)(S.arow(u_, h_ * HALF + R_) * K + C_) * 2u; } asm volatile("s_waitcnt vmcnt(0)" ::: "memory"); } \
        else { _Pragma("unroll") for (int h_ = 0; h_ < 2; ++h_) _Pragma("unroll") for (int i_ = 0; i_ < 2; ++i_) dst_[h_][i_] = voffA[i_] + (unsigned)(h_ * hstep); } } while (0)
#define PG8_LDA(dst, b, h) do { _Pragma("unroll") for (int m = 0; m < 4; ++m) _Pragma("unroll") for (int k = 0; k < 2; ++k) dst[m][k] = *(const PG8_LAS bf16x8*)(lds + PG8_SA(b, h) + aoff + m * 2048 + k * 1024); } while (0)
#define PG8_LDB(dst, b, h) do { _Pragma("unroll") for (int n = 0; n < 2; ++n) _Pragma("unroll") for (int k = 0; k < 2; ++k) dst[n][k] = *(const PG8_LAS bf16x8*)(lds + PG8_SB(b, h) + boff + n * 2048 + k * 1024); } while (0)
#define PG8_MMA(ai, bj, At, Bt) do { __builtin_amdgcn_s_setprio(1); _Pragma("unroll") for (int m = 0; m < 4; ++m) _Pragma("unroll") for (int n = 0; n < 2; ++n) _Pragma("unroll") for (int k = 0; k < 2; ++k) \
        acc[ai][bj][m][n] = __builtin_amdgcn_mfma_f32_16x16x32_bf16(Bt[n][k], At[m][k], acc[ai][bj][m][n], 0, 0, 0); __builtin_amdgcn_s_setprio(0); } while (0)
#define PG8_WAIT_V(n) asm volatile("s_waitcnt vmcnt(" #n ")" ::: "memory")
#define PG8_WAIT_L(n) asm volatile("s_waitcnt lgkmcnt(" #n ")" ::: "memory")
#define PG8_BAR __builtin_amdgcn_s_barrier()
#define PG8_SCHED __builtin_amdgcn_sched_barrier(0)
    Unit cur, nxt; int ui = 0;
    if (!S.next(0, cur)) return;
    f32x4 acc[2][2][4][2];
#pragma unroll
    for (int a = 0; a < 2; ++a)
#pragma unroll
        for (int b = 0; b < 2; ++b)
#pragma unroll
            for (int m = 0; m < 4; ++m)
#pragma unroll
                for (int n = 0; n < 2; ++n) acc[a][b][m][n] = (f32x4){0.f, 0.f, 0.f, 0.f};
    bf16x8 At[4][2], B0[2][2], B1[2][2];
    const char* cA = Sched::GATHER ? (const char*)g.A : (const char*)g.A + (size_t)cur.pm * tstep; PG8_AOFF(cur, vAc); const char* cB = (const char*)g.Bt + (size_t)cur.e * g.bstride + (size_t)cur.pn * tstep;
    S.a_ready(cur);
    if constexpr (SP2) {
        PG8_STAGE(PG8_SB(0, 0), cB, voffB); PG8_STAGE(PG8_SB(0, 1), cB + hstep, voffB); PG8_STAGE_A(PG8_SA(0, 0), cA, vAc[0][0], vAc[0][1]); PG8_STAGE_A(PG8_SA(0, 1), cA, vAc[1][0], vAc[1][1]);
        if (wr == 1) PG8_BAR;
        PG8_WAIT_V(2); PG8_BAR;
        PG8_STAGE(PG8_SB(1, 0), cB + kstep, voffB); PG8_STAGE_A(PG8_SA(1, 0), cA + kstep, vAc[0][0], vAc[0][1]); PG8_STAGE(PG8_SB(1, 1), cB + hstep + kstep, voffB);
        PG8_WAIT_V(6); PG8_BAR;
    } else {
        PG8_STAGE(PG8_SB(0, 0), cB, voffB); PG8_STAGE(PG8_SA(0, 0), cA, voffA); PG8_STAGE(PG8_SB(0, 1), cB + hstep, voffB); PG8_STAGE(PG8_SA(0, 1), cA + hstep, voffA);
        if (wr == 1) PG8_BAR;
        PG8_WAIT_V(4); PG8_BAR;
        PG8_STAGE(PG8_SB(1, 0), cB + kstep, voffB); PG8_STAGE(PG8_SA(1, 0), cA + kstep, voffA); PG8_STAGE(PG8_SB(1, 1), cB + hstep + kstep, voffB);
        PG8_WAIT_V(6); PG8_BAR;
    }
    for (;;) {
        const bool has_next = S.next(ui + 1, nxt);
        const char* nA = (has_next && !Sched::GATHER) ? (const char*)g.A + (size_t)nxt.pm * tstep : cA;
        if (has_next) PG8_AOFF(nxt, vAn); else { _Pragma("unroll") for (int h_ = 0; h_ < 2; ++h_) _Pragma("unroll") for (int i_ = 0; i_ < 2; ++i_) vAn[h_][i_] = vAc[h_][i_]; }
        const char* nB = has_next ? (const char*)g.Bt + (size_t)nxt.e * g.bstride + (size_t)nxt.pn * tstep : cB;
        for (int t = 0; t < nt; t += 2) {
            const bool last = (t == nt - 2);
            const char* a1 = cA + (size_t)(t + 1) * kstep;
            const char* a2 = last ? nA : cA + (size_t)(t + 2) * kstep; const char* b2 = last ? nB : cB + (size_t)(t + 2) * kstep;
            const char* a3 = a2 + kstep; const char* b3 = b2 + kstep;
            if (last && has_next) S.a_ready(nxt);
            if constexpr (SP2) {
            PG8_LDB(B0, 0, 0); PG8_LDB(B1, 0, 1); PG8_SCHED; PG8_LDA(At, 0, 0); PG8_STAGE_A(PG8_SA(1, 1), a1, vAc[1][0], vAc[1][1]);
            PG8_WAIT_V(8); PG8_WAIT_L(0); PG8_BAR; PG8_MMA(0, 0, At, B0); PG8_MMA(0, 1, At, B1); PG8_BAR; PG8_SCHED;
            PG8_LDA(At, 0, 1); PG8_STAGE(PG8_SB(0, 0), b2, voffB); PG8_STAGE(PG8_SB(0, 1), b2 + hstep, voffB); PG8_STAGE_A(PG8_SA(0, 0), a2, last ? vAn[0][0] : vAc[0][0], last ? vAn[0][1] : vAc[0][1]);
            PG8_WAIT_V(8); PG8_WAIT_L(0); PG8_BAR; PG8_MMA(1, 0, At, B0); PG8_MMA(1, 1, At, B1); PG8_BAR; PG8_SCHED;
            PG8_LDB(B0, 1, 0); PG8_LDB(B1, 1, 1); PG8_SCHED; PG8_LDA(At, 1, 0); PG8_STAGE_A(PG8_SA(0, 1), a2, last ? vAn[1][0] : vAc[1][0], last ? vAn[1][1] : vAc[1][1]);
            PG8_WAIT_V(8); PG8_WAIT_L(0); PG8_BAR; PG8_MMA(0, 0, At, B0); PG8_MMA(0, 1, At, B1); PG8_BAR; PG8_SCHED;
            PG8_LDA(At, 1, 1); PG8_STAGE(PG8_SB(1, 0), b3, voffB); PG8_STAGE(PG8_SB(1, 1), b3 + hstep, voffB); PG8_STAGE_A(PG8_SA(1, 0), a3, last ? vAn[0][0] : vAc[0][0], last ? vAn[0][1] : vAc[0][1]);
            PG8_WAIT_V(8); PG8_WAIT_L(0); PG8_BAR; PG8_MMA(1, 0, At, B0); PG8_MMA(1, 1, At, B1); PG8_BAR; PG8_SCHED;
            } else {
            PG8_LDB(B0, 0, 0); PG8_SCHED; PG8_LDA(At, 0, 0); PG8_STAGE(PG8_SA(1, 1), a1 + hstep, voffA);
            PG8_WAIT_L(8); PG8_BAR; PG8_WAIT_L(0); PG8_MMA(0, 0, At, B0); PG8_BAR; PG8_SCHED;
            PG8_LDB(B1, 0, 1); PG8_STAGE(PG8_SB(0, 0), b2, voffB);
            PG8_BAR; PG8_WAIT_L(0); PG8_MMA(0, 1, At, B1); PG8_BAR;
            PG8_LDA(At, 0, 1); PG8_STAGE(PG8_SA(0, 0), a2, voffA);
            PG8_BAR; PG8_WAIT_L(0); PG8_MMA(1, 0, At, B0); PG8_BAR; PG8_SCHED;
            PG8_STAGE(PG8_SB(0, 1), b2 + hstep, voffB);
            PG8_WAIT_V(6); PG8_BAR; PG8_MMA(1, 1, At, B1); PG8_BAR;
            PG8_LDB(B0, 1, 0); PG8_SCHED; PG8_LDA(At, 1, 0); PG8_STAGE(PG8_SA(0, 1), a2 + hstep, voffA);
            PG8_WAIT_L(8); PG8_BAR; PG8_WAIT_L(0); PG8_MMA(0, 0, At, B0); PG8_BAR; PG8_SCHED;
            PG8_LDB(B1, 1, 1); PG8_STAGE(PG8_SB(1, 0), b3, voffB);
            PG8_BAR; PG8_WAIT_L(0); PG8_MMA(0, 1, At, B1); PG8_BAR;
            PG8_LDA(At, 1, 1); PG8_STAGE(PG8_SA(1, 0), a3, voffA);
            PG8_BAR; PG8_WAIT_L(0); PG8_MMA(1, 0, At, B0); PG8_BAR; PG8_SCHED;
            PG8_STAGE(PG8_SB(1, 1), b3 + hstep, voffB);
            PG8_WAIT_V(6); PG8_BAR; PG8_MMA(1, 1, At, B1); PG8_BAR;
            }
        }
        if constexpr (ALIGN_EPI) { if (wr == 0) PG8_BAR; }
        if constexpr (!Epi::AFTER_DRAIN) { E(acc, cur, wr, wc, fr, fq); S.done(cur); }
        if (!has_next) break;
#pragma unroll
        for (int a = 0; a < 2; ++a)
#pragma unroll
            for (int b = 0; b < 2; ++b)
#pragma unroll
                for (int m = 0; m < 4; ++m)
#pragma unroll
                    for (int n = 0; n < 2; ++n) acc[a][b][m][n] = (f32x4){0.f, 0.f, 0.f, 0.f};
        cur = nxt; cA = nA; cB = nB; ++ui;
#pragma unroll
        for (int h_ = 0; h_ < 2; ++h_)
#pragma unroll
            for (int i_ = 0; i_ < 2; ++i_) vAc[h_][i_] = vAn[h_][i_];
        if constexpr (ALIGN_EPI) { if (wr == 1) PG8_BAR; }
    }
    PG8_WAIT_V(0);
    if constexpr (!ALIGN_EPI) { if (wr == 0) PG8_BAR; }
    PG8_BAR;
    if constexpr (Epi::AFTER_DRAIN) { E.fused(acc, cur, wr, wc, fr, fq, lds, wid, lane); S.done(cur); }
#undef PG8_SA
#undef PG8_SB
#undef PG8_STAGE
#undef PG8_STAGE_A
#undef PG8_AOFF
#undef PG8_LDA
#undef PG8_LDB
#undef PG8_MMA
#undef PG8_WAIT_V
#undef PG8_WAIT_L
#undef PG8_BAR
#undef PG8_SCHED
}
}


constexpr int TAB_OFF = 131072;
DI void build_tables(const Params& p, char* lds) {
  int* T = (int*)(lds + TAB_OFF); unsigned char* te = (unsigned char*)(T + 80);
  __syncthreads();
  if (tid_() == 0) {
    int acc = 0;
    for (int e = 0; e < NEXP; ++e) { const int c = ws_cnt(p)[e]; T[e] = c; T[32 + e] = acc; const int nt = (c + 255) >> 8; for (int k = 0; k < nt; ++k) te[acc + k] = (unsigned char)e; acc += nt; }
    T[64] = acc;
  }
  __syncthreads();
}
template <bool GATHER_> struct GroupOrderT { static constexpr bool GATHER = GATHER_; const int* T; const unsigned char* te; int G, c; const int* list;
  DI bool next(int i, pg8::Unit& u) const { const int L = i * G + c; if (L >= T[64] * 4) return false; u.pm = L >> 2; u.pn = L & 3; u.e = te[u.pm]; return true; }
  DI void a_ready(const pg8::Unit&) const {}
  DI void done(const pg8::Unit&) const {}
  DI int arow(const pg8::Unit& u, int r) const {
    const int slot = (u.pm - T[32 + u.e]) * 256 + r; return slot < T[u.e] ? (list[u.e * LCAP + slot] >> 1) : 0; } };
typedef GroupOrderT<false> GroupOrder;

struct EpiProjP { static constexpr bool PERM = true, AFTER_DRAIN = false; bf16_t* O; int ldc;
  DI void operator()(const f32x4 (&acc)[2][2][4][2], const pg8::Unit& u, int wr, int wc, int fr, int fq) const {
    const int row0 = u.pm * 256 + wr * 64 + fr, col0 = u.pn * 256 + wc * 32 + 8 * fq;
#pragma unroll
    for (int ai = 0; ai < 2; ++ai)
#pragma unroll
      for (int m = 0; m < 4; ++m) { bf16_t* rowp = O + (size_t)(row0 + ai * 128 + m * 16) * ldc + col0;
#pragma unroll
        for (int bj = 0; bj < 2; ++bj) { const f32x4 v0 = acc[ai][bj][m][0] + 0.0f, v1 = acc[ai][bj][m][1] + 0.0f;
          u32x4 w; w.x = cvtpk(v0[0], v0[1]); w.y = cvtpk(v0[2], v0[3]); w.z = cvtpk(v1[0], v1[1]); w.w = cvtpk(v1[2], v1[3]);
          *(u32x4*)(rowp + bj * 128) = w; } }
  } };
DI void phase2_pg8(const Params& p, int bid, int nb, char* lds) {
  pg8::Gemm g{ws_h1(p), ws_wtin(p), NTOK, PROJ_LD, DM, 0};
  pg8::StaticOrder S; S.init(NTOK, PROJ_LD, nb, bid);
  EpiProjP E{ws_proj(p), PROJ_LD};
  __syncthreads();
  pg8::gemm_phase<EpiProjP, pg8::StaticOrder, true, true>((PG8_LAS unsigned char*)lds, g, S, E);
  __syncthreads();
}
struct EpiResidP { static constexpr bool PERM = false, AFTER_DRAIN = false; const float* x; const float* mod; float* o;
  DI void operator()(const f32x4 (&acc)[2][2][4][2], const pg8::Unit& u, int wr, int wc, int fr, int fq) const {
    const int row0 = u.pm * 256 + wr * 64 + fr, col0 = u.pn * 256 + wc * 32 + 4 * fq;
#pragma unroll
    for (int ai = 0; ai < 2; ++ai)
#pragma unroll
      for (int m = 0; m < 4; ++m) { const int row = row0 + ai * 128 + m * 16, b = row >> 11;
#pragma unroll
        for (int bj = 0; bj < 2; ++bj)
#pragma unroll
          for (int n = 0; n < 2; ++n) { const int col = col0 + bj * 128 + n * 16; const size_t idx = (size_t)row * DM + col;
            const f32x4 xv = *(const f32x4*)(x + idx), gv = *(const f32x4*)(mod + b * 6144 + 2048 + col);
            *(f32x4*)(o + idx) = xv + (gv + 1.0f) * acc[ai][bj][m][n]; } }
  } };
DI void phase6_pg8(const Params& p, int bid, int nb, char* lds) {
  pg8::Gemm g{ws_mix(p), ws_wtout(p), NTOK, DM, DM, 0};
  pg8::StaticOrder S; S.init(NTOK, DM, nb, bid);
  EpiResidP E{p.x, ws_mod(p), ws_x1(p)};
  __syncthreads();
  pg8::gemm_phase<EpiResidP, pg8::StaticOrder, true, true>((PG8_LAS unsigned char*)lds, g, S, E);
  __syncthreads();
}
DI bf16_t* ws_h2s(const Params& p) { return (bf16_t*)(p.ws + OFF_C); }
DI bf16_t* ws_hidp(const Params& p) { return (bf16_t*)(p.ws + OFF_F); }
DI void phase7c(const Params& p, int bid, int nb, char* lds) {
  build_tables(p, lds);
  const int* T = (const int*)(lds + TAB_OFF);
  const int lane = tid_() & 63, gw = bid * 8 + (tid_() >> 6), nw = nb * 8;
  for (int e = 0; e < NEXP; ++e) {
    const int c = T[e]; const size_t r0 = (size_t)T[32 + e] * 256;
    for (int r = gw; r < c; r += nw) {
      const int tok = ws_list(p)[e * LCAP + r] >> 1;
      const u32x4* src = (const u32x4*)(ws_h2(p) + (size_t)tok * DM); u32x4* dst = (u32x4*)(ws_h2s(p) + (r0 + r) * DM);
      dst[lane] = src[lane]; dst[lane + 64] = src[lane + 64];
    }
  }
}
struct EpiSwiGLU { static constexpr bool PERM = true, AFTER_DRAIN = false; bf16_t* O;
  DI void operator()(const f32x4 (&acc)[2][2][4][2], const pg8::Unit& u, int wr, int wc, int fr, int fq) const {
    const int row0 = u.pm * 256 + wr * 64 + fr, col0 = u.pn * 128 + wc * 32 + 8 * fq;
#pragma unroll
    for (int ai = 0; ai < 2; ++ai)
#pragma unroll
      for (int m = 0; m < 4; ++m) {
        float hv[8];
#pragma unroll
        for (int n = 0; n < 2; ++n)
#pragma unroll
          for (int i = 0; i < 4; ++i) { const float gt = acc[ai][0][m][n][i], up = acc[ai][1][m][n][i]; hv[n * 4 + i] = gt / (1.0f + __expf(-gt)) * up; }
        u32x4 w; w.x = cvtpk(hv[0], hv[1]); w.y = cvtpk(hv[2], hv[3]); w.z = cvtpk(hv[4], hv[5]); w.w = cvtpk(hv[6], hv[7]);
        *(u32x4*)(O + (size_t)(row0 + ai * 128 + m * 16) * DEXP + col0) = w; }
  } };
DI void phase8_pg8(const Params& p, int bid, int nb, char* lds) {
  build_tables(p, lds);
  pg8::Gemm g{ws_h2(p), ws_wgu(p), 0, 1024, DM, (size_t)1024 * 1024 * 2};
  GroupOrderT<true> S{(const int*)(lds + TAB_OFF), (const unsigned char*)((const int*)(lds + TAB_OFF) + 80), nb, bid, ws_list(p)};
  EpiSwiGLU E{ws_hidp(p)};
  pg8::gemm_phase<EpiSwiGLU, GroupOrderT<true>, true, true>((PG8_LAS unsigned char*)lds, g, S, E);
  __syncthreads();
}
struct EpiYP { static constexpr bool PERM = true, AFTER_DRAIN = false; bf16_t* O; const int* list; const float* wa; const int* T;
  DI void operator()(const f32x4 (&acc)[2][2][4][2], const pg8::Unit& u, int wr, int wc, int fr, int fq) const {
    const int cnt = T[u.e], rbase = (u.pm - T[32 + u.e]) * 256 + wr * 64 + fr, col0 = u.pn * 256 + wc * 32 + 8 * fq;
#pragma unroll
    for (int ai = 0; ai < 2; ++ai)
#pragma unroll
      for (int m = 0; m < 4; ++m) { const int r = rbase + ai * 128 + m * 16;
        if (r < cnt) { const int aid = list[u.e * LCAP + r]; const float wv = wa[aid]; bf16_t* rowp = O + (size_t)aid * DM + col0;
#pragma unroll
          for (int bj = 0; bj < 2; ++bj) { const f32x4 v0 = acc[ai][bj][m][0] * wv, v1 = acc[ai][bj][m][1] * wv;
            u32x4 w; w.x = cvtpk(v0[0], v0[1]); w.y = cvtpk(v0[2], v0[3]); w.z = cvtpk(v1[0], v1[1]); w.w = cvtpk(v1[2], v1[3]);
            *(u32x4*)(rowp + bj * 128) = w; } } }
  } };
DI void phase9_pg8(const Params& p, int bid, int nb, char* lds) {
  build_tables(p, lds);
  pg8::Gemm g{ws_hidp(p), ws_wd(p), 0, 1024, DEXP, (size_t)1024 * 512 * 2};
  GroupOrder S{(const int*)(lds + TAB_OFF), (const unsigned char*)((const int*)(lds + TAB_OFF) + 80), nb, bid, nullptr};
  EpiYP E{ws_ybuf(p), ws_list(p), ws_wa(p), (const int*)(lds + TAB_OFF)};
  pg8::gemm_phase<EpiYP, GroupOrder, true, true>((PG8_LAS unsigned char*)lds, g, S, E);
  __syncthreads();
}

typedef float f32x4m __attribute__((ext_vector_type(4)));
constexpr int H_LD = 1028;
DI void split8(const float* x, bf16x8& hi, bf16x8& lo) {
  u32x4 wh, wl; float r[8];
  wh.x = cvtpk(x[0], x[1]); wh.y = cvtpk(x[2], x[3]); wh.z = cvtpk(x[4], x[5]); wh.w = cvtpk(x[6], x[7]);
  r[0] = x[0] - __uint_as_float(wh.x << 16); r[1] = x[1] - __uint_as_float(wh.x & 0xffff0000u); r[2] = x[2] - __uint_as_float(wh.y << 16); r[3] = x[3] - __uint_as_float(wh.y & 0xffff0000u);
  r[4] = x[4] - __uint_as_float(wh.z << 16); r[5] = x[5] - __uint_as_float(wh.z & 0xffff0000u); r[6] = x[6] - __uint_as_float(wh.w << 16); r[7] = x[7] - __uint_as_float(wh.w & 0xffff0000u);
  wl.x = cvtpk(r[0], r[1]); wl.y = cvtpk(r[2], r[3]); wl.z = cvtpk(r[4], r[5]); wl.w = cvtpk(r[6], r[7]);
  hi = *reinterpret_cast<bf16x8*>(&wh); lo = *reinterpret_cast<bf16x8*>(&wl);
}
DI void phase7(const Params& p, int bid, int nb, char* lds) {
  const int t = tid_(), lane = t & 63, wid = t >> 6, l16 = lane & 15, lg4 = lane >> 4;
  float* H = (float*)lds;
  float* part = H + 16 * H_LD;
  float* lgt = part + 8 * 16 * 48;
  int* ecnt = (int*)(lgt + 16 * 16 * 48);
  int* ebase = ecnt + 32;
  int* sl_aid = ebase + 32;
  int* sl_e = sl_aid + 512;
  const float* mod = ws_mod(p);
  if (t < NEXP) ecnt[t] = 0;
  int nloc = 0;
  bf16x8 rbh[4][3], rbl[4][3];
  {
#pragma unroll
    for (int ks = 0; ks < 4; ++ks)
#pragma unroll
      for (int nt = 0; nt < 3; ++nt) {
        float w[8];
#pragma unroll
        for (int j = 0; j < 8; ++j) { const int k = wid * 128 + ks * 32 + lg4 * 8 + j;
          w[j] = (nt < 2) ? p.w_expert[(size_t)k * 32 + nt * 16 + l16] : ((l16 < 4) ? p.w_group[(size_t)k * 4 + (l16 & 3)] : 0.f); }
        split8(w, rbh[ks][nt], rbl[ks][nt]);
      }
  }
  f32x4 pv[2][4];
#define P7_PF(tile_) do { _Pragma("unroll") for (int q_ = 0; q_ < 2; ++q_) { const float* xr_ = ws_x1(p) + (size_t)((tile_) * 16 + wid * 2 + q_) * DM + lane * 4; \
      _Pragma("unroll") for (int i_ = 0; i_ < 4; ++i_) pv[q_][i_] = *(const f32x4*)(xr_ + 256 * i_); } } while (0)
  if (bid < NTOK / 16) P7_PF(bid);
  for (int tile = bid; tile < NTOK / 16; tile += nb) {
    __syncthreads();
#pragma unroll
    for (int q = 0; q < 2; ++q) {
      const int tl = wid * 2 + q, gt = tile * 16 + tl, b = gt >> 11;
      f32x4 v[4]; float ss = 0.f;
#pragma unroll
      for (int i = 0; i < 4; ++i) { v[i] = pv[q][i]; ss += v[i][0] * v[i][0] + v[i][1] * v[i][1] + v[i][2] * v[i][2] + v[i][3] * v[i][3]; }
      ss = wave_sum(ss);
      const float rstd = rsqrtf(ss * (1.0f / DM) + 1e-6f);
#pragma unroll
      for (int i = 0; i < 4; ++i) {
        const int col = lane * 4 + 256 * i;
        const f32x4 g = *(const f32x4*)(p.norm2_g + col), sh = *(const f32x4*)(mod + b * 6144 + 3072 + col), sc = *(const f32x4*)(mod + b * 6144 + 4096 + col);
        f32x4 o;
#pragma unroll
        for (int j = 0; j < 4; ++j) o[j] = v[i][j] * rstd * g[j] * (1.0f + sc[j]) + sh[j];
        *(f32x4*)(H + tl * H_LD + col) = o;
        u32x2 w; w.x = cvtpk(o[0], o[1]); w.y = cvtpk(o[2], o[3]);
        *(u32x2*)(ws_h2(p) + (size_t)gt * DM + col) = w;
      }
    }
    if (tile + nb < NTOK / 16) P7_PF(tile + nb);
    __syncthreads();
    {
      f32x4m acc0 = {0.f, 0.f, 0.f, 0.f}, acc1 = acc0, acc2 = acc0;
      const float* hrow = H + l16 * H_LD + wid * 128 + lg4 * 8;
#pragma unroll
      for (int ks = 0; ks < 4; ++ks) {
        const f32x4 h0 = *(const f32x4*)(hrow + ks * 32), h1 = *(const f32x4*)(hrow + ks * 32 + 4);
        const float hv[8] = {h0[0], h0[1], h0[2], h0[3], h1[0], h1[1], h1[2], h1[3]};
        bf16x8 ah, al; split8(hv, ah, al);
        acc0 = __builtin_amdgcn_mfma_f32_16x16x32_bf16(al, rbh[ks][0], acc0, 0, 0, 0); acc1 = __builtin_amdgcn_mfma_f32_16x16x32_bf16(al, rbh[ks][1], acc1, 0, 0, 0); acc2 = __builtin_amdgcn_mfma_f32_16x16x32_bf16(al, rbh[ks][2], acc2, 0, 0, 0);
        acc0 = __builtin_amdgcn_mfma_f32_16x16x32_bf16(ah, rbl[ks][0], acc0, 0, 0, 0); acc1 = __builtin_amdgcn_mfma_f32_16x16x32_bf16(ah, rbl[ks][1], acc1, 0, 0, 0); acc2 = __builtin_amdgcn_mfma_f32_16x16x32_bf16(ah, rbl[ks][2], acc2, 0, 0, 0);
        acc0 = __builtin_amdgcn_mfma_f32_16x16x32_bf16(ah, rbh[ks][0], acc0, 0, 0, 0); acc1 = __builtin_amdgcn_mfma_f32_16x16x32_bf16(ah, rbh[ks][1], acc1, 0, 0, 0); acc2 = __builtin_amdgcn_mfma_f32_16x16x32_bf16(ah, rbh[ks][2], acc2, 0, 0, 0);
      }
#pragma unroll
      for (int r = 0; r < 4; ++r) {
        float* pr = part + (wid * 16 + lg4 * 4 + r) * 48;
        pr[l16] = acc0[r]; pr[16 + l16] = acc1[r]; pr[32 + l16] = acc2[r];
      }
    }
    __syncthreads();
    for (int idx = t; idx < 16 * 36; idx += NTHR) {
      const int tok = idx / 36, o = idx % 36;
      float sacc = 0.f;
#pragma unroll
      for (int w = 0; w < 8; ++w) sacc += part[(w * 16 + tok) * 48 + o];
      sacc += (o < 32) ? p.b_expert[o] : p.b_group[o - 32];
      lgt[(nloc * 16 + tok) * 48 + o] = sacc;
    }
    ++nloc;
  }
  __syncthreads();
  for (int idx = t; idx < nloc * 16; idx += NTHR) {
    {
      const int kl = idx >> 4, t16 = idx & 15, tile = bid + kl * nb;
      const float* l = lgt + idx * 48;
      int gs = 0; float gm = l[32];
      for (int g = 1; g < 4; ++g) if (l[32 + g] > gm) { gm = l[32 + g]; gs = g; }
      float gsum = 0.f;
      for (int g = 0; g < 4; ++g) gsum += expf(l[32 + g] - gm);
      const float pgroup = 1.0f / gsum;
      const float* el = l + gs * 8;
      float em = el[0];
      for (int e = 1; e < 8; ++e) em = fmaxf(em, el[e]);
      float pe[8], esum = 0.f;
      for (int e = 0; e < 8; ++e) { pe[e] = expf(el[e] - em); esum += pe[e]; }
      for (int e = 0; e < 8; ++e) pe[e] /= esum;
      int i0 = 0;
      for (int e = 1; e < 8; ++e) if (pe[e] > pe[i0]) i0 = e;
      int i1 = (i0 == 0) ? 1 : 0;
      for (int e = 0; e < 8; ++e) if (e != i0 && pe[e] > pe[i1]) i1 = e;
      const float den = pe[i0] + pe[i1];
      const int tok = tile * 16 + t16;
      const int e0 = gs * 8 + i0, e1 = gs * 8 + i1;
      ws_wa(p)[tok * 2] = pgroup * pe[i0] / den; ws_wa(p)[tok * 2 + 1] = pgroup * pe[i1] / den;
      const int slot = kl * 32 + t16 * 2;
      sl_aid[slot] = tok * 2; sl_aid[slot + 1] = tok * 2 + 1;
      sl_e[slot] = e0 | (atomicAdd(ecnt + e0, 1) << 8); sl_e[slot + 1] = e1 | (atomicAdd(ecnt + e1, 1) << 8);
    }
  }
  __syncthreads();
  if (t < NEXP) ebase[t] = ecnt[t] ? atomicAdd(ws_cnt(p) + t, ecnt[t]) : 0;
  __syncthreads();
  for (int sidx = t; sidx < nloc * 32; sidx += NTHR) { const int ev = sl_e[sidx], e = ev & 255, r = ev >> 8; ws_list(p)[e * LCAP + ebase[e] + r] = sl_aid[sidx]; }
}
DI void phase7_tr(const Params& p, int bid, int nb, char* lds) {
  const int t = tid_();
  {
    float* tile = (float*)lds;
    const int ln4 = (t & 31) * 4, lkr = t >> 5, snr = t >> 2, skc = (t & 3) * 16;
#define MOE_TSRC(task_, src_, k0_, n0_, N_) const float* src_; int k0_, n0_, N_; { const int wh_ = (task_) >> 11, q_ = (task_) & 2047, e_ = q_ >> 6, r_ = q_ & 63; \
      if (wh_ < 2) { k0_ = (r_ >> 2) * 64; n0_ = (r_ & 3) * 128; N_ = 512; src_ = (wh_ == 0 ? p.e_gate : p.e_up) + (size_t)e_ * 1024 * 512; } \
      else { k0_ = (r_ >> 3) * 64; n0_ = (r_ & 7) * 128; N_ = 1024; src_ = p.e_down + (size_t)e_ * 512 * 1024; } }
    f32x4 g[4];
    int task = bid;
    if (task < 6144) { MOE_TSRC(task, src, k0, n0, N);
#pragma unroll
      for (int i = 0; i < 4; ++i) g[i] = *(const f32x4*)(src + (size_t)(k0 + lkr + 16 * i) * N + n0 + ln4); }
    for (; task < 6144; task += nb) {
      __syncthreads();
#pragma unroll
      for (int i = 0; i < 4; ++i) { float* d = tile + (lkr + 16 * i) * 129 + ln4; d[0] = g[i][0]; d[1] = g[i][1]; d[2] = g[i][2]; d[3] = g[i][3]; }
      if (task + nb < 6144) { MOE_TSRC(task + nb, src, k0, n0, N);
#pragma unroll
        for (int i = 0; i < 4; ++i) g[i] = *(const f32x4*)(src + (size_t)(k0 + lkr + 16 * i) * N + n0 + ln4); }
      __syncthreads();
      const int which = task >> 11, q = task & 2047, e = q >> 6, r = q & 63;
      float v[16];
#pragma unroll
      for (int j = 0; j < 16; ++j) v[j] = tile[(skc + j) * 129 + snr];
      u32x4 w0, w1;
      w0.x = cvtpk(v[0], v[1]); w0.y = cvtpk(v[2], v[3]); w0.z = cvtpk(v[4], v[5]); w0.w = cvtpk(v[6], v[7]);
      w1.x = cvtpk(v[8], v[9]); w1.y = cvtpk(v[10], v[11]); w1.z = cvtpk(v[12], v[13]); w1.w = cvtpk(v[14], v[15]);
      bf16_t* dst;
      if (which < 2) { const int k0 = (r >> 2) * 64, n = (r & 3) * 128 + snr; dst = ws_wgu(p) + (size_t)e * 1024 * 1024 + (size_t)((n >> 7) * 256 + (n & 127) + which * 128) * 1024 + k0 + skc; }
      else { const int k0 = (r >> 3) * 64, n = (r & 7) * 128 + snr; dst = ws_wd(p) + (size_t)e * 1024 * 512 + (size_t)n * 512 + k0 + skc; }
      *(u32x4*)dst = w0; *(u32x4*)(dst + 8) = w1;
    }
  }
}

struct Seg { int e, r0, cnt, start; };
DI Seg find_seg(const int* cnt, int mtile) {
  Seg s; s.e = -1; int acc = 0, start = 0;
  for (int e = 0; e < NEXP; ++e) { const int c = cnt[e], nt = (c + GBM - 1) / GBM; if (mtile < acc + nt) { s.e = e; s.r0 = (mtile - acc) * GBM; s.cnt = c; s.start = start; return s; } acc += nt; start += c; }
  return s;
}
struct ARowList { const int* list; int r0, cnt; DI int operator()(int r) const { int q = r0 + r; q = q < cnt ? q : cnt - 1; return list[q] >> 1; } };
struct EpiHid { bf16_t* o; int row0, nvalid, col0; DI void operator()(int r, int c, float g, float u) const {
  if (r < nvalid) o[(size_t)(row0 + r) * DEXP + ((col0 + c) >> 6) * 32 + (c & 31)] = f2bf(g / (1.0f + __expf(-g)) * u); } };
DI void phase8(const Params& p, int bid, int nb, char* lds) {
  const int* cnt = ws_cnt(p);
  for (int tile = bid; tile < 288 * 8; tile += nb) {
    const Seg s = find_seg(cnt, tile >> 3);
    if (s.e < 0) break;
    const int nt = tile & 7;
    gemm_tile(ws_h2(p), DM, ARowList{ws_list(p) + s.e * LCAP, s.r0, s.cnt}, ws_wgu(p) + (size_t)s.e * 1024 * 1024, DM, nt * GBN, DM,
              EpiHid{ws_hid(p), s.start + s.r0, s.cnt - s.r0, nt * GBN}, lds);
  }
}
struct ARowClamp { int base, r0, cnt; DI int operator()(int r) const { int q = r0 + r; q = q < cnt ? q : cnt - 1; return base + q; } };
struct EpiY { bf16_t* o; const int* list; const float* wa; int r0, cnt, col0; DI void operator()(int r, int c, float v0, float v1) const {
  if (r0 + r < cnt) { const int aid = list[r0 + r]; const float w = wa[aid]; bf16_t* q = o + (size_t)aid * DM + col0 + c; q[0] = f2bf(v0 * w); q[32] = f2bf(v1 * w); } } };
DI void phase9(const Params& p, int bid, int nb, char* lds) {
  const int* cnt = ws_cnt(p);
  for (int tile = bid; tile < 288 * 8; tile += nb) {
    const Seg s = find_seg(cnt, tile >> 3);
    if (s.e < 0) break;
    const int nt = tile & 7;
    gemm_tile(ws_hid(p), DEXP, ARowClamp{s.start, s.r0, s.cnt}, ws_wd(p) + (size_t)s.e * 1024 * 512, DEXP, nt * GBN, DEXP,
              EpiY{ws_ybuf(p), ws_list(p) + s.e * LCAP, ws_wa(p), s.r0, s.cnt, nt * GBN}, lds);
  }
}

DI void phase10(const Params& p, int bid, int nb, char* lds) {
  const int lane = tid_() & 63, wid = tid_() >> 6;
  const float* mod = ws_mod(p); const float* fm = ws_fmod(p);
  for (int gt = bid * 8 + wid; gt < NTOK; gt += nb * 8) {
    const int b = gt >> 11;
    const float* xr = ws_x1(p) + (size_t)gt * DM; float* xo = p.out + (size_t)gt * DM;
    const bf16_t* ya = ws_ybuf(p) + (size_t)(gt * 2) * DM; const bf16_t* yb = ya + DM;
    f32x4 v[4]; float ss = 0.f;
#pragma unroll
    for (int i = 0; i < 4; ++i) {
      const int col = lane * 4 + 256 * i;
      v[i] = *(const f32x4*)(xr + col);
      const u32x2 a = *(const u32x2*)(ya + col), bq = *(const u32x2*)(yb + col);
      const f32x4 g2 = *(const f32x4*)(mod + b * 6144 + 5120 + col);
      const float m0 = __uint_as_float(a.x << 16) + __uint_as_float(bq.x << 16), m1 = __uint_as_float(a.x & 0xffff0000u) + __uint_as_float(bq.x & 0xffff0000u);
      const float m2 = __uint_as_float(a.y << 16) + __uint_as_float(bq.y << 16), m3 = __uint_as_float(a.y & 0xffff0000u) + __uint_as_float(bq.y & 0xffff0000u);
      v[i][0] += (1.0f + g2[0]) * m0; v[i][1] += (1.0f + g2[1]) * m1; v[i][2] += (1.0f + g2[2]) * m2; v[i][3] += (1.0f + g2[3]) * m3;
      ss += v[i][0] * v[i][0] + v[i][1] * v[i][1] + v[i][2] * v[i][2] + v[i][3] * v[i][3];
    }
    ss = wave_sum(ss);
    const float rstd = rsqrtf(ss * (1.0f / DM) + 1e-6f);
#pragma unroll
    for (int i = 0; i < 4; ++i) {
      const int col = lane * 4 + 256 * i;
      const f32x4 g = *(const f32x4*)(p.final_norm_g + col), sh = *(const f32x4*)(fm + b * 2048 + col), sc = *(const f32x4*)(fm + b * 2048 + 1024 + col);
      f32x4 o;
#pragma unroll
      for (int j = 0; j < 4; ++j) o[j] = v[i][j] * rstd * g[j] * (1.0f + sc[j]) + sh[j];
      *(f32x4*)(xo + col) = o;
    }
  }
}

#define XB_TMO      128
#define XB_XCNT(j)  (256  + 64 * (j))
#define XB_XSUB(j)  (1280 + 64 * (j))
#define XB_XGEN(j)  (2304 + 64 * (j))
#define XB_TOP      3328
#define XB_TOPGEN   3392
#define XCD_BAR_WORDS 3456
#define XB_SPIN_CAP (1u << 18)
#define XLAS __attribute__((address_space(3)))

__device__ __forceinline__ unsigned xb_ld(unsigned* p)              { return __hip_atomic_load(p, __ATOMIC_RELAXED, __HIP_MEMORY_SCOPE_AGENT); }
__device__ __forceinline__ unsigned xb_add(unsigned* p, unsigned v) { return __hip_atomic_fetch_add(p, v, __ATOMIC_RELAXED, __HIP_MEMORY_SCOPE_AGENT); }
__device__ __forceinline__ unsigned xb_xcc_id() { return (unsigned)__builtin_amdgcn_s_getreg((3 << 11) | 20) & 0xFu; }
#define XB_SPIN(cond, bar) do { unsigned _sp = 0; while (cond) { __builtin_amdgcn_s_sleep(1); \
    if ((++_sp & 255u) == 0u) { if (xb_ld(&(bar)[XB_TMO])) break; if (_sp > XB_SPIN_CAP) { atomicAdd(&(bar)[XB_TMO], 1u); break; } } } } while (0)

struct XcdBarrier {
    unsigned* bar; unsigned x;
    volatile XLAS unsigned* st;
};

__device__ __forceinline__ XcdBarrier xcd_barrier_post(unsigned* bar, volatile XLAS unsigned* st) {
    XcdBarrier b; b.bar = bar; b.x = xb_xcc_id(); b.st = st;
    if (threadIdx.x == 0) (void)xb_add(&bar[XB_XCNT(b.x)], 1u);
    return b;
}
__device__ __forceinline__ void xcd_barrier_complete(unsigned* bar, unsigned x, unsigned& nloc, unsigned& nx) {
    const unsigned G = gridDim.x * gridDim.y * gridDim.z;
    unsigned sum, cnt, mine, sp = 0u;
    for (;;) {
        sum = 0u; cnt = 0u; mine = 0u;
#pragma unroll
        for (unsigned j = 0; j < 16; ++j) { const unsigned c = xb_ld(&bar[XB_XCNT(j)]); sum += c; cnt += (c > 0u) ? 1u : 0u; mine = (j == x) ? c : mine; }
        if (sum == G) break;
        __builtin_amdgcn_s_sleep(1);
        if ((++sp & 255u) == 0u) { if (xb_ld(&bar[XB_TMO])) break; if (sp > XB_SPIN_CAP) { atomicAdd(&bar[XB_TMO], 1u); break; } }
    }
    nloc = mine > 0u ? mine : 1u; nx = cnt > 0u ? cnt : 1u;
}

__device__ __forceinline__ void xcd_barrier(const XcdBarrier& b) {
    asm volatile("s_waitcnt vmcnt(0)" ::: "memory");
    __syncthreads();
    if (threadIdx.x == 0) {
        unsigned* bar = b.bar;
        __builtin_amdgcn_s_waitcnt(0);
        unsigned nloc = b.st[0], nx = b.st[1];
        if (nloc == 0u) { xcd_barrier_complete(bar, b.x, nloc, nx); b.st[0] = nloc; b.st[1] = nx; }
        const unsigned old = xb_add(&bar[XB_XSUB(b.x)], 1u);
        const unsigned gen = old / nloc;
        if (old + 1u == (gen + 1u) * nloc) {
            __builtin_amdgcn_fence(__ATOMIC_RELEASE, "agent");
            asm volatile("s_waitcnt vmcnt(0)" ::: "memory");
            const unsigned og = xb_add(&bar[XB_TOP], 1u);
            const unsigned tg = og / nx;
            if (og + 1u == (tg + 1u) * nx) xb_add(&bar[XB_TOPGEN], 1u);
            else XB_SPIN(xb_ld(&bar[XB_TOPGEN]) == tg, bar);
            __builtin_amdgcn_fence(__ATOMIC_ACQUIRE, "agent");
            xb_add(&bar[XB_XGEN(b.x)], 1u);
            asm volatile("s_waitcnt vmcnt(0)" ::: "memory");
        } else {
            XB_SPIN(xb_ld(&bar[XB_XGEN(b.x)]) == gen, bar);
            __builtin_amdgcn_fence(__ATOMIC_ACQUIRE, "agent");
            asm volatile("s_waitcnt vmcnt(0)" ::: "memory");
        }
    }
    __syncthreads();
}

#if MEGA
__global__ void __launch_bounds__(NTHR) k_mega(Params p) {
  extern __shared__ __attribute__((aligned(16))) char smem[];
  cg::grid_group grid = cg::this_grid();
  const int bid = blockIdx.x, nb = gridDim.x;
  volatile XLAS unsigned* xst = (volatile XLAS unsigned*)(XLAS char*)(smem + LDS_BYTES - 64);
  if (threadIdx.x < 4) xst[threadIdx.x] = 0u;
  if (bid == 0) for (int i = threadIdx.x; i < XCD_BAR_WORDS; i += NTHR) ws_bar(p)[i] = 0u;
  phase0(p, bid, nb, smem);
  grid.sync();
  XcdBarrier xb = xcd_barrier_post(ws_bar(p), xst);
#define SEAM() xcd_barrier(xb)
  phase1(p, bid, nb, smem); SEAM();
  phase2_pg8(p, bid, nb, smem); SEAM();
  phase3_mfma<3>(p, bid, nb, smem); SEAM();
  phase4a_chunk(p, bid, nb, smem); phase4b_mfma(p, bid, nb, smem); SEAM();
  phase5a(p, bid, nb, smem); phase5b_mfma(p, bid, nb, smem); SEAM();
  phase6_pg8(p, bid, nb, smem); SEAM();
  phase7(p, bid, nb, smem); SEAM();
  phase8_pg8(p, bid, nb, smem); SEAM();
  phase9_pg8(p, bid, nb, smem); SEAM();
  phase10(p, bid, nb, smem);
}
#else
#define PHASE_KERNEL(name, body) __global__ void __launch_bounds__(NTHR) name(Params p) { extern __shared__ __attribute__((aligned(16))) char smem[]; body(p, blockIdx.x, gridDim.x, smem); }
PHASE_KERNEL(k_phase0, phase0)
PHASE_KERNEL(k_phase1, phase1)
PHASE_KERNEL(k_phase2, phase2)
PHASE_KERNEL(k_phase3a, phase3a)
PHASE_KERNEL(k_phase3b, phase3b)
PHASE_KERNEL(k_phase4a, phase4a)
PHASE_KERNEL(k_phase4a2, phase4a_v2)
PHASE_KERNEL(k_phase4a3, phase4a_v3)
PHASE_KERNEL(k_phase4b, phase4b)
PHASE_KERNEL(k_phase4bm, phase4b_mfma)
PHASE_KERNEL(k_phase3m, phase3_mfma<3>)
PHASE_KERNEL(k_phase5a, phase5a)
PHASE_KERNEL(k_phase5b, phase5b)
PHASE_KERNEL(k_phase5bm, phase5b_mfma)
PHASE_KERNEL(k_phase6, phase6)
PHASE_KERNEL(k_phase7, phase7)
PHASE_KERNEL(k_phase8, phase8)
PHASE_KERNEL(k_phase9, phase9)
PHASE_KERNEL(k_phase10, phase10)
#endif

extern "C" void kernel_launch(void* const* d_in, const int* in_sizes, int n_in, void* d_out, int out_size, void* d_ws, size_t ws_size, hipStream_t stream) {
  Params p{};
  const float** f = (const float**)&p;
  for (int i = 0; i < 33; ++i) f[i] = (const float*)d_in[i];
  p.out = (float*)d_out; p.ws = (char*)d_ws;
  if (n_in != 33 || ws_size < (size_t)(OFF_S + 9 * MiB) || out_size != NTOK * DM) { fprintf(stderr, "kernel_launch: unexpected problem shape or workspace (n_in %d, ws %zu, out %d)\n", n_in, ws_size, out_size); return; }
#if MEGA
  static int grid_blocks = 0;
  if (!grid_blocks) {
    int dev = 0, cus = 0, per_cu = 0;
    hipGetDevice(&dev);
    hipDeviceGetAttribute(&cus, hipDeviceAttributeMultiprocessorCount, dev);
    hipFuncSetAttribute((const void*)k_mega, hipFuncAttributeMaxDynamicSharedMemorySize, LDS_BYTES);
    hipOccupancyMaxActiveBlocksPerMultiprocessor(&per_cu, k_mega, NTHR, LDS_BYTES);
    if (per_cu > 1) per_cu = 1;
    grid_blocks = cus * per_cu;
  }
  void* args[] = {&p};
  hipError_t e = hipLaunchCooperativeKernel((void*)k_mega, dim3(grid_blocks), dim3(NTHR), args, LDS_BYTES, stream);
  if (e != hipSuccess) fprintf(stderr, "cooperative launch failed: %s (grid %d)\n", hipGetErrorString(e), grid_blocks);
#else
  const int G = 512;
#define LAUNCH(k, g) hipLaunchKernelGGL(k, dim3(g), dim3(NTHR), LDS_BYTES, stream, p)
  LAUNCH(k_phase0, G);
  LAUNCH(k_phase1, G);
  LAUNCH(k_phase2, G);
  LAUNCH(k_phase3a, G);
  LAUNCH(k_phase3b, G);
  LAUNCH(k_phase4a, 128);
  LAUNCH(k_phase4b, 1024);
  LAUNCH(k_phase5a, G);
  LAUNCH(k_phase5b, 1024);
  LAUNCH(k_phase6, G);
  LAUNCH(k_phase7, G);
  LAUNCH(k_phase8, G);
  LAUNCH(k_phase9, G);
  LAUNCH(k_phase10, G);
#endif
}
```

```cpp
#include <hip/hip_runtime.h>
#include <hip/hip_cooperative_groups.h>
#include <stdint.h>
#include <stdio.h>

namespace cg = cooperative_groups;

#ifndef MEGA
#define MEGA 1
#endif

typedef unsigned short bf16_t;
typedef short bf16x8 __attribute__((ext_vector_type(8)));
typedef float f32x16 __attribute__((ext_vector_type(16)));
typedef float f32x4 __attribute__((ext_vector_type(4)));
typedef float f32x4v __attribute__((ext_vector_type(4)));
typedef unsigned u32x4 __attribute__((ext_vector_type(4)));
typedef unsigned u32x2 __attribute__((ext_vector_type(2)));

#define DI __device__ __forceinline__

constexpr int DM = 1024, BATCH = 16, SEQ = 2048, NTOK = BATCH * SEQ;
constexpr int RW = 512, NH = 8, HD = 64;
constexpr int PROJ_N = 2756, PROJ_LD = 2816;
constexpr int C_R = 0, C_K = 512, C_V = 1024, C_WL = 1536, C_AL = 1600, C_GL = 1664;
constexpr int C_Q = 1792, C_CKV = 2304, C_QI = 2432, C_KI = 2688, C_WI = 2752;
constexpr int NEXP = 32, DEXP = 512, LCAP = 32768;
constexpr int NTHR = 512;
constexpr int LDS_BYTES = 163840;

constexpr size_t MiB = 1048576;
constexpr size_t OFF_A = 0;
constexpr size_t OFF_B = 64 * MiB;
constexpr size_t OFF_C = 240 * MiB;
constexpr size_t OFF_F = 400 * MiB;
constexpr size_t OFF_G = 464 * MiB;
constexpr size_t OFF_W = 484 * MiB;
constexpr size_t OFF_S = 492 * MiB;

struct Params {
  const float *x, *c, *ada_w, *ada_b, *norm1_g, *w_in, *shift_mu, *w0, *w_decay_up, *a0, *w_aaa_up, *w_gate_up;
  const float *k_k, *k_a, *r_k, *gn_g, *gn_b, *kv_norm_g, *k_idx_norm_g, *w_uk, *w_uv, *w_out, *norm2_g;
  const float *w_group, *b_group, *w_expert, *b_expert, *e_gate, *e_up, *e_down, *final_ada_w, *final_ada_b, *final_norm_g;
  float* out;
  char* ws;
};

DI int tid_() { int t = threadIdx.x; asm volatile("" : "+v"(t)); return t; }
DI float bf2f(bf16_t u) { return __uint_as_float(((unsigned)u) << 16); }
DI bf16_t f2bf(float f) { unsigned u = __float_as_uint(f); u += 0x7fffu + ((u >> 16) & 1u); return (bf16_t)(u >> 16); }
DI unsigned pack2(float lo, float hi) { return (unsigned)f2bf(lo) | ((unsigned)f2bf(hi) << 16); }
DI float wave_sum(float v) { for (int o = 32; o; o >>= 1) v += __shfl_xor(v, o); return v; }
DI float wave_max(float v) { for (int o = 32; o; o >>= 1) v = fmaxf(v, __shfl_xor(v, o)); return v; }
DI float sigmoidf_(float v) { return 1.0f / (1.0f + __expf(-v)); }
DI int crow(int r, int hi) { return (r & 3) + 8 * (r >> 2) + 4 * hi; }
DI unsigned cvtpk(float lo, float hi) { unsigned r; asm volatile("v_cvt_pk_bf16_f32 %0, %1, %2" : "=v"(r) : "v"(lo), "v"(hi)); return r; }

DI void unpack8(const u32x4 w, float* o) {
  o[0] = __uint_as_float(w.x << 16); o[1] = __uint_as_float(w.x & 0xffff0000u); o[2] = __uint_as_float(w.y << 16); o[3] = __uint_as_float(w.y & 0xffff0000u);
  o[4] = __uint_as_float(w.z << 16); o[5] = __uint_as_float(w.z & 0xffff0000u); o[6] = __uint_as_float(w.w << 16); o[7] = __uint_as_float(w.w & 0xffff0000u);
}
DI void load8(const bf16_t* p, float* o) { unpack8(*(const u32x4*)p, o); }

DI bf16_t* ws_h1(const Params& p) { return (bf16_t*)(p.ws + OFF_A); }
DI float* ws_y(const Params& p) { return (float*)(p.ws + OFF_A); }
DI bf16_t* ws_h2(const Params& p) { return (bf16_t*)(p.ws + OFF_A); }
DI bf16_t* ws_proj(const Params& p) { return (bf16_t*)(p.ws + OFF_B); }
DI float* ws_x1(const Params& p) { return (float*)(p.ws + OFF_B); }
DI bf16_t* ws_wgu(const Params& p) { return (bf16_t*)p.out; }
DI bf16_t* ws_wd(const Params& p) { return (bf16_t*)((char*)p.out + 64 * MiB); }
DI bf16_t* ws_hid(const Params& p) { return (bf16_t*)(p.ws + OFF_B + 96 * MiB); }
DI bf16_t* ws_kp(const Params& p) { return (bf16_t*)(p.ws + OFF_C); }
DI bf16_t* ws_kk(const Params& p) { return (bf16_t*)(p.ws + OFF_C + 32 * MiB); }
DI bf16_t* ws_bb(const Params& p) { return (bf16_t*)(p.ws + OFF_C + 64 * MiB); }
DI bf16_t* ws_ee(const Params& p) { return (bf16_t*)(p.ws + OFF_C + 96 * MiB); }
DI bf16_t* ws_gg(const Params& p) { return (bf16_t*)(p.ws + OFF_C + 128 * MiB); }
DI bf16_t* ws_mix(const Params& p) { return (bf16_t*)(p.ws + OFF_C); }
DI bf16_t* ws_ybuf(const Params& p) { return (bf16_t*)(p.ws + OFF_C); }
DI bf16_t* ws_qlat(const Params& p) { return (bf16_t*)(p.ws + OFF_F); }
DI bf16_t* ws_ckv(const Params& p) { return (bf16_t*)(p.ws + OFF_G); }
DI bf16_t* ws_kidx(const Params& p) { return (bf16_t*)(p.ws + OFF_G + 8 * MiB); }
DI unsigned* ws_mask(const Params& p) { return (unsigned*)(p.ws + OFF_G + 12 * MiB); }
DI bf16_t* ws_wtin(const Params& p) { return (bf16_t*)(p.ws + OFF_W); }
DI bf16_t* ws_wtout(const Params& p) { return (bf16_t*)(p.ws + OFF_W + 6 * MiB); }
DI bf16_t* ws_wuvt(const Params& p) { return (bf16_t*)(p.ws + OFF_S + 7 * MiB); }
DI bf16_t* ws_wdt(const Params& p) { return (bf16_t*)(p.ws + OFF_S + 8 * MiB + 64 * 1024); }
DI bf16_t* ws_wat(const Params& p) { return (bf16_t*)(p.ws + OFF_S + 8 * MiB + 128 * 1024); }
DI bf16_t* ws_wgt(const Params& p) { return (bf16_t*)(p.ws + OFF_S + 8 * MiB + 192 * 1024); }
DI bf16_t* ws_wukt(const Params& p) { return (bf16_t*)(p.ws + OFF_S + 8 * MiB + 320 * 1024); }
DI unsigned* ws_bar(const Params& p) { return (unsigned*)(p.ws + OFF_S + 8 * MiB); }
DI float* ws_mod(const Params& p) { return (float*)(p.ws + OFF_S); }
DI float* ws_fmod(const Params& p) { return (float*)(p.ws + OFF_S + 512 * 1024); }
DI float* ws_bonus(const Params& p) { return (float*)(p.ws + OFF_S + 1 * MiB); }
DI int* ws_cnt(const Params& p) { return (int*)(p.ws + OFF_S + 2 * MiB); }
DI float* ws_wa(const Params& p) { return (float*)(p.ws + OFF_S + 2 * MiB + 4096); }
DI int* ws_list(const Params& p) { return (int*)(p.ws + OFF_S + 3 * MiB); }

template <class RowMap>
DI void transpose_tile(const float* src, int N, int k0, int n0, bf16_t* dst, int dstld, RowMap rm, char* lds) {
  float* tile = (float*)lds;
  const int t = tid_();
  __syncthreads();
  {
    const int nc = t & 63, krb = t >> 6;
#pragma unroll
    for (int i = 0; i < 8; ++i) {
      const int kr = krb + 8 * i;
      const int n = n0 + nc;
      tile[kr * 65 + nc] = (n < N) ? src[(size_t)(k0 + kr) * N + n] : 0.f;
    }
  }
  __syncthreads();
  {
    const int nr = t >> 3, kc = (t & 7) * 8;
    u32x4 w;
    w.x = pack2(tile[(kc + 0) * 65 + nr], tile[(kc + 1) * 65 + nr]);
    w.y = pack2(tile[(kc + 2) * 65 + nr], tile[(kc + 3) * 65 + nr]);
    w.z = pack2(tile[(kc + 4) * 65 + nr], tile[(kc + 5) * 65 + nr]);
    w.w = pack2(tile[(kc + 6) * 65 + nr], tile[(kc + 7) * 65 + nr]);
    *(u32x4*)(dst + (size_t)rm(n0 + nr) * dstld + k0 + kc) = w;
  }
}
struct RowId { DI int operator()(int n) const { return n; } };
struct RowGU { int add; DI int operator()(int n) const { return (n >> 7) * 256 + (n & 127) + add; } };

DI void phase0(const Params& p, int bid, int nb, char* lds) {
  const int t = tid_();
  if (bid == 0 && t < NEXP) ws_cnt(p)[t] = 0;
  for (int idx = bid * NTHR + t; idx < 8 * 64 * 128; idx += nb * NTHR) {
    const int e8 = idx & 7, ln = (idx >> 3) & 63, l32 = ln & 31, lh = ln >> 5;
    { const int hh = idx >> 13, i2 = (idx >> 12) & 1, ks = (idx >> 9) & 7, d = i2 * 32 + l32, cc = ks * 16 + lh * 8 + e8;
      ws_wuvt(p)[idx] = f2bf(p.w_uv[(size_t)(cc * NH + hh) * HD + d]); }
    { const int h2 = idx >> 13, mt = (idx >> 11) & 3, ks = (idx >> 9) & 3, c2 = mt * 32 + l32, d2 = ks * 16 + lh * 8 + e8;
      ws_wukt(p)[idx] = f2bf(p.w_uk[(size_t)(c2 * NH + h2) * HD + d2]); }
  }
  for (int idx = bid * NTHR + t; idx < 512 * 128; idx += nb * NTHR) {
    const int e8 = idx & 7, ln = (idx >> 3) & 63, l32 = ln & 31, lh = ln >> 5;
    { const int ks = (idx >> 9) & 7, mt = (idx >> 12) & 1, hh = idx >> 13, ch = hh * HD + mt * 32 + l32, k = ks * 16 + lh * 8 + e8;
      ws_wgt(p)[idx] = f2bf(p.w_gate_up[(size_t)k * RW + ch]); }
    if (idx < 512 * 64) { const int ks = (idx >> 9) & 3, mt = (idx >> 11) & 1, hh = idx >> 12, ch = hh * HD + mt * 32 + l32, k = ks * 16 + lh * 8 + e8;
      ws_wdt(p)[idx] = f2bf(p.w_decay_up[(size_t)k * RW + ch]); ws_wat(p)[idx] = f2bf(p.w_aaa_up[(size_t)k * RW + ch]); }
  }
  for (int task = bid; task < 256; task += nb) {
    float* cact = (float*)lds;
    __syncthreads();
    for (int i = t; i < 16 * 1024; i += NTHR) { const float v = p.c[i]; cact[i] = v / (1.0f + __expf(-v)); }
    __syncthreads();
    const int col = task * 32 + (t & 31), ks = t >> 5;
    const float* w; int ld, cc;
    if (col < 6144) { w = p.ada_w; ld = 6144; cc = col; } else { w = p.final_ada_w; ld = 2048; cc = col - 6144; }
    float acc[16];
#pragma unroll
    for (int b = 0; b < 16; ++b) acc[b] = 0.f;
    for (int kk = 0; kk < 64; ++kk) {
      const int k = ks * 64 + kk;
      const float wv = w[(size_t)k * ld + cc];
#pragma unroll
      for (int b = 0; b < 16; ++b) acc[b] += cact[b * 1024 + k] * wv;
    }
    __syncthreads();
    float* red = (float*)lds;
#pragma unroll
    for (int b = 0; b < 16; ++b) red[(ks * 16 + b) * 32 + (t & 31)] = acc[b];
    __syncthreads();
    {
      const int b = t >> 5, cl = t & 31, colo = task * 32 + cl;
      float s = 0.f;
      for (int k2 = 0; k2 < 16; ++k2) s += red[(k2 * 16 + b) * 32 + cl];
      if (colo < 6144) ws_mod(p)[b * 6144 + colo] = s + p.ada_b[colo];
      else ws_fmod(p)[b * 2048 + colo - 6144] = s + p.final_ada_b[colo - 6144];
    }
  }
  for (int task = bid; task < 704 + 256; task += nb) {
    if (task < 704) { const int kt = task / 44, nt = task % 44; transpose_tile(p.w_in, PROJ_N, kt * 64, nt * 64, ws_wtin(p), 1024, RowId(), lds); }
    else { const int q = task - 704, kt = q >> 4, nt = q & 15; transpose_tile(p.w_out, 1024, kt * 64, nt * 64, ws_wtout(p), 1024, RowId(), lds); }
  }
}

DI void phase1(const Params& p, int bid, int nb, char* lds) {
  const int lane = tid_() & 63, wid = tid_() >> 6;
  const float* mod = ws_mod(p);
  for (int row = bid * 8 + wid; row < NTOK; row += nb * 8) {
    const int b = row >> 11;
    const float* xr = p.x + (size_t)row * DM;
    f32x4 v[4]; float ss = 0.f;
#pragma unroll
    for (int i = 0; i < 4; ++i) { v[i] = *(const f32x4*)(xr + lane * 4 + 256 * i); ss += v[i][0] * v[i][0] + v[i][1] * v[i][1] + v[i][2] * v[i][2] + v[i][3] * v[i][3]; }
    ss = wave_sum(ss);
    const float rstd = rsqrtf(ss * (1.0f / DM) + 1e-6f);
#pragma unroll
    for (int i = 0; i < 4; ++i) {
      const int col = lane * 4 + 256 * i;
      const f32x4 g = *(const f32x4*)(p.norm1_g + col), sh = *(const f32x4*)(mod + b * 6144 + col), sc = *(const f32x4*)(mod + b * 6144 + 1024 + col);
      float o[4];
#pragma unroll
      for (int j = 0; j < 4; ++j) o[j] = v[i][j] * rstd * g[j] * (1.0f + sc[j]) + sh[j];
      u32x2 w; w.x = pack2(o[0], o[1]); w.y = pack2(o[2], o[3]);
      *(u32x2*)(ws_h1(p) + (size_t)row * DM + col) = w;
    }
  }
}

constexpr int GBM = 256, GBN = 128, GBK = 32, GROW = 80, G_LDSA = GBM * GROW, G_STAGE = (GBM + GBN) * GROW;
template <class ARow, class Epi>
DI void gemm_tile(const bf16_t* A, int lda, ARow arow, const bf16_t* Bt, int ldb, int n0, int K, Epi epi, char* lds) {
  const int t = tid_(), lane = t & 63, wid = t >> 6, wm = wid >> 1, wn = wid & 1, r32 = lane & 31, hi = lane >> 5;
  const int srow = t >> 2, sch = t & 3;
  const bf16_t* a0p = A + (size_t)arow(srow) * lda + sch * 8;
  const bf16_t* a1p = A + (size_t)arow(srow + 128) * lda + sch * 8;
  const bf16_t* bp = Bt + (size_t)(n0 + srow) * ldb + sch * 8;
  const int wa0 = srow * GROW + sch * 16, wa1 = (srow + 128) * GROW + sch * 16, wb = G_LDSA + srow * GROW + sch * 16;
  const int ra = (wm * 64 + r32) * GROW + hi * 16, rb = G_LDSA + (wn * 64 + r32) * GROW + hi * 16;
  f32x16 acc[2][2];
#pragma unroll
  for (int i = 0; i < 2; ++i)
#pragma unroll
    for (int j = 0; j < 2; ++j)
#pragma unroll
      for (int r = 0; r < 16; ++r) acc[i][j][r] = 0.f;
  u32x4 ga0 = *(const u32x4*)a0p, ga1 = *(const u32x4*)a1p, gb = *(const u32x4*)bp;
  __syncthreads();
  *(u32x4*)(lds + wa0) = ga0; *(u32x4*)(lds + wa1) = ga1; *(u32x4*)(lds + wb) = gb;
  __syncthreads();
  const int nk = K / GBK;
  for (int kt = 0; kt < nk; ++kt) {
    char* cur = lds + (kt & 1) * G_STAGE;
    char* nxt = lds + ((kt + 1) & 1) * G_STAGE;
    if (kt + 1 < nk) { ga0 = *(const u32x4*)(a0p + (kt + 1) * GBK); ga1 = *(const u32x4*)(a1p + (kt + 1) * GBK); gb = *(const u32x4*)(bp + (kt + 1) * GBK); }
#pragma unroll
    for (int ks = 0; ks < 2; ++ks) {
      bf16x8 a[2], b[2];
#pragma unroll
      for (int i = 0; i < 2; ++i) { a[i] = *(const bf16x8*)(cur + ra + i * 32 * GROW + ks * 32); b[i] = *(const bf16x8*)(cur + rb + i * 32 * GROW + ks * 32); }
#pragma unroll
      for (int i = 0; i < 2; ++i)
#pragma unroll
        for (int j = 0; j < 2; ++j) acc[i][j] = __builtin_amdgcn_mfma_f32_32x32x16_bf16(a[i], b[j], acc[i][j], 0, 0, 0);
    }
    if (kt + 1 < nk) { *(u32x4*)(nxt + wa0) = ga0; *(u32x4*)(nxt + wa1) = ga1; *(u32x4*)(nxt + wb) = gb; }
    __syncthreads();
  }
#pragma unroll
  for (int i = 0; i < 2; ++i)
#pragma unroll
    for (int r = 0; r < 16; ++r) epi(wm * 64 + i * 32 + crow(r, hi), wn * 64 + r32, acc[i][0][r], acc[i][1][r]);
}

struct ARowBase { int base; DI int operator()(int r) const { return base + r; } };

struct EpiProj { bf16_t* o; int row0, col0; DI void operator()(int r, int c, float v0, float v1) const {
  bf16_t* q = o + (size_t)(row0 + r) * PROJ_LD + col0 + c; q[0] = f2bf(v0); q[32] = f2bf(v1); } };
DI void phase2(const Params& p, int bid, int nb, char* lds) {
  constexpr int NT = PROJ_LD / GBN;
  for (int tile = bid; tile < (NTOK / GBM) * NT; tile += nb) {
    const int mt = tile / NT, nt = tile % NT;
    gemm_tile(ws_h1(p), DM, ARowBase{mt * GBM}, ws_wtin(p), DM, nt * GBN, DM, EpiProj{ws_proj(p), mt * GBM, nt * GBN}, lds);
  }
}

DI float proj_shift(const bf16_t* proj, const float* mu, int gt, int col) {
  const float pv = bf2f(proj[(size_t)gt * PROJ_LD + col]);
  const float pp = (gt & (SEQ - 1)) ? bf2f(proj[(size_t)(gt - 1) * PROJ_LD + col]) : 0.f;
  return pv + mu[col] * (pp - pv);
}
DI void phase3a(const Params& p, int bid, int nb, char* lds) {
  const int t = tid_(), lane = t & 63, wid = t >> 6;
  float* xl = (float*)lds;
  const bf16_t* proj = ws_proj(p);
  for (int tile = bid; tile < NTOK / 16; tile += nb) {
    const int t0 = tile * 16;
    __syncthreads();
    for (int idx = t; idx < 16 * 256; idx += NTHR) {
      const int tok = idx >> 8, col = idx & 255;
      float v = proj_shift(proj, p.shift_mu, t0 + tok, C_WL + col);
      if (col < 64) v = tanhf(v); else if (col >= 128) v = sigmoidf_(v);
      xl[idx] = v;
    }
    __syncthreads();
    const int c = t;
    float acc[16];
#pragma unroll
    for (int i = 0; i < 16; ++i) acc[i] = 0.f;
    for (int k4 = 0; k4 < 16; ++k4) {
      float w[4];
#pragma unroll
      for (int j = 0; j < 4; ++j) w[j] = p.w_decay_up[(k4 * 4 + j) * RW + c];
#pragma unroll
      for (int i = 0; i < 16; ++i) { const f32x4 xv = *(const f32x4*)(xl + i * 256 + k4 * 4); acc[i] += xv[0] * w[0] + xv[1] * w[1] + xv[2] * w[2] + xv[3] * w[3]; }
    }
    {
      const float w0c = p.w0[c];
#pragma unroll
      for (int i = 0; i < 16; ++i) {
        const float z = -(w0c + acc[i]);
        const float sp = fmaxf(z, 0.f) + log1pf(__expf(-fabsf(z)));
        ws_ee(p)[(size_t)(t0 + i) * RW + c] = f2bf(__expf(-sp - 0.5f));
      }
    }
#pragma unroll
    for (int i = 0; i < 16; ++i) acc[i] = 0.f;
    for (int k4 = 0; k4 < 32; ++k4) {
      float w[4];
#pragma unroll
      for (int j = 0; j < 4; ++j) w[j] = p.w_gate_up[(k4 * 4 + j) * RW + c];
#pragma unroll
      for (int i = 0; i < 16; ++i) { const f32x4 xv = *(const f32x4*)(xl + i * 256 + 128 + k4 * 4); acc[i] += xv[0] * w[0] + xv[1] * w[1] + xv[2] * w[2] + xv[3] * w[3]; }
    }
#pragma unroll
    for (int i = 0; i < 16; ++i) ws_gg(p)[(size_t)(t0 + i) * RW + c] = f2bf(acc[i]);
#pragma unroll
    for (int i = 0; i < 16; ++i) acc[i] = 0.f;
    for (int k4 = 0; k4 < 16; ++k4) {
      float w[4];
#pragma unroll
      for (int j = 0; j < 4; ++j) w[j] = p.w_aaa_up[(k4 * 4 + j) * RW + c];
#pragma unroll
      for (int i = 0; i < 16; ++i) { const f32x4 xv = *(const f32x4*)(xl + i * 256 + 64 + k4 * 4); acc[i] += xv[0] * w[0] + xv[1] * w[1] + xv[2] * w[2] + xv[3] * w[3]; }
    }
    {
      const float a0c = p.a0[c], kkc = p.k_k[c], kac = p.k_a[c], rkc = p.r_k[c];
#pragma unroll
      for (int i = 0; i < 16; ++i) {
        const int gt = t0 + i;
        const float a = sigmoidf_(a0c + acc[i]);
        const float r = proj_shift(proj, p.shift_mu, gt, C_R + c);
        const float k = proj_shift(proj, p.shift_mu, gt, C_K + c);
        float kk = k * kkc;
        const float nrm = fmaxf(sqrtf(wave_sum(kk * kk)), 1e-12f);
        kk = kk / nrm;
        const float kp = k * (1.0f + (a - 1.0f) * kac);
        const float bs = wave_sum(r * kp * rkc);
        ws_kp(p)[(size_t)gt * RW + c] = f2bf(kp);
        ws_kk(p)[(size_t)gt * RW + c] = f2bf(kk);
        ws_bb(p)[(size_t)gt * RW + c] = f2bf(kk * a);
        if (lane == 0) ws_bonus(p)[gt * NH + wid] = bs;
      }
    }
  }
}

DI void phase3b(const Params& p, int bid, int nb, char* lds) {
  const int t = tid_(), lane = t & 63, wid = t >> 6;
  float* ql = (float*)lds;
  const bf16_t* proj = ws_proj(p);
  for (int tile = bid; tile < NTOK / 16; tile += nb) {
    const int t0 = tile * 16;
    __syncthreads();
    for (int idx = t; idx < 16 * 512; idx += NTHR) ql[idx] = bf2f(proj[(size_t)(t0 + (idx >> 9)) * PROJ_LD + C_Q + (idx & 511)]);
#pragma unroll
    for (int q = 0; q < 2; ++q) {
      const int gt = t0 + wid * 2 + q;
      const float v0 = bf2f(proj[(size_t)gt * PROJ_LD + C_CKV + lane * 2]), v1 = bf2f(proj[(size_t)gt * PROJ_LD + C_CKV + lane * 2 + 1]);
      const float rs = rsqrtf(wave_sum(v0 * v0 + v1 * v1) * (1.0f / 128.0f) + 1e-6f);
      *(unsigned*)(ws_ckv(p) + (size_t)gt * 128 + lane * 2) = pack2(v0 * rs * p.kv_norm_g[lane * 2], v1 * rs * p.kv_norm_g[lane * 2 + 1]);
      const float u = bf2f(proj[(size_t)gt * PROJ_LD + C_KI + lane]);
      const float rs2 = rsqrtf(wave_sum(u * u) * (1.0f / 64.0f) + 1e-6f);
      ws_kidx(p)[(size_t)gt * 64 + lane] = f2bf(u * rs2 * p.k_idx_norm_g[lane]);
    }
    __syncthreads();
    const int h = wid;
#pragma unroll 1
    for (int ps = 0; ps < 2; ++ps) {
      const int cidx = lane + 64 * ps;
      float w[64];
      const float* wp = p.w_uk + (size_t)(cidx * NH + h) * HD;
#pragma unroll
      for (int d4 = 0; d4 < 16; ++d4) { const f32x4 wv = *(const f32x4*)(wp + d4 * 4); w[d4 * 4] = wv[0]; w[d4 * 4 + 1] = wv[1]; w[d4 * 4 + 2] = wv[2]; w[d4 * 4 + 3] = wv[3]; }
#pragma unroll 1
      for (int i = 0; i < 16; ++i) {
        float acc = 0.f;
#pragma unroll
        for (int d4 = 0; d4 < 16; ++d4) { const f32x4 qv = *(const f32x4*)(ql + i * 512 + h * 64 + d4 * 4); acc += qv[0] * w[d4 * 4] + qv[1] * w[d4 * 4 + 1] + qv[2] * w[d4 * 4 + 2] + qv[3] * w[d4 * 4 + 3]; }
        ws_qlat(p)[((size_t)(t0 + i) * NH + h) * 128 + cidx] = f2bf(acc * 0.125f);
      }
    }
  }
}

DI float xhalf_sum(float v) { auto rr = __builtin_amdgcn_permlane32_swap(__float_as_uint(v), __float_as_uint(v), false, false); return __uint_as_float(rr[0]) + __uint_as_float(rr[1]); }
DI float dpp_sum8(float v) {
  v += __int_as_float(__builtin_amdgcn_update_dpp(0, __float_as_int(v), 0xB1, 0xF, 0xF, true));
  v += __int_as_float(__builtin_amdgcn_update_dpp(0, __float_as_int(v), 0x4E, 0xF, 0xF, true));
  v += __int_as_float(__builtin_amdgcn_update_dpp(0, __float_as_int(v), 0x141, 0xF, 0xF, true));
  return v;
}
DI float dpp_sum16b(float v) { v = dpp_sum8(v); v += __int_as_float(__builtin_amdgcn_update_dpp(0, __float_as_int(v), 0x140, 0xF, 0xF, true)); return v; }
DI u32x2 pk4(float a, float b, float c, float d) { u32x2 w; w.x = cvtpk(a, b); w.y = cvtpk(c, d); return w; }
DI void ld4(const bf16_t* p, float* o) { const u32x2 w = *(const u32x2*)p; o[0] = __uint_as_float(w.x << 16); o[1] = __uint_as_float(w.x & 0xffff0000u); o[2] = __uint_as_float(w.y << 16); o[3] = __uint_as_float(w.y & 0xffff0000u); }
constexpr int XL_ROW = 528;
template <int MODE> DI void phase3_mfma(const Params& p, int bid, int nb, char* lds) {
  const int t_ = tid_(), wid = t_ >> 6, h = wid;
  const bf16_t* proj = ws_proj(p);
  float* PL = (float*)(lds + 64 * XL_ROW + 8 * 14336);
  static_assert(64 * XL_ROW + 8 * 14336 + 7 * 512 * 4 <= LDS_BYTES - 64, "prep LDS map");
  for (int i = t_; i < RW; i += NTHR) { PL[i] = p.w0[i]; PL[512 + i] = p.a0[i]; PL[1024 + i] = p.k_k[i]; PL[1536 + i] = p.k_a[i]; PL[2048 + i] = p.r_k[i]; PL[2560 + i] = p.shift_mu[C_R + i]; PL[3072 + i] = p.shift_mu[C_K + i]; }
  for (int tile = bid; tile < NTOK / 64; tile += nb) {
    const int t0 = tile * 64;
    int t = t_;
    asm volatile("" : "+v"(t));
    const int lane = t & 63, r32_ = lane & 31, hi_ = lane >> 5;
    __syncthreads();
#pragma unroll
    for (int i = 0; i < 4; ++i) {
      const int id = t + 512 * i, tok = id >> 5, cc = (id & 31) * 8, gt = t0 + tok;
      float v[8], pv[8];
      const bool firstt = (gt & (SEQ - 1)) == 0;
      load8(proj + (unsigned)(gt * PROJ_LD + C_WL + cc), v);
      load8(proj + (unsigned)((firstt ? gt : gt - 1) * PROJ_LD + C_WL + cc), pv);
      const f32x4 m0 = *(const f32x4*)(p.shift_mu + C_WL + cc), m1 = *(const f32x4*)(p.shift_mu + C_WL + cc + 4);
      const float esc = (cc < 64) ? 2.0f : -1.0f;
      float x[8];
#pragma unroll
      for (int j = 0; j < 8; ++j) {
        const float mu = j < 4 ? m0[j] : m1[j - 4];
        const float pj = firstt ? 0.f : pv[j];
        const float xv = v[j] + mu * (pj - v[j]);
        const float rc = 1.0f / (__expf(esc * xv) + 1.0f);
        x[j] = (cc < 64) ? (1.0f - 2.0f * rc) : ((cc >= 128) ? rc : xv);
      }
      u32x4 w; w.x = cvtpk(x[0], x[1]); w.y = cvtpk(x[2], x[3]); w.z = cvtpk(x[4], x[5]); w.w = cvtpk(x[6], x[7]);
      *(u32x4*)(lds + tok * XL_ROW + cc * 2) = w;
    }
    if (MODE & 2) {
#pragma unroll
    for (int it = 0; it < 2; ++it) {
      const int gt = t0 + wid * 8 + it * 4 + (lane >> 4), c0 = (lane & 15) * 8;
      float v[8]; load8(proj + (size_t)gt * PROJ_LD + C_CKV + c0, v);
      float ss = 0.f;
#pragma unroll
      for (int j = 0; j < 8; ++j) ss += v[j] * v[j];
      const float rs = rsqrtf(dpp_sum16b(ss) * (1.0f / 128.0f) + 1e-6f);
      const f32x4 g0 = *(const f32x4*)(p.kv_norm_g + c0), g1 = *(const f32x4*)(p.kv_norm_g + c0 + 4);
      u32x4 w; w.x = cvtpk(v[0] * rs * g0[0], v[1] * rs * g0[1]); w.y = cvtpk(v[2] * rs * g0[2], v[3] * rs * g0[3]);
      w.z = cvtpk(v[4] * rs * g1[0], v[5] * rs * g1[1]); w.w = cvtpk(v[6] * rs * g1[2], v[7] * rs * g1[3]);
      *(u32x4*)(ws_ckv(p) + (size_t)gt * 128 + c0) = w;
    }
    {
      const int gt = t0 + wid * 8 + (lane >> 3), c0 = (lane & 7) * 8;
      float v[8]; load8(proj + (size_t)gt * PROJ_LD + C_KI + c0, v);
      float ss = 0.f;
#pragma unroll
      for (int j = 0; j < 8; ++j) ss += v[j] * v[j];
      const float rs = rsqrtf(dpp_sum8(ss) * (1.0f / 64.0f) + 1e-6f);
      const f32x4 g0 = *(const f32x4*)(p.k_idx_norm_g + c0), g1 = *(const f32x4*)(p.k_idx_norm_g + c0 + 4);
      u32x4 w; w.x = cvtpk(v[0] * rs * g0[0], v[1] * rs * g0[1]); w.y = cvtpk(v[2] * rs * g0[2], v[3] * rs * g0[3]);
      w.z = cvtpk(v[4] * rs * g1[0], v[5] * rs * g1[1]); w.w = cvtpk(v[6] * rs * g1[2], v[7] * rs * g1[3]);
      *(u32x4*)(ws_kidx(p) + (size_t)gt * 64 + c0) = w;
    }
    }
    __syncthreads();
#pragma unroll 1
    for (int nt = 0; nt < 2; ++nt) {
      int r32 = r32_, hi = hi_;
      asm volatile("" : "+v"(r32), "+v"(hi));
      const int gt = t0 + nt * 32 + r32;
      const bool first = (gt & (SEQ - 1)) == 0;
      const int gp = first ? gt : gt - 1;
      const char* xrow = lds + (nt * 32 + r32) * XL_ROW + hi * 16;
      const int chb = h * HD + 4 * hi;
      char* RBt = lds + 64 * XL_ROW + wid * 14336; char* KBt = RBt + 4752; char* OBt = KBt + 4752;
      const int t0w = t0 + nt * 32, frow = lane >> 3, fch = lane & 7;
      const int cwo = r32 * 144 + hi * 8;
#define P3_FLUSH(dst_, ld_, col_) do { _Pragma("unroll") for (int i_ = 0; i_ < 4; ++i_) { const int row_ = frow + 8 * i_; \
        *(u32x4*)((dst_) + (unsigned)((t0w + row_) * (ld_) + (col_) + fch * 8)) = *(const u32x4*)(OBt + row_ * 144 + fch * 16); } } while (0)
      if (MODE & 1) {
      f32x16 acc[2];
#pragma unroll
      for (int mt = 0; mt < 2; ++mt)
#pragma unroll
        for (int r = 0; r < 16; ++r) acc[mt][r] = 0.f;
#pragma unroll
      for (int ks = 0; ks < 4; ++ks) {
        const bf16x8 bx = *(const bf16x8*)(xrow + ks * 32);
#pragma unroll
        for (int mt = 0; mt < 2; ++mt) { const bf16x8 aw = *(const bf16x8*)(ws_wdt(p) + (unsigned)(((h * 2 + mt) * 4 + ks) * 512 + (hi * 32 + r32) * 8)); acc[mt] = __builtin_amdgcn_mfma_f32_32x32x16_bf16(aw, bx, acc[mt], 0, 0, 0); }
      }
#pragma unroll
      for (int mt = 0; mt < 2; ++mt)
#pragma unroll
        for (int g = 0; g < 4; ++g) {
          const int ch = chb + 32 * mt + 8 * g;
          const f32x4 w0v = *(const f32x4*)(PL + ch);
          float e[4];
#pragma unroll
          for (int i = 0; i < 4; ++i) e[i] = 0.6065306597f / (1.0f + __expf(-(w0v[i] + acc[mt][4 * g + i])));
          *(u32x2*)(OBt + cwo + mt * 64 + g * 16) = pk4(e[0], e[1], e[2], e[3]);
        }
      P3_FLUSH(ws_ee(p), RW, h * HD);
      __builtin_amdgcn_sched_barrier(0);
#pragma unroll
      for (int mt = 0; mt < 2; ++mt)
#pragma unroll
        for (int r = 0; r < 16; ++r) acc[mt][r] = 0.f;
#pragma unroll
      for (int ks = 0; ks < 8; ++ks) {
        const bf16x8 bx = *(const bf16x8*)(xrow + 256 + ks * 32);
#pragma unroll
        for (int mt = 0; mt < 2; ++mt) { const bf16x8 aw = *(const bf16x8*)(ws_wgt(p) + (unsigned)(((h * 2 + mt) * 8 + ks) * 512 + (hi * 32 + r32) * 8)); acc[mt] = __builtin_amdgcn_mfma_f32_32x32x16_bf16(aw, bx, acc[mt], 0, 0, 0); }
      }
#pragma unroll
      for (int mt = 0; mt < 2; ++mt)
#pragma unroll
        for (int g = 0; g < 4; ++g)
          *(u32x2*)(OBt + cwo + mt * 64 + g * 16) =
              pk4(acc[mt][4 * g] + 0.0f, acc[mt][4 * g + 1] + 0.0f, acc[mt][4 * g + 2] + 0.0f, acc[mt][4 * g + 3] + 0.0f);
      P3_FLUSH(ws_gg(p), RW, h * HD);
      __builtin_amdgcn_sched_barrier(0);
#pragma unroll
      for (int mt = 0; mt < 2; ++mt)
#pragma unroll
        for (int r = 0; r < 16; ++r) acc[mt][r] = 0.f;
#pragma unroll
      for (int ks = 0; ks < 4; ++ks) {
        const bf16x8 bx = *(const bf16x8*)(xrow + 128 + ks * 32);
#pragma unroll
        for (int mt = 0; mt < 2; ++mt) { const bf16x8 aw = *(const bf16x8*)(ws_wat(p) + (unsigned)(((h * 2 + mt) * 4 + ks) * 512 + (hi * 32 + r32) * 8)); acc[mt] = __builtin_amdgcn_mfma_f32_32x32x16_bf16(aw, bx, acc[mt], 0, 0, 0); }
      }
      __builtin_amdgcn_sched_barrier(0);
#pragma unroll
      for (int i_ = 0; i_ < 5; ++i_) {
        const int row_ = frow + 8 * i_;
        if (row_ < 33) {
          int tk_ = t0w - 1 + row_; tk_ = tk_ < 0 ? 0 : tk_;
          *(u32x4*)(RBt + row_ * 144 + fch * 16) = *(const u32x4*)(proj + (unsigned)(tk_ * PROJ_LD + C_R + h * HD + fch * 8));
          *(u32x4*)(KBt + row_ * 144 + fch * 16) = *(const u32x4*)(proj + (unsigned)(tk_ * PROJ_LD + C_K + h * HD + fch * 8));
        }
      }
      float ss = 0.f, bs = 0.f; float av[2][16];
#pragma unroll
      for (int mt = 0; mt < 2; ++mt)
#pragma unroll
        for (int g = 0; g < 4; ++g) {
          const int ch = chb + 32 * mt + 8 * g;
          float rv[4], rp[4], kv[4], kq[4];
          ld4((const bf16_t*)(RBt + 144 + cwo + mt * 64 + g * 16), rv); ld4((const bf16_t*)(KBt + 144 + cwo + mt * 64 + g * 16), kv);
          ld4((const bf16_t*)(RBt + cwo + mt * 64 + g * 16), rp); ld4((const bf16_t*)(KBt + cwo + mt * 64 + g * 16), kq);
          const f32x4 mur = *(const f32x4*)(PL + 2560 + ch), muk = *(const f32x4*)(PL + 3072 + ch);
          const f32x4 a0v = *(const f32x4*)(PL + 512 + ch), kkc = *(const f32x4*)(PL + 1024 + ch), kac = *(const f32x4*)(PL + 1536 + ch), rkc = *(const f32x4*)(PL + 2048 + ch);
          float kp[4];
#pragma unroll
          for (int i = 0; i < 4; ++i) {
            const float a = 1.0f / (1.0f + __expf(-(a0v[i] + acc[mt][4 * g + i])));
            const float r = rv[i] + mur[i] * ((first ? 0.f : rp[i]) - rv[i]);
            const float k = kv[i] + muk[i] * ((first ? 0.f : kq[i]) - kv[i]);
            const float kk = k * kkc[i];
            ss += kk * kk;
            kp[i] = k * (1.0f + (a - 1.0f) * kac[i]);
            bs += r * kp[i] * rkc[i];
            av[mt][4 * g + i] = a;
          }
          *(u32x2*)(OBt + cwo + mt * 64 + g * 16) = pk4(kp[0], kp[1], kp[2], kp[3]);
        }
      P3_FLUSH(ws_kp(p), RW, h * HD);
      __builtin_amdgcn_sched_barrier(0);
      ss = xhalf_sum(ss); bs = xhalf_sum(bs);
      const float inv = 1.0f / fmaxf(sqrtf(ss), 1e-12f);
#pragma unroll
      for (int mt = 0; mt < 2; ++mt)
#pragma unroll
        for (int g = 0; g < 4; ++g) {
          const int ch = chb + 32 * mt + 8 * g;
          float kv[4], kq[4];
          ld4((const bf16_t*)(KBt + 144 + cwo + mt * 64 + g * 16), kv); ld4((const bf16_t*)(KBt + cwo + mt * 64 + g * 16), kq);
          const f32x4 muk = *(const f32x4*)(PL + 3072 + ch), kkc = *(const f32x4*)(PL + 1024 + ch);
          float kn[4];
#pragma unroll
          for (int i = 0; i < 4; ++i) { const float kprev = first ? 0.f : kq[i]; kn[i] = (kv[i] + muk[i] * (kprev - kv[i])) * kkc[i] * inv; }
          *(u32x2*)(OBt + cwo + mt * 64 + g * 16) = pk4(kn[0], kn[1], kn[2], kn[3]);
          *(u32x2*)(RBt + cwo + mt * 64 + g * 16) = pk4(kn[0] * av[mt][4 * g], kn[1] * av[mt][4 * g + 1], kn[2] * av[mt][4 * g + 2], kn[3] * av[mt][4 * g + 3]);
        }
      P3_FLUSH(ws_kk(p), RW, h * HD);
      { char* const OBs = OBt; OBt = RBt; P3_FLUSH(ws_bb(p), RW, h * HD); OBt = OBs; }
      if (hi == 0) ws_bonus(p)[gt * NH + h] = bs;
      }
#undef P3_FLUSH
    }
  }
}

DI void phase4a(const Params& p, int bid, int nb, char* lds) {
  const int t = tid_(), i = t >> 3, cg8 = (t & 7) * 8;
  const bf16_t* proj = ws_proj(p);
  for (int task = bid; task < BATCH * NH; task += nb) {
    const int b = task >> 3, h = task & 7;
    const int cbase = h * HD + cg8;
    float mu_r[8], st[8], rprev[8];
#pragma unroll
    for (int j = 0; j < 8; ++j) { mu_r[j] = p.shift_mu[C_R + cbase + j]; st[j] = 0.f; rprev[j] = 0.f; }
    const float mu_v = p.shift_mu[C_V + h * HD + i];
    float vprev = 0.f;
    const size_t tok0 = (size_t)b * SEQ;
    u32x4 n_kk, n_bb, n_kp, n_ee, n_r; bf16_t n_v;
    {
      const size_t g = tok0;
      n_kk = *(const u32x4*)(ws_kk(p) + g * RW + cbase); n_bb = *(const u32x4*)(ws_bb(p) + g * RW + cbase);
      n_kp = *(const u32x4*)(ws_kp(p) + g * RW + cbase); n_ee = *(const u32x4*)(ws_ee(p) + g * RW + cbase);
      n_r = *(const u32x4*)(proj + g * PROJ_LD + C_R + cbase); n_v = proj[g * PROJ_LD + C_V + h * HD + i];
    }
    for (int s = 0; s < SEQ; ++s) {
      const u32x4 c_kk = n_kk, c_bb = n_bb, c_kp = n_kp, c_ee = n_ee, c_r = n_r; const bf16_t c_v = n_v;
      if (s + 1 < SEQ) {
        const size_t g = tok0 + s + 1;
        n_kk = *(const u32x4*)(ws_kk(p) + g * RW + cbase); n_bb = *(const u32x4*)(ws_bb(p) + g * RW + cbase);
        n_kp = *(const u32x4*)(ws_kp(p) + g * RW + cbase); n_ee = *(const u32x4*)(ws_ee(p) + g * RW + cbase);
        n_r = *(const u32x4*)(proj + g * PROJ_LD + C_R + cbase); n_v = proj[g * PROJ_LD + C_V + h * HD + i];
      }
      float kk[8], bb[8], kp[8], ee[8], rr[8];
      unpack8(c_kk, kk); unpack8(c_bb, bb); unpack8(c_kp, kp); unpack8(c_ee, ee); unpack8(c_r, rr);
      const float vraw = bf2f(c_v);
      const float v = vraw + mu_v * (vprev - vraw); vprev = vraw;
      float sa = 0.f;
#pragma unroll
      for (int j = 0; j < 8; ++j) sa += st[j] * kk[j];
      sa += __shfl_xor(sa, 1); sa += __shfl_xor(sa, 2); sa += __shfl_xor(sa, 4);
      sa = -sa;
      float y = 0.f;
#pragma unroll
      for (int j = 0; j < 8; ++j) {
        const float r = rr[j] + mu_r[j] * (rprev[j] - rr[j]); rprev[j] = rr[j];
        const float w = __expf(-ee[j]);
        st[j] = st[j] * w + sa * bb[j] + v * kp[j];
        y += st[j] * r;
      }
      y += __shfl_xor(y, 1); y += __shfl_xor(y, 2); y += __shfl_xor(y, 4);
      if ((t & 7) == 0) ws_y(p)[(tok0 + s) * RW + h * HD + i] = y;
    }
  }
}

DI float dpp_sum16(float v) {
  v += __int_as_float(__builtin_amdgcn_update_dpp(0, __float_as_int(v), 0xB1, 0xF, 0xF, true));
  v += __int_as_float(__builtin_amdgcn_update_dpp(0, __float_as_int(v), 0x4E, 0xF, 0xF, true));
  v += __int_as_float(__builtin_amdgcn_update_dpp(0, __float_as_int(v), 0x141, 0xF, 0xF, true));
  v += __int_as_float(__builtin_amdgcn_update_dpp(0, __float_as_int(v), 0x140, 0xF, 0xF, true));
  return v;
}
constexpr int CK = 16;
constexpr int SC_CH = 16, SC_BUF = 5 * SC_CH * 64 * 4 + SC_CH * 32 * 4 + SC_CH * 8;
DI void phase4a_v2(const Params& p, int bid, int nb, char* lds) {
  const int t = tid_(), rowl = t >> 4, cg = t & 15;
  const bf16_t* proj = ws_proj(p);
  for (int task = bid; task < BATCH * NH * 2; task += nb) {
    const int b = task >> 4, h = (task >> 1) & 7, half = task & 1;
    const size_t tok0 = (size_t)b * SEQ;
    const int sst = t >> 4, scol = h * HD + cg * 4;
    const int vst = t >> 5, vrow = t & 31, vcol = C_V + h * HD + half * 32 + vrow;
    float mur[4];
#pragma unroll
    for (int j = 0; j < 4; ++j) mur[j] = p.shift_mu[C_R + scol + j];
    const float muv = p.shift_mu[vcol];
    u32x2 g_kk, g_bb, g_kp, g_ee, g_r, g_rp; bf16_t g_v, g_vp;
    auto stage_load = [&](int c) {
      if (t < 256) {
        const size_t g = tok0 + c * SC_CH + sst;
        g_kk = *(const u32x2*)(ws_kk(p) + g * RW + scol); g_bb = *(const u32x2*)(ws_bb(p) + g * RW + scol);
        g_kp = *(const u32x2*)(ws_kp(p) + g * RW + scol); g_ee = *(const u32x2*)(ws_ee(p) + g * RW + scol);
        g_r = *(const u32x2*)(proj + g * PROJ_LD + C_R + scol);
        if (c * SC_CH + sst > 0) g_rp = *(const u32x2*)(proj + (g - 1) * PROJ_LD + C_R + scol); else { g_rp.x = 0u; g_rp.y = 0u; }
      }
      const size_t gv = tok0 + c * SC_CH + vst;
      g_v = proj[gv * PROJ_LD + vcol];
      g_vp = (c * SC_CH + vst > 0) ? proj[(gv - 1) * PROJ_LD + vcol] : (bf16_t)0;
    };
    auto stage_write = [&](char* buf) {
      if (t < 256) {
        float* W = (float*)buf + sst * 64 + cg * 4;
        f32x4 o;
        o[0] = __expf(-__uint_as_float(g_ee.x << 16)); o[1] = __expf(-__uint_as_float(g_ee.x & 0xffff0000u));
        o[2] = __expf(-__uint_as_float(g_ee.y << 16)); o[3] = __expf(-__uint_as_float(g_ee.y & 0xffff0000u));
        *(f32x4*)W = o;
        o[0] = __uint_as_float(g_kk.x << 16); o[1] = __uint_as_float(g_kk.x & 0xffff0000u); o[2] = __uint_as_float(g_kk.y << 16); o[3] = __uint_as_float(g_kk.y & 0xffff0000u);
        *(f32x4*)(W + SC_CH * 64) = o;
        o[0] = __uint_as_float(g_bb.x << 16); o[1] = __uint_as_float(g_bb.x & 0xffff0000u); o[2] = __uint_as_float(g_bb.y << 16); o[3] = __uint_as_float(g_bb.y & 0xffff0000u);
        *(f32x4*)(W + 2 * SC_CH * 64) = o;
        o[0] = __uint_as_float(g_kp.x << 16); o[1] = __uint_as_float(g_kp.x & 0xffff0000u); o[2] = __uint_as_float(g_kp.y << 16); o[3] = __uint_as_float(g_kp.y & 0xffff0000u);
        *(f32x4*)(W + 3 * SC_CH * 64) = o;
        float r[4] = {__uint_as_float(g_r.x << 16), __uint_as_float(g_r.x & 0xffff0000u), __uint_as_float(g_r.y << 16), __uint_as_float(g_r.y & 0xffff0000u)};
        float rp[4] = {__uint_as_float(g_rp.x << 16), __uint_as_float(g_rp.x & 0xffff0000u), __uint_as_float(g_rp.y << 16), __uint_as_float(g_rp.y & 0xffff0000u)};
#pragma unroll
        for (int j = 0; j < 4; ++j) o[j] = r[j] + mur[j] * (rp[j] - r[j]);
        *(f32x4*)(W + 4 * SC_CH * 64) = o;
      }
      const float v = bf2f(g_v), vp = bf2f(g_vp);
      ((float*)buf)[5 * SC_CH * 64 + vst * 32 + vrow] = v + muv * (vp - v);
    };
    float st[4] = {0.f, 0.f, 0.f, 0.f};
    __syncthreads();
    stage_load(0); stage_write(lds);
    __syncthreads();
    float* yout = ws_y(p) + tok0 * RW + h * HD + half * 32 + rowl;
    for (int c = 0; c < SEQ / SC_CH; ++c) {
      const char* cur = lds + (c & 1) * SC_BUF;
      if (c + 1 < SEQ / SC_CH) stage_load(c + 1);
      const float* Wb = (const float*)cur + cg * 4;
      const float* Vb = (const float*)cur + 5 * SC_CH * 64 + rowl;
      float yv[SC_CH];
#pragma unroll
      for (int s = 0; s < SC_CH; ++s) {
        const f32x4 w = *(const f32x4*)(Wb + s * 64), kk = *(const f32x4*)(Wb + SC_CH * 64 + s * 64), bb = *(const f32x4*)(Wb + 2 * SC_CH * 64 + s * 64);
        const f32x4 kp = *(const f32x4*)(Wb + 3 * SC_CH * 64 + s * 64), rr = *(const f32x4*)(Wb + 4 * SC_CH * 64 + s * 64);
        const float v = Vb[s * 32];
        float sa = (st[0] * kk[0] + st[1] * kk[1]) + (st[2] * kk[2] + st[3] * kk[3]);
        sa = -dpp_sum16(sa);
#pragma unroll
        for (int j = 0; j < 4; ++j) st[j] = st[j] * w[j] + (sa * bb[j] + v * kp[j]);
        float y = (st[0] * rr[0] + st[1] * rr[1]) + (st[2] * rr[2] + st[3] * rr[3]);
        yv[s] = dpp_sum16(y);
      }
      if (cg == 0) {
#pragma unroll
        for (int s = 0; s < SC_CH; ++s) yout[(size_t)(c * SC_CH + s) * RW] = yv[s];
      }
      if (c + 1 < SEQ / SC_CH) stage_write(lds + ((c + 1) & 1) * SC_BUF);
      __syncthreads();
    }
  }
}

DI void moe_tr_wave(const Params& p, int id, int lane, float* tl  ) {
  const int which = id >> 12, q = id & 4095, e = q >> 7, r = q & 127;
  const float* src; int N, k0, n0;
  if (which < 2) { src = (which == 0 ? p.e_gate : p.e_up) + (size_t)e * 1024 * 512; N = 512; k0 = (r >> 3) * 64; n0 = (r & 7) * 64; }
  else { src = p.e_down + (size_t)e * 512 * 1024; N = 1024; k0 = (r >> 4) * 64; n0 = (r & 15) * 64; }
  const int lr = lane >> 4, lc = (lane & 15) * 4;
  f32x4 g[16];
#pragma unroll
  for (int i = 0; i < 16; ++i) g[i] = *(const f32x4*)(src + (size_t)(k0 + lr + 4 * i) * N + n0 + lc);
#pragma unroll
  for (int i = 0; i < 16; ++i) { float* d = tl + (lr + 4 * i) * 65 + lc; d[0] = g[i][0]; d[1] = g[i][1]; d[2] = g[i][2]; d[3] = g[i][3]; }
  bf16_t* dst;
  { const int n = n0 + lane;
    if (which < 2) dst = ws_wgu(p) + (size_t)e * 1024 * 1024 + (size_t)((n >> 7) * 256 + (n & 127) + which * 128) * 1024 + k0;
    else dst = ws_wd(p) + (size_t)e * 1024 * 512 + (size_t)n * 512 + k0; }
#pragma unroll
  for (int c8 = 0; c8 < 8; ++c8) {
    float v[8];
#pragma unroll
    for (int j = 0; j < 8; ++j) v[j] = tl[(c8 * 8 + j) * 65 + lane];
    u32x4 w; w.x = cvtpk(v[0], v[1]); w.y = cvtpk(v[2], v[3]); w.z = cvtpk(v[4], v[5]); w.w = cvtpk(v[6], v[7]);
    *(u32x4*)(dst + c8 * 8) = w;
  }
}

typedef float f32x2p __attribute__((ext_vector_type(2)));
DI void phase4a_v3(const Params& p, int bid, int nb, char* lds) {
  const int t = tid_(), wid = __builtin_amdgcn_readfirstlane(t >> 6);
  const int rowl = (t >> 3) & 31, cg = t & 7;
  const int pt = t & 255;
  const bf16_t* proj = ws_proj(p);
  for (int task = bid; task < BATCH * NH * 2; task += nb) {
    const int b = task >> 4, h = (task >> 1) & 7, half = task & 1;
    const size_t tok0 = (size_t)b * SEQ;
    const int sst = pt >> 4, scq = pt & 15, scol = h * HD + scq * 4;
    const int vst = pt >> 5, vrow = pt & 31, vcol = C_V + h * HD + half * 32 + vrow;
    float mur[4];
#pragma unroll
    for (int j = 0; j < 4; ++j) mur[j] = p.shift_mu[C_R + scol + j];
    const float muv = p.shift_mu[vcol];
    u32x2 g_kk, g_bb, g_kp, g_ee, g_r, g_rp; bf16_t g_v0, g_v0p, g_v1, g_v1p;
#define SC_LOAD(c_) do { const int c__ = (c_); const size_t g = tok0 + c__ * SC_CH + sst; \
      g_kk = *(const u32x2*)(ws_kk(p) + g * RW + scol); g_bb = *(const u32x2*)(ws_bb(p) + g * RW + scol); \
      g_kp = *(const u32x2*)(ws_kp(p) + g * RW + scol); g_ee = *(const u32x2*)(ws_ee(p) + g * RW + scol); \
      g_r = *(const u32x2*)(proj + g * PROJ_LD + C_R + scol); \
      g_rp = *(const u32x2*)(proj + (g - ((c__ * SC_CH + sst > 0) ? 1 : 0)) * PROJ_LD + C_R + scol); \
      if (c__ * SC_CH + sst == 0) { g_rp.x = 0u; g_rp.y = 0u; } \
      const size_t gv = tok0 + c__ * SC_CH + vst; \
      g_v0 = proj[gv * PROJ_LD + vcol]; g_v0p = (c__ * SC_CH + vst > 0) ? proj[(gv - 1) * PROJ_LD + vcol] : (bf16_t)0; \
      g_v1 = proj[(gv + 8) * PROJ_LD + vcol]; g_v1p = proj[(gv + 7) * PROJ_LD + vcol]; } while (0)
#define SC_WRITE(buf_) do { float* W = (float*)(buf_) + sst * 64 + scq * 4; f32x4 o; \
      o[0] = __expf(-__uint_as_float(g_ee.x << 16)); o[1] = __expf(-__uint_as_float(g_ee.x & 0xffff0000u)); \
      o[2] = __expf(-__uint_as_float(g_ee.y << 16)); o[3] = __expf(-__uint_as_float(g_ee.y & 0xffff0000u)); *(f32x4*)W = o; \
      o[0] = __uint_as_float(g_kk.x << 16); o[1] = __uint_as_float(g_kk.x & 0xffff0000u); o[2] = __uint_as_float(g_kk.y << 16); o[3] = __uint_as_float(g_kk.y & 0xffff0000u); *(f32x4*)(W + SC_CH * 64) = o; \
      o[0] = __uint_as_float(g_bb.x << 16); o[1] = __uint_as_float(g_bb.x & 0xffff0000u); o[2] = __uint_as_float(g_bb.y << 16); o[3] = __uint_as_float(g_bb.y & 0xffff0000u); *(f32x4*)(W + 2 * SC_CH * 64) = o; \
      o[0] = __uint_as_float(g_kp.x << 16); o[1] = __uint_as_float(g_kp.x & 0xffff0000u); o[2] = __uint_as_float(g_kp.y << 16); o[3] = __uint_as_float(g_kp.y & 0xffff0000u); *(f32x4*)(W + 3 * SC_CH * 64) = o; \
      { const float r0 = __uint_as_float(g_r.x << 16), r1 = __uint_as_float(g_r.x & 0xffff0000u), r2 = __uint_as_float(g_r.y << 16), r3 = __uint_as_float(g_r.y & 0xffff0000u); \
        const float q0 = __uint_as_float(g_rp.x << 16), q1 = __uint_as_float(g_rp.x & 0xffff0000u), q2 = __uint_as_float(g_rp.y << 16), q3 = __uint_as_float(g_rp.y & 0xffff0000u); \
        o[0] = r0 + mur[0] * (q0 - r0); o[1] = r1 + mur[1] * (q1 - r1); o[2] = r2 + mur[2] * (q2 - r2); o[3] = r3 + mur[3] * (q3 - r3); \
        const f32x4 wv_ = *(const f32x4*)W, bv_ = *(const f32x4*)(W + 2 * SC_CH * 64), kv_ = *(const f32x4*)(W + 3 * SC_CH * 64); \
        const float br_ = dpp_sum16((bv_[0] * o[0] + bv_[1] * o[1]) + (bv_[2] * o[2] + bv_[3] * o[3])), kr_ = dpp_sum16((kv_[0] * o[0] + kv_[1] * o[1]) + (kv_[2] * o[2] + kv_[3] * o[3])); \
        if (scq == 0) { float* X_ = (float*)(buf_) + 5 * SC_CH * 64 + SC_CH * 32 + sst * 2; X_[0] = br_; X_[1] = kr_; } \
        o[0] *= wv_[0]; o[1] *= wv_[1]; o[2] *= wv_[2]; o[3] *= wv_[3]; *(f32x4*)(W + 4 * SC_CH * 64) = o; } \
      { const float v0 = bf2f(g_v0), v0p = bf2f(g_v0p), v1 = bf2f(g_v1), v1p = bf2f(g_v1p); float* Vw = (float*)(buf_) + 5 * SC_CH * 64 + vst * 32 + vrow; \
        Vw[0] = v0 + muv * (v0p - v0); Vw[8 * 32] = v1 + muv * (v1p - v1); } } while (0)
    f32x2p st2[4];
#pragma unroll
    for (int j = 0; j < 4; ++j) st2[j] = (f32x2p){0.f, 0.f};
    __syncthreads();
    if (wid >= 4) { SC_LOAD(0); SC_WRITE(lds); SC_LOAD(1); }
    __syncthreads();
    float* yout = ws_y(p) + tok0 * RW + h * HD + half * 32 + rowl;
    for (int c = 0; c < SEQ / SC_CH; ++c) {
      const char* cur = lds + (c & 1) * SC_BUF;
      if (wid >= 4) {
        if (c + 1 < SEQ / SC_CH) SC_WRITE(lds + ((c + 1) & 1) * SC_BUF);
        if (c + 2 < SEQ / SC_CH) SC_LOAD(c + 2);
        if ((c & 7) == 3) {
          const int tid_tr = (task * 4 + (wid - 4)) + (BATCH * NH * 2 * 4) * (c >> 3);
          if (tid_tr < 3 * 4096) moe_tr_wave(p, tid_tr, t & 63, (float*)(lds + 2 * SC_BUF + 128) + (wid - 4) * (64 * 65));
        }
      } else {
        const float* Wb = (const float*)cur + cg * 8;
        const float* Vb = (const float*)cur + 5 * SC_CH * 64 + rowl;
        float yv[SC_CH];
#pragma unroll
        for (int s = 0; s < SC_CH; ++s) {
          const f32x4 w0 = *(const f32x4*)(Wb + s * 64), w1 = *(const f32x4*)(Wb + s * 64 + 4);
          const f32x4 k0 = *(const f32x4*)(Wb + SC_CH * 64 + s * 64), k1 = *(const f32x4*)(Wb + SC_CH * 64 + s * 64 + 4);
          const f32x4 b0 = *(const f32x4*)(Wb + 2 * SC_CH * 64 + s * 64), b1 = *(const f32x4*)(Wb + 2 * SC_CH * 64 + s * 64 + 4);
          const f32x4 p0 = *(const f32x4*)(Wb + 3 * SC_CH * 64 + s * 64), p1 = *(const f32x4*)(Wb + 3 * SC_CH * 64 + s * 64 + 4);
          const f32x4 r0 = *(const f32x4*)(Wb + 4 * SC_CH * 64 + s * 64), r1 = *(const f32x4*)(Wb + 4 * SC_CH * 64 + s * 64 + 4);
          const float v = Vb[s * 32];
#define LO2(x) __builtin_shufflevector(x, x, 0, 1)
#define HI2(x) __builtin_shufflevector(x, x, 2, 3)
          const f32x2p xs = *(const f32x2p*)((const float*)cur + 5 * SC_CH * 64 + SC_CH * 32 + s * 2);
          f32x2p sa2 = st2[0] * LO2(k0), yd2 = st2[0] * LO2(r0);
          sa2 = st2[1] * HI2(k0) + sa2; yd2 = st2[1] * HI2(r0) + yd2;
          sa2 = st2[2] * LO2(k1) + sa2; yd2 = st2[2] * LO2(r1) + yd2;
          sa2 = st2[3] * HI2(k1) + sa2; yd2 = st2[3] * HI2(r1) + yd2;
          const float sa = -dpp_sum8(sa2[0] + sa2[1]);
          const float yd = dpp_sum8(yd2[0] + yd2[1]);
          yv[s] = yd + sa * xs[0] + v * xs[1];
          const f32x2p sav = {sa, sa}, vv = {v, v};
          st2[0] = st2[0] * LO2(w0) + (sav * LO2(b0) + vv * LO2(p0));
          st2[1] = st2[1] * HI2(w0) + (sav * HI2(b0) + vv * HI2(p0));
          st2[2] = st2[2] * LO2(w1) + (sav * LO2(b1) + vv * LO2(p1));
          st2[3] = st2[3] * HI2(w1) + (sav * HI2(b1) + vv * HI2(p1));
#undef LO2
#undef HI2
        }
        if (cg == 0) {
#pragma unroll
          for (int s = 0; s < SC_CH; ++s) yout[(size_t)(c * SC_CH + s) * RW] = yv[s];
        }
      }
      __syncthreads();
    }
#undef SC_LOAD
#undef SC_WRITE
  }
}

DI void moe_tr_small(const Params& p, int id, int lane, float* tl  ) {
  const int which = id >> 14, r_ = id & 16383, e = r_ >> 9, rr = r_ & 511;
  const float* src; int N, k0, n0;
  if (which < 2) { src = (which == 0 ? p.e_gate : p.e_up) + (size_t)e * 1024 * 512; N = 512; k0 = (rr >> 5) * 64; n0 = (rr & 31) * 16; }
  else { src = p.e_down + (size_t)e * 512 * 1024; N = 1024; k0 = (rr >> 6) * 64; n0 = (rr & 63) * 16; }
  const float* sp = src + (size_t)(k0 + lane) * N + n0;
  const f32x4 g0 = *(const f32x4*)sp, g1 = *(const f32x4*)(sp + 4), g2 = *(const f32x4*)(sp + 8), g3 = *(const f32x4*)(sp + 12);
  float* d = tl + lane * 17;
  d[0] = g0[0]; d[1] = g0[1]; d[2] = g0[2]; d[3] = g0[3]; d[4] = g1[0]; d[5] = g1[1]; d[6] = g1[2]; d[7] = g1[3];
  d[8] = g2[0]; d[9] = g2[1]; d[10] = g2[2]; d[11] = g2[3]; d[12] = g3[0]; d[13] = g3[1]; d[14] = g3[2]; d[15] = g3[3];
  const int nn = lane & 15, kq = lane >> 4;
  float v[16];
#pragma unroll
  for (int i = 0; i < 16; ++i) v[i] = tl[(kq * 16 + i) * 17 + nn];
  u32x4 w0, w1;
  w0.x = cvtpk(v[0], v[1]); w0.y = cvtpk(v[2], v[3]); w0.z = cvtpk(v[4], v[5]); w0.w = cvtpk(v[6], v[7]);
  w1.x = cvtpk(v[8], v[9]); w1.y = cvtpk(v[10], v[11]); w1.z = cvtpk(v[12], v[13]); w1.w = cvtpk(v[14], v[15]);
  const int n = n0 + nn;
  bf16_t* dst;
  if (which < 2) dst = ws_wgu(p) + (size_t)e * 1024 * 1024 + (size_t)((n >> 7) * 256 + (n & 127) + which * 128) * 1024 + k0 + kq * 16;
  else dst = ws_wd(p) + (size_t)e * 1024 * 512 + (size_t)n * 512 + k0 + kq * 16;
  *(u32x4*)dst = w0; *(u32x4*)(dst + 8) = w1;
}

constexpr int CS_PSZ = 23552, CS_SLSZ = 13312, CS_SL0 = 4 * CS_PSZ, CS_CON = CS_SL0 + 4 * CS_SLSZ;
DI f32x4v cs_mm16(const float* A, int sam, int sak, const float* B, int sbk, int sbn, f32x4v c, int l16, int g) {
#pragma unroll
  for (int q = 0; q < 4; ++q) c = __builtin_amdgcn_mfma_f32_16x16x4f32(A[l16 * sam + (4 * q + g) * sak], B[(4 * q + g) * sbk + l16 * sbn], c, 0, 0, 0);
  return c;
}
DI void cs_st16(float* D, f32x4v c, int l16, int g) {
#pragma unroll
  for (int r = 0; r < 4; ++r) D[(4 * g + r) * 16 + l16] = c[r];
}
DI f32x4v cs_ld16(const float* D, int l16, int g) { f32x4v c;
#pragma unroll
  for (int r = 0; r < 4; ++r) c[r] = D[(4 * g + r) * 16 + l16];
  return c; }
DI void cs_st4(bf16_t* base, int ld, f32x4v c) {
  const unsigned p01 = cvtpk(c[0] + 0.0f, c[1] + 0.0f), p23 = cvtpk(c[2] + 0.0f, c[3] + 0.0f);
  base[0] = (bf16_t)p01; base[ld] = (bf16_t)(p01 >> 16); base[2 * ld] = (bf16_t)p23; base[3 * ld] = (bf16_t)(p23 >> 16);
}
constexpr int CS_FLG = CS_CON + 6144 + 2 * 64 * 17 * 4;
DI void cs_wait(volatile int* f, int v) {
  while (__builtin_amdgcn_readfirstlane(*f) < v) __builtin_amdgcn_s_sleep(2);
  __builtin_amdgcn_fence(__ATOMIC_ACQUIRE, "workgroup");
}
DI void cs_post(volatile int* f, int v, int lane) {
  __builtin_amdgcn_fence(__ATOMIC_RELEASE, "workgroup");
  if (lane == 0) *f = v;
}
static_assert(CS_FLG + 48 <= LDS_BYTES - 64, "chunked scan LDS map");
#define CS_LAS __attribute__((address_space(3)))
DI void phase4a_chunk(const Params& p, int bid, int nb, char* lds) {
  const int t = tid_(), wid = __builtin_amdgcn_readfirstlane(t >> 6), lane = t & 63, l16 = lane & 15, g = lane >> 4;
  const bf16_t* proj = ws_proj(p);
  const f32x4v z4 = {0.f, 0.f, 0.f, 0.f};
  const bf16x8 zf = {0, 0, 0, 0, 0, 0, 0, 0};
  volatile int* fl_ready = (volatile int*)(lds + CS_FLG); volatile int* fl_done = fl_ready + 4;
  if (t < 12) fl_ready[t] = 0;
  int seq0 = 0;
  for (int task = bid; task < BATCH * NH * 2; task += nb, seq0 += SEQ / CK / 4) {
    const int b = task >> 4, h = (task >> 1) & 7, half = task & 1;
    const int tok0 = b * SEQ;
    f32x4v Sacc[4] = {z4, z4, z4, z4};
    bf16x8 sA[2] = {zf, zf};
    const int i0 = (wid & 1) * 16;
    __syncthreads();
    u32x4 pf[10]; bf16_t pf_rp = 0, pf_v[9];
#define CS_PF(cc) do { const int ct_ = tok0 + (cc) * CK; \
      const unsigned ro_ = (unsigned)((ct_ + (lane >> 3)) * RW + h * HD + (lane & 7) * 8) * 2u; \
      const unsigned rp_ = (unsigned)((ct_ + (lane >> 3)) * PROJ_LD + C_R + h * HD + (lane & 7) * 8) * 2u; \
      pf[0] = *(const u32x4*)((const char*)ws_ee(p) + ro_); pf[1] = *(const u32x4*)((const char*)ws_ee(p) + ro_ + 8 * RW * 2); \
      pf[2] = *(const u32x4*)((const char*)ws_kk(p) + ro_); pf[3] = *(const u32x4*)((const char*)ws_kk(p) + ro_ + 8 * RW * 2); \
      pf[4] = *(const u32x4*)((const char*)ws_bb(p) + ro_); pf[5] = *(const u32x4*)((const char*)ws_bb(p) + ro_ + 8 * RW * 2); \
      pf[6] = *(const u32x4*)((const char*)ws_kp(p) + ro_); pf[7] = *(const u32x4*)((const char*)ws_kp(p) + ro_ + 8 * RW * 2); \
      pf[8] = *(const u32x4*)((const char*)proj + rp_); pf[9] = *(const u32x4*)((const char*)proj + rp_ + 8 * PROJ_LD * 2); \
      { const int tp_ = (ct_ - 1 < tok0) ? tok0 : ct_ - 1; pf_rp = proj[(unsigned)(tp_ * PROJ_LD + C_R + h * HD + lane)]; } \
      _Pragma("unroll") for (int q_ = 0; q_ < 9; ++q_) { int tv_ = ct_ + (lane >> 5) * 8 + q_ - 1; tv_ = (tv_ < tok0) ? tok0 : tv_; \
        pf_v[q_] = proj[(unsigned)(tv_ * PROJ_LD + C_V + h * HD + half * 32 + (lane & 31))]; } } while (0)
    if (wid >= 4) CS_PF(wid - 4);
    const float mur = p.shift_mu[C_R + h * HD + lane], muv = p.shift_mu[C_V + h * HD + half * 32 + (lane & 31)];
    if (wid < 2) __builtin_amdgcn_s_setprio(3);
    for (int rnd = 0; rnd < SEQ / CK / 4; ++rnd) {
      if (wid >= 4) {
        const int pw = wid - 4, c = rnd * 4 + pw, ct0 = tok0 + c * CK;
        char* ps = lds + pw * CS_PSZ;
        bf16_t* AB = (bf16_t*)ps; bf16_t* BT = AB + 16 * 72; bf16_t* KT = BT + 16 * 72; bf16_t* RB = KT + 16 * 72;
        float* KHT = (float*)(ps + 9216);
        float* Nf = (float*)(ps + 13312); float* AKB = Nf + 256; float* ABR = AKB + 256; float* AKR = ABR + 256;
        float* T0 = AKR + 256; float* T1 = Nf; float* Pm = T0 + 256; float* Mm = Pm + 256;
        bf16_t* ABT = (bf16_t*)(Mm + 256);
        bf16_t* APb = (bf16_t*)BT;
        bf16_t* MTb = (bf16_t*)KT;
        bf16_t* W1b = MTb + 16 * 24;
        bf16_t* ABRT = W1b + 16 * 24;
        char* sl = lds + CS_SL0 + pw * CS_SLSZ;
        bf16_t* QT = (bf16_t*)sl; bf16_t* APT = QT + 16 * 72; bf16_t* BHT = APT + 16 * 72; bf16_t* GGT = BHT + 64 * 24; bf16_t* HT = GGT + 64 * 24; bf16_t* VT = HT + 16 * 24;
        float* GAM = (float*)(sl + 2304 * 2 + 3072 * 2 + 768 + 1536);
        u32x4 bhw0, bhw1, vw; float gamC;
        {
          const int j = lane, col = h * HD + j;
          float cum[CK];
          {
            char* rawl = ps + 13312 + lane * 16;
#pragma unroll
            for (int i = 0; i < 10; ++i) *(u32x4*)(rawl + i * 1024) = pf[i];
          }
          float rprev = (c * CK > 0) ? bf2f(pf_rp) : 0.f;
          {
            const int vi = lane & 31, sh = lane >> 5, vcol = C_V + h * HD + half * 32 + vi;
            float vprev = (c * CK + sh * 8 > 0) ? bf2f(pf_v[0]) : 0.f;
            float vv[8];
#pragma unroll
            for (int q = 0; q < 8; ++q) { const float vr = bf2f(pf_v[q + 1]); vv[q] = vr + muv * (vprev - vr); vprev = vr; }
            vw.x = cvtpk(vv[0], vv[1]); vw.y = cvtpk(vv[2], vv[3]); vw.z = cvtpk(vv[4], vv[5]); vw.w = cvtpk(vv[6], vv[7]);
          }
          if (rnd + 1 < SEQ / CK / 4) CS_PF(c + 4);
          const bf16_t* RAW = (const bf16_t*)(ps + 13312);
          float run = 0.f;
#pragma unroll
          for (int tt = 0; tt < CK; ++tt) { run += bf2f(RAW[tt * 64 + j]); cum[tt] = run; }
          gamC = __expf(-run);
          float bhv[CK], abv[CK];
          float gprev = 1.0f;
#pragma unroll
          for (int tt = 0; tt < CK; tt += 2) {
            float bt2[2], kt2[2], rb2[2];
#pragma unroll
            for (int u = 0; u < 2; ++u) { const int t_ = tt + u;
              const float kkr = bf2f(RAW[1024 + t_ * 64 + j]), ber = bf2f(RAW[2048 + t_ * 64 + j]), kpr = bf2f(RAW[3072 + t_ * 64 + j]), rr = bf2f(RAW[4096 + t_ * 64 + j]);
              const float rsh = rr + mur * (rprev - rr); rprev = rr;
              const float gt_ = __expf(-cum[t_]), gin = __builtin_amdgcn_rcpf(gt_), gh = gamC * gin;
              abv[t_] = -gprev * kkr; gprev = gt_;
              bt2[u] = ber * gin; kt2[u] = kpr * gin; rb2[u] = gt_ * rsh; bhv[t_] = ber * gh;
              KHT[j * 16 + t_] = kpr * gh; }
            const unsigned pa = cvtpk(abv[tt], abv[tt + 1]), pb = cvtpk(bt2[0], bt2[1]), pk = cvtpk(kt2[0], kt2[1]), pr = cvtpk(rb2[0], rb2[1]);
            AB[tt * 72 + j] = (bf16_t)pa; AB[(tt + 1) * 72 + j] = (bf16_t)(pa >> 16);
            BT[tt * 72 + j] = (bf16_t)pb; BT[(tt + 1) * 72 + j] = (bf16_t)(pb >> 16);
            KT[tt * 72 + j] = (bf16_t)pk; KT[(tt + 1) * 72 + j] = (bf16_t)(pk >> 16);
            RB[tt * 72 + j] = (bf16_t)pr; RB[(tt + 1) * 72 + j] = (bf16_t)(pr >> 16);
          }
          u32x4 bh0, bh1;
          bhw0.x = cvtpk(bhv[0], bhv[1]); bhw0.y = cvtpk(bhv[2], bhv[3]); bhw0.z = cvtpk(bhv[4], bhv[5]); bhw0.w = cvtpk(bhv[6], bhv[7]);
          bhw1.x = cvtpk(bhv[8], bhv[9]); bhw1.y = cvtpk(bhv[10], bhv[11]); bhw1.z = cvtpk(bhv[12], bhv[13]); bhw1.w = cvtpk(bhv[14], bhv[15]);
          bh0.x = cvtpk(abv[0], abv[1]); bh0.y = cvtpk(abv[2], abv[3]); bh0.z = cvtpk(abv[4], abv[5]); bh0.w = cvtpk(abv[6], abv[7]);
          bh1.x = cvtpk(abv[8], abv[9]); bh1.y = cvtpk(abv[10], abv[11]); bh1.z = cvtpk(abv[12], abv[13]); bh1.w = cvtpk(abv[14], abv[15]);
          *(u32x4*)(ABT + j * 24) = bh0; *(u32x4*)(ABT + j * 24 + 8) = bh1;
        }
        {
          bf16x8 fb[2], fk[2], fa[2], fr[2];
#pragma unroll
          for (int ks = 0; ks < 2; ++ks) { const int off = l16 * 72 + 8 * g + 32 * ks;
            fb[ks] = *(const bf16x8*)(BT + off); fk[ks] = *(const bf16x8*)(KT + off); fa[ks] = *(const bf16x8*)(AB + off); fr[ks] = *(const bf16x8*)(RB + off); }
          f32x4v n_ = z4, akb = z4, abr = z4, akr = z4;
#pragma unroll
          for (int ks = 0; ks < 2; ++ks) {
            n_ = __builtin_amdgcn_mfma_f32_16x16x32_bf16(fb[ks], fa[ks], n_, 0, 0, 0);
            akb = __builtin_amdgcn_mfma_f32_16x16x32_bf16(fk[ks], fa[ks], akb, 0, 0, 0);
            abr = __builtin_amdgcn_mfma_f32_16x16x32_bf16(fb[ks], fr[ks], abr, 0, 0, 0);
            akr = __builtin_amdgcn_mfma_f32_16x16x32_bf16(fk[ks], fr[ks], akr, 0, 0, 0);
          }
#pragma unroll
          for (int r = 0; r < 4; ++r) { const int s_ = 4 * g + r, t_ = l16;
            Nf[s_ * 16 + t_] = (s_ < t_) ? n_[r] : 0.f; AKB[s_ * 16 + t_] = (s_ < t_) ? akb[r] : 0.f;
            ABR[s_ * 16 + t_] = (s_ <= t_) ? abr[r] : 0.f; AKR[s_ * 16 + t_] = (s_ <= t_) ? akr[r] : 0.f;
            Pm[s_ * 16 + t_] = ((s_ < t_) ? n_[r] : 0.f) + ((s_ == t_) ? 1.0f : 0.f); }
          { const int t_ = l16; float a4[4];
#pragma unroll
            for (int r = 0; r < 4; ++r) a4[r] = (4 * g + r <= t_) ? abr[r] : 0.f;
            *(u32x2*)(ABRT + t_ * 24 + 4 * g) = pk4(a4[0], a4[1], a4[2], a4[3]); }
        }
        {
          f32x4v c_;
          c_ = cs_mm16(Nf, 16, 1, Nf, 16, 1, z4, l16, g); cs_st16(T0, c_, l16, g);
          c_ = cs_mm16(Pm, 16, 1, T0, 16, 1, cs_ld16(Pm, l16, g), l16, g); cs_st16(Pm, c_, l16, g);
          c_ = cs_mm16(T0, 16, 1, T0, 16, 1, z4, l16, g); cs_st16(T1, c_, l16, g);
          c_ = cs_mm16(Pm, 16, 1, T1, 16, 1, cs_ld16(Pm, l16, g), l16, g); cs_st16(Pm, c_, l16, g);
          c_ = cs_mm16(T1, 16, 1, T1, 16, 1, z4, l16, g); cs_st16(T0, c_, l16, g);
          c_ = cs_mm16(Pm, 16, 1, T0, 16, 1, cs_ld16(Pm, l16, g), l16, g); cs_st16(Mm, c_, l16, g);
          *(u32x2*)(MTb + l16 * 24 + 4 * g) = pk4(c_[0] + 0.0f, c_[1] + 0.0f, c_[2] + 0.0f, c_[3] + 0.0f);
          f32x4v w_ = z4;
#pragma unroll
          for (int q = 0; q < 4; ++q) w_ = __builtin_amdgcn_mfma_f32_16x16x4f32(Mm[(4 * q + g) * 16 + l16], AKB[l16 * 16 + 4 * q + g], w_, 0, 0, 0);
          *(u32x2*)(W1b + l16 * 24 + 4 * g) = pk4(w_[0] + 0.0f, w_[1] + 0.0f, w_[2] + 0.0f, w_[3] + 0.0f);
        }
        cs_wait(fl_done + pw, seq0 + rnd); cs_wait(fl_done + 4 + pw, seq0 + rnd);
        *(u32x4*)(BHT + lane * 24) = bhw0; *(u32x4*)(BHT + lane * 24 + 8) = bhw1;
        GAM[lane] = gamC;
        *(u32x4*)(VT + (lane & 31) * 24 + (lane >> 5) * 8) = vw;
        {
          const bf16x8 mF = (g < 2) ? *(const bf16x8*)(MTb + l16 * 24 + 8 * g) : zf;
          const bf16x8 rF = (g < 2) ? *(const bf16x8*)(ABRT + l16 * 24 + 8 * g) : zf;
          const bf16x8 wF = (g < 2) ? *(const bf16x8*)(W1b + l16 * 24 + 8 * g) : zf;
#pragma unroll
          for (int nt = 0; nt < 4; ++nt) {
            const bf16x8 bF = (g < 2) ? *(const bf16x8*)(ABT + (16 * nt + l16) * 24 + 8 * g) : zf;
            const f32x4v c_ = __builtin_amdgcn_mfma_f32_16x16x32_bf16(mF, bF, z4, 0, 0, 0);
            cs_st4(APT + (4 * g) * 72 + 16 * nt + l16, 72, c_);
            *(u32x2*)(APb + (16 * nt + l16) * 24 + 4 * g) = pk4(c_[0] + 0.0f, c_[1] + 0.0f, c_[2] + 0.0f, c_[3] + 0.0f);
          }
#pragma unroll
          for (int nt = 0; nt < 4; ++nt) {
            f32x4v c_;
#pragma unroll
            for (int r = 0; r < 4; ++r) c_[r] = bf2f(RB[(4 * g + r) * 72 + 16 * nt + l16]);
            const bf16x8 bF = (g < 2) ? *(const bf16x8*)(APb + (16 * nt + l16) * 24 + 8 * g) : zf;
            c_ = __builtin_amdgcn_mfma_f32_16x16x32_bf16(rF, bF, c_, 0, 0, 0);
            cs_st4(QT + (4 * g) * 72 + 16 * nt + l16, 72, c_);
          }
          {
            f32x4v c_;
#pragma unroll
            for (int r = 0; r < 4; ++r) c_[r] = AKR[l16 * 16 + 4 * g + r];
            c_ = __builtin_amdgcn_mfma_f32_16x16x32_bf16(rF, wF, c_, 0, 0, 0);
            cs_st4(HT + (4 * g) * 24 + l16, 24, c_);
          }
#pragma unroll
          for (int mt = 0; mt < 4; ++mt) {
            f32x4v c_;
#pragma unroll
            for (int r = 0; r < 4; ++r) c_[r] = KHT[(16 * mt + 4 * g + r) * 16 + l16];
            const bf16x8 aF = (g < 2) ? *(const bf16x8*)(BHT + (16 * mt + l16) * 24 + 8 * g) : zf;
            c_ = __builtin_amdgcn_mfma_f32_16x16x32_bf16(aF, wF, c_, 0, 0, 0);
            cs_st4(GGT + (16 * mt + 4 * g) * 24 + l16, 24, c_);
          }
        }
        cs_post(fl_ready + pw, seq0 + rnd + 1, lane);
      }
      else if (wid >= 2) {
        float* tl = (float*)(lds + CS_CON + 6144) + (wid - 2) * (64 * 17);
#pragma unroll 1
        for (int q = 0; q < 3; ++q) moe_tr_small(p, ((task * 2 + (wid - 2)) * 96 + rnd * 3 + q), lane, tl);
      }
      else {
#pragma unroll 1
        for (int k = 0; k < 4; ++k) {
          const char* sl = lds + CS_SL0 + k * CS_SLSZ;
          cs_wait(fl_ready + k, seq0 + rnd + 1);
          const bf16_t* QT = (const bf16_t*)sl; const bf16_t* APT = QT + 16 * 72; const bf16_t* BHT = APT + 16 * 72; const bf16_t* GGT = BHT + 64 * 24; const bf16_t* HT = GGT + 64 * 24; const bf16_t* VT = HT + 16 * 24;
          const float* GAM = (const float*)(sl + 2304 * 2 + 3072 * 2 + 768 + 1536);
          bf16x8 qF[2], aF[2];
#pragma unroll
          for (int ks = 0; ks < 2; ++ks) { qF[ks] = *(const bf16x8*)(QT + l16 * 72 + 8 * g + 32 * ks); aF[ks] = *(const bf16x8*)(APT + l16 * 72 + 8 * g + 32 * ks); }
          const bf16x8 vF = (g < 2) ? *(const bf16x8*)(VT + (i0 + l16) * 24 + 8 * g) : zf;
          const bf16x8 hF = (g < 2) ? *(const bf16x8*)(HT + l16 * 24 + 8 * g) : zf;
          f32x4v yT = z4;
          yT = __builtin_amdgcn_mfma_f32_16x16x32_bf16(qF[0], sA[0], yT, 0, 0, 0);
          yT = __builtin_amdgcn_mfma_f32_16x16x32_bf16(qF[1], sA[1], yT, 0, 0, 0);
          yT = __builtin_amdgcn_mfma_f32_16x16x32_bf16(hF, vF, yT, 0, 0, 0);
          {
            float* yo = ws_y(p) + (size_t)(tok0 + (rnd * 4 + k) * CK + 4 * g) * RW + h * HD + half * 32 + i0 + l16;
#pragma unroll
            for (int r = 0; r < 4; ++r) yo[(size_t)r * RW] = yT[r];
          }
          f32x4v uT = z4;
          uT = __builtin_amdgcn_mfma_f32_16x16x32_bf16(aF[0], sA[0], uT, 0, 0, 0);
          uT = __builtin_amdgcn_mfma_f32_16x16x32_bf16(aF[1], sA[1], uT, 0, 0, 0);
          bf16x8 uF;
          {
            const unsigned ud0 = cvtpk(uT[0] + 0.0f, uT[1] + 0.0f), ud1 = cvtpk(uT[2] + 0.0f, uT[3] + 0.0f);
            const auto r0 = __builtin_amdgcn_permlane16_swap(ud0, 0u, false, false); const auto r1 = __builtin_amdgcn_permlane16_swap(ud1, 0u, false, false);
            u32x4 w = {r0[0], r1[0], r0[1], r1[1]}; uF = *reinterpret_cast<bf16x8*>(&w);
          }
          unsigned D[4][2];
#pragma unroll
          for (int nt = 0; nt < 4; ++nt) {
            const f32x4 gm4 = *(const f32x4*)(GAM + 16 * nt + 4 * g);
            const bf16x8 bF = ((g & 1) == 0) ? *(const bf16x8*)(BHT + (16 * nt + l16) * 24 + 4 * g) : zf;
            const bf16x8 gF = (g < 2) ? *(const bf16x8*)(GGT + (16 * nt + l16) * 24 + 8 * g) : zf;
            f32x4v a_ = Sacc[nt];
            a_[0] *= gm4[0]; a_[1] *= gm4[1]; a_[2] *= gm4[2]; a_[3] *= gm4[3];
            a_ = __builtin_amdgcn_mfma_f32_16x16x32_bf16(bF, uF, a_, 0, 0, 0);
            a_ = __builtin_amdgcn_mfma_f32_16x16x32_bf16(gF, vF, a_, 0, 0, 0);
            Sacc[nt] = a_;
            D[nt][0] = cvtpk(a_[0] + 0.0f, a_[1] + 0.0f); D[nt][1] = cvtpk(a_[2] + 0.0f, a_[3] + 0.0f);
          }
          cs_post(fl_done + wid * 4 + k, seq0 + rnd + 1, lane);
#pragma unroll
          for (int n1 = 0; n1 < 2; ++n1) {
            unsigned F[2][2];
#pragma unroll
            for (int rp = 0; rp < 2; ++rp) {
              const auto e = __builtin_amdgcn_permlane32_swap(D[2 * n1][rp], D[2 * n1 + 1][rp], false, false);
              const auto f = __builtin_amdgcn_permlane16_swap(e[0], e[1], false, false);
              F[0][rp] = f[0]; F[1][rp] = f[1];
            }
            u32x4 w = {F[0][0], F[0][1], F[1][0], F[1][1]}; sA[n1] = *reinterpret_cast<bf16x8*>(&w);
          }
        }
      }
    }
  }
  __builtin_amdgcn_s_setprio(0);
  __syncthreads();
}

DI unsigned fkey(float f) { const unsigned u = __float_as_uint(f); return (u & 0x80000000u) ? ~u : (u | 0x80000000u); }
DI int block_sum_i(int v, int* red, int wid, int lane) {
  for (int o = 32; o; o >>= 1) v += __shfl_xor(v, o);
  __syncthreads();
  if (lane == 0) red[wid] = v;
  __syncthreads();
  int s = 0;
#pragma unroll
  for (int w = 0; w < 8; ++w) s += red[w];
  return s;
}
DI void phase4b(const Params& p, int bid, int nb, char* lds) {
  const int t = tid_(), lane = t & 63, wid = t >> 6;
  float* qf = (float*)lds;
  float* wi = qf + 256;
  int* red = (int*)(wi + 4);
  int* wtie = red + 8;
  const bf16_t* proj = ws_proj(p);
  for (int gq = bid; gq < NTOK; gq += nb) {
    const int b = gq >> 11, s = gq & (SEQ - 1);
    const int n = ((s >> 6) + 1) * 64;
    unsigned* mrow = ws_mask(p) + (size_t)gq * 64;
    if (n <= 256) {
      if (t < 64) mrow[t] = (t * 32 < n) ? 0xffffffffu : 0u;
      continue;
    }
    __syncthreads();
    if (t < 256) qf[t] = bf2f(proj[(size_t)gq * PROJ_LD + C_QI + t]) * 0.125f;
    else if (t < 260) wi[t - 256] = bf2f(proj[(size_t)gq * PROJ_LD + C_WI + t - 256]) * 0.5f;
    __syncthreads();
    unsigned uk[4];
#pragma unroll 1
    for (int q = 0; q < 4; ++q) {
      const int key = t * 4 + q;
      uk[q] = 0u;
      if (key < n) {
        float kf[64];
        const bf16_t* kr = ws_kidx(p) + ((size_t)b * SEQ + key) * 64;
#pragma unroll
        for (int d8 = 0; d8 < 8; ++d8) load8(kr + d8 * 8, kf + d8 * 8);
        float sc = 0.f;
#pragma unroll
        for (int hh = 0; hh < 4; ++hh) {
          float dot = 0.f;
#pragma unroll
          for (int d4 = 0; d4 < 16; ++d4) { const f32x4 qv = *(const f32x4*)(qf + hh * 64 + d4 * 4); dot += qv[0] * kf[d4 * 4] + qv[1] * kf[d4 * 4 + 1] + qv[2] * kf[d4 * 4 + 2] + qv[3] * kf[d4 * 4 + 3]; }
          sc += wi[hh] * fmaxf(dot, 0.f);
        }
        sc = sc + 0.0f;
        uk[q] = fkey(sc);
      }
    }
    unsigned T = 0u;
    for (int bit = 31; bit >= 0; --bit) {
      const unsigned cand = T | (1u << bit);
      const int c = (uk[0] >= cand) + (uk[1] >= cand) + (uk[2] >= cand) + (uk[3] >= cand);
      if (block_sum_i(c, red, wid, lane) >= 256) T = cand;
    }
    const int cgt = block_sum_i((uk[0] > T) + (uk[1] > T) + (uk[2] > T) + (uk[3] > T), red, wid, lane);
    const int need = 256 - cgt;
    const int tl = (uk[0] == T) + (uk[1] == T) + (uk[2] == T) + (uk[3] == T);
    int incl = tl;
    for (int o = 1; o < 64; o <<= 1) { const int u = __shfl_up(incl, o); if (lane >= o) incl += u; }
    __syncthreads();
    if (lane == 63) wtie[wid] = incl;
    __syncthreads();
    int before = incl - tl;
    for (int w = 0; w < wid; ++w) before += wtie[w];
    unsigned nib = 0u;
#pragma unroll
    for (int q = 0; q < 4; ++q) {
      bool sel = uk[q] > T;
      if (uk[q] == T) { sel = before < need; ++before; }
      if (sel) nib |= 1u << q;
    }
    unsigned word = nib << ((lane & 7) * 4);
    word |= __shfl_xor(word, 1); word |= __shfl_xor(word, 2); word |= __shfl_xor(word, 4);
    if ((lane & 7) == 0) mrow[t >> 3] = word;
  }
}

constexpr int IDX_LD = 2052;
DI void phase4b_mfma(const Params& p, int bid, int nb, char* lds) {
  const int t = tid_(), lane = t & 63, wid = t >> 6, q16 = lane & 15, g = lane >> 4;
  unsigned* S = (unsigned*)lds;
  const bf16_t* proj = ws_proj(p);
  for (int task = bid; task < NTOK / 16; task += nb) {
    const int b = (task & 255) >> 4, jq = task & 15, kq = task >> 8;
    const int q0 = (((kq & 1) ? 31 - jq : jq) + 32 * (kq >> 1)) * 16;
    const int n = ((q0 >> 6) + 1) * 64, ntile = n >> 4;
    if (n <= 256) {
      unsigned short* mrow = (unsigned short*)(ws_mask(p) + (size_t)(b * SEQ + q0 + q16) * 64);
      if (g == 0) for (int kt = wid; kt < ntile; kt += 8) mrow[kt] = 0xffffu;
      continue;
    }
    const int gq = b * SEQ + q0 + q16;
    const int ntw = (ntile - wid + 7) >> 3;
    const bf16_t* kbase = ws_kidx(p) + (size_t)b * SEQ * 64 + (wid * 16 + q16) * 64 + g * 8;
    bf16x8 qf[4][2]; float wq[4];
#pragma unroll
    for (int h = 0; h < 4; ++h) {
#pragma unroll
      for (int ks = 0; ks < 2; ++ks) qf[h][ks] = *(const bf16x8*)(proj + (size_t)gq * PROJ_LD + C_QI + h * 64 + ks * 32 + g * 8);
      wq[h] = bf2f(proj[(size_t)gq * PROJ_LD + C_WI + h]) * 0.0625f;
    }
    __syncthreads();
    bf16x8 k0 = *(const bf16x8*)kbase, k1 = *(const bf16x8*)(kbase + 32);
#pragma unroll
    for (int tt = 0; tt < 16; ++tt) {
      if (tt < ntw) {
        const bf16x8 c0 = k0, c1 = k1;
        if (tt + 1 < ntw) { int koff = (tt + 1) * 8 * 16 * 64; asm volatile("" : "+v"(koff)); k0 = *(const bf16x8*)(kbase + koff); k1 = *(const bf16x8*)(kbase + koff + 32); }
        float sc[4] = {0.f, 0.f, 0.f, 0.f};
#pragma unroll
        for (int h = 0; h < 4; ++h) {
          f32x4v acc = {0.f, 0.f, 0.f, 0.f};
          acc = __builtin_amdgcn_mfma_f32_16x16x32_bf16(c0, qf[h][0], acc, 0, 0, 0);
          acc = __builtin_amdgcn_mfma_f32_16x16x32_bf16(c1, qf[h][1], acc, 0, 0, 0);
#pragma unroll
          for (int r = 0; r < 4; ++r) sc[r] += wq[h] * fmaxf(acc[r], 0.f);
        }
        u32x4 kv;
#pragma unroll
        for (int r = 0; r < 4; ++r) {
          const unsigned bts = __float_as_uint(sc[r]);
          unsigned key = bts ^ ((unsigned)((int)bts >> 31) | 0x80000000u);
          key += (key == 0x7fffffffu) ? 1u : 0u;
          kv[r] = key;
        }
        *(u32x4*)(S + q16 * IDX_LD + (wid + 8 * tt) * 16 + 4 * g) = kv;
      }
    }
    __syncthreads();
    {
      const int nreg = n >> 6;
      const int qa = 2 * wid;
      unsigned ua[32], ub[32];
#pragma unroll
      for (int j = 0; j < 32; ++j) { ua[j] = (j < nreg) ? S[qa * IDX_LD + 64 * j + lane] : 0u; ub[j] = (j < nreg) ? S[(qa + 1) * IDX_LD + 64 * j + lane] : 0u; }
      unsigned Ta = 0u, Tb = 0u; bool xa = false, xb = false;
      for (int bit = 31; bit >= 0; --bit) {
        const unsigned ca = xa ? Ta : (Ta | (1u << bit)), cb = xb ? Tb : (Tb | (1u << bit));
        int va = 0, vb = 0;
#pragma unroll
        for (int j4 = 0; j4 < 8; ++j4) {
          if (j4 * 4 < nreg) {
#pragma unroll
            for (int j = j4 * 4; j < j4 * 4 + 4; ++j) { va += (ua[j] >= ca) ? 1 : 0; vb += (ub[j] >= cb) ? 1 : 0; }
          }
        }
        int vab = va | (vb << 16);
        vab += __builtin_amdgcn_update_dpp(0, vab, 0xB1, 0xF, 0xF, true);
        vab += __builtin_amdgcn_update_dpp(0, vab, 0x4E, 0xF, 0xF, true);
        vab += __builtin_amdgcn_update_dpp(0, vab, 0x141, 0xF, 0xF, true);
        vab += __builtin_amdgcn_update_dpp(0, vab, 0x140, 0xF, 0xF, true);
        const int tot = __builtin_amdgcn_readlane(vab, 0) + __builtin_amdgcn_readlane(vab, 16) + __builtin_amdgcn_readlane(vab, 32) + __builtin_amdgcn_readlane(vab, 48);
        const int na = tot & 0xffff, nq = tot >> 16;
        if (!xa && na >= 256) { Ta = ca; xa = (na == 256); }
        if (!xb && nq >= 256) { Tb = cb; xb = (nq == 256); }
        if (xa && xb) break;
      }
#pragma unroll 1
      for (int which = 0; which < 2; ++which) {
        const unsigned T = which ? Tb : Ta;
        if (which ? xb : xa) {
          unsigned* mrow = ws_mask(p) + (size_t)(b * SEQ + q0 + qa + which) * 64;
#pragma unroll
          for (int j = 0; j < 32; ++j) {
            if (j < nreg) {
              const unsigned long long sel = __ballot((which ? ub[j] : ua[j]) >= T);
              if (lane == 0) { mrow[2 * j] = (unsigned)sel; mrow[2 * j + 1] = (unsigned)(sel >> 32); }
            }
          }
          continue;
        }
        int cgt = 0;
#pragma unroll
        for (int j = 0; j < 32; ++j) cgt += __popcll(__ballot((which ? ub[j] : ua[j]) > T));
        int need = 256 - cgt;
        unsigned* mrow = ws_mask(p) + (size_t)(b * SEQ + q0 + qa + which) * 64;
#pragma unroll
        for (int j = 0; j < 32; ++j) {
          if (j < nreg) {
            const unsigned uv = which ? ub[j] : ua[j];
            unsigned long long sel = __ballot(uv > T);
            const unsigned long long eq = __ballot(uv == T);
            const int pe = __popcll(eq);
            if (pe <= need) { sel |= eq; need -= pe; }
            else { unsigned long long e = eq; for (int i = 0; i < need; ++i) { const unsigned long long low = e & (0ull - e); sel |= low; e ^= low; } need = 0; }
            if (lane == 0) { mrow[2 * j] = (unsigned)sel; mrow[2 * j + 1] = (unsigned)(sel >> 32); }
          }
        }
      }
    }
  }
}

DI void phase5a(const Params& p, int bid, int nb, char* lds) {
  const int lane = tid_() & 63, wid = tid_() >> 6;
  const bf16_t* proj = ws_proj(p);
  for (int gt = bid * 8 + wid; gt < NTOK; gt += nb * 8) {
    const int c0 = lane * 8, h = lane >> 3;
    const f32x4 y0 = *(const f32x4*)(ws_y(p) + (size_t)gt * RW + c0), y1 = *(const f32x4*)(ws_y(p) + (size_t)gt * RW + c0 + 4);
    float y[8] = {y0[0], y0[1], y0[2], y0[3], y1[0], y1[1], y1[2], y1[3]};
    float s = 0.f;
#pragma unroll
    for (int j = 0; j < 8; ++j) s += y[j];
    s += __shfl_xor(s, 1); s += __shfl_xor(s, 2); s += __shfl_xor(s, 4);
    const float mean = s * (1.0f / 64.0f);
    float q = 0.f;
#pragma unroll
    for (int j = 0; j < 8; ++j) { const float d = y[j] - mean; q += d * d; }
    q += __shfl_xor(q, 1); q += __shfl_xor(q, 2); q += __shfl_xor(q, 4);
    const float rstd = rsqrtf(q * (1.0f / 64.0f) + 64e-5f);
    float g[8], vr[8], vp[8];
    load8(ws_gg(p) + (size_t)gt * RW + c0, g);
    load8(proj + (size_t)gt * PROJ_LD + C_V + c0, vr);
    if (gt & (SEQ - 1)) load8(proj + (size_t)(gt - 1) * PROJ_LD + C_V + c0, vp);
    else {
#pragma unroll
      for (int j = 0; j < 8; ++j) vp[j] = 0.f;
    }
    const float bs = ws_bonus(p)[gt * NH + h];
    float o[8];
#pragma unroll
    for (int j = 0; j < 8; ++j) {
      const float v = vr[j] + p.shift_mu[C_V + c0 + j] * (vp[j] - vr[j]);
      o[j] = ((y[j] - mean) * rstd * p.gn_g[c0 + j] + p.gn_b[c0 + j] + bs * v) * g[j];
    }
    u32x4 w; w.x = pack2(o[0], o[1]); w.y = pack2(o[2], o[3]); w.z = pack2(o[4], o[5]); w.w = pack2(o[6], o[7]);
    *(u32x4*)(ws_mix(p) + (size_t)gt * DM + c0) = w;
  }
}

DI void phase5b(const Params& p, int bid, int nb, char* lds) {
  const int t = tid_(), lane = t & 63, wid = t >> 6;
  float* ql = (float*)lds;
  float* pr = ql + 1024;
  float* ol = pr + 2048;
  int* sel = (int*)(ol + 1024);
  int* nselp = sel + 256;
  for (int gq = bid; gq < NTOK; gq += nb) {
    const int b = gq >> 11;
    const bf16_t* ckv = ws_ckv(p) + (size_t)b * SEQ * 128;
    __syncthreads();
    for (int idx = t; idx < 1024; idx += NTHR) ql[idx] = bf2f(ws_qlat(p)[(size_t)gq * 1024 + idx]);
    if (wid == 0) {
      const int nadm = (((gq & (SEQ - 1)) >> 6) + 1) * 64;
      const unsigned word = (lane * 32 < nadm) ? ws_mask(p)[(size_t)gq * 64 + lane] : 0u;
      const int cnt = __popc(word);
      int incl = cnt;
      for (int o = 1; o < 64; o <<= 1) { const int u = __shfl_up(incl, o); if (lane >= o) incl += u; }
      int pos = incl - cnt;
      unsigned w = word;
      while (w) { const int bit = __ffs(w) - 1; w &= w - 1; if (pos < 256) sel[pos] = lane * 32 + bit; ++pos; }
      if (lane == 63) *nselp = incl < 256 ? incl : 256;
    }
    __syncthreads();
    const int nsel = *nselp;
    const int h = wid;
    float lg[4]; float mx = -1e30f;
#pragma unroll
    for (int q = 0; q < 4; ++q) {
      const int slot = lane + 64 * q;
      lg[q] = -1e30f;
      if (slot < nsel) {
        const bf16_t* kr = ckv + (size_t)sel[slot] * 128;
        float acc = 0.f;
#pragma unroll
        for (int d8 = 0; d8 < 16; ++d8) {
          float kf[8]; load8(kr + d8 * 8, kf);
          const f32x4 q0 = *(const f32x4*)(ql + h * 128 + d8 * 8), q1 = *(const f32x4*)(ql + h * 128 + d8 * 8 + 4);
          acc += q0[0] * kf[0] + q0[1] * kf[1] + q0[2] * kf[2] + q0[3] * kf[3] + q1[0] * kf[4] + q1[1] * kf[5] + q1[2] * kf[6] + q1[3] * kf[7];
        }
        lg[q] = acc;
      }
      mx = fmaxf(mx, lg[q]);
    }
    mx = wave_max(mx);
    float sm = 0.f;
#pragma unroll
    for (int q = 0; q < 4; ++q) { lg[q] = (lane + 64 * q < nsel) ? __expf(lg[q] - mx) : 0.f; sm += lg[q]; }
    sm = wave_sum(sm);
    const float inv = 1.0f / sm;
#pragma unroll
    for (int q = 0; q < 4; ++q) pr[h * 256 + lane + 64 * q] = lg[q] * inv;
    __syncthreads();
    {
      float o0 = 0.f, o1 = 0.f;
      for (int slot = 0; slot < nsel; ++slot) {
        const unsigned kv2 = *(const unsigned*)(ckv + (size_t)sel[slot] * 128 + lane * 2);
        const float pp = pr[h * 256 + slot];
        o0 += pp * __uint_as_float(kv2 << 16); o1 += pp * __uint_as_float(kv2 & 0xffff0000u);
      }
      ol[h * 128 + lane * 2] = o0; ol[h * 128 + lane * 2 + 1] = o1;
    }
    __syncthreads();
    {
      float acc = 0.f;
      for (int cc = 0; cc < 128; ++cc) acc += ol[h * 128 + cc] * p.w_uv[(size_t)(cc * NH + h) * HD + lane];
      ws_mix(p)[(size_t)gq * DM + RW + h * HD + lane] = f2bf(acc);
    }
  }
}

typedef short s16x4 __attribute__((ext_vector_type(4)));
#define KSWZ(row, colB) ((row) * 256 + ((colB) ^ (((row) & 7) << 4)))
DI int v_st(int k, int c) { const int kk = (k & ~0xC) | ((k & 4) << 1) | ((k & 8) >> 1); return ((kk >> 3) * 4 + (c >> 5)) * 512 + ((kk & 7) * 32 + (c & 31)) * 2; }
DI int v_rd_base(int lane) { return ((lane & 3) << 3) | (((lane >> 2) & 3) << 6) | (((lane >> 4) & 1) << 5) | (((lane >> 5) & 1) << 8); }
constexpr int v_rd_off(int d0, int ks, int half) { return d0 * 512 + ks * 4096 + half * 2048; }
template <int OFF> DI s16x4 tr_read(int vb) { s16x4 r; asm volatile("ds_read_b64_tr_b16 %0, %1 offset:%2" : "=&v"(r) : "v"(vb), "i"(OFF) : "memory"); return r; }
template <int D0> DI void pv_one(f32x16& od, int vb, bf16x8 pa0, bf16x8 pa1, bf16x8 pa2, bf16x8 pa3) {
  const s16x4 l0 = tr_read<v_rd_off(D0, 0, 0)>(vb), h0 = tr_read<v_rd_off(D0, 0, 1)>(vb), l1 = tr_read<v_rd_off(D0, 1, 0)>(vb), h1 = tr_read<v_rd_off(D0, 1, 1)>(vb);
  const s16x4 l2 = tr_read<v_rd_off(D0, 2, 0)>(vb), h2 = tr_read<v_rd_off(D0, 2, 1)>(vb), l3 = tr_read<v_rd_off(D0, 3, 0)>(vb), h3 = tr_read<v_rd_off(D0, 3, 1)>(vb);
  asm volatile("s_waitcnt lgkmcnt(0)" ::: "memory"); __builtin_amdgcn_sched_barrier(0);
#define PKV(L, H) (bf16x8){L[0], L[1], L[2], L[3], H[0], H[1], H[2], H[3]}
  od = __builtin_amdgcn_mfma_f32_32x32x16_bf16(pa0, PKV(l0, h0), od, 0, 0, 0);
  od = __builtin_amdgcn_mfma_f32_32x32x16_bf16(pa1, PKV(l1, h1), od, 0, 0, 0);
  od = __builtin_amdgcn_mfma_f32_32x32x16_bf16(pa2, PKV(l2, h2), od, 0, 0, 0);
  od = __builtin_amdgcn_mfma_f32_32x32x16_bf16(pa3, PKV(l3, h3), od, 0, 0, 0);
#undef PKV
}
constexpr int ATT_TILE = 64 * 128 * 2;
constexpr int ATT_LDS = 4 * ATT_TILE + 8 * 64 * 4;
DI void phase5b_mfma(const Params& p, int bid, int nb, char* lds) {
  const int t = tid_(), lane = t & 63, wid = t >> 6, r32 = lane & 31, hi = lane >> 5;
  char* V_lds = lds; char* K_lds = lds + 2 * ATT_TILE;
  float* al_l = (float*)(lds + 4 * ATT_TILE) + wid * 64; float* li_l = al_l + 32;
  const int sr = t >> 4, sc = (t & 15) * 8;
  const int vst0 = v_st(sr, sc), vst1 = v_st(32 + sr, sc), kst0 = KSWZ(sr, sc * 2), kst1 = KSWZ(32 + sr, sc * 2);
  const int vb0 = (int)(uintptr_t)V_lds + v_rd_base(lane);
  const int h = wid;
  constexpr float LOG2E = 1.4426950408889634f, THR = 8.0f;
  for (int task = bid; task < NTOK / 32; task += nb) {
    const int b = (task & 255) >> 4;
    int qt; { const int j = task & 15, k = task >> 8; qt = (k == 0) ? j : (k == 1) ? 31 - j : (k == 2) ? 32 + j : 63 - j; }
    const int q0 = qt * 32, n = ((q0 >> 6) + 1) * 64, NT = n >> 6;
    const int gq = b * SEQ + q0 + r32;
    const bf16_t* ckv = ws_ckv(p) + (size_t)b * SEQ * 128;
    const unsigned* mrow = ws_mask(p) + (size_t)gq * 64;
    bf16x8 qr[8];
    {
      f32x16 qa[4];
#pragma unroll
      for (int mt = 0; mt < 4; ++mt)
#pragma unroll
        for (int r = 0; r < 16; ++r) qa[mt][r] = 0.f;
      const bf16_t* wuk = ws_wukt(p) + (size_t)h * 8192 + lane * 8;
#pragma unroll
      for (int ks = 0; ks < 4; ++ks) {
        const bf16x8 bq = *(const bf16x8*)(ws_proj(p) + (size_t)gq * PROJ_LD + C_Q + h * HD + ks * 16 + hi * 8);
#pragma unroll
        for (int mt = 0; mt < 4; ++mt) { const bf16x8 aw = *(const bf16x8*)(wuk + (mt * 4 + ks) * 512); qa[mt] = __builtin_amdgcn_mfma_f32_32x32x16_bf16(aw, bq, qa[mt], 0, 0, 0); }
      }
#define QPK(P, BASE, OUT) do { unsigned a0 = cvtpk(P[BASE + 0] * 0.125f, P[BASE + 1] * 0.125f), a1 = cvtpk(P[BASE + 2] * 0.125f, P[BASE + 3] * 0.125f);   \
    unsigned b0 = cvtpk(P[BASE + 4] * 0.125f, P[BASE + 5] * 0.125f), b1 = cvtpk(P[BASE + 6] * 0.125f, P[BASE + 7] * 0.125f);                              \
    auto r0 = __builtin_amdgcn_permlane32_swap(a0, b0, false, false); auto r1 = __builtin_amdgcn_permlane32_swap(a1, b1, false, false); \
    u32x4 w = {r0[0], r1[0], r0[1], r1[1]}; OUT = *reinterpret_cast<bf16x8*>(&w); } while (0)
#pragma unroll
      for (int mt = 0; mt < 4; ++mt) { QPK(qa[mt], 0, qr[2 * mt]); QPK(qa[mt], 8, qr[2 * mt + 1]); }
#undef QPK
    }
    float m_reg = -1e30f, l_reg = 0.f;
    f32x16 o[4];
#pragma unroll
    for (int d = 0; d < 4; ++d)
#pragma unroll
      for (int r = 0; r < 16; ++r) o[d][r] = 0.f;
    u32x4 s0 = *(const u32x4*)(ckv + (size_t)sr * 128 + sc), s1 = *(const u32x4*)(ckv + (size_t)(32 + sr) * 128 + sc);
    __syncthreads();
    *(u32x4*)(V_lds + vst0) = s0; *(u32x4*)(V_lds + vst1) = s1; *(u32x4*)(K_lds + kst0) = s0; *(u32x4*)(K_lds + kst1) = s1;
    __syncthreads();
    unsigned mw0 = mrow[0], mw1 = mrow[1];
    for (int j = 0; j < NT; ++j) {
      const int buf = j & 1;
      const unsigned w0 = mw0 >> (4 * hi), w1 = mw1 >> (4 * hi);
      if (j + 1 < NT) { mw0 = mrow[2 * j + 2]; mw1 = mrow[2 * j + 3]; }
      if (j + 1 < NT) { s0 = *(const u32x4*)(ckv + (size_t)((j + 1) * 64 + sr) * 128 + sc); s1 = *(const u32x4*)(ckv + (size_t)((j + 1) * 64 + 32 + sr) * 128 + sc); }
      f32x16 p0, p1;
#pragma unroll
      for (int r = 0; r < 16; ++r) { p0[r] = 0.f; p1[r] = 0.f; }
      const char* Kb = K_lds + buf * ATT_TILE;
#pragma unroll
      for (int d0 = 0; d0 < 8; ++d0) {
        const int cb = (d0 * 16 + hi * 8) * 2;
        const bf16x8 b0 = *(const bf16x8*)(Kb + KSWZ(r32, cb)), b1 = *(const bf16x8*)(Kb + KSWZ(32 + r32, cb));
        p0 = __builtin_amdgcn_mfma_f32_32x32x16_bf16(b0, qr[d0], p0, 0, 0, 0);
        p1 = __builtin_amdgcn_mfma_f32_32x32x16_bf16(b1, qr[d0], p1, 0, 0, 0);
      }
      float pmax = p0[0];
#pragma unroll
      for (int r = 1; r < 16; ++r) pmax = fmaxf(pmax, p0[r]);
#pragma unroll
      for (int r = 0; r < 16; ++r) pmax = fmaxf(pmax, p1[r]);
      { auto rr = __builtin_amdgcn_permlane32_swap(__float_as_uint(pmax), __float_as_uint(pmax), false, false); pmax = fmaxf(__uint_as_float(rr[0]), __uint_as_float(rr[1])); }
      float alpha = 1.f;
      if (!__all(pmax - m_reg <= THR)) { const float mn = fmaxf(m_reg, pmax); alpha = __builtin_amdgcn_exp2f((m_reg - mn) * LOG2E); m_reg = mn; }
      const float mnC = -m_reg * LOG2E;
      float ps = 0.f;
#pragma unroll
      for (int r = 0; r < 16; ++r) {
        const int bitp = (r & 3) + 8 * (r >> 2);
        float e0 = __builtin_amdgcn_exp2f(fmaf(p0[r], LOG2E, mnC)), e1 = __builtin_amdgcn_exp2f(fmaf(p1[r], LOG2E, mnC));
        e0 = __uint_as_float(__float_as_uint(e0) & (unsigned)(((int)(w0 << (31 - bitp))) >> 31));
        e1 = __uint_as_float(__float_as_uint(e1) & (unsigned)(((int)(w1 << (31 - bitp))) >> 31));
        p0[r] = e0; p1[r] = e1; ps += e0 + e1;
      }
      { auto rr = __builtin_amdgcn_permlane32_swap(__float_as_uint(ps), __float_as_uint(ps), false, false); ps = __uint_as_float(rr[0]) + __uint_as_float(rr[1]); }
      l_reg = l_reg * alpha + ps;
      if (__any(alpha < 1.f)) {
        if (hi == 0) al_l[r32] = alpha;
        asm volatile("s_waitcnt lgkmcnt(0)" ::: "memory");
#pragma unroll
        for (int d = 0; d < 4; ++d)
#pragma unroll
          for (int r = 0; r < 16; ++r) o[d][r] *= al_l[crow(r, hi)];
      }
      bf16x8 pa0, pa1, pa2, pa3;
#define PK4(P, BASE, OUT) do { unsigned a0 = cvtpk(P[BASE + 0], P[BASE + 1]), a1 = cvtpk(P[BASE + 2], P[BASE + 3]);   \
    unsigned b0 = cvtpk(P[BASE + 4], P[BASE + 5]), b1 = cvtpk(P[BASE + 6], P[BASE + 7]);                              \
    auto r0 = __builtin_amdgcn_permlane32_swap(a0, b0, false, false); auto r1 = __builtin_amdgcn_permlane32_swap(a1, b1, false, false); \
    u32x4 w = {r0[0], r1[0], r0[1], r1[1]}; OUT = *reinterpret_cast<bf16x8*>(&w); } while (0)
      PK4(p0, 0, pa0); PK4(p0, 8, pa1); PK4(p1, 0, pa2); PK4(p1, 8, pa3);
#undef PK4
      const int vb = vb0 + buf * ATT_TILE;
      pv_one<0>(o[0], vb, pa0, pa1, pa2, pa3); pv_one<1>(o[1], vb, pa0, pa1, pa2, pa3); pv_one<2>(o[2], vb, pa0, pa1, pa2, pa3); pv_one<3>(o[3], vb, pa0, pa1, pa2, pa3);
      if (j + 1 < NT) {
        char* Vn = V_lds + (buf ^ 1) * ATT_TILE; char* Kn = K_lds + (buf ^ 1) * ATT_TILE;
        *(u32x4*)(Vn + vst0) = s0; *(u32x4*)(Vn + vst1) = s1; *(u32x4*)(Kn + kst0) = s0; *(u32x4*)(Kn + kst1) = s1;
      }
      __syncthreads();
    }
    if (hi == 0) li_l[r32] = l_reg;
    asm volatile("s_waitcnt lgkmcnt(0)" ::: "memory");
    int hio = hi, r32o = r32;
    asm volatile("" : "+v"(hio), "+v"(r32o));
    char* Ow = lds + wid * 8192;
#pragma unroll
    for (int r = 0; r < 16; ++r) {
      const int row = crow(r, hio); const float rl = 1.0f / li_l[row];
#pragma unroll
      for (int d = 0; d < 4; ++d) *(bf16_t*)(Ow + KSWZ(row, (d * 32 + r32o) * 2)) = f2bf(o[d][r] * rl);
    }
    asm volatile("s_waitcnt lgkmcnt(0)" ::: "memory");
    f32x16 oa[2];
#pragma unroll
    for (int i = 0; i < 2; ++i)
#pragma unroll
      for (int r = 0; r < 16; ++r) oa[i][r] = 0.f;
    const bf16_t* wuv = ws_wuvt(p) + (size_t)h * 8192 + (hio * 32 + r32o) * 8;
#pragma unroll
    for (int ks = 0; ks < 8; ++ks) {
      const bf16x8 a = *(const bf16x8*)(Ow + KSWZ(r32o, (ks * 16 + hio * 8) * 2));
#pragma unroll
      for (int i = 0; i < 2; ++i) {
        const bf16x8 bw = *(const bf16x8*)(wuv + (i * 8 + ks) * 512);
        oa[i] = __builtin_amdgcn_mfma_f32_32x32x16_bf16(a, bw, oa[i], 0, 0, 0);
      }
    }
    asm volatile("s_waitcnt lgkmcnt(0)" ::: "memory");
#pragma unroll
    for (int i = 0; i < 2; ++i)
#pragma unroll
      for (int r = 0; r < 16; ++r) *(bf16_t*)(Ow + ((r & 3) + 8 * (r >> 2) + 4 * hio) * 144 + (i * 32 + r32o) * 2) = f2bf(oa[i][r]);
    asm volatile("s_waitcnt lgkmcnt(0)" ::: "memory");
    {
      const int lo = hio * 32 + r32o;
      bf16_t* mx = ws_mix(p) + (size_t)(b * SEQ + q0) * DM + RW + h * HD;
#pragma unroll
      for (int k = 0; k < 4; ++k) { const int row = k * 8 + (lo >> 3), sg = lo & 7; *(u32x4*)(mx + (size_t)row * DM + sg * 8) = *(const u32x4*)(Ow + row * 144 + sg * 16); }
    }
  }
}

struct EpiOut { const float* x; const float* mod; float* o; int row0, col0; DI void operator()(int r, int c, float v0, float v1) const {
  const int row = row0 + r, col = col0 + c, b = row >> 11; const size_t idx = (size_t)row * DM + col;
  o[idx] = x[idx] + (1.0f + mod[b * 6144 + 2048 + col]) * v0; o[idx + 32] = x[idx + 32] + (1.0f + mod[b * 6144 + 2048 + col + 32]) * v1; } };
DI void phase6(const Params& p, int bid, int nb, char* lds) {
  constexpr int NT = DM / GBN;
  for (int tile = bid; tile < (NTOK / GBM) * NT; tile += nb) {
    const int mt = tile / NT, nt = tile % NT;
    gemm_tile(ws_mix(p), DM, ARowBase{mt * GBM}, ws_wtout(p), DM, nt * GBN, DM, EpiOut{p.x, ws_mod(p), p.out, mt * GBM, nt * GBN}, lds);
  }
}

namespace pg8 {
#define PG8_LAS __attribute__((address_space(3)))
constexpr int BM = 256, BK = 64, HALF = 128, HTB = HALF * BK * 2  , STAGE_BYTES = 8 * HTB, NXCD = 8, WGM = 8;

__host__ __device__ __forceinline__ int lds_byte(int r, int c) { const int st = (r >> 4) * 2 + (c >> 5), rr = r & 15, cc = c & 31, ob = rr * 64 + cc * 2; return st * 1024 + (ob ^ (((ob >> 9) & 1) << 5)); }
__host__ __device__ __forceinline__ void stage_rc(int b, int& R, int& C) { const int st = b / 1024, sb = b % 1024, swz = sb ^ (((sb >> 9) & 1) << 5); R = (st >> 1) * 16 + swz / 64; C = (st & 1) * 32 + (swz % 64) / 2; }
__host__ __device__ __forceinline__ int perm32(int rho) { const int n = rho >> 4, i = rho & 15; return 8 * (i >> 2) + 4 * n + (i & 3); }

struct Unit { int pm, pn, e; };
struct Gemm { const bf16_t* A; const bf16_t* Bt; int M, N, K; size_t bstride; };

struct StaticOrder {
    static constexpr bool GATHER = false;
    int nM, nN, nwg, G, c;
    __host__ __device__ void init(int M, int N, int G_, int c_) { nM = M / BM; nN = N / BM; nwg = nM * nN; G = G_; c = c_; }
    __host__ __device__ bool next(int i, Unit& u) const {
        const long L = (long)i * G + c; if (L >= nwg) return false;
        int wgid = (int)L; { const int q = nwg / NXCD, r = nwg % NXCD, xcd = wgid % NXCD, off = wgid / NXCD; wgid = (xcd < r ? xcd * (q + 1) : r * (q + 1) + (xcd - r) * q) + off; }
        const int nig = WGM * nN, gid = wgid / nig, fm = gid * WGM, gsz = (nM - fm) < WGM ? (nM - fm) : WGM;
        u.pm = fm + ((wgid % nig) % gsz); u.pn = (wgid % nig) / gsz; u.e = 0; return true;
    }
    __device__ __forceinline__ void a_ready(const Unit&) const {}
    __device__ __forceinline__ void done(const Unit&) const {}
    __device__ __forceinline__ int arow(const Unit&, int) const { return 0; }
};
template <class Epi, class Sched, bool ALIGN_EPI = false, bool SP2 = false>
__device__ __forceinline__ void gemm_phase(PG8_LAS unsigned char* lds, const Gemm g, const Sched& S, const Epi& E) {
    const int tid = tid_(), wid = __builtin_amdgcn_readfirstlane(tid >> 6), lane = tid & 63, wr = wid >> 2, wc = wid & 3, fr = lane & 15, fq = lane >> 4;
    const int K = g.K, nt = K / BK;
    unsigned voffA[2], voffB[2];
#pragma unroll
    for (int i = 0; i < 2; ++i) { int R, C; stage_rc(tid * 16 + i * 8192, R, C); const int Rb = Epi::PERM ? ((R & ~31) + perm32(R & 31)) : R;
        voffA[i] = (unsigned)(R * K + C) * 2u; voffB[i] = (unsigned)(Rb * K + C) * 2u; }
    unsigned vAc[2][2], vAn[2][2];
    const size_t kstep = (size_t)(BK * 2);
    const size_t hstep = (size_t)HALF * K * 2;
    const size_t tstep = 2 * hstep;
    const unsigned ldsw = (unsigned)wid * 1024u;
    const int aoff = lds_byte(wr * 64 + fr, fq * 8), boff = lds_byte(wc * 32 + fr, fq * 8);
#define PG8_SA(b, h) (((b) * 2 + (h)) * HTB)
#define PG8_SB(b, h) ((4 + (b) * 2 + (h)) * HTB)
#define PG8_STAGE(bufoff, gbase, voff) do { _Pragma("unroll") for (int _i = 0; _i < 2; ++_i) \
        __builtin_amdgcn_global_load_lds((const unsigned*)((const char*)(gbase) + (voff)[_i]), (PG8_LAS unsigned*)(lds + (bufoff) + ldsw + _i * 8192), 16, 0, 0); } while (0)
#define PG8_STAGE_A(bufoff, gbase, v0_, v1_) do { \
        __builtin_amdgcn_global_load_lds((const unsigned*)((const char*)(gbase) + (v0_)), (PG8_LAS unsigned*)(lds + (bufoff) + ldsw), 16, 0, 0); \
        __builtin_amdgcn_global_load_lds((const unsigned*)((const char*)(gbase) + (v1_)), (PG8_LAS unsigned*)(lds + (bufoff) + ldsw + 8192), 16, 0, 0); } while (0)
#define PG8_AOFF(u_, dst_) do { if constexpr (Sched::GATHER) { _Pragma("unroll") for (int h_ = 0; h_ < 2; ++h_) _Pragma("unroll") for (int i_ = 0; i_ < 2; ++i_) { int R_, C_; stage_rc(tid * 16 + i_ * 8192, R_, C_); \
            dst_[h_][i_] = (unsigned)(S.arow(u_, h_ * HALF + R_) * K + C_) * 2u; } asm volatile("s_waitcnt vmcnt(0)" ::: "memory"); } \
        else { _Pragma("unroll") for (int h_ = 0; h_ < 2; ++h_) _Pragma("unroll") for (int i_ = 0; i_ < 2; ++i_) dst_[h_][i_] = voffA[i_] + (unsigned)(h_ * hstep); } } while (0)
#define PG8_LDA(dst, b, h) do { _Pragma("unroll") for (int m = 0; m < 4; ++m) _Pragma("unroll") for (int k = 0; k < 2; ++k) dst[m][k] = *(const PG8_LAS bf16x8*)(lds + PG8_SA(b, h) + aoff + m * 2048 + k * 1024); } while (0)
#define PG8_LDB(dst, b, h) do { _Pragma("unroll") for (int n = 0; n < 2; ++n) _Pragma("unroll") for (int k = 0; k < 2; ++k) dst[n][k] = *(const PG8_LAS bf16x8*)(lds + PG8_SB(b, h) + boff + n * 2048 + k * 1024); } while (0)
#define PG8_MMA(ai, bj, At, Bt) do { __builtin_amdgcn_s_setprio(1); _Pragma("unroll") for (int m = 0; m < 4; ++m) _Pragma("unroll") for (int n = 0; n < 2; ++n) _Pragma("unroll") for (int k = 0; k < 2; ++k) \
        acc[ai][bj][m][n] = __builtin_amdgcn_mfma_f32_16x16x32_bf16(Bt[n][k], At[m][k], acc[ai][bj][m][n], 0, 0, 0); __builtin_amdgcn_s_setprio(0); } while (0)
#define PG8_WAIT_V(n) asm volatile("s_waitcnt vmcnt(" #n ")" ::: "memory")
#define PG8_WAIT_L(n) asm volatile("s_waitcnt lgkmcnt(" #n ")" ::: "memory")
#define PG8_BAR __builtin_amdgcn_s_barrier()
#define PG8_SCHED __builtin_amdgcn_sched_barrier(0)
    Unit cur, nxt; int ui = 0;
    if (!S.next(0, cur)) return;
    f32x4 acc[2][2][4][2];
#pragma unroll
    for (int a = 0; a < 2; ++a)
#pragma unroll
        for (int b = 0; b < 2; ++b)
#pragma unroll
            for (int m = 0; m < 4; ++m)
#pragma unroll
                for (int n = 0; n < 2; ++n) acc[a][b][m][n] = (f32x4){0.f, 0.f, 0.f, 0.f};
    bf16x8 At[4][2], B0[2][2], B1[2][2];
    const char* cA = Sched::GATHER ? (const char*)g.A : (const char*)g.A + (size_t)cur.pm * tstep; PG8_AOFF(cur, vAc); const char* cB = (const char*)g.Bt + (size_t)cur.e * g.bstride + (size_t)cur.pn * tstep;
    S.a_ready(cur);
    if constexpr (SP2) {
        PG8_STAGE(PG8_SB(0, 0), cB, voffB); PG8_STAGE(PG8_SB(0, 1), cB + hstep, voffB); PG8_STAGE_A(PG8_SA(0, 0), cA, vAc[0][0], vAc[0][1]); PG8_STAGE_A(PG8_SA(0, 1), cA, vAc[1][0], vAc[1][1]);
        if (wr == 1) PG8_BAR;
        PG8_WAIT_V(2); PG8_BAR;
        PG8_STAGE(PG8_SB(1, 0), cB + kstep, voffB); PG8_STAGE_A(PG8_SA(1, 0), cA + kstep, vAc[0][0], vAc[0][1]); PG8_STAGE(PG8_SB(1, 1), cB + hstep + kstep, voffB);
        PG8_WAIT_V(6); PG8_BAR;
    } else {
        PG8_STAGE(PG8_SB(0, 0), cB, voffB); PG8_STAGE(PG8_SA(0, 0), cA, voffA); PG8_STAGE(PG8_SB(0, 1), cB + hstep, voffB); PG8_STAGE(PG8_SA(0, 1), cA + hstep, voffA);
        if (wr == 1) PG8_BAR;
        PG8_WAIT_V(4); PG8_BAR;
        PG8_STAGE(PG8_SB(1, 0), cB + kstep, voffB); PG8_STAGE(PG8_SA(1, 0), cA + kstep, voffA); PG8_STAGE(PG8_SB(1, 1), cB + hstep + kstep, voffB);
        PG8_WAIT_V(6); PG8_BAR;
    }
    for (;;) {
        const bool has_next = S.next(ui + 1, nxt);
        const char* nA = (has_next && !Sched::GATHER) ? (const char*)g.A + (size_t)nxt.pm * tstep : cA;
        if (has_next) PG8_AOFF(nxt, vAn); else { _Pragma("unroll") for (int h_ = 0; h_ < 2; ++h_) _Pragma("unroll") for (int i_ = 0; i_ < 2; ++i_) vAn[h_][i_] = vAc[h_][i_]; }
        const char* nB = has_next ? (const char*)g.Bt + (size_t)nxt.e * g.bstride + (size_t)nxt.pn * tstep : cB;
        for (int t = 0; t < nt; t += 2) {
            const bool last = (t == nt - 2);
            const char* a1 = cA + (size_t)(t + 1) * kstep;
            const char* a2 = last ? nA : cA + (size_t)(t + 2) * kstep; const char* b2 = last ? nB : cB + (size_t)(t + 2) * kstep;
            const char* a3 = a2 + kstep; const char* b3 = b2 + kstep;
            if (last && has_next) S.a_ready(nxt);
            if constexpr (SP2) {
            PG8_LDB(B0, 0, 0); PG8_LDB(B1, 0, 1); PG8_SCHED; PG8_LDA(At, 0, 0); PG8_STAGE_A(PG8_SA(1, 1), a1, vAc[1][0], vAc[1][1]);
            PG8_WAIT_V(8); PG8_WAIT_L(0); PG8_BAR; PG8_MMA(0, 0, At, B0); PG8_MMA(0, 1, At, B1); PG8_BAR; PG8_SCHED;
            PG8_LDA(At, 0, 1); PG8_STAGE(PG8_SB(0, 0), b2, voffB); PG8_STAGE(PG8_SB(0, 1), b2 + hstep, voffB); PG8_STAGE_A(PG8_SA(0, 0), a2, last ? vAn[0][0] : vAc[0][0], last ? vAn[0][1] : vAc[0][1]);
            PG8_WAIT_V(8); PG8_WAIT_L(0); PG8_BAR; PG8_MMA(1, 0, At, B0); PG8_MMA(1, 1, At, B1); PG8_BAR; PG8_SCHED;
            PG8_LDB(B0, 1, 0); PG8_LDB(B1, 1, 1); PG8_SCHED; PG8_LDA(At, 1, 0); PG8_STAGE_A(PG8_SA(0, 1), a2, last ? vAn[1][0] : vAc[1][0], last ? vAn[1][1] : vAc[1][1]);
            PG8_WAIT_V(8); PG8_WAIT_L(0); PG8_BAR; PG8_MMA(0, 0, At, B0); PG8_MMA(0, 1, At, B1); PG8_BAR; PG8_SCHED;
            PG8_LDA(At, 1, 1); PG8_STAGE(PG8_SB(1, 0), b3, voffB); PG8_STAGE(PG8_SB(1, 1), b3 + hstep, voffB); PG8_STAGE_A(PG8_SA(1, 0), a3, last ? vAn[0][0] : vAc[0][0], last ? vAn[0][1] : vAc[0][1]);
            PG8_WAIT_V(8); PG8_WAIT_L(0); PG8_BAR; PG8_MMA(1, 0, At, B0); PG8_MMA(1, 1, At, B1); PG8_BAR; PG8_SCHED;
            } else {
            PG8_LDB(B0, 0, 0); PG8_SCHED; PG8_LDA(At, 0, 0); PG8_STAGE(PG8_SA(1, 1), a1 + hstep, voffA);
            PG8_WAIT_L(8); PG8_BAR; PG8_WAIT_L(0); PG8_MMA(0, 0, At, B0); PG8_BAR; PG8_SCHED;
            PG8_LDB(B1, 0, 1); PG8_STAGE(PG8_SB(0, 0), b2, voffB);
            PG8_BAR; PG8_WAIT_L(0); PG8_MMA(0, 1, At, B1); PG8_BAR;
            PG8_LDA(At, 0, 1); PG8_STAGE(PG8_SA(0, 0), a2, voffA);
            PG8_BAR; PG8_WAIT_L(0); PG8_MMA(1, 0, At, B0); PG8_BAR; PG8_SCHED;
            PG8_STAGE(PG8_SB(0, 1), b2 + hstep, voffB);
            PG8_WAIT_V(6); PG8_BAR; PG8_MMA(1, 1, At, B1); PG8_BAR;
            PG8_LDB(B0, 1, 0); PG8_SCHED; PG8_LDA(At, 1, 0); PG8_STAGE(PG8_SA(0, 1), a2 + hstep, voffA);
            PG8_WAIT_L(8); PG8_BAR; PG8_WAIT_L(0); PG8_MMA(0, 0, At, B0); PG8_BAR; PG8_SCHED;
            PG8_LDB(B1, 1, 1); PG8_STAGE(PG8_SB(1, 0), b3, voffB);
            PG8_BAR; PG8_WAIT_L(0); PG8_MMA(0, 1, At, B1); PG8_BAR;
            PG8_LDA(At, 1, 1); PG8_STAGE(PG8_SA(1, 0), a3, voffA);
            PG8_BAR; PG8_WAIT_L(0); PG8_MMA(1, 0, At, B0); PG8_BAR; PG8_SCHED;
            PG8_STAGE(PG8_SB(1, 1), b3 + hstep, voffB);
            PG8_WAIT_V(6); PG8_BAR; PG8_MMA(1, 1, At, B1); PG8_BAR;
            }
        }
        if constexpr (ALIGN_EPI) { if (wr == 0) PG8_BAR; }
        if constexpr (!Epi::AFTER_DRAIN) { E(acc, cur, wr, wc, fr, fq); S.done(cur); }
        if (!has_next) break;
#pragma unroll
        for (int a = 0; a < 2; ++a)
#pragma unroll
            for (int b = 0; b < 2; ++b)
#pragma unroll
                for (int m = 0; m < 4; ++m)
#pragma unroll
                    for (int n = 0; n < 2; ++n) acc[a][b][m][n] = (f32x4){0.f, 0.f, 0.f, 0.f};
        cur = nxt; cA = nA; cB = nB; ++ui;
#pragma unroll
        for (int h_ = 0; h_ < 2; ++h_)
#pragma unroll
            for (int i_ = 0; i_ < 2; ++i_) vAc[h_][i_] = vAn[h_][i_];
        if constexpr (ALIGN_EPI) { if (wr == 1) PG8_BAR; }
    }
    PG8_WAIT_V(0);
    if constexpr (!ALIGN_EPI) { if (wr == 0) PG8_BAR; }
    PG8_BAR;
    if constexpr (Epi::AFTER_DRAIN) { E.fused(acc, cur, wr, wc, fr, fq, lds, wid, lane); S.done(cur); }
#undef PG8_SA
#undef PG8_SB
#undef PG8_STAGE
#undef PG8_STAGE_A
#undef PG8_AOFF
#undef PG8_LDA
#undef PG8_LDB
#undef PG8_MMA
#undef PG8_WAIT_V
#undef PG8_WAIT_L
#undef PG8_BAR
#undef PG8_SCHED
}
}


constexpr int TAB_OFF = 131072;
DI void build_tables(const Params& p, char* lds) {
  int* T = (int*)(lds + TAB_OFF); unsigned char* te = (unsigned char*)(T + 80);
  __syncthreads();
  if (tid_() == 0) {
    int acc = 0;
    for (int e = 0; e < NEXP; ++e) { const int c = ws_cnt(p)[e]; T[e] = c; T[32 + e] = acc; const int nt = (c + 255) >> 8; for (int k = 0; k < nt; ++k) te[acc + k] = (unsigned char)e; acc += nt; }
    T[64] = acc;
  }
  __syncthreads();
}
template <bool GATHER_> struct GroupOrderT { static constexpr bool GATHER = GATHER_; const int* T; const unsigned char* te; int G, c; const int* list;
  DI bool next(int i, pg8::Unit& u) const { const int L = i * G + c; if (L >= T[64] * 4) return false; u.pm = L >> 2; u.pn = L & 3; u.e = te[u.pm]; return true; }
  DI void a_ready(const pg8::Unit&) const {}
  DI void done(const pg8::Unit&) const {}
  DI int arow(const pg8::Unit& u, int r) const {
    const int slot = (u.pm - T[32 + u.e]) * 256 + r; return slot < T[u.e] ? (list[u.e * LCAP + slot] >> 1) : 0; } };
typedef GroupOrderT<false> GroupOrder;

struct EpiProjP { static constexpr bool PERM = true, AFTER_DRAIN = false; bf16_t* O; int ldc;
  DI void operator()(const f32x4 (&acc)[2][2][4][2], const pg8::Unit& u, int wr, int wc, int fr, int fq) const {
    const int row0 = u.pm * 256 + wr * 64 + fr, col0 = u.pn * 256 + wc * 32 + 8 * fq;
#pragma unroll
    for (int ai = 0; ai < 2; ++ai)
#pragma unroll
      for (int m = 0; m < 4; ++m) { bf16_t* rowp = O + (size_t)(row0 + ai * 128 + m * 16) * ldc + col0;
#pragma unroll
        for (int bj = 0; bj < 2; ++bj) { const f32x4 v0 = acc[ai][bj][m][0] + 0.0f, v1 = acc[ai][bj][m][1] + 0.0f;
          u32x4 w; w.x = cvtpk(v0[0], v0[1]); w.y = cvtpk(v0[2], v0[3]); w.z = cvtpk(v1[0], v1[1]); w.w = cvtpk(v1[2], v1[3]);
          *(u32x4*)(rowp + bj * 128) = w; } }
  } };
DI void phase2_pg8(const Params& p, int bid, int nb, char* lds) {
  pg8::Gemm g{ws_h1(p), ws_wtin(p), NTOK, PROJ_LD, DM, 0};
  pg8::StaticOrder S; S.init(NTOK, PROJ_LD, nb, bid);
  EpiProjP E{ws_proj(p), PROJ_LD};
  __syncthreads();
  pg8::gemm_phase<EpiProjP, pg8::StaticOrder, true, true>((PG8_LAS unsigned char*)lds, g, S, E);
  __syncthreads();
}
struct EpiResidP { static constexpr bool PERM = false, AFTER_DRAIN = false; const float* x; const float* mod; float* o;
  DI void operator()(const f32x4 (&acc)[2][2][4][2], const pg8::Unit& u, int wr, int wc, int fr, int fq) const {
    const int row0 = u.pm * 256 + wr * 64 + fr, col0 = u.pn * 256 + wc * 32 + 4 * fq;
#pragma unroll
    for (int ai = 0; ai < 2; ++ai)
#pragma unroll
      for (int m = 0; m < 4; ++m) { const int row = row0 + ai * 128 + m * 16, b = row >> 11;
#pragma unroll
        for (int bj = 0; bj < 2; ++bj)
#pragma unroll
          for (int n = 0; n < 2; ++n) { const int col = col0 + bj * 128 + n * 16; const size_t idx = (size_t)row * DM + col;
            const f32x4 xv = *(const f32x4*)(x + idx), gv = *(const f32x4*)(mod + b * 6144 + 2048 + col);
            *(f32x4*)(o + idx) = xv + (gv + 1.0f) * acc[ai][bj][m][n]; } }
  } };
DI void phase6_pg8(const Params& p, int bid, int nb, char* lds) {
  pg8::Gemm g{ws_mix(p), ws_wtout(p), NTOK, DM, DM, 0};
  pg8::StaticOrder S; S.init(NTOK, DM, nb, bid);
  EpiResidP E{p.x, ws_mod(p), ws_x1(p)};
  __syncthreads();
  pg8::gemm_phase<EpiResidP, pg8::StaticOrder, true, true>((PG8_LAS unsigned char*)lds, g, S, E);
  __syncthreads();
}
DI bf16_t* ws_h2s(const Params& p) { return (bf16_t*)(p.ws + OFF_C); }
DI bf16_t* ws_hidp(const Params& p) { return (bf16_t*)(p.ws + OFF_F); }
DI void phase7c(const Params& p, int bid, int nb, char* lds) {
  build_tables(p, lds);
  const int* T = (const int*)(lds + TAB_OFF);
  const int lane = tid_() & 63, gw = bid * 8 + (tid_() >> 6), nw = nb * 8;
  for (int e = 0; e < NEXP; ++e) {
    const int c = T[e]; const size_t r0 = (size_t)T[32 + e] * 256;
    for (int r = gw; r < c; r += nw) {
      const int tok = ws_list(p)[e * LCAP + r] >> 1;
      const u32x4* src = (const u32x4*)(ws_h2(p) + (size_t)tok * DM); u32x4* dst = (u32x4*)(ws_h2s(p) + (r0 + r) * DM);
      dst[lane] = src[lane]; dst[lane + 64] = src[lane + 64];
    }
  }
}
struct EpiSwiGLU { static constexpr bool PERM = true, AFTER_DRAIN = false; bf16_t* O;
  DI void operator()(const f32x4 (&acc)[2][2][4][2], const pg8::Unit& u, int wr, int wc, int fr, int fq) const {
    const int row0 = u.pm * 256 + wr * 64 + fr, col0 = u.pn * 128 + wc * 32 + 8 * fq;
#pragma unroll
    for (int ai = 0; ai < 2; ++ai)
#pragma unroll
      for (int m = 0; m < 4; ++m) {
        float hv[8];
#pragma unroll
        for (int n = 0; n < 2; ++n)
#pragma unroll
          for (int i = 0; i < 4; ++i) { const float gt = acc[ai][0][m][n][i], up = acc[ai][1][m][n][i]; hv[n * 4 + i] = gt / (1.0f + __expf(-gt)) * up; }
        u32x4 w; w.x = cvtpk(hv[0], hv[1]); w.y = cvtpk(hv[2], hv[3]); w.z = cvtpk(hv[4], hv[5]); w.w = cvtpk(hv[6], hv[7]);
        *(u32x4*)(O + (size_t)(row0 + ai * 128 + m * 16) * DEXP + col0) = w; }
  } };
DI void phase8_pg8(const Params& p, int bid, int nb, char* lds) {
  build_tables(p, lds);
  pg8::Gemm g{ws_h2(p), ws_wgu(p), 0, 1024, DM, (size_t)1024 * 1024 * 2};
  GroupOrderT<true> S{(const int*)(lds + TAB_OFF), (const unsigned char*)((const int*)(lds + TAB_OFF) + 80), nb, bid, ws_list(p)};
  EpiSwiGLU E{ws_hidp(p)};
  pg8::gemm_phase<EpiSwiGLU, GroupOrderT<true>, true, true>((PG8_LAS unsigned char*)lds, g, S, E);
  __syncthreads();
}
struct EpiYP { static constexpr bool PERM = true, AFTER_DRAIN = false; bf16_t* O; const int* list; const float* wa; const int* T;
  DI void operator()(const f32x4 (&acc)[2][2][4][2], const pg8::Unit& u, int wr, int wc, int fr, int fq) const {
    const int cnt = T[u.e], rbase = (u.pm - T[32 + u.e]) * 256 + wr * 64 + fr, col0 = u.pn * 256 + wc * 32 + 8 * fq;
#pragma unroll
    for (int ai = 0; ai < 2; ++ai)
#pragma unroll
      for (int m = 0; m < 4; ++m) { const int r = rbase + ai * 128 + m * 16;
        if (r < cnt) { const int aid = list[u.e * LCAP + r]; const float wv = wa[aid]; bf16_t* rowp = O + (size_t)aid * DM + col0;
#pragma unroll
          for (int bj = 0; bj < 2; ++bj) { const f32x4 v0 = acc[ai][bj][m][0] * wv, v1 = acc[ai][bj][m][1] * wv;
            u32x4 w; w.x = cvtpk(v0[0], v0[1]); w.y = cvtpk(v0[2], v0[3]); w.z = cvtpk(v1[0], v1[1]); w.w = cvtpk(v1[2], v1[3]);
            *(u32x4*)(rowp + bj * 128) = w; } } }
  } };
DI void phase9_pg8(const Params& p, int bid, int nb, char* lds) {
  build_tables(p, lds);
  pg8::Gemm g{ws_hidp(p), ws_wd(p), 0, 1024, DEXP, (size_t)1024 * 512 * 2};
  GroupOrder S{(const int*)(lds + TAB_OFF), (const unsigned char*)((const int*)(lds + TAB_OFF) + 80), nb, bid, nullptr};
  EpiYP E{ws_ybuf(p), ws_list(p), ws_wa(p), (const int*)(lds + TAB_OFF)};
  pg8::gemm_phase<EpiYP, GroupOrder, true, true>((PG8_LAS unsigned char*)lds, g, S, E);
  __syncthreads();
}

typedef float f32x4m __attribute__((ext_vector_type(4)));
constexpr int H_LD = 1028;
DI void split8(const float* x, bf16x8& hi, bf16x8& lo) {
  u32x4 wh, wl; float r[8];
  wh.x = cvtpk(x[0], x[1]); wh.y = cvtpk(x[2], x[3]); wh.z = cvtpk(x[4], x[5]); wh.w = cvtpk(x[6], x[7]);
  r[0] = x[0] - __uint_as_float(wh.x << 16); r[1] = x[1] - __uint_as_float(wh.x & 0xffff0000u); r[2] = x[2] - __uint_as_float(wh.y << 16); r[3] = x[3] - __uint_as_float(wh.y & 0xffff0000u);
  r[4] = x[4] - __uint_as_float(wh.z << 16); r[5] = x[5] - __uint_as_float(wh.z & 0xffff0000u); r[6] = x[6] - __uint_as_float(wh.w << 16); r[7] = x[7] - __uint_as_float(wh.w & 0xffff0000u);
  wl.x = cvtpk(r[0], r[1]); wl.y = cvtpk(r[2], r[3]); wl.z = cvtpk(r[4], r[5]); wl.w = cvtpk(r[6], r[7]);
  hi = *reinterpret_cast<bf16x8*>(&wh); lo = *reinterpret_cast<bf16x8*>(&wl);
}
DI void phase7(const Params& p, int bid, int nb, char* lds) {
  const int t = tid_(), lane = t & 63, wid = t >> 6, l16 = lane & 15, lg4 = lane >> 4;
  float* H = (float*)lds;
  float* part = H + 16 * H_LD;
  float* lgt = part + 8 * 16 * 48;
  int* ecnt = (int*)(lgt + 16 * 16 * 48);
  int* ebase = ecnt + 32;
  int* sl_aid = ebase + 32;
  int* sl_e = sl_aid + 512;
  const float* mod = ws_mod(p);
  if (t < NEXP) ecnt[t] = 0;
  int nloc = 0;
  bf16x8 rbh[4][3], rbl[4][3];
  {
#pragma unroll
    for (int ks = 0; ks < 4; ++ks)
#pragma unroll
      for (int nt = 0; nt < 3; ++nt) {
        float w[8];
#pragma unroll
        for (int j = 0; j < 8; ++j) { const int k = wid * 128 + ks * 32 + lg4 * 8 + j;
          w[j] = (nt < 2) ? p.w_expert[(size_t)k * 32 + nt * 16 + l16] : ((l16 < 4) ? p.w_group[(size_t)k * 4 + (l16 & 3)] : 0.f); }
        split8(w, rbh[ks][nt], rbl[ks][nt]);
      }
  }
  f32x4 pv[2][4];
#define P7_PF(tile_) do { _Pragma("unroll") for (int q_ = 0; q_ < 2; ++q_) { const float* xr_ = ws_x1(p) + (size_t)((tile_) * 16 + wid * 2 + q_) * DM + lane * 4; \
      _Pragma("unroll") for (int i_ = 0; i_ < 4; ++i_) pv[q_][i_] = *(const f32x4*)(xr_ + 256 * i_); } } while (0)
  if (bid < NTOK / 16) P7_PF(bid);
  for (int tile = bid; tile < NTOK / 16; tile += nb) {
    __syncthreads();
#pragma unroll
    for (int q = 0; q < 2; ++q) {
      const int tl = wid * 2 + q, gt = tile * 16 + tl, b = gt >> 11;
      f32x4 v[4]; float ss = 0.f;
#pragma unroll
      for (int i = 0; i < 4; ++i) { v[i] = pv[q][i]; ss += v[i][0] * v[i][0] + v[i][1] * v[i][1] + v[i][2] * v[i][2] + v[i][3] * v[i][3]; }
      ss = wave_sum(ss);
      const float rstd = rsqrtf(ss * (1.0f / DM) + 1e-6f);
#pragma unroll
      for (int i = 0; i < 4; ++i) {
        const int col = lane * 4 + 256 * i;
        const f32x4 g = *(const f32x4*)(p.norm2_g + col), sh = *(const f32x4*)(mod + b * 6144 + 3072 + col), sc = *(const f32x4*)(mod + b * 6144 + 4096 + col);
        f32x4 o;
#pragma unroll
        for (int j = 0; j < 4; ++j) o[j] = v[i][j] * rstd * g[j] * (1.0f + sc[j]) + sh[j];
        *(f32x4*)(H + tl * H_LD + col) = o;
        u32x2 w; w.x = cvtpk(o[0], o[1]); w.y = cvtpk(o[2], o[3]);
        *(u32x2*)(ws_h2(p) + (size_t)gt * DM + col) = w;
      }
    }
    if (tile + nb < NTOK / 16) P7_PF(tile + nb);
    __syncthreads();
    {
      f32x4m acc0 = {0.f, 0.f, 0.f, 0.f}, acc1 = acc0, acc2 = acc0;
      const float* hrow = H + l16 * H_LD + wid * 128 + lg4 * 8;
#pragma unroll
      for (int ks = 0; ks < 4; ++ks) {
        const f32x4 h0 = *(const f32x4*)(hrow + ks * 32), h1 = *(const f32x4*)(hrow + ks * 32 + 4);
        const float hv[8] = {h0[0], h0[1], h0[2], h0[3], h1[0], h1[1], h1[2], h1[3]};
        bf16x8 ah, al; split8(hv, ah, al);
        acc0 = __builtin_amdgcn_mfma_f32_16x16x32_bf16(al, rbh[ks][0], acc0, 0, 0, 0); acc1 = __builtin_amdgcn_mfma_f32_16x16x32_bf16(al, rbh[ks][1], acc1, 0, 0, 0); acc2 = __builtin_amdgcn_mfma_f32_16x16x32_bf16(al, rbh[ks][2], acc2, 0, 0, 0);
        acc0 = __builtin_amdgcn_mfma_f32_16x16x32_bf16(ah, rbl[ks][0], acc0, 0, 0, 0); acc1 = __builtin_amdgcn_mfma_f32_16x16x32_bf16(ah, rbl[ks][1], acc1, 0, 0, 0); acc2 = __builtin_amdgcn_mfma_f32_16x16x32_bf16(ah, rbl[ks][2], acc2, 0, 0, 0);
        acc0 = __builtin_amdgcn_mfma_f32_16x16x32_bf16(ah, rbh[ks][0], acc0, 0, 0, 0); acc1 = __builtin_amdgcn_mfma_f32_16x16x32_bf16(ah, rbh[ks][1], acc1, 0, 0, 0); acc2 = __builtin_amdgcn_mfma_f32_16x16x32_bf16(ah, rbh[ks][2], acc2, 0, 0, 0);
      }
#pragma unroll
      for (int r = 0; r < 4; ++r) {
        float* pr = part + (wid * 16 + lg4 * 4 + r) * 48;
        pr[l16] = acc0[r]; pr[16 + l16] = acc1[r]; pr[32 + l16] = acc2[r];
      }
    }
    __syncthreads();
    for (int idx = t; idx < 16 * 36; idx += NTHR) {
      const int tok = idx / 36, o = idx % 36;
      float sacc = 0.f;
#pragma unroll
      for (int w = 0; w < 8; ++w) sacc += part[(w * 16 + tok) * 48 + o];
      sacc += (o < 32) ? p.b_expert[o] : p.b_group[o - 32];
      lgt[(nloc * 16 + tok) * 48 + o] = sacc;
    }
    ++nloc;
  }
  __syncthreads();
  for (int idx = t; idx < nloc * 16; idx += NTHR) {
    {
      const int kl = idx >> 4, t16 = idx & 15, tile = bid + kl * nb;
      const float* l = lgt + idx * 48;
      int gs = 0; float gm = l[32];
      for (int g = 1; g < 4; ++g) if (l[32 + g] > gm) { gm = l[32 + g]; gs = g; }
      float gsum = 0.f;
      for (int g = 0; g < 4; ++g) gsum += expf(l[32 + g] - gm);
      const float pgroup = 1.0f / gsum;
      const float* el = l + gs * 8;
      float em = el[0];
      for (int e = 1; e < 8; ++e) em = fmaxf(em, el[e]);
      float pe[8], esum = 0.f;
      for (int e = 0; e < 8; ++e) { pe[e] = expf(el[e] - em); esum += pe[e]; }
      for (int e = 0; e < 8; ++e) pe[e] /= esum;
      int i0 = 0;
      for (int e = 1; e < 8; ++e) if (pe[e] > pe[i0]) i0 = e;
      int i1 = (i0 == 0) ? 1 : 0;
      for (int e = 0; e < 8; ++e) if (e != i0 && pe[e] > pe[i1]) i1 = e;
      const float den = pe[i0] + pe[i1];
      const int tok = tile * 16 + t16;
      const int e0 = gs * 8 + i0, e1 = gs * 8 + i1;
      ws_wa(p)[tok * 2] = pgroup * pe[i0] / den; ws_wa(p)[tok * 2 + 1] = pgroup * pe[i1] / den;
      const int slot = kl * 32 + t16 * 2;
      sl_aid[slot] = tok * 2; sl_aid[slot + 1] = tok * 2 + 1;
      sl_e[slot] = e0 | (atomicAdd(ecnt + e0, 1) << 8); sl_e[slot + 1] = e1 | (atomicAdd(ecnt + e1, 1) << 8);
    }
  }
  __syncthreads();
  if (t < NEXP) ebase[t] = ecnt[t] ? atomicAdd(ws_cnt(p) + t, ecnt[t]) : 0;
  __syncthreads();
  for (int sidx = t; sidx < nloc * 32; sidx += NTHR) { const int ev = sl_e[sidx], e = ev & 255, r = ev >> 8; ws_list(p)[e * LCAP + ebase[e] + r] = sl_aid[sidx]; }
}
DI void phase7_tr(const Params& p, int bid, int nb, char* lds) {
  const int t = tid_();
  {
    float* tile = (float*)lds;
    const int ln4 = (t & 31) * 4, lkr = t >> 5, snr = t >> 2, skc = (t & 3) * 16;
#define MOE_TSRC(task_, src_, k0_, n0_, N_) const float* src_; int k0_, n0_, N_; { const int wh_ = (task_) >> 11, q_ = (task_) & 2047, e_ = q_ >> 6, r_ = q_ & 63; \
      if (wh_ < 2) { k0_ = (r_ >> 2) * 64; n0_ = (r_ & 3) * 128; N_ = 512; src_ = (wh_ == 0 ? p.e_gate : p.e_up) + (size_t)e_ * 1024 * 512; } \
      else { k0_ = (r_ >> 3) * 64; n0_ = (r_ & 7) * 128; N_ = 1024; src_ = p.e_down + (size_t)e_ * 512 * 1024; } }
    f32x4 g[4];
    int task = bid;
    if (task < 6144) { MOE_TSRC(task, src, k0, n0, N);
#pragma unroll
      for (int i = 0; i < 4; ++i) g[i] = *(const f32x4*)(src + (size_t)(k0 + lkr + 16 * i) * N + n0 + ln4); }
    for (; task < 6144; task += nb) {
      __syncthreads();
#pragma unroll
      for (int i = 0; i < 4; ++i) { float* d = tile + (lkr + 16 * i) * 129 + ln4; d[0] = g[i][0]; d[1] = g[i][1]; d[2] = g[i][2]; d[3] = g[i][3]; }
      if (task + nb < 6144) { MOE_TSRC(task + nb, src, k0, n0, N);
#pragma unroll
        for (int i = 0; i < 4; ++i) g[i] = *(const f32x4*)(src + (size_t)(k0 + lkr + 16 * i) * N + n0 + ln4); }
      __syncthreads();
      const int which = task >> 11, q = task & 2047, e = q >> 6, r = q & 63;
      float v[16];
#pragma unroll
      for (int j = 0; j < 16; ++j) v[j] = tile[(skc + j) * 129 + snr];
      u32x4 w0, w1;
      w0.x = cvtpk(v[0], v[1]); w0.y = cvtpk(v[2], v[3]); w0.z = cvtpk(v[4], v[5]); w0.w = cvtpk(v[6], v[7]);
      w1.x = cvtpk(v[8], v[9]); w1.y = cvtpk(v[10], v[11]); w1.z = cvtpk(v[12], v[13]); w1.w = cvtpk(v[14], v[15]);
      bf16_t* dst;
      if (which < 2) { const int k0 = (r >> 2) * 64, n = (r & 3) * 128 + snr; dst = ws_wgu(p) + (size_t)e * 1024 * 1024 + (size_t)((n >> 7) * 256 + (n & 127) + which * 128) * 1024 + k0 + skc; }
      else { const int k0 = (r >> 3) * 64, n = (r & 7) * 128 + snr; dst = ws_wd(p) + (size_t)e * 1024 * 512 + (size_t)n * 512 + k0 + skc; }
      *(u32x4*)dst = w0; *(u32x4*)(dst + 8) = w1;
    }
  }
}

struct Seg { int e, r0, cnt, start; };
DI Seg find_seg(const int* cnt, int mtile) {
  Seg s; s.e = -1; int acc = 0, start = 0;
  for (int e = 0; e < NEXP; ++e) { const int c = cnt[e], nt = (c + GBM - 1) / GBM; if (mtile < acc + nt) { s.e = e; s.r0 = (mtile - acc) * GBM; s.cnt = c; s.start = start; return s; } acc += nt; start += c; }
  return s;
}
struct ARowList { const int* list; int r0, cnt; DI int operator()(int r) const { int q = r0 + r; q = q < cnt ? q : cnt - 1; return list[q] >> 1; } };
struct EpiHid { bf16_t* o; int row0, nvalid, col0; DI void operator()(int r, int c, float g, float u) const {
  if (r < nvalid) o[(size_t)(row0 + r) * DEXP + ((col0 + c) >> 6) * 32 + (c & 31)] = f2bf(g / (1.0f + __expf(-g)) * u); } };
DI void phase8(const Params& p, int bid, int nb, char* lds) {
  const int* cnt = ws_cnt(p);
  for (int tile = bid; tile < 288 * 8; tile += nb) {
    const Seg s = find_seg(cnt, tile >> 3);
    if (s.e < 0) break;
    const int nt = tile & 7;
    gemm_tile(ws_h2(p), DM, ARowList{ws_list(p) + s.e * LCAP, s.r0, s.cnt}, ws_wgu(p) + (size_t)s.e * 1024 * 1024, DM, nt * GBN, DM,
              EpiHid{ws_hid(p), s.start + s.r0, s.cnt - s.r0, nt * GBN}, lds);
  }
}
struct ARowClamp { int base, r0, cnt; DI int operator()(int r) const { int q = r0 + r; q = q < cnt ? q : cnt - 1; return base + q; } };
struct EpiY { bf16_t* o; const int* list; const float* wa; int r0, cnt, col0; DI void operator()(int r, int c, float v0, float v1) const {
  if (r0 + r < cnt) { const int aid = list[r0 + r]; const float w = wa[aid]; bf16_t* q = o + (size_t)aid * DM + col0 + c; q[0] = f2bf(v0 * w); q[32] = f2bf(v1 * w); } } };
DI void phase9(const Params& p, int bid, int nb, char* lds) {
  const int* cnt = ws_cnt(p);
  for (int tile = bid; tile < 288 * 8; tile += nb) {
    const Seg s = find_seg(cnt, tile >> 3);
    if (s.e < 0) break;
    const int nt = tile & 7;
    gemm_tile(ws_hid(p), DEXP, ARowClamp{s.start, s.r0, s.cnt}, ws_wd(p) + (size_t)s.e * 1024 * 512, DEXP, nt * GBN, DEXP,
              EpiY{ws_ybuf(p), ws_list(p) + s.e * LCAP, ws_wa(p), s.r0, s.cnt, nt * GBN}, lds);
  }
}

DI void phase10(const Params& p, int bid, int nb, char* lds) {
  const int lane = tid_() & 63, wid = tid_() >> 6;
  const float* mod = ws_mod(p); const float* fm = ws_fmod(p);
  for (int gt = bid * 8 + wid; gt < NTOK; gt += nb * 8) {
    const int b = gt >> 11;
    const float* xr = ws_x1(p) + (size_t)gt * DM; float* xo = p.out + (size_t)gt * DM;
    const bf16_t* ya = ws_ybuf(p) + (size_t)(gt * 2) * DM; const bf16_t* yb = ya + DM;
    f32x4 v[4]; float ss = 0.f;
#pragma unroll
    for (int i = 0; i < 4; ++i) {
      const int col = lane * 4 + 256 * i;
      v[i] = *(const f32x4*)(xr + col);
      const u32x2 a = *(const u32x2*)(ya + col), bq = *(const u32x2*)(yb + col);
      const f32x4 g2 = *(const f32x4*)(mod + b * 6144 + 5120 + col);
      const float m0 = __uint_as_float(a.x << 16) + __uint_as_float(bq.x << 16), m1 = __uint_as_float(a.x & 0xffff0000u) + __uint_as_float(bq.x & 0xffff0000u);
      const float m2 = __uint_as_float(a.y << 16) + __uint_as_float(bq.y << 16), m3 = __uint_as_float(a.y & 0xffff0000u) + __uint_as_float(bq.y & 0xffff0000u);
      v[i][0] += (1.0f + g2[0]) * m0; v[i][1] += (1.0f + g2[1]) * m1; v[i][2] += (1.0f + g2[2]) * m2; v[i][3] += (1.0f + g2[3]) * m3;
      ss += v[i][0] * v[i][0] + v[i][1] * v[i][1] + v[i][2] * v[i][2] + v[i][3] * v[i][3];
    }
    ss = wave_sum(ss);
    const float rstd = rsqrtf(ss * (1.0f / DM) + 1e-6f);
#pragma unroll
    for (int i = 0; i < 4; ++i) {
      const int col = lane * 4 + 256 * i;
      const f32x4 g = *(const f32x4*)(p.final_norm_g + col), sh = *(const f32x4*)(fm + b * 2048 + col), sc = *(const f32x4*)(fm + b * 2048 + 1024 + col);
      f32x4 o;
#pragma unroll
      for (int j = 0; j < 4; ++j) o[j] = v[i][j] * rstd * g[j] * (1.0f + sc[j]) + sh[j];
      *(f32x4*)(xo + col) = o;
    }
  }
}

#define XB_TMO      128
#define XB_XCNT(j)  (256  + 64 * (j))
#define XB_XSUB(j)  (1280 + 64 * (j))
#define XB_XGEN(j)  (2304 + 64 * (j))
#define XB_TOP      3328
#define XB_TOPGEN   3392
#define XCD_BAR_WORDS 3456
#define XB_SPIN_CAP (1u << 18)
#define XLAS __attribute__((address_space(3)))

__device__ __forceinline__ unsigned xb_ld(unsigned* p)              { return __hip_atomic_load(p, __ATOMIC_RELAXED, __HIP_MEMORY_SCOPE_AGENT); }
__device__ __forceinline__ unsigned xb_add(unsigned* p, unsigned v) { return __hip_atomic_fetch_add(p, v, __ATOMIC_RELAXED, __HIP_MEMORY_SCOPE_AGENT); }
__device__ __forceinline__ unsigned xb_xcc_id() { return (unsigned)__builtin_amdgcn_s_getreg((3 << 11) | 20) & 0xFu; }
#define XB_SPIN(cond, bar) do { unsigned _sp = 0; while (cond) { __builtin_amdgcn_s_sleep(1); \
    if ((++_sp & 255u) == 0u) { if (xb_ld(&(bar)[XB_TMO])) break; if (_sp > XB_SPIN_CAP) { atomicAdd(&(bar)[XB_TMO], 1u); break; } } } } while (0)

struct XcdBarrier {
    unsigned* bar; unsigned x;
    volatile XLAS unsigned* st;
};

__device__ __forceinline__ XcdBarrier xcd_barrier_post(unsigned* bar, volatile XLAS unsigned* st) {
    XcdBarrier b; b.bar = bar; b.x = xb_xcc_id(); b.st = st;
    if (threadIdx.x == 0) (void)xb_add(&bar[XB_XCNT(b.x)], 1u);
    return b;
}
__device__ __forceinline__ void xcd_barrier_complete(unsigned* bar, unsigned x, unsigned& nloc, unsigned& nx) {
    const unsigned G = gridDim.x * gridDim.y * gridDim.z;
    unsigned sum, cnt, mine, sp = 0u;
    for (;;) {
        sum = 0u; cnt = 0u; mine = 0u;
#pragma unroll
        for (unsigned j = 0; j < 16; ++j) { const unsigned c = xb_ld(&bar[XB_XCNT(j)]); sum += c; cnt += (c > 0u) ? 1u : 0u; mine = (j == x) ? c : mine; }
        if (sum == G) break;
        __builtin_amdgcn_s_sleep(1);
        if ((++sp & 255u) == 0u) { if (xb_ld(&bar[XB_TMO])) break; if (sp > XB_SPIN_CAP) { atomicAdd(&bar[XB_TMO], 1u); break; } }
    }
    nloc = mine > 0u ? mine : 1u; nx = cnt > 0u ? cnt : 1u;
}

__device__ __forceinline__ void xcd_barrier(const XcdBarrier& b) {
    asm volatile("s_waitcnt vmcnt(0)" ::: "memory");
    __syncthreads();
    if (threadIdx.x == 0) {
        unsigned* bar = b.bar;
        __builtin_amdgcn_s_waitcnt(0);
        unsigned nloc = b.st[0], nx = b.st[1];
        if (nloc == 0u) { xcd_barrier_complete(bar, b.x, nloc, nx); b.st[0] = nloc; b.st[1] = nx; }
        const unsigned old = xb_add(&bar[XB_XSUB(b.x)], 1u);
        const unsigned gen = old / nloc;
        if (old + 1u == (gen + 1u) * nloc) {
            __builtin_amdgcn_fence(__ATOMIC_RELEASE, "agent");
            asm volatile("s_waitcnt vmcnt(0)" ::: "memory");
            const unsigned og = xb_add(&bar[XB_TOP], 1u);
            const unsigned tg = og / nx;
            if (og + 1u == (tg + 1u) * nx) xb_add(&bar[XB_TOPGEN], 1u);
            else XB_SPIN(xb_ld(&bar[XB_TOPGEN]) == tg, bar);
            __builtin_amdgcn_fence(__ATOMIC_ACQUIRE, "agent");
            xb_add(&bar[XB_XGEN(b.x)], 1u);
            asm volatile("s_waitcnt vmcnt(0)" ::: "memory");
        } else {
            XB_SPIN(xb_ld(&bar[XB_XGEN(b.x)]) == gen, bar);
            __builtin_amdgcn_fence(__ATOMIC_ACQUIRE, "agent");
            asm volatile("s_waitcnt vmcnt(0)" ::: "memory");
        }
    }
    __syncthreads();
}

#if MEGA
__global__ void __launch_bounds__(NTHR) k_mega(Params p) {
  extern __shared__ __attribute__((aligned(16))) char smem[];
  cg::grid_group grid = cg::this_grid();
  const int bid = blockIdx.x, nb = gridDim.x;
  volatile XLAS unsigned* xst = (volatile XLAS unsigned*)(XLAS char*)(smem + LDS_BYTES - 64);
  if (threadIdx.x < 4) xst[threadIdx.x] = 0u;
  if (bid == 0) for (int i = threadIdx.x; i < XCD_BAR_WORDS; i += NTHR) ws_bar(p)[i] = 0u;
  phase0(p, bid, nb, smem);
  grid.sync();
  XcdBarrier xb = xcd_barrier_post(ws_bar(p), xst);
#define SEAM() xcd_barrier(xb)
  phase1(p, bid, nb, smem); SEAM();
  phase2_pg8(p, bid, nb, smem); SEAM();
  phase3_mfma<3>(p, bid, nb, smem); SEAM();
  phase4a_chunk(p, bid, nb, smem); phase4b_mfma(p, bid, nb, smem); SEAM();
  phase5a(p, bid, nb, smem); phase5b_mfma(p, bid, nb, smem); SEAM();
  phase6_pg8(p, bid, nb, smem); SEAM();
  phase7(p, bid, nb, smem); SEAM();
  phase8_pg8(p, bid, nb, smem); SEAM();
  phase9_pg8(p, bid, nb, smem); SEAM();
  phase10(p, bid, nb, smem);
}
#else
#define PHASE_KERNEL(name, body) __global__ void __launch_bounds__(NTHR) name(Params p) { extern __shared__ __attribute__((aligned(16))) char smem[]; body(p, blockIdx.x, gridDim.x, smem); }
PHASE_KERNEL(k_phase0, phase0)
PHASE_KERNEL(k_phase1, phase1)
PHASE_KERNEL(k_phase2, phase2)
PHASE_KERNEL(k_phase3a, phase3a)
PHASE_KERNEL(k_phase3b, phase3b)
PHASE_KERNEL(k_phase4a, phase4a)
PHASE_KERNEL(k_phase4a2, phase4a_v2)
PHASE_KERNEL(k_phase4a3, phase4a_v3)
PHASE_KERNEL(k_phase4b, phase4b)
PHASE_KERNEL(k_phase4bm, phase4b_mfma)
PHASE_KERNEL(k_phase3m, phase3_mfma<3>)
PHASE_KERNEL(k_phase5a, phase5a)
PHASE_KERNEL(k_phase5b, phase5b)
PHASE_KERNEL(k_phase5bm, phase5b_mfma)
PHASE_KERNEL(k_phase6, phase6)
PHASE_KERNEL(k_phase7, phase7)
PHASE_KERNEL(k_phase8, phase8)
PHASE_KERNEL(k_phase9, phase9)
PHASE_KERNEL(k_phase10, phase10)
#endif

extern "C" void kernel_launch(void* const* d_in, const int* in_sizes, int n_in, void* d_out, int out_size, void* d_ws, size_t ws_size, hipStream_t stream) {
  Params p{};
  const float** f = (const float**)&p;
  for (int i = 0; i < 33; ++i) f[i] = (const float*)d_in[i];
  p.out = (float*)d_out; p.ws = (char*)d_ws;
  if (n_in != 33 || ws_size < (size_t)(OFF_S + 9 * MiB) || out_size != NTOK * DM) { fprintf(stderr, "kernel_launch: unexpected problem shape or workspace (n_in %d, ws %zu, out %d)\n", n_in, ws_size, out_size); return; }
#if MEGA
  static int grid_blocks = 0;
  if (!grid_blocks) {
    int dev = 0, cus = 0, per_cu = 0;
    hipGetDevice(&dev);
    hipDeviceGetAttribute(&cus, hipDeviceAttributeMultiprocessorCount, dev);
    hipFuncSetAttribute((const void*)k_mega, hipFuncAttributeMaxDynamicSharedMemorySize, LDS_BYTES);
    hipOccupancyMaxActiveBlocksPerMultiprocessor(&per_cu, k_mega, NTHR, LDS_BYTES);
    if (per_cu > 1) per_cu = 1;
    grid_blocks = cus * per_cu;
  }
  void* args[] = {&p};
  hipError_t e = hipLaunchCooperativeKernel((void*)k_mega, dim3(grid_blocks), dim3(NTHR), args, LDS_BYTES, stream);
  if (e != hipSuccess) fprintf(stderr, "cooperative launch failed: %s (grid %d)\n", hipGetErrorString(e), grid_blocks);
#else
  const int G = 512;
#define LAUNCH(k, g) hipLaunchKernelGGL(k, dim3(g), dim3(NTHR), LDS_BYTES, stream, p)
  LAUNCH(k_phase0, G);
  LAUNCH(k_phase1, G);
  LAUNCH(k_phase2, G);
  LAUNCH(k_phase3a, G);
  LAUNCH(k_phase3b, G);
  LAUNCH(k_phase4a, 128);
  LAUNCH(k_phase4b, 1024);
  LAUNCH(k_phase5a, G);
  LAUNCH(k_phase5b, 1024);
  LAUNCH(k_phase6, G);
  LAUNCH(k_phase7, G);
  LAUNCH(k_phase8, G);
  LAUNCH(k_phase9, G);
  LAUNCH(k_phase10, G);
#endif
}
```

```cpp
#include <hip/hip_runtime.h>
#include <hip/hip_cooperative_groups.h>
#include <stdint.h>
#include <stdio.h>

namespace cg = cooperative_groups;

#ifndef MEGA
#define MEGA 1
#endif

typedef unsigned short bf16_t;
typedef short bf16x8 __attribute__((ext_vector_type(8)));
typedef float f32x16 __attribute__((ext_vector_type(16)));
typedef float f32x4 __attribute__((ext_vector_type(4)));
typedef float f32x4v __attribute__((ext_vector_type(4)));
typedef unsigned u32x4 __attribute__((ext_vector_type(4)));
typedef unsigned u32x2 __attribute__((ext_vector_type(2)));

#define DI __device__ __forceinline__

constexpr int DM = 1024, BATCH = 16, SEQ = 2048, NTOK = BATCH * SEQ;
constexpr int RW = 512, NH = 8, HD = 64;
constexpr int PROJ_N = 2756, PROJ_LD = 2816;
constexpr int C_R = 0, C_K = 512, C_V = 1024, C_WL = 1536, C_AL = 1600, C_GL = 1664;
constexpr int C_Q = 1792, C_CKV = 2304, C_QI = 2432, C_KI = 2688, C_WI = 2752;
constexpr int NEXP = 32, DEXP = 512, LCAP = 32768;
constexpr int NTHR = 512;
constexpr int LDS_BYTES = 163840;

constexpr size_t MiB = 1048576;
constexpr size_t OFF_A = 0;
constexpr size_t OFF_B = 64 * MiB;
constexpr size_t OFF_C = 240 * MiB;
constexpr size_t OFF_F = 400 * MiB;
constexpr size_t OFF_G = 464 * MiB;
constexpr size_t OFF_W = 484 * MiB;
constexpr size_t OFF_S = 492 * MiB;

struct Params {
  const float *x, *c, *ada_w, *ada_b, *norm1_g, *w_in, *shift_mu, *w0, *w_decay_up, *a0, *w_aaa_up, *w_gate_up;
  const float *k_k, *k_a, *r_k, *gn_g, *gn_b, *kv_norm_g, *k_idx_norm_g, *w_uk, *w_uv, *w_out, *norm2_g;
  const float *w_group, *b_group, *w_expert, *b_expert, *e_gate, *e_up, *e_down, *final_ada_w, *final_ada_b, *final_norm_g;
  float* out;
  char* ws;
};

DI int tid_() { int t = threadIdx.x; asm volatile("" : "+v"(t)); return t; }
DI float bf2f(bf16_t u) { return __uint_as_float(((unsigned)u) << 16); }
DI bf16_t f2bf(float f) { unsigned u = __float_as_uint(f); u += 0x7fffu + ((u >> 16) & 1u); return (bf16_t)(u >> 16); }
DI unsigned pack2(float lo, float hi) { return (unsigned)f2bf(lo) | ((unsigned)f2bf(hi) << 16); }
DI float wave_sum(float v) { for (int o = 32; o; o >>= 1) v += __shfl_xor(v, o); return v; }
DI float wave_max(float v) { for (int o = 32; o; o >>= 1) v = fmaxf(v, __shfl_xor(v, o)); return v; }
DI float sigmoidf_(float v) { return 1.0f / (1.0f + __expf(-v)); }
DI int crow(int r, int hi) { return (r & 3) + 8 * (r >> 2) + 4 * hi; }
DI unsigned cvtpk(float lo, float hi) { unsigned r; asm volatile("v_cvt_pk_bf16_f32 %0, %1, %2" : "=v"(r) : "v"(lo), "v"(hi)); return r; }

DI void unpack8(const u32x4 w, float* o) {
  o[0] = __uint_as_float(w.x << 16); o[1] = __uint_as_float(w.x & 0xffff0000u); o[2] = __uint_as_float(w.y << 16); o[3] = __uint_as_float(w.y & 0xffff0000u);
  o[4] = __uint_as_float(w.z << 16); o[5] = __uint_as_float(w.z & 0xffff0000u); o[6] = __uint_as_float(w.w << 16); o[7] = __uint_as_float(w.w & 0xffff0000u);
}
DI void load8(const bf16_t* p, float* o) { unpack8(*(const u32x4*)p, o); }

DI bf16_t* ws_h1(const Params& p) { return (bf16_t*)(p.ws + OFF_A); }
DI float* ws_y(const Params& p) { return (float*)(p.ws + OFF_A); }
DI bf16_t* ws_h2(const Params& p) { return (bf16_t*)(p.ws + OFF_A); }
DI bf16_t* ws_proj(const Params& p) { return (bf16_t*)(p.ws + OFF_B); }
DI bf16_t* ws_x1(const Params& p) { return (bf16_t*)(p.ws + OFF_B); }
DI f32x4 unpack4(const u32x2 a) { f32x4 r; r[0] = __uint_as_float(a.x << 16); r[1] = __uint_as_float(a.x & 0xffff0000u); r[2] = __uint_as_float(a.y << 16); r[3] = __uint_as_float(a.y & 0xffff0000u); return r; }
DI bf16_t* ws_wgu(const Params& p) { return (bf16_t*)p.out; }
DI bf16_t* ws_wd(const Params& p) { return (bf16_t*)((char*)p.out + 64 * MiB); }
DI bf16_t* ws_hid(const Params& p) { return (bf16_t*)(p.ws + OFF_B + 96 * MiB); }
DI bf16_t* ws_kp(const Params& p) { return (bf16_t*)(p.ws + OFF_C); }
DI bf16_t* ws_kk(const Params& p) { return (bf16_t*)(p.ws + OFF_C + 32 * MiB); }
DI bf16_t* ws_bb(const Params& p) { return (bf16_t*)(p.ws + OFF_C + 64 * MiB); }
DI bf16_t* ws_ee(const Params& p) { return (bf16_t*)(p.ws + OFF_C + 96 * MiB); }
DI bf16_t* ws_gg(const Params& p) { return (bf16_t*)(p.ws + OFF_C + 128 * MiB); }
DI bf16_t* ws_mix(const Params& p) { return (bf16_t*)(p.ws + OFF_C); }
DI bf16_t* ws_ybuf(const Params& p) { return (bf16_t*)(p.ws + OFF_C); }
DI bf16_t* ws_qlat(const Params& p) { return (bf16_t*)(p.ws + OFF_F); }
DI bf16_t* ws_ckv(const Params& p) { return (bf16_t*)(p.ws + OFF_G); }
DI bf16_t* ws_kidx(const Params& p) { return (bf16_t*)(p.ws + OFF_G + 8 * MiB); }
DI unsigned* ws_mask(const Params& p) { return (unsigned*)(p.ws + OFF_G + 12 * MiB); }
DI bf16_t* ws_wtin(const Params& p) { return (bf16_t*)(p.ws + OFF_W); }
DI bf16_t* ws_wtout(const Params& p) { return (bf16_t*)(p.ws + OFF_W + 6 * MiB); }
DI bf16_t* ws_wuvt(const Params& p) { return (bf16_t*)(p.ws + OFF_S + 7 * MiB); }
DI bf16_t* ws_wdt(const Params& p) { return (bf16_t*)(p.ws + OFF_S + 8 * MiB + 64 * 1024); }
DI bf16_t* ws_wat(const Params& p) { return (bf16_t*)(p.ws + OFF_S + 8 * MiB + 128 * 1024); }
DI bf16_t* ws_wgt(const Params& p) { return (bf16_t*)(p.ws + OFF_S + 8 * MiB + 192 * 1024); }
DI bf16_t* ws_wukt(const Params& p) { return (bf16_t*)(p.ws + OFF_S + 8 * MiB + 320 * 1024); }
DI unsigned* ws_bar(const Params& p) { return (unsigned*)(p.ws + OFF_S + 8 * MiB); }
DI float* ws_mod(const Params& p) { return (float*)(p.ws + OFF_S); }
DI float* ws_fmod(const Params& p) { return (float*)(p.ws + OFF_S + 512 * 1024); }
DI float* ws_bonus(const Params& p) { return (float*)(p.ws + OFF_S + 1 * MiB); }
DI int* ws_cnt(const Params& p) { return (int*)(p.ws + OFF_S + 2 * MiB); }
DI float* ws_wa(const Params& p) { return (float*)(p.ws + OFF_S + 2 * MiB + 4096); }
DI int* ws_list(const Params& p) { return (int*)(p.ws + OFF_S + 3 * MiB); }
DI float* ws_lw(const Params& p) { return (float*)(p.ws + OFF_G + 12 * MiB); }

template <class RowMap>
DI void transpose_tile(const float* src, int N, int k0, int n0, bf16_t* dst, int dstld, RowMap rm, char* lds) {
  float* tile = (float*)lds;
  const int t = tid_();
  __syncthreads();
  {
    const int nc = t & 63, krb = t >> 6;
#pragma unroll
    for (int i = 0; i < 8; ++i) {
      const int kr = krb + 8 * i;
      const int n = n0 + nc;
      tile[kr * 65 + nc] = (n < N) ? src[(size_t)(k0 + kr) * N + n] : 0.f;
    }
  }
  __syncthreads();
  {
    const int nr = t >> 3, kc = (t & 7) * 8;
    u32x4 w;
    w.x = pack2(tile[(kc + 0) * 65 + nr], tile[(kc + 1) * 65 + nr]);
    w.y = pack2(tile[(kc + 2) * 65 + nr], tile[(kc + 3) * 65 + nr]);
    w.z = pack2(tile[(kc + 4) * 65 + nr], tile[(kc + 5) * 65 + nr]);
    w.w = pack2(tile[(kc + 6) * 65 + nr], tile[(kc + 7) * 65 + nr]);
    *(u32x4*)(dst + (size_t)rm(n0 + nr) * dstld + k0 + kc) = w;
  }
}
struct RowId { DI int operator()(int n) const { return n; } };
struct RowGU { int add; DI int operator()(int n) const { return (n >> 7) * 256 + (n & 127) + add; } };

DI void phase0(const Params& p, int bid, int nb, char* lds) {
  const int t = tid_();
  if (bid == 0 && t < NEXP) ws_cnt(p)[t] = 0;
  for (int idx = bid * NTHR + t; idx < 8 * 64 * 128; idx += nb * NTHR) {
    const int e8 = idx & 7, ln = (idx >> 3) & 63, l32 = ln & 31, lh = ln >> 5;
    { const int hh = idx >> 13, i2 = (idx >> 12) & 1, ks = (idx >> 9) & 7, d = i2 * 32 + l32, cc = ks * 16 + lh * 8 + e8;
      ws_wuvt(p)[idx] = f2bf(p.w_uv[(size_t)(cc * NH + hh) * HD + d]); }
    { const int h2 = idx >> 13, mt = (idx >> 11) & 3, ks = (idx >> 9) & 3, c2 = mt * 32 + l32, d2 = ks * 16 + lh * 8 + e8;
      ws_wukt(p)[idx] = f2bf(p.w_uk[(size_t)(c2 * NH + h2) * HD + d2]); }
  }
  for (int idx = bid * NTHR + t; idx < 512 * 128; idx += nb * NTHR) {
    const int e8 = idx & 7, ln = (idx >> 3) & 63, l32 = ln & 31, lh = ln >> 5;
    { const int ks = (idx >> 9) & 7, mt = (idx >> 12) & 1, hh = idx >> 13, ch = hh * HD + mt * 32 + l32, k = ks * 16 + lh * 8 + e8;
      ws_wgt(p)[idx] = f2bf(p.w_gate_up[(size_t)k * RW + ch]); }
    if (idx < 512 * 64) { const int ks = (idx >> 9) & 3, mt = (idx >> 11) & 1, hh = idx >> 12, ch = hh * HD + mt * 32 + l32, k = ks * 16 + lh * 8 + e8;
      ws_wdt(p)[idx] = f2bf(p.w_decay_up[(size_t)k * RW + ch]); ws_wat(p)[idx] = f2bf(p.w_aaa_up[(size_t)k * RW + ch]); }
  }
  for (int task = bid; task < 256; task += nb) {
    float* cact = (float*)lds;
    __syncthreads();
    {
      float cv[32];
#pragma unroll
      for (int i = 0; i < 32; ++i) cv[i] = p.c[t + i * NTHR];
#pragma unroll
      for (int i = 0; i < 32; ++i) cact[t + i * NTHR] = cv[i] * __builtin_amdgcn_rcpf(1.0f + __expf(-cv[i]));
    }
    __syncthreads();
    const int col = task * 32 + (t & 31), ks = t >> 5;
    const float* w; int ld, cc;
    if (col < 6144) { w = p.ada_w; ld = 6144; cc = col; } else { w = p.final_ada_w; ld = 2048; cc = col - 6144; }
    float acc[16];
#pragma unroll
    for (int b = 0; b < 16; ++b) acc[b] = 0.f;
#pragma unroll 1
    for (int k8 = 0; k8 < 64; k8 += 16) {
      float wv[16];
#pragma unroll
      for (int u = 0; u < 16; ++u) wv[u] = w[(size_t)(ks * 64 + k8 + u) * ld + cc];
#pragma unroll
      for (int u = 0; u < 16; ++u) { const int k = ks * 64 + k8 + u;
#pragma unroll
        for (int b = 0; b < 16; ++b) acc[b] += cact[b * 1024 + k] * wv[u]; }
    }
    __syncthreads();
    float* red = (float*)lds;
#pragma unroll
    for (int b = 0; b < 16; ++b) red[(ks * 16 + b) * 32 + (t & 31)] = acc[b];
    __syncthreads();
    {
      const int b = t >> 5, cl = t & 31, colo = task * 32 + cl;
      float s = 0.f;
      for (int k2 = 0; k2 < 16; ++k2) s += red[(k2 * 16 + b) * 32 + cl];
      if (colo < 6144) ws_mod(p)[b * 6144 + colo] = s + p.ada_b[colo];
      else ws_fmod(p)[b * 2048 + colo - 6144] = s + p.final_ada_b[colo - 6144];
    }
  }
  for (int task = bid; task < 704 + 256; task += nb) {
    if (task < 704) { const int kt = task / 44, nt = task % 44; transpose_tile(p.w_in, PROJ_N, kt * 64, nt * 64, ws_wtin(p), 1024, RowId(), lds); }
    else { const int q = task - 704, kt = q >> 4, nt = q & 15; transpose_tile(p.w_out, 1024, kt * 64, nt * 64, ws_wtout(p), 1024, RowId(), lds); }
  }
}

DI void phase1(const Params& p, int bid, int nb, char* lds) {
  const int lane = tid_() & 63, wid = tid_() >> 6;
  const float* mod = ws_mod(p);
  for (int row = bid * 8 + wid; row < NTOK; row += nb * 8) {
    const int b = row >> 11;
    const float* xr = p.x + (size_t)row * DM;
    f32x4 v[4]; float ss = 0.f;
#pragma unroll
    for (int i = 0; i < 4; ++i) { v[i] = *(const f32x4*)(xr + lane * 4 + 256 * i); ss += v[i][0] * v[i][0] + v[i][1] * v[i][1] + v[i][2] * v[i][2] + v[i][3] * v[i][3]; }
    ss = wave_sum(ss);
    const float rstd = rsqrtf(ss * (1.0f / DM) + 1e-6f);
#pragma unroll
    for (int i = 0; i < 4; ++i) {
      const int col = lane * 4 + 256 * i;
      const f32x4 g = *(const f32x4*)(p.norm1_g + col), sh = *(const f32x4*)(mod + b * 6144 + col), sc = *(const f32x4*)(mod + b * 6144 + 1024 + col);
      float o[4];
#pragma unroll
      for (int j = 0; j < 4; ++j) o[j] = v[i][j] * rstd * g[j] * (1.0f + sc[j]) + sh[j];
      u32x2 w; w.x = pack2(o[0], o[1]); w.y = pack2(o[2], o[3]);
      *(u32x2*)(ws_h1(p) + (size_t)row * DM + col) = w;
    }
  }
}

constexpr int GBM = 256, GBN = 128, GBK = 32, GROW = 80, G_LDSA = GBM * GROW, G_STAGE = (GBM + GBN) * GROW;
template <class ARow, class Epi>
DI void gemm_tile(const bf16_t* A, int lda, ARow arow, const bf16_t* Bt, int ldb, int n0, int K, Epi epi, char* lds) {
  const int t = tid_(), lane = t & 63, wid = t >> 6, wm = wid >> 1, wn = wid & 1, r32 = lane & 31, hi = lane >> 5;
  const int srow = t >> 2, sch = t & 3;
  const bf16_t* a0p = A + (size_t)arow(srow) * lda + sch * 8;
  const bf16_t* a1p = A + (size_t)arow(srow + 128) * lda + sch * 8;
  const bf16_t* bp = Bt + (size_t)(n0 + srow) * ldb + sch * 8;
  const int wa0 = srow * GROW + sch * 16, wa1 = (srow + 128) * GROW + sch * 16, wb = G_LDSA + srow * GROW + sch * 16;
  const int ra = (wm * 64 + r32) * GROW + hi * 16, rb = G_LDSA + (wn * 64 + r32) * GROW + hi * 16;
  f32x16 acc[2][2];
#pragma unroll
  for (int i = 0; i < 2; ++i)
#pragma unroll
    for (int j = 0; j < 2; ++j)
#pragma unroll
      for (int r = 0; r < 16; ++r) acc[i][j][r] = 0.f;
  u32x4 ga0 = *(const u32x4*)a0p, ga1 = *(const u32x4*)a1p, gb = *(const u32x4*)bp;
  __syncthreads();
  *(u32x4*)(lds + wa0) = ga0; *(u32x4*)(lds + wa1) = ga1; *(u32x4*)(lds + wb) = gb;
  __syncthreads();
  const int nk = K / GBK;
  for (int kt = 0; kt < nk; ++kt) {
    char* cur = lds + (kt & 1) * G_STAGE;
    char* nxt = lds + ((kt + 1) & 1) * G_STAGE;
    if (kt + 1 < nk) { ga0 = *(const u32x4*)(a0p + (kt + 1) * GBK); ga1 = *(const u32x4*)(a1p + (kt + 1) * GBK); gb = *(const u32x4*)(bp + (kt + 1) * GBK); }
#pragma unroll
    for (int ks = 0; ks < 2; ++ks) {
      bf16x8 a[2], b[2];
#pragma unroll
      for (int i = 0; i < 2; ++i) { a[i] = *(const bf16x8*)(cur + ra + i * 32 * GROW + ks * 32); b[i] = *(const bf16x8*)(cur + rb + i * 32 * GROW + ks * 32); }
#pragma unroll
      for (int i = 0; i < 2; ++i)
#pragma unroll
        for (int j = 0; j < 2; ++j) acc[i][j] = __builtin_amdgcn_mfma_f32_32x32x16_bf16(a[i], b[j], acc[i][j], 0, 0, 0);
    }
    if (kt + 1 < nk) { *(u32x4*)(nxt + wa0) = ga0; *(u32x4*)(nxt + wa1) = ga1; *(u32x4*)(nxt + wb) = gb; }
    __syncthreads();
  }
#pragma unroll
  for (int i = 0; i < 2; ++i)
#pragma unroll
    for (int r = 0; r < 16; ++r) epi(wm * 64 + i * 32 + crow(r, hi), wn * 64 + r32, acc[i][0][r], acc[i][1][r]);
}

struct ARowBase { int base; DI int operator()(int r) const { return base + r; } };

struct EpiProj { bf16_t* o; int row0, col0; DI void operator()(int r, int c, float v0, float v1) const {
  bf16_t* q = o + (size_t)(row0 + r) * PROJ_LD + col0 + c; q[0] = f2bf(v0); q[32] = f2bf(v1); } };
DI void phase2(const Params& p, int bid, int nb, char* lds) {
  constexpr int NT = PROJ_LD / GBN;
  for (int tile = bid; tile < (NTOK / GBM) * NT; tile += nb) {
    const int mt = tile / NT, nt = tile % NT;
    gemm_tile(ws_h1(p), DM, ARowBase{mt * GBM}, ws_wtin(p), DM, nt * GBN, DM, EpiProj{ws_proj(p), mt * GBM, nt * GBN}, lds);
  }
}

DI float proj_shift(const bf16_t* proj, const float* mu, int gt, int col) {
  const float pv = bf2f(proj[(size_t)gt * PROJ_LD + col]);
  const float pp = (gt & (SEQ - 1)) ? bf2f(proj[(size_t)(gt - 1) * PROJ_LD + col]) : 0.f;
  return pv + mu[col] * (pp - pv);
}
DI void phase3a(const Params& p, int bid, int nb, char* lds) {
  const int t = tid_(), lane = t & 63, wid = t >> 6;
  float* xl = (float*)lds;
  const bf16_t* proj = ws_proj(p);
  for (int tile = bid; tile < NTOK / 16; tile += nb) {
    const int t0 = tile * 16;
    __syncthreads();
    for (int idx = t; idx < 16 * 256; idx += NTHR) {
      const int tok = idx >> 8, col = idx & 255;
      float v = proj_shift(proj, p.shift_mu, t0 + tok, C_WL + col);
      if (col < 64) v = tanhf(v); else if (col >= 128) v = sigmoidf_(v);
      xl[idx] = v;
    }
    __syncthreads();
    const int c = t;
    float acc[16];
#pragma unroll
    for (int i = 0; i < 16; ++i) acc[i] = 0.f;
    for (int k4 = 0; k4 < 16; ++k4) {
      float w[4];
#pragma unroll
      for (int j = 0; j < 4; ++j) w[j] = p.w_decay_up[(k4 * 4 + j) * RW + c];
#pragma unroll
      for (int i = 0; i < 16; ++i) { const f32x4 xv = *(const f32x4*)(xl + i * 256 + k4 * 4); acc[i] += xv[0] * w[0] + xv[1] * w[1] + xv[2] * w[2] + xv[3] * w[3]; }
    }
    {
      const float w0c = p.w0[c];
#pragma unroll
      for (int i = 0; i < 16; ++i) {
        const float z = -(w0c + acc[i]);
        const float sp = fmaxf(z, 0.f) + log1pf(__expf(-fabsf(z)));
        ws_ee(p)[(size_t)(t0 + i) * RW + c] = f2bf(__expf(-sp - 0.5f));
      }
    }
#pragma unroll
    for (int i = 0; i < 16; ++i) acc[i] = 0.f;
    for (int k4 = 0; k4 < 32; ++k4) {
      float w[4];
#pragma unroll
      for (int j = 0; j < 4; ++j) w[j] = p.w_gate_up[(k4 * 4 + j) * RW + c];
#pragma unroll
      for (int i = 0; i < 16; ++i) { const f32x4 xv = *(const f32x4*)(xl + i * 256 + 128 + k4 * 4); acc[i] += xv[0] * w[0] + xv[1] * w[1] + xv[2] * w[2] + xv[3] * w[3]; }
    }
#pragma unroll
    for (int i = 0; i < 16; ++i) ws_gg(p)[(size_t)(t0 + i) * RW + c] = f2bf(acc[i]);
#pragma unroll
    for (int i = 0; i < 16; ++i) acc[i] = 0.f;
    for (int k4 = 0; k4 < 16; ++k4) {
      float w[4];
#pragma unroll
      for (int j = 0; j < 4; ++j) w[j] = p.w_aaa_up[(k4 * 4 + j) * RW + c];
#pragma unroll
      for (int i = 0; i < 16; ++i) { const f32x4 xv = *(const f32x4*)(xl + i * 256 + 64 + k4 * 4); acc[i] += xv[0] * w[0] + xv[1] * w[1] + xv[2] * w[2] + xv[3] * w[3]; }
    }
    {
      const float a0c = p.a0[c], kkc = p.k_k[c], kac = p.k_a[c], rkc = p.r_k[c];
#pragma unroll
      for (int i = 0; i < 16; ++i) {
        const int gt = t0 + i;
        const float a = sigmoidf_(a0c + acc[i]);
        const float r = proj_shift(proj, p.shift_mu, gt, C_R + c);
        const float k = proj_shift(proj, p.shift_mu, gt, C_K + c);
        float kk = k * kkc;
        const float nrm = fmaxf(sqrtf(wave_sum(kk * kk)), 1e-12f);
        kk = kk / nrm;
        const float kp = k * (1.0f + (a - 1.0f) * kac);
        const float bs = wave_sum(r * kp * rkc);
        ws_kp(p)[(size_t)gt * RW + c] = f2bf(kp);
        ws_kk(p)[(size_t)gt * RW + c] = f2bf(kk);
        ws_bb(p)[(size_t)gt * RW + c] = f2bf(kk * a);
        if (lane == 0) ws_bonus(p)[gt * NH + wid] = bs;
      }
    }
  }
}

DI void phase3b(const Params& p, int bid, int nb, char* lds) {
  const int t = tid_(), lane = t & 63, wid = t >> 6;
  float* ql = (float*)lds;
  const bf16_t* proj = ws_proj(p);
  for (int tile = bid; tile < NTOK / 16; tile += nb) {
    const int t0 = tile * 16;
    __syncthreads();
    for (int idx = t; idx < 16 * 512; idx += NTHR) ql[idx] = bf2f(proj[(size_t)(t0 + (idx >> 9)) * PROJ_LD + C_Q + (idx & 511)]);
#pragma unroll
    for (int q = 0; q < 2; ++q) {
      const int gt = t0 + wid * 2 + q;
      const float v0 = bf2f(proj[(size_t)gt * PROJ_LD + C_CKV + lane * 2]), v1 = bf2f(proj[(size_t)gt * PROJ_LD + C_CKV + lane * 2 + 1]);
      const float rs = rsqrtf(wave_sum(v0 * v0 + v1 * v1) * (1.0f / 128.0f) + 1e-6f);
      *(unsigned*)(ws_ckv(p) + (size_t)gt * 128 + lane * 2) = pack2(v0 * rs * p.kv_norm_g[lane * 2], v1 * rs * p.kv_norm_g[lane * 2 + 1]);
      const float u = bf2f(proj[(size_t)gt * PROJ_LD + C_KI + lane]);
      const float rs2 = rsqrtf(wave_sum(u * u) * (1.0f / 64.0f) + 1e-6f);
      ws_kidx(p)[(size_t)gt * 64 + lane] = f2bf(u * rs2 * p.k_idx_norm_g[lane]);
    }
    __syncthreads();
    const int h = wid;
#pragma unroll 1
    for (int ps = 0; ps < 2; ++ps) {
      const int cidx = lane + 64 * ps;
      float w[64];
      const float* wp = p.w_uk + (size_t)(cidx * NH + h) * HD;
#pragma unroll
      for (int d4 = 0; d4 < 16; ++d4) { const f32x4 wv = *(const f32x4*)(wp + d4 * 4); w[d4 * 4] = wv[0]; w[d4 * 4 + 1] = wv[1]; w[d4 * 4 + 2] = wv[2]; w[d4 * 4 + 3] = wv[3]; }
#pragma unroll 1
      for (int i = 0; i < 16; ++i) {
        float acc = 0.f;
#pragma unroll
        for (int d4 = 0; d4 < 16; ++d4) { const f32x4 qv = *(const f32x4*)(ql + i * 512 + h * 64 + d4 * 4); acc += qv[0] * w[d4 * 4] + qv[1] * w[d4 * 4 + 1] + qv[2] * w[d4 * 4 + 2] + qv[3] * w[d4 * 4 + 3]; }
        ws_qlat(p)[((size_t)(t0 + i) * NH + h) * 128 + cidx] = f2bf(acc * 0.125f);
      }
    }
  }
}

DI float xhalf_sum(float v) { auto rr = __builtin_amdgcn_permlane32_swap(__float_as_uint(v), __float_as_uint(v), false, false); return __uint_as_float(rr[0]) + __uint_as_float(rr[1]); }
DI float dpp_sum8(float v) {
  v += __int_as_float(__builtin_amdgcn_update_dpp(0, __float_as_int(v), 0xB1, 0xF, 0xF, true));
  v += __int_as_float(__builtin_amdgcn_update_dpp(0, __float_as_int(v), 0x4E, 0xF, 0xF, true));
  v += __int_as_float(__builtin_amdgcn_update_dpp(0, __float_as_int(v), 0x141, 0xF, 0xF, true));
  return v;
}
DI float dpp_sum16b(float v) { v = dpp_sum8(v); v += __int_as_float(__builtin_amdgcn_update_dpp(0, __float_as_int(v), 0x140, 0xF, 0xF, true)); return v; }
DI u32x2 pk4(float a, float b, float c, float d) { u32x2 w; w.x = cvtpk(a, b); w.y = cvtpk(c, d); return w; }
DI void ld4(const bf16_t* p, float* o) { const u32x2 w = *(const u32x2*)p; o[0] = __uint_as_float(w.x << 16); o[1] = __uint_as_float(w.x & 0xffff0000u); o[2] = __uint_as_float(w.y << 16); o[3] = __uint_as_float(w.y & 0xffff0000u); }
constexpr int XL_ROW = 528;
template <int MODE> DI void phase3_mfma(const Params& p, int bid, int nb, char* lds) {
  const int t_ = tid_(), wid = t_ >> 6, h = wid;
  const bf16_t* proj = ws_proj(p);
  float* PL = (float*)(lds + 64 * XL_ROW + 8 * 14336);
  static_assert(64 * XL_ROW + 8 * 14336 + 7 * 512 * 4 <= LDS_BYTES - 64, "prep LDS map");
  for (int i = t_; i < RW; i += NTHR) { PL[i] = p.w0[i]; PL[512 + i] = p.a0[i]; PL[1024 + i] = p.k_k[i]; PL[1536 + i] = p.k_a[i]; PL[2048 + i] = p.r_k[i]; PL[2560 + i] = p.shift_mu[C_R + i]; PL[3072 + i] = p.shift_mu[C_K + i]; }
  for (int tile = bid; tile < NTOK / 64; tile += nb) {
    const int t0 = tile * 64;
    int t = t_;
    asm volatile("" : "+v"(t));
    const int lane = t & 63, r32_ = lane & 31, hi_ = lane >> 5;
    __syncthreads();
#pragma unroll
    for (int i = 0; i < 4; ++i) {
      const int id = t + 512 * i, tok = id >> 5, cc = (id & 31) * 8, gt = t0 + tok;
      float v[8], pv[8];
      const bool firstt = (gt & (SEQ - 1)) == 0;
      load8(proj + (unsigned)(gt * PROJ_LD + C_WL + cc), v);
      load8(proj + (unsigned)((firstt ? gt : gt - 1) * PROJ_LD + C_WL + cc), pv);
      const f32x4 m0 = *(const f32x4*)(p.shift_mu + C_WL + cc), m1 = *(const f32x4*)(p.shift_mu + C_WL + cc + 4);
      const float esc = (cc < 64) ? 2.0f : -1.0f;
      float x[8];
#pragma unroll
      for (int j = 0; j < 8; ++j) {
        const float mu = j < 4 ? m0[j] : m1[j - 4];
        const float pj = firstt ? 0.f : pv[j];
        const float xv = v[j] + mu * (pj - v[j]);
        const float rc = __builtin_amdgcn_rcpf(__expf(esc * xv) + 1.0f);
        x[j] = (cc < 64) ? (1.0f - 2.0f * rc) : ((cc >= 128) ? rc : xv);
      }
      u32x4 w; w.x = cvtpk(x[0], x[1]); w.y = cvtpk(x[2], x[3]); w.z = cvtpk(x[4], x[5]); w.w = cvtpk(x[6], x[7]);
      *(u32x4*)(lds + tok * XL_ROW + cc * 2) = w;
    }
    if (MODE & 2) {
#pragma unroll
    for (int it = 0; it < 2; ++it) {
      const int gt = t0 + wid * 8 + it * 4 + (lane >> 4), c0 = (lane & 15) * 8;
      float v[8]; load8(proj + (size_t)gt * PROJ_LD + C_CKV + c0, v);
      float ss = 0.f;
#pragma unroll
      for (int j = 0; j < 8; ++j) ss += v[j] * v[j];
      const float rs = rsqrtf(dpp_sum16b(ss) * (1.0f / 128.0f) + 1e-6f);
      const f32x4 g0 = *(const f32x4*)(p.kv_norm_g + c0), g1 = *(const f32x4*)(p.kv_norm_g + c0 + 4);
      u32x4 w; w.x = cvtpk(v[0] * rs * g0[0], v[1] * rs * g0[1]); w.y = cvtpk(v[2] * rs * g0[2], v[3] * rs * g0[3]);
      w.z = cvtpk(v[4] * rs * g1[0], v[5] * rs * g1[1]); w.w = cvtpk(v[6] * rs * g1[2], v[7] * rs * g1[3]);
      *(u32x4*)(ws_ckv(p) + (size_t)gt * 128 + c0) = w;
    }
    {
      const int gt = t0 + wid * 8 + (lane >> 3), c0 = (lane & 7) * 8;
      float v[8]; load8(proj + (size_t)gt * PROJ_LD + C_KI + c0, v);
      float ss = 0.f;
#pragma unroll
      for (int j = 0; j < 8; ++j) ss += v[j] * v[j];
      const float rs = rsqrtf(dpp_sum8(ss) * (1.0f / 64.0f) + 1e-6f);
      const f32x4 g0 = *(const f32x4*)(p.k_idx_norm_g + c0), g1 = *(const f32x4*)(p.k_idx_norm_g + c0 + 4);
      u32x4 w; w.x = cvtpk(v[0] * rs * g0[0], v[1] * rs * g0[1]); w.y = cvtpk(v[2] * rs * g0[2], v[3] * rs * g0[3]);
      w.z = cvtpk(v[4] * rs * g1[0], v[5] * rs * g1[1]); w.w = cvtpk(v[6] * rs * g1[2], v[7] * rs * g1[3]);
      *(u32x4*)(ws_kidx(p) + (size_t)gt * 64 + c0) = w;
    }
    }
    __syncthreads();
#pragma unroll 1
    for (int nt = 0; nt < 2; ++nt) {
      int r32 = r32_, hi = hi_;
      asm volatile("" : "+v"(r32), "+v"(hi));
      const int gt = t0 + nt * 32 + r32;
      const bool first = (gt & (SEQ - 1)) == 0;
      const int gp = first ? gt : gt - 1;
      const char* xrow = lds + (nt * 32 + r32) * XL_ROW + hi * 16;
      const int chb = h * HD + 4 * hi;
      char* RBt = lds + 64 * XL_ROW + wid * 14336; char* KBt = RBt + 4752; char* OBt = KBt + 4752;
      const int t0w = t0 + nt * 32, frow = lane >> 3, fch = lane & 7;
      const int cwo = r32 * 144 + hi * 8;
#define P3_FLUSH(dst_, ld_, col_) do { _Pragma("unroll") for (int i_ = 0; i_ < 4; ++i_) { const int row_ = frow + 8 * i_; \
        *(u32x4*)((dst_) + (unsigned)((t0w + row_) * (ld_) + (col_) + fch * 8)) = *(const u32x4*)(OBt + row_ * 144 + fch * 16); } } while (0)
      if (MODE & 1) {
      f32x16 acc[2];
#pragma unroll
      for (int mt = 0; mt < 2; ++mt)
#pragma unroll
        for (int r = 0; r < 16; ++r) acc[mt][r] = 0.f;
#pragma unroll
      for (int ks = 0; ks < 4; ++ks) {
        const bf16x8 bx = *(const bf16x8*)(xrow + ks * 32);
#pragma unroll
        for (int mt = 0; mt < 2; ++mt) { const bf16x8 aw = *(const bf16x8*)(ws_wdt(p) + (unsigned)(((h * 2 + mt) * 4 + ks) * 512 + (hi * 32 + r32) * 8)); acc[mt] = __builtin_amdgcn_mfma_f32_32x32x16_bf16(aw, bx, acc[mt], 0, 0, 0); }
      }
#pragma unroll
      for (int mt = 0; mt < 2; ++mt)
#pragma unroll
        for (int g = 0; g < 4; ++g) {
          const int ch = chb + 32 * mt + 8 * g;
          const f32x4 w0v = *(const f32x4*)(PL + ch);
          float e[4];
#pragma unroll
          for (int i = 0; i < 4; ++i) e[i] = 0.6065306597f * __builtin_amdgcn_rcpf(1.0f + __expf(-(w0v[i] + acc[mt][4 * g + i])));
          *(u32x2*)(OBt + cwo + mt * 64 + g * 16) = pk4(e[0], e[1], e[2], e[3]);
        }
      P3_FLUSH(ws_ee(p), RW, h * HD);
      __builtin_amdgcn_sched_barrier(0);
#pragma unroll
      for (int mt = 0; mt < 2; ++mt)
#pragma unroll
        for (int r = 0; r < 16; ++r) acc[mt][r] = 0.f;
#pragma unroll
      for (int ks = 0; ks < 8; ++ks) {
        const bf16x8 bx = *(const bf16x8*)(xrow + 256 + ks * 32);
#pragma unroll
        for (int mt = 0; mt < 2; ++mt) { const bf16x8 aw = *(const bf16x8*)(ws_wgt(p) + (unsigned)(((h * 2 + mt) * 8 + ks) * 512 + (hi * 32 + r32) * 8)); acc[mt] = __builtin_amdgcn_mfma_f32_32x32x16_bf16(aw, bx, acc[mt], 0, 0, 0); }
      }
#pragma unroll
      for (int mt = 0; mt < 2; ++mt)
#pragma unroll
        for (int g = 0; g < 4; ++g)
          *(u32x2*)(OBt + cwo + mt * 64 + g * 16) =
              pk4(acc[mt][4 * g] + 0.0f, acc[mt][4 * g + 1] + 0.0f, acc[mt][4 * g + 2] + 0.0f, acc[mt][4 * g + 3] + 0.0f);
      P3_FLUSH(ws_gg(p), RW, h * HD);
      __builtin_amdgcn_sched_barrier(0);
#pragma unroll
      for (int mt = 0; mt < 2; ++mt)
#pragma unroll
        for (int r = 0; r < 16; ++r) acc[mt][r] = 0.f;
#pragma unroll
      for (int ks = 0; ks < 4; ++ks) {
        const bf16x8 bx = *(const bf16x8*)(xrow + 128 + ks * 32);
#pragma unroll
        for (int mt = 0; mt < 2; ++mt) { const bf16x8 aw = *(const bf16x8*)(ws_wat(p) + (unsigned)(((h * 2 + mt) * 4 + ks) * 512 + (hi * 32 + r32) * 8)); acc[mt] = __builtin_amdgcn_mfma_f32_32x32x16_bf16(aw, bx, acc[mt], 0, 0, 0); }
      }
      __builtin_amdgcn_sched_barrier(0);
#pragma unroll
      for (int i_ = 0; i_ < 5; ++i_) {
        const int row_ = frow + 8 * i_;
        if (row_ < 33) {
          int tk_ = t0w - 1 + row_; tk_ = tk_ < 0 ? 0 : tk_;
          *(u32x4*)(RBt + row_ * 144 + fch * 16) = *(const u32x4*)(proj + (unsigned)(tk_ * PROJ_LD + C_R + h * HD + fch * 8));
          *(u32x4*)(KBt + row_ * 144 + fch * 16) = *(const u32x4*)(proj + (unsigned)(tk_ * PROJ_LD + C_K + h * HD + fch * 8));
        }
      }
      float ss = 0.f, bs = 0.f; float av[2][16];
#pragma unroll
      for (int mt = 0; mt < 2; ++mt)
#pragma unroll
        for (int g = 0; g < 4; ++g) {
          const int ch = chb + 32 * mt + 8 * g;
          float rv[4], rp[4], kv[4], kq[4];
          ld4((const bf16_t*)(RBt + 144 + cwo + mt * 64 + g * 16), rv); ld4((const bf16_t*)(KBt + 144 + cwo + mt * 64 + g * 16), kv);
          ld4((const bf16_t*)(RBt + cwo + mt * 64 + g * 16), rp); ld4((const bf16_t*)(KBt + cwo + mt * 64 + g * 16), kq);
          const f32x4 mur = *(const f32x4*)(PL + 2560 + ch), muk = *(const f32x4*)(PL + 3072 + ch);
          const f32x4 a0v = *(const f32x4*)(PL + 512 + ch), kkc = *(const f32x4*)(PL + 1024 + ch), kac = *(const f32x4*)(PL + 1536 + ch), rkc = *(const f32x4*)(PL + 2048 + ch);
          float kp[4];
#pragma unroll
          for (int i = 0; i < 4; ++i) {
            const float a = __builtin_amdgcn_rcpf(1.0f + __expf(-(a0v[i] + acc[mt][4 * g + i])));
            const float r = rv[i] + mur[i] * ((first ? 0.f : rp[i]) - rv[i]);
            const float k = kv[i] + muk[i] * ((first ? 0.f : kq[i]) - kv[i]);
            const float kk = k * kkc[i];
            ss += kk * kk;
            kp[i] = k * (1.0f + (a - 1.0f) * kac[i]);
            bs += r * kp[i] * rkc[i];
            av[mt][4 * g + i] = a;
          }
          *(u32x2*)(OBt + cwo + mt * 64 + g * 16) = pk4(kp[0], kp[1], kp[2], kp[3]);
        }
      P3_FLUSH(ws_kp(p), RW, h * HD);
      __builtin_amdgcn_sched_barrier(0);
      ss = xhalf_sum(ss); bs = xhalf_sum(bs);
      const float inv = 1.0f / fmaxf(sqrtf(ss), 1e-12f);
#pragma unroll
      for (int mt = 0; mt < 2; ++mt)
#pragma unroll
        for (int g = 0; g < 4; ++g) {
          const int ch = chb + 32 * mt + 8 * g;
          float kv[4], kq[4];
          ld4((const bf16_t*)(KBt + 144 + cwo + mt * 64 + g * 16), kv); ld4((const bf16_t*)(KBt + cwo + mt * 64 + g * 16), kq);
          const f32x4 muk = *(const f32x4*)(PL + 3072 + ch), kkc = *(const f32x4*)(PL + 1024 + ch);
          float kn[4];
#pragma unroll
          for (int i = 0; i < 4; ++i) { const float kprev = first ? 0.f : kq[i]; kn[i] = (kv[i] + muk[i] * (kprev - kv[i])) * kkc[i] * inv; }
          *(u32x2*)(OBt + cwo + mt * 64 + g * 16) = pk4(kn[0], kn[1], kn[2], kn[3]);
          *(u32x2*)(RBt + cwo + mt * 64 + g * 16) = pk4(kn[0] * av[mt][4 * g], kn[1] * av[mt][4 * g + 1], kn[2] * av[mt][4 * g + 2], kn[3] * av[mt][4 * g + 3]);
        }
      P3_FLUSH(ws_kk(p), RW, h * HD);
      { char* const OBs = OBt; OBt = RBt; P3_FLUSH(ws_bb(p), RW, h * HD); OBt = OBs; }
      if (hi == 0) ws_bonus(p)[gt * NH + h] = bs;
      }
#undef P3_FLUSH
    }
  }
}

DI void phase4a(const Params& p, int bid, int nb, char* lds) {
  const int t = tid_(), i = t >> 3, cg8 = (t & 7) * 8;
  const bf16_t* proj = ws_proj(p);
  for (int task = bid; task < BATCH * NH; task += nb) {
    const int b = task >> 3, h = task & 7;
    const int cbase = h * HD + cg8;
    float mu_r[8], st[8], rprev[8];
#pragma unroll
    for (int j = 0; j < 8; ++j) { mu_r[j] = p.shift_mu[C_R + cbase + j]; st[j] = 0.f; rprev[j] = 0.f; }
    const float mu_v = p.shift_mu[C_V + h * HD + i];
    float vprev = 0.f;
    const size_t tok0 = (size_t)b * SEQ;
    u32x4 n_kk, n_bb, n_kp, n_ee, n_r; bf16_t n_v;
    {
      const size_t g = tok0;
      n_kk = *(const u32x4*)(ws_kk(p) + g * RW + cbase); n_bb = *(const u32x4*)(ws_bb(p) + g * RW + cbase);
      n_kp = *(const u32x4*)(ws_kp(p) + g * RW + cbase); n_ee = *(const u32x4*)(ws_ee(p) + g * RW + cbase);
      n_r = *(const u32x4*)(proj + g * PROJ_LD + C_R + cbase); n_v = proj[g * PROJ_LD + C_V + h * HD + i];
    }
    for (int s = 0; s < SEQ; ++s) {
      const u32x4 c_kk = n_kk, c_bb = n_bb, c_kp = n_kp, c_ee = n_ee, c_r = n_r; const bf16_t c_v = n_v;
      if (s + 1 < SEQ) {
        const size_t g = tok0 + s + 1;
        n_kk = *(const u32x4*)(ws_kk(p) + g * RW + cbase); n_bb = *(const u32x4*)(ws_bb(p) + g * RW + cbase);
        n_kp = *(const u32x4*)(ws_kp(p) + g * RW + cbase); n_ee = *(const u32x4*)(ws_ee(p) + g * RW + cbase);
        n_r = *(const u32x4*)(proj + g * PROJ_LD + C_R + cbase); n_v = proj[g * PROJ_LD + C_V + h * HD + i];
      }
      float kk[8], bb[8], kp[8], ee[8], rr[8];
      unpack8(c_kk, kk); unpack8(c_bb, bb); unpack8(c_kp, kp); unpack8(c_ee, ee); unpack8(c_r, rr);
      const float vraw = bf2f(c_v);
      const float v = vraw + mu_v * (vprev - vraw); vprev = vraw;
      float sa = 0.f;
#pragma unroll
      for (int j = 0; j < 8; ++j) sa += st[j] * kk[j];
      sa += __shfl_xor(sa, 1); sa += __shfl_xor(sa, 2); sa += __shfl_xor(sa, 4);
      sa = -sa;
      float y = 0.f;
#pragma unroll
      for (int j = 0; j < 8; ++j) {
        const float r = rr[j] + mu_r[j] * (rprev[j] - rr[j]); rprev[j] = rr[j];
        const float w = __expf(-ee[j]);
        st[j] = st[j] * w + sa * bb[j] + v * kp[j];
        y += st[j] * r;
      }
      y += __shfl_xor(y, 1); y += __shfl_xor(y, 2); y += __shfl_xor(y, 4);
      if ((t & 7) == 0) ws_y(p)[(tok0 + s) * RW + h * HD + i] = y;
    }
  }
}

DI float dpp_sum16(float v) {
  v += __int_as_float(__builtin_amdgcn_update_dpp(0, __float_as_int(v), 0xB1, 0xF, 0xF, true));
  v += __int_as_float(__builtin_amdgcn_update_dpp(0, __float_as_int(v), 0x4E, 0xF, 0xF, true));
  v += __int_as_float(__builtin_amdgcn_update_dpp(0, __float_as_int(v), 0x141, 0xF, 0xF, true));
  v += __int_as_float(__builtin_amdgcn_update_dpp(0, __float_as_int(v), 0x140, 0xF, 0xF, true));
  return v;
}
constexpr int CK = 16;
constexpr int SC_CH = 16, SC_BUF = 5 * SC_CH * 64 * 4 + SC_CH * 32 * 4 + SC_CH * 8;
DI void phase4a_v2(const Params& p, int bid, int nb, char* lds) {
  const int t = tid_(), rowl = t >> 4, cg = t & 15;
  const bf16_t* proj = ws_proj(p);
  for (int task = bid; task < BATCH * NH * 2; task += nb) {
    const int b = task >> 4, h = (task >> 1) & 7, half = task & 1;
    const size_t tok0 = (size_t)b * SEQ;
    const int sst = t >> 4, scol = h * HD + cg * 4;
    const int vst = t >> 5, vrow = t & 31, vcol = C_V + h * HD + half * 32 + vrow;
    float mur[4];
#pragma unroll
    for (int j = 0; j < 4; ++j) mur[j] = p.shift_mu[C_R + scol + j];
    const float muv = p.shift_mu[vcol];
    u32x2 g_kk, g_bb, g_kp, g_ee, g_r, g_rp; bf16_t g_v, g_vp;
    auto stage_load = [&](int c) {
      if (t < 256) {
        const size_t g = tok0 + c * SC_CH + sst;
        g_kk = *(const u32x2*)(ws_kk(p) + g * RW + scol); g_bb = *(const u32x2*)(ws_bb(p) + g * RW + scol);
        g_kp = *(const u32x2*)(ws_kp(p) + g * RW + scol); g_ee = *(const u32x2*)(ws_ee(p) + g * RW + scol);
        g_r = *(const u32x2*)(proj + g * PROJ_LD + C_R + scol);
        if (c * SC_CH + sst > 0) g_rp = *(const u32x2*)(proj + (g - 1) * PROJ_LD + C_R + scol); else { g_rp.x = 0u; g_rp.y = 0u; }
      }
      const size_t gv = tok0 + c * SC_CH + vst;
      g_v = proj[gv * PROJ_LD + vcol];
      g_vp = (c * SC_CH + vst > 0) ? proj[(gv - 1) * PROJ_LD + vcol] : (bf16_t)0;
    };
    auto stage_write = [&](char* buf) {
      if (t < 256) {
        float* W = (float*)buf + sst * 64 + cg * 4;
        f32x4 o;
        o[0] = __expf(-__uint_as_float(g_ee.x << 16)); o[1] = __expf(-__uint_as_float(g_ee.x & 0xffff0000u));
        o[2] = __expf(-__uint_as_float(g_ee.y << 16)); o[3] = __expf(-__uint_as_float(g_ee.y & 0xffff0000u));
        *(f32x4*)W = o;
        o[0] = __uint_as_float(g_kk.x << 16); o[1] = __uint_as_float(g_kk.x & 0xffff0000u); o[2] = __uint_as_float(g_kk.y << 16); o[3] = __uint_as_float(g_kk.y & 0xffff0000u);
        *(f32x4*)(W + SC_CH * 64) = o;
        o[0] = __uint_as_float(g_bb.x << 16); o[1] = __uint_as_float(g_bb.x & 0xffff0000u); o[2] = __uint_as_float(g_bb.y << 16); o[3] = __uint_as_float(g_bb.y & 0xffff0000u);
        *(f32x4*)(W + 2 * SC_CH * 64) = o;
        o[0] = __uint_as_float(g_kp.x << 16); o[1] = __uint_as_float(g_kp.x & 0xffff0000u); o[2] = __uint_as_float(g_kp.y << 16); o[3] = __uint_as_float(g_kp.y & 0xffff0000u);
        *(f32x4*)(W + 3 * SC_CH * 64) = o;
        float r[4] = {__uint_as_float(g_r.x << 16), __uint_as_float(g_r.x & 0xffff0000u), __uint_as_float(g_r.y << 16), __uint_as_float(g_r.y & 0xffff0000u)};
        float rp[4] = {__uint_as_float(g_rp.x << 16), __uint_as_float(g_rp.x & 0xffff0000u), __uint_as_float(g_rp.y << 16), __uint_as_float(g_rp.y & 0xffff0000u)};
#pragma unroll
        for (int j = 0; j < 4; ++j) o[j] = r[j] + mur[j] * (rp[j] - r[j]);
        *(f32x4*)(W + 4 * SC_CH * 64) = o;
      }
      const float v = bf2f(g_v), vp = bf2f(g_vp);
      ((float*)buf)[5 * SC_CH * 64 + vst * 32 + vrow] = v + muv * (vp - v);
    };
    float st[4] = {0.f, 0.f, 0.f, 0.f};
    __syncthreads();
    stage_load(0); stage_write(lds);
    __syncthreads();
    float* yout = ws_y(p) + tok0 * RW + h * HD + half * 32 + rowl;
    for (int c = 0; c < SEQ / SC_CH; ++c) {
      const char* cur = lds + (c & 1) * SC_BUF;
      if (c + 1 < SEQ / SC_CH) stage_load(c + 1);
      const float* Wb = (const float*)cur + cg * 4;
      const float* Vb = (const float*)cur + 5 * SC_CH * 64 + rowl;
      float yv[SC_CH];
#pragma unroll
      for (int s = 0; s < SC_CH; ++s) {
        const f32x4 w = *(const f32x4*)(Wb + s * 64), kk = *(const f32x4*)(Wb + SC_CH * 64 + s * 64), bb = *(const f32x4*)(Wb + 2 * SC_CH * 64 + s * 64);
        const f32x4 kp = *(const f32x4*)(Wb + 3 * SC_CH * 64 + s * 64), rr = *(const f32x4*)(Wb + 4 * SC_CH * 64 + s * 64);
        const float v = Vb[s * 32];
        float sa = (st[0] * kk[0] + st[1] * kk[1]) + (st[2] * kk[2] + st[3] * kk[3]);
        sa = -dpp_sum16(sa);
#pragma unroll
        for (int j = 0; j < 4; ++j) st[j] = st[j] * w[j] + (sa * bb[j] + v * kp[j]);
        float y = (st[0] * rr[0] + st[1] * rr[1]) + (st[2] * rr[2] + st[3] * rr[3]);
        yv[s] = dpp_sum16(y);
      }
      if (cg == 0) {
#pragma unroll
        for (int s = 0; s < SC_CH; ++s) yout[(size_t)(c * SC_CH + s) * RW] = yv[s];
      }
      if (c + 1 < SEQ / SC_CH) stage_write(lds + ((c + 1) & 1) * SC_BUF);
      __syncthreads();
    }
  }
}

DI void moe_tr_wave(const Params& p, int id, int lane, float* tl  ) {
  const int which = id >> 12, q = id & 4095, e = q >> 7, r = q & 127;
  const float* src; int N, k0, n0;
  if (which < 2) { src = (which == 0 ? p.e_gate : p.e_up) + (size_t)e * 1024 * 512; N = 512; k0 = (r >> 3) * 64; n0 = (r & 7) * 64; }
  else { src = p.e_down + (size_t)e * 512 * 1024; N = 1024; k0 = (r >> 4) * 64; n0 = (r & 15) * 64; }
  const int lr = lane >> 4, lc = (lane & 15) * 4;
  f32x4 g[16];
#pragma unroll
  for (int i = 0; i < 16; ++i) g[i] = *(const f32x4*)(src + (size_t)(k0 + lr + 4 * i) * N + n0 + lc);
#pragma unroll
  for (int i = 0; i < 16; ++i) { float* d = tl + (lr + 4 * i) * 65 + lc; d[0] = g[i][0]; d[1] = g[i][1]; d[2] = g[i][2]; d[3] = g[i][3]; }
  bf16_t* dst;
  { const int n = n0 + lane;
    if (which < 2) dst = ws_wgu(p) + (size_t)e * 1024 * 1024 + (size_t)((n >> 7) * 256 + (n & 127) + which * 128) * 1024 + k0;
    else dst = ws_wd(p) + (size_t)e * 1024 * 512 + (size_t)n * 512 + k0; }
#pragma unroll
  for (int c8 = 0; c8 < 8; ++c8) {
    float v[8];
#pragma unroll
    for (int j = 0; j < 8; ++j) v[j] = tl[(c8 * 8 + j) * 65 + lane];
    u32x4 w; w.x = cvtpk(v[0], v[1]); w.y = cvtpk(v[2], v[3]); w.z = cvtpk(v[4], v[5]); w.w = cvtpk(v[6], v[7]);
    *(u32x4*)(dst + c8 * 8) = w;
  }
}

typedef float f32x2p __attribute__((ext_vector_type(2)));
DI void phase4a_v3(const Params& p, int bid, int nb, char* lds) {
  const int t = tid_(), wid = __builtin_amdgcn_readfirstlane(t >> 6);
  const int rowl = (t >> 3) & 31, cg = t & 7;
  const int pt = t & 255;
  const bf16_t* proj = ws_proj(p);
  for (int task = bid; task < BATCH * NH * 2; task += nb) {
    const int b = task >> 4, h = (task >> 1) & 7, half = task & 1;
    const size_t tok0 = (size_t)b * SEQ;
    const int sst = pt >> 4, scq = pt & 15, scol = h * HD + scq * 4;
    const int vst = pt >> 5, vrow = pt & 31, vcol = C_V + h * HD + half * 32 + vrow;
    float mur[4];
#pragma unroll
    for (int j = 0; j < 4; ++j) mur[j] = p.shift_mu[C_R + scol + j];
    const float muv = p.shift_mu[vcol];
    u32x2 g_kk, g_bb, g_kp, g_ee, g_r, g_rp; bf16_t g_v0, g_v0p, g_v1, g_v1p;
#define SC_LOAD(c_) do { const int c__ = (c_); const size_t g = tok0 + c__ * SC_CH + sst; \
      g_kk = *(const u32x2*)(ws_kk(p) + g * RW + scol); g_bb = *(const u32x2*)(ws_bb(p) + g * RW + scol); \
      g_kp = *(const u32x2*)(ws_kp(p) + g * RW + scol); g_ee = *(const u32x2*)(ws_ee(p) + g * RW + scol); \
      g_r = *(const u32x2*)(proj + g * PROJ_LD + C_R + scol); \
      g_rp = *(const u32x2*)(proj + (g - ((c__ * SC_CH + sst > 0) ? 1 : 0)) * PROJ_LD + C_R + scol); \
      if (c__ * SC_CH + sst == 0) { g_rp.x = 0u; g_rp.y = 0u; } \
      const size_t gv = tok0 + c__ * SC_CH + vst; \
      g_v0 = proj[gv * PROJ_LD + vcol]; g_v0p = (c__ * SC_CH + vst > 0) ? proj[(gv - 1) * PROJ_LD + vcol] : (bf16_t)0; \
      g_v1 = proj[(gv + 8) * PROJ_LD + vcol]; g_v1p = proj[(gv + 7) * PROJ_LD + vcol]; } while (0)
#define SC_WRITE(buf_) do { float* W = (float*)(buf_) + sst * 64 + scq * 4; f32x4 o; \
      o[0] = __expf(-__uint_as_float(g_ee.x << 16)); o[1] = __expf(-__uint_as_float(g_ee.x & 0xffff0000u)); \
      o[2] = __expf(-__uint_as_float(g_ee.y << 16)); o[3] = __expf(-__uint_as_float(g_ee.y & 0xffff0000u)); *(f32x4*)W = o; \
      o[0] = __uint_as_float(g_kk.x << 16); o[1] = __uint_as_float(g_kk.x & 0xffff0000u); o[2] = __uint_as_float(g_kk.y << 16); o[3] = __uint_as_float(g_kk.y & 0xffff0000u); *(f32x4*)(W + SC_CH * 64) = o; \
      o[0] = __uint_as_float(g_bb.x << 16); o[1] = __uint_as_float(g_bb.x & 0xffff0000u); o[2] = __uint_as_float(g_bb.y << 16); o[3] = __uint_as_float(g_bb.y & 0xffff0000u); *(f32x4*)(W + 2 * SC_CH * 64) = o; \
      o[0] = __uint_as_float(g_kp.x << 16); o[1] = __uint_as_float(g_kp.x & 0xffff0000u); o[2] = __uint_as_float(g_kp.y << 16); o[3] = __uint_as_float(g_kp.y & 0xffff0000u); *(f32x4*)(W + 3 * SC_CH * 64) = o; \
      { const float r0 = __uint_as_float(g_r.x << 16), r1 = __uint_as_float(g_r.x & 0xffff0000u), r2 = __uint_as_float(g_r.y << 16), r3 = __uint_as_float(g_r.y & 0xffff0000u); \
        const float q0 = __uint_as_float(g_rp.x << 16), q1 = __uint_as_float(g_rp.x & 0xffff0000u), q2 = __uint_as_float(g_rp.y << 16), q3 = __uint_as_float(g_rp.y & 0xffff0000u); \
        o[0] = r0 + mur[0] * (q0 - r0); o[1] = r1 + mur[1] * (q1 - r1); o[2] = r2 + mur[2] * (q2 - r2); o[3] = r3 + mur[3] * (q3 - r3); \
        const f32x4 wv_ = *(const f32x4*)W, bv_ = *(const f32x4*)(W + 2 * SC_CH * 64), kv_ = *(const f32x4*)(W + 3 * SC_CH * 64); \
        const float br_ = dpp_sum16((bv_[0] * o[0] + bv_[1] * o[1]) + (bv_[2] * o[2] + bv_[3] * o[3])), kr_ = dpp_sum16((kv_[0] * o[0] + kv_[1] * o[1]) + (kv_[2] * o[2] + kv_[3] * o[3])); \
        if (scq == 0) { float* X_ = (float*)(buf_) + 5 * SC_CH * 64 + SC_CH * 32 + sst * 2; X_[0] = br_; X_[1] = kr_; } \
        o[0] *= wv_[0]; o[1] *= wv_[1]; o[2] *= wv_[2]; o[3] *= wv_[3]; *(f32x4*)(W + 4 * SC_CH * 64) = o; } \
      { const float v0 = bf2f(g_v0), v0p = bf2f(g_v0p), v1 = bf2f(g_v1), v1p = bf2f(g_v1p); float* Vw = (float*)(buf_) + 5 * SC_CH * 64 + vst * 32 + vrow; \
        Vw[0] = v0 + muv * (v0p - v0); Vw[8 * 32] = v1 + muv * (v1p - v1); } } while (0)
    f32x2p st2[4];
#pragma unroll
    for (int j = 0; j < 4; ++j) st2[j] = (f32x2p){0.f, 0.f};
    __syncthreads();
    if (wid >= 4) { SC_LOAD(0); SC_WRITE(lds); SC_LOAD(1); }
    __syncthreads();
    float* yout = ws_y(p) + tok0 * RW + h * HD + half * 32 + rowl;
    for (int c = 0; c < SEQ / SC_CH; ++c) {
      const char* cur = lds + (c & 1) * SC_BUF;
      if (wid >= 4) {
        if (c + 1 < SEQ / SC_CH) SC_WRITE(lds + ((c + 1) & 1) * SC_BUF);
        if (c + 2 < SEQ / SC_CH) SC_LOAD(c + 2);
        if ((c & 7) == 3) {
          const int tid_tr = (task * 4 + (wid - 4)) + (BATCH * NH * 2 * 4) * (c >> 3);
          if (tid_tr < 3 * 4096) moe_tr_wave(p, tid_tr, t & 63, (float*)(lds + 2 * SC_BUF + 128) + (wid - 4) * (64 * 65));
        }
      } else {
        const float* Wb = (const float*)cur + cg * 8;
        const float* Vb = (const float*)cur + 5 * SC_CH * 64 + rowl;
        float yv[SC_CH];
#pragma unroll
        for (int s = 0; s < SC_CH; ++s) {
          const f32x4 w0 = *(const f32x4*)(Wb + s * 64), w1 = *(const f32x4*)(Wb + s * 64 + 4);
          const f32x4 k0 = *(const f32x4*)(Wb + SC_CH * 64 + s * 64), k1 = *(const f32x4*)(Wb + SC_CH * 64 + s * 64 + 4);
          const f32x4 b0 = *(const f32x4*)(Wb + 2 * SC_CH * 64 + s * 64), b1 = *(const f32x4*)(Wb + 2 * SC_CH * 64 + s * 64 + 4);
          const f32x4 p0 = *(const f32x4*)(Wb + 3 * SC_CH * 64 + s * 64), p1 = *(const f32x4*)(Wb + 3 * SC_CH * 64 + s * 64 + 4);
          const f32x4 r0 = *(const f32x4*)(Wb + 4 * SC_CH * 64 + s * 64), r1 = *(const f32x4*)(Wb + 4 * SC_CH * 64 + s * 64 + 4);
          const float v = Vb[s * 32];
#define LO2(x) __builtin_shufflevector(x, x, 0, 1)
#define HI2(x) __builtin_shufflevector(x, x, 2, 3)
          const f32x2p xs = *(const f32x2p*)((const float*)cur + 5 * SC_CH * 64 + SC_CH * 32 + s * 2);
          f32x2p sa2 = st2[0] * LO2(k0), yd2 = st2[0] * LO2(r0);
          sa2 = st2[1] * HI2(k0) + sa2; yd2 = st2[1] * HI2(r0) + yd2;
          sa2 = st2[2] * LO2(k1) + sa2; yd2 = st2[2] * LO2(r1) + yd2;
          sa2 = st2[3] * HI2(k1) + sa2; yd2 = st2[3] * HI2(r1) + yd2;
          const float sa = -dpp_sum8(sa2[0] + sa2[1]);
          const float yd = dpp_sum8(yd2[0] + yd2[1]);
          yv[s] = yd + sa * xs[0] + v * xs[1];
          const f32x2p sav = {sa, sa}, vv = {v, v};
          st2[0] = st2[0] * LO2(w0) + (sav * LO2(b0) + vv * LO2(p0));
          st2[1] = st2[1] * HI2(w0) + (sav * HI2(b0) + vv * HI2(p0));
          st2[2] = st2[2] * LO2(w1) + (sav * LO2(b1) + vv * LO2(p1));
          st2[3] = st2[3] * HI2(w1) + (sav * HI2(b1) + vv * HI2(p1));
#undef LO2
#undef HI2
        }
        if (cg == 0) {
#pragma unroll
          for (int s = 0; s < SC_CH; ++s) yout[(size_t)(c * SC_CH + s) * RW] = yv[s];
        }
      }
      __syncthreads();
    }
#undef SC_LOAD
#undef SC_WRITE
  }
}

DI void moe_tr_small(const Params& p, int id, int lane, float* tl  ) {
  const int which = id >> 14, r_ = id & 16383, e = r_ >> 9, rr = r_ & 511;
  const float* src; int N, k0, n0;
  if (which < 2) { src = (which == 0 ? p.e_gate : p.e_up) + (size_t)e * 1024 * 512; N = 512; k0 = (rr >> 5) * 64; n0 = (rr & 31) * 16; }
  else { src = p.e_down + (size_t)e * 512 * 1024; N = 1024; k0 = (rr >> 6) * 64; n0 = (rr & 63) * 16; }
  const float* sp = src + (size_t)(k0 + lane) * N + n0;
  const f32x4 g0 = *(const f32x4*)sp, g1 = *(const f32x4*)(sp + 4), g2 = *(const f32x4*)(sp + 8), g3 = *(const f32x4*)(sp + 12);
  float* d = tl + lane * 17;
  d[0] = g0[0]; d[1] = g0[1]; d[2] = g0[2]; d[3] = g0[3]; d[4] = g1[0]; d[5] = g1[1]; d[6] = g1[2]; d[7] = g1[3];
  d[8] = g2[0]; d[9] = g2[1]; d[10] = g2[2]; d[11] = g2[3]; d[12] = g3[0]; d[13] = g3[1]; d[14] = g3[2]; d[15] = g3[3];
  const int nn = lane & 15, kq = lane >> 4;
  float v[16];
#pragma unroll
  for (int i = 0; i < 16; ++i) v[i] = tl[(kq * 16 + i) * 17 + nn];
  u32x4 w0, w1;
  w0.x = cvtpk(v[0], v[1]); w0.y = cvtpk(v[2], v[3]); w0.z = cvtpk(v[4], v[5]); w0.w = cvtpk(v[6], v[7]);
  w1.x = cvtpk(v[8], v[9]); w1.y = cvtpk(v[10], v[11]); w1.z = cvtpk(v[12], v[13]); w1.w = cvtpk(v[14], v[15]);
  const int n = n0 + nn;
  bf16_t* dst;
  if (which < 2) dst = ws_wgu(p) + (size_t)e * 1024 * 1024 + (size_t)((n >> 7) * 256 + (n & 127) + which * 128) * 1024 + k0 + kq * 16;
  else dst = ws_wd(p) + (size_t)e * 1024 * 512 + (size_t)n * 512 + k0 + kq * 16;
  *(u32x4*)dst = w0; *(u32x4*)(dst + 8) = w1;
}
DI void moe_piece_src(const Params& p, int id, int lane, const float*& sp) {
  const int which = id >> 14, r_ = id & 16383, e = r_ >> 9, rr = r_ & 511;
  const float* src; int N, k0, n0;
  if (which < 2) { src = (which == 0 ? p.e_gate : p.e_up) + (size_t)e * 1024 * 512; N = 512; k0 = (rr >> 5) * 64; n0 = (rr & 31) * 16; }
  else { src = p.e_down + (size_t)e * 512 * 1024; N = 1024; k0 = (rr >> 6) * 64; n0 = (rr & 63) * 16; }
  sp = src + (size_t)(k0 + lane) * N + n0;
}
DI void moe_piece_fin(const Params& p, int id, int lane, float* tl  , f32x4 g0, f32x4 g1, f32x4 g2, f32x4 g3) {
  const int which = id >> 14, r_ = id & 16383, e = r_ >> 9, rr = r_ & 511;
  int k0, n0;
  if (which < 2) { k0 = (rr >> 5) * 64; n0 = (rr & 31) * 16; } else { k0 = (rr >> 6) * 64; n0 = (rr & 63) * 16; }
  float* d = tl + lane * 17;
  d[0] = g0[0]; d[1] = g0[1]; d[2] = g0[2]; d[3] = g0[3]; d[4] = g1[0]; d[5] = g1[1]; d[6] = g1[2]; d[7] = g1[3];
  d[8] = g2[0]; d[9] = g2[1]; d[10] = g2[2]; d[11] = g2[3]; d[12] = g3[0]; d[13] = g3[1]; d[14] = g3[2]; d[15] = g3[3];
  const int nn = lane & 15, kq = lane >> 4;
  float v[16];
#pragma unroll
  for (int i = 0; i < 16; ++i) v[i] = tl[(kq * 16 + i) * 17 + nn];
  u32x4 w0, w1;
  w0.x = cvtpk(v[0], v[1]); w0.y = cvtpk(v[2], v[3]); w0.z = cvtpk(v[4], v[5]); w0.w = cvtpk(v[6], v[7]);
  w1.x = cvtpk(v[8], v[9]); w1.y = cvtpk(v[10], v[11]); w1.z = cvtpk(v[12], v[13]); w1.w = cvtpk(v[14], v[15]);
  const int n = n0 + nn;
  bf16_t* dst;
  if (which < 2) dst = ws_wgu(p) + (size_t)e * 1024 * 1024 + (size_t)((n >> 7) * 256 + (n & 127) + which * 128) * 1024 + k0 + kq * 16;
  else dst = ws_wd(p) + (size_t)e * 1024 * 512 + (size_t)n * 512 + k0 + kq * 16;
  *(u32x4*)dst = w0; *(u32x4*)(dst + 8) = w1;
}

constexpr int CS_PSZ = 23552, CS_SLSZ = 13312, CS_SL0 = 4 * CS_PSZ, CS_CON = CS_SL0 + 4 * CS_SLSZ;
DI f32x4v cs_mm16(const float* A, int sam, int sak, const float* B, int sbk, int sbn, f32x4v c, int l16, int g) {
#pragma unroll
  for (int q = 0; q < 4; ++q) c = __builtin_amdgcn_mfma_f32_16x16x4f32(A[l16 * sam + (4 * q + g) * sak], B[(4 * q + g) * sbk + l16 * sbn], c, 0, 0, 0);
  return c;
}
DI void cs_st16(float* D, f32x4v c, int l16, int g) {
#pragma unroll
  for (int r = 0; r < 4; ++r) D[(4 * g + r) * 16 + l16] = c[r];
}
DI f32x4v cs_ld16(const float* D, int l16, int g) { f32x4v c;
#pragma unroll
  for (int r = 0; r < 4; ++r) c[r] = D[(4 * g + r) * 16 + l16];
  return c; }
DI void cs_st4(bf16_t* base, int ld, f32x4v c) {
  const unsigned p01 = cvtpk(c[0] + 0.0f, c[1] + 0.0f), p23 = cvtpk(c[2] + 0.0f, c[3] + 0.0f);
  base[0] = (bf16_t)p01; base[ld] = (bf16_t)(p01 >> 16); base[2 * ld] = (bf16_t)p23; base[3 * ld] = (bf16_t)(p23 >> 16);
}
constexpr int CS_FLG = CS_CON + 6144 + 2 * 64 * 17 * 4;
DI void cs_wait(volatile int* f, int v) {
  while (__builtin_amdgcn_readfirstlane(*f) < v) __builtin_amdgcn_s_sleep(2);
  __builtin_amdgcn_fence(__ATOMIC_ACQUIRE, "workgroup");
}
DI void cs_post(volatile int* f, int v, int lane) {
  __builtin_amdgcn_fence(__ATOMIC_RELEASE, "workgroup");
  if (lane == 0) *f = v;
}
DI void cs_wait_l(volatile int* f, int v) { while (__builtin_amdgcn_readfirstlane(*f) < v) __builtin_amdgcn_s_sleep(1); asm volatile("" ::: "memory"); }
DI void cs_post_l(volatile int* f, int v, int lane) { asm volatile("s_waitcnt lgkmcnt(0)" ::: "memory"); if (lane == 0) *f = v; }
static_assert(CS_FLG + 48 <= LDS_BYTES - 64, "chunked scan LDS map");
#define CS_LAS __attribute__((address_space(3)))
typedef short cs_s16x4 __attribute__((ext_vector_type(4)));
template <int OFF> DI cs_s16x4 cs_tr_read(int vb) { cs_s16x4 r; asm volatile("ds_read_b64_tr_b16 %0, %1 offset:%2" : "=&v"(r) : "v"(vb), "i"(OFF) : "memory"); return r; }
template <int HF> DI void cs_stage0_half(char* ps, int lane, float mur, float rprev0, u32x4& bhw, float& gamC) {
  const int j = lane;
  bf16_t* AB = (bf16_t*)ps; bf16_t* BT = AB + 64 * 16; bf16_t* KT = BT + 64 * 16; bf16_t* RB = KT + 64 * 16;
  float* KHT = (float*)(ps + 9216);
  const int rb_ = (int)(uintptr_t)(ps + 13312) + ((lane >> 2) & 3) * 128 + ((lane >> 4) * 16 + (lane & 3) * 4) * 2;
  cs_s16x4 re[4], rk[2], rbq[2], rp[2], rr[2], rr7;
  re[0] = cs_tr_read<0>(rb_); re[1] = cs_tr_read<512>(rb_); re[2] = cs_tr_read<1024>(rb_); re[3] = cs_tr_read<1536>(rb_);
  rk[0] = cs_tr_read<2048 + HF * 1024>(rb_); rk[1] = cs_tr_read<2048 + HF * 1024 + 512>(rb_);
  rbq[0] = cs_tr_read<4096 + HF * 1024>(rb_); rbq[1] = cs_tr_read<4096 + HF * 1024 + 512>(rb_);
  rp[0] = cs_tr_read<6144 + HF * 1024>(rb_); rp[1] = cs_tr_read<6144 + HF * 1024 + 512>(rb_);
  rr[0] = cs_tr_read<8192 + HF * 1024>(rb_); rr[1] = cs_tr_read<8192 + HF * 1024 + 512>(rb_);
  rr7 = cs_tr_read<8192 + 512>(rb_);
  asm volatile("s_waitcnt lgkmcnt(0)" ::: "memory"); __builtin_amdgcn_sched_barrier(0);
  float cum[CK]; float run = 0.f;
#pragma unroll
  for (int tt = 0; tt < CK; ++tt) { run += bf2f((bf16_t)re[tt >> 2][tt & 3]); cum[tt] = run; }
  gamC = __expf(-run);
  float gprev = HF ? __expf(-cum[7]) : 1.0f;
  float rprev = HF ? bf2f((bf16_t)rr7[3]) : rprev0;
  float abv[8], bhv[8]; unsigned pbp[4], pkp[4], prp[4];
#pragma unroll
  for (int tp = 0; tp < 8; tp += 2) {
    float bt2[2], kt2[2], rb2[2];
#pragma unroll
    for (int u = 0; u < 2; ++u) { const int tl = tp + u, t_ = 8 * HF + tl;
      const float kkr = bf2f((bf16_t)rk[tl >> 2][tl & 3]), ber = bf2f((bf16_t)rbq[tl >> 2][tl & 3]), kpr = bf2f((bf16_t)rp[tl >> 2][tl & 3]), rv = bf2f((bf16_t)rr[tl >> 2][tl & 3]);
      const float rsh = rv + mur * (rprev - rv); rprev = rv;
      const float gt_ = __expf(-cum[t_]), gin = __builtin_amdgcn_rcpf(gt_), gh = gamC * gin;
      abv[tl] = -gprev * kkr; gprev = gt_;
      bt2[u] = ber * gin; kt2[u] = kpr * gin; rb2[u] = gt_ * rsh; bhv[tl] = ber * gh;
      KHT[j * 16 + t_] = kpr * gh; }
    pbp[tp >> 1] = cvtpk(bt2[0], bt2[1]); pkp[tp >> 1] = cvtpk(kt2[0], kt2[1]); prp[tp >> 1] = cvtpk(rb2[0], rb2[1]);
  }
  u32x4 w;
  w.x = pbp[0]; w.y = pbp[1]; w.z = pbp[2]; w.w = pbp[3]; *(u32x4*)(BT + j * 16 + 8 * HF) = w;
  w.x = pkp[0]; w.y = pkp[1]; w.z = pkp[2]; w.w = pkp[3]; *(u32x4*)(KT + j * 16 + 8 * HF) = w;
  w.x = prp[0]; w.y = prp[1]; w.z = prp[2]; w.w = prp[3]; *(u32x4*)(RB + j * 16 + 8 * HF) = w;
  w.x = cvtpk(abv[0], abv[1]); w.y = cvtpk(abv[2], abv[3]); w.z = cvtpk(abv[4], abv[5]); w.w = cvtpk(abv[6], abv[7]); *(u32x4*)(AB + j * 16 + 8 * HF) = w;
  bhw.x = cvtpk(bhv[0], bhv[1]); bhw.y = cvtpk(bhv[2], bhv[3]); bhw.z = cvtpk(bhv[4], bhv[5]); bhw.w = cvtpk(bhv[6], bhv[7]);
}
DI void cs_assist(char* lds, volatile int* fl_parked, volatile int* fl_hdone, int pw, int seq, int lane, float mur) {
  cs_wait_l(fl_parked + pw, seq);
  char* ps = lds + pw * CS_PSZ;
  u32x4 bhw; float gc;
  cs_stage0_half<1>(ps, lane, mur, 0.f, bhw, gc);
  *(u32x4*)(ps + 8192 + lane * 16) = bhw;
  cs_post_l(fl_hdone + pw, seq, lane);
}
DI void phase4a_chunk(const Params& p, int bid, int nb, char* lds) {
  const int t = tid_(), wid = __builtin_amdgcn_readfirstlane(t >> 6), lane = t & 63, l16 = lane & 15, g = lane >> 4;
  const bf16_t* proj = ws_proj(p);
  const f32x4v z4 = {0.f, 0.f, 0.f, 0.f};
  const bf16x8 zf = {0, 0, 0, 0, 0, 0, 0, 0};
  volatile int* fl_ready = (volatile int*)(lds + CS_FLG); volatile int* fl_done = fl_ready + 4; volatile int* fl_parked = fl_ready + 12; volatile int* fl_hdone = fl_ready + 16;
  if (t < 20) fl_ready[t] = 0;
  int seq0 = 0;
  for (int task = bid; task < BATCH * NH * 2; task += nb, seq0 += SEQ / CK / 4) {
    const int b = task >> 4, h = (task >> 1) & 7, half = task & 1;
    const int tok0 = b * SEQ;
    f32x4v Sacc[4] = {z4, z4, z4, z4};
    bf16x8 sA[2] = {zf, zf};
    const int i0 = (wid & 1) * 16;
    __syncthreads();
    u32x4 pf[10]; bf16_t pf_rp = 0, pf_v[9];
#define CS_PF(cc) do { const int ct_ = tok0 + (cc) * CK; \
      const unsigned ro_ = (unsigned)((ct_ + (lane >> 3)) * RW + h * HD + (lane & 7) * 8) * 2u; \
      const unsigned rp_ = (unsigned)((ct_ + (lane >> 3)) * PROJ_LD + C_R + h * HD + (lane & 7) * 8) * 2u; \
      pf[0] = *(const u32x4*)((const char*)ws_ee(p) + ro_); pf[1] = *(const u32x4*)((const char*)ws_ee(p) + ro_ + 8 * RW * 2); \
      pf[2] = *(const u32x4*)((const char*)ws_kk(p) + ro_); pf[3] = *(const u32x4*)((const char*)ws_kk(p) + ro_ + 8 * RW * 2); \
      pf[4] = *(const u32x4*)((const char*)ws_bb(p) + ro_); pf[5] = *(const u32x4*)((const char*)ws_bb(p) + ro_ + 8 * RW * 2); \
      pf[6] = *(const u32x4*)((const char*)ws_kp(p) + ro_); pf[7] = *(const u32x4*)((const char*)ws_kp(p) + ro_ + 8 * RW * 2); \
      pf[8] = *(const u32x4*)((const char*)proj + rp_); pf[9] = *(const u32x4*)((const char*)proj + rp_ + 8 * PROJ_LD * 2); \
      { const int tp_ = (ct_ - 1 < tok0) ? tok0 : ct_ - 1; pf_rp = proj[(unsigned)(tp_ * PROJ_LD + C_R + h * HD + lane)]; } \
      _Pragma("unroll") for (int q_ = 0; q_ < 9; ++q_) { int tv_ = ct_ + (lane >> 5) * 8 + q_ - 1; tv_ = (tv_ < tok0) ? tok0 : tv_; \
        pf_v[q_] = proj[(unsigned)(tv_ * PROJ_LD + C_V + h * HD + half * 32 + (lane & 31))]; } } while (0)
    if (wid >= 4) CS_PF(wid - 4);
    const float mur = p.shift_mu[C_R + h * HD + lane], muv = p.shift_mu[C_V + h * HD + half * 32 + (lane & 31)];
    if (wid < 2) __builtin_amdgcn_s_setprio(3);
    for (int rnd = 0; rnd <= SEQ / CK / 4; ++rnd) {
      if (wid >= 4) {
        if (rnd == SEQ / CK / 4) continue;
        const int pw = wid - 4, c = rnd * 4 + pw, ct0 = tok0 + c * CK;
        char* ps = lds + pw * CS_PSZ;
        bf16_t* AB = (bf16_t*)ps; bf16_t* BT = AB + 64 * 16; bf16_t* KT = BT + 64 * 16; bf16_t* RB = KT + 64 * 16;
        float* KHT = (float*)(ps + 9216);
        float* Nf = (float*)(ps + 13312); float* AKB = Nf + 256; float* ABR = AKB + 256; float* AKR = ABR + 256;
        float* T0 = AKR + 256; float* T1 = Nf; float* Pm = T0 + 256; float* Mm = Pm + 256;
        bf16_t* ABT = AB;
        bf16_t* APb = (bf16_t*)BT;
        bf16_t* MTb = (bf16_t*)KT;
        bf16_t* W1b = MTb + 16 * 16;
        bf16_t* ABRT = W1b + 16 * 16;
        char* sl = lds + CS_SL0 + pw * CS_SLSZ;
        bf16_t* QT = (bf16_t*)sl; bf16_t* APT = QT + 16 * 72; bf16_t* BHT = APT + 16 * 72; bf16_t* GGT = BHT + 64 * 24; bf16_t* HT = GGT + 64 * 24; bf16_t* VT = HT + 16 * 24;
        float* GAM = (float*)(sl + 2304 * 2 + 3072 * 2 + 768 + 1536);
        u32x4 bhw0, vw; float gamC;
        {
          {
            char* rawl = ps + 13312 + lane * 16;
#pragma unroll
            for (int i = 0; i < 10; ++i) *(u32x4*)(rawl + i * 1024) = pf[i];
          }
          cs_post_l(fl_parked + pw, seq0 + rnd + 1, lane);
          float rprev = (c * CK > 0) ? bf2f(pf_rp) : 0.f;
          {
            const int vi = lane & 31, sh = lane >> 5, vcol = C_V + h * HD + half * 32 + vi;
            float vprev = (c * CK + sh * 8 > 0) ? bf2f(pf_v[0]) : 0.f;
            float vv[8];
#pragma unroll
            for (int q = 0; q < 8; ++q) { const float vr = bf2f(pf_v[q + 1]); vv[q] = vr + muv * (vprev - vr); vprev = vr; }
            vw.x = cvtpk(vv[0], vv[1]); vw.y = cvtpk(vv[2], vv[3]); vw.z = cvtpk(vv[4], vv[5]); vw.w = cvtpk(vv[6], vv[7]);
          }
          if (rnd + 1 < SEQ / CK / 4) CS_PF(c + 4);
          cs_stage0_half<0>(ps, lane, mur, rprev, bhw0, gamC);
          cs_wait_l(fl_hdone + pw, seq0 + rnd + 1);
        }
        {
          bf16x8 fb[2], fk[2], fa[2], fr[2];
          {
            const int trb = (int)(uintptr_t)AB + (8 * g + ((lane >> 2) & 3)) * 32 + (lane & 3) * 8;
#define CS_FR(F, X, ks) { const cs_s16x4 l_ = cs_tr_read<(X) * 2048 + (ks) * 1024>(trb), h_ = cs_tr_read<(X) * 2048 + (ks) * 1024 + 128>(trb); F = (bf16x8){l_[0], l_[1], l_[2], l_[3], h_[0], h_[1], h_[2], h_[3]}; }
            cs_s16x4 tl[8], th[8];
            tl[0] = cs_tr_read<0>(trb); th[0] = cs_tr_read<128>(trb); tl[1] = cs_tr_read<1024>(trb); th[1] = cs_tr_read<1024 + 128>(trb);
            tl[2] = cs_tr_read<2048>(trb); th[2] = cs_tr_read<2048 + 128>(trb); tl[3] = cs_tr_read<2048 + 1024>(trb); th[3] = cs_tr_read<2048 + 1024 + 128>(trb);
            tl[4] = cs_tr_read<4096>(trb); th[4] = cs_tr_read<4096 + 128>(trb); tl[5] = cs_tr_read<4096 + 1024>(trb); th[5] = cs_tr_read<4096 + 1024 + 128>(trb);
            tl[6] = cs_tr_read<6144>(trb); th[6] = cs_tr_read<6144 + 128>(trb); tl[7] = cs_tr_read<6144 + 1024>(trb); th[7] = cs_tr_read<6144 + 1024 + 128>(trb);
            asm volatile("s_waitcnt lgkmcnt(0)" ::: "memory"); __builtin_amdgcn_sched_barrier(0);
#define CS_PKF(i_) (bf16x8){tl[i_][0], tl[i_][1], tl[i_][2], tl[i_][3], th[i_][0], th[i_][1], th[i_][2], th[i_][3]}
            fa[0] = CS_PKF(0); fa[1] = CS_PKF(1); fb[0] = CS_PKF(2); fb[1] = CS_PKF(3); fk[0] = CS_PKF(4); fk[1] = CS_PKF(5); fr[0] = CS_PKF(6); fr[1] = CS_PKF(7);
#undef CS_PKF
#undef CS_FR
          }
          f32x4v n_ = z4, akb = z4, abr = z4, akr = z4;
#pragma unroll
          for (int ks = 0; ks < 2; ++ks) {
            n_ = __builtin_amdgcn_mfma_f32_16x16x32_bf16(fb[ks], fa[ks], n_, 0, 0, 0);
            akb = __builtin_amdgcn_mfma_f32_16x16x32_bf16(fk[ks], fa[ks], akb, 0, 0, 0);
            abr = __builtin_amdgcn_mfma_f32_16x16x32_bf16(fb[ks], fr[ks], abr, 0, 0, 0);
            akr = __builtin_amdgcn_mfma_f32_16x16x32_bf16(fk[ks], fr[ks], akr, 0, 0, 0);
          }
#pragma unroll
          for (int r = 0; r < 4; ++r) { const int s_ = 4 * g + r, t_ = l16;
            Nf[s_ * 16 + t_] = (s_ < t_) ? n_[r] : 0.f; AKB[s_ * 16 + t_] = (s_ < t_) ? akb[r] : 0.f;
            ABR[s_ * 16 + t_] = (s_ <= t_) ? abr[r] : 0.f; AKR[t_ * 16 + s_] = (s_ <= t_) ? akr[r] : 0.f;
            Pm[s_ * 16 + t_] = ((s_ < t_) ? n_[r] : 0.f) + ((s_ == t_) ? 1.0f : 0.f); }
          { const int t_ = l16; float a4[4];
#pragma unroll
            for (int r = 0; r < 4; ++r) a4[r] = (4 * g + r <= t_) ? abr[r] : 0.f;
            *(u32x2*)(ABRT + t_ * 16 + 4 * g) = pk4(a4[0], a4[1], a4[2], a4[3]); }
        }
        {
          f32x4v c_;
          c_ = cs_mm16(Nf, 16, 1, Nf, 16, 1, z4, l16, g); cs_st16(T0, c_, l16, g);
          c_ = cs_mm16(Pm, 16, 1, T0, 16, 1, cs_ld16(Pm, l16, g), l16, g); cs_st16(Pm, c_, l16, g);
          c_ = cs_mm16(T0, 16, 1, T0, 16, 1, z4, l16, g); cs_st16(T1, c_, l16, g);
          c_ = cs_mm16(Pm, 16, 1, T1, 16, 1, cs_ld16(Pm, l16, g), l16, g); cs_st16(Pm, c_, l16, g);
          c_ = cs_mm16(T1, 16, 1, T1, 16, 1, z4, l16, g); cs_st16(T0, c_, l16, g);
          c_ = cs_mm16(Pm, 16, 1, T0, 16, 1, cs_ld16(Pm, l16, g), l16, g); cs_st16(Mm, c_, l16, g);
          *(u32x2*)(MTb + l16 * 16 + 4 * g) = pk4(c_[0] + 0.0f, c_[1] + 0.0f, c_[2] + 0.0f, c_[3] + 0.0f);
          f32x4v w_ = z4;
#pragma unroll
          for (int q = 0; q < 4; ++q) w_ = __builtin_amdgcn_mfma_f32_16x16x4f32(Mm[(4 * q + g) * 16 + l16], AKB[l16 * 16 + 4 * q + g], w_, 0, 0, 0);
          *(u32x2*)(W1b + l16 * 16 + 4 * g) = pk4(w_[0] + 0.0f, w_[1] + 0.0f, w_[2] + 0.0f, w_[3] + 0.0f);
        }
        cs_wait(fl_done + pw, seq0 + rnd); cs_wait(fl_done + 4 + pw, seq0 + rnd);
        *(u32x4*)(BHT + lane * 24) = bhw0; *(u32x4*)(BHT + lane * 24 + 8) = *(const u32x4*)(ps + 8192 + lane * 16);
        GAM[lane] = gamC;
        *(u32x4*)(VT + (lane & 31) * 24 + (lane >> 5) * 8) = vw;
        {
          const bf16x8 mF = (g < 2) ? *(const bf16x8*)(MTb + l16 * 16 + 8 * g) : zf;
          const bf16x8 rF = (g < 2) ? *(const bf16x8*)(ABRT + l16 * 16 + 8 * g) : zf;
          const bf16x8 wF = (g < 2) ? *(const bf16x8*)(W1b + l16 * 16 + 8 * g) : zf;
#pragma unroll
          for (int nt = 0; nt < 4; ++nt) {
            const bf16x8 bF = *(const bf16x8*)(ABT + (16 * nt + l16) * 16 + 8 * (g & 1));
            const f32x4v c_ = __builtin_amdgcn_mfma_f32_16x16x32_bf16(mF, bF, z4, 0, 0, 0);
            *(u32x2*)(APb + (16 * nt + l16) * 16 + 4 * g) = pk4(c_[0] + 0.0f, c_[1] + 0.0f, c_[2] + 0.0f, c_[3] + 0.0f);
            const f32x4v d_ = __builtin_amdgcn_mfma_f32_16x16x32_bf16(bF, mF, z4, 0, 0, 0);
            *(u32x2*)(APT + l16 * 72 + 16 * nt + 4 * g) = pk4(d_[0] + 0.0f, d_[1] + 0.0f, d_[2] + 0.0f, d_[3] + 0.0f);
          }
          cs_s16x4 rq[4];
          { const int rbq = (int)(uintptr_t)RB + (4 * g + ((lane >> 2) & 3)) * 32 + (lane & 3) * 8;
            rq[0] = cs_tr_read<0>(rbq); rq[1] = cs_tr_read<512>(rbq); rq[2] = cs_tr_read<1024>(rbq); rq[3] = cs_tr_read<1536>(rbq);
            asm volatile("s_waitcnt lgkmcnt(0)" ::: "memory"); __builtin_amdgcn_sched_barrier(0); }
#pragma unroll
          for (int nt = 0; nt < 4; ++nt) {
            f32x4v c_ = {bf2f((bf16_t)rq[nt][0]), bf2f((bf16_t)rq[nt][1]), bf2f((bf16_t)rq[nt][2]), bf2f((bf16_t)rq[nt][3])};
            const bf16x8 bF = *(const bf16x8*)(APb + (16 * nt + l16) * 16 + 8 * (g & 1));
            c_ = __builtin_amdgcn_mfma_f32_16x16x32_bf16(bF, rF, c_, 0, 0, 0);
            *(u32x2*)(QT + l16 * 72 + 16 * nt + 4 * g) = pk4(c_[0] + 0.0f, c_[1] + 0.0f, c_[2] + 0.0f, c_[3] + 0.0f);
          }
          {
            const f32x4 k4 = *(const f32x4*)(AKR + l16 * 16 + 4 * g);
            f32x4v c_ = {k4[0], k4[1], k4[2], k4[3]};
            c_ = __builtin_amdgcn_mfma_f32_16x16x32_bf16(wF, rF, c_, 0, 0, 0);
            *(u32x2*)(HT + l16 * 24 + 4 * g) = pk4(c_[0] + 0.0f, c_[1] + 0.0f, c_[2] + 0.0f, c_[3] + 0.0f);
          }
#pragma unroll
          for (int mt = 0; mt < 4; ++mt) {
            const f32x4 k4 = *(const f32x4*)(KHT + (16 * mt + l16) * 16 + 4 * g);
            f32x4v c_ = {k4[0], k4[1], k4[2], k4[3]};
            const bf16x8 aF = *(const bf16x8*)(BHT + (16 * mt + l16) * 24 + 8 * (g & 1));
            c_ = __builtin_amdgcn_mfma_f32_16x16x32_bf16(wF, aF, c_, 0, 0, 0);
            *(u32x2*)(GGT + (16 * mt + l16) * 24 + 4 * g) = pk4(c_[0] + 0.0f, c_[1] + 0.0f, c_[2] + 0.0f, c_[3] + 0.0f);
          }
        }
        cs_post(fl_ready + pw, seq0 + rnd + 1, lane);
      }
      else if (wid >= 2) {
        if (rnd == SEQ / CK / 4) continue;
        cs_assist(lds, fl_parked, fl_hdone, wid, seq0 + rnd + 1, lane, mur);
        float* tl = (float*)(lds + CS_CON + 6144) + (wid - 2) * (64 * 17);
        {
          f32x4 mr[3][4]; const int id0 = (task * 2 + (wid - 2)) * 96 + rnd * 3;
#pragma unroll
          for (int q = 0; q < 3; ++q) { const float* sp_; moe_piece_src(p, id0 + q, lane, sp_); mr[q][0] = *(const f32x4*)sp_; mr[q][1] = *(const f32x4*)(sp_ + 4); mr[q][2] = *(const f32x4*)(sp_ + 8); mr[q][3] = *(const f32x4*)(sp_ + 12); }
#pragma unroll
          for (int q = 0; q < 3; ++q) moe_piece_fin(p, id0 + q, lane, tl, mr[q][0], mr[q][1], mr[q][2], mr[q][3]);
        }
      }
      else {
        if (rnd < SEQ / CK / 4) cs_assist(lds, fl_parked, fl_hdone, wid, seq0 + rnd + 1, lane, mur);
        if (rnd == 0) continue;
        const int crnd = rnd - 1;
#pragma unroll 1
        for (int k = 0; k < 4; ++k) {
          const char* sl = lds + CS_SL0 + k * CS_SLSZ;
          cs_wait(fl_ready + k, seq0 + crnd + 1);
          const bf16_t* QT = (const bf16_t*)sl; const bf16_t* APT = QT + 16 * 72; const bf16_t* BHT = APT + 16 * 72; const bf16_t* GGT = BHT + 64 * 24; const bf16_t* HT = GGT + 64 * 24; const bf16_t* VT = HT + 16 * 24;
          const float* GAM = (const float*)(sl + 2304 * 2 + 3072 * 2 + 768 + 1536);
          bf16x8 qF[2], aF[2];
#pragma unroll
          for (int ks = 0; ks < 2; ++ks) { qF[ks] = *(const bf16x8*)(QT + l16 * 72 + 8 * g + 32 * ks); aF[ks] = *(const bf16x8*)(APT + l16 * 72 + 8 * g + 32 * ks); }
          const bf16x8 vF = (g < 2) ? *(const bf16x8*)(VT + (i0 + l16) * 24 + 8 * g) : zf;
          const bf16x8 hF = (g < 2) ? *(const bf16x8*)(HT + l16 * 24 + 8 * g) : zf;
          f32x4v yT = z4;
          yT = __builtin_amdgcn_mfma_f32_16x16x32_bf16(qF[0], sA[0], yT, 0, 0, 0);
          yT = __builtin_amdgcn_mfma_f32_16x16x32_bf16(qF[1], sA[1], yT, 0, 0, 0);
          yT = __builtin_amdgcn_mfma_f32_16x16x32_bf16(hF, vF, yT, 0, 0, 0);
          {
            float* yo = ws_y(p) + (size_t)(tok0 + (crnd * 4 + k) * CK + 4 * g) * RW + h * HD + half * 32 + i0 + l16;
#pragma unroll
            for (int r = 0; r < 4; ++r) yo[(size_t)r * RW] = yT[r];
          }
          f32x4v uT = z4;
          uT = __builtin_amdgcn_mfma_f32_16x16x32_bf16(aF[0], sA[0], uT, 0, 0, 0);
          uT = __builtin_amdgcn_mfma_f32_16x16x32_bf16(aF[1], sA[1], uT, 0, 0, 0);
          bf16x8 uF;
          {
            const unsigned ud0 = cvtpk(uT[0] + 0.0f, uT[1] + 0.0f), ud1 = cvtpk(uT[2] + 0.0f, uT[3] + 0.0f);
            const auto r0 = __builtin_amdgcn_permlane16_swap(ud0, 0u, false, false); const auto r1 = __builtin_amdgcn_permlane16_swap(ud1, 0u, false, false);
            u32x4 w = {r0[0], r1[0], r0[1], r1[1]}; uF = *reinterpret_cast<bf16x8*>(&w);
          }
          unsigned D[4][2];
#pragma unroll
          for (int nt = 0; nt < 4; ++nt) {
            const f32x4 gm4 = *(const f32x4*)(GAM + 16 * nt + 4 * g);
            const bf16x8 bF = *(const bf16x8*)(BHT + (16 * nt + l16) * 24 + 4 * (g & 2));
            const bf16x8 gF = *(const bf16x8*)(GGT + (16 * nt + l16) * 24 + 8 * (g & 1));
            f32x4v a_ = Sacc[nt];
            a_[0] *= gm4[0]; a_[1] *= gm4[1]; a_[2] *= gm4[2]; a_[3] *= gm4[3];
            a_ = __builtin_amdgcn_mfma_f32_16x16x32_bf16(bF, uF, a_, 0, 0, 0);
            a_ = __builtin_amdgcn_mfma_f32_16x16x32_bf16(gF, vF, a_, 0, 0, 0);
            Sacc[nt] = a_;
            D[nt][0] = cvtpk(a_[0] + 0.0f, a_[1] + 0.0f); D[nt][1] = cvtpk(a_[2] + 0.0f, a_[3] + 0.0f);
          }
          cs_post(fl_done + wid * 4 + k, seq0 + crnd + 1, lane);
#pragma unroll
          for (int n1 = 0; n1 < 2; ++n1) {
            unsigned F[2][2];
#pragma unroll
            for (int rp = 0; rp < 2; ++rp) {
              const auto e = __builtin_amdgcn_permlane32_swap(D[2 * n1][rp], D[2 * n1 + 1][rp], false, false);
              const auto f = __builtin_amdgcn_permlane16_swap(e[0], e[1], false, false);
              F[0][rp] = f[0]; F[1][rp] = f[1];
            }
            u32x4 w = {F[0][0], F[0][1], F[1][0], F[1][1]}; sA[n1] = *reinterpret_cast<bf16x8*>(&w);
          }
        }
      }
    }
  }
  __builtin_amdgcn_s_setprio(0);
  __syncthreads();
}

DI unsigned fkey(float f) { const unsigned u = __float_as_uint(f); return (u & 0x80000000u) ? ~u : (u | 0x80000000u); }
DI int block_sum_i(int v, int* red, int wid, int lane) {
  for (int o = 32; o; o >>= 1) v += __shfl_xor(v, o);
  __syncthreads();
  if (lane == 0) red[wid] = v;
  __syncthreads();
  int s = 0;
#pragma unroll
  for (int w = 0; w < 8; ++w) s += red[w];
  return s;
}
DI void phase4b(const Params& p, int bid, int nb, char* lds) {
  const int t = tid_(), lane = t & 63, wid = t >> 6;
  float* qf = (float*)lds;
  float* wi = qf + 256;
  int* red = (int*)(wi + 4);
  int* wtie = red + 8;
  const bf16_t* proj = ws_proj(p);
  for (int gq = bid; gq < NTOK; gq += nb) {
    const int b = gq >> 11, s = gq & (SEQ - 1);
    const int n = ((s >> 6) + 1) * 64;
    unsigned* mrow = ws_mask(p) + (size_t)gq * 64;
    if (n <= 256) {
      if (t < 64) mrow[t] = (t * 32 < n) ? 0xffffffffu : 0u;
      continue;
    }
    __syncthreads();
    if (t < 256) qf[t] = bf2f(proj[(size_t)gq * PROJ_LD + C_QI + t]) * 0.125f;
    else if (t < 260) wi[t - 256] = bf2f(proj[(size_t)gq * PROJ_LD + C_WI + t - 256]) * 0.5f;
    __syncthreads();
    unsigned uk[4];
#pragma unroll 1
    for (int q = 0; q < 4; ++q) {
      const int key = t * 4 + q;
      uk[q] = 0u;
      if (key < n) {
        float kf[64];
        const bf16_t* kr = ws_kidx(p) + ((size_t)b * SEQ + key) * 64;
#pragma unroll
        for (int d8 = 0; d8 < 8; ++d8) load8(kr + d8 * 8, kf + d8 * 8);
        float sc = 0.f;
#pragma unroll
        for (int hh = 0; hh < 4; ++hh) {
          float dot = 0.f;
#pragma unroll
          for (int d4 = 0; d4 < 16; ++d4) { const f32x4 qv = *(const f32x4*)(qf + hh * 64 + d4 * 4); dot += qv[0] * kf[d4 * 4] + qv[1] * kf[d4 * 4 + 1] + qv[2] * kf[d4 * 4 + 2] + qv[3] * kf[d4 * 4 + 3]; }
          sc += wi[hh] * fmaxf(dot, 0.f);
        }
        sc = sc + 0.0f;
        uk[q] = fkey(sc);
      }
    }
    unsigned T = 0u;
    for (int bit = 31; bit >= 0; --bit) {
      const unsigned cand = T | (1u << bit);
      const int c = (uk[0] >= cand) + (uk[1] >= cand) + (uk[2] >= cand) + (uk[3] >= cand);
      if (block_sum_i(c, red, wid, lane) >= 256) T = cand;
    }
    const int cgt = block_sum_i((uk[0] > T) + (uk[1] > T) + (uk[2] > T) + (uk[3] > T), red, wid, lane);
    const int need = 256 - cgt;
    const int tl = (uk[0] == T) + (uk[1] == T) + (uk[2] == T) + (uk[3] == T);
    int incl = tl;
    for (int o = 1; o < 64; o <<= 1) { const int u = __shfl_up(incl, o); if (lane >= o) incl += u; }
    __syncthreads();
    if (lane == 63) wtie[wid] = incl;
    __syncthreads();
    int before = incl - tl;
    for (int w = 0; w < wid; ++w) before += wtie[w];
    unsigned nib = 0u;
#pragma unroll
    for (int q = 0; q < 4; ++q) {
      bool sel = uk[q] > T;
      if (uk[q] == T) { sel = before < need; ++before; }
      if (sel) nib |= 1u << q;
    }
    unsigned word = nib << ((lane & 7) * 4);
    word |= __shfl_xor(word, 1); word |= __shfl_xor(word, 2); word |= __shfl_xor(word, 4);
    if ((lane & 7) == 0) mrow[t >> 3] = word;
  }
}

constexpr int IDX_LD = 2052;
template <int NG> DI void idx_search(const unsigned (&ua)[32], const unsigned (&ub)[32], unsigned& Ta, unsigned& Tb, bool& xa, bool& xb) {
  for (int bit = 31; bit >= 0; --bit) {
    const unsigned ca = xa ? Ta : (Ta | (1u << bit)), cb = xb ? Tb : (Tb | (1u << bit));
    int va = 0, vb = 0;
    const unsigned cav = ca, cbv = cb;
#pragma unroll
    for (int j = 0; j < NG * 4; j += 2) {
      unsigned long long m0, m1, m2, m3;
      asm volatile("v_cmp_ge_u32_e64 %[m0], %[a0], %[ca]\n\tv_cmp_ge_u32_e64 %[m1], %[b0], %[cb]\n\tv_cmp_ge_u32_e64 %[m2], %[a1], %[ca]\n\tv_cmp_ge_u32_e64 %[m3], %[b1], %[cb]\n\t"
                   "v_addc_co_u32_e64 %[va], %[m0], 0, %[va], %[m0]\n\tv_addc_co_u32_e64 %[vb], %[m1], 0, %[vb], %[m1]\n\tv_addc_co_u32_e64 %[va], %[m2], 0, %[va], %[m2]\n\tv_addc_co_u32_e64 %[vb], %[m3], 0, %[vb], %[m3]"
                   : [va] "+v"(va), [vb] "+v"(vb), [m0] "=&s"(m0), [m1] "=&s"(m1), [m2] "=&s"(m2), [m3] "=&s"(m3)
                   : [a0] "v"(ua[j]), [b0] "v"(ub[j]), [a1] "v"(ua[j + 1]), [b1] "v"(ub[j + 1]), [ca] "v"(cav), [cb] "v"(cbv));
    }
    int vab = va | (vb << 16);
    vab += __builtin_amdgcn_update_dpp(0, vab, 0xB1, 0xF, 0xF, true);
    vab += __builtin_amdgcn_update_dpp(0, vab, 0x4E, 0xF, 0xF, true);
    vab += __builtin_amdgcn_update_dpp(0, vab, 0x141, 0xF, 0xF, true);
    vab += __builtin_amdgcn_update_dpp(0, vab, 0x140, 0xF, 0xF, true);
    const int tot = __builtin_amdgcn_readlane(vab, 0) + __builtin_amdgcn_readlane(vab, 16) + __builtin_amdgcn_readlane(vab, 32) + __builtin_amdgcn_readlane(vab, 48);
    const int na = tot & 0xffff, nq = tot >> 16;
    if (!xa && na >= 256) { Ta = ca; xa = (na == 256); }
    if (!xb && nq >= 256) { Tb = cb; xb = (nq == 256); }
    if (xa && xb) break;
  }
}
template <int NG> DI void idx_emit(const unsigned (&u)[32], unsigned T, bool exact, unsigned* mrow, int lane) {
  if (exact) {
#pragma unroll
    for (int j = 0; j < NG * 4; ++j) {
      const unsigned long long sel = __ballot(u[j] >= T);
      if (lane == 0) { mrow[2 * j] = (unsigned)sel; mrow[2 * j + 1] = (unsigned)(sel >> 32); }
    }
    return;
  }
  int cgt = 0;
#pragma unroll
  for (int j = 0; j < NG * 4; ++j) cgt += __popcll(__ballot(u[j] > T));
  int need = 256 - cgt;
#pragma unroll
  for (int j = 0; j < NG * 4; ++j) {
    unsigned long long sel = __ballot(u[j] > T);
    const unsigned long long eq = __ballot(u[j] == T);
    const int pe = __popcll(eq);
    if (pe <= need) { sel |= eq; need -= pe; }
    else { unsigned long long e = eq; for (int i = 0; i < need; ++i) { const unsigned long long low = e & (0ull - e); sel |= low; e ^= low; } need = 0; }
    if (lane == 0) { mrow[2 * j] = (unsigned)sel; mrow[2 * j + 1] = (unsigned)(sel >> 32); }
  }
}
DI void phase4b_mfma(const Params& p, int bid, int nb, char* lds) {
  const int t = tid_(), lane = t & 63, wid = __builtin_amdgcn_readfirstlane(t >> 6), q16 = lane & 15, g = lane >> 4;
  unsigned* S = (unsigned*)lds;
  const bf16_t* proj = ws_proj(p);
  for (int task = bid; task < NTOK / 16; task += nb) {
    const int b = (task & 255) >> 4, jq = task & 15, kq = task >> 8;
    const int q0 = (((kq & 1) ? 31 - jq : jq) + 32 * (kq >> 1)) * 16;
    const int n = ((q0 >> 6) + 1) * 64, ntile = n >> 4;
    if (n <= 256) {
      unsigned short* mrow = (unsigned short*)(ws_mask(p) + (size_t)(b * SEQ + q0 + q16) * 64);
      if (g == 0) for (int kt = wid; kt < ntile; kt += 8) mrow[kt] = 0xffffu;
      continue;
    }
    const int gq = b * SEQ + q0 + q16;
    const int ntw = (ntile - wid + 7) >> 3;
    const bf16_t* kbase = ws_kidx(p) + (size_t)b * SEQ * 64 + (wid * 16 + q16) * 64 + g * 8;
    bf16x8 qf[4][2]; float wq[4];
#pragma unroll
    for (int h = 0; h < 4; ++h) {
#pragma unroll
      for (int ks = 0; ks < 2; ++ks) qf[h][ks] = *(const bf16x8*)(proj + (size_t)gq * PROJ_LD + C_QI + h * 64 + ks * 32 + g * 8);
      wq[h] = bf2f(proj[(size_t)gq * PROJ_LD + C_WI + h]) * 0.0625f;
    }
    __syncthreads();
    bf16x8 k0 = *(const bf16x8*)kbase, k1 = *(const bf16x8*)(kbase + 32);
#pragma unroll
    for (int tt = 0; tt < 16; ++tt) {
      if (tt < ntw) {
        const bf16x8 c0 = k0, c1 = k1;
        if (tt + 1 < ntw) { int koff = (tt + 1) * 8 * 16 * 64; asm volatile("" : "+v"(koff)); k0 = *(const bf16x8*)(kbase + koff); k1 = *(const bf16x8*)(kbase + koff + 32); }
        float sc[4] = {0.f, 0.f, 0.f, 0.f};
#pragma unroll
        for (int h = 0; h < 4; ++h) {
          f32x4v acc = {0.f, 0.f, 0.f, 0.f};
          acc = __builtin_amdgcn_mfma_f32_16x16x32_bf16(c0, qf[h][0], acc, 0, 0, 0);
          acc = __builtin_amdgcn_mfma_f32_16x16x32_bf16(c1, qf[h][1], acc, 0, 0, 0);
#pragma unroll
          for (int r = 0; r < 4; ++r) sc[r] += wq[h] * __builtin_amdgcn_fmed3f(acc[r], 0.f, __builtin_inff());
        }
        u32x4 kv;
#pragma unroll
        for (int r = 0; r < 4; ++r) {
          const unsigned bts = __float_as_uint(sc[r]);
          unsigned key = bts ^ ((unsigned)((int)bts >> 31) | 0x80000000u);
          key += (key == 0x7fffffffu) ? 1u : 0u;
          kv[r] = key;
        }
        *(u32x4*)(S + q16 * IDX_LD + (wid + 8 * tt) * 16 + 4 * g) = kv;
      }
    }
    __syncthreads();
    {
      const int nreg = n >> 6;
      const int qa = 2 * wid;
      unsigned ua[32], ub[32];
#pragma unroll
      for (int j = 0; j < 32; ++j) { ua[j] = (j < nreg) ? S[qa * IDX_LD + 64 * j + lane] : 0u; ub[j] = (j < nreg) ? S[(qa + 1) * IDX_LD + 64 * j + lane] : 0u; }
      unsigned Ta = 0u, Tb = 0u; bool xa = false, xb = false;
      switch ((nreg + 3) >> 2) {
        case 2: idx_search<2>(ua, ub, Ta, Tb, xa, xb); break;
        case 3: idx_search<3>(ua, ub, Ta, Tb, xa, xb); break;
        case 4: idx_search<4>(ua, ub, Ta, Tb, xa, xb); break;
        case 5: idx_search<5>(ua, ub, Ta, Tb, xa, xb); break;
        case 6: idx_search<6>(ua, ub, Ta, Tb, xa, xb); break;
        case 7: idx_search<7>(ua, ub, Ta, Tb, xa, xb); break;
        default: idx_search<8>(ua, ub, Ta, Tb, xa, xb); break;
      }
      {
        unsigned* mrowa = ws_mask(p) + (size_t)(b * SEQ + q0 + qa) * 64;
        switch ((nreg + 3) >> 2) {
          case 2: idx_emit<2>(ua, Ta, xa, mrowa, lane); idx_emit<2>(ub, Tb, xb, mrowa + 64, lane); break;
          case 3: idx_emit<3>(ua, Ta, xa, mrowa, lane); idx_emit<3>(ub, Tb, xb, mrowa + 64, lane); break;
          case 4: idx_emit<4>(ua, Ta, xa, mrowa, lane); idx_emit<4>(ub, Tb, xb, mrowa + 64, lane); break;
          case 5: idx_emit<5>(ua, Ta, xa, mrowa, lane); idx_emit<5>(ub, Tb, xb, mrowa + 64, lane); break;
          case 6: idx_emit<6>(ua, Ta, xa, mrowa, lane); idx_emit<6>(ub, Tb, xb, mrowa + 64, lane); break;
          case 7: idx_emit<7>(ua, Ta, xa, mrowa, lane); idx_emit<7>(ub, Tb, xb, mrowa + 64, lane); break;
          default: idx_emit<8>(ua, Ta, xa, mrowa, lane); idx_emit<8>(ub, Tb, xb, mrowa + 64, lane); break;
        }
      }
    }
  }
}

DI void phase5a(const Params& p, int bid, int nb, char* lds) {
  const int lane = tid_() & 63, wid = tid_() >> 6;
  const bf16_t* proj = ws_proj(p);
  for (int gt = bid * 8 + wid; gt < NTOK; gt += nb * 8) {
    const int c0 = lane * 8, h = lane >> 3;
    const f32x4 y0 = *(const f32x4*)(ws_y(p) + (size_t)gt * RW + c0), y1 = *(const f32x4*)(ws_y(p) + (size_t)gt * RW + c0 + 4);
    float y[8] = {y0[0], y0[1], y0[2], y0[3], y1[0], y1[1], y1[2], y1[3]};
    float s = 0.f;
#pragma unroll
    for (int j = 0; j < 8; ++j) s += y[j];
    s += __shfl_xor(s, 1); s += __shfl_xor(s, 2); s += __shfl_xor(s, 4);
    const float mean = s * (1.0f / 64.0f);
    float q = 0.f;
#pragma unroll
    for (int j = 0; j < 8; ++j) { const float d = y[j] - mean; q += d * d; }
    q += __shfl_xor(q, 1); q += __shfl_xor(q, 2); q += __shfl_xor(q, 4);
    const float rstd = rsqrtf(q * (1.0f / 64.0f) + 64e-5f);
    float g[8], vr[8], vp[8];
    load8(ws_gg(p) + (size_t)gt * RW + c0, g);
    load8(proj + (size_t)gt * PROJ_LD + C_V + c0, vr);
    if (gt & (SEQ - 1)) load8(proj + (size_t)(gt - 1) * PROJ_LD + C_V + c0, vp);
    else {
#pragma unroll
      for (int j = 0; j < 8; ++j) vp[j] = 0.f;
    }
    const float bs = ws_bonus(p)[gt * NH + h];
    float o[8];
#pragma unroll
    for (int j = 0; j < 8; ++j) {
      const float v = vr[j] + p.shift_mu[C_V + c0 + j] * (vp[j] - vr[j]);
      o[j] = ((y[j] - mean) * rstd * p.gn_g[c0 + j] + p.gn_b[c0 + j] + bs * v) * g[j];
    }
    u32x4 w; w.x = pack2(o[0], o[1]); w.y = pack2(o[2], o[3]); w.z = pack2(o[4], o[5]); w.w = pack2(o[6], o[7]);
    *(u32x4*)(ws_mix(p) + (size_t)gt * DM + c0) = w;
  }
}

DI void phase5b(const Params& p, int bid, int nb, char* lds) {
  const int t = tid_(), lane = t & 63, wid = t >> 6;
  float* ql = (float*)lds;
  float* pr = ql + 1024;
  float* ol = pr + 2048;
  int* sel = (int*)(ol + 1024);
  int* nselp = sel + 256;
  for (int gq = bid; gq < NTOK; gq += nb) {
    const int b = gq >> 11;
    const bf16_t* ckv = ws_ckv(p) + (size_t)b * SEQ * 128;
    __syncthreads();
    for (int idx = t; idx < 1024; idx += NTHR) ql[idx] = bf2f(ws_qlat(p)[(size_t)gq * 1024 + idx]);
    if (wid == 0) {
      const int nadm = (((gq & (SEQ - 1)) >> 6) + 1) * 64;
      const unsigned word = (lane * 32 < nadm) ? ws_mask(p)[(size_t)gq * 64 + lane] : 0u;
      const int cnt = __popc(word);
      int incl = cnt;
      for (int o = 1; o < 64; o <<= 1) { const int u = __shfl_up(incl, o); if (lane >= o) incl += u; }
      int pos = incl - cnt;
      unsigned w = word;
      while (w) { const int bit = __ffs(w) - 1; w &= w - 1; if (pos < 256) sel[pos] = lane * 32 + bit; ++pos; }
      if (lane == 63) *nselp = incl < 256 ? incl : 256;
    }
    __syncthreads();
    const int nsel = *nselp;
    const int h = wid;
    float lg[4]; float mx = -1e30f;
#pragma unroll
    for (int q = 0; q < 4; ++q) {
      const int slot = lane + 64 * q;
      lg[q] = -1e30f;
      if (slot < nsel) {
        const bf16_t* kr = ckv + (size_t)sel[slot] * 128;
        float acc = 0.f;
#pragma unroll
        for (int d8 = 0; d8 < 16; ++d8) {
          float kf[8]; load8(kr + d8 * 8, kf);
          const f32x4 q0 = *(const f32x4*)(ql + h * 128 + d8 * 8), q1 = *(const f32x4*)(ql + h * 128 + d8 * 8 + 4);
          acc += q0[0] * kf[0] + q0[1] * kf[1] + q0[2] * kf[2] + q0[3] * kf[3] + q1[0] * kf[4] + q1[1] * kf[5] + q1[2] * kf[6] + q1[3] * kf[7];
        }
        lg[q] = acc;
      }
      mx = fmaxf(mx, lg[q]);
    }
    mx = wave_max(mx);
    float sm = 0.f;
#pragma unroll
    for (int q = 0; q < 4; ++q) { lg[q] = (lane + 64 * q < nsel) ? __expf(lg[q] - mx) : 0.f; sm += lg[q]; }
    sm = wave_sum(sm);
    const float inv = 1.0f / sm;
#pragma unroll
    for (int q = 0; q < 4; ++q) pr[h * 256 + lane + 64 * q] = lg[q] * inv;
    __syncthreads();
    {
      float o0 = 0.f, o1 = 0.f;
      for (int slot = 0; slot < nsel; ++slot) {
        const unsigned kv2 = *(const unsigned*)(ckv + (size_t)sel[slot] * 128 + lane * 2);
        const float pp = pr[h * 256 + slot];
        o0 += pp * __uint_as_float(kv2 << 16); o1 += pp * __uint_as_float(kv2 & 0xffff0000u);
      }
      ol[h * 128 + lane * 2] = o0; ol[h * 128 + lane * 2 + 1] = o1;
    }
    __syncthreads();
    {
      float acc = 0.f;
      for (int cc = 0; cc < 128; ++cc) acc += ol[h * 128 + cc] * p.w_uv[(size_t)(cc * NH + h) * HD + lane];
      ws_mix(p)[(size_t)gq * DM + RW + h * HD + lane] = f2bf(acc);
    }
  }
}

typedef short s16x4 __attribute__((ext_vector_type(4)));
#define KSWZ(row, colB) ((row) * 256 + ((colB) ^ (((row) & 7) << 4)))
DI int v_st(int k, int c) { const int kk = (k & ~0xC) | ((k & 4) << 1) | ((k & 8) >> 1); return ((kk >> 3) * 4 + (c >> 5)) * 512 + ((kk & 7) * 32 + (c & 31)) * 2; }
DI int v_rd_base(int lane) { return ((lane & 3) << 3) | (((lane >> 2) & 3) << 6) | (((lane >> 4) & 1) << 5) | (((lane >> 5) & 1) << 8); }
constexpr int v_rd_off(int d0, int ks, int half) { return d0 * 512 + ks * 4096 + half * 2048; }
template <int OFF> DI s16x4 tr_read(int vb) { s16x4 r; asm volatile("ds_read_b64_tr_b16 %0, %1 offset:%2" : "=&v"(r) : "v"(vb), "i"(OFF) : "memory"); return r; }
template <int D0> DI void pv_one(f32x16& od, int vb, bf16x8 pa0, bf16x8 pa1, bf16x8 pa2, bf16x8 pa3) {
  const s16x4 l0 = tr_read<v_rd_off(D0, 0, 0)>(vb), h0 = tr_read<v_rd_off(D0, 0, 1)>(vb), l1 = tr_read<v_rd_off(D0, 1, 0)>(vb), h1 = tr_read<v_rd_off(D0, 1, 1)>(vb);
  const s16x4 l2 = tr_read<v_rd_off(D0, 2, 0)>(vb), h2 = tr_read<v_rd_off(D0, 2, 1)>(vb), l3 = tr_read<v_rd_off(D0, 3, 0)>(vb), h3 = tr_read<v_rd_off(D0, 3, 1)>(vb);
  asm volatile("s_waitcnt lgkmcnt(0)" ::: "memory"); __builtin_amdgcn_sched_barrier(0);
#define PKV(L, H) (bf16x8){L[0], L[1], L[2], L[3], H[0], H[1], H[2], H[3]}
  od = __builtin_amdgcn_mfma_f32_32x32x16_bf16(pa0, PKV(l0, h0), od, 0, 0, 0);
  od = __builtin_amdgcn_mfma_f32_32x32x16_bf16(pa1, PKV(l1, h1), od, 0, 0, 0);
  od = __builtin_amdgcn_mfma_f32_32x32x16_bf16(pa2, PKV(l2, h2), od, 0, 0, 0);
  od = __builtin_amdgcn_mfma_f32_32x32x16_bf16(pa3, PKV(l3, h3), od, 0, 0, 0);
#undef PKV
}
constexpr int ATT_TILE = 64 * 128 * 2;
constexpr int ATT_LDS = 4 * ATT_TILE + 8 * 64 * 4;
template <int BIT> DI float at_mask(float e, unsigned w) {
  int m; asm("v_bfe_i32 %0, %1, %2, 1" : "=v"(m) : "v"(w), "n"(BIT)); return __uint_as_float(__float_as_uint(e) & (unsigned)m); }
DI void phase5b_mfma(const Params& p, int bid, int nb, char* lds) {
  char* V_lds = lds; char* K_lds = lds + 2 * ATT_TILE;
  constexpr float LOG2E = 1.4426950408889634f, THR = 8.0f;
  for (int task = bid; task < NTOK / 32; task += nb) {
    const int t = tid_();
    const int lane = t & 63, wid = t >> 6, r32 = lane & 31, hi = lane >> 5, h = wid;
    float* al_l = (float*)(lds + 4 * ATT_TILE) + wid * 64; float* li_l = al_l + 32;
    const int sr = t >> 4, sc = (t & 15) * 8;
    const int vst0 = v_st(sr, sc), kst0 = KSWZ(sr, sc * 2);
    const int vb0 = (int)(uintptr_t)V_lds + v_rd_base(lane);
    int kq0 = KSWZ(r32, hi * 16), kq1 = KSWZ(r32, 32 + hi * 16), kq2 = KSWZ(r32, 64 + hi * 16), kq3 = KSWZ(r32, 96 + hi * 16);
    const int b = (task & 255) >> 4;
    int qt; { const int j = task & 15, k = task >> 8; qt = (k == 0) ? j : (k == 1) ? 31 - j : (k == 2) ? 32 + j : 63 - j; }
    const int q0 = qt * 32, n = ((q0 >> 6) + 1) * 64, NT = n >> 6;
    const int gq = b * SEQ + q0 + r32;
    const bf16_t* ckv = ws_ckv(p) + (size_t)b * SEQ * 128;
    const unsigned mro = (unsigned)gq * 256u;
#define mrow(i_) (*(const unsigned*)((const char*)ws_mask(p) + mro + 4u * (unsigned)(i_)))
    bf16x8 qr[8];
    {
      f32x16 qa[4];
#pragma unroll
      for (int mt = 0; mt < 4; ++mt)
#pragma unroll
        for (int r = 0; r < 16; ++r) qa[mt][r] = 0.f;
      const bf16_t* wuk = ws_wukt(p) + (size_t)h * 8192 + lane * 8;
      bf16x8 bqv[4], awv[4][4];
#pragma unroll
      for (int ks = 0; ks < 4; ++ks) {
        bqv[ks] = *(const bf16x8*)(ws_proj(p) + (size_t)gq * PROJ_LD + C_Q + h * HD + ks * 16 + hi * 8);
#pragma unroll
        for (int mt = 0; mt < 4; ++mt) awv[mt][ks] = *(const bf16x8*)(wuk + (mt * 4 + ks) * 512);
      }
      __builtin_amdgcn_sched_barrier(0);
#pragma unroll
      for (int ks = 0; ks < 4; ++ks)
#pragma unroll
        for (int mt = 0; mt < 4; ++mt) qa[mt] = __builtin_amdgcn_mfma_f32_32x32x16_bf16(awv[mt][ks], bqv[ks], qa[mt], 0, 0, 0);
#define QPK(P, BASE, OUT) do { unsigned a0 = cvtpk(P[BASE + 0] * 0.125f, P[BASE + 1] * 0.125f), a1 = cvtpk(P[BASE + 2] * 0.125f, P[BASE + 3] * 0.125f);   \
    unsigned b0 = cvtpk(P[BASE + 4] * 0.125f, P[BASE + 5] * 0.125f), b1 = cvtpk(P[BASE + 6] * 0.125f, P[BASE + 7] * 0.125f);                              \
    auto r0 = __builtin_amdgcn_permlane32_swap(a0, b0, false, false); auto r1 = __builtin_amdgcn_permlane32_swap(a1, b1, false, false); \
    u32x4 w = {r0[0], r1[0], r0[1], r1[1]}; OUT = *reinterpret_cast<bf16x8*>(&w); } while (0)
#pragma unroll
      for (int mt = 0; mt < 4; ++mt) { QPK(qa[mt], 0, qr[2 * mt]); QPK(qa[mt], 8, qr[2 * mt + 1]); }
#undef QPK
    }
    float m_reg = -1e30f, l_reg = 0.f;
    f32x16 o[4];
#pragma unroll
    for (int d = 0; d < 4; ++d)
#pragma unroll
      for (int r = 0; r < 16; ++r) o[d][r] = 0.f;
    const f32x16 at_z16 = {0.f, 0.f, 0.f, 0.f, 0.f, 0.f, 0.f, 0.f, 0.f, 0.f, 0.f, 0.f, 0.f, 0.f, 0.f, 0.f};
#define AT_SBAR() __builtin_amdgcn_sched_barrier(0)
#define AT_LOAD(S0, S1, tj) do { const unsigned go_ = (unsigned)(((tj) * 64 + sr) * 128 + sc) * 2u; S0 = *(const u32x4*)((const char*)ckv + go_); S1 = *(const u32x4*)((const char*)ckv + go_ + 32 * 128 * 2); } while (0)
#define AT_WRITE(b, S0, S1) do { char* Vn = V_lds + (b) * ATT_TILE; char* Kn = K_lds + (b) * ATT_TILE; \
      *(u32x4*)(Vn + vst0) = S0; *(u32x4*)(Vn + vst0 + 8192) = S1; *(u32x4*)(Kn + kst0) = S0; *(u32x4*)(Kn + kst0 + 8192) = S1; } while (0)
#define AT_QKT(P0, P1, b) do { const char* Kb = K_lds + (b) * ATT_TILE; \
      _Pragma("unroll") for (int d0 = 0; d0 < 8; ++d0) { const int ko_ = ((d0 & 3) == 0 ? kq0 : (d0 & 3) == 1 ? kq1 : (d0 & 3) == 2 ? kq2 : kq3) + (d0 >> 2) * 128; \
        const bf16x8 b0 = *(const bf16x8*)(Kb + ko_), b1 = *(const bf16x8*)(Kb + ko_ + 8192); \
        if (d0 == 0) { P0 = __builtin_amdgcn_mfma_f32_32x32x16_bf16(b0, qr[0], at_z16, 0, 0, 0); P1 = __builtin_amdgcn_mfma_f32_32x32x16_bf16(b1, qr[0], at_z16, 0, 0, 0); }     \
        else { P0 = __builtin_amdgcn_mfma_f32_32x32x16_bf16(b0, qr[d0], P0, 0, 0, 0); P1 = __builtin_amdgcn_mfma_f32_32x32x16_bf16(b1, qr[d0], P1, 0, 0, 0); } } } while (0)
#define AT_PARTIAL(P0, P1, AL) do { float pmax = P0[0]; \
      _Pragma("unroll") for (int r = 1; r < 16; ++r) pmax = fmaxf(pmax, P0[r]); \
      _Pragma("unroll") for (int r = 0; r < 16; ++r) pmax = fmaxf(pmax, P1[r]); \
      { auto rr = __builtin_amdgcn_permlane32_swap(__float_as_uint(pmax), __float_as_uint(pmax), false, false); pmax = fmaxf(__uint_as_float(rr[0]), __uint_as_float(rr[1])); } \
      float mn_; if (__all(pmax - m_reg <= THR)) { mn_ = m_reg; AL = 1.f; } else { mn_ = fmaxf(m_reg, pmax); AL = __builtin_amdgcn_exp2f((m_reg - mn_) * LOG2E); m_reg = mn_; l_reg *= AL; } \
      const float mnC = -mn_ * LOG2E; \
      _Pragma("unroll") for (int r = 0; r < 16; ++r) { P0[r] = fmaf(P0[r], LOG2E, mnC); P1[r] = fmaf(P1[r], LOG2E, mnC); } \
      _Pragma("unroll") for (int r = 0; r < 16; ++r) P0[r] = __builtin_amdgcn_exp2f(P0[r]); } while (0)
#define AT_MK1(P, W, r_, b_) P[r_] = at_mask<b_>(P[r_], W);
#define AT_FINISH(P0, P1, W0, W1) do { \
      _Pragma("unroll") for (int r = 0; r < 16; ++r) P1[r] = __builtin_amdgcn_exp2f(P1[r]); \
      float ps = 0.f; \
      AT_MK1(P0, W0, 0, 0) AT_MK1(P1, W1, 0, 0) AT_MK1(P0, W0, 1, 1) AT_MK1(P1, W1, 1, 1) AT_MK1(P0, W0, 2, 2) AT_MK1(P1, W1, 2, 2) AT_MK1(P0, W0, 3, 3) AT_MK1(P1, W1, 3, 3) AT_MK1(P0, W0, 4, 8) AT_MK1(P1, W1, 4, 8) AT_MK1(P0, W0, 5, 9) AT_MK1(P1, W1, 5, 9) AT_MK1(P0, W0, 6, 10) AT_MK1(P1, W1, 6, 10) AT_MK1(P0, W0, 7, 11) AT_MK1(P1, W1, 7, 11) AT_MK1(P0, W0, 8, 16) AT_MK1(P1, W1, 8, 16) AT_MK1(P0, W0, 9, 17) AT_MK1(P1, W1, 9, 17) AT_MK1(P0, W0, 10, 18) AT_MK1(P1, W1, 10, 18) AT_MK1(P0, W0, 11, 19) AT_MK1(P1, W1, 11, 19) AT_MK1(P0, W0, 12, 24) AT_MK1(P1, W1, 12, 24) AT_MK1(P0, W0, 13, 25) AT_MK1(P1, W1, 13, 25) AT_MK1(P0, W0, 14, 26) AT_MK1(P1, W1, 14, 26) AT_MK1(P0, W0, 15, 27) AT_MK1(P1, W1, 15, 27) \
      _Pragma("unroll") for (int r = 0; r < 16; ++r) ps += P0[r] + P1[r]; \
      { auto rr = __builtin_amdgcn_permlane32_swap(__float_as_uint(ps), __float_as_uint(ps), false, false); ps = __uint_as_float(rr[0]) + __uint_as_float(rr[1]); } \
      l_reg += ps; } while (0)
#define AT_PACK(P0, P1) do { AT_PK4(P0, 0, pa0); AT_PK4(P0, 8, pa1); AT_PK4(P1, 0, pa2); AT_PK4(P1, 8, pa3); } while (0)
#define AT_PK4(P, BASE, OUT) do { unsigned a0 = cvtpk(P[BASE + 0], P[BASE + 1]), a1 = cvtpk(P[BASE + 2], P[BASE + 3]);   \
    unsigned b0 = cvtpk(P[BASE + 4], P[BASE + 5]), b1 = cvtpk(P[BASE + 6], P[BASE + 7]);                              \
    auto r0 = __builtin_amdgcn_permlane32_swap(a0, b0, false, false); auto r1 = __builtin_amdgcn_permlane32_swap(a1, b1, false, false); \
    u32x4 w = {r0[0], r1[0], r0[1], r1[1]}; OUT = *reinterpret_cast<bf16x8*>(&w); } while (0)
#define AT_RESC(AL) do { if (__any((AL) < 1.f)) { if (hi == 0) al_l[r32] = (AL); asm volatile("s_waitcnt lgkmcnt(0)" ::: "memory"); \
      _Pragma("unroll") for (int d = 0; d < 4; ++d) _Pragma("unroll") for (int r = 0; r < 16; ++r) o[d][r] *= al_l[crow(r, hi)]; } } while (0)
#define AT_PV(b) do { const int vb = vb0 + (b) * ATT_TILE; pv_one<0>(o[0], vb, pa0, pa1, pa2, pa3); pv_one<1>(o[1], vb, pa0, pa1, pa2, pa3); pv_one<2>(o[2], vb, pa0, pa1, pa2, pa3); pv_one<3>(o[3], vb, pa0, pa1, pa2, pa3); } while (0)
#define AT_STEP(C0, C1, Q0, Q1, SN0, SN1, bC) do { float alc_; \
      AT_SBAR(); const unsigned WQ0 = mrow(2 * j - 2) >> (4 * hi), WQ1 = mrow(2 * j - 1) >> (4 * hi); AT_QKT(C0, C1, bC); \
      AT_FINISH(Q0, Q1, WQ0, WQ1); AT_SBAR(); \
      if (j + 1 < NT) AT_LOAD(SN0, SN1, j + 1); AT_PACK(Q0, Q1); AT_SBAR(); \
      AT_PV((bC) ^ 1); AT_PARTIAL(C0, C1, alc_); \
      __syncthreads(); \
      if (j + 1 < NT) AT_WRITE((bC) ^ 1, SN0, SN1); \
      AT_RESC(alc_); __syncthreads(); } while (0)
    f32x16 pA0, pA1, pB0, pB1; bf16x8 pa0, pa1, pa2, pa3;
    u32x4 sE0, sE1;
    AT_LOAD(sE0, sE1, 0);
    __syncthreads();
    AT_WRITE(0, sE0, sE1);
    if (NT > 1) AT_LOAD(sE0, sE1, 1);
    __syncthreads();
    { float al0_; AT_QKT(pA0, pA1, 0); AT_PARTIAL(pA0, pA1, al0_); (void)al0_; }
    if (NT > 1) AT_WRITE(1, sE0, sE1);
    __syncthreads();
    int j = 1;
    for (; j + 1 < NT; j += 2) {
      AT_STEP(pB0, pB1, pA0, pA1, sE0, sE1, 1);
      { const int j_ = j; j = j_ + 1; AT_STEP(pA0, pA1, pB0, pB1, sE0, sE1, 0); j = j_; }
    }
    if (j < NT) {
      AT_STEP(pB0, pB1, pA0, pA1, sE0, sE1, 1);
      { const unsigned wl0 = mrow(2 * NT - 2) >> (4 * hi), wl1 = mrow(2 * NT - 1) >> (4 * hi); AT_FINISH(pB0, pB1, wl0, wl1); } AT_PACK(pB0, pB1); AT_SBAR(); AT_PV(1);
    } else { const unsigned wl0 = mrow(2 * NT - 2) >> (4 * hi), wl1 = mrow(2 * NT - 1) >> (4 * hi); AT_FINISH(pA0, pA1, wl0, wl1); AT_PACK(pA0, pA1); AT_SBAR(); AT_PV(0); }
    __syncthreads();
#undef AT_SBAR
#undef AT_LOAD
#undef AT_WRITE
#undef AT_QKT
#undef AT_PARTIAL
#undef AT_FINISH
#undef AT_MK1
#undef AT_PACK
#undef AT_PK4
#undef AT_RESC
#undef AT_PV
#undef AT_STEP
#undef mrow
    if (hi == 0) li_l[r32] = l_reg;
    asm volatile("s_waitcnt lgkmcnt(0)" ::: "memory");
    int hio = hi, r32o = r32, ho = h;
    asm volatile("" : "+v"(hio), "+v"(r32o), "+v"(ho));
    char* Ow = lds + wid * 8192;
#pragma unroll
    for (int r = 0; r < 16; ++r) {
      const int row = crow(r, hio); const float rl = __builtin_amdgcn_rcpf(li_l[row]);
#pragma unroll
      for (int d = 0; d < 4; ++d) *(bf16_t*)(Ow + KSWZ(row, (d * 32 + r32o) * 2)) = f2bf(o[d][r] * rl);
    }
    asm volatile("s_waitcnt lgkmcnt(0)" ::: "memory");
    f32x16 oa[2];
#pragma unroll
    for (int i = 0; i < 2; ++i)
#pragma unroll
      for (int r = 0; r < 16; ++r) oa[i][r] = 0.f;
    const bf16_t* wuv = ws_wuvt(p) + (size_t)ho * 8192 + (hio * 32 + r32o) * 8;
    bf16x8 bwv[8][2];
#pragma unroll
    for (int ks = 0; ks < 8; ++ks)
#pragma unroll
      for (int i = 0; i < 2; ++i) bwv[ks][i] = *(const bf16x8*)(wuv + (i * 8 + ks) * 512);
    __builtin_amdgcn_sched_barrier(0);
#pragma unroll
    for (int ks = 0; ks < 8; ++ks) {
      const bf16x8 a = *(const bf16x8*)(Ow + KSWZ(r32o, (ks * 16 + hio * 8) * 2));
#pragma unroll
      for (int i = 0; i < 2; ++i) {
        const bf16x8 bw = bwv[ks][i];
        oa[i] = __builtin_amdgcn_mfma_f32_32x32x16_bf16(a, bw, oa[i], 0, 0, 0);
      }
    }
    asm volatile("s_waitcnt lgkmcnt(0)" ::: "memory");
#pragma unroll
    for (int i = 0; i < 2; ++i)
#pragma unroll
      for (int r = 0; r < 16; ++r) *(bf16_t*)(Ow + ((r & 3) + 8 * (r >> 2) + 4 * hio) * 144 + (i * 32 + r32o) * 2) = f2bf(oa[i][r]);
    asm volatile("s_waitcnt lgkmcnt(0)" ::: "memory");
    {
      const int lo = hio * 32 + r32o;
      bf16_t* mx = ws_mix(p) + (size_t)(b * SEQ + q0) * DM + RW + h * HD;
#pragma unroll
      for (int k = 0; k < 4; ++k) { const int row = k * 8 + (lo >> 3), sg = lo & 7; *(u32x4*)(mx + (size_t)row * DM + sg * 8) = *(const u32x4*)(Ow + row * 144 + sg * 16); }
    }
  }
}

struct EpiOut { const float* x; const float* mod; float* o; int row0, col0; DI void operator()(int r, int c, float v0, float v1) const {
  const int row = row0 + r, col = col0 + c, b = row >> 11; const size_t idx = (size_t)row * DM + col;
  o[idx] = x[idx] + (1.0f + mod[b * 6144 + 2048 + col]) * v0; o[idx + 32] = x[idx + 32] + (1.0f + mod[b * 6144 + 2048 + col + 32]) * v1; } };
DI void phase6(const Params& p, int bid, int nb, char* lds) {
  constexpr int NT = DM / GBN;
  for (int tile = bid; tile < (NTOK / GBM) * NT; tile += nb) {
    const int mt = tile / NT, nt = tile % NT;
    gemm_tile(ws_mix(p), DM, ARowBase{mt * GBM}, ws_wtout(p), DM, nt * GBN, DM, EpiOut{p.x, ws_mod(p), p.out, mt * GBM, nt * GBN}, lds);
  }
}

namespace pg8 {
#define PG8_LAS __attribute__((address_space(3)))
constexpr int BM = 256, BK = 64, HALF = 128, HTB = HALF * BK * 2  , STAGE_BYTES = 8 * HTB, NXCD = 8, WGM = 8;

__host__ __device__ __forceinline__ int lds_byte(int r, int c) { const int st = (r >> 4) * 2 + (c >> 5), rr = r & 15, cc = c & 31, ob = rr * 64 + cc * 2; return st * 1024 + (ob ^ (((ob >> 9) & 1) << 5)); }
__host__ __device__ __forceinline__ void stage_rc(int b, int& R, int& C) { const int st = b / 1024, sb = b % 1024, swz = sb ^ (((sb >> 9) & 1) << 5); R = (st >> 1) * 16 + swz / 64; C = (st & 1) * 32 + (swz % 64) / 2; }
__host__ __device__ __forceinline__ int perm32(int rho) { const int n = rho >> 4, i = rho & 15; return 8 * (i >> 2) + 4 * n + (i & 3); }

struct Unit { int pm, pn, e, rows; };
struct Gemm { const bf16_t* A; const bf16_t* Bt; int M, N, K; size_t bstride; };

struct StaticOrder {
    static constexpr bool GATHER = false, PARTIAL = false;
    int nM, nN, nwg, G, c;
    __host__ __device__ void init(int M, int N, int G_, int c_) { nM = M / BM; nN = N / BM; nwg = nM * nN; G = G_; c = c_; }
    __host__ __device__ bool next(int i, Unit& u) const {
        const long L = (long)i * G + c; if (L >= nwg) return false;
        int wgid = (int)L; { const int q = nwg / NXCD, r = nwg % NXCD, xcd = wgid % NXCD, off = wgid / NXCD; wgid = (xcd < r ? xcd * (q + 1) : r * (q + 1) + (xcd - r) * q) + off; }
        const int nig = WGM * nN, gid = wgid / nig, fm = gid * WGM, gsz = (nM - fm) < WGM ? (nM - fm) : WGM;
        u.pm = fm + ((wgid % nig) % gsz); u.pn = (wgid % nig) / gsz; u.e = 0; u.rows = BM; return true;
    }
    __device__ __forceinline__ void a_ready(const Unit&) const {}
    __device__ __forceinline__ void done(const Unit&) const {}
    __device__ __forceinline__ int arow(const Unit&, int) const { return 0; }
};
template <class Epi, class Sched, bool ALIGN_EPI = false, bool SP2 = false>
__device__ __forceinline__ void gemm_phase(PG8_LAS unsigned char* lds, const Gemm g, const Sched& S, const Epi& E) {
    const int tid = tid_(), wid = __builtin_amdgcn_readfirstlane(tid >> 6), lane = tid & 63, wr = wid >> 2, wc = wid & 3, fr = lane & 15, fq = lane >> 4;
    const int K = g.K, nt = K / BK;
    unsigned voffA[2], voffB[2];
#pragma unroll
    for (int i = 0; i < 2; ++i) { int R, C; stage_rc(tid * 16 + i * 8192, R, C); const int Rb = Epi::PERM ? ((R & ~31) + perm32(R & 31)) : R;
        voffA[i] = (unsigned)(R * K + C) * 2u; voffB[i] = (unsigned)(Rb * K + C) * 2u; }
    unsigned vAc[2][2], vAn[2][2];
    const size_t kstep = (size_t)(BK * 2);
    const size_t hstep = (size_t)HALF * K * 2;
    const size_t tstep = 2 * hstep;
    const unsigned ldsw = (unsigned)wid * 1024u;
    const int aoff = lds_byte(wr * 64 + fr, fq * 8), boff = lds_byte(wc * 32 + fr, fq * 8);
#define PG8_SA(b, h) (((b) * 2 + (h)) * HTB)
#define PG8_SB(b, h) ((4 + (b) * 2 + (h)) * HTB)
#define PG8_STAGE(bufoff, gbase, voff) do { _Pragma("unroll") for (int _i = 0; _i < 2; ++_i) \
        __builtin_amdgcn_global_load_lds((const unsigned*)((const char*)(gbase) + (voff)[_i]), (PG8_LAS unsigned*)(lds + (bufoff) + ldsw + _i * 8192), 16, 0, 0); } while (0)
#define PG8_STAGE_A(bufoff, gbase, v0_, v1_) do { \
        __builtin_amdgcn_global_load_lds((const unsigned*)((const char*)(gbase) + (v0_)), (PG8_LAS unsigned*)(lds + (bufoff) + ldsw), 16, 0, 0); \
        __builtin_amdgcn_global_load_lds((const unsigned*)((const char*)(gbase) + (v1_)), (PG8_LAS unsigned*)(lds + (bufoff) + ldsw + 8192), 16, 0, 0); } while (0)
#define PG8_AOFF(u_, dst_) do { if constexpr (Sched::GATHER) { _Pragma("unroll") for (int h_ = 0; h_ < 2; ++h_) _Pragma("unroll") for (int i_ = 0; i_ < 2; ++i_) { int R_, C_; stage_rc(tid * 16 + i_ * 8192, R_, C_); \
            dst_[h_][i_] = (unsigned)(S.arow(u_, h_ * HALF + R_) * K + C_) * 2u; } asm volatile("s_waitcnt vmcnt(0)" ::: "memory"); } \
        else { _Pragma("unroll") for (int h_ = 0; h_ < 2; ++h_) _Pragma("unroll") for (int i_ = 0; i_ < 2; ++i_) dst_[h_][i_] = voffA[i_] + (unsigned)(h_ * hstep); } } while (0)
#define PG8_LDA(dst, b, h) do { _Pragma("unroll") for (int m = 0; m < 4; ++m) _Pragma("unroll") for (int k = 0; k < 2; ++k) dst[m][k] = *(const PG8_LAS bf16x8*)(lds + PG8_SA(b, h) + aoff + m * 2048 + k * 1024); } while (0)
#define PG8_LDB(dst, b, h) do { _Pragma("unroll") for (int n = 0; n < 2; ++n) _Pragma("unroll") for (int k = 0; k < 2; ++k) dst[n][k] = *(const PG8_LAS bf16x8*)(lds + PG8_SB(b, h) + boff + n * 2048 + k * 1024); } while (0)
#define PG8_MMA(ai, bj, At, Bt) do { if (!Sched::PARTIAL || ((ai) ? mma1 : mma0)) { __builtin_amdgcn_s_setprio(1); _Pragma("unroll") for (int m = 0; m < 4; ++m) _Pragma("unroll") for (int n = 0; n < 2; ++n) _Pragma("unroll") for (int k = 0; k < 2; ++k) \
        acc[ai][bj][m][n] = __builtin_amdgcn_mfma_f32_16x16x32_bf16(Bt[n][k], At[m][k], acc[ai][bj][m][n], 0, 0, 0); __builtin_amdgcn_s_setprio(0); } } while (0)
#define PG8_WAIT_V(n) asm volatile("s_waitcnt vmcnt(" #n ")" ::: "memory")
#define PG8_WAIT_L(n) asm volatile("s_waitcnt lgkmcnt(" #n ")" ::: "memory")
#define PG8_BAR __builtin_amdgcn_s_barrier()
#define PG8_SCHED __builtin_amdgcn_sched_barrier(0)
    Unit cur, nxt; int ui = 0;
    if (!S.next(0, cur)) return;
    bool mma0 = true, mma1 = true;
    if constexpr (Sched::PARTIAL) { const int rv = __builtin_amdgcn_readfirstlane(cur.rows); mma0 = wr * 64 < rv; mma1 = 128 + wr * 64 < rv; }
    f32x4 acc[2][2][4][2];
#pragma unroll
    for (int a = 0; a < 2; ++a)
#pragma unroll
        for (int b = 0; b < 2; ++b)
#pragma unroll
            for (int m = 0; m < 4; ++m)
#pragma unroll
                for (int n = 0; n < 2; ++n) acc[a][b][m][n] = (f32x4){0.f, 0.f, 0.f, 0.f};
    bf16x8 At[4][2], B0[2][2], B1[2][2];
    const char* cA = Sched::GATHER ? (const char*)g.A : (const char*)g.A + (size_t)cur.pm * tstep; PG8_AOFF(cur, vAc); const char* cB = (const char*)g.Bt + (size_t)cur.e * g.bstride + (size_t)cur.pn * tstep;
    S.a_ready(cur);
    if constexpr (SP2) {
        PG8_STAGE(PG8_SB(0, 0), cB, voffB); PG8_STAGE(PG8_SB(0, 1), cB + hstep, voffB); PG8_STAGE_A(PG8_SA(0, 0), cA, vAc[0][0], vAc[0][1]); PG8_STAGE_A(PG8_SA(0, 1), cA, vAc[1][0], vAc[1][1]);
        if (wr == 1) PG8_BAR;
        PG8_WAIT_V(2); PG8_BAR;
        PG8_STAGE(PG8_SB(1, 0), cB + kstep, voffB); PG8_STAGE_A(PG8_SA(1, 0), cA + kstep, vAc[0][0], vAc[0][1]); PG8_STAGE(PG8_SB(1, 1), cB + hstep + kstep, voffB);
        PG8_WAIT_V(6); PG8_BAR;
    } else {
        PG8_STAGE(PG8_SB(0, 0), cB, voffB); PG8_STAGE(PG8_SA(0, 0), cA, voffA); PG8_STAGE(PG8_SB(0, 1), cB + hstep, voffB); PG8_STAGE(PG8_SA(0, 1), cA + hstep, voffA);
        if (wr == 1) PG8_BAR;
        PG8_WAIT_V(4); PG8_BAR;
        PG8_STAGE(PG8_SB(1, 0), cB + kstep, voffB); PG8_STAGE(PG8_SA(1, 0), cA + kstep, voffA); PG8_STAGE(PG8_SB(1, 1), cB + hstep + kstep, voffB);
        PG8_WAIT_V(6); PG8_BAR;
    }
    for (;;) {
        const bool has_next = S.next(ui + 1, nxt);
        const char* nA = (has_next && !Sched::GATHER) ? (const char*)g.A + (size_t)nxt.pm * tstep : cA;
        if (has_next) PG8_AOFF(nxt, vAn); else { _Pragma("unroll") for (int h_ = 0; h_ < 2; ++h_) _Pragma("unroll") for (int i_ = 0; i_ < 2; ++i_) vAn[h_][i_] = vAc[h_][i_]; }
        const char* nB = has_next ? (const char*)g.Bt + (size_t)nxt.e * g.bstride + (size_t)nxt.pn * tstep : cB;
        for (int t = 0; t < nt; t += 2) {
            const bool last = (t == nt - 2);
            const char* a1 = cA + (size_t)(t + 1) * kstep;
            const char* a2 = last ? nA : cA + (size_t)(t + 2) * kstep; const char* b2 = last ? nB : cB + (size_t)(t + 2) * kstep;
            const char* a3 = a2 + kstep; const char* b3 = b2 + kstep;
            if (last && has_next) S.a_ready(nxt);
            if constexpr (SP2) {
            PG8_LDB(B0, 0, 0); PG8_LDB(B1, 0, 1); PG8_SCHED; PG8_LDA(At, 0, 0); PG8_STAGE_A(PG8_SA(1, 1), a1, vAc[1][0], vAc[1][1]);
            PG8_WAIT_V(8); PG8_WAIT_L(0); PG8_BAR; PG8_MMA(0, 0, At, B0); PG8_MMA(0, 1, At, B1); PG8_BAR; PG8_SCHED;
            PG8_LDA(At, 0, 1); PG8_STAGE(PG8_SB(0, 0), b2, voffB); PG8_STAGE(PG8_SB(0, 1), b2 + hstep, voffB); PG8_STAGE_A(PG8_SA(0, 0), a2, last ? vAn[0][0] : vAc[0][0], last ? vAn[0][1] : vAc[0][1]);
            PG8_WAIT_V(8); PG8_WAIT_L(0); PG8_BAR; PG8_MMA(1, 0, At, B0); PG8_MMA(1, 1, At, B1); PG8_BAR; PG8_SCHED;
            PG8_LDB(B0, 1, 0); PG8_LDB(B1, 1, 1); PG8_SCHED; PG8_LDA(At, 1, 0); PG8_STAGE_A(PG8_SA(0, 1), a2, last ? vAn[1][0] : vAc[1][0], last ? vAn[1][1] : vAc[1][1]);
            PG8_WAIT_V(8); PG8_WAIT_L(0); PG8_BAR; PG8_MMA(0, 0, At, B0); PG8_MMA(0, 1, At, B1); PG8_BAR; PG8_SCHED;
            PG8_LDA(At, 1, 1); PG8_STAGE(PG8_SB(1, 0), b3, voffB); PG8_STAGE(PG8_SB(1, 1), b3 + hstep, voffB); PG8_STAGE_A(PG8_SA(1, 0), a3, last ? vAn[0][0] : vAc[0][0], last ? vAn[0][1] : vAc[0][1]);
            PG8_WAIT_V(8); PG8_WAIT_L(0); PG8_BAR; PG8_MMA(1, 0, At, B0); PG8_MMA(1, 1, At, B1); PG8_BAR; PG8_SCHED;
            } else {
            PG8_LDB(B0, 0, 0); PG8_SCHED; PG8_LDA(At, 0, 0); PG8_STAGE(PG8_SA(1, 1), a1 + hstep, voffA);
            PG8_WAIT_L(8); PG8_BAR; PG8_WAIT_L(0); PG8_MMA(0, 0, At, B0); PG8_BAR; PG8_SCHED;
            PG8_LDB(B1, 0, 1); PG8_STAGE(PG8_SB(0, 0), b2, voffB);
            PG8_BAR; PG8_WAIT_L(0); PG8_MMA(0, 1, At, B1); PG8_BAR;
            PG8_LDA(At, 0, 1); PG8_STAGE(PG8_SA(0, 0), a2, voffA);
            PG8_BAR; PG8_WAIT_L(0); PG8_MMA(1, 0, At, B0); PG8_BAR; PG8_SCHED;
            PG8_STAGE(PG8_SB(0, 1), b2 + hstep, voffB);
            PG8_WAIT_V(6); PG8_BAR; PG8_MMA(1, 1, At, B1); PG8_BAR;
            PG8_LDB(B0, 1, 0); PG8_SCHED; PG8_LDA(At, 1, 0); PG8_STAGE(PG8_SA(0, 1), a2 + hstep, voffA);
            PG8_WAIT_L(8); PG8_BAR; PG8_WAIT_L(0); PG8_MMA(0, 0, At, B0); PG8_BAR; PG8_SCHED;
            PG8_LDB(B1, 1, 1); PG8_STAGE(PG8_SB(1, 0), b3, voffB);
            PG8_BAR; PG8_WAIT_L(0); PG8_MMA(0, 1, At, B1); PG8_BAR;
            PG8_LDA(At, 1, 1); PG8_STAGE(PG8_SA(1, 0), a3, voffA);
            PG8_BAR; PG8_WAIT_L(0); PG8_MMA(1, 0, At, B0); PG8_BAR; PG8_SCHED;
            PG8_STAGE(PG8_SB(1, 1), b3 + hstep, voffB);
            PG8_WAIT_V(6); PG8_BAR; PG8_MMA(1, 1, At, B1); PG8_BAR;
            }
        }
        if constexpr (ALIGN_EPI) { if (wr == 0) PG8_BAR; }
        if constexpr (!Epi::AFTER_DRAIN) { E(acc, cur, wr, wc, fr, fq); S.done(cur); }
        if (!has_next) break;
#pragma unroll
        for (int a = 0; a < 2; ++a)
#pragma unroll
            for (int b = 0; b < 2; ++b)
#pragma unroll
                for (int m = 0; m < 4; ++m)
#pragma unroll
                    for (int n = 0; n < 2; ++n) acc[a][b][m][n] = (f32x4){0.f, 0.f, 0.f, 0.f};
        cur = nxt; cA = nA; cB = nB; ++ui;
        if constexpr (Sched::PARTIAL) { const int rv = __builtin_amdgcn_readfirstlane(cur.rows); mma0 = wr * 64 < rv; mma1 = 128 + wr * 64 < rv; }
#pragma unroll
        for (int h_ = 0; h_ < 2; ++h_)
#pragma unroll
            for (int i_ = 0; i_ < 2; ++i_) vAc[h_][i_] = vAn[h_][i_];
        if constexpr (ALIGN_EPI) { if (wr == 1) PG8_BAR; }
    }
    PG8_WAIT_V(0);
    if constexpr (!ALIGN_EPI) { if (wr == 0) PG8_BAR; }
    PG8_BAR;
    if constexpr (Epi::AFTER_DRAIN) { E.fused(acc, cur, wr, wc, fr, fq, lds, wid, lane); S.done(cur); }
#undef PG8_SA
#undef PG8_SB
#undef PG8_STAGE
#undef PG8_STAGE_A
#undef PG8_AOFF
#undef PG8_LDA
#undef PG8_LDB
#undef PG8_MMA
#undef PG8_WAIT_V
#undef PG8_WAIT_L
#undef PG8_BAR
#undef PG8_SCHED
}
}


constexpr int TAB_OFF = 131072;
DI void build_tables(const Params& p, char* lds) {
  int* T = (int*)(lds + TAB_OFF); unsigned char* te = (unsigned char*)(T + 80);
  unsigned short* perm = (unsigned short*)(te + 288); unsigned short* rw = perm + 288;
  __syncthreads();
  const int t = tid_();
  if (t < 64) {
    const int e = t & 31;
    const int c = ws_cnt(p)[e], nt = (c + 255) >> 8, nf = c >> 8, rpart = c & 255;
    int s0 = nt, f0 = nf;
#pragma unroll
    for (int o = 1; o < 32; o <<= 1) { const int a_ = __shfl_up(s0, o, 32), b_ = __shfl_up(f0, o, 32); if (e >= o) { s0 += a_; f0 += b_; } }
    const int ntot = __shfl(s0, 31, 32), nftot = __shfl(f0, 31, 32);
    s0 -= nt; f0 -= nf;
    int rank = 0;
#pragma unroll 4
    for (int j = 0; j < 32; ++j) { const int rj = __shfl(rpart, j, 32); rank += (rj > rpart || (rj == rpart && j < e)) ? 1 : 0; }
    if (t < 32) {
      T[e] = c; T[32 + e] = s0; if (e == 0) T[64] = ntot;
      for (int k = 0; k < nt; ++k) te[s0 + k] = (unsigned char)e;
      for (int k = 0; k < nf; ++k) { perm[f0 + k] = (unsigned short)(s0 + k); rw[f0 + k] = 256; }
      if (rpart) { perm[nftot + rank] = (unsigned short)(s0 + nf); rw[nftot + rank] = (unsigned short)rpart; }
    }
  }
  __syncthreads();
}
template <bool GATHER_> struct GroupOrderT { static constexpr bool GATHER = GATHER_, PARTIAL = true; const int* T; const unsigned char* te; int G, c; const int* list;
  DI bool next(int i, pg8::Unit& u) const { const int L = i * G + c; if (L >= T[64] * 4) return false; const unsigned short* perm = (const unsigned short*)(te + 288);
    u.pm = perm[L >> 2]; u.rows = perm[288 + (L >> 2)]; u.pn = L & 3; u.e = te[u.pm]; return true; }
  DI void a_ready(const pg8::Unit&) const {}
  DI void done(const pg8::Unit&) const {}
  DI int arow(const pg8::Unit& u, int r) const {
    const int slot = (u.pm - T[32 + u.e]) * 256 + r, cnt = T[u.e]; return list[u.e * LCAP + (slot < cnt ? slot : cnt - 1)] >> 1; } };
typedef GroupOrderT<false> GroupOrder;

struct EpiProjP { static constexpr bool PERM = true, AFTER_DRAIN = false; bf16_t* O; int ldc;
  DI void operator()(const f32x4 (&acc)[2][2][4][2], const pg8::Unit& u, int wr, int wc, int fr, int fq) const {
    const int row0 = u.pm * 256 + wr * 64 + fr, col0 = u.pn * 256 + wc * 32 + 8 * fq;
#pragma unroll
    for (int ai = 0; ai < 2; ++ai)
#pragma unroll
      for (int m = 0; m < 4; ++m) { bf16_t* rowp = O + (size_t)(row0 + ai * 128 + m * 16) * ldc + col0;
#pragma unroll
        for (int bj = 0; bj < 2; ++bj) { const f32x4 v0 = acc[ai][bj][m][0] + 0.0f, v1 = acc[ai][bj][m][1] + 0.0f;
          u32x4 w; w.x = cvtpk(v0[0], v0[1]); w.y = cvtpk(v0[2], v0[3]); w.z = cvtpk(v1[0], v1[1]); w.w = cvtpk(v1[2], v1[3]);
          *(u32x4*)(rowp + bj * 128) = w; } }
  } };
DI void phase2_pg8(const Params& p, int bid, int nb, char* lds) {
  pg8::Gemm g{ws_h1(p), ws_wtin(p), NTOK, PROJ_LD, DM, 0};
  pg8::StaticOrder S; S.init(NTOK, PROJ_LD, nb, bid);
  EpiProjP E{ws_proj(p), PROJ_LD};
  __syncthreads();
  pg8::gemm_phase<EpiProjP, pg8::StaticOrder, true, true>((PG8_LAS unsigned char*)lds, g, S, E);
  __syncthreads();
}
struct EpiResidP { static constexpr bool PERM = false, AFTER_DRAIN = false; const float* x; const float* mod; bf16_t* o;
  DI void operator()(const f32x4 (&acc)[2][2][4][2], const pg8::Unit& u, int wr, int wc, int fr, int fq) const {
    const int row0 = u.pm * 256 + wr * 64 + fr, col0 = u.pn * 256 + wc * 32 + 4 * fq;
#pragma unroll
    for (int ai = 0; ai < 2; ++ai)
#pragma unroll
      for (int m = 0; m < 4; ++m) { const int row = row0 + ai * 128 + m * 16, b = row >> 11;
#pragma unroll
        for (int bj = 0; bj < 2; ++bj)
#pragma unroll
          for (int n = 0; n < 2; ++n) { const int col = col0 + bj * 128 + n * 16; const size_t idx = (size_t)row * DM + col;
            const f32x4 xv = *(const f32x4*)(x + idx), gv = *(const f32x4*)(mod + b * 6144 + 2048 + col);
            const f32x4 r = xv + (gv + 1.0f) * acc[ai][bj][m][n]; u32x2 w; w.x = cvtpk(r[0], r[1]); w.y = cvtpk(r[2], r[3]);
            *(u32x2*)(o + idx) = w; } }
  } };
DI void phase6_pg8(const Params& p, int bid, int nb, char* lds) {
  pg8::Gemm g{ws_mix(p), ws_wtout(p), NTOK, DM, DM, 0};
  pg8::StaticOrder S; S.init(NTOK, DM, nb, bid);
  EpiResidP E{p.x, ws_mod(p), ws_x1(p)};
  __syncthreads();
  pg8::gemm_phase<EpiResidP, pg8::StaticOrder, true, true>((PG8_LAS unsigned char*)lds, g, S, E);
  __syncthreads();
}
DI bf16_t* ws_h2s(const Params& p) { return (bf16_t*)(p.ws + OFF_C); }
DI bf16_t* ws_hidp(const Params& p) { return (bf16_t*)(p.ws + OFF_F); }
DI void phase7c(const Params& p, int bid, int nb, char* lds) {
  build_tables(p, lds);
  const int* T = (const int*)(lds + TAB_OFF);
  const int lane = tid_() & 63, gw = bid * 8 + (tid_() >> 6), nw = nb * 8;
  for (int e = 0; e < NEXP; ++e) {
    const int c = T[e]; const size_t r0 = (size_t)T[32 + e] * 256;
    for (int r = gw; r < c; r += nw) {
      const int tok = ws_list(p)[e * LCAP + r] >> 1;
      const u32x4* src = (const u32x4*)(ws_h2(p) + (size_t)tok * DM); u32x4* dst = (u32x4*)(ws_h2s(p) + (r0 + r) * DM);
      dst[lane] = src[lane]; dst[lane + 64] = src[lane + 64];
    }
  }
}
struct EpiSwiGLU { static constexpr bool PERM = true, AFTER_DRAIN = false; bf16_t* O;
  DI void operator()(const f32x4 (&acc)[2][2][4][2], const pg8::Unit& u, int wr, int wc, int fr, int fq) const {
    const int row0 = u.pm * 256 + wr * 64 + fr, col0 = u.pn * 128 + wc * 32 + 8 * fq;
#pragma unroll
    for (int ai = 0; ai < 2; ++ai)
#pragma unroll
      for (int m = 0; m < 4; ++m) {
        float hv[8];
#pragma unroll
        for (int n = 0; n < 2; ++n)
#pragma unroll
          for (int i = 0; i < 4; ++i) { const float gt = acc[ai][0][m][n][i], up = acc[ai][1][m][n][i]; hv[n * 4 + i] = gt * __builtin_amdgcn_rcpf(1.0f + __expf(-gt)) * up; }
        u32x4 w; w.x = cvtpk(hv[0], hv[1]); w.y = cvtpk(hv[2], hv[3]); w.z = cvtpk(hv[4], hv[5]); w.w = cvtpk(hv[6], hv[7]);
        *(u32x4*)(O + (size_t)(row0 + ai * 128 + m * 16) * DEXP + col0) = w; }
  } };
DI void phase8_pg8(const Params& p, int bid, int nb, char* lds) {
  build_tables(p, lds);
  pg8::Gemm g{ws_h2(p), ws_wgu(p), 0, 1024, DM, (size_t)1024 * 1024 * 2};
  GroupOrderT<true> S{(const int*)(lds + TAB_OFF), (const unsigned char*)((const int*)(lds + TAB_OFF) + 80), nb, bid, ws_list(p)};
  EpiSwiGLU E{ws_hidp(p)};
  pg8::gemm_phase<EpiSwiGLU, GroupOrderT<true>, true, true>((PG8_LAS unsigned char*)lds, g, S, E);
  __syncthreads();
}
struct EpiYP { static constexpr bool PERM = true, AFTER_DRAIN = false; bf16_t* O; const int* list; const float* wa; const int* T;
  DI void operator()(const f32x4 (&acc)[2][2][4][2], const pg8::Unit& u, int wr, int wc, int fr, int fq) const {
    const int cnt = T[u.e], rbase = (u.pm - T[32 + u.e]) * 256 + wr * 64 + fr, col0 = u.pn * 256 + wc * 32 + 8 * fq;
    int aid[8]; float wv[8];
#pragma unroll
    for (int i = 0; i < 8; ++i) { const int r = rbase + (i >> 2) * 128 + (i & 3) * 16, li = u.e * LCAP + (r < cnt ? r : cnt - 1); aid[i] = list[li]; wv[i] = wa[li]; }
#pragma unroll
    for (int ai = 0; ai < 2; ++ai)
#pragma unroll
      for (int m = 0; m < 4; ++m) { const int r = rbase + ai * 128 + m * 16;
        if (r < cnt) { const float wq = wv[ai * 4 + m]; bf16_t* rowp = O + (size_t)aid[ai * 4 + m] * DM + col0;
#pragma unroll
          for (int bj = 0; bj < 2; ++bj) { const f32x4 v0 = acc[ai][bj][m][0] * wq, v1 = acc[ai][bj][m][1] * wq;
            u32x4 w; w.x = cvtpk(v0[0], v0[1]); w.y = cvtpk(v0[2], v0[3]); w.z = cvtpk(v1[0], v1[1]); w.w = cvtpk(v1[2], v1[3]);
            *(u32x4*)(rowp + bj * 128) = w; } } }
  } };
DI void phase9_pg8(const Params& p, int bid, int nb, char* lds) {
  pg8::Gemm g{ws_hidp(p), ws_wd(p), 0, 1024, DEXP, (size_t)1024 * 512 * 2};
  GroupOrder S{(const int*)(lds + TAB_OFF), (const unsigned char*)((const int*)(lds + TAB_OFF) + 80), nb, bid, nullptr};
  EpiYP E{ws_ybuf(p), ws_list(p), ws_lw(p), (const int*)(lds + TAB_OFF)};
  pg8::gemm_phase<EpiYP, GroupOrder, true, true>((PG8_LAS unsigned char*)lds, g, S, E);
  __syncthreads();
}

typedef float f32x4m __attribute__((ext_vector_type(4)));
constexpr int H_LD = 1028;
DI void split8(const float* x, bf16x8& hi, bf16x8& lo) {
  u32x4 wh, wl; float r[8];
  wh.x = cvtpk(x[0], x[1]); wh.y = cvtpk(x[2], x[3]); wh.z = cvtpk(x[4], x[5]); wh.w = cvtpk(x[6], x[7]);
  r[0] = x[0] - __uint_as_float(wh.x << 16); r[1] = x[1] - __uint_as_float(wh.x & 0xffff0000u); r[2] = x[2] - __uint_as_float(wh.y << 16); r[3] = x[3] - __uint_as_float(wh.y & 0xffff0000u);
  r[4] = x[4] - __uint_as_float(wh.z << 16); r[5] = x[5] - __uint_as_float(wh.z & 0xffff0000u); r[6] = x[6] - __uint_as_float(wh.w << 16); r[7] = x[7] - __uint_as_float(wh.w & 0xffff0000u);
  wl.x = cvtpk(r[0], r[1]); wl.y = cvtpk(r[2], r[3]); wl.z = cvtpk(r[4], r[5]); wl.w = cvtpk(r[6], r[7]);
  hi = *reinterpret_cast<bf16x8*>(&wh); lo = *reinterpret_cast<bf16x8*>(&wl);
}
DI void phase7(const Params& p, int bid, int nb, char* lds) {
  const int t = tid_(), lane = t & 63, wid = t >> 6, l16 = lane & 15, lg4 = lane >> 4;
  float* H = (float*)lds;
  float* part = H + 16 * H_LD;
  float* lgt = part + 8 * 16 * 48;
  int* ecnt = (int*)(lgt + 16 * 16 * 48);
  int* ebase = ecnt + 32;
  int* sl_aid = ebase + 32;
  int* sl_e = sl_aid + 512;
  float* sl_w = (float*)(sl_e + 512);
  float* rbias = sl_w + 512;
  const float* mod = ws_mod(p);
  if (t < NEXP) ecnt[t] = 0;
  if (t < 36) rbias[t] = (t < 32) ? p.b_expert[t] : p.b_group[t - 32];
  int nloc = 0;
  bf16x8 rbh[4][3], rbl[4][3];
  {
#pragma unroll
    for (int ks = 0; ks < 4; ++ks)
#pragma unroll
      for (int nt = 0; nt < 3; ++nt) {
        float w[8];
#pragma unroll
        for (int j = 0; j < 8; ++j) { const int k = wid * 128 + ks * 32 + lg4 * 8 + j;
          w[j] = (nt < 2) ? p.w_expert[(size_t)k * 32 + nt * 16 + l16] : ((l16 < 4) ? p.w_group[(size_t)k * 4 + (l16 & 3)] : 0.f); }
        split8(w, rbh[ks][nt], rbl[ks][nt]);
      }
  }
  u32x2 pv[2][4];
#define P7_PF(tile_) do { _Pragma("unroll") for (int q_ = 0; q_ < 2; ++q_) { const bf16_t* xr_ = ws_x1(p) + (size_t)((tile_) * 16 + wid * 2 + q_) * DM + lane * 4; \
      _Pragma("unroll") for (int i_ = 0; i_ < 4; ++i_) pv[q_][i_] = *(const u32x2*)(xr_ + 256 * i_); } } while (0)
  f32x4 gv[4], psh[4], psc[4];
#pragma unroll
  for (int i = 0; i < 4; ++i) gv[i] = *(const f32x4*)(p.norm2_g + lane * 4 + 256 * i);
#define P7_PM(tile_) do { const float* mb_ = mod + (((tile_) * 16) >> 11) * 6144 + lane * 4; _Pragma("unroll") for (int i_ = 0; i_ < 4; ++i_) { psh[i_] = *(const f32x4*)(mb_ + 3072 + 256 * i_); psc[i_] = *(const f32x4*)(mb_ + 4096 + 256 * i_); } } while (0)
  if (bid < NTOK / 16) { P7_PF(bid); P7_PM(bid); }
  for (int tile = bid; tile < NTOK / 16; tile += nb) {
    __syncthreads();
#pragma unroll
    for (int q = 0; q < 2; ++q) {
      const int tl = wid * 2 + q, gt = tile * 16 + tl, b = gt >> 11;
      f32x4 v[4]; float ss = 0.f;
#pragma unroll
      for (int i = 0; i < 4; ++i) { v[i] = unpack4(pv[q][i]); ss += v[i][0] * v[i][0] + v[i][1] * v[i][1] + v[i][2] * v[i][2] + v[i][3] * v[i][3]; }
      ss = wave_sum(ss);
      const float rstd = rsqrtf(ss * (1.0f / DM) + 1e-6f);
#pragma unroll
      for (int i = 0; i < 4; ++i) {
        const int col = lane * 4 + 256 * i;
        const f32x4 g = gv[i], sh = psh[i], sc = psc[i];
        f32x4 o;
#pragma unroll
        for (int j = 0; j < 4; ++j) o[j] = v[i][j] * rstd * g[j] * (1.0f + sc[j]) + sh[j];
        *(f32x4*)(H + tl * H_LD + col) = o;
        u32x2 w; w.x = cvtpk(o[0], o[1]); w.y = cvtpk(o[2], o[3]);
        *(u32x2*)(ws_h2(p) + (size_t)gt * DM + col) = w;
      }
    }
    if (tile + nb < NTOK / 16) { P7_PF(tile + nb); P7_PM(tile + nb); }
    __syncthreads();
    {
      f32x4m acc0 = {0.f, 0.f, 0.f, 0.f}, acc1 = acc0, acc2 = acc0;
      const float* hrow = H + l16 * H_LD + wid * 128 + lg4 * 8;
#pragma unroll
      for (int ks = 0; ks < 4; ++ks) {
        const f32x4 h0 = *(const f32x4*)(hrow + ks * 32), h1 = *(const f32x4*)(hrow + ks * 32 + 4);
        const float hv[8] = {h0[0], h0[1], h0[2], h0[3], h1[0], h1[1], h1[2], h1[3]};
        bf16x8 ah, al; split8(hv, ah, al);
        acc0 = __builtin_amdgcn_mfma_f32_16x16x32_bf16(al, rbh[ks][0], acc0, 0, 0, 0); acc1 = __builtin_amdgcn_mfma_f32_16x16x32_bf16(al, rbh[ks][1], acc1, 0, 0, 0); acc2 = __builtin_amdgcn_mfma_f32_16x16x32_bf16(al, rbh[ks][2], acc2, 0, 0, 0);
        acc0 = __builtin_amdgcn_mfma_f32_16x16x32_bf16(ah, rbl[ks][0], acc0, 0, 0, 0); acc1 = __builtin_amdgcn_mfma_f32_16x16x32_bf16(ah, rbl[ks][1], acc1, 0, 0, 0); acc2 = __builtin_amdgcn_mfma_f32_16x16x32_bf16(ah, rbl[ks][2], acc2, 0, 0, 0);
        acc0 = __builtin_amdgcn_mfma_f32_16x16x32_bf16(ah, rbh[ks][0], acc0, 0, 0, 0); acc1 = __builtin_amdgcn_mfma_f32_16x16x32_bf16(ah, rbh[ks][1], acc1, 0, 0, 0); acc2 = __builtin_amdgcn_mfma_f32_16x16x32_bf16(ah, rbh[ks][2], acc2, 0, 0, 0);
      }
#pragma unroll
      for (int r = 0; r < 4; ++r) {
        float* pr = part + (wid * 16 + lg4 * 4 + r) * 48;
        pr[l16] = acc0[r]; pr[16 + l16] = acc1[r]; pr[32 + l16] = acc2[r];
      }
    }
    __syncthreads();
    for (int idx = t; idx < 16 * 36; idx += NTHR) {
      const int tok = idx / 36, o = idx % 36;
      float sacc = 0.f;
#pragma unroll
      for (int w = 0; w < 8; ++w) sacc += part[(w * 16 + tok) * 48 + o];
      sacc += rbias[o];
      lgt[(nloc * 16 + tok) * 48 + o] = sacc;
    }
    ++nloc;
  }
  __syncthreads();
  for (int idx = t; idx < nloc * 16; idx += NTHR) {
    {
      const int kl = idx >> 4, t16 = idx & 15, tile = bid + kl * nb;
      const float* l = lgt + idx * 48;
      int gs = 0; float gm = l[32];
      for (int g = 1; g < 4; ++g) if (l[32 + g] > gm) { gm = l[32 + g]; gs = g; }
      float gsum = 0.f;
      for (int g = 0; g < 4; ++g) gsum += expf(l[32 + g] - gm);
      const float pgroup = 1.0f / gsum;
      const float* el = l + gs * 8;
      float em = el[0];
      for (int e = 1; e < 8; ++e) em = fmaxf(em, el[e]);
      float pe[8], esum = 0.f;
      for (int e = 0; e < 8; ++e) { pe[e] = expf(el[e] - em); esum += pe[e]; }
      for (int e = 0; e < 8; ++e) pe[e] /= esum;
      int i0 = 0;
      for (int e = 1; e < 8; ++e) if (pe[e] > pe[i0]) i0 = e;
      int i1 = (i0 == 0) ? 1 : 0;
      for (int e = 0; e < 8; ++e) if (e != i0 && pe[e] > pe[i1]) i1 = e;
      const float den = pe[i0] + pe[i1];
      const int tok = tile * 16 + t16;
      const int e0 = gs * 8 + i0, e1 = gs * 8 + i1;
      const float wa0 = pgroup * pe[i0] / den, wa1 = pgroup * pe[i1] / den;
      ws_wa(p)[tok * 2] = wa0; ws_wa(p)[tok * 2 + 1] = wa1;
      const int slot = kl * 32 + t16 * 2;
      sl_aid[slot] = tok * 2; sl_aid[slot + 1] = tok * 2 + 1; sl_w[slot] = wa0; sl_w[slot + 1] = wa1;
      sl_e[slot] = e0 | (atomicAdd(ecnt + e0, 1) << 8); sl_e[slot + 1] = e1 | (atomicAdd(ecnt + e1, 1) << 8);
    }
  }
  __syncthreads();
  if (t < NEXP) ebase[t] = ecnt[t] ? atomicAdd(ws_cnt(p) + t, ecnt[t]) : 0;
  __syncthreads();
  for (int sidx = t; sidx < nloc * 32; sidx += NTHR) { const int ev = sl_e[sidx], e = ev & 255, r = ev >> 8; ws_list(p)[e * LCAP + ebase[e] + r] = sl_aid[sidx]; ws_lw(p)[e * LCAP + ebase[e] + r] = sl_w[sidx]; }
}
DI void phase7_tr(const Params& p, int bid, int nb, char* lds) {
  const int t = tid_();
  {
    float* tile = (float*)lds;
    const int ln4 = (t & 31) * 4, lkr = t >> 5, snr = t >> 2, skc = (t & 3) * 16;
#define MOE_TSRC(task_, src_, k0_, n0_, N_) const float* src_; int k0_, n0_, N_; { const int wh_ = (task_) >> 11, q_ = (task_) & 2047, e_ = q_ >> 6, r_ = q_ & 63; \
      if (wh_ < 2) { k0_ = (r_ >> 2) * 64; n0_ = (r_ & 3) * 128; N_ = 512; src_ = (wh_ == 0 ? p.e_gate : p.e_up) + (size_t)e_ * 1024 * 512; } \
      else { k0_ = (r_ >> 3) * 64; n0_ = (r_ & 7) * 128; N_ = 1024; src_ = p.e_down + (size_t)e_ * 512 * 1024; } }
    f32x4 g[4];
    int task = bid;
    if (task < 6144) { MOE_TSRC(task, src, k0, n0, N);
#pragma unroll
      for (int i = 0; i < 4; ++i) g[i] = *(const f32x4*)(src + (size_t)(k0 + lkr + 16 * i) * N + n0 + ln4); }
    for (; task < 6144; task += nb) {
      __syncthreads();
#pragma unroll
      for (int i = 0; i < 4; ++i) { float* d = tile + (lkr + 16 * i) * 129 + ln4; d[0] = g[i][0]; d[1] = g[i][1]; d[2] = g[i][2]; d[3] = g[i][3]; }
      if (task + nb < 6144) { MOE_TSRC(task + nb, src, k0, n0, N);
#pragma unroll
        for (int i = 0; i < 4; ++i) g[i] = *(const f32x4*)(src + (size_t)(k0 + lkr + 16 * i) * N + n0 + ln4); }
      __syncthreads();
      const int which = task >> 11, q = task & 2047, e = q >> 6, r = q & 63;
      float v[16];
#pragma unroll
      for (int j = 0; j < 16; ++j) v[j] = tile[(skc + j) * 129 + snr];
      u32x4 w0, w1;
      w0.x = cvtpk(v[0], v[1]); w0.y = cvtpk(v[2], v[3]); w0.z = cvtpk(v[4], v[5]); w0.w = cvtpk(v[6], v[7]);
      w1.x = cvtpk(v[8], v[9]); w1.y = cvtpk(v[10], v[11]); w1.z = cvtpk(v[12], v[13]); w1.w = cvtpk(v[14], v[15]);
      bf16_t* dst;
      if (which < 2) { const int k0 = (r >> 2) * 64, n = (r & 3) * 128 + snr; dst = ws_wgu(p) + (size_t)e * 1024 * 1024 + (size_t)((n >> 7) * 256 + (n & 127) + which * 128) * 1024 + k0 + skc; }
      else { const int k0 = (r >> 3) * 64, n = (r & 7) * 128 + snr; dst = ws_wd(p) + (size_t)e * 1024 * 512 + (size_t)n * 512 + k0 + skc; }
      *(u32x4*)dst = w0; *(u32x4*)(dst + 8) = w1;
    }
  }
}

struct Seg { int e, r0, cnt, start; };
DI Seg find_seg(const int* cnt, int mtile) {
  Seg s; s.e = -1; int acc = 0, start = 0;
  for (int e = 0; e < NEXP; ++e) { const int c = cnt[e], nt = (c + GBM - 1) / GBM; if (mtile < acc + nt) { s.e = e; s.r0 = (mtile - acc) * GBM; s.cnt = c; s.start = start; return s; } acc += nt; start += c; }
  return s;
}
struct ARowList { const int* list; int r0, cnt; DI int operator()(int r) const { int q = r0 + r; q = q < cnt ? q : cnt - 1; return list[q] >> 1; } };
struct EpiHid { bf16_t* o; int row0, nvalid, col0; DI void operator()(int r, int c, float g, float u) const {
  if (r < nvalid) o[(size_t)(row0 + r) * DEXP + ((col0 + c) >> 6) * 32 + (c & 31)] = f2bf(g / (1.0f + __expf(-g)) * u); } };
DI void phase8(const Params& p, int bid, int nb, char* lds) {
  const int* cnt = ws_cnt(p);
  for (int tile = bid; tile < 288 * 8; tile += nb) {
    const Seg s = find_seg(cnt, tile >> 3);
    if (s.e < 0) break;
    const int nt = tile & 7;
    gemm_tile(ws_h2(p), DM, ARowList{ws_list(p) + s.e * LCAP, s.r0, s.cnt}, ws_wgu(p) + (size_t)s.e * 1024 * 1024, DM, nt * GBN, DM,
              EpiHid{ws_hid(p), s.start + s.r0, s.cnt - s.r0, nt * GBN}, lds);
  }
}
struct ARowClamp { int base, r0, cnt; DI int operator()(int r) const { int q = r0 + r; q = q < cnt ? q : cnt - 1; return base + q; } };
struct EpiY { bf16_t* o; const int* list; const float* wa; int r0, cnt, col0; DI void operator()(int r, int c, float v0, float v1) const {
  if (r0 + r < cnt) { const int aid = list[r0 + r]; const float w = wa[aid]; bf16_t* q = o + (size_t)aid * DM + col0 + c; q[0] = f2bf(v0 * w); q[32] = f2bf(v1 * w); } } };
DI void phase9(const Params& p, int bid, int nb, char* lds) {
  const int* cnt = ws_cnt(p);
  for (int tile = bid; tile < 288 * 8; tile += nb) {
    const Seg s = find_seg(cnt, tile >> 3);
    if (s.e < 0) break;
    const int nt = tile & 7;
    gemm_tile(ws_hid(p), DEXP, ARowClamp{s.start, s.r0, s.cnt}, ws_wd(p) + (size_t)s.e * 1024 * 512, DEXP, nt * GBN, DEXP,
              EpiY{ws_ybuf(p), ws_list(p) + s.e * LCAP, ws_wa(p), s.r0, s.cnt, nt * GBN}, lds);
  }
}

DI void phase10(const Params& p, int bid, int nb, char* lds) {
  const int lane = tid_() & 63, wid = tid_() >> 6;
  const float* mod = ws_mod(p); const float* fm = ws_fmod(p);
  u32x2 px[4], pa[4], pb[4];
#define P10_PF(gt_) do { const bf16_t* xr_ = ws_x1(p) + (size_t)(gt_) * DM + lane * 4; const bf16_t* ya_ = ws_ybuf(p) + (size_t)((gt_) * 2) * DM + lane * 4; \
    _Pragma("unroll") for (int i_ = 0; i_ < 4; ++i_) { px[i_] = *(const u32x2*)(xr_ + 256 * i_); pa[i_] = *(const u32x2*)(ya_ + 256 * i_); pb[i_] = *(const u32x2*)(ya_ + DM + 256 * i_); } } while (0)
  if (bid * 8 + wid < NTOK) P10_PF(bid * 8 + wid);
  for (int gt = bid * 8 + wid; gt < NTOK; gt += nb * 8) {
    const int b = gt >> 11;
    float* xo = p.out + (size_t)gt * DM;
    u32x2 cx[4], ca[4], cb[4];
#pragma unroll
    for (int i = 0; i < 4; ++i) { cx[i] = px[i]; ca[i] = pa[i]; cb[i] = pb[i]; }
    if (gt + nb * 8 < NTOK) P10_PF(gt + nb * 8);
    __builtin_amdgcn_sched_barrier(0);
    f32x4 v[4]; float ss = 0.f;
#pragma unroll
    for (int i = 0; i < 4; ++i) {
      const int col = lane * 4 + 256 * i;
      v[i] = unpack4(cx[i]);
      const u32x2 a = ca[i], bq = cb[i];
      const f32x4 g2 = *(const f32x4*)(mod + b * 6144 + 5120 + col);
      const float m0 = __uint_as_float(a.x << 16) + __uint_as_float(bq.x << 16), m1 = __uint_as_float(a.x & 0xffff0000u) + __uint_as_float(bq.x & 0xffff0000u);
      const float m2 = __uint_as_float(a.y << 16) + __uint_as_float(bq.y << 16), m3 = __uint_as_float(a.y & 0xffff0000u) + __uint_as_float(bq.y & 0xffff0000u);
      v[i][0] += (1.0f + g2[0]) * m0; v[i][1] += (1.0f + g2[1]) * m1; v[i][2] += (1.0f + g2[2]) * m2; v[i][3] += (1.0f + g2[3]) * m3;
      ss += v[i][0] * v[i][0] + v[i][1] * v[i][1] + v[i][2] * v[i][2] + v[i][3] * v[i][3];
    }
    ss = wave_sum(ss);
    const float rstd = rsqrtf(ss * (1.0f / DM) + 1e-6f);
#pragma unroll
    for (int i = 0; i < 4; ++i) {
      const int col = lane * 4 + 256 * i;
      const f32x4 g = *(const f32x4*)(p.final_norm_g + col), sh = *(const f32x4*)(fm + b * 2048 + col), sc = *(const f32x4*)(fm + b * 2048 + 1024 + col);
      f32x4 o;
#pragma unroll
      for (int j = 0; j < 4; ++j) o[j] = v[i][j] * rstd * g[j] * (1.0f + sc[j]) + sh[j];
      *(f32x4*)(xo + col) = o;
    }
  }
}

#define XB_TMO      128
#define XB_XCNT(j)  (256  + 64 * (j))
#define XB_XSUB(j)  (1280 + 64 * (j))
#define XB_XGEN(j)  (2304 + 64 * (j))
#define XB_TOP      3328
#define XB_TOPGEN   3392
#define XCD_BAR_WORDS 3456
#define XB_SPIN_CAP (1u << 18)
#define XLAS __attribute__((address_space(3)))

__device__ __forceinline__ unsigned xb_ld(unsigned* p)              { return __hip_atomic_load(p, __ATOMIC_RELAXED, __HIP_MEMORY_SCOPE_AGENT); }
__device__ __forceinline__ unsigned xb_add(unsigned* p, unsigned v) { return __hip_atomic_fetch_add(p, v, __ATOMIC_RELAXED, __HIP_MEMORY_SCOPE_AGENT); }
__device__ __forceinline__ unsigned xb_xcc_id() { return (unsigned)__builtin_amdgcn_s_getreg((3 << 11) | 20) & 0xFu; }
#define XB_SPIN(cond, bar) do { unsigned _sp = 0; while (cond) { __builtin_amdgcn_s_sleep(1); \
    if ((++_sp & 255u) == 0u) { if (xb_ld(&(bar)[XB_TMO])) break; if (_sp > XB_SPIN_CAP) { atomicAdd(&(bar)[XB_TMO], 1u); break; } } } } while (0)

struct XcdBarrier {
    unsigned* bar; unsigned x;
    volatile XLAS unsigned* st;
};

__device__ __forceinline__ XcdBarrier xcd_barrier_post(unsigned* bar, volatile XLAS unsigned* st) {
    XcdBarrier b; b.bar = bar; b.x = xb_xcc_id(); b.st = st;
    if (tid_() == 0) (void)xb_add(&bar[XB_XCNT(b.x)], 1u);
    return b;
}
__device__ __forceinline__ void xcd_barrier_complete(unsigned* bar, unsigned x, unsigned& nloc, unsigned& nx) {
    const unsigned G = gridDim.x * gridDim.y * gridDim.z;
    unsigned sum, cnt, mine, sp = 0u;
    for (;;) {
        sum = 0u; cnt = 0u; mine = 0u;
#pragma unroll
        for (unsigned j = 0; j < 16; ++j) { const unsigned c = xb_ld(&bar[XB_XCNT(j)]); sum += c; cnt += (c > 0u) ? 1u : 0u; mine = (j == x) ? c : mine; }
        if (sum == G) break;
        __builtin_amdgcn_s_sleep(1);
        if ((++sp & 255u) == 0u) { if (xb_ld(&bar[XB_TMO])) break; if (sp > XB_SPIN_CAP) { atomicAdd(&bar[XB_TMO], 1u); break; } }
    }
    nloc = mine > 0u ? mine : 1u; nx = cnt > 0u ? cnt : 1u;
}

__device__ __forceinline__ void xcd_barrier(const XcdBarrier& b) {
    asm volatile("s_waitcnt vmcnt(0)" ::: "memory");
    __syncthreads();
    if (tid_() == 0) {
        unsigned* bar = b.bar;
        __builtin_amdgcn_s_waitcnt(0);
        unsigned nloc = b.st[0], nx = b.st[1];
        if (nloc == 0u) { xcd_barrier_complete(bar, b.x, nloc, nx); b.st[0] = nloc; b.st[1] = nx; }
        const unsigned old = xb_add(&bar[XB_XSUB(b.x)], 1u);
        const unsigned gen = old / nloc;
        if (old + 1u == (gen + 1u) * nloc) {
            __builtin_amdgcn_fence(__ATOMIC_RELEASE, "agent");
            asm volatile("s_waitcnt vmcnt(0)" ::: "memory");
            const unsigned og = xb_add(&bar[XB_TOP], 1u);
            const unsigned tg = og / nx;
            if (og + 1u == (tg + 1u) * nx) xb_add(&bar[XB_TOPGEN], 1u);
            else XB_SPIN(xb_ld(&bar[XB_TOPGEN]) == tg, bar);
            __builtin_amdgcn_fence(__ATOMIC_ACQUIRE, "agent");
            xb_add(&bar[XB_XGEN(b.x)], 1u);
            asm volatile("s_waitcnt vmcnt(0)" ::: "memory");
        } else {
            XB_SPIN(xb_ld(&bar[XB_XGEN(b.x)]) == gen, bar);
            __builtin_amdgcn_fence(__ATOMIC_ACQUIRE, "agent");
            asm volatile("s_waitcnt vmcnt(0)" ::: "memory");
        }
    }
    __syncthreads();
}

#if MEGA
__global__ void __launch_bounds__(NTHR) k_mega(Params p) {
  extern __shared__ __attribute__((aligned(16))) char smem[];
  const int bid = blockIdx.x, nb = gridDim.x;
  volatile XLAS unsigned* xst = (volatile XLAS unsigned*)(XLAS char*)(smem + LDS_BYTES - 64);
  { const int t0 = tid_(); if (t0 < 4) xst[t0] = 0u; }
  __syncthreads();
  XcdBarrier xb = xcd_barrier_post(ws_bar(p), xst);
#define SEAM() xcd_barrier(xb)
  phase0(p, bid, nb, smem); SEAM();
  phase1(p, bid, nb, smem); SEAM();
  phase2_pg8(p, bid, nb, smem); SEAM();
  phase3_mfma<3>(p, bid, nb, smem); SEAM();
  phase4a_chunk(p, bid, nb, smem); phase4b_mfma(p, bid, nb, smem); SEAM();
  phase5a(p, bid, nb, smem); phase5b_mfma(p, bid, nb, smem); SEAM();
  phase6_pg8(p, bid, nb, smem); SEAM();
  phase7(p, bid, nb, smem); SEAM();
  phase8_pg8(p, bid, nb, smem); SEAM();
  phase9_pg8(p, bid, nb, smem); SEAM();
  phase10(p, bid, nb, smem);
}
#else
#define PHASE_KERNEL(name, body) __global__ void __launch_bounds__(NTHR) name(Params p) { extern __shared__ __attribute__((aligned(16))) char smem[]; body(p, blockIdx.x, gridDim.x, smem); }
PHASE_KERNEL(k_phase0, phase0)
PHASE_KERNEL(k_phase1, phase1)
PHASE_KERNEL(k_phase2, phase2)
PHASE_KERNEL(k_phase3a, phase3a)
PHASE_KERNEL(k_phase3b, phase3b)
PHASE_KERNEL(k_phase4a, phase4a)
PHASE_KERNEL(k_phase4a2, phase4a_v2)
PHASE_KERNEL(k_phase4a3, phase4a_v3)
PHASE_KERNEL(k_phase4b, phase4b)
PHASE_KERNEL(k_phase4bm, phase4b_mfma)
PHASE_KERNEL(k_phase3m, phase3_mfma<3>)
PHASE_KERNEL(k_phase5a, phase5a)
PHASE_KERNEL(k_phase5b, phase5b)
PHASE_KERNEL(k_phase5bm, phase5b_mfma)
PHASE_KERNEL(k_phase6, phase6)
PHASE_KERNEL(k_phase7, phase7)
PHASE_KERNEL(k_phase8, phase8)
PHASE_KERNEL(k_phase9, phase9)
PHASE_KERNEL(k_phase10, phase10)
#endif

extern "C" void kernel_launch(void* const* d_in, const int* in_sizes, int n_in, void* d_out, int out_size, void* d_ws, size_t ws_size, hipStream_t stream) {
  Params p{};
  const float** f = (const float**)&p;
  for (int i = 0; i < 33; ++i) f[i] = (const float*)d_in[i];
  p.out = (float*)d_out; p.ws = (char*)d_ws;
  if (n_in != 33 || ws_size < (size_t)(OFF_S + 9 * MiB) || out_size != NTOK * DM) { fprintf(stderr, "kernel_launch: unexpected problem shape or workspace (n_in %d, ws %zu, out %d)\n", n_in, ws_size, out_size); return; }
#if MEGA
  static int grid_blocks = 0;
  if (!grid_blocks) {
    int dev = 0, cus = 0, per_cu = 0;
    hipGetDevice(&dev);
    hipDeviceGetAttribute(&cus, hipDeviceAttributeMultiprocessorCount, dev);
    hipFuncSetAttribute((const void*)k_mega, hipFuncAttributeMaxDynamicSharedMemorySize, LDS_BYTES);
    hipOccupancyMaxActiveBlocksPerMultiprocessor(&per_cu, k_mega, NTHR, LDS_BYTES);
    if (per_cu > 1) per_cu = 1;
    grid_blocks = cus * per_cu;
  }
  void* args[] = {&p};
  (void)hipMemsetAsync(p.ws + OFF_S + 8 * MiB, 0, XCD_BAR_WORDS * sizeof(unsigned), stream);
  hipError_t e = hipLaunchCooperativeKernel((void*)k_mega, dim3(grid_blocks), dim3(NTHR), args, LDS_BYTES, stream);
  if (e != hipSuccess) fprintf(stderr, "cooperative launch failed: %s (grid %d)\n", hipGetErrorString(e), grid_blocks);
#else
  const int G = 512;
#define LAUNCH(k, g) hipLaunchKernelGGL(k, dim3(g), dim3(NTHR), LDS_BYTES, stream, p)
  LAUNCH(k_phase0, G);
  LAUNCH(k_phase1, G);
  LAUNCH(k_phase2, G);
  LAUNCH(k_phase3a, G);
  LAUNCH(k_phase3b, G);
  LAUNCH(k_phase4a, 128);
  LAUNCH(k_phase4b, 1024);
  LAUNCH(k_phase5a, G);
  LAUNCH(k_phase5b, 1024);
  LAUNCH(k_phase6, G);
  LAUNCH(k_phase7, G);
  LAUNCH(k_phase8, G);
  LAUNCH(k_phase9, G);
  LAUNCH(k_phase10, G);
#endif
}
```
